# Optimizing an MI355X kernel written in HIP

```python
import math
import jax, jax.numpy as jnp
from jax import lax
import numpy as np

D_MODEL = 2048
BATCH = 2
SEQ = 4096
DEPTH = 2

GRID_W = 64
CTX_LEN = 256
D_FF = 5504
N_MOD = 9
CHUNK = 128
A_WIDTH = 1024
A_GROUPS = 8
A_GROUP_DIM = A_WIDTH // A_GROUPS
B_WIDTH = 1024
B_HEAD_DIM = 64
B_HEADS = B_WIDTH // B_HEAD_DIM
DECAY_LORA = 96
ICL_LORA = 96
GATE_LORA = 256
C_HEADS = 8
C_HEAD_DIM = 64
C_WIDTH = C_HEADS * 2 * C_HEAD_DIM
BRANCH_W = 1024
N_BRANCH = 3
PROJ_SIZES = (A_WIDTH, A_WIDTH, 3 * B_WIDTH, GATE_LORA, 2 * DECAY_LORA, 2 * ICL_LORA, 3 * C_WIDTH, N_BRANCH * D_MODEL)
PROJ_W = sum(PROJ_SIZES)
ROPE_BASE = 10000.0
ROPE_AXIS_DIM = C_HEAD_DIM // 2
Q_BLOCK = 128
NORM_EPS = 1e-6
LN_X_EPS = 64e-5

kernel_name = 'hybrid_prefix_gmlp_rwkv7_diffattn_block'


def rms_norm(x, g, eps=NORM_EPS):
    x32 = x.astype(jnp.float32)
    y = x32 * lax.rsqrt(jnp.mean(x32 * x32, axis=-1, keepdims=True) + eps)
    return (y * g.astype(jnp.float32)).astype(x.dtype)


def modulate(h, shift, scale):
    return h * (1 + scale) + shift


def swiglu(h, w_in, w_out):
    gate, up = jnp.split(h @ w_in, 2, axis=-1)
    return (jax.nn.silu(gate) * up) @ w_out


def split_proj(p):
    out, start = [], 0
    for n in PROJ_SIZES:
        out.append(p[..., start:start + n])
        start += n
    return out


def conv3_centered(x, w):
    xp = jnp.pad(x, ((0, 0), (1, 1), (0, 0)))
    return xp[:, :-2] * w[0] + xp[:, 1:-1] * w[1] + xp[:, 2:] * w[2]


def rope_tables(n_tokens, dtype):
    rows = n_tokens // GRID_W
    row = jnp.repeat(jnp.arange(rows), GRID_W).astype(jnp.float32)
    col = jnp.tile(jnp.arange(GRID_W), rows).astype(jnp.float32)
    inv = 1.0 / (ROPE_BASE ** (jnp.arange(0, ROPE_AXIS_DIM, 2, dtype=jnp.float32) / ROPE_AXIS_DIM))
    ar, ac = row[:, None] * inv, col[:, None] * inv
    return tuple(t[:, None, None, :].astype(dtype) for t in (jnp.cos(ar), jnp.sin(ar), jnp.cos(ac), jnp.sin(ac)))


def _rotate(x, cos, sin):
    x1, x2 = jnp.split(x, 2, axis=-1)
    return jnp.concatenate([x1 * cos - x2 * sin, x2 * cos + x1 * sin], axis=-1)


def rope_2d(x, tabs):
    cr, sr, cc, sc = tabs
    return jnp.concatenate([_rotate(x[..., :ROPE_AXIS_DIM], cr, sr), _rotate(x[..., ROPE_AXIS_DIM:], cc, sc)], axis=-1)


def gmlp_branch(pu, pv, v_norm, ws, bs):
    bn, t, _ = pu.shape
    u = jax.nn.gelu(pu)
    v = rms_norm(jax.nn.gelu(pv).reshape(bn, t, A_GROUPS, A_GROUP_DIM), v_norm.reshape(A_GROUPS, A_GROUP_DIM))
    v = v.reshape(bn, t // CHUNK, CHUNK, A_GROUPS, A_GROUP_DIM)
    sv = jnp.einsum('gpq,bnqgc->bnpgc', ws, v) + bs.T[:, :, None]
    return u * sv.reshape(bn, t, A_WIDTH)


def rwkv_prep(p_rkv, p_w, p_a, conv_w, w0, w_up, a0, a_up, k_k, k_a):
    r, k, v = jnp.split(conv3_centered(p_rkv, conv_w), 3, axis=-1)
    bn, t, _ = r.shape
    f32 = jnp.float32
    heads = lambda z: z.astype(f32).reshape(z.shape[:-1] + (B_HEADS, B_HEAD_DIM))
    w_lo = w0 + jnp.einsum('btdr,drc->btdc', jnp.tanh(p_w.reshape(bn, t, 2, DECAY_LORA)), w_up)
    decay = jnp.exp(-jnp.exp(-jax.nn.softplus(-w_lo.astype(f32)) - 0.5))
    a = jax.nn.sigmoid((a0 + jnp.einsum('btdr,drc->btdc', p_a.reshape(bn, t, 2, ICL_LORA), a_up)).astype(f32))
    kk = heads(k * k_k)
    kk = kk * lax.rsqrt(jnp.sum(kk * kk, axis=-1, keepdims=True) + 1e-12)
    k_dir = k.astype(f32)[:, :, None, :] * (1 + (a - 1) * k_a.astype(f32))
    return (heads(r), heads(k_dir), heads(v), kk, heads(decay), heads(a))


def wkv7_scan(s0, decay, k, v, kk, a, r, reverse):
    seqs = (decay, k, v, kk, kk * a) + ((r,) if r is not None else ())
    xs = tuple(jnp.moveaxis(z, 1, 0) for z in seqs)

    def step(s, inp):
        w_t, k_t, v_t, kk_t, b_t = inp[:5]
        sa = jnp.einsum('bhvk,bhk->bhv', s, kk_t)
        s = s * w_t[:, :, None, :] - sa[..., None] * b_t[:, :, None, :] + v_t[..., None] * k_t[:, :, None, :]
        if r is None:
            return s, None
        return s, jnp.einsum('bhvk,bhk->bhv', s, inp[5])

    s, ys = lax.scan(step, s0, xs, reverse=reverse)
    return s, (None if r is None else jnp.moveaxis(ys, 0, 1))


def rwkv_bidirectional(prep_l, prep_c, ctx_out):
    r_l, kd_l, v_l, kk_l, dec_l, a_l = prep_l
    r_c, kd_c, v_c, kk_c, dec_c, a_c = prep_c
    s0 = jnp.zeros((r_l.shape[0], B_HEADS, B_HEAD_DIM, B_HEAD_DIM), jnp.float32)
    o_l, o_c = None, None
    for d in (0, 1):
        rev = d == 1
        s_c, yc_d = wkv7_scan(s0, dec_c[:, :, d], kd_c[:, :, d], v_c, kk_c, a_c[:, :, d], r_c if ctx_out else None, rev)
        _, yl_d = wkv7_scan(s_c, dec_l[:, :, d], kd_l[:, :, d], v_l, kk_l, a_l[:, :, d], r_l, rev)
        o_l = yl_d if o_l is None else o_l + yl_d
        if ctx_out:
            o_c = yc_d if o_c is None else o_c + yc_d
    return o_l, o_c


def rwkv_out(y, prep, p_g, g_up, ln_g, ln_b, r_k, out_dtype):
    r, k_dir, v = prep[0], prep[1], prep[2]
    mu = jnp.mean(y, axis=-1, keepdims=True)
    var = jnp.mean(jnp.square(y - mu), axis=-1, keepdims=True)
    y = (y - mu) * lax.rsqrt(var + LN_X_EPS) * ln_g.reshape(B_HEADS, B_HEAD_DIM) + ln_b.reshape(B_HEADS, B_HEAD_DIM)
    k_bar = 0.5 * (k_dir[:, :, 0] + k_dir[:, :, 1])
    y = y + jnp.sum(r * k_bar * r_k, axis=-1, keepdims=True) * v
    g = jax.nn.sigmoid(p_g) @ g_up
    bn, t = y.shape[:2]
    return y.reshape(bn, t, B_WIDTH).astype(out_dtype) * g


def diff_heads(p):
    q, k, v = jnp.split(p, 3, axis=-1)
    bn, t, _ = p.shape
    return (q.reshape(bn, t, C_HEADS, 2, C_HEAD_DIM), k.reshape(bn, t, C_HEADS, 2, C_HEAD_DIM),
            v.reshape(bn, t, C_HEADS, 2 * C_HEAD_DIM))


def diff_attn(q, k, v, lam):
    s = jnp.einsum('bqhjd,bkhjd->bhjqk', q, k).astype(jnp.float32) * (C_HEAD_DIM ** -0.5)
    p = jax.nn.softmax(s, axis=-1)
    attn = p[:, :, 0] - lam * p[:, :, 1]
    return jnp.einsum('bhqk,bkhe->bqhe', attn.astype(v.dtype), v)


def diff_post(o, subln, lam_init):
    return (rms_norm(o, subln) * (1.0 - lam_init)).reshape(o.shape[0], o.shape[1], C_WIDTH)


def gated_merge(ys, p_gate, b_gate, w_branch, w_out):
    gates = jnp.split(p_gate, N_BRANCH, axis=-1)
    z = jax.nn.sigmoid(gates[0] + b_gate[0]) * (ys[0] @ w_branch[0])
    for i in range(1, N_BRANCH):
        z = z + jax.nn.sigmoid(gates[i] + b_gate[i]) * (ys[i] @ w_branch[i])
    return z @ w_out


def token_mixer(h, hc, lp, lam_init, tabs, ctx_out):
    pl = split_proj(h @ lp['w_in'])
    pc = split_proj(hc @ lp['w_in'])
    ya = gmlp_branch(pl[0], pl[1], lp['gm_v_norm'], lp['gm_ws'], lp['gm_bs'])
    rw_args = (lp['rw_conv'], lp['rw_w0'], lp['rw_w_up'], lp['rw_a0'], lp['rw_a_up'], lp['rw_k_k'], lp['rw_k_a'])
    prep_l = rwkv_prep(pl[2], pl[4], pl[5], *rw_args)
    prep_c = rwkv_prep(pc[2], pc[4], pc[5], *rw_args)
    o_l, o_c = rwkv_bidirectional(prep_l, prep_c, ctx_out)
    out_args = (lp['rw_g_up'], lp['rw_ln_g'], lp['rw_ln_b'], lp['rw_r_k'])
    yb = rwkv_out(o_l, prep_l, pl[3], *out_args, h.dtype)
    lam_v = lp['da_lam'].astype(jnp.float32)
    lam = jnp.exp(jnp.sum(lam_v[0] * lam_v[1])) - jnp.exp(jnp.sum(lam_v[2] * lam_v[3])) + lam_init
    ql, kl, vl = diff_heads(pl[6])
    ql = rope_2d(rms_norm(ql, lp['da_q_norm']), tabs)
    kl = rope_2d(rms_norm(kl, lp['da_k_norm']), tabs)
    qc_raw, kc_raw, vc = diff_heads(pc[6])
    kc = rms_norm(kc_raw, lp['da_k_norm'])
    k_all = jnp.concatenate([kl, kc], axis=1)
    v_all = jnp.concatenate([vl, vc], axis=1)
    bn, t = h.shape[0], h.shape[1]
    nb = t // Q_BLOCK
    qb = jnp.moveaxis(ql.reshape(bn, nb, Q_BLOCK, C_HEADS, 2, C_HEAD_DIM), 1, 0)
    ob = lax.map(lambda qq: diff_attn(qq, k_all, v_all, lam), qb)
    o = jnp.moveaxis(ob, 0, 1).reshape(bn, t, C_HEADS, 2 * C_HEAD_DIM)
    yc = diff_post(o, lp['da_subln'], lam_init)
    y = gated_merge([ya, yb, yc], pl[7], lp['b_gate'], lp['w_branch'], lp['w_out'])
    if not ctx_out:
        return y, None
    ya_c = gmlp_branch(pc[0], pc[1], lp['gm_v_norm'], lp['gm_ws'], lp['gm_bs'])
    yb_c = rwkv_out(o_c, prep_c, pc[3], *out_args, hc.dtype)
    qc = rms_norm(qc_raw, lp['da_q_norm'])
    yc_c = diff_post(diff_attn(qc, kc, vc, lam), lp['da_subln'], lam_init)
    y_ctx = gated_merge([ya_c, yb_c, yc_c], pc[7], lp['b_gate'], lp['w_branch'], lp['w_out'])
    return y, y_ctx


def layer_forward(x, xc, mod, modc, lp, lam_init, tabs, last):
    ada = lambda m, j: m[..., j:j + 1, :]

    def half_ffn(z, m, i, w):
        hn = modulate(rms_norm(z, lp['norm_g'][i]), ada(m, 3 * i), ada(m, 3 * i + 1))
        return z + 0.5 * ada(m, 3 * i + 2) * swiglu(hn, lp['ffn_w_in'][w], lp['ffn_w_out'][w])

    x = half_ffn(x, mod, 0, 0)
    xc = half_ffn(xc, modc, 0, 0)
    h = modulate(rms_norm(x, lp['norm_g'][1]), ada(mod, 3), ada(mod, 4))
    hc = modulate(rms_norm(xc, lp['norm_g'][1]), ada(modc, 3), ada(modc, 4))
    y, yc = token_mixer(h, hc, lp, lam_init, tabs, ctx_out=not last)
    x = x + ada(mod, 5) * y
    x = half_ffn(x, mod, 2, 1)
    if not last:
        xc = xc + ada(modc, 5) * yc
        xc = half_ffn(xc, modc, 2, 1)
    return x, xc


def setup_inputs(seed: int = 0) -> dict:
    key = jax.random.key(seed)
    ks = jax.random.split(key, 32)
    nrm = lambda k, shape, s: jax.random.normal(k, shape, jnp.float32) * s
    L = DEPTH
    return {
        'x': nrm(ks[0], (BATCH, SEQ, D_MODEL), 1.0),
        'c': nrm(ks[1], (BATCH, D_MODEL), 1.0),
        'ctx': nrm(ks[2], (BATCH, CTX_LEN, D_MODEL), 1.0),
        'c_ctx': nrm(ks[3], (D_MODEL,), 1.0),
        'w_ada': nrm(ks[4], (L, D_MODEL, N_MOD * D_MODEL), 0.5 * D_MODEL ** -0.5),
        'b_ada': nrm(ks[5], (L, N_MOD * D_MODEL), 0.02),
        'norm_g': 1.0 + nrm(ks[6], (L, 3, D_MODEL), 0.02),
        'ffn_w_in': nrm(ks[7], (L, 2, D_MODEL, 2 * D_FF), D_MODEL ** -0.5),
        'ffn_w_out': nrm(ks[8], (L, 2, D_FF, D_MODEL), D_FF ** -0.5),
        'w_in': nrm(ks[9], (L, D_MODEL, PROJ_W), D_MODEL ** -0.5),
        'gm_v_norm': 1.0 + nrm(ks[10], (L, A_WIDTH), 0.02),
        'gm_ws': nrm(ks[11], (L, A_GROUPS, CHUNK, CHUNK), CHUNK ** -0.5),
        'gm_bs': 1.0 + nrm(ks[12], (L, A_GROUPS, CHUNK), 0.02),
        'rw_conv': nrm(ks[13], (L, 3, 3 * B_WIDTH), 0.3).at[:, 1].add(1.0),
        'rw_w0': nrm(ks[14], (L, 2, B_WIDTH), 0.5),
        'rw_w_up': nrm(ks[15], (L, 2, DECAY_LORA, B_WIDTH), DECAY_LORA ** -0.5),
        'rw_a0': nrm(ks[16], (L, 2, B_WIDTH), 0.5),
        'rw_a_up': nrm(ks[17], (L, 2, ICL_LORA, B_WIDTH), ICL_LORA ** -0.5),
        'rw_g_up': nrm(ks[18], (L, GATE_LORA, B_WIDTH), GATE_LORA ** -0.5),
        'rw_k_k': 1.0 + nrm(ks[19], (L, B_WIDTH), 0.1),
        'rw_k_a': 1.0 + nrm(ks[20], (L, B_WIDTH), 0.1),
        'rw_r_k': nrm(ks[21], (L, B_HEADS, B_HEAD_DIM), 0.1),
        'rw_ln_g': 1.0 + nrm(ks[22], (L, B_WIDTH), 0.02),
        'rw_ln_b': nrm(ks[23], (L, B_WIDTH), 0.02),
        'da_q_norm': 1.0 + nrm(ks[24], (L, C_HEAD_DIM), 0.02),
        'da_k_norm': 1.0 + nrm(ks[25], (L, C_HEAD_DIM), 0.02),
        'da_lam': nrm(ks[26], (L, 4, C_HEAD_DIM), 0.1),
        'da_subln': 1.0 + nrm(ks[27], (L, 2 * C_HEAD_DIM), 0.02),
        'w_branch': nrm(ks[28], (L, N_BRANCH, BRANCH_W, D_MODEL), BRANCH_W ** -0.5),
        'b_gate': nrm(ks[29], (L, N_BRANCH, D_MODEL), 0.02),
        'w_out': nrm(ks[30], (L, D_MODEL, D_MODEL), D_MODEL ** -0.5),
    }


def reference(x, c, ctx, c_ctx, w_ada, b_ada, norm_g, ffn_w_in, ffn_w_out, w_in, gm_v_norm, gm_ws, gm_bs,
              rw_conv, rw_w0, rw_w_up, rw_a0, rw_a_up, rw_g_up, rw_k_k, rw_k_a, rw_r_k, rw_ln_g, rw_ln_b,
              da_q_norm, da_k_norm, da_lam, da_subln, w_branch, b_gate, w_out):
    tabs = rope_tables(x.shape[1], x.dtype)
    xc = ctx
    for l in range(DEPTH):
        lp = dict(norm_g=norm_g[l], ffn_w_in=ffn_w_in[l], ffn_w_out=ffn_w_out[l], w_in=w_in[l],
                  gm_v_norm=gm_v_norm[l], gm_ws=gm_ws[l], gm_bs=gm_bs[l], rw_conv=rw_conv[l],
                  rw_w0=rw_w0[l], rw_w_up=rw_w_up[l], rw_a0=rw_a0[l], rw_a_up=rw_a_up[l], rw_g_up=rw_g_up[l],
                  rw_k_k=rw_k_k[l], rw_k_a=rw_k_a[l], rw_r_k=rw_r_k[l], rw_ln_g=rw_ln_g[l], rw_ln_b=rw_ln_b[l],
                  da_q_norm=da_q_norm[l], da_k_norm=da_k_norm[l], da_lam=da_lam[l], da_subln=da_subln[l],
                  w_branch=w_branch[l], b_gate=b_gate[l], w_out=w_out[l])
        mod = (jax.nn.silu(c) @ w_ada[l] + b_ada[l]).reshape(c.shape[0], N_MOD, D_MODEL)
        modc = (jax.nn.silu(c_ctx) @ w_ada[l] + b_ada[l]).reshape(N_MOD, D_MODEL)
        lam_init = 0.8 - 0.6 * math.exp(-0.3 * l)
        x, xc = layer_forward(x, xc, mod, modc, lp, lam_init, tabs, last=(l == DEPTH - 1))
    return x
```

```cpp
#include <hip/hip_runtime.h>
#include <cstdio>
#include <cstdint>
namespace pg8 {
#define PG8_LAS __attribute__((address_space(3)))
typedef unsigned short bf16_t;
typedef short bf16x8 __attribute__((ext_vector_type(8)));
typedef float f32x4 __attribute__((ext_vector_type(4)));
typedef unsigned u32x4 __attribute__((ext_vector_type(4)));
constexpr int BM = 256, BK = 64, HALF = 128, HTB = HALF * BK * 2  , STAGE_BYTES = 8 * HTB, NXCD = 8, WGM = 8;

__host__ __device__ __forceinline__ int lds_byte(int r, int c) { const int st = (r >> 4) * 2 + (c >> 5), rr = r & 15, cc = c & 31, ob = rr * 64 + cc * 2; return st * 1024 + (ob ^ (((ob >> 9) & 1) << 5)); }
__host__ __device__ __forceinline__ void stage_rc(int b, int& R, int& C) { const int st = b / 1024, sb = b % 1024, swz = sb ^ (((sb >> 9) & 1) << 5); R = (st >> 1) * 16 + swz / 64; C = (st & 1) * 32 + (swz % 64) / 2; }
__host__ __device__ __forceinline__ int perm32(int rho) { const int n = rho >> 4, i = rho & 15; return 8 * (i >> 2) + 4 * n + (i & 3); }

struct Unit { int pm, pn; };
struct Gemm { const bf16_t* A; const bf16_t* Bt; int M, N, K; };

struct StaticOrder {
    int nM, nN, nwg, G, c;
    __host__ __device__ void init(int M, int N, int G_, int c_) { nM = M / BM; nN = N / BM; nwg = nM * nN; G = G_; c = c_; }
    __host__ __device__ bool next(int i, Unit& u) const {
        const long L = (long)i * G + c; if (L >= nwg) return false;
        int wgid = (int)L; { const int q = nwg / NXCD, r = nwg % NXCD, xcd = wgid % NXCD, off = wgid / NXCD; wgid = (xcd < r ? xcd * (q + 1) : r * (q + 1) + (xcd - r) * q) + off; }
        const int nig = WGM * nN, gid = wgid / nig, fm = gid * WGM, gsz = (nM - fm) < WGM ? (nM - fm) : WGM;
        u.pm = fm + ((wgid % nig) % gsz); u.pn = (wgid % nig) / gsz; return true;
    }
    __device__ __forceinline__ void a_ready(const Unit&) const {}
    __device__ __forceinline__ void done(const Unit&) const {}
};

__device__ __forceinline__ unsigned cvt_pk_bf16(float lo, float hi) { unsigned r; asm volatile("v_cvt_pk_bf16_f32 %0, %1, %2" : "=v"(r) : "v"(lo), "v"(hi)); return r; }
typedef float f32x2 __attribute__((ext_vector_type(2)));
typedef unsigned u32x2 __attribute__((ext_vector_type(2)));
__device__ __forceinline__ float fsigmoid(float x) { return __builtin_amdgcn_rcpf(1.f + __expf(-x)); }
__device__ __forceinline__ float bflo(unsigned w) { return __builtin_bit_cast(float, w << 16); }
__device__ __forceinline__ float bfhi(unsigned w) { return __builtin_bit_cast(float, w & 0xffff0000u); }

struct EpiSwiglu {
    static constexpr bool PERM = true, AFTER_DRAIN = false;
    bf16_t* H; int ldh;
    __device__ __forceinline__ void operator()(const f32x4 (&acc)[2][2][4][2], const Unit& u, int wr, int wc, int fr, int fq) const {
        const int col0 = u.pn * HALF + wc * 32 + 8 * fq, row0 = u.pm * BM + wr * 64 + fr;
#pragma unroll
        for (int ai = 0; ai < 2; ++ai)
#pragma unroll
            for (int m = 0; m < 4; ++m) {
                const f32x4 g0 = acc[ai][0][m][0], g1 = acc[ai][0][m][1], u0 = acc[ai][1][m][0], u1 = acc[ai][1][m][1];
                float o[8];
#pragma unroll
                for (int e = 0; e < 4; ++e) { o[e] = g0[e] * fsigmoid(g0[e]) * u0[e]; o[4 + e] = g1[e] * fsigmoid(g1[e]) * u1[e]; }
                u32x4 w; w.x = cvt_pk_bf16(o[0], o[1]); w.y = cvt_pk_bf16(o[2], o[3]); w.z = cvt_pk_bf16(o[4], o[5]); w.w = cvt_pk_bf16(o[6], o[7]);
                *(u32x4*)(H + (size_t)(row0 + ai * HALF + m * 16) * ldh + col0) = w;
            }
    }
};

struct EpiResid {
    static constexpr bool PERM = true, AFTER_DRAIN = false;
    const float* xin; long din; float* out; long dout; int skip_ctx; const float* gvec; int gstride; float scale; int nlat_tiles, tiles_per_set;
    __device__ __forceinline__ void operator()(const f32x4 (&acc)[2][2][4][2], const Unit& u, int wr, int wc, int fr, int fq) const {
        const bool isctx = u.pm >= nlat_tiles;
        if (isctx && skip_ctx) return;
        const int set = isctx ? 2 : (u.pm / tiles_per_set);
        const float* gv = gvec + (size_t)set * gstride;
        const int colb = u.pn * BM + wc * 32 + 8 * fq;
        const long rbase = (long)(u.pm * BM + wr * 64 + fr) * 2048 + colb;
        const float* xi = xin + rbase + (isctx ? din : 0L); float* xo = out + rbase + (isctx ? dout : 0L);
        f32x4 gg[2][2];
#pragma unroll
        for (int bj = 0; bj < 2; ++bj)
#pragma unroll
            for (int n = 0; n < 2; ++n) gg[bj][n] = *(const f32x4*)(gv + colb + bj * HALF + 4 * n) * scale;
#pragma unroll
        for (int ai = 0; ai < 2; ++ai)
#pragma unroll
            for (int m = 0; m < 4; ++m) {
                const size_t off = (size_t)(ai * HALF + m * 16) * 2048;
#pragma unroll
                for (int bj = 0; bj < 2; ++bj)
#pragma unroll
                    for (int n = 0; n < 2; ++n) {
                        const f32x4 x = *(const f32x4*)(xi + off + bj * HALF + 4 * n);
                        *(f32x4*)(xo + off + bj * HALF + 4 * n) = x + gg[bj][n] * acc[ai][bj][m][n];
                    }
            }
    }
};

struct EpiRawBf16 {
    static constexpr bool PERM = true, AFTER_DRAIN = false;
    bf16_t* O; int ldc;
    __device__ __forceinline__ void operator()(const f32x4 (&acc)[2][2][4][2], const Unit& u, int wr, int wc, int fr, int fq) const {
        const int col0 = u.pn * BM + wc * 32 + 8 * fq, row0 = u.pm * BM + wr * 64 + fr;
#pragma unroll
        for (int ai = 0; ai < 2; ++ai)
#pragma unroll
            for (int m = 0; m < 4; ++m) {
                bf16_t* rowp = O + (size_t)(row0 + ai * HALF + m * 16) * ldc + col0;
#pragma unroll
                for (int bj = 0; bj < 2; ++bj) {
                    const f32x4 v0 = acc[ai][bj][m][0], v1 = acc[ai][bj][m][1];
                    u32x4 w; w.x = cvt_pk_bf16(v0[0], v0[1]); w.y = cvt_pk_bf16(v0[2], v0[3]); w.z = cvt_pk_bf16(v1[0], v1[1]); w.w = cvt_pk_bf16(v1[2], v1[3]);
                    *(u32x4*)(rowp + bj * HALF) = w;
                }
            }
    }
};

struct EpiLora {
    static constexpr bool PERM = true, AFTER_DRAIN = false;
    float* LO; const float* w0; const float* a0;
    __device__ __forceinline__ void operator()(const f32x4 (&acc)[2][2][4][2], const Unit& u, int wr, int wc, int fr, int fq) const {
        const int sec = u.pn >> 2;
        const int col0 = u.pn * BM + wc * 32 + 8 * fq, row0 = u.pm * BM + wr * 64 + fr, c0 = col0 - sec * 1024;
        f32x4 bb[2][2];
#pragma unroll
        for (int bj = 0; bj < 2; ++bj)
#pragma unroll
            for (int n = 0; n < 2; ++n) {
                if (sec == 0) bb[bj][n] = (f32x4){0.f, 0.f, 0.f, 0.f};
                else if (sec <= 2) bb[bj][n] = *(const f32x4*)(w0 + (sec - 1) * 1024 + c0 + bj * HALF + 4 * n);
                else bb[bj][n] = *(const f32x4*)(a0 + (sec - 3) * 1024 + c0 + bj * HALF + 4 * n);
            }
#pragma unroll
        for (int ai = 0; ai < 2; ++ai)
#pragma unroll
            for (int m = 0; m < 4; ++m) {
                float* rowp = LO + (size_t)(row0 + ai * HALF + m * 16) * 5120 + col0;
#pragma unroll
                for (int bj = 0; bj < 2; ++bj)
#pragma unroll
                    for (int n = 0; n < 2; ++n) {
                        f32x4 v = acc[ai][bj][m][n] + bb[bj][n];
                        if (sec >= 1) {
#pragma unroll
                            for (int e = 0; e < 4; ++e) { const float s = fsigmoid(v[e]); v[e] = (sec <= 2) ? __expf(-0.60653066f * s) : s; }
                        }
                        *(f32x4*)(rowp + bj * HALF + 4 * n) = v;
                    }
            }
    }
};

struct EpiMerge {
    static constexpr bool PERM = true, AFTER_DRAIN = false;
    const bf16_t* pgate; int ldp;
    const float* bgate;
    float* ZF; bf16_t* Z; int mtiles;
    __device__ __forceinline__ void operator()(const f32x4 (&acc)[2][2][4][2], const Unit& u, int wr, int wc, int fr, int fq) const {
        const int br = u.pn >> 3, pn = u.pn & 7, pm = u.pm - mtiles * br;
        const int col0 = pn * BM + wc * 32 + 8 * fq, row0 = pm * BM + wr * 64 + fr;
        f32x4 bb[2][2];
#pragma unroll
        for (int bj = 0; bj < 2; ++bj)
#pragma unroll
            for (int n = 0; n < 2; ++n) bb[bj][n] = *(const f32x4*)(bgate + br * 2048 + col0 + bj * HALF + 4 * n);
#pragma unroll
        for (int ai = 0; ai < 2; ++ai)
#pragma unroll
            for (int m = 0; m < 4; ++m) {
                const size_t row = (size_t)(row0 + ai * HALF + m * 16);
#pragma unroll
                for (int bj = 0; bj < 2; ++bj) {
                    const u32x4 pg = *(const u32x4*)(pgate + row * ldp + br * 2048 + col0 + bj * HALF);
                    f32x4 g0, g1;
                    g0[0] = bflo(pg.x); g0[1] = bfhi(pg.x); g0[2] = bflo(pg.y); g0[3] = bfhi(pg.y); g1[0] = bflo(pg.z); g1[1] = bfhi(pg.z); g1[2] = bflo(pg.w); g1[3] = bfhi(pg.w);
                    g0 = g0 + bb[bj][0]; g1 = g1 + bb[bj][1];
                    f32x4 v0, v1;
#pragma unroll
                    for (int e = 0; e < 4; ++e) { v0[e] = fsigmoid(g0[e]) * acc[ai][bj][m][0][e]; v1[e] = fsigmoid(g1[e]) * acc[ai][bj][m][1][e]; }
                    float* zf = ZF + row * 2048 + col0 + bj * HALF;
                    if (br >= 1) { v0 = v0 + *(const f32x4*)zf; v1 = v1 + *(const f32x4*)(zf + 4); }
                    if (br <= 1) { *(f32x4*)zf = v0; *(f32x4*)(zf + 4) = v1; }
                    else { u32x4 w; w.x = cvt_pk_bf16(v0[0], v0[1]); w.y = cvt_pk_bf16(v0[2], v0[3]); w.z = cvt_pk_bf16(v1[0], v1[1]); w.w = cvt_pk_bf16(v1[2], v1[3]);
                        *(u32x4*)(Z + row * 2048 + col0 + bj * HALF) = w; }
                }
            }
    }
};
struct MergeOrder {
    int G, c, mtiles, ntiles;
    __device__ __forceinline__ bool next(int i, Unit& u) const {
        const int t = (i / 3) * G + c, br = i % 3; if (t >= mtiles * 8) return false;
        u.pm = (t >> 3) + mtiles * br; u.pn = (t & 7) + 8 * br; return true;
    }
    __device__ __forceinline__ void a_ready(const Unit&) const {}
    __device__ __forceinline__ void done(const Unit&) const {}
};

template <class Epi, class Sched, bool ALIGN_EPI = false, bool SP2 = false>
__device__ __forceinline__ void gemm_phase(PG8_LAS unsigned char* lds, const Gemm g, const Sched& S, const Epi& E) {
    const int tid = threadIdx.x, wid = __builtin_amdgcn_readfirstlane(tid >> 6), lane = tid & 63, wr = wid >> 2, wc = wid & 3, fr = lane & 15, fq = lane >> 4;
    const int K = g.K, nt = K / BK;
    unsigned voffA[2], voffB[2];
#pragma unroll
    for (int i = 0; i < 2; ++i) { int R, C; stage_rc(tid * 16 + i * 8192, R, C); const int Rb = Epi::PERM ? ((R & ~31) + perm32(R & 31)) : R;
        voffA[i] = (unsigned)(R * K + C) * 2u; voffB[i] = (unsigned)(Rb * K + C) * 2u; }
    const size_t kstep = (size_t)(BK * 2);
    const size_t hstep = (size_t)HALF * K * 2;
    const size_t tstep = 2 * hstep;
    const unsigned ldsw = (unsigned)wid * 1024u;
    const int aoff = lds_byte(wr * 64 + fr, fq * 8), boff = lds_byte(wc * 32 + fr, fq * 8);
#define PG8_SA(b, h) (((b) * 2 + (h)) * HTB)
#define PG8_SB(b, h) ((4 + (b) * 2 + (h)) * HTB)
#define PG8_STAGE(bufoff, gbase, voff) do { _Pragma("unroll") for (int _i = 0; _i < 2; ++_i) \
        __builtin_amdgcn_global_load_lds((const unsigned*)((const char*)(gbase) + (voff)[_i]), (PG8_LAS unsigned*)(lds + (bufoff) + ldsw + _i * 8192), 16, 0, 0); } while (0)
#define PG8_LDA(dst, b, h) do { _Pragma("unroll") for (int m = 0; m < 4; ++m) _Pragma("unroll") for (int k = 0; k < 2; ++k) dst[m][k] = *(const PG8_LAS bf16x8*)(lds + PG8_SA(b, h) + aoff + m * 2048 + k * 1024); } while (0)
#define PG8_LDB(dst, b, h) do { _Pragma("unroll") for (int n = 0; n < 2; ++n) _Pragma("unroll") for (int k = 0; k < 2; ++k) dst[n][k] = *(const PG8_LAS bf16x8*)(lds + PG8_SB(b, h) + boff + n * 2048 + k * 1024); } while (0)
#define PG8_MMA(ai, bj, At, Bt) do { __builtin_amdgcn_s_setprio(1); _Pragma("unroll") for (int m = 0; m < 4; ++m) _Pragma("unroll") for (int n = 0; n < 2; ++n) _Pragma("unroll") for (int k = 0; k < 2; ++k) \
        acc[ai][bj][m][n] = __builtin_amdgcn_mfma_f32_16x16x32_bf16(Bt[n][k], At[m][k], acc[ai][bj][m][n], 0, 0, 0); __builtin_amdgcn_s_setprio(0); } while (0)
#define PG8_WAIT_V(n) asm volatile("s_waitcnt vmcnt(" #n ")" ::: "memory")
#define PG8_WAIT_L(n) asm volatile("s_waitcnt lgkmcnt(" #n ")" ::: "memory")
#define PG8_BAR __builtin_amdgcn_s_barrier()
#define PG8_SCHED __builtin_amdgcn_sched_barrier(0)
    Unit cur, nxt; int ui = 0;
    if (!S.next(0, cur)) return;
    f32x4 acc[2][2][4][2];
#pragma unroll
    for (int a = 0; a < 2; ++a)
#pragma unroll
        for (int b = 0; b < 2; ++b)
#pragma unroll
            for (int m = 0; m < 4; ++m)
#pragma unroll
                for (int n = 0; n < 2; ++n) acc[a][b][m][n] = (f32x4){0.f, 0.f, 0.f, 0.f};
    bf16x8 At[4][2], B0[2][2], B1[2][2];
    const char* cA = (const char*)g.A + (size_t)cur.pm * tstep; const char* cB = (const char*)g.Bt + (size_t)cur.pn * tstep;
    S.a_ready(cur);
    if constexpr (SP2) {
        PG8_STAGE(PG8_SB(0, 0), cB, voffB); PG8_STAGE(PG8_SB(0, 1), cB + hstep, voffB); PG8_STAGE(PG8_SA(0, 0), cA, voffA); PG8_STAGE(PG8_SA(0, 1), cA + hstep, voffA);
        if (wr == 1) PG8_BAR;
        PG8_WAIT_V(2); PG8_BAR;
        PG8_STAGE(PG8_SB(1, 0), cB + kstep, voffB); PG8_STAGE(PG8_SA(1, 0), cA + kstep, voffA); PG8_STAGE(PG8_SB(1, 1), cB + hstep + kstep, voffB);
        PG8_WAIT_V(6); PG8_BAR;
    } else {
        PG8_STAGE(PG8_SB(0, 0), cB, voffB); PG8_STAGE(PG8_SA(0, 0), cA, voffA); PG8_STAGE(PG8_SB(0, 1), cB + hstep, voffB); PG8_STAGE(PG8_SA(0, 1), cA + hstep, voffA);
        if (wr == 1) PG8_BAR;
        PG8_WAIT_V(4); PG8_BAR;
        PG8_STAGE(PG8_SB(1, 0), cB + kstep, voffB); PG8_STAGE(PG8_SA(1, 0), cA + kstep, voffA); PG8_STAGE(PG8_SB(1, 1), cB + hstep + kstep, voffB);
        PG8_WAIT_V(6); PG8_BAR;
    }
    for (;;) {
        const bool has_next = S.next(ui + 1, nxt);
        const char* nA = has_next ? (const char*)g.A + (size_t)nxt.pm * tstep : cA; const char* nB = has_next ? (const char*)g.Bt + (size_t)nxt.pn * tstep : cB;
        for (int t = 0; t < nt; t += 2) {
            const bool last = (t == nt - 2);
            const char* a1 = cA + (size_t)(t + 1) * kstep;
            const char* a2 = last ? nA : cA + (size_t)(t + 2) * kstep; const char* b2 = last ? nB : cB + (size_t)(t + 2) * kstep;
            const char* a3 = a2 + kstep; const char* b3 = b2 + kstep;
            if (last && has_next) S.a_ready(nxt);
            if constexpr (SP2) {
            PG8_LDB(B0, 0, 0); PG8_LDB(B1, 0, 1); PG8_SCHED; PG8_LDA(At, 0, 0); PG8_STAGE(PG8_SA(1, 1), a1 + hstep, voffA);
            PG8_WAIT_V(8); PG8_WAIT_L(0); PG8_BAR; PG8_MMA(0, 0, At, B0); PG8_MMA(0, 1, At, B1); PG8_BAR; PG8_SCHED;
            PG8_LDA(At, 0, 1); PG8_STAGE(PG8_SB(0, 0), b2, voffB); PG8_STAGE(PG8_SB(0, 1), b2 + hstep, voffB); PG8_STAGE(PG8_SA(0, 0), a2, voffA);
            PG8_WAIT_V(8); PG8_WAIT_L(0); PG8_BAR; PG8_MMA(1, 0, At, B0); PG8_MMA(1, 1, At, B1); PG8_BAR; PG8_SCHED;
            PG8_LDB(B0, 1, 0); PG8_LDB(B1, 1, 1); PG8_SCHED; PG8_LDA(At, 1, 0); PG8_STAGE(PG8_SA(0, 1), a2 + hstep, voffA);
            PG8_WAIT_V(8); PG8_WAIT_L(0); PG8_BAR; PG8_MMA(0, 0, At, B0); PG8_MMA(0, 1, At, B1); PG8_BAR; PG8_SCHED;
            PG8_LDA(At, 1, 1); PG8_STAGE(PG8_SB(1, 0), b3, voffB); PG8_STAGE(PG8_SB(1, 1), b3 + hstep, voffB); PG8_STAGE(PG8_SA(1, 0), a3, voffA);
            PG8_WAIT_V(8); PG8_WAIT_L(0); PG8_BAR; PG8_MMA(1, 0, At, B0); PG8_MMA(1, 1, At, B1); PG8_BAR; PG8_SCHED;
            } else {
            PG8_LDB(B0, 0, 0); PG8_SCHED; PG8_LDA(At, 0, 0); PG8_STAGE(PG8_SA(1, 1), a1 + hstep, voffA);
            PG8_WAIT_L(8); PG8_BAR; PG8_WAIT_L(0); PG8_MMA(0, 0, At, B0); PG8_BAR; PG8_SCHED;
            PG8_LDB(B1, 0, 1); PG8_STAGE(PG8_SB(0, 0), b2, voffB);
            PG8_BAR; PG8_WAIT_L(0); PG8_MMA(0, 1, At, B1); PG8_BAR;
            PG8_LDA(At, 0, 1); PG8_STAGE(PG8_SA(0, 0), a2, voffA);
            PG8_BAR; PG8_WAIT_L(0); PG8_MMA(1, 0, At, B0); PG8_BAR; PG8_SCHED;
            PG8_STAGE(PG8_SB(0, 1), b2 + hstep, voffB);
            PG8_WAIT_V(6); PG8_BAR; PG8_MMA(1, 1, At, B1); PG8_BAR;
            PG8_LDB(B0, 1, 0); PG8_SCHED; PG8_LDA(At, 1, 0); PG8_STAGE(PG8_SA(0, 1), a2 + hstep, voffA);
            PG8_WAIT_L(8); PG8_BAR; PG8_WAIT_L(0); PG8_MMA(0, 0, At, B0); PG8_BAR; PG8_SCHED;
            PG8_LDB(B1, 1, 1); PG8_STAGE(PG8_SB(1, 0), b3, voffB);
            PG8_BAR; PG8_WAIT_L(0); PG8_MMA(0, 1, At, B1); PG8_BAR;
            PG8_LDA(At, 1, 1); PG8_STAGE(PG8_SA(1, 0), a3, voffA);
            PG8_BAR; PG8_WAIT_L(0); PG8_MMA(1, 0, At, B0); PG8_BAR; PG8_SCHED;
            PG8_STAGE(PG8_SB(1, 1), b3 + hstep, voffB);
            PG8_WAIT_V(6); PG8_BAR; PG8_MMA(1, 1, At, B1); PG8_BAR;
            }
        }
        if constexpr (ALIGN_EPI) { if (wr == 0) PG8_BAR; }
        if constexpr (!Epi::AFTER_DRAIN) { E(acc, cur, wr, wc, fr, fq); S.done(cur); }
        if (!has_next) break;
#pragma unroll
        for (int a = 0; a < 2; ++a)
#pragma unroll
            for (int b = 0; b < 2; ++b)
#pragma unroll
                for (int m = 0; m < 4; ++m)
#pragma unroll
                    for (int n = 0; n < 2; ++n) acc[a][b][m][n] = (f32x4){0.f, 0.f, 0.f, 0.f};
        cur = nxt; cA = nA; cB = nB; ++ui;
        if constexpr (ALIGN_EPI) { if (wr == 1) PG8_BAR; }
    }
    PG8_WAIT_V(0);
    if constexpr (!ALIGN_EPI) { if (wr == 0) PG8_BAR; }
    PG8_BAR;
    if constexpr (Epi::AFTER_DRAIN) { E.fused(acc, cur, wr, wc, fr, fq, lds, wid, lane); S.done(cur); }
#undef PG8_SA
#undef PG8_SB
#undef PG8_STAGE
#undef PG8_LDA
#undef PG8_LDB
#undef PG8_MMA
#undef PG8_WAIT_V
#undef PG8_WAIT_L
#undef PG8_BAR
#undef PG8_SCHED
}
}

constexpr int NWAVES = 8, NTHR = NWAVES * 64;
constexpr int DM = 2048, FF = 5504, FF2 = 2 * FF, NLAT = 8192, NCTX = 512, MT = NLAT + NCTX, TSEQ = 4096, TCTX = 256;
constexpr int PROJ = 14976, PROJP = 15104;
constexpr int P_U = 0, P_V = 1024, P_RKV = 2048, P_G = 5120, P_W = 5376, P_A = 5568, P_QKV = 5760, P_GATE = 8832;
constexpr int ACTW = 768, LOW = 5120;
constexpr int NLAYER = 2, NMOD = 9;

constexpr size_t MiB = 1u << 20;
constexpr size_t al(size_t x) { return (x + MiB - 1) / MiB * MiB; }
constexpr size_t WS_CTL = 0, CTL_ZERO_BYTES = 1 * MiB;
constexpr size_t WS_MODS = 1 * MiB;
constexpr size_t WS_ROPE = WS_MODS + al((size_t)NLAYER * 3 * NMOD * DM * 4);
constexpr size_t WS_WF1 = WS_ROPE + MiB;
constexpr size_t SZ_WF1 = (size_t)FF2 * DM * 2;
constexpr size_t WS_WF2 = WS_WF1 + al(4 * SZ_WF1);
constexpr size_t SZ_WF2 = (size_t)DM * FF * 2;
constexpr size_t WS_WIN = WS_WF2 + al(4 * SZ_WF2);
constexpr size_t SZ_WIN = (size_t)PROJP * DM * 2;
constexpr size_t WS_WLO = WS_WIN + al(2 * SZ_WIN);
constexpr size_t SZ_WLO = (size_t)LOW * ACTW * 2;
constexpr size_t WS_WBR = WS_WLO + al(2 * SZ_WLO);
constexpr size_t SZ_WBR = (size_t)3 * DM * 1024 * 2;
constexpr size_t WS_WOUT = WS_WBR + al(2 * SZ_WBR);
constexpr size_t SZ_WOUT = (size_t)DM * DM * 2;
constexpr size_t WS_XS = WS_WOUT + al(2 * SZ_WOUT);
constexpr size_t WS_XN = WS_XS + al((size_t)MT * DM * 4);
constexpr size_t WS_P = WS_XN + al((size_t)MT * DM * 2);
constexpr size_t WS_R1 = WS_P + al((size_t)MT * PROJP * 2);
constexpr size_t WS_ACT = WS_R1 + al((size_t)MT * LOW * 4);
constexpr size_t WS_RKVK = WS_ACT + al((size_t)MT * ACTW * 2);
constexpr size_t WS_QK = WS_RKVK + al((size_t)MT * 4096 * 2);
constexpr size_t WS_YS = WS_QK + al((size_t)MT * DM * 2);
constexpr size_t WS_Y3 = WS_YS + al((size_t)2 * MT * 1024 * 4);
constexpr size_t WS_END = WS_Y3 + al((size_t)3 * MT * 1024 * 2);

constexpr int CW_TMO = 0, CW_CODE = 1, CW_BAR = 4096;

constexpr int RING_BYTES = 131072, LDSCTL_OFF = RING_BYTES, MISC_OFF = LDSCTL_OFF + 320, LDS_BYTES = 147456;

#define GAS __attribute__((address_space(1)))
#define LAS __attribute__((address_space(3)))
typedef unsigned short bf16;
typedef unsigned v4u __attribute__((ext_vector_type(4)));
typedef unsigned v2u __attribute__((ext_vector_type(2)));
typedef float f32x4 __attribute__((ext_vector_type(4)));
typedef short bf16x8 __attribute__((ext_vector_type(8)));
typedef GAS unsigned gu32;
#define RLX_AGENT __ATOMIC_RELAXED, __HIP_MEMORY_SCOPE_AGENT
__device__ __forceinline__ unsigned f2bf(float f) { unsigned u = __builtin_bit_cast(unsigned, f); return (u + 0x7fffu + ((u >> 16) & 1u)) >> 16; }
__device__ __forceinline__ unsigned pk2(float lo, float hi) { return f2bf(lo) | (f2bf(hi) << 16); }
__device__ __forceinline__ float bflo(unsigned w) { return __builtin_bit_cast(float, w << 16); }
__device__ __forceinline__ float bfhi(unsigned w) { return __builtin_bit_cast(float, w & 0xffff0000u); }
__device__ __forceinline__ float bf1(bf16 h) { return __builtin_bit_cast(float, (unsigned)h << 16); }
__device__ __forceinline__ void unpack8(const v4u w, float (&f)[8]) { f[0] = bflo(w.x); f[1] = bfhi(w.x); f[2] = bflo(w.y); f[3] = bfhi(w.y); f[4] = bflo(w.z); f[5] = bfhi(w.z); f[6] = bflo(w.w); f[7] = bfhi(w.w); }
__device__ __forceinline__ v4u pack8(const float (&f)[8]) { v4u w; w.x = pk2(f[0], f[1]); w.y = pk2(f[2], f[3]); w.z = pk2(f[4], f[5]); w.w = pk2(f[6], f[7]); return w; }
__device__ __forceinline__ float fsigm(float x) { return __builtin_amdgcn_rcpf(1.f + __expf(-x)); }
__device__ __forceinline__ float ftanh(float x) { return 1.f - 2.f * __builtin_amdgcn_rcpf(__expf(2.f * x) + 1.f); }
__device__ __forceinline__ float gelu_t(float x) { return 0.5f * x * (1.f + ftanh(0.7978845608f * (x + 0.044715f * x * x * x))); }
__device__ __forceinline__ float wave_sum(float v) {
#pragma unroll
    for (int o = 1; o < 64; o <<= 1) v += __shfl_xor(v, o);
    return v;
}
#define XB_TMO      128
#define XB_XCNT(j)  (256  + 64 * (j))
#define XB_XSUB(j)  (1280 + 64 * (j))
#define XB_XGEN(j)  (2304 + 64 * (j))
#define XB_TOP      3328
#define XB_TOPGEN   3392
#define XCD_BAR_WORDS 3456
#define XB_SPIN_CAP (1u << 18)

__device__ __forceinline__ unsigned xb_ld(unsigned* p)              { return __hip_atomic_load(p, __ATOMIC_RELAXED, __HIP_MEMORY_SCOPE_AGENT); }
__device__ __forceinline__ unsigned xb_add(unsigned* p, unsigned v) { return __hip_atomic_fetch_add(p, v, __ATOMIC_RELAXED, __HIP_MEMORY_SCOPE_AGENT); }
__device__ __forceinline__ unsigned xb_xcc_id() { return (unsigned)__builtin_amdgcn_s_getreg((3 << 11) | 20) & 0xFu; }
#define XB_SPIN(cond, bar) do { unsigned _sp = 0; while (cond) { __builtin_amdgcn_s_sleep(1); \
    if ((++_sp & 255u) == 0u) { if (xb_ld(&(bar)[XB_TMO])) break; if (_sp > XB_SPIN_CAP) { atomicAdd(&(bar)[XB_TMO], 1u); break; } } } } while (0)

struct XcdBarrier {
    unsigned* bar; unsigned x;
    volatile LAS unsigned* st;
};

__device__ __forceinline__ XcdBarrier xcd_barrier_post(unsigned* bar, volatile LAS unsigned* st) {
    XcdBarrier b; b.bar = bar; b.x = xb_xcc_id(); b.st = st;
    if (threadIdx.x == 0) (void)xb_add(&bar[XB_XCNT(b.x)], 1u);
    return b;
}
__device__ __forceinline__ void xcd_barrier_complete(unsigned* bar, unsigned x, unsigned& nloc, unsigned& nx) {
    const unsigned G = gridDim.x * gridDim.y * gridDim.z;
    unsigned sum, cnt, mine, sp = 0u;
    for (;;) {
        sum = 0u; cnt = 0u; mine = 0u;
#pragma unroll
        for (unsigned j = 0; j < 16; ++j) { const unsigned c = xb_ld(&bar[XB_XCNT(j)]); sum += c; cnt += (c > 0u) ? 1u : 0u; mine = (j == x) ? c : mine; }
        if (sum == G) break;
        __builtin_amdgcn_s_sleep(1);
        if ((++sp & 255u) == 0u) { if (xb_ld(&bar[XB_TMO])) break; if (sp > XB_SPIN_CAP) { atomicAdd(&bar[XB_TMO], 1u); break; } }
    }
    nloc = mine > 0u ? mine : 1u; nx = cnt > 0u ? cnt : 1u;
}

__device__ __forceinline__ void xcd_barrier(const XcdBarrier& b) {
    asm volatile("s_waitcnt vmcnt(0)" ::: "memory");
    __syncthreads();
    if (threadIdx.x == 0) {
        unsigned* bar = b.bar;
        __builtin_amdgcn_s_waitcnt(0);
        unsigned nloc = b.st[0], nx = b.st[1];
        if (nloc == 0u) { xcd_barrier_complete(bar, b.x, nloc, nx); b.st[0] = nloc; b.st[1] = nx; }
        const unsigned old = xb_add(&bar[XB_XSUB(b.x)], 1u);
        const unsigned gen = old / nloc;
        if (old + 1u == (gen + 1u) * nloc) {
            __builtin_amdgcn_fence(__ATOMIC_RELEASE, "agent");
            asm volatile("s_waitcnt vmcnt(0)" ::: "memory");
            const unsigned og = xb_add(&bar[XB_TOP], 1u);
            const unsigned tg = og / nx;
            if (og + 1u == (tg + 1u) * nx) xb_add(&bar[XB_TOPGEN], 1u);
            else XB_SPIN(xb_ld(&bar[XB_TOPGEN]) == tg, bar);
            __builtin_amdgcn_fence(__ATOMIC_ACQUIRE, "agent");
            xb_add(&bar[XB_XGEN(b.x)], 1u);
            asm volatile("s_waitcnt vmcnt(0)" ::: "memory");
        } else {
            XB_SPIN(xb_ld(&bar[XB_XGEN(b.x)]) == gen, bar);
            __builtin_amdgcn_fence(__ATOMIC_ACQUIRE, "agent");
            asm volatile("s_waitcnt vmcnt(0)" ::: "memory");
        }
    }
    __syncthreads();
}

struct Args { const float* in[31]; float* out; unsigned char* ws; int ph_lo, ph_hi; };
enum In { I_X = 0, I_C, I_CTX, I_CCTX, I_WADA, I_BADA, I_NORMG, I_FFNIN, I_FFNOUT, I_WIN, I_GMVN, I_GMWS, I_GMBS, I_CONV, I_W0, I_WUP, I_A0, I_AUP, I_GUP, I_KK, I_KA, I_RK, I_LNG, I_LNB,
          I_QN, I_KN, I_LAM, I_SUBLN, I_WBR, I_BGATE, I_WOUT };

__device__ __forceinline__ void ph_ada(const Args& a, LAS unsigned char* lds, int tid, int vcu, int G) {
    LAS float* sc = (LAS float*)lds;
    LAS float* red = sc + 3 * 2048;
    const float* c = a.in[I_C]; const float* cc = a.in[I_CCTX];
    for (int i = tid; i < 3 * 2048; i += NTHR) { const float x = i < 4096 ? c[i] : cc[i - 4096]; sc[i] = x * fsigm(x); }
    __syncthreads();
    const int lane = tid & 63, wave = tid >> 6;
    float* mods = (float*)(a.ws + WS_MODS);
    for (int u = vcu; u < 576; u += G) {
        const int l = u / 288, jc = u % 288, j = jc * 64 + lane;
        const float* W = a.in[I_WADA] + (size_t)l * 2048 * 18432 + j;
        float s0 = 0.f, s1 = 0.f, s2 = 0.f;
        const int k0 = wave * 256;
#pragma unroll 8
        for (int k = 0; k < 256; ++k) { const float w = W[(size_t)(k0 + k) * 18432]; s0 += sc[k0 + k] * w; s1 += sc[2048 + k0 + k] * w; s2 += sc[4096 + k0 + k] * w; }
        red[(wave * 3 + 0) * 64 + lane] = s0; red[(wave * 3 + 1) * 64 + lane] = s1; red[(wave * 3 + 2) * 64 + lane] = s2;
        __syncthreads();
        if (wave < 3) { float s = a.in[I_BADA][(size_t)l * 18432 + j];
#pragma unroll
            for (int w8 = 0; w8 < 8; ++w8) s += red[(w8 * 3 + wave) * 64 + lane];
            mods[(size_t)(l * 3 + wave) * 18432 + j] = s; }
        __syncthreads();
    }
}
__device__ __forceinline__ void transpose_item(const float* W, int N, int sc0, bf16* WT, int Kd, int nd0, int k0, LAS float* scr, int lane) {
    if (sc0 >= 0) {
#pragma unroll 8
        for (int i = 0; i < 32; ++i) { const int kk = 2 * i + (lane >> 5); scr[kk * 33 + (lane & 31)] = W[(size_t)(k0 + kk) * N + sc0 + (lane & 31)]; }
    } else {
#pragma unroll 8
        for (int i = 0; i < 32; ++i) { const int kk = 2 * i + (lane >> 5); scr[kk * 33 + (lane & 31)] = 0.f; }
    }
    asm volatile("s_waitcnt lgkmcnt(0)" ::: "memory");
    const int c = lane & 7;
#pragma unroll
    for (int j = 0; j < 4; ++j) { const int n = (lane >> 3) + 8 * j; const LAS float* s = scr + (8 * c) * 33 + n;
        v4u o; o.x = pk2(s[0 * 33], s[1 * 33]); o.y = pk2(s[2 * 33], s[3 * 33]); o.z = pk2(s[4 * 33], s[5 * 33]); o.w = pk2(s[6 * 33], s[7 * 33]);
        *(GAS v4u*)(WT + (size_t)(nd0 + n) * Kd + k0 + 8 * c) = o; }
    asm volatile("s_waitcnt lgkmcnt(0)" ::: "memory");
}
__device__ __forceinline__ void ph_weights(const Args& a, LAS unsigned char* lds, int tid, int vcu, int G) {
    const int lane = tid & 63, wave = tid >> 6;
    LAS float* scr = (LAS float*)(lds + wave * 16384);
    const int gw = vcu * NWAVES + wave, NGW = G * NWAVES;
    constexpr int I_F1 = 32 * (FF2 / 32), I_F2 = (FF / 64) * (DM / 32), I_IN = 32 * (PROJP / 32), I_BR = 16 * (DM / 32), I_WO = 32 * (DM / 32);
    constexpr int NITEMS = 4 * I_F1 + 4 * I_F2 + 2 * I_IN + 6 * I_BR + 2 * I_WO;
    unsigned char* ws = a.ws;
    for (int it = gw; it < NITEMS; it += NGW) {
        int r = it;
        if (r < 4 * I_F1) { const int mi = r / I_F1, q = r % I_F1, nb = q % (FF2 / 32), kb = q / (FF2 / 32), nd0 = 32 * nb, pn = nd0 >> 8, rr = nd0 & 255;
            const int sc0 = rr < 128 ? pn * 128 + rr : FF + pn * 128 + (rr - 128);
            transpose_item(a.in[I_FFNIN] + (size_t)mi * DM * FF2, FF2, sc0, (bf16*)(ws + WS_WF1 + (size_t)mi * SZ_WF1), DM, nd0, 64 * kb, scr, lane); continue; }
        r -= 4 * I_F1;
        if (r < 4 * I_F2) { const int mi = r / I_F2, q = r % I_F2, nb = q % (DM / 32), kb = q / (DM / 32);
            transpose_item(a.in[I_FFNOUT] + (size_t)mi * FF * DM, DM, 32 * nb, (bf16*)(ws + WS_WF2 + (size_t)mi * SZ_WF2), FF, 32 * nb, 64 * kb, scr, lane); continue; }
        r -= 4 * I_F2;
        if (r < 2 * I_IN) { const int mi = r / I_IN, q = r % I_IN, nb = q % (PROJP / 32), kb = q / (PROJP / 32), nd0 = 32 * nb;
            transpose_item(a.in[I_WIN] + (size_t)mi * DM * PROJ, PROJ, nd0 < PROJ ? nd0 : -1, (bf16*)(ws + WS_WIN + (size_t)mi * SZ_WIN), DM, nd0, 64 * kb, scr, lane); continue; }
        r -= 2 * I_IN;
        if (r < 6 * I_BR) { const int mi = r / I_BR, q = r % I_BR, nb = q % (DM / 32), kb = q / (DM / 32);
            transpose_item(a.in[I_WBR] + (size_t)mi * 1024 * DM, DM, 32 * nb, (bf16*)(ws + WS_WBR + (size_t)mi * ((size_t)DM * 1024 * 2)), 1024, 32 * nb, 64 * kb, scr, lane); continue; }
        r -= 6 * I_BR;
        { const int mi = r / I_WO, q = r % I_WO, nb = q % (DM / 32), kb = q / (DM / 32);
            transpose_item(a.in[I_WOUT] + (size_t)mi * DM * DM, DM, 32 * nb, (bf16*)(ws + WS_WOUT + (size_t)mi * SZ_WOUT), DM, 32 * nb, 64 * kb, scr, lane); }
    }
    const int gt = vcu * NTHR + tid, NGT = G * NTHR;
    for (int i = gt; i < NLAYER * LOW * (ACTW / 8); i += NGT) {
        const int l = i / (LOW * (ACTW / 8)), q = i % (LOW * (ACTW / 8)), n = q / (ACTW / 8), k0 = (q % (ACTW / 8)) * 8, sec = n >> 10, cc = n & 1023;
        float f[8];
#pragma unroll
        for (int e = 0; e < 8; ++e) { const int k = k0 + e; float v = 0.f;
            if (sec == 0) { if (k < 256) v = a.in[I_GUP][((size_t)l * 256 + k) * 1024 + cc]; }
            else if (sec <= 2) { const int d = sec - 1, kb = 256 + 128 * d; if (k >= kb && k < kb + 96) v = a.in[I_WUP][((size_t)(l * 2 + d) * 96 + (k - kb)) * 1024 + cc]; }
            else { const int d = sec - 3, kb = 512 + 128 * d; if (k >= kb && k < kb + 96) v = a.in[I_AUP][((size_t)(l * 2 + d) * 96 + (k - kb)) * 1024 + cc]; }
            f[e] = v; }
        *(GAS v4u*)((bf16*)(ws + WS_WLO) + ((size_t)l * LOW + n) * ACTW + k0) = pack8(f);
    }
    for (int i = gt; i < 64 * 16; i += NGT) { const int p = i >> 4, ii = i & 15;
        const float inv = exp2f(-(float)(2 * ii) * (1.f / 32.f) * 13.287712379549449f);
        const float rev = (float)p * inv * 0.15915494309189535f;
        float* rt = (float*)(ws + WS_ROPE) + 2 * i; rt[0] = __builtin_amdgcn_cosf(rev); rt[1] = __builtin_amdgcn_sinf(rev); }
}

__device__ __forceinline__ void ph_norm(const float* xl, const float* xc, const float* gain, const float* mods  , int si, bf16* XN, int gw, int NGW, int lane) {
    for (int m = gw; m < MT; m += NGW) {
        const float* xr = m < NLAT ? xl + (size_t)m * DM : xc + (size_t)(m - NLAT) * DM;
        const int set = m < TSEQ ? 0 : (m < NLAT ? 1 : 2);
        const float* sh = mods + (size_t)(set * NMOD + si) * DM; const float* scl = sh + DM;
        f32x4 v[8]; float ss = 0.f;
#pragma unroll
        for (int j = 0; j < 8; ++j) { v[j] = *(const GAS f32x4*)(xr + 4 * lane + 256 * j); ss += (v[j].x * v[j].x + v[j].y * v[j].y) + (v[j].z * v[j].z + v[j].w * v[j].w); }
        const float rinv = 1.f / sqrtf(wave_sum(ss) * (1.f / DM) + 1e-6f);
#pragma unroll
        for (int j = 0; j < 8; ++j) { const int col = 4 * lane + 256 * j;
            const f32x4 g = *(const GAS f32x4*)(gain + col), s1 = *(const GAS f32x4*)(scl + col), s0 = *(const GAS f32x4*)(sh + col);
            const f32x4 o = (v[j] * rinv * g) * (s1 + 1.f) + s0;
            v2u w; w.x = pk2(o.x, o.y); w.y = pk2(o.z, o.w);
            *(GAS v2u*)(XN + (size_t)m * DM + col) = w; }
    }
}

__device__ __forceinline__ void ph_e1(const Args& a, int l, int gt, int NGT) {
    unsigned char* ws = a.ws;
    const bf16* P = (const bf16*)(ws + WS_P);
    bf16* ACT = (bf16*)(ws + WS_ACT);
    for (int i = gt; i < MT * (ACTW / 8); i += NGT) {
        const int m = i / (ACTW / 8), c0 = (i % (ACTW / 8)) * 8;
        int src = -1, fn = 0;
        if (c0 < 256) { src = P_G + c0; fn = 1; }
        else if (c0 < 352) { src = P_W + (c0 - 256); fn = 2; }
        else if (c0 >= 384 && c0 < 480) { src = P_W + 96 + (c0 - 384); fn = 2; }
        else if (c0 >= 512 && c0 < 608) { src = P_A + (c0 - 512); }
        else if (c0 >= 640 && c0 < 736) { src = P_A + 96 + (c0 - 640); }
        float f[8];
        if (src >= 0) { unpack8(*(const GAS v4u*)(P + (size_t)m * PROJP + src), f);
#pragma unroll
            for (int e = 0; e < 8; ++e) f[e] = fn == 1 ? fsigm(f[e]) : (fn == 2 ? ftanh(f[e]) : f[e]); }
        else {
#pragma unroll
            for (int e = 0; e < 8; ++e) f[e] = 0.f; }
        *(GAS v4u*)(ACT + (size_t)m * ACTW + c0) = pack8(f);
    }
    bf16* QK = (bf16*)(ws + WS_QK);
    const float* rope = (const float*)(ws + WS_ROPE);
    for (int i = gt; i < MT * 32; i += NGT) {
        const int m = i >> 5, gi = i & 31; const bool isq = gi < 16;
        const float* gain = a.in[isq ? I_QN : I_KN] + l * 64;
        const bf16* src = P + (size_t)m * PROJP + P_QKV + gi * 64;
        float y[64]; float ss = 0.f;
#pragma unroll
        for (int j = 0; j < 8; ++j) { float f[8]; unpack8(*(const GAS v4u*)(src + 8 * j), f);
#pragma unroll
            for (int e = 0; e < 8; ++e) { y[8 * j + e] = f[e]; ss += f[e] * f[e]; } }
        const float rinv = 1.f / sqrtf(ss * (1.f / 64.f) + 1e-6f);
#pragma unroll
        for (int d = 0; d < 64; ++d) y[d] = y[d] * rinv * gain[d];
        if (m < NLAT) { const int t = m & (TSEQ - 1), pr = t >> 6, pc = t & 63;
#pragma unroll
            for (int ii = 0; ii < 16; ++ii) {
                const float c1 = rope[(pr * 16 + ii) * 2], s1 = rope[(pr * 16 + ii) * 2 + 1], c2 = rope[(pc * 16 + ii) * 2], s2 = rope[(pc * 16 + ii) * 2 + 1];
                const float a1 = y[ii], a2 = y[16 + ii], b1 = y[32 + ii], b2 = y[48 + ii];
                y[ii] = a1 * c1 - a2 * s1; y[16 + ii] = a2 * c1 + a1 * s1; y[32 + ii] = b1 * c2 - b2 * s2; y[48 + ii] = b2 * c2 + b1 * s2; } }
        const float qs = isq ? 0.18033688011112042f : 1.f;
        bf16* dst = QK + (size_t)m * DM + gi * 64;
#pragma unroll
        for (int j = 0; j < 8; ++j) { float f[8];
#pragma unroll
            for (int e = 0; e < 8; ++e) f[e] = y[8 * j + e] * qs;
            *(GAS v4u*)(dst + 8 * j) = pack8(f); }
    }
    bf16* RK = (bf16*)(ws + WS_RKVK);
    const float* cw = a.in[I_CONV] + (size_t)l * 3 * 3072; const float* kkw = a.in[I_KK] + l * 1024;
    for (int i = gt; i < MT * 128; i += NGT) {
        const int m = i >> 7, c0 = (i & 127) * 8;
        const int t = m < NLAT ? (m & (TSEQ - 1)) : ((m - NLAT) & (TCTX - 1)), tl = m < NLAT ? TSEQ : TCTX;
        const bool hp = t > 0, hn = t < tl - 1;
        float kv[8];
#pragma unroll
        for (int sec = 0; sec < 3; ++sec) {
            const int col = sec * 1024 + c0; const bf16* pc = P + (size_t)m * PROJP + P_RKV + col;
            float x0[8], x1[8], x2[8], o[8];
            unpack8(*(const GAS v4u*)pc, x1);
            if (hp) unpack8(*(const GAS v4u*)(pc - PROJP), x0);
            if (hn) unpack8(*(const GAS v4u*)(pc + PROJP), x2);
#pragma unroll
            for (int e = 0; e < 8; ++e) { float v = x1[e] * cw[3072 + col + e]; if (hp) v += x0[e] * cw[col + e]; if (hn) v += x2[e] * cw[2 * 3072 + col + e]; o[e] = v; if (sec == 1) kv[e] = v; }
            *(GAS v4u*)(RK + (size_t)m * 4096 + col) = pack8(o);
        }
        float ss = 0.f;
#pragma unroll
        for (int e = 0; e < 8; ++e) { kv[e] *= kkw[c0 + e]; ss += kv[e] * kv[e]; }
        ss += __shfl_xor(ss, 1); ss += __shfl_xor(ss, 2); ss += __shfl_xor(ss, 4);
        const float rinv = 1.f / sqrtf(ss + 1e-12f);
#pragma unroll
        for (int e = 0; e < 8; ++e) kv[e] *= rinv;
        *(GAS v4u*)(RK + (size_t)m * 4096 + 3072 + c0) = pack8(kv);
    }
}

__device__ __forceinline__ void ph_gmlp(const Args& a, int l, LAS unsigned char* lds, int tid, int vcu, int G) {
    constexpr int VP = 136;
    LAS bf16* vnT = (LAS bf16*)lds;
    const bf16* P = (const bf16*)(a.ws + WS_P); bf16* YA = (bf16*)(a.ws + WS_Y3);
    const float* vng = a.in[I_GMVN] + l * 1024; const float* wsm = a.in[I_GMWS] + (size_t)l * 8 * 128 * 128; const float* bs = a.in[I_GMBS] + l * 8 * 128;
    const int lane = tid & 63, w = tid >> 6, fr = lane & 15, fq = lane >> 4;
    for (int u = vcu; u < (MT / 128) * 8; u += G) {
        const int n = u >> 3, g = u & 7, m0 = n * 128;
        { const int q = tid >> 2, qt = tid & 3; const bf16* src = P + (size_t)(m0 + q) * PROJP + P_V + g * 128 + qt * 32;
            float v[32]; float ss = 0.f;
#pragma unroll
            for (int j = 0; j < 4; ++j) { float f[8]; unpack8(*(const GAS v4u*)(src + 8 * j), f);
#pragma unroll
                for (int e = 0; e < 8; ++e) { const float x = gelu_t(f[e]); v[8 * j + e] = x; ss += x * x; } }
            ss += __shfl_xor(ss, 1); ss += __shfl_xor(ss, 2);
            const float rinv = 1.f / sqrtf(ss * (1.f / 128.f) + 1e-6f);
#pragma unroll
            for (int e = 0; e < 32; ++e) { const int c = qt * 32 + e; vnT[c * VP + q] = (bf16)f2bf(v[e] * rinv * vng[g * 128 + c]); } }
        __syncthreads();
        pg8::f32x4 acc[8];
#pragma unroll
        for (int cb = 0; cb < 8; ++cb) acc[cb] = (pg8::f32x4){0.f, 0.f, 0.f, 0.f};
#pragma unroll
        for (int ks = 0; ks < 4; ++ks) {
            const float* wr = wsm + ((size_t)g * 128 + 16 * w + fr) * 128 + ks * 32 + 8 * fq;
            const f32x4 w0 = *(const GAS f32x4*)wr, w1 = *(const GAS f32x4*)(wr + 4);
            v4u aw; aw.x = pk2(w0.x, w0.y); aw.y = pk2(w0.z, w0.w); aw.z = pk2(w1.x, w1.y); aw.w = pk2(w1.z, w1.w);
            const bf16x8 af = __builtin_bit_cast(bf16x8, aw);
#pragma unroll
            for (int cb = 0; cb < 8; ++cb) { const bf16x8 bfr = *(const LAS bf16x8*)(vnT + (cb * 16 + fr) * VP + ks * 32 + 8 * fq);
                acc[cb] = __builtin_amdgcn_mfma_f32_16x16x32_bf16(af, bfr, acc[cb], 0, 0, 0); }
        }
#pragma unroll
        for (int cb = 0; cb < 8; ++cb)
#pragma unroll
            for (int i = 0; i < 4; ++i) { const int p = 16 * w + 4 * fq + i, c = cb * 16 + fr;
                const float pu = bf1(P[(size_t)(m0 + p) * PROJP + P_U + g * 128 + c]);
                YA[(size_t)(m0 + p) * 1024 + g * 128 + c] = (bf16)f2bf(gelu_t(pu) * (acc[cb][i] + bs[g * 128 + p])); }
        __syncthreads();
    }
}

__device__ __forceinline__ void ph_attn(const Args& a, int l, bool ctx_out, LAS unsigned char* lds, int tid, int vcu, int G) {
    constexpr int KP = 72, VTP = 40;
    LAS bf16* Ks = (LAS bf16*)lds; LAS bf16* VT = (LAS bf16*)(lds + 32 * KP * 2);
    const bf16* QK = (const bf16*)(a.ws + WS_QK); const bf16* P = (const bf16*)(a.ws + WS_P); bf16* YC = (bf16*)(a.ws + WS_Y3) + (size_t)2 * MT * 1024;
    const int lane = tid & 63, w = tid >> 6, fr = lane & 15, fq = lane >> 4;
    const float* lv = a.in[I_LAM] + l * 256;
    float l1 = lv[lane] * lv[64 + lane], l2 = lv[128 + lane] * lv[192 + lane];
    l1 = wave_sum(l1); l2 = wave_sum(l2);
    const float lam_init = 0.8f - 0.6f * __expf(-0.3f * (float)l);
    const float lam = __expf(l1) - __expf(l2) + lam_init;
    const float* subln = a.in[I_SUBLN] + l * 128;
    const int nunits = ctx_out ? 544 : 512;
    for (int u = vcu; u < nunits; u += G) {
        int b, h, qrow0, kt0, kt1;
        if (u < 512) { b = u >> 8; h = (u >> 5) & 7; qrow0 = b * TSEQ + (u & 31) * 128; kt0 = 0; kt1 = 136; }
        else { const int uu = u - 512; b = uu >> 4; h = (uu >> 1) & 7; qrow0 = NLAT + b * TCTX + (uu & 1) * 128; kt0 = 128; kt1 = 136; }
        pg8::f32x4 O0[8];
#pragma unroll
        for (int j = 0; j < 2; ++j) {
            bf16x8 qf[2];
#pragma unroll
            for (int ds = 0; ds < 2; ++ds) qf[ds] = *(const GAS bf16x8*)(QK + (size_t)(qrow0 + 16 * w + fr) * DM + (h * 2 + j) * 64 + ds * 32 + 8 * fq);
            float m_run = -1e30f, l_part = 0.f;
            pg8::f32x4 O[8];
#pragma unroll
            for (int eb = 0; eb < 8; ++eb) O[eb] = (pg8::f32x4){0.f, 0.f, 0.f, 0.f};
            for (int kt = kt0; kt < kt1; ++kt) {
                const int krow0 = kt < 128 ? b * TSEQ + kt * 32 : NLAT + b * TCTX + (kt - 128) * 32;
                __syncthreads();
                if (tid < 256) { const int key = tid >> 3, ch = tid & 7;
                    *(LAS v4u*)(Ks + key * KP + ch * 8) = *(const GAS v4u*)(QK + (size_t)(krow0 + key) * DM + 1024 + (h * 2 + j) * 64 + ch * 8); }
                { const int key = tid >> 4, ch = tid & 15;
                    const v4u vv = *(const GAS v4u*)(P + (size_t)(krow0 + key) * PROJP + P_QKV + 2048 + h * 128 + ch * 8);
                    LAS bf16* d = VT + (ch * 8) * VTP + key;
                    d[0 * VTP] = (bf16)(vv.x & 0xffffu); d[1 * VTP] = (bf16)(vv.x >> 16); d[2 * VTP] = (bf16)(vv.y & 0xffffu); d[3 * VTP] = (bf16)(vv.y >> 16);
                    d[4 * VTP] = (bf16)(vv.z & 0xffffu); d[5 * VTP] = (bf16)(vv.z >> 16); d[6 * VTP] = (bf16)(vv.w & 0xffffu); d[7 * VTP] = (bf16)(vv.w >> 16); }
                __syncthreads();
                pg8::f32x4 s[2];
#pragma unroll
                for (int kb = 0; kb < 2; ++kb) { s[kb] = (pg8::f32x4){0.f, 0.f, 0.f, 0.f};
#pragma unroll
                    for (int ds = 0; ds < 2; ++ds) { const bf16x8 kf = *(const LAS bf16x8*)(Ks + (kb * 16 + fr) * KP + ds * 32 + 8 * fq);
                        s[kb] = __builtin_amdgcn_mfma_f32_16x16x32_bf16(kf, qf[ds], s[kb], 0, 0, 0); } }
                float mx = fmaxf(fmaxf(fmaxf(s[0][0], s[0][1]), fmaxf(s[0][2], s[0][3])), fmaxf(fmaxf(s[1][0], s[1][1]), fmaxf(s[1][2], s[1][3])));
                mx = fmaxf(mx, __shfl_xor(mx, 16)); mx = fmaxf(mx, __shfl_xor(mx, 32));
                const float m_new = fmaxf(m_run, mx), alpha = exp2f(m_run - m_new); m_run = m_new;
                float p[8]; float ps = 0.f;
#pragma unroll
                for (int i = 0; i < 4; ++i) { p[i] = exp2f(s[0][i] - m_new); p[4 + i] = exp2f(s[1][i] - m_new); ps += p[i] + p[4 + i]; }
                l_part = l_part * alpha + ps;
                v4u pw; pw.x = pk2(p[0], p[1]); pw.y = pk2(p[2], p[3]); pw.z = pk2(p[4], p[5]); pw.w = pk2(p[6], p[7]);
                const bf16x8 pb = __builtin_bit_cast(bf16x8, pw);
#pragma unroll
                for (int eb = 0; eb < 8; ++eb) {
                    O[eb] = O[eb] * alpha;
                    const LAS bf16* vp = VT + (eb * 16 + fr) * VTP + 4 * fq;
                    const v2u va = *(const LAS v2u*)vp, vb = *(const LAS v2u*)(vp + 16);
                    v4u vw; vw.x = va.x; vw.y = va.y; vw.z = vb.x; vw.w = vb.y;
                    O[eb] = __builtin_amdgcn_mfma_f32_16x16x32_bf16(__builtin_bit_cast(bf16x8, vw), pb, O[eb], 0, 0, 0);
                }
            }
            float lsum = l_part; lsum += __shfl_xor(lsum, 16); lsum += __shfl_xor(lsum, 32);
            const float rl = 1.f / lsum;
            if (j == 0) {
#pragma unroll
                for (int eb = 0; eb < 8; ++eb) O0[eb] = O[eb] * rl;
            } else {
#pragma unroll
                for (int eb = 0; eb < 8; ++eb) O0[eb] = O0[eb] - O[eb] * (lam * rl);
            }
        }
        float ss = 0.f;
#pragma unroll
        for (int eb = 0; eb < 8; ++eb) ss += (O0[eb][0] * O0[eb][0] + O0[eb][1] * O0[eb][1]) + (O0[eb][2] * O0[eb][2] + O0[eb][3] * O0[eb][3]);
        ss += __shfl_xor(ss, 16); ss += __shfl_xor(ss, 32);
        const float rinv = (1.f - lam_init) / sqrtf(ss * (1.f / 128.f) + 1e-6f);
        bf16* dst = YC + (size_t)(qrow0 + 16 * w + fr) * 1024 + h * 128 + 4 * fq;
#pragma unroll
        for (int eb = 0; eb < 8; ++eb) { const f32x4 g = *(const GAS f32x4*)(subln + eb * 16 + 4 * fq);
            v2u o; o.x = pk2(O0[eb][0] * rinv * g.x, O0[eb][1] * rinv * g.y); o.y = pk2(O0[eb][2] * rinv * g.z, O0[eb][3] * rinv * g.w);
            *(GAS v2u*)(dst + eb * 16) = o; }
    }
}

__device__ __forceinline__ void ph_scan(const Args& a, int l, LAS unsigned char* lds, int tid, int vcu, int G) {
    LAS float* op = (LAS float*)lds;
    LAS float* yb = op + 32 * 6 * 64;
    const float* LO = (const float*)(a.ws + WS_R1); const bf16* RK = (const bf16*)(a.ws + WS_RKVK); float* YS = (float*)(a.ws + WS_YS);
    const float* ka = a.in[I_KA] + l * 1024;
    const int row = tid >> 3, kg = tid & 7;
    for (int u = vcu; u < 64; u += G) {
        const int b = u >> 5, h = (u >> 1) & 15, d = u & 1;
        float s[8];
#pragma unroll
        for (int e = 0; e < 8; ++e) s[e] = 0.f;
        for (int blk = 0; blk < (TCTX + TSEQ) / 32; ++blk) {
#pragma unroll
            for (int r4 = 0; r4 < 4; ++r4) { const int idx = tid + NTHR * r4, st = idx >> 6, c = idx & 63, i = blk * 32 + st;
                const int m = i < TCTX ? NLAT + b * TCTX + (d ? TCTX - 1 - i : i) : b * TSEQ + (d ? TSEQ - 1 - (i - TCTX) : (i - TCTX));
                const int ch = h * 64 + c;
                const float wv = LO[(size_t)m * LOW + 1024 + d * 1024 + ch], av = LO[(size_t)m * LOW + 3072 + d * 1024 + ch];
                const bf16* rk = RK + (size_t)m * 4096 + ch;
                const float rv = bf1(rk[0]), kv = bf1(rk[1024]), vv = bf1(rk[2048]), kkv = bf1(rk[3072]);
                LAS float* o = op + st * 384 + c;
                o[0] = wv; o[64] = kv * (1.f + (av - 1.f) * ka[ch]); o[128] = kkv; o[192] = kkv * av; o[256] = rv; o[320] = vv; }
            __syncthreads();
            for (int st = 0; st < 32; ++st) {
                const LAS float* o = op + st * 384 + kg * 8;
                const f32x4 w0 = *(const LAS f32x4*)(o), w1 = *(const LAS f32x4*)(o + 4), k0 = *(const LAS f32x4*)(o + 64), k1 = *(const LAS f32x4*)(o + 68),
                            q0 = *(const LAS f32x4*)(o + 128), q1 = *(const LAS f32x4*)(o + 132), b0 = *(const LAS f32x4*)(o + 192), b1 = *(const LAS f32x4*)(o + 196),
                            r0 = *(const LAS f32x4*)(o + 256), r1 = *(const LAS f32x4*)(o + 260);
                const float vv = op[st * 384 + 320 + row];
                float sa = (s[0] * q0.x + s[1] * q0.y) + (s[2] * q0.z + s[3] * q0.w) + (s[4] * q1.x + s[5] * q1.y) + (s[6] * q1.z + s[7] * q1.w);
                sa += __shfl_xor(sa, 1); sa += __shfl_xor(sa, 2); sa += __shfl_xor(sa, 4);
                s[0] = s[0] * w0.x - sa * b0.x + vv * k0.x; s[1] = s[1] * w0.y - sa * b0.y + vv * k0.y; s[2] = s[2] * w0.z - sa * b0.z + vv * k0.z; s[3] = s[3] * w0.w - sa * b0.w + vv * k0.w;
                s[4] = s[4] * w1.x - sa * b1.x + vv * k1.x; s[5] = s[5] * w1.y - sa * b1.y + vv * k1.y; s[6] = s[6] * w1.z - sa * b1.z + vv * k1.z; s[7] = s[7] * w1.w - sa * b1.w + vv * k1.w;
                float y = (s[0] * r0.x + s[1] * r0.y) + (s[2] * r0.z + s[3] * r0.w) + (s[4] * r1.x + s[5] * r1.y) + (s[6] * r1.z + s[7] * r1.w);
                y += __shfl_xor(y, 1); y += __shfl_xor(y, 2); y += __shfl_xor(y, 4);
                if (kg == 0) yb[st * 64 + row] = y;
            }
            __syncthreads();
#pragma unroll
            for (int r4 = 0; r4 < 4; ++r4) { const int idx = tid + NTHR * r4, st = idx >> 6, c = idx & 63, i = blk * 32 + st;
                const int m = i < TCTX ? NLAT + b * TCTX + (d ? TCTX - 1 - i : i) : b * TSEQ + (d ? TSEQ - 1 - (i - TCTX) : (i - TCTX));
                YS[((size_t)d * MT + m) * 1024 + h * 64 + c] = yb[st * 64 + c]; }
        }
        __syncthreads();
    }
}

__device__ __forceinline__ void ph_rwkv_out(const Args& a, int l, int gt, int NGT) {
    const float* LO = (const float*)(a.ws + WS_R1); const bf16* RK = (const bf16*)(a.ws + WS_RKVK); const float* YS = (const float*)(a.ws + WS_YS);
    bf16* YB = (bf16*)(a.ws + WS_Y3) + (size_t)MT * 1024;
    const float* ka = a.in[I_KA] + l * 1024; const float* rkw = a.in[I_RK] + l * 1024; const float* lng = a.in[I_LNG] + l * 1024; const float* lnb = a.in[I_LNB] + l * 1024;
    for (int i = gt; i < MT * 128; i += NGT) {
        const int m = i >> 7, c0 = (i & 127) * 8;
        float y[8]; float s1 = 0.f;
        { const f32x4 a0 = *(const GAS f32x4*)(YS + (size_t)m * 1024 + c0), a1 = *(const GAS f32x4*)(YS + (size_t)m * 1024 + c0 + 4),
                      b0 = *(const GAS f32x4*)(YS + ((size_t)MT + m) * 1024 + c0), b1 = *(const GAS f32x4*)(YS + ((size_t)MT + m) * 1024 + c0 + 4);
            y[0] = a0.x + b0.x; y[1] = a0.y + b0.y; y[2] = a0.z + b0.z; y[3] = a0.w + b0.w; y[4] = a1.x + b1.x; y[5] = a1.y + b1.y; y[6] = a1.z + b1.z; y[7] = a1.w + b1.w; }
#pragma unroll
        for (int e = 0; e < 8; ++e) s1 += y[e];
        s1 += __shfl_xor(s1, 1); s1 += __shfl_xor(s1, 2); s1 += __shfl_xor(s1, 4);
        const float mu = s1 * (1.f / 64.f); float s2 = 0.f;
#pragma unroll
        for (int e = 0; e < 8; ++e) { y[e] -= mu; s2 += y[e] * y[e]; }
        s2 += __shfl_xor(s2, 1); s2 += __shfl_xor(s2, 2); s2 += __shfl_xor(s2, 4);
        const float rstd = 1.f / sqrtf(s2 * (1.f / 64.f) + 64e-5f);
        float r[8], k[8], v[8];
        unpack8(*(const GAS v4u*)(RK + (size_t)m * 4096 + c0), r); unpack8(*(const GAS v4u*)(RK + (size_t)m * 4096 + 1024 + c0), k); unpack8(*(const GAS v4u*)(RK + (size_t)m * 4096 + 2048 + c0), v);
        float rk = 0.f;
#pragma unroll
        for (int e = 0; e < 8; ++e) { const int c = c0 + e; const float am = 0.5f * (LO[(size_t)m * LOW + 3072 + c] + LO[(size_t)m * LOW + 4096 + c]);
            rk += r[e] * (k[e] * (1.f + (am - 1.f) * ka[c])) * rkw[c]; }
        rk += __shfl_xor(rk, 1); rk += __shfl_xor(rk, 2); rk += __shfl_xor(rk, 4);
        float o[8];
#pragma unroll
        for (int e = 0; e < 8; ++e) { const int c = c0 + e; o[e] = (y[e] * rstd * lng[c] + lnb[c] + rk * v[e]) * LO[(size_t)m * LOW + c]; }
        *(GAS v4u*)(YB + (size_t)m * 1024 + c0) = pack8(o);
    }
}

constexpr int PH_PER_LAYER = 16, NPH = 1 + NLAYER * PH_PER_LAYER;
#define IN(k) (lo <= (k) && (k) < hi)
#define SEAM(k) do { if (IN(k) && IN((k) + 1)) xcd_barrier(bar); } while (0)
#ifndef ONLY_PH
#define ONLY_PH -1
#endif
#define INL(k) ((ONLY_PH < 0 || ONLY_PH == (k)) && IN(pb + (k)))
#define SEAML(k) SEAM(pb + (k))
template <int l> __device__ __forceinline__ void layer_body(const Args& args, LAS unsigned char* lds, unsigned char* ws, const XcdBarrier& bar, int lo, int hi, int tid, int lane, int G, int bx, int vcu, int gw, int NGW, int gt, int NGT) {
        const int pb = 1 + l * PH_PER_LAYER;
        const bool last = (l == NLAYER - 1);
        float* XS = (float*)(ws + WS_XS);
        const float* mods = (const float*)(ws + WS_MODS) + (size_t)l * 3 * NMOD * DM;
        const float* normg = args.in[I_NORMG] + (size_t)l * 3 * DM;
        pg8::bf16_t* XN = (pg8::bf16_t*)(ws + WS_XN);
        pg8::bf16_t* Hb = (pg8::bf16_t*)(ws + WS_R1);
        const float* xl0 = (l == 0) ? args.in[I_X] : XS; const float* xc0 = (l == 0) ? args.in[I_CTX] : XS + (size_t)NLAT * DM;

        if (INL(0)) ph_norm(xl0, xc0, normg, mods, 0, (bf16*)XN, gw, NGW, lane);
        SEAML(0);
        if (INL(1)) { pg8::Gemm g{XN, (const pg8::bf16_t*)(ws + WS_WF1 + (size_t)(l * 2 + 0) * SZ_WF1), MT, FF2, DM}; pg8::StaticOrder S; S.init(MT, FF2, G, bx);
            pg8::EpiSwiglu E{Hb, FF}; pg8::gemm_phase<pg8::EpiSwiglu, pg8::StaticOrder, true, true>(lds, g, S, E); }
        SEAML(1);
        if (INL(2)) { pg8::Gemm g{Hb, (const pg8::bf16_t*)(ws + WS_WF2 + (size_t)(l * 2 + 0) * SZ_WF2), MT, DM, FF}; pg8::StaticOrder S; S.init(MT, DM, G, bx);
            pg8::EpiResid E{xl0, (long)((xc0 - (size_t)NLAT * DM) - xl0), XS, 0L, 0, mods + 2 * DM, NMOD * DM, 0.5f, NLAT / 256, TSEQ / 256};
            pg8::gemm_phase<pg8::EpiResid, pg8::StaticOrder, true, true>(lds, g, S, E); }
        SEAML(2);
        if (INL(3)) ph_norm(XS, XS + (size_t)NLAT * DM, normg + DM, mods, 3, (bf16*)XN, gw, NGW, lane);
        SEAML(3);
        if (INL(4)) { pg8::Gemm g{XN, (const pg8::bf16_t*)(ws + WS_WIN + (size_t)l * SZ_WIN), MT, PROJP, DM}; pg8::StaticOrder S; S.init(MT, PROJP, G, bx);
            pg8::EpiRawBf16 E{(pg8::bf16_t*)(ws + WS_P), PROJP}; pg8::gemm_phase<pg8::EpiRawBf16, pg8::StaticOrder, true, true>(lds, g, S, E); }
        SEAML(4);
        if (INL(5)) ph_e1(args, l, gt, NGT);
        SEAML(5);
        if (INL(6)) { pg8::Gemm g{(const pg8::bf16_t*)(ws + WS_ACT), (const pg8::bf16_t*)(ws + WS_WLO + (size_t)l * SZ_WLO), MT, LOW, ACTW}; pg8::StaticOrder S; S.init(MT, LOW, G, bx);
            pg8::EpiLora E{(float*)(ws + WS_R1), args.in[I_W0] + l * 2048, args.in[I_A0] + l * 2048}; pg8::gemm_phase<pg8::EpiLora, pg8::StaticOrder, true, true>(lds, g, S, E); }
        SEAML(6);
        if (INL(7)) ph_gmlp(args, l, lds, tid, vcu, G);
        SEAML(7);
        if (INL(8)) ph_attn(args, l, !last, lds, tid, vcu, G);
        SEAML(8);
        if (INL(9)) ph_scan(args, l, lds, tid, vcu, G);
        SEAML(9);
        if (INL(10)) ph_rwkv_out(args, l, gt, NGT);
        SEAML(10);
        if (INL(11)) { pg8::Gemm g{(const pg8::bf16_t*)(ws + WS_Y3), (const pg8::bf16_t*)(ws + WS_WBR + (size_t)l * SZ_WBR), 3 * MT, 3 * DM, 1024}; pg8::MergeOrder S{G, bx, MT / 256, 8};
            pg8::EpiMerge E{(const pg8::bf16_t*)(ws + WS_P) + P_GATE, PROJP, args.in[I_BGATE] + (size_t)l * 3 * DM, (float*)(ws + WS_YS), XN, MT / 256};
            pg8::gemm_phase<pg8::EpiMerge, pg8::MergeOrder, true, true>(lds, g, S, E); }
        SEAML(11);
        if (INL(12)) { pg8::Gemm g{XN, (const pg8::bf16_t*)(ws + WS_WOUT + (size_t)l * SZ_WOUT), MT, DM, DM}; pg8::StaticOrder S; S.init(MT, DM, G, bx);
            pg8::EpiResid E{XS, 0L, XS, 0L, 0, mods + 5 * DM, NMOD * DM, 1.0f, NLAT / 256, TSEQ / 256};
            pg8::gemm_phase<pg8::EpiResid, pg8::StaticOrder, true, true>(lds, g, S, E); }
        SEAML(12);
        if (INL(13)) ph_norm(XS, XS + (size_t)NLAT * DM, normg + 2 * DM, mods, 6, (bf16*)XN, gw, NGW, lane);
        SEAML(13);
        if (INL(14)) { pg8::Gemm g{XN, (const pg8::bf16_t*)(ws + WS_WF1 + (size_t)(l * 2 + 1) * SZ_WF1), MT, FF2, DM}; pg8::StaticOrder S; S.init(MT, FF2, G, bx);
            pg8::EpiSwiglu E{Hb, FF}; pg8::gemm_phase<pg8::EpiSwiglu, pg8::StaticOrder, true, true>(lds, g, S, E); }
        SEAML(14);
        if (INL(15)) { pg8::Gemm g{Hb, (const pg8::bf16_t*)(ws + WS_WF2 + (size_t)(l * 2 + 1) * SZ_WF2), MT, DM, FF}; pg8::StaticOrder S; S.init(MT, DM, G, bx);
            pg8::EpiResid E{XS, 0L, last ? args.out : XS, 0L, last ? 1 : 0, mods + 8 * DM, NMOD * DM, 0.5f, NLAT / 256, TSEQ / 256};
            pg8::gemm_phase<pg8::EpiResid, pg8::StaticOrder, true, true>(lds, g, S, E); }
        SEAML(15);
    }
__global__ void __launch_bounds__(NTHR, 2) fwd(Args args) {
    extern __shared__ __attribute__((aligned(16))) unsigned char lds_raw[];
    LAS unsigned char* lds = (LAS unsigned char*)lds_raw;
    const int tid = threadIdx.x, lane = tid & 63, wave = __builtin_amdgcn_readfirstlane(tid >> 6);
    const int G = gridDim.x; const int bx = blockIdx.x; const int vcu = (G % 8 == 0) ? (bx % 8) * (G / 8) + bx / 8 : bx;
    const int gw = vcu * NWAVES + wave, NGW = G * NWAVES, gt = vcu * NTHR + tid, NGT = G * NTHR;
    unsigned char* ws = args.ws;
    volatile LAS unsigned* MISC = (volatile LAS unsigned*)(lds + MISC_OFF);
    for (int u = tid; u < (LDS_BYTES - LDSCTL_OFF) / 4; u += NTHR) ((LAS unsigned*)(lds + LDSCTL_OFF))[u] = 0u;
    __syncthreads();
    const int lo = args.ph_lo, hi = args.ph_hi;
    const bool multi = (hi - lo) > 1;
    XcdBarrier bar; bar.bar = (unsigned*)(ws + WS_CTL) + CW_BAR; bar.x = 0; bar.st = nullptr;
    if (multi) bar = xcd_barrier_post((unsigned*)(ws + WS_CTL) + CW_BAR, MISC + 8);

    if ((ONLY_PH < 0 || ONLY_PH == 100) && IN(0)) { ph_ada(args, lds, tid, vcu, G); __syncthreads(); ph_weights(args, lds, tid, vcu, G); }
    SEAM(0);

    layer_body<0>(args, lds, ws, bar, lo, hi, tid, lane, G, bx, vcu, gw, NGW, gt, NGT);
    layer_body<1>(args, lds, ws, bar, lo, hi, tid, lane, G, bx, vcu, gw, NGW, gt, NGT);
#undef IN
#undef SEAM
}

#ifndef MK_PER_PHASE
#define MK_PER_PHASE 1
#endif
extern "C" void kernel_launch(void* const* d_in, const int* in_sizes, int n_in, void* d_out, int out_size, void* d_ws, size_t ws_size, hipStream_t stream) {
    static int grid = 0;
    if (grid == 0) {
        if (n_in != 31 || in_sizes[0] != NLAT * DM || out_size != NLAT * DM || ws_size < WS_END) {
            fprintf(stderr, "kernel_launch: unexpected shapes: n_in %d in0 %d out %d ws %zu (need %zu); nothing launched\n", n_in, n_in > 0 ? in_sizes[0] : -1, out_size, ws_size, (size_t)WS_END); grid = -1; return; }
        int dev = 0, cus = 0, per_cu = 0;
        if (hipGetDevice(&dev) != hipSuccess || hipDeviceGetAttribute(&cus, hipDeviceAttributeMultiprocessorCount, dev) != hipSuccess) { grid = -1; return; }
        if (hipFuncSetAttribute((const void*)fwd, hipFuncAttributeMaxDynamicSharedMemorySize, LDS_BYTES) != hipSuccess) { fprintf(stderr, "kernel_launch: hipFuncSetAttribute failed\n"); grid = -1; return; }
        if (hipOccupancyMaxActiveBlocksPerMultiprocessor(&per_cu, (const void*)fwd, NTHR, LDS_BYTES) != hipSuccess || per_cu < 1) fprintf(stderr, "kernel_launch: occupancy query says %d\n", per_cu);
        (void)hipGetLastError();
        grid = cus;
    }
    if (grid < 0) return;
    (void)hipMemsetAsync((char*)d_ws + WS_CTL, 0, CTL_ZERO_BYTES, stream);
    Args a{};
    for (int i = 0; i < 31; ++i) a.in[i] = (const float*)d_in[i];
    a.out = (float*)d_out; a.ws = (unsigned char*)d_ws;
#if MK_PER_PHASE
    for (int p = 0; p < NPH; ++p) { a.ph_lo = p; a.ph_hi = p + 1; hipLaunchKernelGGL(fwd, dim3(grid), dim3(NTHR), LDS_BYTES, stream, a); }
#else
    a.ph_lo = 0; a.ph_hi = NPH; hipLaunchKernelGGL(fwd, dim3(grid), dim3(NTHR), LDS_BYTES, stream, a);
#endif
}
```

```cpp
#include <hip/hip_runtime.h>
#include <cstdio>
#include <cstdint>
namespace pg8 {
#define PG8_LAS __attribute__((address_space(3)))
typedef unsigned short bf16_t;
typedef short bf16x8 __attribute__((ext_vector_type(8)));
typedef float f32x4 __attribute__((ext_vector_type(4)));
typedef unsigned u32x4 __attribute__((ext_vector_type(4)));
constexpr int BM = 256, BK = 64, HALF = 128, HTB = HALF * BK * 2  , STAGE_BYTES = 8 * HTB, NXCD = 8, WGM = 8;

__host__ __device__ __forceinline__ int lds_byte(int r, int c) { const int st = (r >> 4) * 2 + (c >> 5), rr = r & 15, cc = c & 31, ob = rr * 64 + cc * 2; return st * 1024 + (ob ^ (((ob >> 9) & 1) << 5)); }
__host__ __device__ __forceinline__ void stage_rc(int b, int& R, int& C) { const int st = b / 1024, sb = b % 1024, swz = sb ^ (((sb >> 9) & 1) << 5); R = (st >> 1) * 16 + swz / 64; C = (st & 1) * 32 + (swz % 64) / 2; }
__host__ __device__ __forceinline__ int perm32(int rho) { const int n = rho >> 4, i = rho & 15; return 8 * (i >> 2) + 4 * n + (i & 3); }

struct Unit { int pm, pn; };
struct Gemm { const bf16_t* A; const bf16_t* Bt; int M, N, K; };

struct StaticOrder {
    int nM, nN, nwg, G, c;
    __host__ __device__ void init(int M, int N, int G_, int c_) { nM = M / BM; nN = N / BM; nwg = nM * nN; G = G_; c = c_; }
    __host__ __device__ bool next(int i, Unit& u) const {
        const long L = (long)i * G + c; if (L >= nwg) return false;
        int wgid = (int)L; { const int q = nwg / NXCD, r = nwg % NXCD, xcd = wgid % NXCD, off = wgid / NXCD; wgid = (xcd < r ? xcd * (q + 1) : r * (q + 1) + (xcd - r) * q) + off; }
        const int nig = WGM * nN, gid = wgid / nig, fm = gid * WGM, gsz = (nM - fm) < WGM ? (nM - fm) : WGM;
        u.pm = fm + ((wgid % nig) % gsz); u.pn = (wgid % nig) / gsz; return true;
    }
    __device__ __forceinline__ void a_ready(const Unit&) const {}
    __device__ __forceinline__ void done(const Unit&) const {}
};

__device__ __forceinline__ unsigned cvt_pk_bf16(float lo, float hi) { unsigned r; asm volatile("v_cvt_pk_bf16_f32 %0, %1, %2" : "=v"(r) : "v"(lo), "v"(hi)); return r; }
typedef float f32x2 __attribute__((ext_vector_type(2)));
typedef unsigned u32x2 __attribute__((ext_vector_type(2)));
__device__ __forceinline__ float fsigmoid(float x) { return __builtin_amdgcn_rcpf(1.f + __expf(-x)); }
__device__ __forceinline__ float bflo(unsigned w) { return __builtin_bit_cast(float, w << 16); }
__device__ __forceinline__ float bfhi(unsigned w) { return __builtin_bit_cast(float, w & 0xffff0000u); }

struct EpiSwiglu {
    static constexpr bool PERM = true, AFTER_DRAIN = false;
    bf16_t* H; int ldh;
    __device__ __forceinline__ void operator()(const f32x4 (&acc)[2][2][4][2], const Unit& u, int wr, int wc, int fr, int fq) const {
        const int col0 = u.pn * HALF + wc * 32 + 8 * fq, row0 = u.pm * BM + wr * 64 + fr;
#pragma unroll
        for (int ai = 0; ai < 2; ++ai)
#pragma unroll
            for (int m = 0; m < 4; ++m) {
                const f32x4 g0 = acc[ai][0][m][0], g1 = acc[ai][0][m][1], u0 = acc[ai][1][m][0], u1 = acc[ai][1][m][1];
                float o[8];
#pragma unroll
                for (int e = 0; e < 4; ++e) { o[e] = g0[e] * fsigmoid(g0[e]) * u0[e]; o[4 + e] = g1[e] * fsigmoid(g1[e]) * u1[e]; }
                u32x4 w; w.x = cvt_pk_bf16(o[0], o[1]); w.y = cvt_pk_bf16(o[2], o[3]); w.z = cvt_pk_bf16(o[4], o[5]); w.w = cvt_pk_bf16(o[6], o[7]);
                *(u32x4*)(H + (size_t)(row0 + ai * HALF + m * 16) * ldh + col0) = w;
            }
    }
};

struct EpiResid {
    static constexpr bool PERM = true, AFTER_DRAIN = false;
    const float* xin; long din; float* out; long dout; int skip_ctx; const float* gvec; int gstride; float scale; int nlat_tiles, tiles_per_set;
    __device__ __forceinline__ void operator()(const f32x4 (&acc)[2][2][4][2], const Unit& u, int wr, int wc, int fr, int fq) const {
        const bool isctx = u.pm >= nlat_tiles;
        if (isctx && skip_ctx) return;
        const int set = isctx ? 2 : (u.pm / tiles_per_set);
        const float* gv = gvec + (size_t)set * gstride;
        const int colb = u.pn * BM + wc * 32 + 8 * fq;
        const long rbase = (long)(u.pm * BM + wr * 64 + fr) * 2048 + colb;
        const float* xi = xin + rbase + (isctx ? din : 0L); float* xo = out + rbase + (isctx ? dout : 0L);
        f32x4 gg[2][2];
#pragma unroll
        for (int bj = 0; bj < 2; ++bj)
#pragma unroll
            for (int n = 0; n < 2; ++n) gg[bj][n] = *(const f32x4*)(gv + colb + bj * HALF + 4 * n) * scale;
#pragma unroll
        for (int ai = 0; ai < 2; ++ai)
#pragma unroll
            for (int m = 0; m < 4; ++m) {
                const size_t off = (size_t)(ai * HALF + m * 16) * 2048;
#pragma unroll
                for (int bj = 0; bj < 2; ++bj)
#pragma unroll
                    for (int n = 0; n < 2; ++n) {
                        const f32x4 x = *(const f32x4*)(xi + off + bj * HALF + 4 * n);
                        *(f32x4*)(xo + off + bj * HALF + 4 * n) = x + gg[bj][n] * acc[ai][bj][m][n];
                    }
            }
    }
};

struct EpiRawBf16 {
    static constexpr bool PERM = true, AFTER_DRAIN = false;
    bf16_t* O; int ldc;
    __device__ __forceinline__ void operator()(const f32x4 (&acc)[2][2][4][2], const Unit& u, int wr, int wc, int fr, int fq) const {
        const int col0 = u.pn * BM + wc * 32 + 8 * fq, row0 = u.pm * BM + wr * 64 + fr;
#pragma unroll
        for (int ai = 0; ai < 2; ++ai)
#pragma unroll
            for (int m = 0; m < 4; ++m) {
                bf16_t* rowp = O + (size_t)(row0 + ai * HALF + m * 16) * ldc + col0;
#pragma unroll
                for (int bj = 0; bj < 2; ++bj) {
                    const f32x4 v0 = acc[ai][bj][m][0], v1 = acc[ai][bj][m][1];
                    u32x4 w; w.x = cvt_pk_bf16(v0[0], v0[1]); w.y = cvt_pk_bf16(v0[2], v0[3]); w.z = cvt_pk_bf16(v1[0], v1[1]); w.w = cvt_pk_bf16(v1[2], v1[3]);
                    *(u32x4*)(rowp + bj * HALF) = w;
                }
            }
    }
};

struct EpiLora {
    static constexpr bool PERM = true, AFTER_DRAIN = false;
    float* LO; const float* w0; const float* a0;
    __device__ __forceinline__ void operator()(const f32x4 (&acc)[2][2][4][2], const Unit& u, int wr, int wc, int fr, int fq) const {
        const int sec = u.pn >> 2;
        const int col0 = u.pn * BM + wc * 32 + 8 * fq, row0 = u.pm * BM + wr * 64 + fr, c0 = col0 - sec * 1024;
        f32x4 bb[2][2];
#pragma unroll
        for (int bj = 0; bj < 2; ++bj)
#pragma unroll
            for (int n = 0; n < 2; ++n) {
                if (sec == 0) bb[bj][n] = (f32x4){0.f, 0.f, 0.f, 0.f};
                else if (sec <= 2) bb[bj][n] = *(const f32x4*)(w0 + (sec - 1) * 1024 + c0 + bj * HALF + 4 * n);
                else bb[bj][n] = *(const f32x4*)(a0 + (sec - 3) * 1024 + c0 + bj * HALF + 4 * n);
            }
#pragma unroll
        for (int ai = 0; ai < 2; ++ai)
#pragma unroll
            for (int m = 0; m < 4; ++m) {
                float* rowp = LO + (size_t)(row0 + ai * HALF + m * 16) * 5120 + col0;
#pragma unroll
                for (int bj = 0; bj < 2; ++bj)
#pragma unroll
                    for (int n = 0; n < 2; ++n) {
                        f32x4 v = acc[ai][bj][m][n] + bb[bj][n];
                        if (sec >= 1) {
#pragma unroll
                            for (int e = 0; e < 4; ++e) { const float s = fsigmoid(v[e]); v[e] = (sec <= 2) ? __expf(-0.60653066f * s) : s; }
                        }
                        *(f32x4*)(rowp + bj * HALF + 4 * n) = v;
                    }
            }
    }
};

struct EpiMerge {
    static constexpr bool PERM = true, AFTER_DRAIN = false;
    const bf16_t* pgate; int ldp;
    const float* bgate;
    float* ZF; bf16_t* Z; int mtiles;
    __device__ __forceinline__ void operator()(const f32x4 (&acc)[2][2][4][2], const Unit& u, int wr, int wc, int fr, int fq) const {
        const int br = u.pn >> 3, pn = u.pn & 7, pm = u.pm - mtiles * br;
        const int col0 = pn * BM + wc * 32 + 8 * fq, row0 = pm * BM + wr * 64 + fr;
        f32x4 bb[2][2];
#pragma unroll
        for (int bj = 0; bj < 2; ++bj)
#pragma unroll
            for (int n = 0; n < 2; ++n) bb[bj][n] = *(const f32x4*)(bgate + br * 2048 + col0 + bj * HALF + 4 * n);
#pragma unroll
        for (int ai = 0; ai < 2; ++ai)
#pragma unroll
            for (int m = 0; m < 4; ++m) {
                const size_t row = (size_t)(row0 + ai * HALF + m * 16);
#pragma unroll
                for (int bj = 0; bj < 2; ++bj) {
                    const u32x4 pg = *(const u32x4*)(pgate + row * ldp + br * 2048 + col0 + bj * HALF);
                    f32x4 g0, g1;
                    g0[0] = bflo(pg.x); g0[1] = bfhi(pg.x); g0[2] = bflo(pg.y); g0[3] = bfhi(pg.y); g1[0] = bflo(pg.z); g1[1] = bfhi(pg.z); g1[2] = bflo(pg.w); g1[3] = bfhi(pg.w);
                    g0 = g0 + bb[bj][0]; g1 = g1 + bb[bj][1];
                    f32x4 v0, v1;
#pragma unroll
                    for (int e = 0; e < 4; ++e) { v0[e] = fsigmoid(g0[e]) * acc[ai][bj][m][0][e]; v1[e] = fsigmoid(g1[e]) * acc[ai][bj][m][1][e]; }
                    float* zf = ZF + row * 2048 + col0 + bj * HALF;
                    if (br >= 1) { v0 = v0 + *(const f32x4*)zf; v1 = v1 + *(const f32x4*)(zf + 4); }
                    if (br <= 1) { *(f32x4*)zf = v0; *(f32x4*)(zf + 4) = v1; }
                    else { u32x4 w; w.x = cvt_pk_bf16(v0[0], v0[1]); w.y = cvt_pk_bf16(v0[2], v0[3]); w.z = cvt_pk_bf16(v1[0], v1[1]); w.w = cvt_pk_bf16(v1[2], v1[3]);
                        *(u32x4*)(Z + row * 2048 + col0 + bj * HALF) = w; }
                }
            }
    }
};
struct MergeOrder {
    int G, c, mtiles, ntiles;
    __device__ __forceinline__ bool next(int i, Unit& u) const {
        const int t = (i / 3) * G + c, br = i % 3; if (t >= mtiles * 8) return false;
        u.pm = (t >> 3) + mtiles * br; u.pn = (t & 7) + 8 * br; return true;
    }
    __device__ __forceinline__ void a_ready(const Unit&) const {}
    __device__ __forceinline__ void done(const Unit&) const {}
};

template <class Epi, class Sched, bool ALIGN_EPI = false, bool SP2 = false>
__device__ __forceinline__ void gemm_phase(PG8_LAS unsigned char* lds, const Gemm g, const Sched& S, const Epi& E) {
    const int tid = threadIdx.x, wid = __builtin_amdgcn_readfirstlane(tid >> 6), lane = tid & 63, wr = wid >> 2, wc = wid & 3, fr = lane & 15, fq = lane >> 4;
    const int K = g.K, nt = K / BK;
    unsigned voffA[2], voffB[2];
#pragma unroll
    for (int i = 0; i < 2; ++i) { int R, C; stage_rc(tid * 16 + i * 8192, R, C); const int Rb = Epi::PERM ? ((R & ~31) + perm32(R & 31)) : R;
        voffA[i] = (unsigned)(R * K + C) * 2u; voffB[i] = (unsigned)(Rb * K + C) * 2u; }
    const size_t kstep = (size_t)(BK * 2);
    const size_t hstep = (size_t)HALF * K * 2;
    const size_t tstep = 2 * hstep;
    const unsigned ldsw = (unsigned)wid * 1024u;
    const int aoff = lds_byte(wr * 64 + fr, fq * 8), boff = lds_byte(wc * 32 + fr, fq * 8);
#define PG8_SA(b, h) (((b) * 2 + (h)) * HTB)
#define PG8_SB(b, h) ((4 + (b) * 2 + (h)) * HTB)
#define PG8_STAGE(bufoff, gbase, voff) do { _Pragma("unroll") for (int _i = 0; _i < 2; ++_i) \
        __builtin_amdgcn_global_load_lds((const unsigned*)((const char*)(gbase) + (voff)[_i]), (PG8_LAS unsigned*)(lds + (bufoff) + ldsw + _i * 8192), 16, 0, 0); } while (0)
#define PG8_LDA(dst, b, h) do { _Pragma("unroll") for (int m = 0; m < 4; ++m) _Pragma("unroll") for (int k = 0; k < 2; ++k) dst[m][k] = *(const PG8_LAS bf16x8*)(lds + PG8_SA(b, h) + aoff + m * 2048 + k * 1024); } while (0)
#define PG8_LDB(dst, b, h) do { _Pragma("unroll") for (int n = 0; n < 2; ++n) _Pragma("unroll") for (int k = 0; k < 2; ++k) dst[n][k] = *(const PG8_LAS bf16x8*)(lds + PG8_SB(b, h) + boff + n * 2048 + k * 1024); } while (0)
#define PG8_MMA(ai, bj, At, Bt) do { __builtin_amdgcn_s_setprio(1); _Pragma("unroll") for (int m = 0; m < 4; ++m) _Pragma("unroll") for (int n = 0; n < 2; ++n) _Pragma("unroll") for (int k = 0; k < 2; ++k) \
        acc[ai][bj][m][n] = __builtin_amdgcn_mfma_f32_16x16x32_bf16(Bt[n][k], At[m][k], acc[ai][bj][m][n], 0, 0, 0); __builtin_amdgcn_s_setprio(0); } while (0)
#define PG8_WAIT_V(n) asm volatile("s_waitcnt vmcnt(" #n ")" ::: "memory")
#define PG8_WAIT_L(n) asm volatile("s_waitcnt lgkmcnt(" #n ")" ::: "memory")
#define PG8_BAR __builtin_amdgcn_s_barrier()
#define PG8_SCHED __builtin_amdgcn_sched_barrier(0)
    Unit cur, nxt; int ui = 0;
    if (!S.next(0, cur)) return;
    f32x4 acc[2][2][4][2];
#pragma unroll
    for (int a = 0; a < 2; ++a)
#pragma unroll
        for (int b = 0; b < 2; ++b)
#pragma unroll
            for (int m = 0; m < 4; ++m)
#pragma unroll
                for (int n = 0; n < 2; ++n) acc[a][b][m][n] = (f32x4){0.f, 0.f, 0.f, 0.f};
    bf16x8 At[4][2], B0[2][2], B1[2][2];
    const char* cA = (const char*)g.A + (size_t)cur.pm * tstep; const char* cB = (const char*)g.Bt + (size_t)cur.pn * tstep;
    S.a_ready(cur);
    if constexpr (SP2) {
        PG8_STAGE(PG8_SB(0, 0), cB, voffB); PG8_STAGE(PG8_SB(0, 1), cB + hstep, voffB); PG8_STAGE(PG8_SA(0, 0), cA, voffA); PG8_STAGE(PG8_SA(0, 1), cA + hstep, voffA);
        if (wr == 1) PG8_BAR;
        PG8_WAIT_V(2); PG8_BAR;
        PG8_STAGE(PG8_SB(1, 0), cB + kstep, voffB); PG8_STAGE(PG8_SA(1, 0), cA + kstep, voffA); PG8_STAGE(PG8_SB(1, 1), cB + hstep + kstep, voffB);
        PG8_WAIT_V(6); PG8_BAR;
    } else {
        PG8_STAGE(PG8_SB(0, 0), cB, voffB); PG8_STAGE(PG8_SA(0, 0), cA, voffA); PG8_STAGE(PG8_SB(0, 1), cB + hstep, voffB); PG8_STAGE(PG8_SA(0, 1), cA + hstep, voffA);
        if (wr == 1) PG8_BAR;
        PG8_WAIT_V(4); PG8_BAR;
        PG8_STAGE(PG8_SB(1, 0), cB + kstep, voffB); PG8_STAGE(PG8_SA(1, 0), cA + kstep, voffA); PG8_STAGE(PG8_SB(1, 1), cB + hstep + kstep, voffB);
        PG8_WAIT_V(6); PG8_BAR;
    }
    for (;;) {
        const bool has_next = S.next(ui + 1, nxt);
        const char* nA = has_next ? (const char*)g.A + (size_t)nxt.pm * tstep : cA; const char* nB = has_next ? (const char*)g.Bt + (size_t)nxt.pn * tstep : cB;
        for (int t = 0; t < nt; t += 2) {
            const bool last = (t == nt - 2);
            const char* a1 = cA + (size_t)(t + 1) * kstep;
            const char* a2 = last ? nA : cA + (size_t)(t + 2) * kstep; const char* b2 = last ? nB : cB + (size_t)(t + 2) * kstep;
            const char* a3 = a2 + kstep; const char* b3 = b2 + kstep;
            if (last && has_next) S.a_ready(nxt);
            if constexpr (SP2) {
            PG8_LDB(B0, 0, 0); PG8_LDB(B1, 0, 1); PG8_SCHED; PG8_LDA(At, 0, 0); PG8_STAGE(PG8_SA(1, 1), a1 + hstep, voffA);
            PG8_WAIT_V(8); PG8_WAIT_L(0); PG8_BAR; PG8_MMA(0, 0, At, B0); PG8_MMA(0, 1, At, B1); PG8_BAR; PG8_SCHED;
            PG8_LDA(At, 0, 1); PG8_STAGE(PG8_SB(0, 0), b2, voffB); PG8_STAGE(PG8_SB(0, 1), b2 + hstep, voffB); PG8_STAGE(PG8_SA(0, 0), a2, voffA);
            PG8_WAIT_V(8); PG8_WAIT_L(0); PG8_BAR; PG8_MMA(1, 0, At, B0); PG8_MMA(1, 1, At, B1); PG8_BAR; PG8_SCHED;
            PG8_LDB(B0, 1, 0); PG8_LDB(B1, 1, 1); PG8_SCHED; PG8_LDA(At, 1, 0); PG8_STAGE(PG8_SA(0, 1), a2 + hstep, voffA);
            PG8_WAIT_V(8); PG8_WAIT_L(0); PG8_BAR; PG8_MMA(0, 0, At, B0); PG8_MMA(0, 1, At, B1); PG8_BAR; PG8_SCHED;
            PG8_LDA(At, 1, 1); PG8_STAGE(PG8_SB(1, 0), b3, voffB); PG8_STAGE(PG8_SB(1, 1), b3 + hstep, voffB); PG8_STAGE(PG8_SA(1, 0), a3, voffA);
            PG8_WAIT_V(8); PG8_WAIT_L(0); PG8_BAR; PG8_MMA(1, 0, At, B0); PG8_MMA(1, 1, At, B1); PG8_BAR; PG8_SCHED;
            } else {
            PG8_LDB(B0, 0, 0); PG8_SCHED; PG8_LDA(At, 0, 0); PG8_STAGE(PG8_SA(1, 1), a1 + hstep, voffA);
            PG8_WAIT_L(8); PG8_BAR; PG8_WAIT_L(0); PG8_MMA(0, 0, At, B0); PG8_BAR; PG8_SCHED;
            PG8_LDB(B1, 0, 1); PG8_STAGE(PG8_SB(0, 0), b2, voffB);
            PG8_BAR; PG8_WAIT_L(0); PG8_MMA(0, 1, At, B1); PG8_BAR;
            PG8_LDA(At, 0, 1); PG8_STAGE(PG8_SA(0, 0), a2, voffA);
            PG8_BAR; PG8_WAIT_L(0); PG8_MMA(1, 0, At, B0); PG8_BAR; PG8_SCHED;
            PG8_STAGE(PG8_SB(0, 1), b2 + hstep, voffB);
            PG8_WAIT_V(6); PG8_BAR; PG8_MMA(1, 1, At, B1); PG8_BAR;
            PG8_LDB(B0, 1, 0); PG8_SCHED; PG8_LDA(At, 1, 0); PG8_STAGE(PG8_SA(0, 1), a2 + hstep, voffA);
            PG8_WAIT_L(8); PG8_BAR; PG8_WAIT_L(0); PG8_MMA(0, 0, At, B0); PG8_BAR; PG8_SCHED;
            PG8_LDB(B1, 1, 1); PG8_STAGE(PG8_SB(1, 0), b3, voffB);
            PG8_BAR; PG8_WAIT_L(0); PG8_MMA(0, 1, At, B1); PG8_BAR;
            PG8_LDA(At, 1, 1); PG8_STAGE(PG8_SA(1, 0), a3, voffA);
            PG8_BAR; PG8_WAIT_L(0); PG8_MMA(1, 0, At, B0); PG8_BAR; PG8_SCHED;
            PG8_STAGE(PG8_SB(1, 1), b3 + hstep, voffB);
            PG8_WAIT_V(6); PG8_BAR; PG8_MMA(1, 1, At, B1); PG8_BAR;
            }
        }
        if constexpr (ALIGN_EPI) { if (wr == 0) PG8_BAR; }
        if constexpr (!Epi::AFTER_DRAIN) { E(acc, cur, wr, wc, fr, fq); S.done(cur); }
        if (!has_next) break;
#pragma unroll
        for (int a = 0; a < 2; ++a)
#pragma unroll
            for (int b = 0; b < 2; ++b)
#pragma unroll
                for (int m = 0; m < 4; ++m)
#pragma unroll
                    for (int n = 0; n < 2; ++n) acc[a][b][m][n] = (f32x4){0.f, 0.f, 0.f, 0.f};
        cur = nxt; cA = nA; cB = nB; ++ui;
        if constexpr (ALIGN_EPI) { if (wr == 1) PG8_BAR; }
    }
    PG8_WAIT_V(0);
    if constexpr (!ALIGN_EPI) { if (wr == 0) PG8_BAR; }
    PG8_BAR;
    if constexpr (Epi::AFTER_DRAIN) { E.fused(acc, cur, wr, wc, fr, fq, lds, wid, lane); S.done(cur); }
#undef PG8_SA
#undef PG8_SB
#undef PG8_STAGE
#undef PG8_LDA
#undef PG8_LDB
#undef PG8_MMA
#undef PG8_WAIT_V
#undef PG8_WAIT_L
#undef PG8_BAR
#undef PG8_SCHED
}
}

constexpr int NWAVES = 8, NTHR = NWAVES * 64;
constexpr int DM = 2048, FF = 5504, FF2 = 2 * FF, NLAT = 8192, NCTX = 512, MT = NLAT + NCTX, TSEQ = 4096, TCTX = 256;
constexpr int PROJ = 14976, PROJP = 15104;
constexpr int P_U = 0, P_V = 1024, P_RKV = 2048, P_G = 5120, P_W = 5376, P_A = 5568, P_QKV = 5760, P_GATE = 8832;
constexpr int ACTW = 768, LOW = 5120;
constexpr int NLAYER = 2, NMOD = 9;

constexpr size_t MiB = 1u << 20;
constexpr size_t al(size_t x) { return (x + MiB - 1) / MiB * MiB; }
constexpr size_t WS_CTL = 0, CTL_ZERO_BYTES = 1 * MiB;
constexpr size_t WS_MODS = 1 * MiB;
constexpr size_t WS_ROPE = WS_MODS + al((size_t)NLAYER * 3 * NMOD * DM * 4);
constexpr size_t WS_WF1 = WS_ROPE + MiB;
constexpr size_t SZ_WF1 = (size_t)FF2 * DM * 2;
constexpr size_t WS_WF2 = WS_WF1 + al(4 * SZ_WF1);
constexpr size_t SZ_WF2 = (size_t)DM * FF * 2;
constexpr size_t WS_WIN = WS_WF2 + al(4 * SZ_WF2);
constexpr size_t SZ_WIN = (size_t)PROJP * DM * 2;
constexpr size_t WS_WLO = WS_WIN + al(2 * SZ_WIN);
constexpr size_t SZ_WLO = (size_t)LOW * ACTW * 2;
constexpr size_t WS_WBR = WS_WLO + al(2 * SZ_WLO);
constexpr size_t SZ_WBR = (size_t)3 * DM * 1024 * 2;
constexpr size_t WS_WOUT = WS_WBR + al(2 * SZ_WBR);
constexpr size_t SZ_WOUT = (size_t)DM * DM * 2;
constexpr size_t WS_XS = WS_WOUT + al(2 * SZ_WOUT);
constexpr size_t WS_XN = WS_XS + al((size_t)MT * DM * 4);
constexpr size_t WS_P = WS_XN + al((size_t)MT * DM * 2);
constexpr size_t WS_R1 = WS_P + al((size_t)MT * PROJP * 2);
constexpr size_t WS_ACT = WS_R1 + al((size_t)MT * LOW * 4);
constexpr size_t WS_RKVK = WS_ACT + al((size_t)MT * ACTW * 2);
constexpr size_t WS_QK = WS_RKVK + al((size_t)MT * 4096 * 2);
constexpr size_t WS_YS = WS_QK + al((size_t)MT * DM * 2);
constexpr size_t WS_Y3 = WS_YS + al((size_t)2 * MT * 1024 * 4);
constexpr size_t WS_END = WS_Y3 + al((size_t)3 * MT * 1024 * 2);

constexpr int CW_TMO = 0, CW_CODE = 1, CW_BAR = 4096;

constexpr int RING_BYTES = 131072, LDSCTL_OFF = RING_BYTES, MISC_OFF = LDSCTL_OFF + 320, LDS_BYTES = 147456;

#define GAS __attribute__((address_space(1)))
#define LAS __attribute__((address_space(3)))
typedef unsigned short bf16;
typedef unsigned v4u __attribute__((ext_vector_type(4)));
typedef unsigned v2u __attribute__((ext_vector_type(2)));
typedef float f32x4 __attribute__((ext_vector_type(4)));
typedef short bf16x8 __attribute__((ext_vector_type(8)));
typedef GAS unsigned gu32;
#define RLX_AGENT __ATOMIC_RELAXED, __HIP_MEMORY_SCOPE_AGENT
__device__ __forceinline__ unsigned f2bf(float f) { unsigned u = __builtin_bit_cast(unsigned, f); return (u + 0x7fffu + ((u >> 16) & 1u)) >> 16; }
__device__ __forceinline__ unsigned pk2(float lo, float hi) { return f2bf(lo) | (f2bf(hi) << 16); }
__device__ __forceinline__ float bflo(unsigned w) { return __builtin_bit_cast(float, w << 16); }
__device__ __forceinline__ float bfhi(unsigned w) { return __builtin_bit_cast(float, w & 0xffff0000u); }
__device__ __forceinline__ float bf1(bf16 h) { return __builtin_bit_cast(float, (unsigned)h << 16); }
__device__ __forceinline__ void unpack8(const v4u w, float (&f)[8]) { f[0] = bflo(w.x); f[1] = bfhi(w.x); f[2] = bflo(w.y); f[3] = bfhi(w.y); f[4] = bflo(w.z); f[5] = bfhi(w.z); f[6] = bflo(w.w); f[7] = bfhi(w.w); }
__device__ __forceinline__ v4u pack8(const float (&f)[8]) { v4u w; w.x = pk2(f[0], f[1]); w.y = pk2(f[2], f[3]); w.z = pk2(f[4], f[5]); w.w = pk2(f[6], f[7]); return w; }
__device__ __forceinline__ float fsigm(float x) { return __builtin_amdgcn_rcpf(1.f + __expf(-x)); }
__device__ __forceinline__ float ftanh(float x) { return 1.f - 2.f * __builtin_amdgcn_rcpf(__expf(2.f * x) + 1.f); }
__device__ __forceinline__ float gelu_t(float x) { return 0.5f * x * (1.f + ftanh(0.7978845608f * (x + 0.044715f * x * x * x))); }
__device__ __forceinline__ float wave_sum(float v) {
#pragma unroll
    for (int o = 1; o < 64; o <<= 1) v += __shfl_xor(v, o);
    return v;
}
#define XB_TMO      128
#define XB_XCNT(j)  (256  + 64 * (j))
#define XB_XSUB(j)  (1280 + 64 * (j))
#define XB_XGEN(j)  (2304 + 64 * (j))
#define XB_TOP      3328
#define XB_TOPGEN   3392
#define XCD_BAR_WORDS 3456
#define XB_SPIN_CAP (1u << 18)

__device__ __forceinline__ unsigned xb_ld(unsigned* p)              { return __hip_atomic_load(p, __ATOMIC_RELAXED, __HIP_MEMORY_SCOPE_AGENT); }
__device__ __forceinline__ unsigned xb_add(unsigned* p, unsigned v) { return __hip_atomic_fetch_add(p, v, __ATOMIC_RELAXED, __HIP_MEMORY_SCOPE_AGENT); }
__device__ __forceinline__ unsigned xb_xcc_id() { return (unsigned)__builtin_amdgcn_s_getreg((3 << 11) | 20) & 0xFu; }
#define XB_SPIN(cond, bar) do { unsigned _sp = 0; while (cond) { __builtin_amdgcn_s_sleep(1); \
    if ((++_sp & 255u) == 0u) { if (xb_ld(&(bar)[XB_TMO])) break; if (_sp > XB_SPIN_CAP) { atomicAdd(&(bar)[XB_TMO], 1u); break; } } } } while (0)

struct XcdBarrier {
    unsigned* bar; unsigned x;
    volatile LAS unsigned* st;
};

__device__ __forceinline__ XcdBarrier xcd_barrier_post(unsigned* bar, volatile LAS unsigned* st) {
    XcdBarrier b; b.bar = bar; b.x = xb_xcc_id(); b.st = st;
    if (threadIdx.x == 0) (void)xb_add(&bar[XB_XCNT(b.x)], 1u);
    return b;
}
__device__ __forceinline__ void xcd_barrier_complete(unsigned* bar, unsigned x, unsigned& nloc, unsigned& nx) {
    const unsigned G = gridDim.x * gridDim.y * gridDim.z;
    unsigned sum, cnt, mine, sp = 0u;
    for (;;) {
        sum = 0u; cnt = 0u; mine = 0u;
#pragma unroll
        for (unsigned j = 0; j < 16; ++j) { const unsigned c = xb_ld(&bar[XB_XCNT(j)]); sum += c; cnt += (c > 0u) ? 1u : 0u; mine = (j == x) ? c : mine; }
        if (sum == G) break;
        __builtin_amdgcn_s_sleep(1);
        if ((++sp & 255u) == 0u) { if (xb_ld(&bar[XB_TMO])) break; if (sp > XB_SPIN_CAP) { atomicAdd(&bar[XB_TMO], 1u); break; } }
    }
    nloc = mine > 0u ? mine : 1u; nx = cnt > 0u ? cnt : 1u;
}

__device__ __forceinline__ void xcd_barrier(const XcdBarrier& b) {
    asm volatile("s_waitcnt vmcnt(0)" ::: "memory");
    __syncthreads();
    if (threadIdx.x == 0) {
        unsigned* bar = b.bar;
        __builtin_amdgcn_s_waitcnt(0);
        unsigned nloc = b.st[0], nx = b.st[1];
        if (nloc == 0u) { xcd_barrier_complete(bar, b.x, nloc, nx); b.st[0] = nloc; b.st[1] = nx; }
        const unsigned old = xb_add(&bar[XB_XSUB(b.x)], 1u);
        const unsigned gen = old / nloc;
        if (old + 1u == (gen + 1u) * nloc) {
            __builtin_amdgcn_fence(__ATOMIC_RELEASE, "agent");
            asm volatile("s_waitcnt vmcnt(0)" ::: "memory");
            const unsigned og = xb_add(&bar[XB_TOP], 1u);
            const unsigned tg = og / nx;
            if (og + 1u == (tg + 1u) * nx) xb_add(&bar[XB_TOPGEN], 1u);
            else XB_SPIN(xb_ld(&bar[XB_TOPGEN]) == tg, bar);
            __builtin_amdgcn_fence(__ATOMIC_ACQUIRE, "agent");
            xb_add(&bar[XB_XGEN(b.x)], 1u);
            asm volatile("s_waitcnt vmcnt(0)" ::: "memory");
        } else {
            XB_SPIN(xb_ld(&bar[XB_XGEN(b.x)]) == gen, bar);
            __builtin_amdgcn_fence(__ATOMIC_ACQUIRE, "agent");
            asm volatile("s_waitcnt vmcnt(0)" ::: "memory");
        }
    }
    __syncthreads();
}

struct Args { const float* in[31]; float* out; unsigned char* ws; int ph_lo, ph_hi; };
enum In { I_X = 0, I_C, I_CTX, I_CCTX, I_WADA, I_BADA, I_NORMG, I_FFNIN, I_FFNOUT, I_WIN, I_GMVN, I_GMWS, I_GMBS, I_CONV, I_W0, I_WUP, I_A0, I_AUP, I_GUP, I_KK, I_KA, I_RK, I_LNG, I_LNB,
          I_QN, I_KN, I_LAM, I_SUBLN, I_WBR, I_BGATE, I_WOUT };

__device__ __forceinline__ void ph_ada(const Args& a, LAS unsigned char* lds, int tid, int vcu, int G) {
    LAS float* sc = (LAS float*)lds;
    LAS float* red = sc + 3 * 2048;
    const float* c = a.in[I_C]; const float* cc = a.in[I_CCTX];
    for (int i = tid; i < 3 * 2048; i += NTHR) { const float x = i < 4096 ? c[i] : cc[i - 4096]; sc[i] = x * fsigm(x); }
    __syncthreads();
    const int lane = tid & 63, wave = tid >> 6;
    float* mods = (float*)(a.ws + WS_MODS);
    for (int u = vcu; u < 576; u += G) {
        const int l = u / 288, jc = u % 288, j = jc * 64 + lane;
        const float* W = a.in[I_WADA] + (size_t)l * 2048 * 18432 + j;
        float s0 = 0.f, s1 = 0.f, s2 = 0.f;
        const int k0 = wave * 256;
#pragma unroll 8
        for (int k = 0; k < 256; ++k) { const float w = W[(size_t)(k0 + k) * 18432]; s0 += sc[k0 + k] * w; s1 += sc[2048 + k0 + k] * w; s2 += sc[4096 + k0 + k] * w; }
        red[(wave * 3 + 0) * 64 + lane] = s0; red[(wave * 3 + 1) * 64 + lane] = s1; red[(wave * 3 + 2) * 64 + lane] = s2;
        __syncthreads();
        if (wave < 3) { float s = a.in[I_BADA][(size_t)l * 18432 + j];
#pragma unroll
            for (int w8 = 0; w8 < 8; ++w8) s += red[(w8 * 3 + wave) * 64 + lane];
            mods[(size_t)(l * 3 + wave) * 18432 + j] = s; }
        __syncthreads();
    }
}
__device__ __forceinline__ void transpose_item(const float* W, int N, int sc0, bf16* WT, int Kd, int nd0, int k0, LAS float* scr, int lane) {
    if (sc0 >= 0) {
#pragma unroll 8
        for (int i = 0; i < 32; ++i) { const int kk = 2 * i + (lane >> 5); scr[kk * 33 + (lane & 31)] = W[(size_t)(k0 + kk) * N + sc0 + (lane & 31)]; }
    } else {
#pragma unroll 8
        for (int i = 0; i < 32; ++i) { const int kk = 2 * i + (lane >> 5); scr[kk * 33 + (lane & 31)] = 0.f; }
    }
    asm volatile("s_waitcnt lgkmcnt(0)" ::: "memory");
    const int c = lane & 7;
#pragma unroll
    for (int j = 0; j < 4; ++j) { const int n = (lane >> 3) + 8 * j; const LAS float* s = scr + (8 * c) * 33 + n;
        v4u o; o.x = pk2(s[0 * 33], s[1 * 33]); o.y = pk2(s[2 * 33], s[3 * 33]); o.z = pk2(s[4 * 33], s[5 * 33]); o.w = pk2(s[6 * 33], s[7 * 33]);
        *(GAS v4u*)(WT + (size_t)(nd0 + n) * Kd + k0 + 8 * c) = o; }
    asm volatile("s_waitcnt lgkmcnt(0)" ::: "memory");
}
__device__ __forceinline__ void ph_weights(const Args& a, LAS unsigned char* lds, int tid, int vcu, int G) {
    const int lane = tid & 63, wave = tid >> 6;
    LAS float* scr = (LAS float*)(lds + wave * 16384);
    const int gw = vcu * NWAVES + wave, NGW = G * NWAVES;
    constexpr int I_F1 = 32 * (FF2 / 32), I_F2 = (FF / 64) * (DM / 32), I_IN = 32 * (PROJP / 32), I_BR = 16 * (DM / 32), I_WO = 32 * (DM / 32);
    constexpr int NITEMS = 4 * I_F1 + 4 * I_F2 + 2 * I_IN + 6 * I_BR + 2 * I_WO;
    unsigned char* ws = a.ws;
    for (int it = gw; it < NITEMS; it += NGW) {
        int r = it;
        if (r < 4 * I_F1) { const int mi = r / I_F1, q = r % I_F1, nb = q % (FF2 / 32), kb = q / (FF2 / 32), nd0 = 32 * nb, pn = nd0 >> 8, rr = nd0 & 255;
            const int sc0 = rr < 128 ? pn * 128 + rr : FF + pn * 128 + (rr - 128);
            transpose_item(a.in[I_FFNIN] + (size_t)mi * DM * FF2, FF2, sc0, (bf16*)(ws + WS_WF1 + (size_t)mi * SZ_WF1), DM, nd0, 64 * kb, scr, lane); continue; }
        r -= 4 * I_F1;
        if (r < 4 * I_F2) { const int mi = r / I_F2, q = r % I_F2, nb = q % (DM / 32), kb = q / (DM / 32);
            transpose_item(a.in[I_FFNOUT] + (size_t)mi * FF * DM, DM, 32 * nb, (bf16*)(ws + WS_WF2 + (size_t)mi * SZ_WF2), FF, 32 * nb, 64 * kb, scr, lane); continue; }
        r -= 4 * I_F2;
        if (r < 2 * I_IN) { const int mi = r / I_IN, q = r % I_IN, nb = q % (PROJP / 32), kb = q / (PROJP / 32), nd0 = 32 * nb;
            transpose_item(a.in[I_WIN] + (size_t)mi * DM * PROJ, PROJ, nd0 < PROJ ? nd0 : -1, (bf16*)(ws + WS_WIN + (size_t)mi * SZ_WIN), DM, nd0, 64 * kb, scr, lane); continue; }
        r -= 2 * I_IN;
        if (r < 6 * I_BR) { const int mi = r / I_BR, q = r % I_BR, nb = q % (DM / 32), kb = q / (DM / 32);
            transpose_item(a.in[I_WBR] + (size_t)mi * 1024 * DM, DM, 32 * nb, (bf16*)(ws + WS_WBR + (size_t)mi * ((size_t)DM * 1024 * 2)), 1024, 32 * nb, 64 * kb, scr, lane); continue; }
        r -= 6 * I_BR;
        { const int mi = r / I_WO, q = r % I_WO, nb = q % (DM / 32), kb = q / (DM / 32);
            transpose_item(a.in[I_WOUT] + (size_t)mi * DM * DM, DM, 32 * nb, (bf16*)(ws + WS_WOUT + (size_t)mi * SZ_WOUT), DM, 32 * nb, 64 * kb, scr, lane); }
    }
    const int gt = vcu * NTHR + tid, NGT = G * NTHR;
    for (int i = gt; i < NLAYER * LOW * (ACTW / 8); i += NGT) {
        const int l = i / (LOW * (ACTW / 8)), q = i % (LOW * (ACTW / 8)), n = q / (ACTW / 8), k0 = (q % (ACTW / 8)) * 8, sec = n >> 10, cc = n & 1023;
        float f[8];
#pragma unroll
        for (int e = 0; e < 8; ++e) { const int k = k0 + e; float v = 0.f;
            if (sec == 0) { if (k < 256) v = a.in[I_GUP][((size_t)l * 256 + k) * 1024 + cc]; }
            else if (sec <= 2) { const int d = sec - 1, kb = 256 + 128 * d; if (k >= kb && k < kb + 96) v = a.in[I_WUP][((size_t)(l * 2 + d) * 96 + (k - kb)) * 1024 + cc]; }
            else { const int d = sec - 3, kb = 512 + 128 * d; if (k >= kb && k < kb + 96) v = a.in[I_AUP][((size_t)(l * 2 + d) * 96 + (k - kb)) * 1024 + cc]; }
            f[e] = v; }
        *(GAS v4u*)((bf16*)(ws + WS_WLO) + ((size_t)l * LOW + n) * ACTW + k0) = pack8(f);
    }
    for (int i = gt; i < 64 * 16; i += NGT) { const int p = i >> 4, ii = i & 15;
        const float inv = exp2f(-(float)(2 * ii) * (1.f / 32.f) * 13.287712379549449f);
        const float rev = (float)p * inv * 0.15915494309189535f;
        float* rt = (float*)(ws + WS_ROPE) + 2 * i; rt[0] = __builtin_amdgcn_cosf(rev); rt[1] = __builtin_amdgcn_sinf(rev); }
}

__device__ __forceinline__ void ph_norm(const float* xl, const float* xc, const float* gain, const float* mods  , int si, bf16* XN, int gw, int NGW, int lane) {
    for (int m = gw; m < MT; m += NGW) {
        const float* xr = m < NLAT ? xl + (size_t)m * DM : xc + (size_t)(m - NLAT) * DM;
        const int set = m < TSEQ ? 0 : (m < NLAT ? 1 : 2);
        const float* sh = mods + (size_t)(set * NMOD + si) * DM; const float* scl = sh + DM;
        f32x4 v[8]; float ss = 0.f;
#pragma unroll
        for (int j = 0; j < 8; ++j) { v[j] = *(const GAS f32x4*)(xr + 4 * lane + 256 * j); ss += (v[j].x * v[j].x + v[j].y * v[j].y) + (v[j].z * v[j].z + v[j].w * v[j].w); }
        const float rinv = 1.f / sqrtf(wave_sum(ss) * (1.f / DM) + 1e-6f);
#pragma unroll
        for (int j = 0; j < 8; ++j) { const int col = 4 * lane + 256 * j;
            const f32x4 g = *(const GAS f32x4*)(gain + col), s1 = *(const GAS f32x4*)(scl + col), s0 = *(const GAS f32x4*)(sh + col);
            const f32x4 o = (v[j] * rinv * g) * (s1 + 1.f) + s0;
            v2u w; w.x = pk2(o.x, o.y); w.y = pk2(o.z, o.w);
            *(GAS v2u*)(XN + (size_t)m * DM + col) = w; }
    }
}

__device__ __forceinline__ void ph_e1(const Args& a, int l, int gt, int NGT) {
    unsigned char* ws = a.ws;
    const bf16* P = (const bf16*)(ws + WS_P);
    bf16* ACT = (bf16*)(ws + WS_ACT);
    for (int i = gt; i < MT * (ACTW / 8); i += NGT) {
        const int m = i / (ACTW / 8), c0 = (i % (ACTW / 8)) * 8;
        int src = -1, fn = 0;
        if (c0 < 256) { src = P_G + c0; fn = 1; }
        else if (c0 < 352) { src = P_W + (c0 - 256); fn = 2; }
        else if (c0 >= 384 && c0 < 480) { src = P_W + 96 + (c0 - 384); fn = 2; }
        else if (c0 >= 512 && c0 < 608) { src = P_A + (c0 - 512); }
        else if (c0 >= 640 && c0 < 736) { src = P_A + 96 + (c0 - 640); }
        float f[8];
        if (src >= 0) { unpack8(*(const GAS v4u*)(P + (size_t)m * PROJP + src), f);
#pragma unroll
            for (int e = 0; e < 8; ++e) f[e] = fn == 1 ? fsigm(f[e]) : (fn == 2 ? ftanh(f[e]) : f[e]); }
        else {
#pragma unroll
            for (int e = 0; e < 8; ++e) f[e] = 0.f; }
        *(GAS v4u*)(ACT + (size_t)m * ACTW + c0) = pack8(f);
    }
    bf16* QK = (bf16*)(ws + WS_QK);
    const float* rope = (const float*)(ws + WS_ROPE);
    for (int i = gt; i < MT * 32; i += NGT) {
        const int m = i >> 5, gi = i & 31; const bool isq = gi < 16;
        const float* gain = a.in[isq ? I_QN : I_KN] + l * 64;
        const bf16* src = P + (size_t)m * PROJP + P_QKV + gi * 64;
        float y[64]; float ss = 0.f;
#pragma unroll
        for (int j = 0; j < 8; ++j) { float f[8]; unpack8(*(const GAS v4u*)(src + 8 * j), f);
#pragma unroll
            for (int e = 0; e < 8; ++e) { y[8 * j + e] = f[e]; ss += f[e] * f[e]; } }
        const float rinv = 1.f / sqrtf(ss * (1.f / 64.f) + 1e-6f);
#pragma unroll
        for (int d = 0; d < 64; ++d) y[d] = y[d] * rinv * gain[d];
        if (m < NLAT) { const int t = m & (TSEQ - 1), pr = t >> 6, pc = t & 63;
#pragma unroll
            for (int ii = 0; ii < 16; ++ii) {
                const float c1 = rope[(pr * 16 + ii) * 2], s1 = rope[(pr * 16 + ii) * 2 + 1], c2 = rope[(pc * 16 + ii) * 2], s2 = rope[(pc * 16 + ii) * 2 + 1];
                const float a1 = y[ii], a2 = y[16 + ii], b1 = y[32 + ii], b2 = y[48 + ii];
                y[ii] = a1 * c1 - a2 * s1; y[16 + ii] = a2 * c1 + a1 * s1; y[32 + ii] = b1 * c2 - b2 * s2; y[48 + ii] = b2 * c2 + b1 * s2; } }
        const float qs = isq ? 0.18033688011112042f : 1.f;
        bf16* dst = QK + (size_t)m * DM + gi * 64;
#pragma unroll
        for (int j = 0; j < 8; ++j) { float f[8];
#pragma unroll
            for (int e = 0; e < 8; ++e) f[e] = y[8 * j + e] * qs;
            *(GAS v4u*)(dst + 8 * j) = pack8(f); }
    }
    bf16* RK = (bf16*)(ws + WS_RKVK);
    const float* cw = a.in[I_CONV] + (size_t)l * 3 * 3072; const float* kkw = a.in[I_KK] + l * 1024;
    for (int i = gt; i < MT * 128; i += NGT) {
        const int m = i >> 7, c0 = (i & 127) * 8;
        const int t = m < NLAT ? (m & (TSEQ - 1)) : ((m - NLAT) & (TCTX - 1)), tl = m < NLAT ? TSEQ : TCTX;
        const bool hp = t > 0, hn = t < tl - 1;
        float kv[8];
#pragma unroll
        for (int sec = 0; sec < 3; ++sec) {
            const int col = sec * 1024 + c0; const bf16* pc = P + (size_t)m * PROJP + P_RKV + col;
            float x0[8], x1[8], x2[8], o[8];
            unpack8(*(const GAS v4u*)pc, x1);
            if (hp) unpack8(*(const GAS v4u*)(pc - PROJP), x0);
            if (hn) unpack8(*(const GAS v4u*)(pc + PROJP), x2);
#pragma unroll
            for (int e = 0; e < 8; ++e) { float v = x1[e] * cw[3072 + col + e]; if (hp) v += x0[e] * cw[col + e]; if (hn) v += x2[e] * cw[2 * 3072 + col + e]; o[e] = v; if (sec == 1) kv[e] = v; }
            *(GAS v4u*)(RK + (size_t)m * 4096 + col) = pack8(o);
        }
        float ss = 0.f;
#pragma unroll
        for (int e = 0; e < 8; ++e) { kv[e] *= kkw[c0 + e]; ss += kv[e] * kv[e]; }
        ss += __shfl_xor(ss, 1); ss += __shfl_xor(ss, 2); ss += __shfl_xor(ss, 4);
        const float rinv = 1.f / sqrtf(ss + 1e-12f);
#pragma unroll
        for (int e = 0; e < 8; ++e) kv[e] *= rinv;
        *(GAS v4u*)(RK + (size_t)m * 4096 + 3072 + c0) = pack8(kv);
    }
}

__device__ __forceinline__ void ph_gmlp(const Args& a, int l, LAS unsigned char* lds, int tid, int vcu, int G) {
    constexpr int VP = 136;
    LAS bf16* vnT = (LAS bf16*)lds;
    const bf16* P = (const bf16*)(a.ws + WS_P); bf16* YA = (bf16*)(a.ws + WS_Y3);
    const float* vng = a.in[I_GMVN] + l * 1024; const float* wsm = a.in[I_GMWS] + (size_t)l * 8 * 128 * 128; const float* bs = a.in[I_GMBS] + l * 8 * 128;
    const int lane = tid & 63, w = tid >> 6, fr = lane & 15, fq = lane >> 4;
    for (int u = vcu; u < (MT / 128) * 8; u += G) {
        const int n = u >> 3, g = u & 7, m0 = n * 128;
        { const int q = tid >> 2, qt = tid & 3; const bf16* src = P + (size_t)(m0 + q) * PROJP + P_V + g * 128 + qt * 32;
            float v[32]; float ss = 0.f;
#pragma unroll
            for (int j = 0; j < 4; ++j) { float f[8]; unpack8(*(const GAS v4u*)(src + 8 * j), f);
#pragma unroll
                for (int e = 0; e < 8; ++e) { const float x = gelu_t(f[e]); v[8 * j + e] = x; ss += x * x; } }
            ss += __shfl_xor(ss, 1); ss += __shfl_xor(ss, 2);
            const float rinv = 1.f / sqrtf(ss * (1.f / 128.f) + 1e-6f);
#pragma unroll
            for (int e = 0; e < 32; ++e) { const int c = qt * 32 + e; vnT[c * VP + q] = (bf16)f2bf(v[e] * rinv * vng[g * 128 + c]); } }
        __syncthreads();
        pg8::f32x4 acc[8];
#pragma unroll
        for (int cb = 0; cb < 8; ++cb) acc[cb] = (pg8::f32x4){0.f, 0.f, 0.f, 0.f};
#pragma unroll
        for (int ks = 0; ks < 4; ++ks) {
            const float* wr = wsm + ((size_t)g * 128 + 16 * w + fr) * 128 + ks * 32 + 8 * fq;
            const f32x4 w0 = *(const GAS f32x4*)wr, w1 = *(const GAS f32x4*)(wr + 4);
            v4u aw; aw.x = pk2(w0.x, w0.y); aw.y = pk2(w0.z, w0.w); aw.z = pk2(w1.x, w1.y); aw.w = pk2(w1.z, w1.w);
            const bf16x8 af = __builtin_bit_cast(bf16x8, aw);
#pragma unroll
            for (int cb = 0; cb < 8; ++cb) { const bf16x8 bfr = *(const LAS bf16x8*)(vnT + (cb * 16 + fr) * VP + ks * 32 + 8 * fq);
                acc[cb] = __builtin_amdgcn_mfma_f32_16x16x32_bf16(af, bfr, acc[cb], 0, 0, 0); }
        }
#pragma unroll
        for (int cb = 0; cb < 8; ++cb)
#pragma unroll
            for (int i = 0; i < 4; ++i) { const int p = 16 * w + 4 * fq + i, c = cb * 16 + fr;
                const float pu = bf1(P[(size_t)(m0 + p) * PROJP + P_U + g * 128 + c]);
                YA[(size_t)(m0 + p) * 1024 + g * 128 + c] = (bf16)f2bf(gelu_t(pu) * (acc[cb][i] + bs[g * 128 + p])); }
        __syncthreads();
    }
}

__device__ __forceinline__ void ph_attn(const Args& a, int l, bool ctx_out, LAS unsigned char* lds, int tid, int vcu, int G) {
    constexpr int KP = 72, VTP = 40;
    LAS bf16* Ks = (LAS bf16*)lds; LAS bf16* VT = (LAS bf16*)(lds + 32 * KP * 2);
    const bf16* QK = (const bf16*)(a.ws + WS_QK); const bf16* P = (const bf16*)(a.ws + WS_P); bf16* YC = (bf16*)(a.ws + WS_Y3) + (size_t)2 * MT * 1024;
    const int lane = tid & 63, w = tid >> 6, fr = lane & 15, fq = lane >> 4;
    const float* lv = a.in[I_LAM] + l * 256;
    float l1 = lv[lane] * lv[64 + lane], l2 = lv[128 + lane] * lv[192 + lane];
    l1 = wave_sum(l1); l2 = wave_sum(l2);
    const float lam_init = 0.8f - 0.6f * __expf(-0.3f * (float)l);
    const float lam = __expf(l1) - __expf(l2) + lam_init;
    const float* subln = a.in[I_SUBLN] + l * 128;
    const int nunits = ctx_out ? 544 : 512;
    for (int u = vcu; u < nunits; u += G) {
        int b, h, qrow0, kt0, kt1;
        if (u < 512) { b = u >> 8; h = (u >> 5) & 7; qrow0 = b * TSEQ + (u & 31) * 128; kt0 = 0; kt1 = 136; }
        else { const int uu = u - 512; b = uu >> 4; h = (uu >> 1) & 7; qrow0 = NLAT + b * TCTX + (uu & 1) * 128; kt0 = 128; kt1 = 136; }
        pg8::f32x4 O0[8];
#pragma unroll
        for (int j = 0; j < 2; ++j) {
            bf16x8 qf[2];
#pragma unroll
            for (int ds = 0; ds < 2; ++ds) qf[ds] = *(const GAS bf16x8*)(QK + (size_t)(qrow0 + 16 * w + fr) * DM + (h * 2 + j) * 64 + ds * 32 + 8 * fq);
            float m_run = -1e30f, l_part = 0.f;
            pg8::f32x4 O[8];
#pragma unroll
            for (int eb = 0; eb < 8; ++eb) O[eb] = (pg8::f32x4){0.f, 0.f, 0.f, 0.f};
            for (int kt = kt0; kt < kt1; ++kt) {
                const int krow0 = kt < 128 ? b * TSEQ + kt * 32 : NLAT + b * TCTX + (kt - 128) * 32;
                __syncthreads();
                if (tid < 256) { const int key = tid >> 3, ch = tid & 7;
                    *(LAS v4u*)(Ks + key * KP + ch * 8) = *(const GAS v4u*)(QK + (size_t)(krow0 + key) * DM + 1024 + (h * 2 + j) * 64 + ch * 8); }
                { const int key = tid >> 4, ch = tid & 15;
                    const v4u vv = *(const GAS v4u*)(P + (size_t)(krow0 + key) * PROJP + P_QKV + 2048 + h * 128 + ch * 8);
                    LAS bf16* d = VT + (ch * 8) * VTP + key;
                    d[0 * VTP] = (bf16)(vv.x & 0xffffu); d[1 * VTP] = (bf16)(vv.x >> 16); d[2 * VTP] = (bf16)(vv.y & 0xffffu); d[3 * VTP] = (bf16)(vv.y >> 16);
                    d[4 * VTP] = (bf16)(vv.z & 0xffffu); d[5 * VTP] = (bf16)(vv.z >> 16); d[6 * VTP] = (bf16)(vv.w & 0xffffu); d[7 * VTP] = (bf16)(vv.w >> 16); }
                __syncthreads();
                pg8::f32x4 s[2];
#pragma unroll
                for (int kb = 0; kb < 2; ++kb) { s[kb] = (pg8::f32x4){0.f, 0.f, 0.f, 0.f};
#pragma unroll
                    for (int ds = 0; ds < 2; ++ds) { const bf16x8 kf = *(const LAS bf16x8*)(Ks + (kb * 16 + fr) * KP + ds * 32 + 8 * fq);
                        s[kb] = __builtin_amdgcn_mfma_f32_16x16x32_bf16(kf, qf[ds], s[kb], 0, 0, 0); } }
                float mx = fmaxf(fmaxf(fmaxf(s[0][0], s[0][1]), fmaxf(s[0][2], s[0][3])), fmaxf(fmaxf(s[1][0], s[1][1]), fmaxf(s[1][2], s[1][3])));
                mx = fmaxf(mx, __shfl_xor(mx, 16)); mx = fmaxf(mx, __shfl_xor(mx, 32));
                const float m_new = fmaxf(m_run, mx), alpha = exp2f(m_run - m_new); m_run = m_new;
                float p[8]; float ps = 0.f;
#pragma unroll
                for (int i = 0; i < 4; ++i) { p[i] = exp2f(s[0][i] - m_new); p[4 + i] = exp2f(s[1][i] - m_new); ps += p[i] + p[4 + i]; }
                l_part = l_part * alpha + ps;
                v4u pw; pw.x = pk2(p[0], p[1]); pw.y = pk2(p[2], p[3]); pw.z = pk2(p[4], p[5]); pw.w = pk2(p[6], p[7]);
                const bf16x8 pb = __builtin_bit_cast(bf16x8, pw);
#pragma unroll
                for (int eb = 0; eb < 8; ++eb) {
                    O[eb] = O[eb] * alpha;
                    const LAS bf16* vp = VT + (eb * 16 + fr) * VTP + 4 * fq;
                    const v2u va = *(const LAS v2u*)vp, vb = *(const LAS v2u*)(vp + 16);
                    v4u vw; vw.x = va.x; vw.y = va.y; vw.z = vb.x; vw.w = vb.y;
                    O[eb] = __builtin_amdgcn_mfma_f32_16x16x32_bf16(__builtin_bit_cast(bf16x8, vw), pb, O[eb], 0, 0, 0);
                }
            }
            float lsum = l_part; lsum += __shfl_xor(lsum, 16); lsum += __shfl_xor(lsum, 32);
            const float rl = 1.f / lsum;
            if (j == 0) {
#pragma unroll
                for (int eb = 0; eb < 8; ++eb) O0[eb] = O[eb] * rl;
            } else {
#pragma unroll
                for (int eb = 0; eb < 8; ++eb) O0[eb] = O0[eb] - O[eb] * (lam * rl);
            }
        }
        float ss = 0.f;
#pragma unroll
        for (int eb = 0; eb < 8; ++eb) ss += (O0[eb][0] * O0[eb][0] + O0[eb][1] * O0[eb][1]) + (O0[eb][2] * O0[eb][2] + O0[eb][3] * O0[eb][3]);
        ss += __shfl_xor(ss, 16); ss += __shfl_xor(ss, 32);
        const float rinv = (1.f - lam_init) / sqrtf(ss * (1.f / 128.f) + 1e-6f);
        bf16* dst = YC + (size_t)(qrow0 + 16 * w + fr) * 1024 + h * 128 + 4 * fq;
#pragma unroll
        for (int eb = 0; eb < 8; ++eb) { const f32x4 g = *(const GAS f32x4*)(subln + eb * 16 + 4 * fq);
            v2u o; o.x = pk2(O0[eb][0] * rinv * g.x, O0[eb][1] * rinv * g.y); o.y = pk2(O0[eb][2] * rinv * g.z, O0[eb][3] * rinv * g.w);
            *(GAS v2u*)(dst + eb * 16) = o; }
    }
}

__device__ __forceinline__ void ph_scan(const Args& a, int l, LAS unsigned char* lds, int tid, int vcu, int G) {
    LAS float* op = (LAS float*)lds;
    LAS float* yb = op + 32 * 6 * 64;
    const float* LO = (const float*)(a.ws + WS_R1); const bf16* RK = (const bf16*)(a.ws + WS_RKVK); float* YS = (float*)(a.ws + WS_YS);
    const float* ka = a.in[I_KA] + l * 1024;
    const int row = tid >> 3, kg = tid & 7;
    for (int u = vcu; u < 64; u += G) {
        const int b = u >> 5, h = (u >> 1) & 15, d = u & 1;
        float s[8];
#pragma unroll
        for (int e = 0; e < 8; ++e) s[e] = 0.f;
        for (int blk = 0; blk < (TCTX + TSEQ) / 32; ++blk) {
#pragma unroll
            for (int r4 = 0; r4 < 4; ++r4) { const int idx = tid + NTHR * r4, st = idx >> 6, c = idx & 63, i = blk * 32 + st;
                const int m = i < TCTX ? NLAT + b * TCTX + (d ? TCTX - 1 - i : i) : b * TSEQ + (d ? TSEQ - 1 - (i - TCTX) : (i - TCTX));
                const int ch = h * 64 + c;
                const float wv = LO[(size_t)m * LOW + 1024 + d * 1024 + ch], av = LO[(size_t)m * LOW + 3072 + d * 1024 + ch];
                const bf16* rk = RK + (size_t)m * 4096 + ch;
                const float rv = bf1(rk[0]), kv = bf1(rk[1024]), vv = bf1(rk[2048]), kkv = bf1(rk[3072]);
                LAS float* o = op + st * 384 + c;
                o[0] = wv; o[64] = kv * (1.f + (av - 1.f) * ka[ch]); o[128] = kkv; o[192] = kkv * av; o[256] = rv; o[320] = vv; }
            __syncthreads();
            for (int st = 0; st < 32; ++st) {
                const LAS float* o = op + st * 384 + kg * 8;
                const f32x4 w0 = *(const LAS f32x4*)(o), w1 = *(const LAS f32x4*)(o + 4), k0 = *(const LAS f32x4*)(o + 64), k1 = *(const LAS f32x4*)(o + 68),
                            q0 = *(const LAS f32x4*)(o + 128), q1 = *(const LAS f32x4*)(o + 132), b0 = *(const LAS f32x4*)(o + 192), b1 = *(const LAS f32x4*)(o + 196),
                            r0 = *(const LAS f32x4*)(o + 256), r1 = *(const LAS f32x4*)(o + 260);
                const float vv = op[st * 384 + 320 + row];
                float sa = (s[0] * q0.x + s[1] * q0.y) + (s[2] * q0.z + s[3] * q0.w) + (s[4] * q1.x + s[5] * q1.y) + (s[6] * q1.z + s[7] * q1.w);
                sa += __shfl_xor(sa, 1); sa += __shfl_xor(sa, 2); sa += __shfl_xor(sa, 4);
                s[0] = s[0] * w0.x - sa * b0.x + vv * k0.x; s[1] = s[1] * w0.y - sa * b0.y + vv * k0.y; s[2] = s[2] * w0.z - sa * b0.z + vv * k0.z; s[3] = s[3] * w0.w - sa * b0.w + vv * k0.w;
                s[4] = s[4] * w1.x - sa * b1.x + vv * k1.x; s[5] = s[5] * w1.y - sa * b1.y + vv * k1.y; s[6] = s[6] * w1.z - sa * b1.z + vv * k1.z; s[7] = s[7] * w1.w - sa * b1.w + vv * k1.w;
                float y = (s[0] * r0.x + s[1] * r0.y) + (s[2] * r0.z + s[3] * r0.w) + (s[4] * r1.x + s[5] * r1.y) + (s[6] * r1.z + s[7] * r1.w);
                y += __shfl_xor(y, 1); y += __shfl_xor(y, 2); y += __shfl_xor(y, 4);
                if (kg == 0) yb[st * 64 + row] = y;
            }
            __syncthreads();
#pragma unroll
            for (int r4 = 0; r4 < 4; ++r4) { const int idx = tid + NTHR * r4, st = idx >> 6, c = idx & 63, i = blk * 32 + st;
                const int m = i < TCTX ? NLAT + b * TCTX + (d ? TCTX - 1 - i : i) : b * TSEQ + (d ? TSEQ - 1 - (i - TCTX) : (i - TCTX));
                YS[((size_t)d * MT + m) * 1024 + h * 64 + c] = yb[st * 64 + c]; }
        }
        __syncthreads();
    }
}

__device__ __forceinline__ void ph_rwkv_out(const Args& a, int l, int gt, int NGT) {
    const float* LO = (const float*)(a.ws + WS_R1); const bf16* RK = (const bf16*)(a.ws + WS_RKVK); const float* YS = (const float*)(a.ws + WS_YS);
    bf16* YB = (bf16*)(a.ws + WS_Y3) + (size_t)MT * 1024;
    const float* ka = a.in[I_KA] + l * 1024; const float* rkw = a.in[I_RK] + l * 1024; const float* lng = a.in[I_LNG] + l * 1024; const float* lnb = a.in[I_LNB] + l * 1024;
    for (int i = gt; i < MT * 128; i += NGT) {
        const int m = i >> 7, c0 = (i & 127) * 8;
        float y[8]; float s1 = 0.f;
        { const f32x4 a0 = *(const GAS f32x4*)(YS + (size_t)m * 1024 + c0), a1 = *(const GAS f32x4*)(YS + (size_t)m * 1024 + c0 + 4),
                      b0 = *(const GAS f32x4*)(YS + ((size_t)MT + m) * 1024 + c0), b1 = *(const GAS f32x4*)(YS + ((size_t)MT + m) * 1024 + c0 + 4);
            y[0] = a0.x + b0.x; y[1] = a0.y + b0.y; y[2] = a0.z + b0.z; y[3] = a0.w + b0.w; y[4] = a1.x + b1.x; y[5] = a1.y + b1.y; y[6] = a1.z + b1.z; y[7] = a1.w + b1.w; }
#pragma unroll
        for (int e = 0; e < 8; ++e) s1 += y[e];
        s1 += __shfl_xor(s1, 1); s1 += __shfl_xor(s1, 2); s1 += __shfl_xor(s1, 4);
        const float mu = s1 * (1.f / 64.f); float s2 = 0.f;
#pragma unroll
        for (int e = 0; e < 8; ++e) { y[e] -= mu; s2 += y[e] * y[e]; }
        s2 += __shfl_xor(s2, 1); s2 += __shfl_xor(s2, 2); s2 += __shfl_xor(s2, 4);
        const float rstd = 1.f / sqrtf(s2 * (1.f / 64.f) + 64e-5f);
        float r[8], k[8], v[8];
        unpack8(*(const GAS v4u*)(RK + (size_t)m * 4096 + c0), r); unpack8(*(const GAS v4u*)(RK + (size_t)m * 4096 + 1024 + c0), k); unpack8(*(const GAS v4u*)(RK + (size_t)m * 4096 + 2048 + c0), v);
        float rk = 0.f;
#pragma unroll
        for (int e = 0; e < 8; ++e) { const int c = c0 + e; const float am = 0.5f * (LO[(size_t)m * LOW + 3072 + c] + LO[(size_t)m * LOW + 4096 + c]);
            rk += r[e] * (k[e] * (1.f + (am - 1.f) * ka[c])) * rkw[c]; }
        rk += __shfl_xor(rk, 1); rk += __shfl_xor(rk, 2); rk += __shfl_xor(rk, 4);
        float o[8];
#pragma unroll
        for (int e = 0; e < 8; ++e) { const int c = c0 + e; o[e] = (y[e] * rstd * lng[c] + lnb[c] + rk * v[e]) * LO[(size_t)m * LOW + c]; }
        *(GAS v4u*)(YB + (size_t)m * 1024 + c0) = pack8(o);
    }
}

constexpr int PH_PER_LAYER = 16, NPH = 1 + NLAYER * PH_PER_LAYER;
#define IN(k) (lo <= (k) && (k) < hi)
#define SEAM(k) do { if (IN(k) && IN((k) + 1)) xcd_barrier(bar); } while (0)
#ifndef ONLY_PH
#define ONLY_PH -1
#endif
#define INL(k) ((ONLY_PH < 0 || ONLY_PH == (k)) && IN(pb + (k)))
#define SEAML(k) SEAM(pb + (k))
template <int l> __device__ __forceinline__ void layer_body(const Args& args, LAS unsigned char* lds, unsigned char* ws, const XcdBarrier& bar, int lo, int hi, int tid, int lane, int G, int bx, int vcu, int gw, int NGW, int gt, int NGT) {
        const int pb = 1 + l * PH_PER_LAYER;
        const bool last = (l == NLAYER - 1);
        float* XS = (float*)(ws + WS_XS);
        const float* mods = (const float*)(ws + WS_MODS) + (size_t)l * 3 * NMOD * DM;
        const float* normg = args.in[I_NORMG] + (size_t)l * 3 * DM;
        pg8::bf16_t* XN = (pg8::bf16_t*)(ws + WS_XN);
        pg8::bf16_t* Hb = (pg8::bf16_t*)(ws + WS_R1);
        const float* xl0 = (l == 0) ? args.in[I_X] : XS; const float* xc0 = (l == 0) ? args.in[I_CTX] : XS + (size_t)NLAT * DM;

        if (INL(0)) ph_norm(xl0, xc0, normg, mods, 0, (bf16*)XN, gw, NGW, lane);
        SEAML(0);
        if (INL(1)) { pg8::Gemm g{XN, (const pg8::bf16_t*)(ws + WS_WF1 + (size_t)(l * 2 + 0) * SZ_WF1), MT, FF2, DM}; pg8::StaticOrder S; S.init(MT, FF2, G, bx);
            pg8::EpiSwiglu E{Hb, FF}; pg8::gemm_phase<pg8::EpiSwiglu, pg8::StaticOrder, true, true>(lds, g, S, E); }
        SEAML(1);
        if (INL(2)) { pg8::Gemm g{Hb, (const pg8::bf16_t*)(ws + WS_WF2 + (size_t)(l * 2 + 0) * SZ_WF2), MT, DM, FF}; pg8::StaticOrder S; S.init(MT, DM, G, bx);
            pg8::EpiResid E{xl0, (long)((xc0 - (size_t)NLAT * DM) - xl0), XS, 0L, 0, mods + 2 * DM, NMOD * DM, 0.5f, NLAT / 256, TSEQ / 256};
            pg8::gemm_phase<pg8::EpiResid, pg8::StaticOrder, true, true>(lds, g, S, E); }
        SEAML(2);
        if (INL(3)) ph_norm(XS, XS + (size_t)NLAT * DM, normg + DM, mods, 3, (bf16*)XN, gw, NGW, lane);
        SEAML(3);
        if (INL(4)) { pg8::Gemm g{XN, (const pg8::bf16_t*)(ws + WS_WIN + (size_t)l * SZ_WIN), MT, PROJP, DM}; pg8::StaticOrder S; S.init(MT, PROJP, G, bx);
            pg8::EpiRawBf16 E{(pg8::bf16_t*)(ws + WS_P), PROJP}; pg8::gemm_phase<pg8::EpiRawBf16, pg8::StaticOrder, true, true>(lds, g, S, E); }
        SEAML(4);
        if (INL(5)) ph_e1(args, l, gt, NGT);
        SEAML(5);
        if (INL(6)) { pg8::Gemm g{(const pg8::bf16_t*)(ws + WS_ACT), (const pg8::bf16_t*)(ws + WS_WLO + (size_t)l * SZ_WLO), MT, LOW, ACTW}; pg8::StaticOrder S; S.init(MT, LOW, G, bx);
            pg8::EpiLora E{(float*)(ws + WS_R1), args.in[I_W0] + l * 2048, args.in[I_A0] + l * 2048}; pg8::gemm_phase<pg8::EpiLora, pg8::StaticOrder, true, true>(lds, g, S, E); }
        SEAML(6);
        if (INL(7)) ph_gmlp(args, l, lds, tid, vcu, G);
        SEAML(7);
        if (INL(8)) ph_attn(args, l, !last, lds, tid, vcu, G);
        SEAML(8);
        if (INL(9)) ph_scan(args, l, lds, tid, vcu, G);
        SEAML(9);
        if (INL(10)) ph_rwkv_out(args, l, gt, NGT);
        SEAML(10);
        if (INL(11)) { pg8::Gemm g{(const pg8::bf16_t*)(ws + WS_Y3), (const pg8::bf16_t*)(ws + WS_WBR + (size_t)l * SZ_WBR), 3 * MT, 3 * DM, 1024}; pg8::MergeOrder S{G, bx, MT / 256, 8};
            pg8::EpiMerge E{(const pg8::bf16_t*)(ws + WS_P) + P_GATE, PROJP, args.in[I_BGATE] + (size_t)l * 3 * DM, (float*)(ws + WS_YS), XN, MT / 256};
            pg8::gemm_phase<pg8::EpiMerge, pg8::MergeOrder, true, true>(lds, g, S, E); }
        SEAML(11);
        if (INL(12)) { pg8::Gemm g{XN, (const pg8::bf16_t*)(ws + WS_WOUT + (size_t)l * SZ_WOUT), MT, DM, DM}; pg8::StaticOrder S; S.init(MT, DM, G, bx);
            pg8::EpiResid E{XS, 0L, XS, 0L, 0, mods + 5 * DM, NMOD * DM, 1.0f, NLAT / 256, TSEQ / 256};
            pg8::gemm_phase<pg8::EpiResid, pg8::StaticOrder, true, true>(lds, g, S, E); }
        SEAML(12);
        if (INL(13)) ph_norm(XS, XS + (size_t)NLAT * DM, normg + 2 * DM, mods, 6, (bf16*)XN, gw, NGW, lane);
        SEAML(13);
        if (INL(14)) { pg8::Gemm g{XN, (const pg8::bf16_t*)(ws + WS_WF1 + (size_t)(l * 2 + 1) * SZ_WF1), MT, FF2, DM}; pg8::StaticOrder S; S.init(MT, FF2, G, bx);
            pg8::EpiSwiglu E{Hb, FF}; pg8::gemm_phase<pg8::EpiSwiglu, pg8::StaticOrder, true, true>(lds, g, S, E); }
        SEAML(14);
        if (INL(15)) { pg8::Gemm g{Hb, (const pg8::bf16_t*)(ws + WS_WF2 + (size_t)(l * 2 + 1) * SZ_WF2), MT, DM, FF}; pg8::StaticOrder S; S.init(MT, DM, G, bx);
            pg8::EpiResid E{XS, 0L, last ? args.out : XS, 0L, last ? 1 : 0, mods + 8 * DM, NMOD * DM, 0.5f, NLAT / 256, TSEQ / 256};
            pg8::gemm_phase<pg8::EpiResid, pg8::StaticOrder, true, true>(lds, g, S, E); }
        SEAML(15);
    }
__global__ void __launch_bounds__(NTHR, 2) fwd(Args args) {
    extern __shared__ __attribute__((aligned(16))) unsigned char lds_raw[];
    LAS unsigned char* lds = (LAS unsigned char*)lds_raw;
    const int tid = threadIdx.x, lane = tid & 63, wave = __builtin_amdgcn_readfirstlane(tid >> 6);
    const int G = gridDim.x; const int bx = blockIdx.x; const int vcu = (G % 8 == 0) ? (bx % 8) * (G / 8) + bx / 8 : bx;
    const int gw = vcu * NWAVES + wave, NGW = G * NWAVES, gt = vcu * NTHR + tid, NGT = G * NTHR;
    unsigned char* ws = args.ws;
    volatile LAS unsigned* MISC = (volatile LAS unsigned*)(lds + MISC_OFF);
    for (int u = tid; u < (LDS_BYTES - LDSCTL_OFF) / 4; u += NTHR) ((LAS unsigned*)(lds + LDSCTL_OFF))[u] = 0u;
    __syncthreads();
    const int lo = args.ph_lo, hi = args.ph_hi;
    const bool multi = (hi - lo) > 1;
    XcdBarrier bar; bar.bar = (unsigned*)(ws + WS_CTL) + CW_BAR; bar.x = 0; bar.st = nullptr;
    if (multi) bar = xcd_barrier_post((unsigned*)(ws + WS_CTL) + CW_BAR, MISC + 8);

    if ((ONLY_PH < 0 || ONLY_PH == 100) && IN(0)) { ph_ada(args, lds, tid, vcu, G); __syncthreads(); ph_weights(args, lds, tid, vcu, G); }
    SEAM(0);

    layer_body<0>(args, lds, ws, bar, lo, hi, tid, lane, G, bx, vcu, gw, NGW, gt, NGT);
    layer_body<1>(args, lds, ws, bar, lo, hi, tid, lane, G, bx, vcu, gw, NGW, gt, NGT);
#undef IN
#undef SEAM
}

#ifndef MK_PER_PHASE
#define MK_PER_PHASE 0
#endif
extern "C" void kernel_launch(void* const* d_in, const int* in_sizes, int n_in, void* d_out, int out_size, void* d_ws, size_t ws_size, hipStream_t stream) {
    static int grid = 0;
    if (grid == 0) {
        if (n_in != 31 || in_sizes[0] != NLAT * DM || out_size != NLAT * DM || ws_size < WS_END) {
            fprintf(stderr, "kernel_launch: unexpected shapes: n_in %d in0 %d out %d ws %zu (need %zu); nothing launched\n", n_in, n_in > 0 ? in_sizes[0] : -1, out_size, ws_size, (size_t)WS_END); grid = -1; return; }
        int dev = 0, cus = 0, per_cu = 0;
        if (hipGetDevice(&dev) != hipSuccess || hipDeviceGetAttribute(&cus, hipDeviceAttributeMultiprocessorCount, dev) != hipSuccess) { grid = -1; return; }
        if (hipFuncSetAttribute((const void*)fwd, hipFuncAttributeMaxDynamicSharedMemorySize, LDS_BYTES) != hipSuccess) { fprintf(stderr, "kernel_launch: hipFuncSetAttribute failed\n"); grid = -1; return; }
        if (hipOccupancyMaxActiveBlocksPerMultiprocessor(&per_cu, (const void*)fwd, NTHR, LDS_BYTES) != hipSuccess || per_cu < 1) fprintf(stderr, "kernel_launch: occupancy query says %d\n", per_cu);
        (void)hipGetLastError();
        grid = cus;
    }
    if (grid < 0) return;
    (void)hipMemsetAsync((char*)d_ws + WS_CTL, 0, CTL_ZERO_BYTES, stream);
    Args a{};
    for (int i = 0; i < 31; ++i) a.in[i] = (const float*)d_in[i];
    a.out = (float*)d_out; a.ws = (unsigned char*)d_ws;
#if MK_PER_PHASE
    for (int p = 0; p < NPH; ++p) { a.ph_lo = p; a.ph_hi = p + 1; hipLaunchKernelGGL(fwd, dim3(grid), dim3(NTHR), LDS_BYTES, stream, a); }
#else
    a.ph_lo = 0; a.ph_hi = NPH; hipLaunchKernelGGL(fwd, dim3(grid), dim3(NTHR), LDS_BYTES, stream, a);
#endif
}
```

```cpp
#include <hip/hip_runtime.h>
#include <cstdio>
#include <cstdint>
namespace pg8 {
#define PG8_LAS __attribute__((address_space(3)))
typedef unsigned short bf16_t;
typedef short bf16x8 __attribute__((ext_vector_type(8)));
typedef float f32x4 __attribute__((ext_vector_type(4)));
typedef unsigned u32x4 __attribute__((ext_vector_type(4)));
constexpr int BM = 256, BK = 64, HALF = 128, HTB = HALF * BK * 2  , STAGE_BYTES = 8 * HTB, NXCD = 8, WGM = 8;

__host__ __device__ __forceinline__ int lds_byte(int r, int c) { const int st = (r >> 4) * 2 + (c >> 5), rr = r & 15, cc = c & 31, ob = rr * 64 + cc * 2; return st * 1024 + (ob ^ (((ob >> 9) & 1) << 5)); }
__host__ __device__ __forceinline__ void stage_rc(int b, int& R, int& C) { const int st = b / 1024, sb = b % 1024, swz = sb ^ (((sb >> 9) & 1) << 5); R = (st >> 1) * 16 + swz / 64; C = (st & 1) * 32 + (swz % 64) / 2; }
__host__ __device__ __forceinline__ int perm32(int rho) { const int n = rho >> 4, i = rho & 15; return 8 * (i >> 2) + 4 * n + (i & 3); }

struct Unit { int pm, pn; };
struct Gemm { const bf16_t* A; const bf16_t* Bt; int M, N, K; };

struct StaticOrder {
    int nM, nN, nwg, G, c;
    __host__ __device__ void init(int M, int N, int G_, int c_) { nM = M / BM; nN = N / BM; nwg = nM * nN; G = G_; c = c_; }
    __host__ __device__ bool next(int i, Unit& u) const {
        const long L = (long)i * G + c; if (L >= nwg) return false;
        int wgid = (int)L; { const int q = nwg / NXCD, r = nwg % NXCD, xcd = wgid % NXCD, off = wgid / NXCD; wgid = (xcd < r ? xcd * (q + 1) : r * (q + 1) + (xcd - r) * q) + off; }
        const int nig = WGM * nN, gid = wgid / nig, fm = gid * WGM, gsz = (nM - fm) < WGM ? (nM - fm) : WGM;
        u.pm = fm + ((wgid % nig) % gsz); u.pn = (wgid % nig) / gsz; return true;
    }
    __device__ __forceinline__ void a_ready(const Unit&) const {}
    __device__ __forceinline__ void done(const Unit&) const {}
};

__device__ __forceinline__ unsigned cvt_pk_bf16(float lo, float hi) { unsigned r; asm volatile("v_cvt_pk_bf16_f32 %0, %1, %2" : "=v"(r) : "v"(lo), "v"(hi)); return r; }
typedef float f32x2 __attribute__((ext_vector_type(2)));
typedef unsigned u32x2 __attribute__((ext_vector_type(2)));
__device__ __forceinline__ float fsigmoid(float x) { return __builtin_amdgcn_rcpf(1.f + __expf(-x)); }
__device__ __forceinline__ float bflo(unsigned w) { return __builtin_bit_cast(float, w << 16); }
__device__ __forceinline__ float bfhi(unsigned w) { return __builtin_bit_cast(float, w & 0xffff0000u); }

struct EpiSwiglu {
    static constexpr bool PERM = true, AFTER_DRAIN = false;
    bf16_t* H; int ldh;
    __device__ __forceinline__ void operator()(const f32x4 (&acc)[2][2][4][2], const Unit& u, int wr, int wc, int fr, int fq) const {
        const int col0 = u.pn * HALF + wc * 32 + 8 * fq, row0 = u.pm * BM + wr * 64 + fr;
#pragma unroll
        for (int ai = 0; ai < 2; ++ai)
#pragma unroll
            for (int m = 0; m < 4; ++m) {
                const f32x4 g0 = acc[ai][0][m][0], g1 = acc[ai][0][m][1], u0 = acc[ai][1][m][0], u1 = acc[ai][1][m][1];
                float o[8];
#pragma unroll
                for (int e = 0; e < 4; ++e) { o[e] = g0[e] * fsigmoid(g0[e]) * u0[e]; o[4 + e] = g1[e] * fsigmoid(g1[e]) * u1[e]; }
                u32x4 w; w.x = cvt_pk_bf16(o[0], o[1]); w.y = cvt_pk_bf16(o[2], o[3]); w.z = cvt_pk_bf16(o[4], o[5]); w.w = cvt_pk_bf16(o[6], o[7]);
                *(u32x4*)(H + (size_t)(row0 + ai * HALF + m * 16) * ldh + col0) = w;
            }
    }
};

struct EpiResid {
    static constexpr bool PERM = true, AFTER_DRAIN = false;
    const float* xin; long din; float* out; long dout; int skip_ctx; const float* gvec; int gstride; float scale; int nlat_tiles, tiles_per_set;
    __device__ __forceinline__ void operator()(const f32x4 (&acc)[2][2][4][2], const Unit& u, int wr, int wc, int fr, int fq) const {
        const bool isctx = u.pm >= nlat_tiles;
        if (isctx && skip_ctx) return;
        const int set = isctx ? 2 : (u.pm / tiles_per_set);
        const float* gv = gvec + (size_t)set * gstride;
        const int colb = u.pn * BM + wc * 32 + 8 * fq;
        const long rbase = (long)(u.pm * BM + wr * 64 + fr) * 2048 + colb;
        const float* xi = xin + rbase + (isctx ? din : 0L); float* xo = out + rbase + (isctx ? dout : 0L);
        f32x4 gg[2][2];
#pragma unroll
        for (int bj = 0; bj < 2; ++bj)
#pragma unroll
            for (int n = 0; n < 2; ++n) gg[bj][n] = *(const f32x4*)(gv + colb + bj * HALF + 4 * n) * scale;
#pragma unroll
        for (int ai = 0; ai < 2; ++ai)
#pragma unroll
            for (int m = 0; m < 4; ++m) {
                const size_t off = (size_t)(ai * HALF + m * 16) * 2048;
#pragma unroll
                for (int bj = 0; bj < 2; ++bj)
#pragma unroll
                    for (int n = 0; n < 2; ++n) {
                        const f32x4 x = *(const f32x4*)(xi + off + bj * HALF + 4 * n);
                        *(f32x4*)(xo + off + bj * HALF + 4 * n) = x + gg[bj][n] * acc[ai][bj][m][n];
                    }
            }
    }
};

struct EpiRawBf16 {
    static constexpr bool PERM = true, AFTER_DRAIN = false;
    bf16_t* O; int ldc;
    __device__ __forceinline__ void operator()(const f32x4 (&acc)[2][2][4][2], const Unit& u, int wr, int wc, int fr, int fq) const {
        const int col0 = u.pn * BM + wc * 32 + 8 * fq, row0 = u.pm * BM + wr * 64 + fr;
#pragma unroll
        for (int ai = 0; ai < 2; ++ai)
#pragma unroll
            for (int m = 0; m < 4; ++m) {
                bf16_t* rowp = O + (size_t)(row0 + ai * HALF + m * 16) * ldc + col0;
#pragma unroll
                for (int bj = 0; bj < 2; ++bj) {
                    const f32x4 v0 = acc[ai][bj][m][0], v1 = acc[ai][bj][m][1];
                    u32x4 w; w.x = cvt_pk_bf16(v0[0], v0[1]); w.y = cvt_pk_bf16(v0[2], v0[3]); w.z = cvt_pk_bf16(v1[0], v1[1]); w.w = cvt_pk_bf16(v1[2], v1[3]);
                    *(u32x4*)(rowp + bj * HALF) = w;
                }
            }
    }
};

struct EpiLora {
    static constexpr bool PERM = true, AFTER_DRAIN = false;
    float* LO; const float* w0; const float* a0;
    __device__ __forceinline__ void operator()(const f32x4 (&acc)[2][2][4][2], const Unit& u, int wr, int wc, int fr, int fq) const {
        const int sec = u.pn >> 2;
        const int col0 = u.pn * BM + wc * 32 + 8 * fq, row0 = u.pm * BM + wr * 64 + fr, c0 = col0 - sec * 1024;
        f32x4 bb[2][2];
#pragma unroll
        for (int bj = 0; bj < 2; ++bj)
#pragma unroll
            for (int n = 0; n < 2; ++n) {
                if (sec == 0) bb[bj][n] = (f32x4){0.f, 0.f, 0.f, 0.f};
                else if (sec <= 2) bb[bj][n] = *(const f32x4*)(w0 + (sec - 1) * 1024 + c0 + bj * HALF + 4 * n);
                else bb[bj][n] = *(const f32x4*)(a0 + (sec - 3) * 1024 + c0 + bj * HALF + 4 * n);
            }
#pragma unroll
        for (int ai = 0; ai < 2; ++ai)
#pragma unroll
            for (int m = 0; m < 4; ++m) {
                float* rowp = LO + (size_t)(row0 + ai * HALF + m * 16) * 5120 + col0;
#pragma unroll
                for (int bj = 0; bj < 2; ++bj)
#pragma unroll
                    for (int n = 0; n < 2; ++n) {
                        f32x4 v = acc[ai][bj][m][n] + bb[bj][n];
                        if (sec >= 1) {
#pragma unroll
                            for (int e = 0; e < 4; ++e) { const float s = fsigmoid(v[e]); v[e] = (sec <= 2) ? __expf(-0.60653066f * s) : s; }
                        }
                        *(f32x4*)(rowp + bj * HALF + 4 * n) = v;
                    }
            }
    }
};

struct EpiMerge {
    static constexpr bool PERM = true, AFTER_DRAIN = false;
    const bf16_t* pgate; int ldp;
    const float* bgate;
    float* ZF; bf16_t* Z; int mtiles;
    __device__ __forceinline__ void operator()(const f32x4 (&acc)[2][2][4][2], const Unit& u, int wr, int wc, int fr, int fq) const {
        const int br = u.pn >> 3, pn = u.pn & 7, pm = u.pm - mtiles * br;
        const int col0 = pn * BM + wc * 32 + 8 * fq, row0 = pm * BM + wr * 64 + fr;
        f32x4 bb[2][2];
#pragma unroll
        for (int bj = 0; bj < 2; ++bj)
#pragma unroll
            for (int n = 0; n < 2; ++n) bb[bj][n] = *(const f32x4*)(bgate + br * 2048 + col0 + bj * HALF + 4 * n);
#pragma unroll
        for (int ai = 0; ai < 2; ++ai)
#pragma unroll
            for (int m = 0; m < 4; ++m) {
                const size_t row = (size_t)(row0 + ai * HALF + m * 16);
#pragma unroll
                for (int bj = 0; bj < 2; ++bj) {
                    const u32x4 pg = *(const u32x4*)(pgate + row * ldp + br * 2048 + col0 + bj * HALF);
                    f32x4 g0, g1;
                    g0[0] = bflo(pg.x); g0[1] = bfhi(pg.x); g0[2] = bflo(pg.y); g0[3] = bfhi(pg.y); g1[0] = bflo(pg.z); g1[1] = bfhi(pg.z); g1[2] = bflo(pg.w); g1[3] = bfhi(pg.w);
                    g0 = g0 + bb[bj][0]; g1 = g1 + bb[bj][1];
                    f32x4 v0, v1;
#pragma unroll
                    for (int e = 0; e < 4; ++e) { v0[e] = fsigmoid(g0[e]) * acc[ai][bj][m][0][e]; v1[e] = fsigmoid(g1[e]) * acc[ai][bj][m][1][e]; }
                    float* zf = ZF + row * 2048 + col0 + bj * HALF;
                    if (br >= 1) { v0 = v0 + *(const f32x4*)zf; v1 = v1 + *(const f32x4*)(zf + 4); }
                    if (br <= 1) { *(f32x4*)zf = v0; *(f32x4*)(zf + 4) = v1; }
                    else { u32x4 w; w.x = cvt_pk_bf16(v0[0], v0[1]); w.y = cvt_pk_bf16(v0[2], v0[3]); w.z = cvt_pk_bf16(v1[0], v1[1]); w.w = cvt_pk_bf16(v1[2], v1[3]);
                        *(u32x4*)(Z + row * 2048 + col0 + bj * HALF) = w; }
                }
            }
    }
};
struct MergeOrder {
    int G, c, mtiles, ntiles;
    __device__ __forceinline__ bool next(int i, Unit& u) const {
        const int t = (i / 3) * G + c, br = i % 3; if (t >= mtiles * 8) return false;
        u.pm = (t >> 3) + mtiles * br; u.pn = (t & 7) + 8 * br; return true;
    }
    __device__ __forceinline__ void a_ready(const Unit&) const {}
    __device__ __forceinline__ void done(const Unit&) const {}
};

template <class Epi, class Sched, bool ALIGN_EPI = false, bool SP2 = false>
__device__ __forceinline__ void gemm_phase(PG8_LAS unsigned char* lds, const Gemm g, const Sched& S, const Epi& E) {
    const int tid = threadIdx.x, wid = __builtin_amdgcn_readfirstlane(tid >> 6), lane = tid & 63, wr = wid >> 2, wc = wid & 3, fr = lane & 15, fq = lane >> 4;
    const int K = g.K, nt = K / BK;
    unsigned voffA[2], voffB[2];
#pragma unroll
    for (int i = 0; i < 2; ++i) { int R, C; stage_rc(tid * 16 + i * 8192, R, C); const int Rb = Epi::PERM ? ((R & ~31) + perm32(R & 31)) : R;
        voffA[i] = (unsigned)(R * K + C) * 2u; voffB[i] = (unsigned)(Rb * K + C) * 2u; }
    const size_t kstep = (size_t)(BK * 2);
    const size_t hstep = (size_t)HALF * K * 2;
    const size_t tstep = 2 * hstep;
    const unsigned ldsw = (unsigned)wid * 1024u;
    const int aoff = lds_byte(wr * 64 + fr, fq * 8), boff = lds_byte(wc * 32 + fr, fq * 8);
#define PG8_SA(b, h) (((b) * 2 + (h)) * HTB)
#define PG8_SB(b, h) ((4 + (b) * 2 + (h)) * HTB)
#define PG8_STAGE(bufoff, gbase, voff) do { _Pragma("unroll") for (int _i = 0; _i < 2; ++_i) \
        __builtin_amdgcn_global_load_lds((const unsigned*)((const char*)(gbase) + (voff)[_i]), (PG8_LAS unsigned*)(lds + (bufoff) + ldsw + _i * 8192), 16, 0, 0); } while (0)
#define PG8_LDA(dst, b, h) do { _Pragma("unroll") for (int m = 0; m < 4; ++m) _Pragma("unroll") for (int k = 0; k < 2; ++k) dst[m][k] = *(const PG8_LAS bf16x8*)(lds + PG8_SA(b, h) + aoff + m * 2048 + k * 1024); } while (0)
#define PG8_LDB(dst, b, h) do { _Pragma("unroll") for (int n = 0; n < 2; ++n) _Pragma("unroll") for (int k = 0; k < 2; ++k) dst[n][k] = *(const PG8_LAS bf16x8*)(lds + PG8_SB(b, h) + boff + n * 2048 + k * 1024); } while (0)
#define PG8_MMA(ai, bj, At, Bt) do { __builtin_amdgcn_s_setprio(1); _Pragma("unroll") for (int m = 0; m < 4; ++m) _Pragma("unroll") for (int n = 0; n < 2; ++n) _Pragma("unroll") for (int k = 0; k < 2; ++k) \
        acc[ai][bj][m][n] = __builtin_amdgcn_mfma_f32_16x16x32_bf16(Bt[n][k], At[m][k], acc[ai][bj][m][n], 0, 0, 0); __builtin_amdgcn_s_setprio(0); } while (0)
#define PG8_WAIT_V(n) asm volatile("s_waitcnt vmcnt(" #n ")" ::: "memory")
#define PG8_WAIT_L(n) asm volatile("s_waitcnt lgkmcnt(" #n ")" ::: "memory")
#define PG8_BAR __builtin_amdgcn_s_barrier()
#define PG8_SCHED __builtin_amdgcn_sched_barrier(0)
    Unit cur, nxt; int ui = 0;
    if (!S.next(0, cur)) return;
    f32x4 acc[2][2][4][2];
#pragma unroll
    for (int a = 0; a < 2; ++a)
#pragma unroll
        for (int b = 0; b < 2; ++b)
#pragma unroll
            for (int m = 0; m < 4; ++m)
#pragma unroll
                for (int n = 0; n < 2; ++n) acc[a][b][m][n] = (f32x4){0.f, 0.f, 0.f, 0.f};
    bf16x8 At[4][2], B0[2][2], B1[2][2];
    const char* cA = (const char*)g.A + (size_t)cur.pm * tstep; const char* cB = (const char*)g.Bt + (size_t)cur.pn * tstep;
    S.a_ready(cur);
    if constexpr (SP2) {
        PG8_STAGE(PG8_SB(0, 0), cB, voffB); PG8_STAGE(PG8_SB(0, 1), cB + hstep, voffB); PG8_STAGE(PG8_SA(0, 0), cA, voffA); PG8_STAGE(PG8_SA(0, 1), cA + hstep, voffA);
        if (wr == 1) PG8_BAR;
        PG8_WAIT_V(2); PG8_BAR;
        PG8_STAGE(PG8_SB(1, 0), cB + kstep, voffB); PG8_STAGE(PG8_SA(1, 0), cA + kstep, voffA); PG8_STAGE(PG8_SB(1, 1), cB + hstep + kstep, voffB);
        PG8_WAIT_V(6); PG8_BAR;
    } else {
        PG8_STAGE(PG8_SB(0, 0), cB, voffB); PG8_STAGE(PG8_SA(0, 0), cA, voffA); PG8_STAGE(PG8_SB(0, 1), cB + hstep, voffB); PG8_STAGE(PG8_SA(0, 1), cA + hstep, voffA);
        if (wr == 1) PG8_BAR;
        PG8_WAIT_V(4); PG8_BAR;
        PG8_STAGE(PG8_SB(1, 0), cB + kstep, voffB); PG8_STAGE(PG8_SA(1, 0), cA + kstep, voffA); PG8_STAGE(PG8_SB(1, 1), cB + hstep + kstep, voffB);
        PG8_WAIT_V(6); PG8_BAR;
    }
    for (;;) {
        const bool has_next = S.next(ui + 1, nxt);
        const char* nA = has_next ? (const char*)g.A + (size_t)nxt.pm * tstep : cA; const char* nB = has_next ? (const char*)g.Bt + (size_t)nxt.pn * tstep : cB;
        for (int t = 0; t < nt; t += 2) {
            const bool last = (t == nt - 2);
            const char* a1 = cA + (size_t)(t + 1) * kstep;
            const char* a2 = last ? nA : cA + (size_t)(t + 2) * kstep; const char* b2 = last ? nB : cB + (size_t)(t + 2) * kstep;
            const char* a3 = a2 + kstep; const char* b3 = b2 + kstep;
            if (last && has_next) S.a_ready(nxt);
            if constexpr (SP2) {
            PG8_LDB(B0, 0, 0); PG8_LDB(B1, 0, 1); PG8_SCHED; PG8_LDA(At, 0, 0); PG8_STAGE(PG8_SA(1, 1), a1 + hstep, voffA);
            PG8_WAIT_V(8); PG8_WAIT_L(0); PG8_BAR; PG8_MMA(0, 0, At, B0); PG8_MMA(0, 1, At, B1); PG8_BAR; PG8_SCHED;
            PG8_LDA(At, 0, 1); PG8_STAGE(PG8_SB(0, 0), b2, voffB); PG8_STAGE(PG8_SB(0, 1), b2 + hstep, voffB); PG8_STAGE(PG8_SA(0, 0), a2, voffA);
            PG8_WAIT_V(8); PG8_WAIT_L(0); PG8_BAR; PG8_MMA(1, 0, At, B0); PG8_MMA(1, 1, At, B1); PG8_BAR; PG8_SCHED;
            PG8_LDB(B0, 1, 0); PG8_LDB(B1, 1, 1); PG8_SCHED; PG8_LDA(At, 1, 0); PG8_STAGE(PG8_SA(0, 1), a2 + hstep, voffA);
            PG8_WAIT_V(8); PG8_WAIT_L(0); PG8_BAR; PG8_MMA(0, 0, At, B0); PG8_MMA(0, 1, At, B1); PG8_BAR; PG8_SCHED;
            PG8_LDA(At, 1, 1); PG8_STAGE(PG8_SB(1, 0), b3, voffB); PG8_STAGE(PG8_SB(1, 1), b3 + hstep, voffB); PG8_STAGE(PG8_SA(1, 0), a3, voffA);
            PG8_WAIT_V(8); PG8_WAIT_L(0); PG8_BAR; PG8_MMA(1, 0, At, B0); PG8_MMA(1, 1, At, B1); PG8_BAR; PG8_SCHED;
            } else {
            PG8_LDB(B0, 0, 0); PG8_SCHED; PG8_LDA(At, 0, 0); PG8_STAGE(PG8_SA(1, 1), a1 + hstep, voffA);
            PG8_WAIT_L(8); PG8_BAR; PG8_WAIT_L(0); PG8_MMA(0, 0, At, B0); PG8_BAR; PG8_SCHED;
            PG8_LDB(B1, 0, 1); PG8_STAGE(PG8_SB(0, 0), b2, voffB);
            PG8_BAR; PG8_WAIT_L(0); PG8_MMA(0, 1, At, B1); PG8_BAR;
            PG8_LDA(At, 0, 1); PG8_STAGE(PG8_SA(0, 0), a2, voffA);
            PG8_BAR; PG8_WAIT_L(0); PG8_MMA(1, 0, At, B0); PG8_BAR; PG8_SCHED;
            PG8_STAGE(PG8_SB(0, 1), b2 + hstep, voffB);
            PG8_WAIT_V(6); PG8_BAR; PG8_MMA(1, 1, At, B1); PG8_BAR;
            PG8_LDB(B0, 1, 0); PG8_SCHED; PG8_LDA(At, 1, 0); PG8_STAGE(PG8_SA(0, 1), a2 + hstep, voffA);
            PG8_WAIT_L(8); PG8_BAR; PG8_WAIT_L(0); PG8_MMA(0, 0, At, B0); PG8_BAR; PG8_SCHED;
            PG8_LDB(B1, 1, 1); PG8_STAGE(PG8_SB(1, 0), b3, voffB);
            PG8_BAR; PG8_WAIT_L(0); PG8_MMA(0, 1, At, B1); PG8_BAR;
            PG8_LDA(At, 1, 1); PG8_STAGE(PG8_SA(1, 0), a3, voffA);
            PG8_BAR; PG8_WAIT_L(0); PG8_MMA(1, 0, At, B0); PG8_BAR; PG8_SCHED;
            PG8_STAGE(PG8_SB(1, 1), b3 + hstep, voffB);
            PG8_WAIT_V(6); PG8_BAR; PG8_MMA(1, 1, At, B1); PG8_BAR;
            }
        }
        if constexpr (ALIGN_EPI) { if (wr == 0) PG8_BAR; }
        if constexpr (!Epi::AFTER_DRAIN) { E(acc, cur, wr, wc, fr, fq); S.done(cur); }
        if (!has_next) break;
#pragma unroll
        for (int a = 0; a < 2; ++a)
#pragma unroll
            for (int b = 0; b < 2; ++b)
#pragma unroll
                for (int m = 0; m < 4; ++m)
#pragma unroll
                    for (int n = 0; n < 2; ++n) acc[a][b][m][n] = (f32x4){0.f, 0.f, 0.f, 0.f};
        cur = nxt; cA = nA; cB = nB; ++ui;
        if constexpr (ALIGN_EPI) { if (wr == 1) PG8_BAR; }
    }
    PG8_WAIT_V(0);
    if constexpr (!ALIGN_EPI) { if (wr == 0) PG8_BAR; }
    PG8_BAR;
    if constexpr (Epi::AFTER_DRAIN) { E.fused(acc, cur, wr, wc, fr, fq, lds, wid, lane); S.done(cur); }
#undef PG8_SA
#undef PG8_SB
#undef PG8_STAGE
#undef PG8_LDA
#undef PG8_LDB
#undef PG8_MMA
#undef PG8_WAIT_V
#undef PG8_WAIT_L
#undef PG8_BAR
#undef PG8_SCHED
}
}

constexpr int NWAVES = 8, NTHR = NWAVES * 64;
constexpr int DM = 2048, FF = 5504, FF2 = 2 * FF, NLAT = 8192, NCTX = 512, MT = NLAT + NCTX, TSEQ = 4096, TCTX = 256;
constexpr int PROJ = 14976, PROJP = 15104;
constexpr int P_U = 0, P_V = 1024, P_RKV = 2048, P_G = 5120, P_W = 5376, P_A = 5568, P_QKV = 5760, P_GATE = 8832;
constexpr int ACTW = 768, LOW = 5120;
constexpr int NLAYER = 2, NMOD = 9;

constexpr size_t MiB = 1u << 20;
constexpr size_t al(size_t x) { return (x + MiB - 1) / MiB * MiB; }
constexpr size_t WS_CTL = 0, CTL_ZERO_BYTES = 1 * MiB;
constexpr size_t WS_MODS = 1 * MiB;
constexpr size_t WS_ROPE = WS_MODS + al((size_t)NLAYER * 3 * NMOD * DM * 4);
constexpr size_t WS_WF1 = WS_ROPE + MiB;
constexpr size_t SZ_WF1 = (size_t)FF2 * DM * 2;
constexpr size_t WS_WF2 = WS_WF1 + al(4 * SZ_WF1);
constexpr size_t SZ_WF2 = (size_t)DM * FF * 2;
constexpr size_t WS_WIN = WS_WF2 + al(4 * SZ_WF2);
constexpr size_t SZ_WIN = (size_t)PROJP * DM * 2;
constexpr size_t WS_WLO = WS_WIN + al(2 * SZ_WIN);
constexpr size_t SZ_WLO = (size_t)LOW * ACTW * 2;
constexpr size_t WS_WBR = WS_WLO + al(2 * SZ_WLO);
constexpr size_t SZ_WBR = (size_t)3 * DM * 1024 * 2;
constexpr size_t WS_WOUT = WS_WBR + al(2 * SZ_WBR);
constexpr size_t SZ_WOUT = (size_t)DM * DM * 2;
constexpr size_t WS_XS = WS_WOUT + al(2 * SZ_WOUT);
constexpr size_t WS_XN = WS_XS + al((size_t)MT * DM * 4);
constexpr size_t WS_P = WS_XN + al((size_t)MT * DM * 2);
constexpr size_t WS_R1 = WS_P + al((size_t)MT * PROJP * 2);
constexpr size_t WS_ACT = WS_R1 + al((size_t)MT * LOW * 4);
constexpr size_t WS_RKVK = WS_ACT + al((size_t)MT * ACTW * 2);
constexpr size_t WS_QK = WS_RKVK + al((size_t)MT * 4096 * 2);
constexpr size_t WS_YS = WS_QK + al((size_t)MT * DM * 2);
constexpr size_t WS_Y3 = WS_YS + al((size_t)2 * MT * 1024 * 4);
constexpr size_t WS_END = WS_Y3 + al((size_t)3 * MT * 1024 * 2);

constexpr int CW_TMO = 0, CW_CODE = 1, CW_BAR = 4096;

constexpr int RING_BYTES = 131072, LDSCTL_OFF = RING_BYTES, MISC_OFF = LDSCTL_OFF + 320, LDS_BYTES = 147456;

#define GAS __attribute__((address_space(1)))
#define LAS __attribute__((address_space(3)))
typedef unsigned short bf16;
typedef unsigned v4u __attribute__((ext_vector_type(4)));
typedef unsigned v2u __attribute__((ext_vector_type(2)));
typedef float f32x4 __attribute__((ext_vector_type(4)));
typedef short bf16x8 __attribute__((ext_vector_type(8)));
typedef GAS unsigned gu32;
#define RLX_AGENT __ATOMIC_RELAXED, __HIP_MEMORY_SCOPE_AGENT
__device__ __forceinline__ unsigned f2bf(float f) { unsigned u = __builtin_bit_cast(unsigned, f); return (u + 0x7fffu + ((u >> 16) & 1u)) >> 16; }
__device__ __forceinline__ unsigned pk2(float lo, float hi) { return f2bf(lo) | (f2bf(hi) << 16); }
__device__ __forceinline__ float bflo(unsigned w) { return __builtin_bit_cast(float, w << 16); }
__device__ __forceinline__ float bfhi(unsigned w) { return __builtin_bit_cast(float, w & 0xffff0000u); }
__device__ __forceinline__ float bf1(bf16 h) { return __builtin_bit_cast(float, (unsigned)h << 16); }
__device__ __forceinline__ void unpack8(const v4u w, float (&f)[8]) { f[0] = bflo(w.x); f[1] = bfhi(w.x); f[2] = bflo(w.y); f[3] = bfhi(w.y); f[4] = bflo(w.z); f[5] = bfhi(w.z); f[6] = bflo(w.w); f[7] = bfhi(w.w); }
__device__ __forceinline__ v4u pack8(const float (&f)[8]) { v4u w; w.x = pk2(f[0], f[1]); w.y = pk2(f[2], f[3]); w.z = pk2(f[4], f[5]); w.w = pk2(f[6], f[7]); return w; }
__device__ __forceinline__ float fsigm(float x) { return __builtin_amdgcn_rcpf(1.f + __expf(-x)); }
__device__ __forceinline__ float ftanh(float x) { return 1.f - 2.f * __builtin_amdgcn_rcpf(__expf(2.f * x) + 1.f); }
__device__ __forceinline__ float gelu_t(float x) { return 0.5f * x * (1.f + ftanh(0.7978845608f * (x + 0.044715f * x * x * x))); }
__device__ __forceinline__ float wave_sum(float v) {
#pragma unroll
    for (int o = 1; o < 64; o <<= 1) v += __shfl_xor(v, o);
    return v;
}
#define XB_TMO      128
#define XB_XCNT(j)  (256  + 64 * (j))
#define XB_XSUB(j)  (1280 + 64 * (j))
#define XB_XGEN(j)  (2304 + 64 * (j))
#define XB_TOP      3328
#define XB_TOPGEN   3392
#define XCD_BAR_WORDS 3456
#define XB_SPIN_CAP (1u << 18)

__device__ __forceinline__ unsigned xb_ld(unsigned* p)              { return __hip_atomic_load(p, __ATOMIC_RELAXED, __HIP_MEMORY_SCOPE_AGENT); }
__device__ __forceinline__ unsigned xb_add(unsigned* p, unsigned v) { return __hip_atomic_fetch_add(p, v, __ATOMIC_RELAXED, __HIP_MEMORY_SCOPE_AGENT); }
__device__ __forceinline__ unsigned xb_xcc_id() { return (unsigned)__builtin_amdgcn_s_getreg((3 << 11) | 20) & 0xFu; }
#define XB_SPIN(cond, bar) do { unsigned _sp = 0; while (cond) { __builtin_amdgcn_s_sleep(1); \
    if ((++_sp & 255u) == 0u) { if (xb_ld(&(bar)[XB_TMO])) break; if (_sp > XB_SPIN_CAP) { atomicAdd(&(bar)[XB_TMO], 1u); break; } } } } while (0)

struct XcdBarrier {
    unsigned* bar; unsigned x;
    volatile LAS unsigned* st;
};

__device__ __forceinline__ XcdBarrier xcd_barrier_post(unsigned* bar, volatile LAS unsigned* st) {
    XcdBarrier b; b.bar = bar; b.x = xb_xcc_id(); b.st = st;
    if (threadIdx.x == 0) (void)xb_add(&bar[XB_XCNT(b.x)], 1u);
    return b;
}
__device__ __forceinline__ void xcd_barrier_complete(unsigned* bar, unsigned x, unsigned& nloc, unsigned& nx) {
    const unsigned G = gridDim.x * gridDim.y * gridDim.z;
    unsigned sum, cnt, mine, sp = 0u;
    for (;;) {
        sum = 0u; cnt = 0u; mine = 0u;
#pragma unroll
        for (unsigned j = 0; j < 16; ++j) { const unsigned c = xb_ld(&bar[XB_XCNT(j)]); sum += c; cnt += (c > 0u) ? 1u : 0u; mine = (j == x) ? c : mine; }
        if (sum == G) break;
        __builtin_amdgcn_s_sleep(1);
        if ((++sp & 255u) == 0u) { if (xb_ld(&bar[XB_TMO])) break; if (sp > XB_SPIN_CAP) { atomicAdd(&bar[XB_TMO], 1u); break; } }
    }
    nloc = mine > 0u ? mine : 1u; nx = cnt > 0u ? cnt : 1u;
}

__device__ __forceinline__ void xcd_barrier(const XcdBarrier& b) {
    asm volatile("s_waitcnt vmcnt(0)" ::: "memory");
    __syncthreads();
    if (threadIdx.x == 0) {
        unsigned* bar = b.bar;
        __builtin_amdgcn_s_waitcnt(0);
        unsigned nloc = b.st[0], nx = b.st[1];
        if (nloc == 0u) { xcd_barrier_complete(bar, b.x, nloc, nx); b.st[0] = nloc; b.st[1] = nx; }
        const unsigned old = xb_add(&bar[XB_XSUB(b.x)], 1u);
        const unsigned gen = old / nloc;
        if (old + 1u == (gen + 1u) * nloc) {
            __builtin_amdgcn_fence(__ATOMIC_RELEASE, "agent");
            asm volatile("s_waitcnt vmcnt(0)" ::: "memory");
            const unsigned og = xb_add(&bar[XB_TOP], 1u);
            const unsigned tg = og / nx;
            if (og + 1u == (tg + 1u) * nx) xb_add(&bar[XB_TOPGEN], 1u);
            else XB_SPIN(xb_ld(&bar[XB_TOPGEN]) == tg, bar);
            __builtin_amdgcn_fence(__ATOMIC_ACQUIRE, "agent");
            xb_add(&bar[XB_XGEN(b.x)], 1u);
            asm volatile("s_waitcnt vmcnt(0)" ::: "memory");
        } else {
            XB_SPIN(xb_ld(&bar[XB_XGEN(b.x)]) == gen, bar);
            __builtin_amdgcn_fence(__ATOMIC_ACQUIRE, "agent");
            asm volatile("s_waitcnt vmcnt(0)" ::: "memory");
        }
    }
    __syncthreads();
}

struct Args { const float* in[31]; float* out; unsigned char* ws; int ph_lo, ph_hi; };
enum In { I_X = 0, I_C, I_CTX, I_CCTX, I_WADA, I_BADA, I_NORMG, I_FFNIN, I_FFNOUT, I_WIN, I_GMVN, I_GMWS, I_GMBS, I_CONV, I_W0, I_WUP, I_A0, I_AUP, I_GUP, I_KK, I_KA, I_RK, I_LNG, I_LNB,
          I_QN, I_KN, I_LAM, I_SUBLN, I_WBR, I_BGATE, I_WOUT };

__device__ __forceinline__ void ph_ada(const Args& a, LAS unsigned char* lds, int tid, int vcu, int G) {
    LAS float* sc = (LAS float*)lds;
    LAS float* red = sc + 3 * 2048;
    const float* c = a.in[I_C]; const float* cc = a.in[I_CCTX];
    for (int i = tid; i < 3 * 2048; i += NTHR) { const float x = i < 4096 ? c[i] : cc[i - 4096]; sc[i] = x * fsigm(x); }
    __syncthreads();
    const int lane = tid & 63, wave = tid >> 6;
    float* mods = (float*)(a.ws + WS_MODS);
    for (int u = vcu; u < 576; u += G) {
        const int l = u / 288, jc = u % 288, j = jc * 64 + lane;
        const float* W = a.in[I_WADA] + (size_t)l * 2048 * 18432 + j;
        float s0 = 0.f, s1 = 0.f, s2 = 0.f;
        const int k0 = wave * 256;
#pragma unroll 8
        for (int k = 0; k < 256; ++k) { const float w = W[(size_t)(k0 + k) * 18432]; s0 += sc[k0 + k] * w; s1 += sc[2048 + k0 + k] * w; s2 += sc[4096 + k0 + k] * w; }
        red[(wave * 3 + 0) * 64 + lane] = s0; red[(wave * 3 + 1) * 64 + lane] = s1; red[(wave * 3 + 2) * 64 + lane] = s2;
        __syncthreads();
        if (wave < 3) { float s = a.in[I_BADA][(size_t)l * 18432 + j];
#pragma unroll
            for (int w8 = 0; w8 < 8; ++w8) s += red[(w8 * 3 + wave) * 64 + lane];
            mods[(size_t)(l * 3 + wave) * 18432 + j] = s; }
        __syncthreads();
    }
}
__device__ __forceinline__ void transpose_item(const float* W, int N, int sc0, bf16* WT, int Kd, int nd0, int k0, LAS float* scr, int lane) {
    if (sc0 >= 0) {
#pragma unroll 8
        for (int i = 0; i < 32; ++i) { const int kk = 2 * i + (lane >> 5); scr[kk * 33 + (lane & 31)] = W[(size_t)(k0 + kk) * N + sc0 + (lane & 31)]; }
    } else {
#pragma unroll 8
        for (int i = 0; i < 32; ++i) { const int kk = 2 * i + (lane >> 5); scr[kk * 33 + (lane & 31)] = 0.f; }
    }
    asm volatile("s_waitcnt lgkmcnt(0)" ::: "memory");
    const int c = lane & 7;
#pragma unroll
    for (int j = 0; j < 4; ++j) { const int n = (lane >> 3) + 8 * j; const LAS float* s = scr + (8 * c) * 33 + n;
        v4u o; o.x = pk2(s[0 * 33], s[1 * 33]); o.y = pk2(s[2 * 33], s[3 * 33]); o.z = pk2(s[4 * 33], s[5 * 33]); o.w = pk2(s[6 * 33], s[7 * 33]);
        *(GAS v4u*)(WT + (size_t)(nd0 + n) * Kd + k0 + 8 * c) = o; }
    asm volatile("s_waitcnt lgkmcnt(0)" ::: "memory");
}
__device__ __forceinline__ void ph_weights(const Args& a, LAS unsigned char* lds, int tid, int vcu, int G) {
    const int lane = tid & 63, wave = tid >> 6;
    LAS float* scr = (LAS float*)(lds + wave * 16384);
    const int gw = vcu * NWAVES + wave, NGW = G * NWAVES;
    constexpr int I_F1 = 32 * (FF2 / 32), I_F2 = (FF / 64) * (DM / 32), I_IN = 32 * (PROJP / 32), I_BR = 16 * (DM / 32), I_WO = 32 * (DM / 32);
    constexpr int NITEMS = 4 * I_F1 + 4 * I_F2 + 2 * I_IN + 6 * I_BR + 2 * I_WO;
    unsigned char* ws = a.ws;
    for (int it = gw; it < NITEMS; it += NGW) {
        int r = it;
        if (r < 4 * I_F1) { const int mi = r / I_F1, q = r % I_F1, nb = q % (FF2 / 32), kb = q / (FF2 / 32), nd0 = 32 * nb, pn = nd0 >> 8, rr = nd0 & 255;
            const int sc0 = rr < 128 ? pn * 128 + rr : FF + pn * 128 + (rr - 128);
            transpose_item(a.in[I_FFNIN] + (size_t)mi * DM * FF2, FF2, sc0, (bf16*)(ws + WS_WF1 + (size_t)mi * SZ_WF1), DM, nd0, 64 * kb, scr, lane); continue; }
        r -= 4 * I_F1;
        if (r < 4 * I_F2) { const int mi = r / I_F2, q = r % I_F2, nb = q % (DM / 32), kb = q / (DM / 32);
            transpose_item(a.in[I_FFNOUT] + (size_t)mi * FF * DM, DM, 32 * nb, (bf16*)(ws + WS_WF2 + (size_t)mi * SZ_WF2), FF, 32 * nb, 64 * kb, scr, lane); continue; }
        r -= 4 * I_F2;
        if (r < 2 * I_IN) { const int mi = r / I_IN, q = r % I_IN, nb = q % (PROJP / 32), kb = q / (PROJP / 32), nd0 = 32 * nb;
            transpose_item(a.in[I_WIN] + (size_t)mi * DM * PROJ, PROJ, nd0 < PROJ ? nd0 : -1, (bf16*)(ws + WS_WIN + (size_t)mi * SZ_WIN), DM, nd0, 64 * kb, scr, lane); continue; }
        r -= 2 * I_IN;
        if (r < 6 * I_BR) { const int mi = r / I_BR, q = r % I_BR, nb = q % (DM / 32), kb = q / (DM / 32);
            transpose_item(a.in[I_WBR] + (size_t)mi * 1024 * DM, DM, 32 * nb, (bf16*)(ws + WS_WBR + (size_t)mi * ((size_t)DM * 1024 * 2)), 1024, 32 * nb, 64 * kb, scr, lane); continue; }
        r -= 6 * I_BR;
        { const int mi = r / I_WO, q = r % I_WO, nb = q % (DM / 32), kb = q / (DM / 32);
            transpose_item(a.in[I_WOUT] + (size_t)mi * DM * DM, DM, 32 * nb, (bf16*)(ws + WS_WOUT + (size_t)mi * SZ_WOUT), DM, 32 * nb, 64 * kb, scr, lane); }
    }
    const int gt = vcu * NTHR + tid, NGT = G * NTHR;
    for (int i = gt; i < NLAYER * LOW * (ACTW / 8); i += NGT) {
        const int l = i / (LOW * (ACTW / 8)), q = i % (LOW * (ACTW / 8)), n = q / (ACTW / 8), k0 = (q % (ACTW / 8)) * 8, sec = n >> 10, cc = n & 1023;
        float f[8];
#pragma unroll
        for (int e = 0; e < 8; ++e) { const int k = k0 + e; float v = 0.f;
            if (sec == 0) { if (k < 256) v = a.in[I_GUP][((size_t)l * 256 + k) * 1024 + cc]; }
            else if (sec <= 2) { const int d = sec - 1, kb = 256 + 128 * d; if (k >= kb && k < kb + 96) v = a.in[I_WUP][((size_t)(l * 2 + d) * 96 + (k - kb)) * 1024 + cc]; }
            else { const int d = sec - 3, kb = 512 + 128 * d; if (k >= kb && k < kb + 96) v = a.in[I_AUP][((size_t)(l * 2 + d) * 96 + (k - kb)) * 1024 + cc]; }
            f[e] = v; }
        *(GAS v4u*)((bf16*)(ws + WS_WLO) + ((size_t)l * LOW + n) * ACTW + k0) = pack8(f);
    }
    for (int i = gt; i < 64 * 16; i += NGT) { const int p = i >> 4, ii = i & 15;
        const float inv = exp2f(-(float)(2 * ii) * (1.f / 32.f) * 13.287712379549449f);
        const float rev = (float)p * inv * 0.15915494309189535f;
        float* rt = (float*)(ws + WS_ROPE) + 2 * i; rt[0] = __builtin_amdgcn_cosf(rev); rt[1] = __builtin_amdgcn_sinf(rev); }
}

__device__ __forceinline__ void ph_norm(const float* xl, const float* xc, const float* gain, const float* mods  , int si, bf16* XN, int gw, int NGW, int lane) {
    for (int m = gw; m < MT; m += NGW) {
        const float* xr = m < NLAT ? xl + (size_t)m * DM : xc + (size_t)(m - NLAT) * DM;
        const int set = m < TSEQ ? 0 : (m < NLAT ? 1 : 2);
        const float* sh = mods + (size_t)(set * NMOD + si) * DM; const float* scl = sh + DM;
        f32x4 v[8]; float ss = 0.f;
#pragma unroll
        for (int j = 0; j < 8; ++j) { v[j] = *(const GAS f32x4*)(xr + 4 * lane + 256 * j); ss += (v[j].x * v[j].x + v[j].y * v[j].y) + (v[j].z * v[j].z + v[j].w * v[j].w); }
        const float rinv = 1.f / sqrtf(wave_sum(ss) * (1.f / DM) + 1e-6f);
#pragma unroll
        for (int j = 0; j < 8; ++j) { const int col = 4 * lane + 256 * j;
            const f32x4 g = *(const GAS f32x4*)(gain + col), s1 = *(const GAS f32x4*)(scl + col), s0 = *(const GAS f32x4*)(sh + col);
            const f32x4 o = (v[j] * rinv * g) * (s1 + 1.f) + s0;
            v2u w; w.x = pk2(o.x, o.y); w.y = pk2(o.z, o.w);
            *(GAS v2u*)(XN + (size_t)m * DM + col) = w; }
    }
}

__device__ __forceinline__ void ph_e1(const Args& a, int l, int gt, int NGT) {
    unsigned char* ws = a.ws;
    const bf16* P = (const bf16*)(ws + WS_P);
    bf16* ACT = (bf16*)(ws + WS_ACT);
    for (int i = gt; i < MT * (ACTW / 8); i += NGT) {
        const int m = i / (ACTW / 8), c0 = (i % (ACTW / 8)) * 8;
        int src = -1, fn = 0;
        if (c0 < 256) { src = P_G + c0; fn = 1; }
        else if (c0 < 352) { src = P_W + (c0 - 256); fn = 2; }
        else if (c0 >= 384 && c0 < 480) { src = P_W + 96 + (c0 - 384); fn = 2; }
        else if (c0 >= 512 && c0 < 608) { src = P_A + (c0 - 512); }
        else if (c0 >= 640 && c0 < 736) { src = P_A + 96 + (c0 - 640); }
        float f[8];
        if (src >= 0) { unpack8(*(const GAS v4u*)(P + (size_t)m * PROJP + src), f);
#pragma unroll
            for (int e = 0; e < 8; ++e) f[e] = fn == 1 ? fsigm(f[e]) : (fn == 2 ? ftanh(f[e]) : f[e]); }
        else {
#pragma unroll
            for (int e = 0; e < 8; ++e) f[e] = 0.f; }
        *(GAS v4u*)(ACT + (size_t)m * ACTW + c0) = pack8(f);
    }
    bf16* QK = (bf16*)(ws + WS_QK);
    const float* rope = (const float*)(ws + WS_ROPE);
    for (int i = gt; i < MT * 32; i += NGT) {
        const int m = i >> 5, gi = i & 31; const bool isq = gi < 16;
        const float* gain = a.in[isq ? I_QN : I_KN] + l * 64;
        const bf16* src = P + (size_t)m * PROJP + P_QKV + gi * 64;
        float y[64]; float ss = 0.f;
#pragma unroll
        for (int j = 0; j < 8; ++j) { float f[8]; unpack8(*(const GAS v4u*)(src + 8 * j), f);
#pragma unroll
            for (int e = 0; e < 8; ++e) { y[8 * j + e] = f[e]; ss += f[e] * f[e]; } }
        const float rinv = 1.f / sqrtf(ss * (1.f / 64.f) + 1e-6f);
#pragma unroll
        for (int d = 0; d < 64; ++d) y[d] = y[d] * rinv * gain[d];
        if (m < NLAT) { const int t = m & (TSEQ - 1), pr = t >> 6, pc = t & 63;
#pragma unroll
            for (int ii = 0; ii < 16; ++ii) {
                const float c1 = rope[(pr * 16 + ii) * 2], s1 = rope[(pr * 16 + ii) * 2 + 1], c2 = rope[(pc * 16 + ii) * 2], s2 = rope[(pc * 16 + ii) * 2 + 1];
                const float a1 = y[ii], a2 = y[16 + ii], b1 = y[32 + ii], b2 = y[48 + ii];
                y[ii] = a1 * c1 - a2 * s1; y[16 + ii] = a2 * c1 + a1 * s1; y[32 + ii] = b1 * c2 - b2 * s2; y[48 + ii] = b2 * c2 + b1 * s2; } }
        const float qs = isq ? 0.18033688011112042f : 1.f;
        bf16* dst = QK + (size_t)m * DM + gi * 64;
#pragma unroll
        for (int j = 0; j < 8; ++j) { float f[8];
#pragma unroll
            for (int e = 0; e < 8; ++e) f[e] = y[8 * j + e] * qs;
            *(GAS v4u*)(dst + 8 * j) = pack8(f); }
    }
    bf16* RK = (bf16*)(ws + WS_RKVK);
    const float* cw = a.in[I_CONV] + (size_t)l * 3 * 3072; const float* kkw = a.in[I_KK] + l * 1024;
    for (int i = gt; i < MT * 128; i += NGT) {
        const int m = i >> 7, c0 = (i & 127) * 8;
        const int t = m < NLAT ? (m & (TSEQ - 1)) : ((m - NLAT) & (TCTX - 1)), tl = m < NLAT ? TSEQ : TCTX;
        const bool hp = t > 0, hn = t < tl - 1;
        float kv[8];
#pragma unroll
        for (int sec = 0; sec < 3; ++sec) {
            const int col = sec * 1024 + c0; const bf16* pc = P + (size_t)m * PROJP + P_RKV + col;
            float x0[8], x1[8], x2[8], o[8];
            unpack8(*(const GAS v4u*)pc, x1);
            if (hp) unpack8(*(const GAS v4u*)(pc - PROJP), x0);
            if (hn) unpack8(*(const GAS v4u*)(pc + PROJP), x2);
#pragma unroll
            for (int e = 0; e < 8; ++e) { float v = x1[e] * cw[3072 + col + e]; if (hp) v += x0[e] * cw[col + e]; if (hn) v += x2[e] * cw[2 * 3072 + col + e]; o[e] = v; if (sec == 1) kv[e] = v; }
            *(GAS v4u*)(RK + (size_t)m * 4096 + col) = pack8(o);
        }
        float ss = 0.f;
#pragma unroll
        for (int e = 0; e < 8; ++e) { kv[e] *= kkw[c0 + e]; ss += kv[e] * kv[e]; }
        ss += __shfl_xor(ss, 1); ss += __shfl_xor(ss, 2); ss += __shfl_xor(ss, 4);
        const float rinv = 1.f / sqrtf(ss + 1e-12f);
#pragma unroll
        for (int e = 0; e < 8; ++e) kv[e] *= rinv;
        *(GAS v4u*)(RK + (size_t)m * 4096 + 3072 + c0) = pack8(kv);
    }
}

__device__ __forceinline__ void ph_gmlp(const Args& a, int l, LAS unsigned char* lds, int tid, int vcu, int G) {
    constexpr int VP = 136;
    LAS bf16* vnT = (LAS bf16*)lds;
    const bf16* P = (const bf16*)(a.ws + WS_P); bf16* YA = (bf16*)(a.ws + WS_Y3);
    const float* vng = a.in[I_GMVN] + l * 1024; const float* wsm = a.in[I_GMWS] + (size_t)l * 8 * 128 * 128; const float* bs = a.in[I_GMBS] + l * 8 * 128;
    const int lane = tid & 63, w = tid >> 6, fr = lane & 15, fq = lane >> 4;
    for (int u = vcu; u < (MT / 128) * 8; u += G) {
        const int n = u >> 3, g = u & 7, m0 = n * 128;
        { const int q = tid >> 2, qt = tid & 3; const bf16* src = P + (size_t)(m0 + q) * PROJP + P_V + g * 128 + qt * 32;
            float v[32]; float ss = 0.f;
#pragma unroll
            for (int j = 0; j < 4; ++j) { float f[8]; unpack8(*(const GAS v4u*)(src + 8 * j), f);
#pragma unroll
                for (int e = 0; e < 8; ++e) { const float x = gelu_t(f[e]); v[8 * j + e] = x; ss += x * x; } }
            ss += __shfl_xor(ss, 1); ss += __shfl_xor(ss, 2);
            const float rinv = 1.f / sqrtf(ss * (1.f / 128.f) + 1e-6f);
#pragma unroll
            for (int e = 0; e < 32; ++e) { const int c = qt * 32 + e; vnT[c * VP + q] = (bf16)f2bf(v[e] * rinv * vng[g * 128 + c]); } }
        __syncthreads();
        pg8::f32x4 acc[8];
#pragma unroll
        for (int cb = 0; cb < 8; ++cb) acc[cb] = (pg8::f32x4){0.f, 0.f, 0.f, 0.f};
#pragma unroll
        for (int ks = 0; ks < 4; ++ks) {
            const float* wr = wsm + ((size_t)g * 128 + 16 * w + fr) * 128 + ks * 32 + 8 * fq;
            const f32x4 w0 = *(const GAS f32x4*)wr, w1 = *(const GAS f32x4*)(wr + 4);
            v4u aw; aw.x = pk2(w0.x, w0.y); aw.y = pk2(w0.z, w0.w); aw.z = pk2(w1.x, w1.y); aw.w = pk2(w1.z, w1.w);
            const bf16x8 af = __builtin_bit_cast(bf16x8, aw);
#pragma unroll
            for (int cb = 0; cb < 8; ++cb) { const bf16x8 bfr = *(const LAS bf16x8*)(vnT + (cb * 16 + fr) * VP + ks * 32 + 8 * fq);
                acc[cb] = __builtin_amdgcn_mfma_f32_16x16x32_bf16(af, bfr, acc[cb], 0, 0, 0); }
        }
#pragma unroll
        for (int cb = 0; cb < 8; ++cb)
#pragma unroll
            for (int i = 0; i < 4; ++i) { const int p = 16 * w + 4 * fq + i, c = cb * 16 + fr;
                const float pu = bf1(P[(size_t)(m0 + p) * PROJP + P_U + g * 128 + c]);
                YA[(size_t)(m0 + p) * 1024 + g * 128 + c] = (bf16)f2bf(gelu_t(pu) * (acc[cb][i] + bs[g * 128 + p])); }
        __syncthreads();
    }
}

__device__ __forceinline__ void ph_attn(const Args& a, int l, bool ctx_out, LAS unsigned char* lds, int tid, int vcu, int G) {
    constexpr int KP = 72, VTP = 40;
    LAS bf16* Ks = (LAS bf16*)lds; LAS bf16* VT = (LAS bf16*)(lds + 32 * KP * 2);
    const bf16* QK = (const bf16*)(a.ws + WS_QK); const bf16* P = (const bf16*)(a.ws + WS_P); bf16* YC = (bf16*)(a.ws + WS_Y3) + (size_t)2 * MT * 1024;
    const int lane = tid & 63, w = tid >> 6, fr = lane & 15, fq = lane >> 4;
    const float* lv = a.in[I_LAM] + l * 256;
    float l1 = lv[lane] * lv[64 + lane], l2 = lv[128 + lane] * lv[192 + lane];
    l1 = wave_sum(l1); l2 = wave_sum(l2);
    const float lam_init = 0.8f - 0.6f * __expf(-0.3f * (float)l);
    const float lam = __expf(l1) - __expf(l2) + lam_init;
    const float* subln = a.in[I_SUBLN] + l * 128;
    const int nunits = ctx_out ? 544 : 512;
    for (int u = vcu; u < nunits; u += G) {
        int b, h, qrow0, kt0, kt1;
        if (u < 512) { b = u >> 8; h = (u >> 5) & 7; qrow0 = b * TSEQ + (u & 31) * 128; kt0 = 0; kt1 = 136; }
        else { const int uu = u - 512; b = uu >> 4; h = (uu >> 1) & 7; qrow0 = NLAT + b * TCTX + (uu & 1) * 128; kt0 = 128; kt1 = 136; }
        pg8::f32x4 O0[8];
#pragma unroll
        for (int j = 0; j < 2; ++j) {
            bf16x8 qf[2];
#pragma unroll
            for (int ds = 0; ds < 2; ++ds) qf[ds] = *(const GAS bf16x8*)(QK + (size_t)(qrow0 + 16 * w + fr) * DM + (h * 2 + j) * 64 + ds * 32 + 8 * fq);
            float m_run = -1e30f, l_part = 0.f;
            pg8::f32x4 O[8];
#pragma unroll
            for (int eb = 0; eb < 8; ++eb) O[eb] = (pg8::f32x4){0.f, 0.f, 0.f, 0.f};
            for (int kt = kt0; kt < kt1; ++kt) {
                const int krow0 = kt < 128 ? b * TSEQ + kt * 32 : NLAT + b * TCTX + (kt - 128) * 32;
                __syncthreads();
                if (tid < 256) { const int key = tid >> 3, ch = tid & 7;
                    *(LAS v4u*)(Ks + key * KP + ch * 8) = *(const GAS v4u*)(QK + (size_t)(krow0 + key) * DM + 1024 + (h * 2 + j) * 64 + ch * 8); }
                { const int key = tid >> 4, ch = tid & 15;
                    const v4u vv = *(const GAS v4u*)(P + (size_t)(krow0 + key) * PROJP + P_QKV + 2048 + h * 128 + ch * 8);
                    LAS bf16* d = VT + (ch * 8) * VTP + key;
                    d[0 * VTP] = (bf16)(vv.x & 0xffffu); d[1 * VTP] = (bf16)(vv.x >> 16); d[2 * VTP] = (bf16)(vv.y & 0xffffu); d[3 * VTP] = (bf16)(vv.y >> 16);
                    d[4 * VTP] = (bf16)(vv.z & 0xffffu); d[5 * VTP] = (bf16)(vv.z >> 16); d[6 * VTP] = (bf16)(vv.w & 0xffffu); d[7 * VTP] = (bf16)(vv.w >> 16); }
                __syncthreads();
                pg8::f32x4 s[2];
#pragma unroll
                for (int kb = 0; kb < 2; ++kb) { s[kb] = (pg8::f32x4){0.f, 0.f, 0.f, 0.f};
#pragma unroll
                    for (int ds = 0; ds < 2; ++ds) { const bf16x8 kf = *(const LAS bf16x8*)(Ks + (kb * 16 + fr) * KP + ds * 32 + 8 * fq);
                        s[kb] = __builtin_amdgcn_mfma_f32_16x16x32_bf16(kf, qf[ds], s[kb], 0, 0, 0); } }
                float mx = fmaxf(fmaxf(fmaxf(s[0][0], s[0][1]), fmaxf(s[0][2], s[0][3])), fmaxf(fmaxf(s[1][0], s[1][1]), fmaxf(s[1][2], s[1][3])));
                mx = fmaxf(mx, __shfl_xor(mx, 16)); mx = fmaxf(mx, __shfl_xor(mx, 32));
                const float m_new = fmaxf(m_run, mx), alpha = exp2f(m_run - m_new); m_run = m_new;
                float p[8]; float ps = 0.f;
#pragma unroll
                for (int i = 0; i < 4; ++i) { p[i] = exp2f(s[0][i] - m_new); p[4 + i] = exp2f(s[1][i] - m_new); ps += p[i] + p[4 + i]; }
                l_part = l_part * alpha + ps;
                v4u pw; pw.x = pk2(p[0], p[1]); pw.y = pk2(p[2], p[3]); pw.z = pk2(p[4], p[5]); pw.w = pk2(p[6], p[7]);
                const bf16x8 pb = __builtin_bit_cast(bf16x8, pw);
#pragma unroll
                for (int eb = 0; eb < 8; ++eb) {
                    O[eb] = O[eb] * alpha;
                    const LAS bf16* vp = VT + (eb * 16 + fr) * VTP + 4 * fq;
                    const v2u va = *(const LAS v2u*)vp, vb = *(const LAS v2u*)(vp + 16);
                    v4u vw; vw.x = va.x; vw.y = va.y; vw.z = vb.x; vw.w = vb.y;
                    O[eb] = __builtin_amdgcn_mfma_f32_16x16x32_bf16(__builtin_bit_cast(bf16x8, vw), pb, O[eb], 0, 0, 0);
                }
            }
            float lsum = l_part; lsum += __shfl_xor(lsum, 16); lsum += __shfl_xor(lsum, 32);
            const float rl = 1.f / lsum;
            if (j == 0) {
#pragma unroll
                for (int eb = 0; eb < 8; ++eb) O0[eb] = O[eb] * rl;
            } else {
#pragma unroll
                for (int eb = 0; eb < 8; ++eb) O0[eb] = O0[eb] - O[eb] * (lam * rl);
            }
        }
        float ss = 0.f;
#pragma unroll
        for (int eb = 0; eb < 8; ++eb) ss += (O0[eb][0] * O0[eb][0] + O0[eb][1] * O0[eb][1]) + (O0[eb][2] * O0[eb][2] + O0[eb][3] * O0[eb][3]);
        ss += __shfl_xor(ss, 16); ss += __shfl_xor(ss, 32);
        const float rinv = (1.f - lam_init) / sqrtf(ss * (1.f / 128.f) + 1e-6f);
        bf16* dst = YC + (size_t)(qrow0 + 16 * w + fr) * 1024 + h * 128 + 4 * fq;
#pragma unroll
        for (int eb = 0; eb < 8; ++eb) { const f32x4 g = *(const GAS f32x4*)(subln + eb * 16 + 4 * fq);
            v2u o; o.x = pk2(O0[eb][0] * rinv * g.x, O0[eb][1] * rinv * g.y); o.y = pk2(O0[eb][2] * rinv * g.z, O0[eb][3] * rinv * g.w);
            *(GAS v2u*)(dst + eb * 16) = o; }
    }
}

constexpr int SC_STEP = 1280, SC_BLK = 32, SC_BUF = SC_BLK * SC_STEP, SC_Y = 2 * SC_BUF, SC_LDS = SC_Y + 2 * SC_BLK * 64 * 4;
__device__ __forceinline__ int scan_row(int i, int b, int d) { return i < TCTX ? NLAT + b * TCTX + (d ? TCTX - 1 - i : i) : b * TSEQ + (d ? TSEQ - 1 - (i - TCTX) : (i - TCTX)); }
#define SC_UPD(N) "v_mul_f32_dpp %" #N ", %16, %" #N " row_newbcast:" #N " row_mask:0xf bank_mask:0xf\n\tv_fmac_f32_dpp %" #N ", %17, %19 row_newbcast:" #N " row_mask:0xf bank_mask:0xf\n\tv_fmac_f32_dpp %" #N ", %18, %20 row_newbcast:" #N " row_mask:0xf bank_mask:0xf\n\t"
__device__ __forceinline__ void scan_fill(const float* LO, const bf16* RK, const float* ka, LAS unsigned char* buf, int blk, int b, int h, int d, int hw, int lane) {
    const int ch = h * 64 + lane; const float kav = ka[ch];
    constexpr int NQ = SC_BLK / 4;
    float wv[NQ], av[NQ]; bf16 rb[NQ], kb[NQ], vb[NQ], kkb[NQ], kkn[NQ];
#pragma unroll
    for (int q = 0; q < NQ; ++q) {
        const int st = hw + 4 * q, i = blk * SC_BLK + st, m = scan_row(i, b, d), mn = (i + 1 < TCTX + TSEQ) ? scan_row(i + 1, b, d) : m;
        const GAS float* lo = (const GAS float*)(LO + (size_t)m * LOW + d * 1024 + ch); const GAS bf16* rk = (const GAS bf16*)(RK + (size_t)m * 4096 + ch);
        wv[q] = lo[1024]; av[q] = lo[3072]; rb[q] = rk[0]; kb[q] = rk[1024]; vb[q] = rk[2048]; kkb[q] = rk[3072]; kkn[q] = *(const GAS bf16*)(RK + (size_t)mn * 4096 + 3072 + ch);
    }
    asm volatile("" ::: "memory");
#pragma unroll
    for (int q = 0; q < NQ; ++q) {
        LAS unsigned char* o = buf + (hw + 4 * q) * SC_STEP;
        ((LAS float*)o)[lane] = wv[q]; ((LAS float*)(o + 256))[lane] = bf1(kb[q]) * (1.f + (av[q] - 1.f) * kav); ((LAS float*)(o + 512))[lane] = bf1(kkb[q]) * av[q]; ((LAS float*)(o + 768))[lane] = bf1(vb[q]);
        ((LAS bf16*)(o + 1024))[lane] = kkn[q]; ((LAS bf16*)(o + 1152))[lane] = rb[q];
    }
}
__device__ __forceinline__ void scan_unit(const Args& a, int l, int u, LAS unsigned char* lds, int tid) {
    const float* LO = (const float*)(a.ws + WS_R1); const bf16* RK = (const bf16*)(a.ws + WS_RKVK); float* YS = (float*)(a.ws + WS_YS);
    const float* ka = a.in[I_KA] + l * 1024;
    const int lane = tid & 63, w = __builtin_amdgcn_readfirstlane(tid >> 6), fr = lane & 15, fq = lane >> 4;
    const int b = u >> 5, h = (u >> 1) & 15, d = u & 1;
    constexpr int NBLK = (TCTX + TSEQ) / SC_BLK;
    float s0 = 0.f, s1 = 0.f, s2 = 0.f, s3 = 0.f, s4 = 0.f, s5 = 0.f, s6 = 0.f, s7 = 0.f, s8 = 0.f, s9 = 0.f, s10 = 0.f, s11 = 0.f, s12 = 0.f, s13 = 0.f, s14 = 0.f, s15 = 0.f, sa = 0.f;
    if (w >= 4) scan_fill(LO, RK, ka, lds, 0, b, h, d, w - 4, lane);
    __syncthreads();
    for (int blk = 0; blk < NBLK; ++blk) {
        LAS unsigned char* buf = lds + (blk & 1) * SC_BUF;
        LAS float* yb = (LAS float*)(lds + SC_Y) + (blk & 1) * SC_BLK * 64;
        if (w < 4) {
            const int aoff = 1024 + ((fr & 2) ? 128 : 0) + 32 * fq;
            float W = ((LAS float*)buf)[lane], KD = ((LAS float*)(buf + 256))[lane], B = ((LAS float*)(buf + 512))[lane], vv = ((LAS float*)(buf + 768))[16 * w + fr];
            bf16x8 A0 = *(const LAS bf16x8*)(buf + aoff), A1 = *(const LAS bf16x8*)(buf + aoff + 16);
#pragma unroll 2
            for (int st = 0; st < SC_BLK; ++st) {
                const float cW = W, cKD = KD, cB = B, cvv = vv, nsa = -sa; const bf16x8 cA0 = A0, cA1 = A1;
                if (st + 1 < SC_BLK) { LAS unsigned char* nb = buf + (st + 1) * SC_STEP;
                    W = ((LAS float*)nb)[lane]; KD = ((LAS float*)(nb + 256))[lane]; B = ((LAS float*)(nb + 512))[lane]; vv = ((LAS float*)(nb + 768))[16 * w + fr];
                    A0 = *(const LAS bf16x8*)(nb + aoff); A1 = *(const LAS bf16x8*)(nb + aoff + 16); }
                asm volatile("s_nop 4\n\t" SC_UPD(0) SC_UPD(1) SC_UPD(2) SC_UPD(3) SC_UPD(4) SC_UPD(5) SC_UPD(6) SC_UPD(7) SC_UPD(8) SC_UPD(9) SC_UPD(10) SC_UPD(11) SC_UPD(12) SC_UPD(13) SC_UPD(14) SC_UPD(15)
                             : "+v"(s0), "+v"(s1), "+v"(s2), "+v"(s3), "+v"(s4), "+v"(s5), "+v"(s6), "+v"(s7), "+v"(s8), "+v"(s9), "+v"(s10), "+v"(s11), "+v"(s12), "+v"(s13), "+v"(s14), "+v"(s15)
                             : "v"(cW), "v"(cKD), "v"(cB), "v"(cvv), "v"(nsa));
                v4u p0, p1;
                p0.x = pg8::cvt_pk_bf16(s0, s1); p0.y = pg8::cvt_pk_bf16(s2, s3); p0.z = pg8::cvt_pk_bf16(s4, s5); p0.w = pg8::cvt_pk_bf16(s6, s7);
                p1.x = pg8::cvt_pk_bf16(s8, s9); p1.y = pg8::cvt_pk_bf16(s10, s11); p1.z = pg8::cvt_pk_bf16(s12, s13); p1.w = pg8::cvt_pk_bf16(s14, s15);
                pg8::f32x4 acc = (pg8::f32x4){0.f, 0.f, 0.f, 0.f};
                acc = __builtin_amdgcn_mfma_f32_16x16x32_bf16(cA0, __builtin_bit_cast(bf16x8, p0), acc, 0, 0, 0);
                acc = __builtin_amdgcn_mfma_f32_16x16x32_bf16(cA1, __builtin_bit_cast(bf16x8, p1), acc, 0, 0, 0);
                sa = acc[0];
                yb[st * 64 + 16 * w + fr] = acc[2];
            }
        } else {
            const int hw = w - 4;
            if (blk > 0) { const LAS float* ypb = (const LAS float*)(lds + SC_Y) + ((blk - 1) & 1) * SC_BLK * 64;
#pragma unroll
                for (int q = 0; q < SC_BLK / 4; ++q) { const int st = hw + 4 * q, m = scan_row((blk - 1) * SC_BLK + st, b, d); YS[((size_t)d * MT + m) * 1024 + h * 64 + lane] = ypb[st * 64 + lane]; } }
            if (blk + 1 < NBLK) scan_fill(LO, RK, ka, lds + ((blk + 1) & 1) * SC_BUF, blk + 1, b, h, d, hw, lane);
        }
        __syncthreads();
    }
    if (w >= 4) { const int hw = w - 4; const LAS float* ypb = (const LAS float*)(lds + SC_Y) + ((NBLK - 1) & 1) * SC_BLK * 64;
#pragma unroll
        for (int q = 0; q < SC_BLK / 4; ++q) { const int st = hw + 4 * q, m = scan_row((NBLK - 1) * SC_BLK + st, b, d); YS[((size_t)d * MT + m) * 1024 + h * 64 + lane] = ypb[st * 64 + lane]; } }
    __syncthreads();
}

__device__ __forceinline__ void ph_rwkv_out(const Args& a, int l, int gt, int NGT) {
    const float* LO = (const float*)(a.ws + WS_R1); const bf16* RK = (const bf16*)(a.ws + WS_RKVK); const float* YS = (const float*)(a.ws + WS_YS);
    bf16* YB = (bf16*)(a.ws + WS_Y3) + (size_t)MT * 1024;
    const float* ka = a.in[I_KA] + l * 1024; const float* rkw = a.in[I_RK] + l * 1024; const float* lng = a.in[I_LNG] + l * 1024; const float* lnb = a.in[I_LNB] + l * 1024;
    for (int i = gt; i < MT * 128; i += NGT) {
        const int m = i >> 7, c0 = (i & 127) * 8;
        float y[8]; float s1 = 0.f;
        { const f32x4 a0 = *(const GAS f32x4*)(YS + (size_t)m * 1024 + c0), a1 = *(const GAS f32x4*)(YS + (size_t)m * 1024 + c0 + 4),
                      b0 = *(const GAS f32x4*)(YS + ((size_t)MT + m) * 1024 + c0), b1 = *(const GAS f32x4*)(YS + ((size_t)MT + m) * 1024 + c0 + 4);
            y[0] = a0.x + b0.x; y[1] = a0.y + b0.y; y[2] = a0.z + b0.z; y[3] = a0.w + b0.w; y[4] = a1.x + b1.x; y[5] = a1.y + b1.y; y[6] = a1.z + b1.z; y[7] = a1.w + b1.w; }
#pragma unroll
        for (int e = 0; e < 8; ++e) s1 += y[e];
        s1 += __shfl_xor(s1, 1); s1 += __shfl_xor(s1, 2); s1 += __shfl_xor(s1, 4);
        const float mu = s1 * (1.f / 64.f); float s2 = 0.f;
#pragma unroll
        for (int e = 0; e < 8; ++e) { y[e] -= mu; s2 += y[e] * y[e]; }
        s2 += __shfl_xor(s2, 1); s2 += __shfl_xor(s2, 2); s2 += __shfl_xor(s2, 4);
        const float rstd = 1.f / sqrtf(s2 * (1.f / 64.f) + 64e-5f);
        float r[8], k[8], v[8];
        unpack8(*(const GAS v4u*)(RK + (size_t)m * 4096 + c0), r); unpack8(*(const GAS v4u*)(RK + (size_t)m * 4096 + 1024 + c0), k); unpack8(*(const GAS v4u*)(RK + (size_t)m * 4096 + 2048 + c0), v);
        float rk = 0.f;
#pragma unroll
        for (int e = 0; e < 8; ++e) { const int c = c0 + e; const float am = 0.5f * (LO[(size_t)m * LOW + 3072 + c] + LO[(size_t)m * LOW + 4096 + c]);
            rk += r[e] * (k[e] * (1.f + (am - 1.f) * ka[c])) * rkw[c]; }
        rk += __shfl_xor(rk, 1); rk += __shfl_xor(rk, 2); rk += __shfl_xor(rk, 4);
        float o[8];
#pragma unroll
        for (int e = 0; e < 8; ++e) { const int c = c0 + e; o[e] = (y[e] * rstd * lng[c] + lnb[c] + rk * v[e]) * LO[(size_t)m * LOW + c]; }
        *(GAS v4u*)(YB + (size_t)m * 1024 + c0) = pack8(o);
    }
}

constexpr int PH_PER_LAYER = 14, NPH = 1 + NLAYER * PH_PER_LAYER;
#define IN(k) (lo <= (k) && (k) < hi)
#define SEAM(k) do { if (IN(k) && IN((k) + 1)) xcd_barrier(bar); } while (0)
#ifndef ONLY_PH
#define ONLY_PH -1
#endif
#define INL(k) ((ONLY_PH < 0 || ONLY_PH == (k)) && IN(pb + (k)))
#define SEAML(k) SEAM(pb + (k))
#ifndef PROBE_REP
#define PROBE_REP 0
#endif
#define REPL(k) for (int rep_ = 0; rep_ < (((PROBE_REP) >> (k)) & 1) + 1; ++rep_)
template <int l> __device__ __forceinline__ void layer_body(const Args& args, LAS unsigned char* lds, unsigned char* ws, const XcdBarrier& bar, int lo, int hi, int tid, int lane, int G, int bx, int vcu, int gw, int NGW, int gt, int NGT) {
        const int pb = 1 + l * PH_PER_LAYER;
        const bool last = (l == NLAYER - 1);
        float* XS = (float*)(ws + WS_XS);
        const float* mods = (const float*)(ws + WS_MODS) + (size_t)l * 3 * NMOD * DM;
        const float* normg = args.in[I_NORMG] + (size_t)l * 3 * DM;
        pg8::bf16_t* XN = (pg8::bf16_t*)(ws + WS_XN);
        pg8::bf16_t* Hb = (pg8::bf16_t*)(ws + WS_R1);
        const float* xl0 = (l == 0) ? args.in[I_X] : XS; const float* xc0 = (l == 0) ? args.in[I_CTX] : XS + (size_t)NLAT * DM;

        if (INL(0)) REPL(0) ph_norm(xl0, xc0, normg, mods, 0, (bf16*)XN, gw, NGW, lane);
        SEAML(0);
        if (INL(1)) REPL(1) { pg8::Gemm g{XN, (const pg8::bf16_t*)(ws + WS_WF1 + (size_t)(l * 2 + 0) * SZ_WF1), MT, FF2, DM}; pg8::StaticOrder S; S.init(MT, FF2, G, bx);
            pg8::EpiSwiglu E{Hb, FF}; pg8::gemm_phase<pg8::EpiSwiglu, pg8::StaticOrder, true, true>(lds, g, S, E); }
        SEAML(1);
        if (INL(2)) REPL(2) { pg8::Gemm g{Hb, (const pg8::bf16_t*)(ws + WS_WF2 + (size_t)(l * 2 + 0) * SZ_WF2), MT, DM, FF}; pg8::StaticOrder S; S.init(MT, DM, G, bx);
            pg8::EpiResid E{xl0, (long)((xc0 - (size_t)NLAT * DM) - xl0), XS, 0L, 0, mods + 2 * DM, NMOD * DM, 0.5f, NLAT / 256, TSEQ / 256};
            pg8::gemm_phase<pg8::EpiResid, pg8::StaticOrder, true, true>(lds, g, S, E); }
        SEAML(2);
        if (INL(3)) REPL(3) ph_norm(XS, XS + (size_t)NLAT * DM, normg + DM, mods, 3, (bf16*)XN, gw, NGW, lane);
        SEAML(3);
        if (INL(4)) REPL(4) { pg8::Gemm g{XN, (const pg8::bf16_t*)(ws + WS_WIN + (size_t)l * SZ_WIN), MT, PROJP, DM}; pg8::StaticOrder S; S.init(MT, PROJP, G, bx);
            pg8::EpiRawBf16 E{(pg8::bf16_t*)(ws + WS_P), PROJP}; pg8::gemm_phase<pg8::EpiRawBf16, pg8::StaticOrder, true, true>(lds, g, S, E); }
        SEAML(4);
        if (INL(5)) REPL(5) ph_e1(args, l, gt, NGT);
        SEAML(5);
        if (INL(6)) REPL(6) { pg8::Gemm g{(const pg8::bf16_t*)(ws + WS_ACT), (const pg8::bf16_t*)(ws + WS_WLO + (size_t)l * SZ_WLO), MT, LOW, ACTW}; pg8::StaticOrder S; S.init(MT, LOW, G, bx);
            pg8::EpiLora E{(float*)(ws + WS_R1), args.in[I_W0] + l * 2048, args.in[I_A0] + l * 2048}; pg8::gemm_phase<pg8::EpiLora, pg8::StaticOrder, true, true>(lds, g, S, E); }
        SEAML(6);
        if (INL(7)) REPL(7) {
            if (bx < 64) scan_unit(args, l, bx, lds, tid);
            else { ph_attn(args, l, !last, lds, tid, bx - 64, G - 64); __syncthreads(); ph_gmlp(args, l, lds, tid, bx - 64, G - 64); }
        }
        SEAML(7);
        if (INL(8)) REPL(8) ph_rwkv_out(args, l, gt, NGT);
        SEAML(8);
        if (INL(9)) REPL(9) { pg8::Gemm g{(const pg8::bf16_t*)(ws + WS_Y3), (const pg8::bf16_t*)(ws + WS_WBR + (size_t)l * SZ_WBR), 3 * MT, 3 * DM, 1024}; pg8::MergeOrder S{G, bx, MT / 256, 8};
            pg8::EpiMerge E{(const pg8::bf16_t*)(ws + WS_P) + P_GATE, PROJP, args.in[I_BGATE] + (size_t)l * 3 * DM, (float*)(ws + WS_YS), XN, MT / 256};
            pg8::gemm_phase<pg8::EpiMerge, pg8::MergeOrder, true, true>(lds, g, S, E); }
        SEAML(9);
        if (INL(10)) REPL(10) { pg8::Gemm g{XN, (const pg8::bf16_t*)(ws + WS_WOUT + (size_t)l * SZ_WOUT), MT, DM, DM}; pg8::StaticOrder S; S.init(MT, DM, G, bx);
            pg8::EpiResid E{XS, 0L, XS, 0L, 0, mods + 5 * DM, NMOD * DM, 1.0f, NLAT / 256, TSEQ / 256};
            pg8::gemm_phase<pg8::EpiResid, pg8::StaticOrder, true, true>(lds, g, S, E); }
        SEAML(10);
        if (INL(11)) REPL(11) ph_norm(XS, XS + (size_t)NLAT * DM, normg + 2 * DM, mods, 6, (bf16*)XN, gw, NGW, lane);
        SEAML(11);
        if (INL(12)) REPL(12) { pg8::Gemm g{XN, (const pg8::bf16_t*)(ws + WS_WF1 + (size_t)(l * 2 + 1) * SZ_WF1), MT, FF2, DM}; pg8::StaticOrder S; S.init(MT, FF2, G, bx);
            pg8::EpiSwiglu E{Hb, FF}; pg8::gemm_phase<pg8::EpiSwiglu, pg8::StaticOrder, true, true>(lds, g, S, E); }
        SEAML(12);
        if (INL(13)) REPL(13) { pg8::Gemm g{Hb, (const pg8::bf16_t*)(ws + WS_WF2 + (size_t)(l * 2 + 1) * SZ_WF2), MT, DM, FF}; pg8::StaticOrder S; S.init(MT, DM, G, bx);
            pg8::EpiResid E{XS, 0L, last ? args.out : XS, 0L, last ? 1 : 0, mods + 8 * DM, NMOD * DM, 0.5f, NLAT / 256, TSEQ / 256};
            pg8::gemm_phase<pg8::EpiResid, pg8::StaticOrder, true, true>(lds, g, S, E); }
        SEAML(13);
    }
__global__ void __launch_bounds__(NTHR, 2) fwd(Args args) {
    extern __shared__ __attribute__((aligned(16))) unsigned char lds_raw[];
    LAS unsigned char* lds = (LAS unsigned char*)lds_raw;
    const int tid = threadIdx.x, lane = tid & 63, wave = __builtin_amdgcn_readfirstlane(tid >> 6);
    const int G = gridDim.x; const int bx = blockIdx.x; const int vcu = (G % 8 == 0) ? (bx % 8) * (G / 8) + bx / 8 : bx;
    const int gw = vcu * NWAVES + wave, NGW = G * NWAVES, gt = vcu * NTHR + tid, NGT = G * NTHR;
    unsigned char* ws = args.ws;
    volatile LAS unsigned* MISC = (volatile LAS unsigned*)(lds + MISC_OFF);
    for (int u = tid; u < (LDS_BYTES - LDSCTL_OFF) / 4; u += NTHR) ((LAS unsigned*)(lds + LDSCTL_OFF))[u] = 0u;
    __syncthreads();
    const int lo = args.ph_lo, hi = args.ph_hi;
    const bool multi = (hi - lo) > 1;
    XcdBarrier bar; bar.bar = (unsigned*)(ws + WS_CTL) + CW_BAR; bar.x = 0; bar.st = nullptr;
    if (multi) bar = xcd_barrier_post((unsigned*)(ws + WS_CTL) + CW_BAR, MISC + 8);

    if ((ONLY_PH < 0 || ONLY_PH == 100) && IN(0)) REPL(16) { ph_ada(args, lds, tid, vcu, G); __syncthreads(); ph_weights(args, lds, tid, vcu, G); }
    SEAM(0);

    layer_body<0>(args, lds, ws, bar, lo, hi, tid, lane, G, bx, vcu, gw, NGW, gt, NGT);
    layer_body<1>(args, lds, ws, bar, lo, hi, tid, lane, G, bx, vcu, gw, NGW, gt, NGT);
#undef IN
#undef SEAM
}

#ifndef MK_PER_PHASE
#define MK_PER_PHASE 0
#endif
extern "C" void kernel_launch(void* const* d_in, const int* in_sizes, int n_in, void* d_out, int out_size, void* d_ws, size_t ws_size, hipStream_t stream) {
    static int grid = 0;
    if (grid == 0) {
        if (n_in != 31 || in_sizes[0] != NLAT * DM || out_size != NLAT * DM || ws_size < WS_END) {
            fprintf(stderr, "kernel_launch: unexpected shapes: n_in %d in0 %d out %d ws %zu (need %zu); nothing launched\n", n_in, n_in > 0 ? in_sizes[0] : -1, out_size, ws_size, (size_t)WS_END); grid = -1; return; }
        int dev = 0, cus = 0, per_cu = 0;
        if (hipGetDevice(&dev) != hipSuccess || hipDeviceGetAttribute(&cus, hipDeviceAttributeMultiprocessorCount, dev) != hipSuccess) { grid = -1; return; }
        if (hipFuncSetAttribute((const void*)fwd, hipFuncAttributeMaxDynamicSharedMemorySize, LDS_BYTES) != hipSuccess) { fprintf(stderr, "kernel_launch: hipFuncSetAttribute failed\n"); grid = -1; return; }
        if (hipOccupancyMaxActiveBlocksPerMultiprocessor(&per_cu, (const void*)fwd, NTHR, LDS_BYTES) != hipSuccess || per_cu < 1) fprintf(stderr, "kernel_launch: occupancy query says %d\n", per_cu);
        (void)hipGetLastError();
        grid = cus;
    }
    if (grid < 0) return;
    (void)hipMemsetAsync((char*)d_ws + WS_CTL, 0, CTL_ZERO_BYTES, stream);
    Args a{};
    for (int i = 0; i < 31; ++i) a.in[i] = (const float*)d_in[i];
    a.out = (float*)d_out; a.ws = (unsigned char*)d_ws;
#if MK_PER_PHASE
    for (int p = 0; p < NPH; ++p) { a.ph_lo = p; a.ph_hi = p + 1; hipLaunchKernelGGL(fwd, dim3(grid), dim3(NTHR), LDS_BYTES, stream, a); }
#else
    a.ph_lo = 0; a.ph_hi = NPH; hipLaunchKernelGGL(fwd, dim3(grid), dim3(NTHR), LDS_BYTES, stream, a);
#endif
}
```

```cpp
#include <hip/hip_runtime.h>
#include <cstdio>
#include <cstdint>
namespace pg8 {
#define PG8_LAS __attribute__((address_space(3)))
typedef unsigned short bf16_t;
typedef short bf16x8 __attribute__((ext_vector_type(8)));
typedef float f32x4 __attribute__((ext_vector_type(4)));
typedef unsigned u32x4 __attribute__((ext_vector_type(4)));
constexpr int BM = 256, BK = 64, HALF = 128, HTB = HALF * BK * 2  , STAGE_BYTES = 8 * HTB, NXCD = 8, WGM = 8;

__host__ __device__ __forceinline__ int lds_byte(int r, int c) { const int st = (r >> 4) * 2 + (c >> 5), rr = r & 15, cc = c & 31, ob = rr * 64 + cc * 2; return st * 1024 + (ob ^ (((ob >> 9) & 1) << 5)); }
__host__ __device__ __forceinline__ void stage_rc(int b, int& R, int& C) { const int st = b / 1024, sb = b % 1024, swz = sb ^ (((sb >> 9) & 1) << 5); R = (st >> 1) * 16 + swz / 64; C = (st & 1) * 32 + (swz % 64) / 2; }
__host__ __device__ __forceinline__ int perm32(int rho) { const int n = rho >> 4, i = rho & 15; return 8 * (i >> 2) + 4 * n + (i & 3); }

struct Unit { int pm, pn; };
struct Gemm { const bf16_t* A; const bf16_t* Bt; int M, N, K; };

struct StaticOrder {
    int nM, nN, nwg, G, c;
    __host__ __device__ void init(int M, int N, int G_, int c_) { nM = M / BM; nN = N / BM; nwg = nM * nN; G = G_; c = c_; }
    __host__ __device__ bool next(int i, Unit& u) const {
        const long L = (long)i * G + c; if (L >= nwg) return false;
        int wgid = (int)L; { const int q = nwg / NXCD, r = nwg % NXCD, xcd = wgid % NXCD, off = wgid / NXCD; wgid = (xcd < r ? xcd * (q + 1) : r * (q + 1) + (xcd - r) * q) + off; }
        const int nig = WGM * nN, gid = wgid / nig, fm = gid * WGM, gsz = (nM - fm) < WGM ? (nM - fm) : WGM;
        u.pm = fm + ((wgid % nig) % gsz); u.pn = (wgid % nig) / gsz; return true;
    }
    __device__ __forceinline__ void a_ready(const Unit&) const {}
    __device__ __forceinline__ void done(const Unit&) const {}
};

__device__ __forceinline__ unsigned cvt_pk_bf16(float lo, float hi) { unsigned r; asm volatile("v_cvt_pk_bf16_f32 %0, %1, %2" : "=v"(r) : "v"(lo), "v"(hi)); return r; }
typedef float f32x2 __attribute__((ext_vector_type(2)));
typedef unsigned u32x2 __attribute__((ext_vector_type(2)));
__device__ __forceinline__ float fsigmoid(float x) { return __builtin_amdgcn_rcpf(1.f + __expf(-x)); }
__device__ __forceinline__ float bflo(unsigned w) { return __builtin_bit_cast(float, w << 16); }
__device__ __forceinline__ float bfhi(unsigned w) { return __builtin_bit_cast(float, w & 0xffff0000u); }

struct EpiSwiglu {
    static constexpr bool PERM = true, AFTER_DRAIN = false;
    bf16_t* H; int ldh;
    __device__ __forceinline__ void operator()(const f32x4 (&acc)[2][2][4][2], const Unit& u, int wr, int wc, int fr, int fq) const {
        const int col0 = u.pn * HALF + wc * 32 + 8 * fq, row0 = u.pm * BM + wr * 64 + fr;
#pragma unroll
        for (int ai = 0; ai < 2; ++ai)
#pragma unroll
            for (int m = 0; m < 4; ++m) {
                const f32x4 g0 = acc[ai][0][m][0], g1 = acc[ai][0][m][1], u0 = acc[ai][1][m][0], u1 = acc[ai][1][m][1];
                float o[8];
#pragma unroll
                for (int e = 0; e < 4; ++e) { o[e] = g0[e] * fsigmoid(g0[e]) * u0[e]; o[4 + e] = g1[e] * fsigmoid(g1[e]) * u1[e]; }
                u32x4 w; w.x = cvt_pk_bf16(o[0], o[1]); w.y = cvt_pk_bf16(o[2], o[3]); w.z = cvt_pk_bf16(o[4], o[5]); w.w = cvt_pk_bf16(o[6], o[7]);
                *(u32x4*)(H + (size_t)(row0 + ai * HALF + m * 16) * ldh + col0) = w;
            }
    }
};

struct EpiResid {
    static constexpr bool PERM = true, AFTER_DRAIN = false;
    const float* xin; long din; float* out; long dout; int skip_ctx; const float* gvec; int gstride; float scale; int nlat_tiles, tiles_per_set;
    __device__ __forceinline__ void operator()(const f32x4 (&acc)[2][2][4][2], const Unit& u, int wr, int wc, int fr, int fq) const {
        const bool isctx = u.pm >= nlat_tiles;
        if (isctx && skip_ctx) return;
        const int set = isctx ? 2 : (u.pm / tiles_per_set);
        const float* gv = gvec + (size_t)set * gstride;
        const int colb = u.pn * BM + wc * 32 + 8 * fq;
        const long rbase = (long)(u.pm * BM + wr * 64 + fr) * 2048 + colb;
        const float* xi = xin + rbase + (isctx ? din : 0L); float* xo = out + rbase + (isctx ? dout : 0L);
        f32x4 gg[2][2];
#pragma unroll
        for (int bj = 0; bj < 2; ++bj)
#pragma unroll
            for (int n = 0; n < 2; ++n) gg[bj][n] = *(const f32x4*)(gv + colb + bj * HALF + 4 * n) * scale;
#pragma unroll
        for (int ai = 0; ai < 2; ++ai)
#pragma unroll
            for (int m = 0; m < 4; ++m) {
                const size_t off = (size_t)(ai * HALF + m * 16) * 2048;
#pragma unroll
                for (int bj = 0; bj < 2; ++bj)
#pragma unroll
                    for (int n = 0; n < 2; ++n) {
                        const f32x4 x = *(const f32x4*)(xi + off + bj * HALF + 4 * n);
                        *(f32x4*)(xo + off + bj * HALF + 4 * n) = x + gg[bj][n] * acc[ai][bj][m][n];
                    }
            }
    }
};

struct EpiRawBf16 {
    static constexpr bool PERM = true, AFTER_DRAIN = false;
    bf16_t* O; int ldc;
    __device__ __forceinline__ void operator()(const f32x4 (&acc)[2][2][4][2], const Unit& u, int wr, int wc, int fr, int fq) const {
        const int col0 = u.pn * BM + wc * 32 + 8 * fq, row0 = u.pm * BM + wr * 64 + fr;
#pragma unroll
        for (int ai = 0; ai < 2; ++ai)
#pragma unroll
            for (int m = 0; m < 4; ++m) {
                bf16_t* rowp = O + (size_t)(row0 + ai * HALF + m * 16) * ldc + col0;
#pragma unroll
                for (int bj = 0; bj < 2; ++bj) {
                    const f32x4 v0 = acc[ai][bj][m][0], v1 = acc[ai][bj][m][1];
                    u32x4 w; w.x = cvt_pk_bf16(v0[0], v0[1]); w.y = cvt_pk_bf16(v0[2], v0[3]); w.z = cvt_pk_bf16(v1[0], v1[1]); w.w = cvt_pk_bf16(v1[2], v1[3]);
                    *(u32x4*)(rowp + bj * HALF) = w;
                }
            }
    }
};

struct EpiLora {
    static constexpr bool PERM = true, AFTER_DRAIN = false;
    float* LO; const float* w0; const float* a0;
    __device__ __forceinline__ void operator()(const f32x4 (&acc)[2][2][4][2], const Unit& u, int wr, int wc, int fr, int fq) const {
        const int sec = u.pn >> 2;
        const int col0 = u.pn * BM + wc * 32 + 8 * fq, row0 = u.pm * BM + wr * 64 + fr, c0 = col0 - sec * 1024;
        f32x4 bb[2][2];
#pragma unroll
        for (int bj = 0; bj < 2; ++bj)
#pragma unroll
            for (int n = 0; n < 2; ++n) {
                if (sec == 0) bb[bj][n] = (f32x4){0.f, 0.f, 0.f, 0.f};
                else if (sec <= 2) bb[bj][n] = *(const f32x4*)(w0 + (sec - 1) * 1024 + c0 + bj * HALF + 4 * n);
                else bb[bj][n] = *(const f32x4*)(a0 + (sec - 3) * 1024 + c0 + bj * HALF + 4 * n);
            }
#pragma unroll
        for (int ai = 0; ai < 2; ++ai)
#pragma unroll
            for (int m = 0; m < 4; ++m) {
                float* rowp = LO + (size_t)(row0 + ai * HALF + m * 16) * 5120 + col0;
#pragma unroll
                for (int bj = 0; bj < 2; ++bj)
#pragma unroll
                    for (int n = 0; n < 2; ++n) {
                        f32x4 v = acc[ai][bj][m][n] + bb[bj][n];
                        if (sec >= 1) {
#pragma unroll
                            for (int e = 0; e < 4; ++e) { const float s = fsigmoid(v[e]); v[e] = (sec <= 2) ? __expf(-0.60653066f * s) : s; }
                        }
                        *(f32x4*)(rowp + bj * HALF + 4 * n) = v;
                    }
            }
    }
};

struct EpiMerge {
    static constexpr bool PERM = true, AFTER_DRAIN = false;
    const bf16_t* pgate; int ldp;
    const float* bgate;
    float* ZF; bf16_t* Z; int mtiles;
    __device__ __forceinline__ void operator()(const f32x4 (&acc)[2][2][4][2], const Unit& u, int wr, int wc, int fr, int fq) const {
        const int br = u.pn >> 3, pn = u.pn & 7, pm = u.pm - mtiles * br;
        const int col0 = pn * BM + wc * 32 + 8 * fq, row0 = pm * BM + wr * 64 + fr;
        f32x4 bb[2][2];
#pragma unroll
        for (int bj = 0; bj < 2; ++bj)
#pragma unroll
            for (int n = 0; n < 2; ++n) bb[bj][n] = *(const f32x4*)(bgate + br * 2048 + col0 + bj * HALF + 4 * n);
#pragma unroll
        for (int ai = 0; ai < 2; ++ai)
#pragma unroll
            for (int m = 0; m < 4; ++m) {
                const size_t row = (size_t)(row0 + ai * HALF + m * 16);
#pragma unroll
                for (int bj = 0; bj < 2; ++bj) {
                    const u32x4 pg = *(const u32x4*)(pgate + row * ldp + br * 2048 + col0 + bj * HALF);
                    f32x4 g0, g1;
                    g0[0] = bflo(pg.x); g0[1] = bfhi(pg.x); g0[2] = bflo(pg.y); g0[3] = bfhi(pg.y); g1[0] = bflo(pg.z); g1[1] = bfhi(pg.z); g1[2] = bflo(pg.w); g1[3] = bfhi(pg.w);
                    g0 = g0 + bb[bj][0]; g1 = g1 + bb[bj][1];
                    f32x4 v0, v1;
#pragma unroll
                    for (int e = 0; e < 4; ++e) { v0[e] = fsigmoid(g0[e]) * acc[ai][bj][m][0][e]; v1[e] = fsigmoid(g1[e]) * acc[ai][bj][m][1][e]; }
                    float* zf = ZF + row * 2048 + col0 + bj * HALF;
                    if (br >= 1) { v0 = v0 + *(const f32x4*)zf; v1 = v1 + *(const f32x4*)(zf + 4); }
                    if (br <= 1) { *(f32x4*)zf = v0; *(f32x4*)(zf + 4) = v1; }
                    else { u32x4 w; w.x = cvt_pk_bf16(v0[0], v0[1]); w.y = cvt_pk_bf16(v0[2], v0[3]); w.z = cvt_pk_bf16(v1[0], v1[1]); w.w = cvt_pk_bf16(v1[2], v1[3]);
                        *(u32x4*)(Z + row * 2048 + col0 + bj * HALF) = w; }
                }
            }
    }
};
struct MergeOrder {
    int G, c, mtiles, ntiles;
    __device__ __forceinline__ bool next(int i, Unit& u) const {
        const int t = (i / 3) * G + c, br = i % 3; if (t >= mtiles * 8) return false;
        u.pm = (t >> 3) + mtiles * br; u.pn = (t & 7) + 8 * br; return true;
    }
    __device__ __forceinline__ void a_ready(const Unit&) const {}
    __device__ __forceinline__ void done(const Unit&) const {}
};

template <class Epi, class Sched, bool ALIGN_EPI = false, bool SP2 = false>
__device__ __forceinline__ void gemm_phase(PG8_LAS unsigned char* lds, const Gemm g, const Sched& S, const Epi& E) {
    const int tid = threadIdx.x, wid = __builtin_amdgcn_readfirstlane(tid >> 6), lane = tid & 63, wr = wid >> 2, wc = wid & 3, fr = lane & 15, fq = lane >> 4;
    const int K = g.K, nt = K / BK;
    unsigned voffA[2], voffB[2];
#pragma unroll
    for (int i = 0; i < 2; ++i) { int R, C; stage_rc(tid * 16 + i * 8192, R, C); const int Rb = Epi::PERM ? ((R & ~31) + perm32(R & 31)) : R;
        voffA[i] = (unsigned)(R * K + C) * 2u; voffB[i] = (unsigned)(Rb * K + C) * 2u; }
    const size_t kstep = (size_t)(BK * 2);
    const size_t hstep = (size_t)HALF * K * 2;
    const size_t tstep = 2 * hstep;
    const unsigned ldsw = (unsigned)wid * 1024u;
    const int aoff = lds_byte(wr * 64 + fr, fq * 8), boff = lds_byte(wc * 32 + fr, fq * 8);
#define PG8_SA(b, h) (((b) * 2 + (h)) * HTB)
#define PG8_SB(b, h) ((4 + (b) * 2 + (h)) * HTB)
#define PG8_STAGE(bufoff, gbase, voff) do { _Pragma("unroll") for (int _i = 0; _i < 2; ++_i) \
        __builtin_amdgcn_global_load_lds((const unsigned*)((const char*)(gbase) + (voff)[_i]), (PG8_LAS unsigned*)(lds + (bufoff) + ldsw + _i * 8192), 16, 0, 0); } while (0)
#define PG8_LDA(dst, b, h) do { _Pragma("unroll") for (int m = 0; m < 4; ++m) _Pragma("unroll") for (int k = 0; k < 2; ++k) dst[m][k] = *(const PG8_LAS bf16x8*)(lds + PG8_SA(b, h) + aoff + m * 2048 + k * 1024); } while (0)
#define PG8_LDB(dst, b, h) do { _Pragma("unroll") for (int n = 0; n < 2; ++n) _Pragma("unroll") for (int k = 0; k < 2; ++k) dst[n][k] = *(const PG8_LAS bf16x8*)(lds + PG8_SB(b, h) + boff + n * 2048 + k * 1024); } while (0)
#define PG8_MMA(ai, bj, At, Bt) do { __builtin_amdgcn_s_setprio(1); _Pragma("unroll") for (int m = 0; m < 4; ++m) _Pragma("unroll") for (int n = 0; n < 2; ++n) _Pragma("unroll") for (int k = 0; k < 2; ++k) \
        acc[ai][bj][m][n] = __builtin_amdgcn_mfma_f32_16x16x32_bf16(Bt[n][k], At[m][k], acc[ai][bj][m][n], 0, 0, 0); __builtin_amdgcn_s_setprio(0); } while (0)
#define PG8_WAIT_V(n) asm volatile("s_waitcnt vmcnt(" #n ")" ::: "memory")
#define PG8_WAIT_L(n) asm volatile("s_waitcnt lgkmcnt(" #n ")" ::: "memory")
#define PG8_BAR __builtin_amdgcn_s_barrier()
#define PG8_SCHED __builtin_amdgcn_sched_barrier(0)
    Unit cur, nxt; int ui = 0;
    if (!S.next(0, cur)) return;
    f32x4 acc[2][2][4][2];
#pragma unroll
    for (int a = 0; a < 2; ++a)
#pragma unroll
        for (int b = 0; b < 2; ++b)
#pragma unroll
            for (int m = 0; m < 4; ++m)
#pragma unroll
                for (int n = 0; n < 2; ++n) acc[a][b][m][n] = (f32x4){0.f, 0.f, 0.f, 0.f};
    bf16x8 At[4][2], B0[2][2], B1[2][2];
    const char* cA = (const char*)g.A + (size_t)cur.pm * tstep; const char* cB = (const char*)g.Bt + (size_t)cur.pn * tstep;
    S.a_ready(cur);
    if constexpr (SP2) {
        PG8_STAGE(PG8_SB(0, 0), cB, voffB); PG8_STAGE(PG8_SB(0, 1), cB + hstep, voffB); PG8_STAGE(PG8_SA(0, 0), cA, voffA); PG8_STAGE(PG8_SA(0, 1), cA + hstep, voffA);
        if (wr == 1) PG8_BAR;
        PG8_WAIT_V(2); PG8_BAR;
        PG8_STAGE(PG8_SB(1, 0), cB + kstep, voffB); PG8_STAGE(PG8_SA(1, 0), cA + kstep, voffA); PG8_STAGE(PG8_SB(1, 1), cB + hstep + kstep, voffB);
        PG8_WAIT_V(6); PG8_BAR;
    } else {
        PG8_STAGE(PG8_SB(0, 0), cB, voffB); PG8_STAGE(PG8_SA(0, 0), cA, voffA); PG8_STAGE(PG8_SB(0, 1), cB + hstep, voffB); PG8_STAGE(PG8_SA(0, 1), cA + hstep, voffA);
        if (wr == 1) PG8_BAR;
        PG8_WAIT_V(4); PG8_BAR;
        PG8_STAGE(PG8_SB(1, 0), cB + kstep, voffB); PG8_STAGE(PG8_SA(1, 0), cA + kstep, voffA); PG8_STAGE(PG8_SB(1, 1), cB + hstep + kstep, voffB);
        PG8_WAIT_V(6); PG8_BAR;
    }
    for (;;) {
        const bool has_next = S.next(ui + 1, nxt);
        const char* nA = has_next ? (const char*)g.A + (size_t)nxt.pm * tstep : cA; const char* nB = has_next ? (const char*)g.Bt + (size_t)nxt.pn * tstep : cB;
        for (int t = 0; t < nt; t += 2) {
            const bool last = (t == nt - 2);
            const char* a1 = cA + (size_t)(t + 1) * kstep;
            const char* a2 = last ? nA : cA + (size_t)(t + 2) * kstep; const char* b2 = last ? nB : cB + (size_t)(t + 2) * kstep;
            const char* a3 = a2 + kstep; const char* b3 = b2 + kstep;
            if (last && has_next) S.a_ready(nxt);
            if constexpr (SP2) {
            PG8_LDB(B0, 0, 0); PG8_LDB(B1, 0, 1); PG8_SCHED; PG8_LDA(At, 0, 0); PG8_STAGE(PG8_SA(1, 1), a1 + hstep, voffA);
            PG8_WAIT_V(8); PG8_WAIT_L(0); PG8_BAR; PG8_MMA(0, 0, At, B0); PG8_MMA(0, 1, At, B1); PG8_BAR; PG8_SCHED;
            PG8_LDA(At, 0, 1); PG8_STAGE(PG8_SB(0, 0), b2, voffB); PG8_STAGE(PG8_SB(0, 1), b2 + hstep, voffB); PG8_STAGE(PG8_SA(0, 0), a2, voffA);
            PG8_WAIT_V(8); PG8_WAIT_L(0); PG8_BAR; PG8_MMA(1, 0, At, B0); PG8_MMA(1, 1, At, B1); PG8_BAR; PG8_SCHED;
            PG8_LDB(B0, 1, 0); PG8_LDB(B1, 1, 1); PG8_SCHED; PG8_LDA(At, 1, 0); PG8_STAGE(PG8_SA(0, 1), a2 + hstep, voffA);
            PG8_WAIT_V(8); PG8_WAIT_L(0); PG8_BAR; PG8_MMA(0, 0, At, B0); PG8_MMA(0, 1, At, B1); PG8_BAR; PG8_SCHED;
            PG8_LDA(At, 1, 1); PG8_STAGE(PG8_SB(1, 0), b3, voffB); PG8_STAGE(PG8_SB(1, 1), b3 + hstep, voffB); PG8_STAGE(PG8_SA(1, 0), a3, voffA);
            PG8_WAIT_V(8); PG8_WAIT_L(0); PG8_BAR; PG8_MMA(1, 0, At, B0); PG8_MMA(1, 1, At, B1); PG8_BAR; PG8_SCHED;
            } else {
            PG8_LDB(B0, 0, 0); PG8_SCHED; PG8_LDA(At, 0, 0); PG8_STAGE(PG8_SA(1, 1), a1 + hstep, voffA);
            PG8_WAIT_L(8); PG8_BAR; PG8_WAIT_L(0); PG8_MMA(0, 0, At, B0); PG8_BAR; PG8_SCHED;
            PG8_LDB(B1, 0, 1); PG8_STAGE(PG8_SB(0, 0), b2, voffB);
            PG8_BAR; PG8_WAIT_L(0); PG8_MMA(0, 1, At, B1); PG8_BAR;
            PG8_LDA(At, 0, 1); PG8_STAGE(PG8_SA(0, 0), a2, voffA);
            PG8_BAR; PG8_WAIT_L(0); PG8_MMA(1, 0, At, B0); PG8_BAR; PG8_SCHED;
            PG8_STAGE(PG8_SB(0, 1), b2 + hstep, voffB);
            PG8_WAIT_V(6); PG8_BAR; PG8_MMA(1, 1, At, B1); PG8_BAR;
            PG8_LDB(B0, 1, 0); PG8_SCHED; PG8_LDA(At, 1, 0); PG8_STAGE(PG8_SA(0, 1), a2 + hstep, voffA);
            PG8_WAIT_L(8); PG8_BAR; PG8_WAIT_L(0); PG8_MMA(0, 0, At, B0); PG8_BAR; PG8_SCHED;
            PG8_LDB(B1, 1, 1); PG8_STAGE(PG8_SB(1, 0), b3, voffB);
            PG8_BAR; PG8_WAIT_L(0); PG8_MMA(0, 1, At, B1); PG8_BAR;
            PG8_LDA(At, 1, 1); PG8_STAGE(PG8_SA(1, 0), a3, voffA);
            PG8_BAR; PG8_WAIT_L(0); PG8_MMA(1, 0, At, B0); PG8_BAR; PG8_SCHED;
            PG8_STAGE(PG8_SB(1, 1), b3 + hstep, voffB);
            PG8_WAIT_V(6); PG8_BAR; PG8_MMA(1, 1, At, B1); PG8_BAR;
            }
        }
        if constexpr (ALIGN_EPI) { if (wr == 0) PG8_BAR; }
        if constexpr (!Epi::AFTER_DRAIN) { E(acc, cur, wr, wc, fr, fq); S.done(cur); }
        if (!has_next) break;
#pragma unroll
        for (int a = 0; a < 2; ++a)
#pragma unroll
            for (int b = 0; b < 2; ++b)
#pragma unroll
                for (int m = 0; m < 4; ++m)
#pragma unroll
                    for (int n = 0; n < 2; ++n) acc[a][b][m][n] = (f32x4){0.f, 0.f, 0.f, 0.f};
        cur = nxt; cA = nA; cB = nB; ++ui;
        if constexpr (ALIGN_EPI) { if (wr == 1) PG8_BAR; }
    }
    PG8_WAIT_V(0);
    if constexpr (!ALIGN_EPI) { if (wr == 0) PG8_BAR; }
    PG8_BAR;
    if constexpr (Epi::AFTER_DRAIN) { E.fused(acc, cur, wr, wc, fr, fq, lds, wid, lane); S.done(cur); }
#undef PG8_SA
#undef PG8_SB
#undef PG8_STAGE
#undef PG8_LDA
#undef PG8_LDB
#undef PG8_MMA
#undef PG8_WAIT_V
#undef PG8_WAIT_L
#undef PG8_BAR
#undef PG8_SCHED
}
}

constexpr int NWAVES = 8, NTHR = NWAVES * 64;
constexpr int DM = 2048, FF = 5504, FF2 = 2 * FF, NLAT = 8192, NCTX = 512, MT = NLAT + NCTX, TSEQ = 4096, TCTX = 256;
constexpr int PROJ = 14976, PROJP = 15104;
constexpr int P_U = 0, P_V = 1024, P_RKV = 2048, P_G = 5120, P_W = 5376, P_A = 5568, P_QKV = 5760, P_GATE = 8832;
constexpr int ACTW = 768, LOW = 5120;
constexpr int NLAYER = 2, NMOD = 9;

constexpr size_t MiB = 1u << 20;
constexpr size_t al(size_t x) { return (x + MiB - 1) / MiB * MiB; }
constexpr size_t WS_CTL = 0, CTL_ZERO_BYTES = 1 * MiB;
constexpr size_t WS_MODS = 1 * MiB;
constexpr size_t WS_ROPE = WS_MODS + al((size_t)NLAYER * 3 * NMOD * DM * 4);
constexpr size_t WS_WF1 = WS_ROPE + MiB;
constexpr size_t SZ_WF1 = (size_t)FF2 * DM * 2;
constexpr size_t WS_WF2 = WS_WF1 + al(4 * SZ_WF1);
constexpr size_t SZ_WF2 = (size_t)DM * FF * 2;
constexpr size_t WS_WIN = WS_WF2 + al(4 * SZ_WF2);
constexpr size_t SZ_WIN = (size_t)PROJP * DM * 2;
constexpr size_t WS_WLO = WS_WIN + al(2 * SZ_WIN);
constexpr size_t SZ_WLO = (size_t)LOW * ACTW * 2;
constexpr size_t WS_WBR = WS_WLO + al(2 * SZ_WLO);
constexpr size_t SZ_WBR = (size_t)3 * DM * 1024 * 2;
constexpr size_t WS_WOUT = WS_WBR + al(2 * SZ_WBR);
constexpr size_t SZ_WOUT = (size_t)DM * DM * 2;
constexpr size_t WS_XS = WS_WOUT + al(2 * SZ_WOUT);
constexpr size_t WS_XN = WS_XS + al((size_t)MT * DM * 4);
constexpr size_t WS_P = WS_XN + al((size_t)MT * DM * 2);
constexpr size_t WS_R1 = WS_P + al((size_t)MT * PROJP * 2);
constexpr size_t WS_ACT = WS_R1 + al((size_t)MT * LOW * 4);
constexpr size_t WS_RKVK = WS_ACT + al((size_t)MT * ACTW * 2);
constexpr size_t WS_QK = WS_RKVK + al((size_t)MT * 4096 * 2);
constexpr size_t WS_YS = WS_QK + al((size_t)MT * DM * 2);
constexpr size_t WS_Y3 = WS_YS + al((size_t)2 * MT * 1024 * 4);
constexpr size_t WS_OJ = WS_Y3 + al((size_t)3 * MT * 1024 * 2);
constexpr size_t WS_END = WS_OJ + al((size_t)2 * MT * 1024 * 4);

constexpr int CW_TMO = 0, CW_CODE = 1, CW_BAR = 4096;

constexpr int RING_BYTES = 131072, LDSCTL_OFF = RING_BYTES, MISC_OFF = LDSCTL_OFF + 320, LDS_BYTES = 147456;

#define GAS __attribute__((address_space(1)))
#define LAS __attribute__((address_space(3)))
typedef unsigned short bf16;
typedef unsigned v4u __attribute__((ext_vector_type(4)));
typedef unsigned v2u __attribute__((ext_vector_type(2)));
typedef float f32x4 __attribute__((ext_vector_type(4)));
typedef short bf16x8 __attribute__((ext_vector_type(8)));
typedef GAS unsigned gu32;
#define RLX_AGENT __ATOMIC_RELAXED, __HIP_MEMORY_SCOPE_AGENT
__device__ __forceinline__ unsigned f2bf(float f) { unsigned u = __builtin_bit_cast(unsigned, f); return (u + 0x7fffu + ((u >> 16) & 1u)) >> 16; }
__device__ __forceinline__ unsigned pk2(float lo, float hi) { return f2bf(lo) | (f2bf(hi) << 16); }
__device__ __forceinline__ float bflo(unsigned w) { return __builtin_bit_cast(float, w << 16); }
__device__ __forceinline__ float bfhi(unsigned w) { return __builtin_bit_cast(float, w & 0xffff0000u); }
__device__ __forceinline__ float bf1(bf16 h) { return __builtin_bit_cast(float, (unsigned)h << 16); }
__device__ __forceinline__ void unpack8(const v4u w, float (&f)[8]) { f[0] = bflo(w.x); f[1] = bfhi(w.x); f[2] = bflo(w.y); f[3] = bfhi(w.y); f[4] = bflo(w.z); f[5] = bfhi(w.z); f[6] = bflo(w.w); f[7] = bfhi(w.w); }
__device__ __forceinline__ v4u pack8(const float (&f)[8]) { v4u w; w.x = pk2(f[0], f[1]); w.y = pk2(f[2], f[3]); w.z = pk2(f[4], f[5]); w.w = pk2(f[6], f[7]); return w; }
__device__ __forceinline__ float fsigm(float x) { return __builtin_amdgcn_rcpf(1.f + __expf(-x)); }
__device__ __forceinline__ float ftanh(float x) { return 1.f - 2.f * __builtin_amdgcn_rcpf(__expf(2.f * x) + 1.f); }
__device__ __forceinline__ float gelu_t(float x) { return 0.5f * x * (1.f + ftanh(0.7978845608f * (x + 0.044715f * x * x * x))); }
__device__ __forceinline__ float wave_sum(float v) {
#pragma unroll
    for (int o = 1; o < 64; o <<= 1) v += __shfl_xor(v, o);
    return v;
}
#define XB_TMO      128
#define XB_XCNT(j)  (256  + 64 * (j))
#define XB_XSUB(j)  (1280 + 64 * (j))
#define XB_XGEN(j)  (2304 + 64 * (j))
#define XB_TOP      3328
#define XB_TOPGEN   3392
#define XCD_BAR_WORDS 3456
#define XB_SPIN_CAP (1u << 18)

__device__ __forceinline__ unsigned xb_ld(unsigned* p)              { return __hip_atomic_load(p, __ATOMIC_RELAXED, __HIP_MEMORY_SCOPE_AGENT); }
__device__ __forceinline__ unsigned xb_add(unsigned* p, unsigned v) { return __hip_atomic_fetch_add(p, v, __ATOMIC_RELAXED, __HIP_MEMORY_SCOPE_AGENT); }
__device__ __forceinline__ unsigned xb_xcc_id() { return (unsigned)__builtin_amdgcn_s_getreg((3 << 11) | 20) & 0xFu; }
#define XB_SPIN(cond, bar) do { unsigned _sp = 0; while (cond) { __builtin_amdgcn_s_sleep(1); \
    if ((++_sp & 255u) == 0u) { if (xb_ld(&(bar)[XB_TMO])) break; if (_sp > XB_SPIN_CAP) { atomicAdd(&(bar)[XB_TMO], 1u); break; } } } } while (0)

struct XcdBarrier {
    unsigned* bar; unsigned x;
    volatile LAS unsigned* st;
};

__device__ __forceinline__ XcdBarrier xcd_barrier_post(unsigned* bar, volatile LAS unsigned* st) {
    XcdBarrier b; b.bar = bar; b.x = xb_xcc_id(); b.st = st;
    if (threadIdx.x == 0) (void)xb_add(&bar[XB_XCNT(b.x)], 1u);
    return b;
}
__device__ __forceinline__ void xcd_barrier_complete(unsigned* bar, unsigned x, unsigned& nloc, unsigned& nx) {
    const unsigned G = gridDim.x * gridDim.y * gridDim.z;
    unsigned sum, cnt, mine, sp = 0u;
    for (;;) {
        sum = 0u; cnt = 0u; mine = 0u;
#pragma unroll
        for (unsigned j = 0; j < 16; ++j) { const unsigned c = xb_ld(&bar[XB_XCNT(j)]); sum += c; cnt += (c > 0u) ? 1u : 0u; mine = (j == x) ? c : mine; }
        if (sum == G) break;
        __builtin_amdgcn_s_sleep(1);
        if ((++sp & 255u) == 0u) { if (xb_ld(&bar[XB_TMO])) break; if (sp > XB_SPIN_CAP) { atomicAdd(&bar[XB_TMO], 1u); break; } }
    }
    nloc = mine > 0u ? mine : 1u; nx = cnt > 0u ? cnt : 1u;
}

__device__ __forceinline__ void xcd_barrier(const XcdBarrier& b) {
    asm volatile("s_waitcnt vmcnt(0)" ::: "memory");
    __syncthreads();
    if (threadIdx.x == 0) {
        unsigned* bar = b.bar;
        __builtin_amdgcn_s_waitcnt(0);
        unsigned nloc = b.st[0], nx = b.st[1];
        if (nloc == 0u) { xcd_barrier_complete(bar, b.x, nloc, nx); b.st[0] = nloc; b.st[1] = nx; }
        const unsigned old = xb_add(&bar[XB_XSUB(b.x)], 1u);
        const unsigned gen = old / nloc;
        if (old + 1u == (gen + 1u) * nloc) {
            __builtin_amdgcn_fence(__ATOMIC_RELEASE, "agent");
            asm volatile("s_waitcnt vmcnt(0)" ::: "memory");
            const unsigned og = xb_add(&bar[XB_TOP], 1u);
            const unsigned tg = og / nx;
            if (og + 1u == (tg + 1u) * nx) xb_add(&bar[XB_TOPGEN], 1u);
            else XB_SPIN(xb_ld(&bar[XB_TOPGEN]) == tg, bar);
            __builtin_amdgcn_fence(__ATOMIC_ACQUIRE, "agent");
            xb_add(&bar[XB_XGEN(b.x)], 1u);
            asm volatile("s_waitcnt vmcnt(0)" ::: "memory");
        } else {
            XB_SPIN(xb_ld(&bar[XB_XGEN(b.x)]) == gen, bar);
            __builtin_amdgcn_fence(__ATOMIC_ACQUIRE, "agent");
            asm volatile("s_waitcnt vmcnt(0)" ::: "memory");
        }
    }
    __syncthreads();
}

struct Args { const float* in[31]; float* out; unsigned char* ws; int ph_lo, ph_hi; };
enum In { I_X = 0, I_C, I_CTX, I_CCTX, I_WADA, I_BADA, I_NORMG, I_FFNIN, I_FFNOUT, I_WIN, I_GMVN, I_GMWS, I_GMBS, I_CONV, I_W0, I_WUP, I_A0, I_AUP, I_GUP, I_KK, I_KA, I_RK, I_LNG, I_LNB,
          I_QN, I_KN, I_LAM, I_SUBLN, I_WBR, I_BGATE, I_WOUT };

__device__ __forceinline__ void ph_ada(const Args& a, LAS unsigned char* lds, int tid, int vcu, int G) {
    LAS float* sc = (LAS float*)lds;
    LAS float* red = sc + 3 * 2048;
    const float* c = a.in[I_C]; const float* cc = a.in[I_CCTX];
    for (int i = tid; i < 3 * 2048; i += NTHR) { const float x = i < 4096 ? c[i] : cc[i - 4096]; sc[i] = x * fsigm(x); }
    __syncthreads();
    const int lane = tid & 63, wave = tid >> 6;
    float* mods = (float*)(a.ws + WS_MODS);
    for (int u = vcu; u < 576; u += G) {
        const int l = u / 288, jc = u % 288, j = jc * 64 + lane;
        const float* W = a.in[I_WADA] + (size_t)l * 2048 * 18432 + j;
        float s0 = 0.f, s1 = 0.f, s2 = 0.f;
        const int k0 = wave * 256;
#pragma unroll 8
        for (int k = 0; k < 256; ++k) { const float w = W[(size_t)(k0 + k) * 18432]; s0 += sc[k0 + k] * w; s1 += sc[2048 + k0 + k] * w; s2 += sc[4096 + k0 + k] * w; }
        red[(wave * 3 + 0) * 64 + lane] = s0; red[(wave * 3 + 1) * 64 + lane] = s1; red[(wave * 3 + 2) * 64 + lane] = s2;
        __syncthreads();
        if (wave < 3) { float s = a.in[I_BADA][(size_t)l * 18432 + j];
#pragma unroll
            for (int w8 = 0; w8 < 8; ++w8) s += red[(w8 * 3 + wave) * 64 + lane];
            mods[(size_t)(l * 3 + wave) * 18432 + j] = s; }
        __syncthreads();
    }
}
__device__ __forceinline__ void transpose_item(const float* W, int N, int sc0, bf16* WT, int Kd, int nd0, int k0, LAS float* scr, int lane) {
    if (sc0 >= 0) {
#pragma unroll 8
        for (int i = 0; i < 32; ++i) { const int kk = 2 * i + (lane >> 5); scr[kk * 33 + (lane & 31)] = W[(size_t)(k0 + kk) * N + sc0 + (lane & 31)]; }
    } else {
#pragma unroll 8
        for (int i = 0; i < 32; ++i) { const int kk = 2 * i + (lane >> 5); scr[kk * 33 + (lane & 31)] = 0.f; }
    }
    asm volatile("s_waitcnt lgkmcnt(0)" ::: "memory");
    const int c = lane & 7;
#pragma unroll
    for (int j = 0; j < 4; ++j) { const int n = (lane >> 3) + 8 * j; const LAS float* s = scr + (8 * c) * 33 + n;
        v4u o; o.x = pk2(s[0 * 33], s[1 * 33]); o.y = pk2(s[2 * 33], s[3 * 33]); o.z = pk2(s[4 * 33], s[5 * 33]); o.w = pk2(s[6 * 33], s[7 * 33]);
        *(GAS v4u*)(WT + (size_t)(nd0 + n) * Kd + k0 + 8 * c) = o; }
    asm volatile("s_waitcnt lgkmcnt(0)" ::: "memory");
}
__device__ __forceinline__ void ph_weights(const Args& a, LAS unsigned char* lds, int tid, int vcu, int G) {
    const int lane = tid & 63, wave = tid >> 6;
    LAS float* scr = (LAS float*)(lds + wave * 16384);
    const int gw = vcu * NWAVES + wave, NGW = G * NWAVES;
    constexpr int I_F1 = 32 * (FF2 / 32), I_F2 = (FF / 64) * (DM / 32), I_IN = 32 * (PROJP / 32), I_BR = 16 * (DM / 32), I_WO = 32 * (DM / 32);
    constexpr int NITEMS = 4 * I_F1 + 4 * I_F2 + 2 * I_IN + 6 * I_BR + 2 * I_WO;
    unsigned char* ws = a.ws;
    for (int it = gw; it < NITEMS; it += NGW) {
        int r = it;
        if (r < 4 * I_F1) { const int mi = r / I_F1, q = r % I_F1, nb = q % (FF2 / 32), kb = q / (FF2 / 32), nd0 = 32 * nb, pn = nd0 >> 8, rr = nd0 & 255;
            const int sc0 = rr < 128 ? pn * 128 + rr : FF + pn * 128 + (rr - 128);
            transpose_item(a.in[I_FFNIN] + (size_t)mi * DM * FF2, FF2, sc0, (bf16*)(ws + WS_WF1 + (size_t)mi * SZ_WF1), DM, nd0, 64 * kb, scr, lane); continue; }
        r -= 4 * I_F1;
        if (r < 4 * I_F2) { const int mi = r / I_F2, q = r % I_F2, nb = q % (DM / 32), kb = q / (DM / 32);
            transpose_item(a.in[I_FFNOUT] + (size_t)mi * FF * DM, DM, 32 * nb, (bf16*)(ws + WS_WF2 + (size_t)mi * SZ_WF2), FF, 32 * nb, 64 * kb, scr, lane); continue; }
        r -= 4 * I_F2;
        if (r < 2 * I_IN) { const int mi = r / I_IN, q = r % I_IN, nb = q % (PROJP / 32), kb = q / (PROJP / 32), nd0 = 32 * nb;
            transpose_item(a.in[I_WIN] + (size_t)mi * DM * PROJ, PROJ, nd0 < PROJ ? nd0 : -1, (bf16*)(ws + WS_WIN + (size_t)mi * SZ_WIN), DM, nd0, 64 * kb, scr, lane); continue; }
        r -= 2 * I_IN;
        if (r < 6 * I_BR) { const int mi = r / I_BR, q = r % I_BR, nb = q % (DM / 32), kb = q / (DM / 32);
            transpose_item(a.in[I_WBR] + (size_t)mi * 1024 * DM, DM, 32 * nb, (bf16*)(ws + WS_WBR + (size_t)mi * ((size_t)DM * 1024 * 2)), 1024, 32 * nb, 64 * kb, scr, lane); continue; }
        r -= 6 * I_BR;
        { const int mi = r / I_WO, q = r % I_WO, nb = q % (DM / 32), kb = q / (DM / 32);
            transpose_item(a.in[I_WOUT] + (size_t)mi * DM * DM, DM, 32 * nb, (bf16*)(ws + WS_WOUT + (size_t)mi * SZ_WOUT), DM, 32 * nb, 64 * kb, scr, lane); }
    }
    const int gt = vcu * NTHR + tid, NGT = G * NTHR;
    for (int i = gt; i < NLAYER * LOW * (ACTW / 8); i += NGT) {
        const int l = i / (LOW * (ACTW / 8)), q = i % (LOW * (ACTW / 8)), n = q / (ACTW / 8), k0 = (q % (ACTW / 8)) * 8, sec = n >> 10, cc = n & 1023;
        float f[8];
#pragma unroll
        for (int e = 0; e < 8; ++e) { const int k = k0 + e; float v = 0.f;
            if (sec == 0) { if (k < 256) v = a.in[I_GUP][((size_t)l * 256 + k) * 1024 + cc]; }
            else if (sec <= 2) { const int d = sec - 1, kb = 256 + 128 * d; if (k >= kb && k < kb + 96) v = a.in[I_WUP][((size_t)(l * 2 + d) * 96 + (k - kb)) * 1024 + cc]; }
            else { const int d = sec - 3, kb = 512 + 128 * d; if (k >= kb && k < kb + 96) v = a.in[I_AUP][((size_t)(l * 2 + d) * 96 + (k - kb)) * 1024 + cc]; }
            f[e] = v; }
        *(GAS v4u*)((bf16*)(ws + WS_WLO) + ((size_t)l * LOW + n) * ACTW + k0) = pack8(f);
    }
    for (int i = gt; i < 64 * 16; i += NGT) { const int p = i >> 4, ii = i & 15;
        const float inv = exp2f(-(float)(2 * ii) * (1.f / 32.f) * 13.287712379549449f);
        const float rev = (float)p * inv * 0.15915494309189535f;
        float* rt = (float*)(ws + WS_ROPE) + 2 * i; rt[0] = __builtin_amdgcn_cosf(rev); rt[1] = __builtin_amdgcn_sinf(rev); }
}

__device__ __forceinline__ void ph_norm(const float* xl, const float* xc, const float* gain, const float* mods  , int si, bf16* XN, int gw, int NGW, int lane) {
    for (int m = gw; m < MT; m += NGW) {
        const float* xr = m < NLAT ? xl + (size_t)m * DM : xc + (size_t)(m - NLAT) * DM;
        const int set = m < TSEQ ? 0 : (m < NLAT ? 1 : 2);
        const float* sh = mods + (size_t)(set * NMOD + si) * DM; const float* scl = sh + DM;
        f32x4 v[8]; float ss = 0.f;
#pragma unroll
        for (int j = 0; j < 8; ++j) { v[j] = *(const GAS f32x4*)(xr + 4 * lane + 256 * j); ss += (v[j].x * v[j].x + v[j].y * v[j].y) + (v[j].z * v[j].z + v[j].w * v[j].w); }
        const float rinv = 1.f / sqrtf(wave_sum(ss) * (1.f / DM) + 1e-6f);
#pragma unroll
        for (int j = 0; j < 8; ++j) { const int col = 4 * lane + 256 * j;
            const f32x4 g = *(const GAS f32x4*)(gain + col), s1 = *(const GAS f32x4*)(scl + col), s0 = *(const GAS f32x4*)(sh + col);
            const f32x4 o = (v[j] * rinv * g) * (s1 + 1.f) + s0;
            v2u w; w.x = pk2(o.x, o.y); w.y = pk2(o.z, o.w);
            *(GAS v2u*)(XN + (size_t)m * DM + col) = w; }
    }
}

__device__ __forceinline__ void ph_e1(const Args& a, int l, int gt, int NGT) {
    unsigned char* ws = a.ws;
    const bf16* P = (const bf16*)(ws + WS_P);
    bf16* ACT = (bf16*)(ws + WS_ACT);
    for (int i = gt; i < MT * (ACTW / 8); i += NGT) {
        const int m = i / (ACTW / 8), c0 = (i % (ACTW / 8)) * 8;
        int src = -1, fn = 0;
        if (c0 < 256) { src = P_G + c0; fn = 1; }
        else if (c0 < 352) { src = P_W + (c0 - 256); fn = 2; }
        else if (c0 >= 384 && c0 < 480) { src = P_W + 96 + (c0 - 384); fn = 2; }
        else if (c0 >= 512 && c0 < 608) { src = P_A + (c0 - 512); }
        else if (c0 >= 640 && c0 < 736) { src = P_A + 96 + (c0 - 640); }
        float f[8];
        if (src >= 0) { unpack8(*(const GAS v4u*)(P + (size_t)m * PROJP + src), f);
#pragma unroll
            for (int e = 0; e < 8; ++e) f[e] = fn == 1 ? fsigm(f[e]) : (fn == 2 ? ftanh(f[e]) : f[e]); }
        else {
#pragma unroll
            for (int e = 0; e < 8; ++e) f[e] = 0.f; }
        *(GAS v4u*)(ACT + (size_t)m * ACTW + c0) = pack8(f);
    }
    bf16* QK = (bf16*)(ws + WS_QK);
    const float* rope = (const float*)(ws + WS_ROPE);
    for (int i = gt; i < MT * 32; i += NGT) {
        const int m = i >> 5, gi = i & 31; const bool isq = gi < 16;
        const float* gain = a.in[isq ? I_QN : I_KN] + l * 64;
        const bf16* src = P + (size_t)m * PROJP + P_QKV + gi * 64;
        float y[64]; float ss = 0.f;
#pragma unroll
        for (int j = 0; j < 8; ++j) { float f[8]; unpack8(*(const GAS v4u*)(src + 8 * j), f);
#pragma unroll
            for (int e = 0; e < 8; ++e) { y[8 * j + e] = f[e]; ss += f[e] * f[e]; } }
        const float rinv = 1.f / sqrtf(ss * (1.f / 64.f) + 1e-6f);
#pragma unroll
        for (int d = 0; d < 64; ++d) y[d] = y[d] * rinv * gain[d];
        if (m < NLAT) { const int t = m & (TSEQ - 1), pr = t >> 6, pc = t & 63;
#pragma unroll
            for (int ii = 0; ii < 16; ++ii) {
                const float c1 = rope[(pr * 16 + ii) * 2], s1 = rope[(pr * 16 + ii) * 2 + 1], c2 = rope[(pc * 16 + ii) * 2], s2 = rope[(pc * 16 + ii) * 2 + 1];
                const float a1 = y[ii], a2 = y[16 + ii], b1 = y[32 + ii], b2 = y[48 + ii];
                y[ii] = a1 * c1 - a2 * s1; y[16 + ii] = a2 * c1 + a1 * s1; y[32 + ii] = b1 * c2 - b2 * s2; y[48 + ii] = b2 * c2 + b1 * s2; } }
        const float qs = isq ? 0.18033688011112042f : 1.f;
        bf16* dst = QK + (size_t)m * DM + gi * 64;
#pragma unroll
        for (int j = 0; j < 8; ++j) { float f[8];
#pragma unroll
            for (int e = 0; e < 8; ++e) f[e] = y[8 * j + e] * qs;
            *(GAS v4u*)(dst + 8 * j) = pack8(f); }
    }
    bf16* RK = (bf16*)(ws + WS_RKVK);
    const float* cw = a.in[I_CONV] + (size_t)l * 3 * 3072; const float* kkw = a.in[I_KK] + l * 1024;
    for (int i = gt; i < MT * 128; i += NGT) {
        const int m = i >> 7, c0 = (i & 127) * 8;
        const int t = m < NLAT ? (m & (TSEQ - 1)) : ((m - NLAT) & (TCTX - 1)), tl = m < NLAT ? TSEQ : TCTX;
        const bool hp = t > 0, hn = t < tl - 1;
        float kv[8];
#pragma unroll
        for (int sec = 0; sec < 3; ++sec) {
            const int col = sec * 1024 + c0; const bf16* pc = P + (size_t)m * PROJP + P_RKV + col;
            float x0[8], x1[8], x2[8], o[8];
            unpack8(*(const GAS v4u*)pc, x1);
            if (hp) unpack8(*(const GAS v4u*)(pc - PROJP), x0);
            if (hn) unpack8(*(const GAS v4u*)(pc + PROJP), x2);
#pragma unroll
            for (int e = 0; e < 8; ++e) { float v = x1[e] * cw[3072 + col + e]; if (hp) v += x0[e] * cw[col + e]; if (hn) v += x2[e] * cw[2 * 3072 + col + e]; o[e] = v; if (sec == 1) kv[e] = v; }
            *(GAS v4u*)(RK + (size_t)m * 4096 + col) = pack8(o);
        }
        float ss = 0.f;
#pragma unroll
        for (int e = 0; e < 8; ++e) { kv[e] *= kkw[c0 + e]; ss += kv[e] * kv[e]; }
        ss += __shfl_xor(ss, 1); ss += __shfl_xor(ss, 2); ss += __shfl_xor(ss, 4);
        const float rinv = 1.f / sqrtf(ss + 1e-12f);
#pragma unroll
        for (int e = 0; e < 8; ++e) kv[e] *= rinv;
        *(GAS v4u*)(RK + (size_t)m * 4096 + 3072 + c0) = pack8(kv);
    }
}

__device__ __forceinline__ void ph_gmlp(const Args& a, int l, LAS unsigned char* lds, int tid, int vcu, int G) {
    constexpr int VP = 136;
    LAS bf16* vnT = (LAS bf16*)lds;
    const bf16* P = (const bf16*)(a.ws + WS_P); bf16* YA = (bf16*)(a.ws + WS_Y3);
    const float* vng = a.in[I_GMVN] + l * 1024; const float* wsm = a.in[I_GMWS] + (size_t)l * 8 * 128 * 128; const float* bs = a.in[I_GMBS] + l * 8 * 128;
    const int lane = tid & 63, w = tid >> 6, fr = lane & 15, fq = lane >> 4;
    for (int u = vcu; u < (MT / 128) * 8; u += G) {
        const int n = u >> 3, g = u & 7, m0 = n * 128;
        { const int q = tid >> 2, qt = tid & 3; const bf16* src = P + (size_t)(m0 + q) * PROJP + P_V + g * 128 + qt * 32;
            float v[32]; float ss = 0.f;
#pragma unroll
            for (int j = 0; j < 4; ++j) { float f[8]; unpack8(*(const GAS v4u*)(src + 8 * j), f);
#pragma unroll
                for (int e = 0; e < 8; ++e) { const float x = gelu_t(f[e]); v[8 * j + e] = x; ss += x * x; } }
            ss += __shfl_xor(ss, 1); ss += __shfl_xor(ss, 2);
            const float rinv = 1.f / sqrtf(ss * (1.f / 128.f) + 1e-6f);
#pragma unroll
            for (int e = 0; e < 32; ++e) { const int c = qt * 32 + e; vnT[c * VP + q] = (bf16)f2bf(v[e] * rinv * vng[g * 128 + c]); } }
        __syncthreads();
        pg8::f32x4 acc[8];
#pragma unroll
        for (int cb = 0; cb < 8; ++cb) acc[cb] = (pg8::f32x4){0.f, 0.f, 0.f, 0.f};
#pragma unroll
        for (int ks = 0; ks < 4; ++ks) {
            const float* wr = wsm + ((size_t)g * 128 + 16 * w + fr) * 128 + ks * 32 + 8 * fq;
            const f32x4 w0 = *(const GAS f32x4*)wr, w1 = *(const GAS f32x4*)(wr + 4);
            v4u aw; aw.x = pk2(w0.x, w0.y); aw.y = pk2(w0.z, w0.w); aw.z = pk2(w1.x, w1.y); aw.w = pk2(w1.z, w1.w);
            const bf16x8 af = __builtin_bit_cast(bf16x8, aw);
#pragma unroll
            for (int cb = 0; cb < 8; ++cb) { const bf16x8 bfr = *(const LAS bf16x8*)(vnT + (cb * 16 + fr) * VP + ks * 32 + 8 * fq);
                acc[cb] = __builtin_amdgcn_mfma_f32_16x16x32_bf16(af, bfr, acc[cb], 0, 0, 0); }
        }
#pragma unroll
        for (int cb = 0; cb < 8; ++cb)
#pragma unroll
            for (int i = 0; i < 4; ++i) { const int p = 16 * w + 4 * fq + i, c = cb * 16 + fr;
                const float pu = bf1(P[(size_t)(m0 + p) * PROJP + P_U + g * 128 + c]);
                YA[(size_t)(m0 + p) * 1024 + g * 128 + c] = (bf16)f2bf(gelu_t(pu) * (acc[cb][i] + bs[g * 128 + p])); }
        __syncthreads();
    }
}

namespace att {
using bf16x8 = __attribute__((ext_vector_type(8))) short;
using s16x4  = __attribute__((ext_vector_type(4))) short;
using f32x16 = __attribute__((ext_vector_type(16))) float;
using u32x4  = __attribute__((ext_vector_type(4))) unsigned;
constexpr int NW = 8, QBLK = 32, KVBLK = 64;
constexpr float THRL = 11.5f;
constexpr int SHM_V = KVBLK * 128 * 2, SHM_K = KVBLK * 64 * 2, SHM_ATTN = 2 * SHM_V + 2 * SHM_K + NW * 64 * 4;
#define KSWZ(row, colB) ((row) * 128 + ((colB) ^ ((((row) >> 1) & 7) << 4)))
#define SBAR() __builtin_amdgcn_sched_barrier(0)
__device__ __forceinline__ int crow(int r, int hi) { return (r & 3) + 8 * (r >> 2) + 4 * hi; }
__device__ __forceinline__ unsigned cvtpk(float lo, float hi) { unsigned r; asm volatile("v_cvt_pk_bf16_f32 %0, %1, %2" : "=v"(r) : "v"(lo), "v"(hi)); return r; }
__device__ __forceinline__ void partialSM(f32x16& p0, f32x16& p1, float& m_reg, float& mn, float& alpha) {
  float pmax = p0[0];
#pragma unroll
  for (int r = 1; r < 16; ++r) pmax = fmaxf(pmax, p0[r]);
#pragma unroll
  for (int r = 0; r < 16; ++r) pmax = fmaxf(pmax, p1[r]);
  { auto rr = __builtin_amdgcn_permlane32_swap(__float_as_uint(pmax), __float_as_uint(pmax), false, false);
    pmax = fmaxf(__uint_as_float(rr[0]), __uint_as_float(rr[1])); }
  if (__builtin_expect(__all(pmax - m_reg <= THRL), 1)) { mn = m_reg; alpha = 1.f; }
  else { mn = fmaxf(m_reg, pmax); alpha = __builtin_amdgcn_exp2f(m_reg - mn); m_reg = mn; }
#pragma unroll
  for (int r = 0; r < 16; ++r) p0[r] = p0[r] - mn;
#pragma unroll
  for (int r = 0; r < 16; ++r) p1[r] = p1[r] - mn;
#pragma unroll
  for (int r = 0; r < 16; ++r) p0[r] = __builtin_amdgcn_exp2f(p0[r]);
}
__device__ __forceinline__ void finishSM(f32x16& p0, f32x16& p1, float alpha, float& l_reg, bf16x8& pa0, bf16x8& pa1, bf16x8& pa2, bf16x8& pa3) {
#pragma unroll
  for (int r = 0; r < 16; ++r) p1[r] = __builtin_amdgcn_exp2f(p1[r]);
  float ps = 0;
#pragma unroll
  for (int r = 0; r < 16; ++r) ps += p0[r];
#pragma unroll
  for (int r = 0; r < 16; ++r) ps += p1[r];
  { auto rr = __builtin_amdgcn_permlane32_swap(__float_as_uint(ps), __float_as_uint(ps), false, false);
    ps = __uint_as_float(rr[0]) + __uint_as_float(rr[1]); }
  l_reg = l_reg * alpha + ps;
#define PK4(P, BASE, OUT) do { unsigned a0 = cvtpk(P[BASE + 0], P[BASE + 1]), a1 = cvtpk(P[BASE + 2], P[BASE + 3]);   \
    unsigned b0 = cvtpk(P[BASE + 4], P[BASE + 5]), b1 = cvtpk(P[BASE + 6], P[BASE + 7]);                              \
    auto r0 = __builtin_amdgcn_permlane32_swap(a0, b0, false, false); auto r1 = __builtin_amdgcn_permlane32_swap(a1, b1, false, false); \
    u32x4 w = {r0[0], r1[0], r0[1], r1[1]}; OUT = *reinterpret_cast<bf16x8*>(&w); } while (0)
  PK4(p0, 0, pa0); PK4(p0, 8, pa1); PK4(p1, 0, pa2); PK4(p1, 8, pa3);
#undef PK4
}
__device__ __forceinline__ void qkt(f32x16& p0, f32x16& p1, const unsigned short* Ks, const bf16x8* qr, int r32, int hi) {
  p0 = f32x16{}; p1 = f32x16{};
#pragma unroll
  for (int d0 = 0; d0 < 4; ++d0) { int cb = (d0 * 16 + hi * 8) * 2;
    bf16x8 b0 = *reinterpret_cast<const bf16x8*>((const char*)Ks + KSWZ(r32, cb));
    bf16x8 b1 = *reinterpret_cast<const bf16x8*>((const char*)Ks + KSWZ(32 + r32, cb));
    p0 = __builtin_amdgcn_mfma_f32_32x32x16_bf16(b0, qr[d0], p0, 0, 0, 0);
    p1 = __builtin_amdgcn_mfma_f32_32x32x16_bf16(b1, qr[d0], p1, 0, 0, 0); }
}
__device__ __forceinline__ int v_st(int k, int c) { const int kk = (k & ~0xC) | ((k & 4) << 1) | ((k & 8) >> 1); return ((kk >> 3) * 4 + (c >> 5)) * 512 + ((kk & 7) * 32 + (c & 31)) * 2; }
__device__ __forceinline__ int v_rd_base(int lane) { return ((lane & 3) << 3) | (((lane >> 2) & 3) << 6) | (((lane >> 4) & 1) << 5) | (((lane >> 5) & 1) << 8); }
constexpr int v_rd_off(int d0, int ks, int half) { return d0 * 512 + ks * 4096 + half * 2048; }
template <int OFF> __device__ __forceinline__ s16x4 tr_read(int vb) {
  s16x4 r; asm volatile("ds_read_b64_tr_b16 %0, %1 offset:%2" : "=&v"(r) : "v"(vb), "i"(OFF) : "memory"); return r;
}
template <int D0> __device__ __forceinline__ void pv_one(f32x16& od, int vb, bf16x8 pa0, bf16x8 pa1, bf16x8 pa2, bf16x8 pa3) {
  const s16x4 l0 = tr_read<v_rd_off(D0, 0, 0)>(vb), h0 = tr_read<v_rd_off(D0, 0, 1)>(vb), l1 = tr_read<v_rd_off(D0, 1, 0)>(vb), h1 = tr_read<v_rd_off(D0, 1, 1)>(vb);
  const s16x4 l2 = tr_read<v_rd_off(D0, 2, 0)>(vb), h2 = tr_read<v_rd_off(D0, 2, 1)>(vb), l3 = tr_read<v_rd_off(D0, 3, 0)>(vb), h3 = tr_read<v_rd_off(D0, 3, 1)>(vb);
  asm volatile("s_waitcnt lgkmcnt(0)" ::: "memory"); SBAR();
#define PK(L, H) (bf16x8){L[0], L[1], L[2], L[3], H[0], H[1], H[2], H[3]}
  od = __builtin_amdgcn_mfma_f32_32x32x16_bf16(pa0, PK(l0, h0), od, 0, 0, 0);
  od = __builtin_amdgcn_mfma_f32_32x32x16_bf16(pa1, PK(l1, h1), od, 0, 0, 0);
  od = __builtin_amdgcn_mfma_f32_32x32x16_bf16(pa2, PK(l2, h2), od, 0, 0, 0);
  od = __builtin_amdgcn_mfma_f32_32x32x16_bf16(pa3, PK(l3, h3), od, 0, 0, 0);
#undef PK
}
__device__ __forceinline__ void pv_d0(f32x16* o, int vb, bf16x8 pa0, bf16x8 pa1, bf16x8 pa2, bf16x8 pa3) {
  pv_one<0>(o[0], vb, pa0, pa1, pa2, pa3); pv_one<1>(o[1], vb, pa0, pa1, pa2, pa3); pv_one<2>(o[2], vb, pa0, pa1, pa2, pa3); pv_one<3>(o[3], vb, pa0, pa1, pa2, pa3);
}
__device__ __forceinline__ void attn_unit(const unsigned short* __restrict__ Qb, const unsigned short* __restrict__ Kb, const unsigned short* __restrict__ Vb,
                                          float* __restrict__ Ob, int NT, int ntl, int klat, int kctx, char* lds) {
  constexpr int LDQ = 2048, LDKK = 2048, LDV = 15104, LDO = 1024;
  const int tid = threadIdx.x, wid = tid >> 6, lane = tid & 63, r32 = lane & 31, hi = lane >> 5;
  unsigned short* V_lds = (unsigned short*)lds; unsigned short* K_lds = (unsigned short*)(lds + 2 * SHM_V);
  float* ws = (float*)(lds + 2 * SHM_V + 2 * SHM_K) + wid * 64; float* li_l = ws; float* al_l = ws + 32;
  float m_reg = -1e30f, l_reg = 0; f32x16 o[4] = {}; bf16x8 qr[4];
  const unsigned short* Qw = Qb + (long)(wid * QBLK + r32) * LDQ + hi * 8;
#pragma unroll
  for (int d0 = 0; d0 < 4; ++d0) qr[d0] = *reinterpret_cast<const bf16x8*>(Qw + d0 * 16);
  const int sr = tid >> 4, sc = (tid & 15) * 8, vst0 = v_st(sr, sc), vst1 = v_st(32 + sr, sc);
  const int kr = tid >> 3, kc = (tid & 7) * 8, kst = KSWZ(kr, kc * 2);
  const int vb0 = (int)(uintptr_t)V_lds + v_rd_base(lane);
  struct { bf16x8 vs0, vs1, ks0; } sr_[2];
#define KROW(t) ((t) < ntl ? klat + 64 * (t) : kctx + 64 * ((t) - ntl))
#define SLOAD(i, t) do { const long k0_ = KROW(t); sr_[i].vs0 = *reinterpret_cast<const bf16x8*>(&Vb[(k0_ + sr) * LDV + sc]); sr_[i].vs1 = *reinterpret_cast<const bf16x8*>(&Vb[(k0_ + 32 + sr) * LDV + sc]); \
    sr_[i].ks0 = *reinterpret_cast<const bf16x8*>(&Kb[(k0_ + kr) * LDKK + kc]); } while (0)
#define SWRITE(b, i) do { *(bf16x8*)((char*)V_lds + (b) * SHM_V + vst0) = sr_[i].vs0; *(bf16x8*)((char*)V_lds + (b) * SHM_V + vst1) = sr_[i].vs1; \
    *(bf16x8*)((char*)K_lds + (b) * SHM_K + kst) = sr_[i].ks0; } while (0)
#define SWAIT() asm volatile("s_waitcnt vmcnt(3)" ::: "memory")
#define RESC(a) do { if (__any((a) < 1.f)) { if (hi == 0) al_l[r32] = (a); asm volatile("s_waitcnt lgkmcnt(0)" ::: "memory"); \
    _Pragma("unroll") for (int d = 0; d < 4; ++d) _Pragma("unroll") for (int r = 0; r < 16; ++r) o[d][r] *= al_l[crow(r, hi)]; } } while (0)
  f32x16 pA0, pA1, pB0, pB1; float mnA, mnB, alA, alB; bf16x8 pa0, pa1, pa2, pa3;
  constexpr int SE = 0, SO = 1;
  SLOAD(SE, 0); asm volatile("s_waitcnt vmcnt(0)" ::: "memory"); SWRITE(0, SE); __syncthreads();
  qkt(pA0, pA1, K_lds, qr, r32, hi); partialSM(pA0, pA1, m_reg, mnA, alA);
  SLOAD(SO, 1); if (2 < NT) SLOAD(SE, 2);
  SWAIT(); SWRITE(1, SO); __syncthreads();
  for (int j = 1; j + 1 < NT; j += 2) {
    SBAR(); qkt(pB0, pB1, (const unsigned short*)((char*)K_lds + SHM_K), qr, r32, hi);
    finishSM(pA0, pA1, alA, l_reg, pa0, pa1, pa2, pa3); SBAR();
    SLOAD(SO, j + 2); SBAR();
    pv_d0(o, vb0, pa0, pa1, pa2, pa3); partialSM(pB0, pB1, m_reg, mnB, alB);
    __syncthreads(); SWAIT(); SWRITE(0, SE);
    RESC(alB); __syncthreads();
    SBAR(); qkt(pA0, pA1, K_lds, qr, r32, hi);
    finishSM(pB0, pB1, alB, l_reg, pa0, pa1, pa2, pa3); SBAR();
    if (j + 3 < NT) SLOAD(SE, j + 3); SBAR();
    pv_d0(o, vb0 + (int)SHM_V, pa0, pa1, pa2, pa3); partialSM(pA0, pA1, m_reg, mnA, alA);
    __syncthreads(); SWAIT(); SWRITE(1, SO);
    RESC(alA); __syncthreads();
  }
  SBAR(); qkt(pB0, pB1, (const unsigned short*)((char*)K_lds + SHM_K), qr, r32, hi);
  finishSM(pA0, pA1, alA, l_reg, pa0, pa1, pa2, pa3); SBAR();
  pv_d0(o, vb0, pa0, pa1, pa2, pa3); partialSM(pB0, pB1, m_reg, mnB, alB);
  __syncthreads(); RESC(alB);
  finishSM(pB0, pB1, alB, l_reg, pa0, pa1, pa2, pa3); SBAR();
  pv_d0(o, vb0 + (int)SHM_V, pa0, pa1, pa2, pa3);
  if (hi == 0) li_l[r32] = l_reg; asm volatile("s_waitcnt lgkmcnt(0)" ::: "memory");
  float rli[16];
#pragma unroll
  for (int r = 0; r < 16; ++r) rli[r] = __builtin_amdgcn_rcpf(li_l[crow(r, hi)]);
  float* Ow = Ob + (long)(wid * QBLK) * LDO;
#pragma unroll
  for (int r = 0; r < 16; ++r) { int orow = crow(r, hi);
#pragma unroll
    for (int d0 = 0; d0 < 4; ++d0) Ow[(long)orow * LDO + d0 * 32 + r32] = o[d0][r] * rli[r]; }
  __syncthreads();
#undef KROW
#undef SLOAD
#undef SWRITE
#undef SWAIT
#undef RESC
}
#undef KSWZ
#undef SBAR
}

__device__ __forceinline__ void ph_attn(const Args& a, bool ctx_out, char* lds, int widx, int wstride) {
    const unsigned short* QK = (const unsigned short*)(a.ws + WS_QK); const unsigned short* P = (const unsigned short*)(a.ws + WS_P); float* OJ = (float*)(a.ws + WS_OJ);
    const int nunits = ctx_out ? 544 : 512;
    for (int u = widx; u < nunits; u += wstride) {
        int b, hj, qrow0, NT, ntl;
        if (u < 512) { b = u >> 8; hj = (u >> 4) & 15; qrow0 = b * TSEQ + (u & 15) * 256; NT = 68; ntl = 64; }
        else { const int uu = u - 512; b = uu >> 4; hj = uu & 15; qrow0 = NLAT + b * TCTX; NT = 4; ntl = 0; }
        att::attn_unit(QK + (size_t)qrow0 * DM + hj * 64, QK + 1024 + hj * 64, P + P_QKV + 2048 + (hj >> 1) * 128,
                       OJ + ((size_t)(hj & 1) * MT + qrow0) * 1024 + (hj >> 1) * 128, NT, ntl, b * TSEQ, NLAT + b * TCTX, lds);
    }
}

constexpr int SC_STEP = 1280, SC_BLK = 32, SC_BUF = SC_BLK * SC_STEP, SC_Y = 2 * SC_BUF, SC_LDS = SC_Y + 2 * SC_BLK * 64 * 4;
__device__ __forceinline__ int scan_row(int i, int b, int d) { return i < TCTX ? NLAT + b * TCTX + (d ? TCTX - 1 - i : i) : b * TSEQ + (d ? TSEQ - 1 - (i - TCTX) : (i - TCTX)); }
#define SC_UPD(N) "v_mul_f32_dpp %" #N ", %16, %" #N " row_newbcast:" #N " row_mask:0xf bank_mask:0xf\n\tv_fmac_f32_dpp %" #N ", %17, %19 row_newbcast:" #N " row_mask:0xf bank_mask:0xf\n\tv_fmac_f32_dpp %" #N ", %18, %20 row_newbcast:" #N " row_mask:0xf bank_mask:0xf\n\t"
__device__ __forceinline__ void scan_fill(const float* LO, const bf16* RK, const float* ka, LAS unsigned char* buf, int blk, int b, int h, int d, int hw, int lane) {
    const int ch = h * 64 + lane; const float kav = ka[ch];
    constexpr int NQ = SC_BLK / 4;
    float wv[NQ], av[NQ]; bf16 rb[NQ], kb[NQ], vb[NQ], kkb[NQ], kkn[NQ];
#pragma unroll
    for (int q = 0; q < NQ; ++q) {
        const int st = hw + 4 * q, i = blk * SC_BLK + st, m = scan_row(i, b, d), mn = (i + 1 < TCTX + TSEQ) ? scan_row(i + 1, b, d) : m;
        const GAS float* lo = (const GAS float*)(LO + (size_t)m * LOW + d * 1024 + ch); const GAS bf16* rk = (const GAS bf16*)(RK + (size_t)m * 4096 + ch);
        wv[q] = lo[1024]; av[q] = lo[3072]; rb[q] = rk[0]; kb[q] = rk[1024]; vb[q] = rk[2048]; kkb[q] = rk[3072]; kkn[q] = *(const GAS bf16*)(RK + (size_t)mn * 4096 + 3072 + ch);
    }
    asm volatile("" ::: "memory");
#pragma unroll
    for (int q = 0; q < NQ; ++q) {
        LAS unsigned char* o = buf + (hw + 4 * q) * SC_STEP;
        ((LAS float*)o)[lane] = wv[q]; ((LAS float*)(o + 256))[lane] = bf1(kb[q]) * (1.f + (av[q] - 1.f) * kav); ((LAS float*)(o + 512))[lane] = bf1(kkb[q]) * av[q]; ((LAS float*)(o + 768))[lane] = bf1(vb[q]);
        ((LAS bf16*)(o + 1024))[lane] = kkn[q]; ((LAS bf16*)(o + 1152))[lane] = rb[q];
    }
}
__device__ __forceinline__ void scan_unit(const Args& a, int l, int u, LAS unsigned char* lds, int tid) {
    const float* LO = (const float*)(a.ws + WS_R1); const bf16* RK = (const bf16*)(a.ws + WS_RKVK); float* YS = (float*)(a.ws + WS_YS);
    const float* ka = a.in[I_KA] + l * 1024;
    const int lane = tid & 63, w = __builtin_amdgcn_readfirstlane(tid >> 6), fr = lane & 15, fq = lane >> 4;
    const int b = u >> 5, h = (u >> 1) & 15, d = u & 1;
    constexpr int NBLK = (TCTX + TSEQ) / SC_BLK;
    float s0 = 0.f, s1 = 0.f, s2 = 0.f, s3 = 0.f, s4 = 0.f, s5 = 0.f, s6 = 0.f, s7 = 0.f, s8 = 0.f, s9 = 0.f, s10 = 0.f, s11 = 0.f, s12 = 0.f, s13 = 0.f, s14 = 0.f, s15 = 0.f, sa = 0.f;
    if (w >= 4) scan_fill(LO, RK, ka, lds, 0, b, h, d, w - 4, lane);
    __syncthreads();
    for (int blk = 0; blk < NBLK; ++blk) {
        LAS unsigned char* buf = lds + (blk & 1) * SC_BUF;
        LAS float* yb = (LAS float*)(lds + SC_Y) + (blk & 1) * SC_BLK * 64;
        if (w < 4) {
            const int aoff = 1024 + ((fr & 2) ? 128 : 0) + 32 * fq;
            float W = ((LAS float*)buf)[lane], KD = ((LAS float*)(buf + 256))[lane], B = ((LAS float*)(buf + 512))[lane], vv = ((LAS float*)(buf + 768))[16 * w + fr];
            bf16x8 A0 = *(const LAS bf16x8*)(buf + aoff), A1 = *(const LAS bf16x8*)(buf + aoff + 16);
#pragma unroll 2
            for (int st = 0; st < SC_BLK; ++st) {
                const float cW = W, cKD = KD, cB = B, cvv = vv, nsa = -sa; const bf16x8 cA0 = A0, cA1 = A1;
                if (st + 1 < SC_BLK) { LAS unsigned char* nb = buf + (st + 1) * SC_STEP;
                    W = ((LAS float*)nb)[lane]; KD = ((LAS float*)(nb + 256))[lane]; B = ((LAS float*)(nb + 512))[lane]; vv = ((LAS float*)(nb + 768))[16 * w + fr];
                    A0 = *(const LAS bf16x8*)(nb + aoff); A1 = *(const LAS bf16x8*)(nb + aoff + 16); }
                asm volatile("s_nop 4\n\t" SC_UPD(0) SC_UPD(1) SC_UPD(2) SC_UPD(3) SC_UPD(4) SC_UPD(5) SC_UPD(6) SC_UPD(7) SC_UPD(8) SC_UPD(9) SC_UPD(10) SC_UPD(11) SC_UPD(12) SC_UPD(13) SC_UPD(14) SC_UPD(15)
                             : "+v"(s0), "+v"(s1), "+v"(s2), "+v"(s3), "+v"(s4), "+v"(s5), "+v"(s6), "+v"(s7), "+v"(s8), "+v"(s9), "+v"(s10), "+v"(s11), "+v"(s12), "+v"(s13), "+v"(s14), "+v"(s15)
                             : "v"(cW), "v"(cKD), "v"(cB), "v"(cvv), "v"(nsa));
                v4u p0, p1;
                p0.x = pg8::cvt_pk_bf16(s0, s1); p0.y = pg8::cvt_pk_bf16(s2, s3); p0.z = pg8::cvt_pk_bf16(s4, s5); p0.w = pg8::cvt_pk_bf16(s6, s7);
                p1.x = pg8::cvt_pk_bf16(s8, s9); p1.y = pg8::cvt_pk_bf16(s10, s11); p1.z = pg8::cvt_pk_bf16(s12, s13); p1.w = pg8::cvt_pk_bf16(s14, s15);
                pg8::f32x4 acc = (pg8::f32x4){0.f, 0.f, 0.f, 0.f};
                acc = __builtin_amdgcn_mfma_f32_16x16x32_bf16(cA0, __builtin_bit_cast(bf16x8, p0), acc, 0, 0, 0);
                acc = __builtin_amdgcn_mfma_f32_16x16x32_bf16(cA1, __builtin_bit_cast(bf16x8, p1), acc, 0, 0, 0);
                sa = acc[0];
                yb[st * 64 + 16 * w + fr] = acc[2];
            }
        } else {
            const int hw = w - 4;
            if (blk > 0) { const LAS float* ypb = (const LAS float*)(lds + SC_Y) + ((blk - 1) & 1) * SC_BLK * 64;
#pragma unroll
                for (int q = 0; q < SC_BLK / 4; ++q) { const int st = hw + 4 * q, m = scan_row((blk - 1) * SC_BLK + st, b, d); YS[((size_t)d * MT + m) * 1024 + h * 64 + lane] = ypb[st * 64 + lane]; } }
            if (blk + 1 < NBLK) scan_fill(LO, RK, ka, lds + ((blk + 1) & 1) * SC_BUF, blk + 1, b, h, d, hw, lane);
        }
        __syncthreads();
    }
    if (w >= 4) { const int hw = w - 4; const LAS float* ypb = (const LAS float*)(lds + SC_Y) + ((NBLK - 1) & 1) * SC_BLK * 64;
#pragma unroll
        for (int q = 0; q < SC_BLK / 4; ++q) { const int st = hw + 4 * q, m = scan_row((NBLK - 1) * SC_BLK + st, b, d); YS[((size_t)d * MT + m) * 1024 + h * 64 + lane] = ypb[st * 64 + lane]; } }
    __syncthreads();
}

__device__ __forceinline__ void ph_rwkv_out(const Args& a, int l, int gt, int NGT) {
    const float* OJ = (const float*)(a.ws + WS_OJ); bf16* YC = (bf16*)(a.ws + WS_Y3) + (size_t)2 * MT * 1024;
    const float* subln = a.in[I_SUBLN] + l * 128;
    float lam, lam_init;
    { const int lane = threadIdx.x & 63; const float* lv = a.in[I_LAM] + l * 256;
      float l1 = lv[lane] * lv[64 + lane], l2 = lv[128 + lane] * lv[192 + lane]; l1 = wave_sum(l1); l2 = wave_sum(l2);
      lam_init = 0.8f - 0.6f * __expf(-0.3f * (float)l); lam = __expf(l1) - __expf(l2) + lam_init; }
    const float* LO = (const float*)(a.ws + WS_R1); const bf16* RK = (const bf16*)(a.ws + WS_RKVK); const float* YS = (const float*)(a.ws + WS_YS);
    bf16* YB = (bf16*)(a.ws + WS_Y3) + (size_t)MT * 1024;
    const float* ka = a.in[I_KA] + l * 1024; const float* rkw = a.in[I_RK] + l * 1024; const float* lng = a.in[I_LNG] + l * 1024; const float* lnb = a.in[I_LNB] + l * 1024;
    for (int i = gt; i < MT * 128; i += NGT) {
        const int m = i >> 7, c0 = (i & 127) * 8;
        float y[8]; float s1 = 0.f;
        { const f32x4 a0 = *(const GAS f32x4*)(YS + (size_t)m * 1024 + c0), a1 = *(const GAS f32x4*)(YS + (size_t)m * 1024 + c0 + 4),
                      b0 = *(const GAS f32x4*)(YS + ((size_t)MT + m) * 1024 + c0), b1 = *(const GAS f32x4*)(YS + ((size_t)MT + m) * 1024 + c0 + 4);
            y[0] = a0.x + b0.x; y[1] = a0.y + b0.y; y[2] = a0.z + b0.z; y[3] = a0.w + b0.w; y[4] = a1.x + b1.x; y[5] = a1.y + b1.y; y[6] = a1.z + b1.z; y[7] = a1.w + b1.w; }
#pragma unroll
        for (int e = 0; e < 8; ++e) s1 += y[e];
        s1 += __shfl_xor(s1, 1); s1 += __shfl_xor(s1, 2); s1 += __shfl_xor(s1, 4);
        const float mu = s1 * (1.f / 64.f); float s2 = 0.f;
#pragma unroll
        for (int e = 0; e < 8; ++e) { y[e] -= mu; s2 += y[e] * y[e]; }
        s2 += __shfl_xor(s2, 1); s2 += __shfl_xor(s2, 2); s2 += __shfl_xor(s2, 4);
        const float rstd = 1.f / sqrtf(s2 * (1.f / 64.f) + 64e-5f);
        float r[8], k[8], v[8];
        unpack8(*(const GAS v4u*)(RK + (size_t)m * 4096 + c0), r); unpack8(*(const GAS v4u*)(RK + (size_t)m * 4096 + 1024 + c0), k); unpack8(*(const GAS v4u*)(RK + (size_t)m * 4096 + 2048 + c0), v);
        float rk = 0.f;
#pragma unroll
        for (int e = 0; e < 8; ++e) { const int c = c0 + e; const float am = 0.5f * (LO[(size_t)m * LOW + 3072 + c] + LO[(size_t)m * LOW + 4096 + c]);
            rk += r[e] * (k[e] * (1.f + (am - 1.f) * ka[c])) * rkw[c]; }
        rk += __shfl_xor(rk, 1); rk += __shfl_xor(rk, 2); rk += __shfl_xor(rk, 4);
        float o[8];
#pragma unroll
        for (int e = 0; e < 8; ++e) { const int c = c0 + e; o[e] = (y[e] * rstd * lng[c] + lnb[c] + rk * v[e]) * LO[(size_t)m * LOW + c]; }
        *(GAS v4u*)(YB + (size_t)m * 1024 + c0) = pack8(o);
        { const f32x4 p0 = *(const GAS f32x4*)(OJ + (size_t)m * 1024 + c0), p1 = *(const GAS f32x4*)(OJ + (size_t)m * 1024 + c0 + 4),
                      q0 = *(const GAS f32x4*)(OJ + ((size_t)MT + m) * 1024 + c0), q1 = *(const GAS f32x4*)(OJ + ((size_t)MT + m) * 1024 + c0 + 4);
          float d[8]; d[0] = p0.x - lam * q0.x; d[1] = p0.y - lam * q0.y; d[2] = p0.z - lam * q0.z; d[3] = p0.w - lam * q0.w; d[4] = p1.x - lam * q1.x; d[5] = p1.y - lam * q1.y; d[6] = p1.z - lam * q1.z; d[7] = p1.w - lam * q1.w;
          float ss = 0.f;
#pragma unroll
          for (int e = 0; e < 8; ++e) ss += d[e] * d[e];
          ss += __shfl_xor(ss, 1); ss += __shfl_xor(ss, 2); ss += __shfl_xor(ss, 4); ss += __shfl_xor(ss, 8);
          const float rinv = (1.f - lam_init) / sqrtf(ss * (1.f / 128.f) + 1e-6f);
#pragma unroll
          for (int e = 0; e < 8; ++e) d[e] = d[e] * rinv * subln[(c0 & 127) + e];
          *(GAS v4u*)(YC + (size_t)m * 1024 + c0) = pack8(d); }
    }
}

constexpr int PH_PER_LAYER = 14, NPH = 1 + NLAYER * PH_PER_LAYER;
#define IN(k) (lo <= (k) && (k) < hi)
#define SEAM(k) do { if (IN(k) && IN((k) + 1)) xcd_barrier(bar); } while (0)
#ifndef ONLY_PH
#define ONLY_PH -1
#endif
#define INL(k) ((ONLY_PH < 0 || ONLY_PH == (k)) && IN(pb + (k)))
#define SEAML(k) SEAM(pb + (k))
#ifndef PROBE_REP
#define PROBE_REP 0
#endif
#define REPL(k) for (int rep_ = 0; rep_ < (((PROBE_REP) >> (k)) & 1) + 1; ++rep_)
template <int l> __device__ __forceinline__ void layer_body(const Args& args, LAS unsigned char* lds, unsigned char* lds_raw, unsigned char* ws, const XcdBarrier& bar, int lo, int hi, int tid, int lane, int G, int bx, int vcu, int gw, int NGW, int gt, int NGT) {
        const int pb = 1 + l * PH_PER_LAYER;
        const bool last = (l == NLAYER - 1);
        float* XS = (float*)(ws + WS_XS);
        const float* mods = (const float*)(ws + WS_MODS) + (size_t)l * 3 * NMOD * DM;
        const float* normg = args.in[I_NORMG] + (size_t)l * 3 * DM;
        pg8::bf16_t* XN = (pg8::bf16_t*)(ws + WS_XN);
        pg8::bf16_t* Hb = (pg8::bf16_t*)(ws + WS_R1);
        const float* xl0 = (l == 0) ? args.in[I_X] : XS; const float* xc0 = (l == 0) ? args.in[I_CTX] : XS + (size_t)NLAT * DM;

        if (INL(0)) REPL(0) ph_norm(xl0, xc0, normg, mods, 0, (bf16*)XN, gw, NGW, lane);
        SEAML(0);
        if (INL(1)) REPL(1) { pg8::Gemm g{XN, (const pg8::bf16_t*)(ws + WS_WF1 + (size_t)(l * 2 + 0) * SZ_WF1), MT, FF2, DM}; pg8::StaticOrder S; S.init(MT, FF2, G, bx);
            pg8::EpiSwiglu E{Hb, FF}; pg8::gemm_phase<pg8::EpiSwiglu, pg8::StaticOrder, true, true>(lds, g, S, E); }
        SEAML(1);
        if (INL(2)) REPL(2) { pg8::Gemm g{Hb, (const pg8::bf16_t*)(ws + WS_WF2 + (size_t)(l * 2 + 0) * SZ_WF2), MT, DM, FF}; pg8::StaticOrder S; S.init(MT, DM, G, bx);
            pg8::EpiResid E{xl0, (long)((xc0 - (size_t)NLAT * DM) - xl0), XS, 0L, 0, mods + 2 * DM, NMOD * DM, 0.5f, NLAT / 256, TSEQ / 256};
            pg8::gemm_phase<pg8::EpiResid, pg8::StaticOrder, true, true>(lds, g, S, E); }
        SEAML(2);
        if (INL(3)) REPL(3) ph_norm(XS, XS + (size_t)NLAT * DM, normg + DM, mods, 3, (bf16*)XN, gw, NGW, lane);
        SEAML(3);
        if (INL(4)) REPL(4) { pg8::Gemm g{XN, (const pg8::bf16_t*)(ws + WS_WIN + (size_t)l * SZ_WIN), MT, PROJP, DM}; pg8::StaticOrder S; S.init(MT, PROJP, G, bx);
            pg8::EpiRawBf16 E{(pg8::bf16_t*)(ws + WS_P), PROJP}; pg8::gemm_phase<pg8::EpiRawBf16, pg8::StaticOrder, true, true>(lds, g, S, E); }
        SEAML(4);
        if (INL(5)) REPL(5) ph_e1(args, l, gt, NGT);
        SEAML(5);
        if (INL(6)) REPL(6) { pg8::Gemm g{(const pg8::bf16_t*)(ws + WS_ACT), (const pg8::bf16_t*)(ws + WS_WLO + (size_t)l * SZ_WLO), MT, LOW, ACTW}; pg8::StaticOrder S; S.init(MT, LOW, G, bx);
            pg8::EpiLora E{(float*)(ws + WS_R1), args.in[I_W0] + l * 2048, args.in[I_A0] + l * 2048}; pg8::gemm_phase<pg8::EpiLora, pg8::StaticOrder, true, true>(lds, g, S, E); }
        SEAML(6);
        if (INL(7)) REPL(7) {
            if (bx < 64) scan_unit(args, l, bx, lds, tid);
            else { ph_attn(args, !last, (char*)lds_raw, bx - 64, G - 64); __syncthreads(); ph_gmlp(args, l, lds, tid, bx - 64, G - 64); }
        }
        SEAML(7);
        if (INL(8)) REPL(8) ph_rwkv_out(args, l, gt, NGT);
        SEAML(8);
        if (INL(9)) REPL(9) { pg8::Gemm g{(const pg8::bf16_t*)(ws + WS_Y3), (const pg8::bf16_t*)(ws + WS_WBR + (size_t)l * SZ_WBR), 3 * MT, 3 * DM, 1024}; pg8::MergeOrder S{G, bx, MT / 256, 8};
            pg8::EpiMerge E{(const pg8::bf16_t*)(ws + WS_P) + P_GATE, PROJP, args.in[I_BGATE] + (size_t)l * 3 * DM, (float*)(ws + WS_YS), XN, MT / 256};
            pg8::gemm_phase<pg8::EpiMerge, pg8::MergeOrder, true, true>(lds, g, S, E); }
        SEAML(9);
        if (INL(10)) REPL(10) { pg8::Gemm g{XN, (const pg8::bf16_t*)(ws + WS_WOUT + (size_t)l * SZ_WOUT), MT, DM, DM}; pg8::StaticOrder S; S.init(MT, DM, G, bx);
            pg8::EpiResid E{XS, 0L, XS, 0L, 0, mods + 5 * DM, NMOD * DM, 1.0f, NLAT / 256, TSEQ / 256};
            pg8::gemm_phase<pg8::EpiResid, pg8::StaticOrder, true, true>(lds, g, S, E); }
        SEAML(10);
        if (INL(11)) REPL(11) ph_norm(XS, XS + (size_t)NLAT * DM, normg + 2 * DM, mods, 6, (bf16*)XN, gw, NGW, lane);
        SEAML(11);
        if (INL(12)) REPL(12) { pg8::Gemm g{XN, (const pg8::bf16_t*)(ws + WS_WF1 + (size_t)(l * 2 + 1) * SZ_WF1), MT, FF2, DM}; pg8::StaticOrder S; S.init(MT, FF2, G, bx);
            pg8::EpiSwiglu E{Hb, FF}; pg8::gemm_phase<pg8::EpiSwiglu, pg8::StaticOrder, true, true>(lds, g, S, E); }
        SEAML(12);
        if (INL(13)) REPL(13) { pg8::Gemm g{Hb, (const pg8::bf16_t*)(ws + WS_WF2 + (size_t)(l * 2 + 1) * SZ_WF2), MT, DM, FF}; pg8::StaticOrder S; S.init(MT, DM, G, bx);
            pg8::EpiResid E{XS, 0L, last ? args.out : XS, 0L, last ? 1 : 0, mods + 8 * DM, NMOD * DM, 0.5f, NLAT / 256, TSEQ / 256};
            pg8::gemm_phase<pg8::EpiResid, pg8::StaticOrder, true, true>(lds, g, S, E); }
        SEAML(13);
    }
__global__ void __launch_bounds__(NTHR, 2) fwd(Args args) {
    extern __shared__ __attribute__((aligned(16))) unsigned char lds_raw[];
    LAS unsigned char* lds = (LAS unsigned char*)lds_raw;
    const int tid = threadIdx.x, lane = tid & 63, wave = __builtin_amdgcn_readfirstlane(tid >> 6);
    const int G = gridDim.x; const int bx = blockIdx.x; const int vcu = (G % 8 == 0) ? (bx % 8) * (G / 8) + bx / 8 : bx;
    const int gw = vcu * NWAVES + wave, NGW = G * NWAVES, gt = vcu * NTHR + tid, NGT = G * NTHR;
    unsigned char* ws = args.ws;
    volatile LAS unsigned* MISC = (volatile LAS unsigned*)(lds + MISC_OFF);
    for (int u = tid; u < (LDS_BYTES - LDSCTL_OFF) / 4; u += NTHR) ((LAS unsigned*)(lds + LDSCTL_OFF))[u] = 0u;
    __syncthreads();
    const int lo = args.ph_lo, hi = args.ph_hi;
    const bool multi = (hi - lo) > 1;
    XcdBarrier bar; bar.bar = (unsigned*)(ws + WS_CTL) + CW_BAR; bar.x = 0; bar.st = nullptr;
    if (multi) bar = xcd_barrier_post((unsigned*)(ws + WS_CTL) + CW_BAR, MISC + 8);

    if ((ONLY_PH < 0 || ONLY_PH == 100) && IN(0)) REPL(16) { ph_ada(args, lds, tid, vcu, G); __syncthreads(); ph_weights(args, lds, tid, vcu, G); }
    SEAM(0);

    layer_body<0>(args, lds, lds_raw, ws, bar, lo, hi, tid, lane, G, bx, vcu, gw, NGW, gt, NGT);
    layer_body<1>(args, lds, lds_raw, ws, bar, lo, hi, tid, lane, G, bx, vcu, gw, NGW, gt, NGT);
#undef IN
#undef SEAM
}

#ifndef MK_PER_PHASE
#define MK_PER_PHASE 0
#endif
extern "C" void kernel_launch(void* const* d_in, const int* in_sizes, int n_in, void* d_out, int out_size, void* d_ws, size_t ws_size, hipStream_t stream) {
    static int grid = 0;
    if (grid == 0) {
        if (n_in != 31 || in_sizes[0] != NLAT * DM || out_size != NLAT * DM || ws_size < WS_END) {
            fprintf(stderr, "kernel_launch: unexpected shapes: n_in %d in0 %d out %d ws %zu (need %zu); nothing launched\n", n_in, n_in > 0 ? in_sizes[0] : -1, out_size, ws_size, (size_t)WS_END); grid = -1; return; }
        int dev = 0, cus = 0, per_cu = 0;
        if (hipGetDevice(&dev) != hipSuccess || hipDeviceGetAttribute(&cus, hipDeviceAttributeMultiprocessorCount, dev) != hipSuccess) { grid = -1; return; }
        if (hipFuncSetAttribute((const void*)fwd, hipFuncAttributeMaxDynamicSharedMemorySize, LDS_BYTES) != hipSuccess) { fprintf(stderr, "kernel_launch: hipFuncSetAttribute failed\n"); grid = -1; return; }
        if (hipOccupancyMaxActiveBlocksPerMultiprocessor(&per_cu, (const void*)fwd, NTHR, LDS_BYTES) != hipSuccess || per_cu < 1) fprintf(stderr, "kernel_launch: occupancy query says %d\n", per_cu);
        (void)hipGetLastError();
        grid = cus;
    }
    if (grid < 0) return;
    (void)hipMemsetAsync((char*)d_ws + WS_CTL, 0, CTL_ZERO_BYTES, stream);
    Args a{};
    for (int i = 0; i < 31; ++i) a.in[i] = (const float*)d_in[i];
    a.out = (float*)d_out; a.ws = (unsigned char*)d_ws;
#if MK_PER_PHASE
    for (int p = 0; p < NPH; ++p) { a.ph_lo = p; a.ph_hi = p + 1; hipLaunchKernelGGL(fwd, dim3(grid), dim3(NTHR), LDS_BYTES, stream, a); }
#else
    a.ph_lo = 0; a.ph_hi = NPH; hipLaunchKernelGGL(fwd, dim3(grid), dim3(NTHR), LDS_BYTES, stream, a);
#endif
}
```

```cpp
#include <hip/hip_runtime.h>
#include <cstdio>
#include <cstdint>
namespace pg8 {
#define PG8_LAS __attribute__((address_space(3)))
typedef unsigned short bf16_t;
typedef short bf16x8 __attribute__((ext_vector_type(8)));
typedef float f32x4 __attribute__((ext_vector_type(4)));
typedef unsigned u32x4 __attribute__((ext_vector_type(4)));
constexpr int BM = 256, BK = 64, HALF = 128, HTB = HALF * BK * 2  , STAGE_BYTES = 8 * HTB, NXCD = 8, WGM = 8;

__host__ __device__ __forceinline__ int lds_byte(int r, int c) { const int st = (r >> 4) * 2 + (c >> 5), rr = r & 15, cc = c & 31, ob = rr * 64 + cc * 2; return st * 1024 + (ob ^ (((ob >> 9) & 1) << 5)); }
__host__ __device__ __forceinline__ void stage_rc(int b, int& R, int& C) { const int st = b / 1024, sb = b % 1024, swz = sb ^ (((sb >> 9) & 1) << 5); R = (st >> 1) * 16 + swz / 64; C = (st & 1) * 32 + (swz % 64) / 2; }
__host__ __device__ __forceinline__ int perm32(int rho) { const int n = rho >> 4, i = rho & 15; return 8 * (i >> 2) + 4 * n + (i & 3); }

struct Unit { int pm, pn, ks, kn, aux; };
struct Gemm { const bf16_t* A; const bf16_t* Bt; int M, N, K; };

struct StaticOrder {
    int nM, nN, nwg, G, c;
    __host__ __device__ void init(int M, int N, int G_, int c_) { nM = M / BM; nN = N / BM; nwg = nM * nN; G = G_; c = c_; }
    __host__ __device__ bool next(int i, Unit& u) const {
        const long L = (long)i * G + c; if (L >= nwg) return false;
        int wgid = (int)L; { const int q = nwg / NXCD, r = nwg % NXCD, xcd = wgid % NXCD, off = wgid / NXCD; wgid = (xcd < r ? xcd * (q + 1) : r * (q + 1) + (xcd - r) * q) + off; }
        const int nig = WGM * nN, gid = wgid / nig, fm = gid * WGM, gsz = (nM - fm) < WGM ? (nM - fm) : WGM;
        u.pm = fm + ((wgid % nig) % gsz); u.pn = (wgid % nig) / gsz; u.ks = 0; u.kn = 0; u.aux = 0; return true;
    }
    __device__ __forceinline__ void a_ready(const Unit&) const {}
    __device__ __forceinline__ void done(const Unit&) const {}
};

__device__ __forceinline__ unsigned cvt_pk_bf16(float lo, float hi) { unsigned r; asm volatile("v_cvt_pk_bf16_f32 %0, %1, %2" : "=v"(r) : "v"(lo), "v"(hi)); return r; }
typedef float f32x2 __attribute__((ext_vector_type(2)));
typedef unsigned u32x2 __attribute__((ext_vector_type(2)));
__device__ __forceinline__ float fsigmoid(float x) { return __builtin_amdgcn_rcpf(1.f + __expf(-x)); }
__device__ __forceinline__ float bflo(unsigned w) { return __builtin_bit_cast(float, w << 16); }
__device__ __forceinline__ float bfhi(unsigned w) { return __builtin_bit_cast(float, w & 0xffff0000u); }

struct EpiSwiglu {
    static constexpr bool PERM = true, AFTER_DRAIN = false;
    bf16_t* H; int ldh;
    __device__ __forceinline__ void operator()(const f32x4 (&acc)[2][2][4][2], const Unit& u, int wr, int wc, int fr, int fq) const {
        const int col0 = u.pn * HALF + wc * 32 + 8 * fq, row0 = u.pm * BM + wr * 64 + fr;
#pragma unroll
        for (int ai = 0; ai < 2; ++ai)
#pragma unroll
            for (int m = 0; m < 4; ++m) {
                const f32x4 g0 = acc[ai][0][m][0], g1 = acc[ai][0][m][1], u0 = acc[ai][1][m][0], u1 = acc[ai][1][m][1];
                float o[8];
#pragma unroll
                for (int e = 0; e < 4; ++e) { o[e] = g0[e] * fsigmoid(g0[e]) * u0[e]; o[4 + e] = g1[e] * fsigmoid(g1[e]) * u1[e]; }
                u32x4 w; w.x = cvt_pk_bf16(o[0], o[1]); w.y = cvt_pk_bf16(o[2], o[3]); w.z = cvt_pk_bf16(o[4], o[5]); w.w = cvt_pk_bf16(o[6], o[7]);
                *(u32x4*)(H + (size_t)(row0 + ai * HALF + m * 16) * ldh + col0) = w;
            }
    }
};

struct EpiResid {
    static constexpr bool PERM = true, AFTER_DRAIN = false;
    const float* xin; long din; float* out; long dout; const float* gvec; int gstride; float scale; int nlat_tiles, tiles_per_set; float* part; int nctx_rows;
    __device__ __forceinline__ void operator()(const f32x4 (&acc)[2][2][4][2], const Unit& u, int wr, int wc, int fr, int fq) const {
        const bool isctx = u.pm >= nlat_tiles;
        const int set = isctx ? 2 : (u.pm / tiles_per_set);
        const float* gv = gvec + (size_t)set * gstride;
        const int colb = u.pn * BM + wc * 32 + 8 * fq;
        const long rbase = (long)(u.pm * BM + wr * 64 + fr) * 2048 + colb;
        const float* xi = xin + rbase + (isctx ? din : 0L); float* xo = out + rbase + (isctx ? dout : 0L);
        f32x4 gg[2][2];
#pragma unroll
        for (int bj = 0; bj < 2; ++bj)
#pragma unroll
            for (int n = 0; n < 2; ++n) gg[bj][n] = *(const f32x4*)(gv + colb + bj * HALF + 4 * n) * scale;
        if (u.kn != 0) {
            float* pp = part + ((size_t)u.aux * (size_t)nctx_rows + (size_t)((u.pm - nlat_tiles) * BM + wr * 64 + fr)) * 2048 + colb;
#pragma unroll
            for (int ai = 0; ai < 2; ++ai)
#pragma unroll
                for (int m = 0; m < 4; ++m)
#pragma unroll
                    for (int bj = 0; bj < 2; ++bj)
#pragma unroll
                        for (int n = 0; n < 2; ++n) *(f32x4*)(pp + (size_t)(ai * HALF + m * 16) * 2048 + bj * HALF + 4 * n) = gg[bj][n] * acc[ai][bj][m][n];
            return;
        }
#pragma unroll
        for (int ai = 0; ai < 2; ++ai) {
            f32x4 xv[4][2][2];
#pragma unroll
            for (int m = 0; m < 4; ++m)
#pragma unroll
                for (int bj = 0; bj < 2; ++bj)
#pragma unroll
                    for (int n = 0; n < 2; ++n) xv[m][bj][n] = *(const f32x4*)(xi + (size_t)(ai * HALF + m * 16) * 2048 + bj * HALF + 4 * n);
#pragma unroll
            for (int m = 0; m < 4; ++m)
#pragma unroll
                for (int bj = 0; bj < 2; ++bj)
#pragma unroll
                    for (int n = 0; n < 2; ++n) *(f32x4*)(xo + (size_t)(ai * HALF + m * 16) * 2048 + bj * HALF + 4 * n) = xv[m][bj][n] + gg[bj][n] * acc[ai][bj][m][n];
        }
    }
};
struct SplitCtxOrder {
    int G, c, nlat_tiles, nctx_tiles, nsplit, ntk;
    __device__ __forceinline__ bool next(int i, Unit& u) const {
        const int e = i * G + c, nl = nlat_tiles * 8;
        if (e < nl) { u.pm = e >> 3; u.pn = e & 7; u.ks = 0; u.kn = 0; u.aux = 0; return true; }
        const int f = e - nl; if (f >= nctx_tiles * 8 * nsplit) return false;
        const int sp = f % nsplit, t = f / nsplit, np = ntk >> 1, p0 = sp * np / nsplit, p1 = (sp + 1) * np / nsplit;
        u.pm = nlat_tiles + (t >> 3); u.pn = t & 7; u.ks = 2 * p0; u.kn = 2 * (p1 - p0); u.aux = sp; return true;
    }
    __device__ __forceinline__ void a_ready(const Unit&) const {}
    __device__ __forceinline__ void done(const Unit&) const {}
};
struct LoraOrder : StaticOrder {
    __device__ __forceinline__ bool next(int i, Unit& u) const {
        if (!StaticOrder::next(i, u)) return false;
        const int sec = u.pn >> 2; int k4 = 4; asm volatile("" : "+s"(k4));
        u.ks = sec == 0 ? 0 : (sec <= 2 ? 4 : 8); u.kn = k4; return true;
    }
};

struct EpiRawBf16 {
    static constexpr bool PERM = true, AFTER_DRAIN = false;
    bf16_t* O; int ldc;
    __device__ __forceinline__ void operator()(const f32x4 (&acc)[2][2][4][2], const Unit& u, int wr, int wc, int fr, int fq) const {
        const int col0 = u.pn * BM + wc * 32 + 8 * fq, row0 = u.pm * BM + wr * 64 + fr;
#pragma unroll
        for (int ai = 0; ai < 2; ++ai)
#pragma unroll
            for (int m = 0; m < 4; ++m) {
                bf16_t* rowp = O + (size_t)(row0 + ai * HALF + m * 16) * ldc + col0;
#pragma unroll
                for (int bj = 0; bj < 2; ++bj) {
                    const f32x4 v0 = acc[ai][bj][m][0], v1 = acc[ai][bj][m][1];
                    u32x4 w; w.x = cvt_pk_bf16(v0[0], v0[1]); w.y = cvt_pk_bf16(v0[2], v0[3]); w.z = cvt_pk_bf16(v1[0], v1[1]); w.w = cvt_pk_bf16(v1[2], v1[3]);
                    *(u32x4*)(rowp + bj * HALF) = w;
                }
            }
    }
};

struct EpiLora {
    static constexpr bool PERM = true, AFTER_DRAIN = false;
    float* LO; const float* w0; const float* a0;
    __device__ __forceinline__ void operator()(const f32x4 (&acc)[2][2][4][2], const Unit& u, int wr, int wc, int fr, int fq) const {
        const int sec = u.pn >> 2;
        const int col0 = u.pn * BM + wc * 32 + 8 * fq, row0 = u.pm * BM + wr * 64 + fr, c0 = col0 - sec * 1024;
        const float* bp = (sec <= 2 ? w0 + (sec <= 1 ? 0 : 1024) : a0 + (sec - 3) * 1024) + c0;
#pragma unroll
        for (int ai = 0; ai < 2; ++ai)
#pragma unroll
            for (int m = 0; m < 4; ++m) {
                float* rowp = LO + (size_t)(row0 + ai * HALF + m * 16) * 5120 + col0;
#pragma unroll
                for (int bj = 0; bj < 2; ++bj)
#pragma unroll
                    for (int n = 0; n < 2; ++n) {
                        f32x4 v = acc[ai][bj][m][n];
                        if (sec >= 1) { v = v + *(const f32x4*)(bp + bj * HALF + 4 * n);
#pragma unroll
                            for (int e = 0; e < 4; ++e) { const float s = fsigmoid(v[e]); v[e] = (sec <= 2) ? __expf(-0.60653066f * s) : s; }
                        }
                        *(f32x4*)(rowp + bj * HALF + 4 * n) = v;
                    }
                asm volatile("" ::: "memory");
            }
    }
};

struct EpiMerge {
    static constexpr bool PERM = true, AFTER_DRAIN = false;
    const bf16_t* pgate; int ldp;
    const float* bgate;
    float* ZF; bf16_t* Z; int mtiles;
    __device__ __forceinline__ void operator()(const f32x4 (&acc)[2][2][4][2], const Unit& u, int wr, int wc, int fr, int fq) const {
        const int br = u.pn >> 3, pn = u.pn & 7, pm = u.pm - mtiles * br;
        const int col0 = pn * BM + wc * 32 + 8 * fq, row0 = pm * BM + wr * 64 + fr;
        f32x4 bb[2][2];
#pragma unroll
        for (int bj = 0; bj < 2; ++bj)
#pragma unroll
            for (int n = 0; n < 2; ++n) bb[bj][n] = *(const f32x4*)(bgate + br * 2048 + col0 + bj * HALF + 4 * n);
#pragma unroll
        for (int ai = 0; ai < 2; ++ai)
#pragma unroll
            for (int mp = 0; mp < 2; ++mp) {
                u32x4 pg[2][2]; f32x4 zf[2][2][2];
#pragma unroll
                for (int mm = 0; mm < 2; ++mm)
#pragma unroll
                    for (int bj = 0; bj < 2; ++bj) { const size_t row = (size_t)(row0 + ai * HALF + (2 * mp + mm) * 16);
                        pg[mm][bj] = *(const u32x4*)(pgate + row * ldp + br * 2048 + col0 + bj * HALF);
                        if (br >= 1) { zf[mm][bj][0] = *(const f32x4*)(ZF + row * 2048 + col0 + bj * HALF); zf[mm][bj][1] = *(const f32x4*)(ZF + row * 2048 + col0 + bj * HALF + 4); } }
#pragma unroll
                for (int mm = 0; mm < 2; ++mm)
#pragma unroll
                    for (int bj = 0; bj < 2; ++bj) { const int m = 2 * mp + mm; const size_t row = (size_t)(row0 + ai * HALF + m * 16); const u32x4 q = pg[mm][bj];
                        f32x4 g0, g1;
                        g0[0] = bflo(q.x); g0[1] = bfhi(q.x); g0[2] = bflo(q.y); g0[3] = bfhi(q.y); g1[0] = bflo(q.z); g1[1] = bfhi(q.z); g1[2] = bflo(q.w); g1[3] = bfhi(q.w);
                        g0 = g0 + bb[bj][0]; g1 = g1 + bb[bj][1];
                        f32x4 v0, v1;
#pragma unroll
                        for (int e = 0; e < 4; ++e) { v0[e] = fsigmoid(g0[e]) * acc[ai][bj][m][0][e]; v1[e] = fsigmoid(g1[e]) * acc[ai][bj][m][1][e]; }
                        float* zp = ZF + row * 2048 + col0 + bj * HALF;
                        if (br >= 1) { v0 = v0 + zf[mm][bj][0]; v1 = v1 + zf[mm][bj][1]; }
                        if (br <= 1) { *(f32x4*)zp = v0; *(f32x4*)(zp + 4) = v1; }
                        else { u32x4 w; w.x = cvt_pk_bf16(v0[0], v0[1]); w.y = cvt_pk_bf16(v0[2], v0[3]); w.z = cvt_pk_bf16(v1[0], v1[1]); w.w = cvt_pk_bf16(v1[2], v1[3]);
                            *(u32x4*)(Z + row * 2048 + col0 + bj * HALF) = w; } }
            }
    }
};
struct MergeOrder {
    int G, c, mtiles, mactive;
    __device__ __forceinline__ bool next(int i, Unit& u) const {
        const int t = (i / 3) * G + c, br = i % 3; if (t >= mactive * 8) return false;
        u.pm = (t >> 3) + mtiles * br; u.pn = (t & 7) + 8 * br; u.ks = 0; u.kn = 0; u.aux = 0; return true;
    }
    __device__ __forceinline__ void a_ready(const Unit&) const {}
    __device__ __forceinline__ void done(const Unit&) const {}
};

template <class Epi, class Sched, bool ALIGN_EPI = false, bool SP2 = false>
__device__ __forceinline__ void gemm_phase(PG8_LAS unsigned char* lds, const Gemm g, const Sched& S, const Epi& E) {
    const int tid = threadIdx.x, wid = __builtin_amdgcn_readfirstlane(tid >> 6), lane = tid & 63, wr = wid >> 2, wc = wid & 3, fr = lane & 15, fq = lane >> 4;
    const int K = g.K, nt = K / BK;
    unsigned voffA[2], voffB[2];
#pragma unroll
    for (int i = 0; i < 2; ++i) { int R, C; stage_rc(tid * 16 + i * 8192, R, C); const int Rb = Epi::PERM ? ((R & ~31) + perm32(R & 31)) : R;
        voffA[i] = (unsigned)(R * K + C) * 2u; voffB[i] = (unsigned)(Rb * K + C) * 2u; }
    const size_t kstep = (size_t)(BK * 2);
    const size_t hstep = (size_t)HALF * K * 2;
    const size_t tstep = 2 * hstep;
    const unsigned ldsw = (unsigned)wid * 1024u;
    const int aoff = lds_byte(wr * 64 + fr, fq * 8), boff = lds_byte(wc * 32 + fr, fq * 8);
#define PG8_SA(b, h) (((b) * 2 + (h)) * HTB)
#define PG8_SB(b, h) ((4 + (b) * 2 + (h)) * HTB)
#define PG8_STAGE(bufoff, gbase, voff) do { _Pragma("unroll") for (int _i = 0; _i < 2; ++_i) \
        __builtin_amdgcn_global_load_lds((const unsigned*)((const char*)(gbase) + (voff)[_i]), (PG8_LAS unsigned*)(lds + (bufoff) + ldsw + _i * 8192), 16, 0, 0); } while (0)
#define PG8_LDA(dst, b, h) do { _Pragma("unroll") for (int m = 0; m < 4; ++m) _Pragma("unroll") for (int k = 0; k < 2; ++k) dst[m][k] = *(const PG8_LAS bf16x8*)(lds + PG8_SA(b, h) + aoff + m * 2048 + k * 1024); } while (0)
#define PG8_LDB(dst, b, h) do { _Pragma("unroll") for (int n = 0; n < 2; ++n) _Pragma("unroll") for (int k = 0; k < 2; ++k) dst[n][k] = *(const PG8_LAS bf16x8*)(lds + PG8_SB(b, h) + boff + n * 2048 + k * 1024); } while (0)
#define PG8_MMA(ai, bj, At, Bt) do { __builtin_amdgcn_s_setprio(1); _Pragma("unroll") for (int m = 0; m < 4; ++m) _Pragma("unroll") for (int n = 0; n < 2; ++n) _Pragma("unroll") for (int k = 0; k < 2; ++k) \
        acc[ai][bj][m][n] = __builtin_amdgcn_mfma_f32_16x16x32_bf16(Bt[n][k], At[m][k], acc[ai][bj][m][n], 0, 0, 0); __builtin_amdgcn_s_setprio(0); } while (0)
#define PG8_WAIT_V(n) asm volatile("s_waitcnt vmcnt(" #n ")" ::: "memory")
#define PG8_WAIT_L(n) asm volatile("s_waitcnt lgkmcnt(" #n ")" ::: "memory")
#define PG8_BAR __builtin_amdgcn_s_barrier()
#define PG8_SCHED __builtin_amdgcn_sched_barrier(0)
    Unit cur, nxt; int ui = 0;
    if (!S.next(0, cur)) return;
    f32x4 acc[2][2][4][2];
#pragma unroll
    for (int a = 0; a < 2; ++a)
#pragma unroll
        for (int b = 0; b < 2; ++b)
#pragma unroll
            for (int m = 0; m < 4; ++m)
#pragma unroll
                for (int n = 0; n < 2; ++n) acc[a][b][m][n] = (f32x4){0.f, 0.f, 0.f, 0.f};
    bf16x8 At[4][2], B0[2][2], B1[2][2];
    const char* cA = (const char*)g.A + (size_t)cur.pm * tstep + (size_t)cur.ks * kstep; const char* cB = (const char*)g.Bt + (size_t)cur.pn * tstep + (size_t)cur.ks * kstep;
    int ntc = cur.kn ? cur.kn : nt;
    S.a_ready(cur);
    if constexpr (SP2) {
        PG8_STAGE(PG8_SB(0, 0), cB, voffB); PG8_STAGE(PG8_SB(0, 1), cB + hstep, voffB); PG8_STAGE(PG8_SA(0, 0), cA, voffA); PG8_STAGE(PG8_SA(0, 1), cA + hstep, voffA);
        if (wr == 1) PG8_BAR;
        PG8_WAIT_V(2); PG8_BAR;
        PG8_STAGE(PG8_SB(1, 0), cB + kstep, voffB); PG8_STAGE(PG8_SA(1, 0), cA + kstep, voffA); PG8_STAGE(PG8_SB(1, 1), cB + hstep + kstep, voffB);
        PG8_WAIT_V(6); PG8_BAR;
    } else {
        PG8_STAGE(PG8_SB(0, 0), cB, voffB); PG8_STAGE(PG8_SA(0, 0), cA, voffA); PG8_STAGE(PG8_SB(0, 1), cB + hstep, voffB); PG8_STAGE(PG8_SA(0, 1), cA + hstep, voffA);
        if (wr == 1) PG8_BAR;
        PG8_WAIT_V(4); PG8_BAR;
        PG8_STAGE(PG8_SB(1, 0), cB + kstep, voffB); PG8_STAGE(PG8_SA(1, 0), cA + kstep, voffA); PG8_STAGE(PG8_SB(1, 1), cB + hstep + kstep, voffB);
        PG8_WAIT_V(6); PG8_BAR;
    }
    for (;;) {
        const bool has_next = S.next(ui + 1, nxt);
        const char* nA = has_next ? (const char*)g.A + (size_t)nxt.pm * tstep + (size_t)nxt.ks * kstep : cA; const char* nB = has_next ? (const char*)g.Bt + (size_t)nxt.pn * tstep + (size_t)nxt.ks * kstep : cB;
        for (int t = 0; t < ntc; t += 2) {
            const bool last = (t == ntc - 2);
            const char* a1 = cA + (size_t)(t + 1) * kstep;
            const char* a2 = last ? nA : cA + (size_t)(t + 2) * kstep; const char* b2 = last ? nB : cB + (size_t)(t + 2) * kstep;
            const char* a3 = a2 + kstep; const char* b3 = b2 + kstep;
            if (last && has_next) S.a_ready(nxt);
            if constexpr (SP2) {
            PG8_LDB(B0, 0, 0); PG8_LDB(B1, 0, 1); PG8_SCHED; PG8_LDA(At, 0, 0); PG8_STAGE(PG8_SA(1, 1), a1 + hstep, voffA);
            PG8_WAIT_V(8); PG8_WAIT_L(0); PG8_BAR; PG8_MMA(0, 0, At, B0); PG8_MMA(0, 1, At, B1); PG8_BAR; PG8_SCHED;
            PG8_LDA(At, 0, 1); PG8_STAGE(PG8_SB(0, 0), b2, voffB); PG8_STAGE(PG8_SB(0, 1), b2 + hstep, voffB); PG8_STAGE(PG8_SA(0, 0), a2, voffA);
            PG8_WAIT_V(8); PG8_WAIT_L(0); PG8_BAR; PG8_MMA(1, 0, At, B0); PG8_MMA(1, 1, At, B1); PG8_BAR; PG8_SCHED;
            PG8_LDB(B0, 1, 0); PG8_LDB(B1, 1, 1); PG8_SCHED; PG8_LDA(At, 1, 0); PG8_STAGE(PG8_SA(0, 1), a2 + hstep, voffA);
            PG8_WAIT_V(8); PG8_WAIT_L(0); PG8_BAR; PG8_MMA(0, 0, At, B0); PG8_MMA(0, 1, At, B1); PG8_BAR; PG8_SCHED;
            PG8_LDA(At, 1, 1); PG8_STAGE(PG8_SB(1, 0), b3, voffB); PG8_STAGE(PG8_SB(1, 1), b3 + hstep, voffB); PG8_STAGE(PG8_SA(1, 0), a3, voffA);
            PG8_WAIT_V(8); PG8_WAIT_L(0); PG8_BAR; PG8_MMA(1, 0, At, B0); PG8_MMA(1, 1, At, B1); PG8_BAR; PG8_SCHED;
            } else {
            PG8_LDB(B0, 0, 0); PG8_SCHED; PG8_LDA(At, 0, 0); PG8_STAGE(PG8_SA(1, 1), a1 + hstep, voffA);
            PG8_WAIT_L(8); PG8_BAR; PG8_WAIT_L(0); PG8_MMA(0, 0, At, B0); PG8_BAR; PG8_SCHED;
            PG8_LDB(B1, 0, 1); PG8_STAGE(PG8_SB(0, 0), b2, voffB);
            PG8_BAR; PG8_WAIT_L(0); PG8_MMA(0, 1, At, B1); PG8_BAR;
            PG8_LDA(At, 0, 1); PG8_STAGE(PG8_SA(0, 0), a2, voffA);
            PG8_BAR; PG8_WAIT_L(0); PG8_MMA(1, 0, At, B0); PG8_BAR; PG8_SCHED;
            PG8_STAGE(PG8_SB(0, 1), b2 + hstep, voffB);
            PG8_WAIT_V(6); PG8_BAR; PG8_MMA(1, 1, At, B1); PG8_BAR;
            PG8_LDB(B0, 1, 0); PG8_SCHED; PG8_LDA(At, 1, 0); PG8_STAGE(PG8_SA(0, 1), a2 + hstep, voffA);
            PG8_WAIT_L(8); PG8_BAR; PG8_WAIT_L(0); PG8_MMA(0, 0, At, B0); PG8_BAR; PG8_SCHED;
            PG8_LDB(B1, 1, 1); PG8_STAGE(PG8_SB(1, 0), b3, voffB);
            PG8_BAR; PG8_WAIT_L(0); PG8_MMA(0, 1, At, B1); PG8_BAR;
            PG8_LDA(At, 1, 1); PG8_STAGE(PG8_SA(1, 0), a3, voffA);
            PG8_BAR; PG8_WAIT_L(0); PG8_MMA(1, 0, At, B0); PG8_BAR; PG8_SCHED;
            PG8_STAGE(PG8_SB(1, 1), b3 + hstep, voffB);
            PG8_WAIT_V(6); PG8_BAR; PG8_MMA(1, 1, At, B1); PG8_BAR;
            }
        }
        if constexpr (ALIGN_EPI) { if (wr == 0) PG8_BAR; }
        if constexpr (!Epi::AFTER_DRAIN) { E(acc, cur, wr, wc, fr, fq); S.done(cur); }
        if (!has_next) break;
#pragma unroll
        for (int a = 0; a < 2; ++a)
#pragma unroll
            for (int b = 0; b < 2; ++b)
#pragma unroll
                for (int m = 0; m < 4; ++m)
#pragma unroll
                    for (int n = 0; n < 2; ++n) acc[a][b][m][n] = (f32x4){0.f, 0.f, 0.f, 0.f};
        cur = nxt; cA = nA; cB = nB; ++ui; ntc = cur.kn ? cur.kn : nt;
        if constexpr (ALIGN_EPI) { if (wr == 1) PG8_BAR; }
    }
    PG8_WAIT_V(0);
    if constexpr (!ALIGN_EPI) { if (wr == 0) PG8_BAR; }
    PG8_BAR;
    if constexpr (Epi::AFTER_DRAIN) { E.fused(acc, cur, wr, wc, fr, fq, lds, wid, lane); S.done(cur); }
#undef PG8_SA
#undef PG8_SB
#undef PG8_STAGE
#undef PG8_LDA
#undef PG8_LDB
#undef PG8_MMA
#undef PG8_WAIT_V
#undef PG8_WAIT_L
#undef PG8_BAR
#undef PG8_SCHED
}
}

constexpr int NWAVES = 8, NTHR = NWAVES * 64;
constexpr int DM = 2048, FF = 5504, FF2 = 2 * FF, NLAT = 8192, NCTX = 512, MT = NLAT + NCTX, TSEQ = 4096, TCTX = 256;
constexpr int PROJ = 14976, PROJP = 15104;
constexpr int P_U = 0, P_V = 1024, P_RKV = 2048, P_G = 5120, P_W = 5376, P_A = 5568, P_QKV = 5760, P_GATE = 8832;
constexpr int ACTW = 768, LOW = 5120;
constexpr int NLAYER = 2, NMOD = 9;

constexpr size_t MiB = 1u << 20;
constexpr size_t al(size_t x) { return (x + MiB - 1) / MiB * MiB; }
constexpr size_t WS_CTL = 0, CTL_ZERO_BYTES = 1 * MiB;
constexpr size_t WS_MODS = 1 * MiB;
constexpr size_t WS_ROPE = WS_MODS + al((size_t)NLAYER * 3 * NMOD * DM * 4);
constexpr size_t WS_WF1 = WS_ROPE + MiB;
constexpr size_t SZ_WF1 = (size_t)FF2 * DM * 2;
constexpr size_t WS_WF2 = WS_WF1 + al(4 * SZ_WF1);
constexpr size_t SZ_WF2 = (size_t)DM * FF * 2;
constexpr size_t WS_WIN = WS_WF2 + al(4 * SZ_WF2);
constexpr size_t SZ_WIN = (size_t)PROJP * DM * 2;
constexpr size_t WS_WLO = WS_WIN + al(2 * SZ_WIN);
constexpr size_t SZ_WLO = (size_t)LOW * ACTW * 2;
constexpr size_t WS_WBR = WS_WLO + al(2 * SZ_WLO);
constexpr size_t SZ_WBR = (size_t)3 * DM * 1024 * 2;
constexpr size_t WS_WOUT = WS_WBR + al(2 * SZ_WBR);
constexpr size_t SZ_WOUT = (size_t)DM * DM * 2;
constexpr size_t WS_XS = WS_WOUT + al(2 * SZ_WOUT);
constexpr size_t WS_XN = WS_XS + al((size_t)MT * DM * 4);
constexpr size_t WS_P = WS_XN + al((size_t)MT * DM * 2);
constexpr size_t WS_R1 = WS_P + al((size_t)MT * PROJP * 2);
constexpr size_t WS_ACT = WS_R1 + al((size_t)MT * LOW * 4);
constexpr size_t WS_RKVK = WS_ACT + al((size_t)MT * ACTW * 2);
constexpr size_t WS_QK = WS_RKVK + al((size_t)MT * 4096 * 2);
constexpr size_t WS_YS = WS_QK + al((size_t)MT * DM * 2);
constexpr size_t WS_Y3 = WS_YS + al((size_t)2 * MT * 1024 * 4);
constexpr size_t WS_OJ = WS_Y3 + al((size_t)3 * MT * 1024 * 2);
constexpr size_t WS_PART = WS_OJ + al((size_t)2 * MT * 1024 * 4);
constexpr size_t WS_END = WS_PART + al((size_t)16 * NCTX * DM * 4);

constexpr int CW_TMO = 0, CW_CODE = 1, CW_BAR = 4096;

constexpr int RING_BYTES = 131072, LDSCTL_OFF = RING_BYTES, MISC_OFF = LDSCTL_OFF + 320, LDS_BYTES = 147456;

#define GAS __attribute__((address_space(1)))
#define LAS __attribute__((address_space(3)))
typedef unsigned short bf16;
typedef unsigned v4u __attribute__((ext_vector_type(4)));
typedef unsigned v2u __attribute__((ext_vector_type(2)));
typedef float f32x4 __attribute__((ext_vector_type(4)));
typedef short bf16x8 __attribute__((ext_vector_type(8)));
typedef GAS unsigned gu32;
#define RLX_AGENT __ATOMIC_RELAXED, __HIP_MEMORY_SCOPE_AGENT
__device__ __forceinline__ unsigned f2bf(float f) { unsigned u = __builtin_bit_cast(unsigned, f); return (u + 0x7fffu + ((u >> 16) & 1u)) >> 16; }
__device__ __forceinline__ unsigned pk2(float lo, float hi) { return f2bf(lo) | (f2bf(hi) << 16); }
__device__ __forceinline__ float bflo(unsigned w) { return __builtin_bit_cast(float, w << 16); }
__device__ __forceinline__ float bfhi(unsigned w) { return __builtin_bit_cast(float, w & 0xffff0000u); }
__device__ __forceinline__ float bf1(bf16 h) { return __builtin_bit_cast(float, (unsigned)h << 16); }
__device__ __forceinline__ void unpack8(const v4u w, float (&f)[8]) { f[0] = bflo(w.x); f[1] = bfhi(w.x); f[2] = bflo(w.y); f[3] = bfhi(w.y); f[4] = bflo(w.z); f[5] = bfhi(w.z); f[6] = bflo(w.w); f[7] = bfhi(w.w); }
__device__ __forceinline__ v4u pack8(const float (&f)[8]) { v4u w; w.x = pk2(f[0], f[1]); w.y = pk2(f[2], f[3]); w.z = pk2(f[4], f[5]); w.w = pk2(f[6], f[7]); return w; }
__device__ __forceinline__ float fsigm(float x) { return __builtin_amdgcn_rcpf(1.f + __expf(-x)); }
__device__ __forceinline__ float ftanh(float x) { return 1.f - 2.f * __builtin_amdgcn_rcpf(__expf(2.f * x) + 1.f); }
__device__ __forceinline__ float gelu_t(float x) { return 0.5f * x * (1.f + ftanh(0.7978845608f * (x + 0.044715f * x * x * x))); }
__device__ __forceinline__ float wave_sum(float v) {
#pragma unroll
    for (int o = 1; o < 64; o <<= 1) v += __shfl_xor(v, o);
    return v;
}
#define XB_TMO      128
#define XB_XCNT(j)  (256  + 64 * (j))
#define XB_XSUB(j)  (1280 + 64 * (j))
#define XB_XGEN(j)  (2304 + 64 * (j))
#define XB_TOP      3328
#define XB_TOPGEN   3392
#define XCD_BAR_WORDS 3456
#define XB_SPIN_CAP (1u << 18)

__device__ __forceinline__ unsigned xb_ld(unsigned* p)              { return __hip_atomic_load(p, __ATOMIC_RELAXED, __HIP_MEMORY_SCOPE_AGENT); }
__device__ __forceinline__ unsigned xb_add(unsigned* p, unsigned v) { return __hip_atomic_fetch_add(p, v, __ATOMIC_RELAXED, __HIP_MEMORY_SCOPE_AGENT); }
__device__ __forceinline__ unsigned xb_xcc_id() { return (unsigned)__builtin_amdgcn_s_getreg((3 << 11) | 20) & 0xFu; }
#define XB_SPIN(cond, bar) do { unsigned _sp = 0; while (cond) { __builtin_amdgcn_s_sleep(1); \
    if ((++_sp & 255u) == 0u) { if (xb_ld(&(bar)[XB_TMO])) break; if (_sp > XB_SPIN_CAP) { atomicAdd(&(bar)[XB_TMO], 1u); break; } } } } while (0)

struct XcdBarrier {
    unsigned* bar; unsigned x;
    volatile LAS unsigned* st;
};

__device__ __forceinline__ XcdBarrier xcd_barrier_post(unsigned* bar, volatile LAS unsigned* st) {
    XcdBarrier b; b.bar = bar; b.x = xb_xcc_id(); b.st = st;
    if (threadIdx.x == 0) (void)xb_add(&bar[XB_XCNT(b.x)], 1u);
    return b;
}
__device__ __forceinline__ void xcd_barrier_complete(unsigned* bar, unsigned x, unsigned& nloc, unsigned& nx) {
    const unsigned G = gridDim.x * gridDim.y * gridDim.z;
    unsigned sum, cnt, mine, sp = 0u;
    for (;;) {
        sum = 0u; cnt = 0u; mine = 0u;
#pragma unroll
        for (unsigned j = 0; j < 16; ++j) { const unsigned c = xb_ld(&bar[XB_XCNT(j)]); sum += c; cnt += (c > 0u) ? 1u : 0u; mine = (j == x) ? c : mine; }
        if (sum == G) break;
        __builtin_amdgcn_s_sleep(1);
        if ((++sp & 255u) == 0u) { if (xb_ld(&bar[XB_TMO])) break; if (sp > XB_SPIN_CAP) { atomicAdd(&bar[XB_TMO], 1u); break; } }
    }
    nloc = mine > 0u ? mine : 1u; nx = cnt > 0u ? cnt : 1u;
}

__device__ __forceinline__ void xcd_barrier(const XcdBarrier& b) {
    asm volatile("s_waitcnt vmcnt(0)" ::: "memory");
    __syncthreads();
    if (threadIdx.x == 0) {
        unsigned* bar = b.bar;
        __builtin_amdgcn_s_waitcnt(0);
        unsigned nloc = b.st[0], nx = b.st[1];
        if (nloc == 0u) { xcd_barrier_complete(bar, b.x, nloc, nx); b.st[0] = nloc; b.st[1] = nx; }
        const unsigned old = xb_add(&bar[XB_XSUB(b.x)], 1u);
        const unsigned gen = old / nloc;
        if (old + 1u == (gen + 1u) * nloc) {
            __builtin_amdgcn_fence(__ATOMIC_RELEASE, "agent");
            asm volatile("s_waitcnt vmcnt(0)" ::: "memory");
            const unsigned og = xb_add(&bar[XB_TOP], 1u);
            const unsigned tg = og / nx;
            if (og + 1u == (tg + 1u) * nx) xb_add(&bar[XB_TOPGEN], 1u);
            else XB_SPIN(xb_ld(&bar[XB_TOPGEN]) == tg, bar);
            __builtin_amdgcn_fence(__ATOMIC_ACQUIRE, "agent");
            xb_add(&bar[XB_XGEN(b.x)], 1u);
            asm volatile("s_waitcnt vmcnt(0)" ::: "memory");
        } else {
            XB_SPIN(xb_ld(&bar[XB_XGEN(b.x)]) == gen, bar);
            __builtin_amdgcn_fence(__ATOMIC_ACQUIRE, "agent");
            asm volatile("s_waitcnt vmcnt(0)" ::: "memory");
        }
    }
    __syncthreads();
}

struct Args { const float* in[31]; float* out; unsigned char* ws; int ph_lo, ph_hi; };
enum In { I_X = 0, I_C, I_CTX, I_CCTX, I_WADA, I_BADA, I_NORMG, I_FFNIN, I_FFNOUT, I_WIN, I_GMVN, I_GMWS, I_GMBS, I_CONV, I_W0, I_WUP, I_A0, I_AUP, I_GUP, I_KK, I_KA, I_RK, I_LNG, I_LNB,
          I_QN, I_KN, I_LAM, I_SUBLN, I_WBR, I_BGATE, I_WOUT };

__device__ __forceinline__ void ph_ada(const Args& a, LAS unsigned char* lds, int tid, int vcu, int G) {
    LAS float* sc = (LAS float*)lds;
    LAS float* red = sc + 3 * 2048;
    const float* c = a.in[I_C]; const float* cc = a.in[I_CCTX];
    for (int i = tid; i < 3 * 2048; i += NTHR) { const float x = i < 4096 ? c[i] : cc[i - 4096]; sc[i] = x * fsigm(x); }
    __syncthreads();
    const int lane = tid & 63, wave = tid >> 6;
    float* mods = (float*)(a.ws + WS_MODS);
    for (int u = vcu; u < 576; u += G) {
        const int l = u / 288, jc = u % 288, j = jc * 64 + lane;
        const float* W = a.in[I_WADA] + (size_t)l * 2048 * 18432 + j;
        float s0 = 0.f, s1 = 0.f, s2 = 0.f;
        const int k0 = wave * 256;
#pragma unroll 8
        for (int k = 0; k < 256; ++k) { const float w = W[(size_t)(k0 + k) * 18432]; s0 += sc[k0 + k] * w; s1 += sc[2048 + k0 + k] * w; s2 += sc[4096 + k0 + k] * w; }
        red[(wave * 3 + 0) * 64 + lane] = s0; red[(wave * 3 + 1) * 64 + lane] = s1; red[(wave * 3 + 2) * 64 + lane] = s2;
        __syncthreads();
        if (wave < 3) { float s = a.in[I_BADA][(size_t)l * 18432 + j];
#pragma unroll
            for (int w8 = 0; w8 < 8; ++w8) s += red[(w8 * 3 + wave) * 64 + lane];
            mods[(size_t)(l * 3 + wave) * 18432 + j] = s; }
        __syncthreads();
    }
}
__device__ __forceinline__ void transpose_item(const float* W, int N, int sc0, bf16* WT, int Kd, int nd0, int k0, LAS float* scr, int lane) {
    if (sc0 >= 0) {
#pragma unroll 8
        for (int i = 0; i < 32; ++i) { const int kk = 2 * i + (lane >> 5); scr[kk * 33 + (lane & 31)] = W[(size_t)(k0 + kk) * N + sc0 + (lane & 31)]; }
    } else {
#pragma unroll 8
        for (int i = 0; i < 32; ++i) { const int kk = 2 * i + (lane >> 5); scr[kk * 33 + (lane & 31)] = 0.f; }
    }
    asm volatile("s_waitcnt lgkmcnt(0)" ::: "memory");
    const int c = lane & 7;
#pragma unroll
    for (int j = 0; j < 4; ++j) { const int n = (lane >> 3) + 8 * j; const LAS float* s = scr + (8 * c) * 33 + n;
        v4u o; o.x = pk2(s[0 * 33], s[1 * 33]); o.y = pk2(s[2 * 33], s[3 * 33]); o.z = pk2(s[4 * 33], s[5 * 33]); o.w = pk2(s[6 * 33], s[7 * 33]);
        *(GAS v4u*)(WT + (size_t)(nd0 + n) * Kd + k0 + 8 * c) = o; }
    asm volatile("s_waitcnt lgkmcnt(0)" ::: "memory");
}
__device__ __forceinline__ void ph_weights(const Args& a, LAS unsigned char* lds, int tid, int vcu, int G) {
    const int lane = tid & 63, wave = tid >> 6;
    LAS float* scr = (LAS float*)(lds + wave * 16384);
    const int gw = vcu * NWAVES + wave, NGW = G * NWAVES;
    constexpr int I_F1 = 32 * (FF2 / 32), I_F2 = (FF / 64) * (DM / 32), I_IN = 32 * (PROJP / 32), I_BR = 16 * (DM / 32), I_WO = 32 * (DM / 32);
    constexpr int NITEMS = 4 * I_F1 + 4 * I_F2 + 2 * I_IN + 6 * I_BR + 2 * I_WO;
    unsigned char* ws = a.ws;
    for (int it = gw; it < NITEMS; it += NGW) {
        int r = it;
        if (r < 4 * I_F1) { const int mi = r / I_F1, q = r % I_F1, nb = q % (FF2 / 32), kb = q / (FF2 / 32), nd0 = 32 * nb, pn = nd0 >> 8, rr = nd0 & 255;
            const int sc0 = rr < 128 ? pn * 128 + rr : FF + pn * 128 + (rr - 128);
            transpose_item(a.in[I_FFNIN] + (size_t)mi * DM * FF2, FF2, sc0, (bf16*)(ws + WS_WF1 + (size_t)mi * SZ_WF1), DM, nd0, 64 * kb, scr, lane); continue; }
        r -= 4 * I_F1;
        if (r < 4 * I_F2) { const int mi = r / I_F2, q = r % I_F2, nb = q % (DM / 32), kb = q / (DM / 32);
            transpose_item(a.in[I_FFNOUT] + (size_t)mi * FF * DM, DM, 32 * nb, (bf16*)(ws + WS_WF2 + (size_t)mi * SZ_WF2), FF, 32 * nb, 64 * kb, scr, lane); continue; }
        r -= 4 * I_F2;
        if (r < 2 * I_IN) { const int mi = r / I_IN, q = r % I_IN, nb = q % (PROJP / 32), kb = q / (PROJP / 32), nd0 = 32 * nb;
            transpose_item(a.in[I_WIN] + (size_t)mi * DM * PROJ, PROJ, nd0 < PROJ ? nd0 : -1, (bf16*)(ws + WS_WIN + (size_t)mi * SZ_WIN), DM, nd0, 64 * kb, scr, lane); continue; }
        r -= 2 * I_IN;
        if (r < 6 * I_BR) { const int mi = r / I_BR, q = r % I_BR, nb = q % (DM / 32), kb = q / (DM / 32);
            transpose_item(a.in[I_WBR] + (size_t)mi * 1024 * DM, DM, 32 * nb, (bf16*)(ws + WS_WBR + (size_t)mi * ((size_t)DM * 1024 * 2)), 1024, 32 * nb, 64 * kb, scr, lane); continue; }
        r -= 6 * I_BR;
        { const int mi = r / I_WO, q = r % I_WO, nb = q % (DM / 32), kb = q / (DM / 32);
            transpose_item(a.in[I_WOUT] + (size_t)mi * DM * DM, DM, 32 * nb, (bf16*)(ws + WS_WOUT + (size_t)mi * SZ_WOUT), DM, 32 * nb, 64 * kb, scr, lane); }
    }
    const int gt = vcu * NTHR + tid, NGT = G * NTHR;
    for (int i = gt; i < NLAYER * LOW * (ACTW / 8); i += NGT) {
        const int l = i / (LOW * (ACTW / 8)), q = i % (LOW * (ACTW / 8)), n = q / (ACTW / 8), k0 = (q % (ACTW / 8)) * 8, sec = n >> 10, cc = n & 1023;
        float f[8];
#pragma unroll
        for (int e = 0; e < 8; ++e) { const int k = k0 + e; float v = 0.f;
            if (sec == 0) { if (k < 256) v = a.in[I_GUP][((size_t)l * 256 + k) * 1024 + cc]; }
            else if (sec <= 2) { const int d = sec - 1, kb = 256 + 128 * d; if (k >= kb && k < kb + 96) v = a.in[I_WUP][((size_t)(l * 2 + d) * 96 + (k - kb)) * 1024 + cc]; }
            else { const int d = sec - 3, kb = 512 + 128 * d; if (k >= kb && k < kb + 96) v = a.in[I_AUP][((size_t)(l * 2 + d) * 96 + (k - kb)) * 1024 + cc]; }
            f[e] = v; }
        *(GAS v4u*)((bf16*)(ws + WS_WLO) + ((size_t)l * LOW + n) * ACTW + k0) = pack8(f);
    }
    for (int i = gt; i < 64 * 16; i += NGT) { const int p = i >> 4, ii = i & 15;
        const float inv = exp2f(-(float)(2 * ii) * (1.f / 32.f) * 13.287712379549449f);
        const float rev = (float)p * inv * 0.15915494309189535f;
        float* rt = (float*)(ws + WS_ROPE) + 2 * i; rt[0] = __builtin_amdgcn_cosf(rev); rt[1] = __builtin_amdgcn_sinf(rev); }
}

__device__ __forceinline__ void ph_norm(const float* xl, const float* xc, const float* gain, const float* mods  , int si, bf16* XN, float* xs_out  , const float* part, int nsplit, int nrows, int gw, int NGW, int lane) {
    for (int m = gw; m < nrows; m += NGW) {
        const float* xr = m < NLAT ? xl + (size_t)m * DM : xc + (size_t)(m - NLAT) * DM;
        const int set = m < TSEQ ? 0 : (m < NLAT ? 1 : 2);
        const float* sh = mods + (size_t)(set * NMOD + si) * DM; const float* scl = sh + DM;
        f32x4 v[8]; float ss = 0.f;
#pragma unroll
        for (int j = 0; j < 8; ++j) v[j] = *(const GAS f32x4*)(xr + 4 * lane + 256 * j);
        if (m >= NLAT) {
            if (part != nullptr) for (int s = 0; s < nsplit; ++s) { const float* pr = part + ((size_t)s * NCTX + (m - NLAT)) * DM + 4 * lane;
#pragma unroll
                for (int j = 0; j < 8; ++j) v[j] = v[j] + *(const GAS f32x4*)(pr + 256 * j); }
#pragma unroll
            for (int j = 0; j < 8; ++j) *(GAS f32x4*)(xs_out + (size_t)m * DM + 4 * lane + 256 * j) = v[j];
        }
#pragma unroll
        for (int j = 0; j < 8; ++j) ss += (v[j].x * v[j].x + v[j].y * v[j].y) + (v[j].z * v[j].z + v[j].w * v[j].w);
        const float rinv = 1.f / sqrtf(wave_sum(ss) * (1.f / DM) + 1e-6f);
#pragma unroll
        for (int j = 0; j < 8; ++j) { const int col = 4 * lane + 256 * j;
            const f32x4 g = *(const GAS f32x4*)(gain + col), s1 = *(const GAS f32x4*)(scl + col), s0 = *(const GAS f32x4*)(sh + col);
            const f32x4 o = (v[j] * rinv * g) * (s1 + 1.f) + s0;
            v2u w; w.x = pk2(o.x, o.y); w.y = pk2(o.z, o.w);
            *(GAS v2u*)(XN + (size_t)m * DM + col) = w; }
    }
}

__device__ __forceinline__ void ph_e1(const Args& a, int l, int gt, int NGT) {
    unsigned char* ws = a.ws;
    const bf16* P = (const bf16*)(ws + WS_P);
    bf16* ACT = (bf16*)(ws + WS_ACT);
    for (int i = gt; i < MT * (ACTW / 8); i += NGT) {
        const int m = i / (ACTW / 8), c0 = (i % (ACTW / 8)) * 8;
        int src = -1, fn = 0;
        if (c0 < 256) { src = P_G + c0; fn = 1; }
        else if (c0 < 352) { src = P_W + (c0 - 256); fn = 2; }
        else if (c0 >= 384 && c0 < 480) { src = P_W + 96 + (c0 - 384); fn = 2; }
        else if (c0 >= 512 && c0 < 608) { src = P_A + (c0 - 512); }
        else if (c0 >= 640 && c0 < 736) { src = P_A + 96 + (c0 - 640); }
        float f[8];
        if (src >= 0) { unpack8(*(const GAS v4u*)(P + (size_t)m * PROJP + src), f);
#pragma unroll
            for (int e = 0; e < 8; ++e) f[e] = fn == 1 ? fsigm(f[e]) : (fn == 2 ? ftanh(f[e]) : f[e]); }
        else {
#pragma unroll
            for (int e = 0; e < 8; ++e) f[e] = 0.f; }
        *(GAS v4u*)(ACT + (size_t)m * ACTW + c0) = pack8(f);
    }
    bf16* QK = (bf16*)(ws + WS_QK);
    const float* rope = (const float*)(ws + WS_ROPE);
    for (int i = gt; i < MT * 32; i += NGT) {
        const int m = i >> 5, gi = i & 31; const bool isq = gi < 16;
        const float* gain = a.in[isq ? I_QN : I_KN] + l * 64;
        const bf16* src = P + (size_t)m * PROJP + P_QKV + gi * 64;
        float y[64]; float ss = 0.f;
#pragma unroll
        for (int j = 0; j < 8; ++j) { float f[8]; unpack8(*(const GAS v4u*)(src + 8 * j), f);
#pragma unroll
            for (int e = 0; e < 8; ++e) { y[8 * j + e] = f[e]; ss += f[e] * f[e]; } }
        const float rinv = 1.f / sqrtf(ss * (1.f / 64.f) + 1e-6f);
#pragma unroll
        for (int d = 0; d < 64; ++d) y[d] = y[d] * rinv * gain[d];
        if (m < NLAT) { const int t = m & (TSEQ - 1), pr = t >> 6, pc = t & 63;
#pragma unroll
            for (int ii = 0; ii < 16; ++ii) {
                const float c1 = rope[(pr * 16 + ii) * 2], s1 = rope[(pr * 16 + ii) * 2 + 1], c2 = rope[(pc * 16 + ii) * 2], s2 = rope[(pc * 16 + ii) * 2 + 1];
                const float a1 = y[ii], a2 = y[16 + ii], b1 = y[32 + ii], b2 = y[48 + ii];
                y[ii] = a1 * c1 - a2 * s1; y[16 + ii] = a2 * c1 + a1 * s1; y[32 + ii] = b1 * c2 - b2 * s2; y[48 + ii] = b2 * c2 + b1 * s2; } }
        const float qs = isq ? 0.18033688011112042f : 1.f;
        bf16* dst = QK + (size_t)m * DM + gi * 64;
#pragma unroll
        for (int j = 0; j < 8; ++j) { float f[8];
#pragma unroll
            for (int e = 0; e < 8; ++e) f[e] = y[8 * j + e] * qs;
            *(GAS v4u*)(dst + 8 * j) = pack8(f); }
    }
    bf16* RK = (bf16*)(ws + WS_RKVK);
    const float* cw = a.in[I_CONV] + (size_t)l * 3 * 3072; const float* kkw = a.in[I_KK] + l * 1024;
    for (int i = gt; i < MT * 128; i += NGT) {
        const int m = i >> 7, c0 = (i & 127) * 8;
        const int t = m < NLAT ? (m & (TSEQ - 1)) : ((m - NLAT) & (TCTX - 1)), tl = m < NLAT ? TSEQ : TCTX;
        const bool hp = t > 0, hn = t < tl - 1;
        float rkv[3][8];
#pragma unroll
        for (int sec = 0; sec < 3; ++sec) {
            const int col = sec * 1024 + c0; const bf16* pc = P + (size_t)m * PROJP + P_RKV + col;
            float x0[8], x1[8], x2[8];
            unpack8(*(const GAS v4u*)pc, x1);
            if (hp) unpack8(*(const GAS v4u*)(pc - PROJP), x0);
            if (hn) unpack8(*(const GAS v4u*)(pc + PROJP), x2);
#pragma unroll
            for (int e = 0; e < 8; ++e) { float v = x1[e] * cw[3072 + col + e]; if (hp) v += x0[e] * cw[col + e]; if (hn) v += x2[e] * cw[2 * 3072 + col + e]; rkv[sec][e] = v; }
        }
        float kk8[8]; float ss = 0.f;
#pragma unroll
        for (int e = 0; e < 8; ++e) { kk8[e] = rkv[1][e] * kkw[c0 + e]; ss += kk8[e] * kk8[e]; }
        ss += __shfl_xor(ss, 1); ss += __shfl_xor(ss, 2); ss += __shfl_xor(ss, 4);
        const float rinv = 1.f / sqrtf(ss + 1e-12f);
        GAS v4u* dst = (GAS v4u*)(RK + (size_t)m * 4096 + c0 * 4);
#pragma unroll
        for (int j = 0; j < 4; ++j) { v4u o; o.x = pk2(rkv[0][2 * j], rkv[1][2 * j]); o.y = pk2(rkv[2][2 * j], kk8[2 * j] * rinv); o.z = pk2(rkv[0][2 * j + 1], rkv[1][2 * j + 1]); o.w = pk2(rkv[2][2 * j + 1], kk8[2 * j + 1] * rinv); dst[j] = o; }
    }
}

__device__ __forceinline__ void ph_gmlp(const Args& a, int l, LAS unsigned char* lds, int tid, int vcu, int G) {
    constexpr int VP = 136;
    LAS bf16* vnT = (LAS bf16*)lds;
    const bf16* P = (const bf16*)(a.ws + WS_P); bf16* YA = (bf16*)(a.ws + WS_Y3);
    const float* vng = a.in[I_GMVN] + l * 1024; const float* wsm = a.in[I_GMWS] + (size_t)l * 8 * 128 * 128; const float* bs = a.in[I_GMBS] + l * 8 * 128;
    const int lane = tid & 63, w = tid >> 6, fr = lane & 15, fq = lane >> 4;
    for (int u = vcu; u < (MT / 128) * 8; u += G) {
        const int n = u >> 3, g = u & 7, m0 = n * 128;
        { const int q = tid >> 2, qt = tid & 3; const bf16* src = P + (size_t)(m0 + q) * PROJP + P_V + g * 128 + qt * 32;
            float v[32]; float ss = 0.f;
#pragma unroll
            for (int j = 0; j < 4; ++j) { float f[8]; unpack8(*(const GAS v4u*)(src + 8 * j), f);
#pragma unroll
                for (int e = 0; e < 8; ++e) { const float x = gelu_t(f[e]); v[8 * j + e] = x; ss += x * x; } }
            ss += __shfl_xor(ss, 1); ss += __shfl_xor(ss, 2);
            const float rinv = 1.f / sqrtf(ss * (1.f / 128.f) + 1e-6f);
#pragma unroll
            for (int e = 0; e < 32; ++e) { const int c = qt * 32 + e; vnT[c * VP + q] = (bf16)f2bf(v[e] * rinv * vng[g * 128 + c]); } }
        __syncthreads();
        pg8::f32x4 acc[8];
#pragma unroll
        for (int cb = 0; cb < 8; ++cb) acc[cb] = (pg8::f32x4){0.f, 0.f, 0.f, 0.f};
#pragma unroll
        for (int ks = 0; ks < 4; ++ks) {
            const float* wr = wsm + ((size_t)g * 128 + 16 * w + fr) * 128 + ks * 32 + 8 * fq;
            const f32x4 w0 = *(const GAS f32x4*)wr, w1 = *(const GAS f32x4*)(wr + 4);
            v4u aw; aw.x = pk2(w0.x, w0.y); aw.y = pk2(w0.z, w0.w); aw.z = pk2(w1.x, w1.y); aw.w = pk2(w1.z, w1.w);
            const bf16x8 af = __builtin_bit_cast(bf16x8, aw);
#pragma unroll
            for (int cb = 0; cb < 8; ++cb) { const bf16x8 bfr = *(const LAS bf16x8*)(vnT + (cb * 16 + fr) * VP + ks * 32 + 8 * fq);
                acc[cb] = __builtin_amdgcn_mfma_f32_16x16x32_bf16(af, bfr, acc[cb], 0, 0, 0); }
        }
#pragma unroll
        for (int cb = 0; cb < 8; ++cb)
#pragma unroll
            for (int i = 0; i < 4; ++i) { const int p = 16 * w + 4 * fq + i, c = cb * 16 + fr;
                const float pu = bf1(P[(size_t)(m0 + p) * PROJP + P_U + g * 128 + c]);
                YA[(size_t)(m0 + p) * 1024 + g * 128 + c] = (bf16)f2bf(gelu_t(pu) * (acc[cb][i] + bs[g * 128 + p])); }
        __syncthreads();
    }
}

namespace att {
using bf16x8 = __attribute__((ext_vector_type(8))) short;
using s16x4  = __attribute__((ext_vector_type(4))) short;
using f32x16 = __attribute__((ext_vector_type(16))) float;
using u32x4  = __attribute__((ext_vector_type(4))) unsigned;
constexpr int NW = 8, QBLK = 32, KVBLK = 64;
constexpr float THRL = 11.5f;
constexpr int SHM_V = KVBLK * 128 * 2, SHM_K = KVBLK * 64 * 2, SHM_ATTN = 2 * SHM_V + 2 * SHM_K + NW * 64 * 4;
#define KSWZ(row, colB) ((row) * 128 + ((colB) ^ ((((row) >> 1) & 7) << 4)))
#define SBAR() __builtin_amdgcn_sched_barrier(0)
__device__ __forceinline__ int crow(int r, int hi) { return (r & 3) + 8 * (r >> 2) + 4 * hi; }
__device__ __forceinline__ unsigned cvtpk(float lo, float hi) { unsigned r; asm volatile("v_cvt_pk_bf16_f32 %0, %1, %2" : "=v"(r) : "v"(lo), "v"(hi)); return r; }
__device__ __forceinline__ void partialSM(f32x16& p0, f32x16& p1, float& m_reg, float& mn, float& alpha) {
  float pmax = p0[0];
#pragma unroll
  for (int r = 1; r < 16; ++r) pmax = fmaxf(pmax, p0[r]);
#pragma unroll
  for (int r = 0; r < 16; ++r) pmax = fmaxf(pmax, p1[r]);
  { auto rr = __builtin_amdgcn_permlane32_swap(__float_as_uint(pmax), __float_as_uint(pmax), false, false);
    pmax = fmaxf(__uint_as_float(rr[0]), __uint_as_float(rr[1])); }
  if (__builtin_expect(__all(pmax - m_reg <= THRL), 1)) { mn = m_reg; alpha = 1.f; }
  else { mn = fmaxf(m_reg, pmax); alpha = __builtin_amdgcn_exp2f(m_reg - mn); m_reg = mn; }
#pragma unroll
  for (int r = 0; r < 16; ++r) p0[r] = p0[r] - mn;
#pragma unroll
  for (int r = 0; r < 16; ++r) p1[r] = p1[r] - mn;
#pragma unroll
  for (int r = 0; r < 16; ++r) p0[r] = __builtin_amdgcn_exp2f(p0[r]);
}
__device__ __forceinline__ void finishSM(f32x16& p0, f32x16& p1, float alpha, float& l_reg, bf16x8& pa0, bf16x8& pa1, bf16x8& pa2, bf16x8& pa3) {
#pragma unroll
  for (int r = 0; r < 16; ++r) p1[r] = __builtin_amdgcn_exp2f(p1[r]);
  float ps = 0;
#pragma unroll
  for (int r = 0; r < 16; ++r) ps += p0[r];
#pragma unroll
  for (int r = 0; r < 16; ++r) ps += p1[r];
  { auto rr = __builtin_amdgcn_permlane32_swap(__float_as_uint(ps), __float_as_uint(ps), false, false);
    ps = __uint_as_float(rr[0]) + __uint_as_float(rr[1]); }
  l_reg = l_reg * alpha + ps;
#define PK4(P, BASE, OUT) do { unsigned a0 = cvtpk(P[BASE + 0], P[BASE + 1]), a1 = cvtpk(P[BASE + 2], P[BASE + 3]);   \
    unsigned b0 = cvtpk(P[BASE + 4], P[BASE + 5]), b1 = cvtpk(P[BASE + 6], P[BASE + 7]);                              \
    auto r0 = __builtin_amdgcn_permlane32_swap(a0, b0, false, false); auto r1 = __builtin_amdgcn_permlane32_swap(a1, b1, false, false); \
    u32x4 w = {r0[0], r1[0], r0[1], r1[1]}; OUT = *reinterpret_cast<bf16x8*>(&w); } while (0)
  PK4(p0, 0, pa0); PK4(p0, 8, pa1); PK4(p1, 0, pa2); PK4(p1, 8, pa3);
#undef PK4
}
__device__ __forceinline__ void qkt(f32x16& p0, f32x16& p1, const unsigned short* Ks, const bf16x8* qr, int r32, int hi) {
  p0 = f32x16{}; p1 = f32x16{};
#pragma unroll
  for (int d0 = 0; d0 < 4; ++d0) { int cb = (d0 * 16 + hi * 8) * 2;
    bf16x8 b0 = *reinterpret_cast<const bf16x8*>((const char*)Ks + KSWZ(r32, cb));
    bf16x8 b1 = *reinterpret_cast<const bf16x8*>((const char*)Ks + KSWZ(32 + r32, cb));
    p0 = __builtin_amdgcn_mfma_f32_32x32x16_bf16(b0, qr[d0], p0, 0, 0, 0);
    p1 = __builtin_amdgcn_mfma_f32_32x32x16_bf16(b1, qr[d0], p1, 0, 0, 0); }
}
__device__ __forceinline__ int v_st(int k, int c) { const int kk = (k & ~0xC) | ((k & 4) << 1) | ((k & 8) >> 1); return ((kk >> 3) * 4 + (c >> 5)) * 512 + ((kk & 7) * 32 + (c & 31)) * 2; }
__device__ __forceinline__ int v_rd_base(int lane) { return ((lane & 3) << 3) | (((lane >> 2) & 3) << 6) | (((lane >> 4) & 1) << 5) | (((lane >> 5) & 1) << 8); }
constexpr int v_rd_off(int d0, int ks, int half) { return d0 * 512 + ks * 4096 + half * 2048; }
template <int OFF> __device__ __forceinline__ s16x4 tr_read(int vb) {
  s16x4 r; asm volatile("ds_read_b64_tr_b16 %0, %1 offset:%2" : "=&v"(r) : "v"(vb), "i"(OFF) : "memory"); return r;
}
template <int D0> __device__ __forceinline__ void pv_one(f32x16& od, int vb, bf16x8 pa0, bf16x8 pa1, bf16x8 pa2, bf16x8 pa3) {
  const s16x4 l0 = tr_read<v_rd_off(D0, 0, 0)>(vb), h0 = tr_read<v_rd_off(D0, 0, 1)>(vb), l1 = tr_read<v_rd_off(D0, 1, 0)>(vb), h1 = tr_read<v_rd_off(D0, 1, 1)>(vb);
  const s16x4 l2 = tr_read<v_rd_off(D0, 2, 0)>(vb), h2 = tr_read<v_rd_off(D0, 2, 1)>(vb), l3 = tr_read<v_rd_off(D0, 3, 0)>(vb), h3 = tr_read<v_rd_off(D0, 3, 1)>(vb);
  asm volatile("s_waitcnt lgkmcnt(0)" ::: "memory"); SBAR();
#define PK(L, H) (bf16x8){L[0], L[1], L[2], L[3], H[0], H[1], H[2], H[3]}
  od = __builtin_amdgcn_mfma_f32_32x32x16_bf16(pa0, PK(l0, h0), od, 0, 0, 0);
  od = __builtin_amdgcn_mfma_f32_32x32x16_bf16(pa1, PK(l1, h1), od, 0, 0, 0);
  od = __builtin_amdgcn_mfma_f32_32x32x16_bf16(pa2, PK(l2, h2), od, 0, 0, 0);
  od = __builtin_amdgcn_mfma_f32_32x32x16_bf16(pa3, PK(l3, h3), od, 0, 0, 0);
#undef PK
}
__device__ __forceinline__ void pv_d0(f32x16* o, int vb, bf16x8 pa0, bf16x8 pa1, bf16x8 pa2, bf16x8 pa3) {
  pv_one<0>(o[0], vb, pa0, pa1, pa2, pa3); pv_one<1>(o[1], vb, pa0, pa1, pa2, pa3); pv_one<2>(o[2], vb, pa0, pa1, pa2, pa3); pv_one<3>(o[3], vb, pa0, pa1, pa2, pa3);
}
__device__ __forceinline__ void attn_unit(const unsigned short* __restrict__ Qb, const unsigned short* __restrict__ Kb, const unsigned short* __restrict__ Vb,
                                          float* __restrict__ Ob, int NT, int ntl, int klat, int kctx, char* lds) {
  constexpr int LDQ = 2048, LDKK = 2048, LDV = 15104, LDO = 1024;
  const int tid = threadIdx.x, wid = tid >> 6, lane = tid & 63, r32 = lane & 31, hi = lane >> 5;
  unsigned short* V_lds = (unsigned short*)lds; unsigned short* K_lds = (unsigned short*)(lds + 2 * SHM_V);
  float* ws = (float*)(lds + 2 * SHM_V + 2 * SHM_K) + wid * 64; float* li_l = ws; float* al_l = ws + 32;
  float m_reg = -1e30f, l_reg = 0; f32x16 o[4] = {}; bf16x8 qr[4];
  const unsigned short* Qw = Qb + (long)(wid * QBLK + r32) * LDQ + hi * 8;
#pragma unroll
  for (int d0 = 0; d0 < 4; ++d0) qr[d0] = *reinterpret_cast<const bf16x8*>(Qw + d0 * 16);
  const int sr = tid >> 4, sc = (tid & 15) * 8, vst0 = v_st(sr, sc), vst1 = v_st(32 + sr, sc);
  const int kr = tid >> 3, kc = (tid & 7) * 8, kst = KSWZ(kr, kc * 2);
  const int vb0 = (int)(uintptr_t)V_lds + v_rd_base(lane);
  struct { bf16x8 vs0, vs1, ks0; } sr_[2];
#define KROW(t) ((t) < ntl ? klat + 64 * (t) : kctx + 64 * ((t) - ntl))
#define SLOAD(i, t) do { const long k0_ = KROW(t); sr_[i].vs0 = *reinterpret_cast<const bf16x8*>(&Vb[(k0_ + sr) * LDV + sc]); sr_[i].vs1 = *reinterpret_cast<const bf16x8*>(&Vb[(k0_ + 32 + sr) * LDV + sc]); \
    sr_[i].ks0 = *reinterpret_cast<const bf16x8*>(&Kb[(k0_ + kr) * LDKK + kc]); } while (0)
#define SWRITE(b, i) do { *(bf16x8*)((char*)V_lds + (b) * SHM_V + vst0) = sr_[i].vs0; *(bf16x8*)((char*)V_lds + (b) * SHM_V + vst1) = sr_[i].vs1; \
    *(bf16x8*)((char*)K_lds + (b) * SHM_K + kst) = sr_[i].ks0; } while (0)
#define SWAIT() asm volatile("s_waitcnt vmcnt(3)" ::: "memory")
#define RESC(a) do { if (__any((a) < 1.f)) { if (hi == 0) al_l[r32] = (a); asm volatile("s_waitcnt lgkmcnt(0)" ::: "memory"); \
    _Pragma("unroll") for (int d = 0; d < 4; ++d) _Pragma("unroll") for (int r = 0; r < 16; ++r) o[d][r] *= al_l[crow(r, hi)]; } } while (0)
  f32x16 pA0, pA1, pB0, pB1; float mnA, mnB, alA, alB; bf16x8 pa0, pa1, pa2, pa3;
  constexpr int SE = 0, SO = 1;
  SLOAD(SE, 0); asm volatile("s_waitcnt vmcnt(0)" ::: "memory"); SWRITE(0, SE); __syncthreads();
  qkt(pA0, pA1, K_lds, qr, r32, hi); partialSM(pA0, pA1, m_reg, mnA, alA);
  SLOAD(SO, 1); if (2 < NT) SLOAD(SE, 2);
  SWAIT(); SWRITE(1, SO); __syncthreads();
  for (int j = 1; j + 1 < NT; j += 2) {
    SBAR(); qkt(pB0, pB1, (const unsigned short*)((char*)K_lds + SHM_K), qr, r32, hi);
    finishSM(pA0, pA1, alA, l_reg, pa0, pa1, pa2, pa3); SBAR();
    SLOAD(SO, j + 2); SBAR();
    pv_d0(o, vb0, pa0, pa1, pa2, pa3); partialSM(pB0, pB1, m_reg, mnB, alB);
    __syncthreads(); SWAIT(); SWRITE(0, SE);
    RESC(alB); __syncthreads();
    SBAR(); qkt(pA0, pA1, K_lds, qr, r32, hi);
    finishSM(pB0, pB1, alB, l_reg, pa0, pa1, pa2, pa3); SBAR();
    if (j + 3 < NT) SLOAD(SE, j + 3); SBAR();
    pv_d0(o, vb0 + (int)SHM_V, pa0, pa1, pa2, pa3); partialSM(pA0, pA1, m_reg, mnA, alA);
    __syncthreads(); SWAIT(); SWRITE(1, SO);
    RESC(alA); __syncthreads();
  }
  SBAR(); qkt(pB0, pB1, (const unsigned short*)((char*)K_lds + SHM_K), qr, r32, hi);
  finishSM(pA0, pA1, alA, l_reg, pa0, pa1, pa2, pa3); SBAR();
  pv_d0(o, vb0, pa0, pa1, pa2, pa3); partialSM(pB0, pB1, m_reg, mnB, alB);
  __syncthreads(); RESC(alB);
  finishSM(pB0, pB1, alB, l_reg, pa0, pa1, pa2, pa3); SBAR();
  pv_d0(o, vb0 + (int)SHM_V, pa0, pa1, pa2, pa3);
  if (hi == 0) li_l[r32] = l_reg; asm volatile("s_waitcnt lgkmcnt(0)" ::: "memory");
  float rli[16];
#pragma unroll
  for (int r = 0; r < 16; ++r) rli[r] = __builtin_amdgcn_rcpf(li_l[crow(r, hi)]);
  float* Ow = Ob + (long)(wid * QBLK) * LDO;
#pragma unroll
  for (int r = 0; r < 16; ++r) { int orow = crow(r, hi);
#pragma unroll
    for (int d0 = 0; d0 < 4; ++d0) Ow[(long)orow * LDO + d0 * 32 + r32] = o[d0][r] * rli[r]; }
  __syncthreads();
#undef KROW
#undef SLOAD
#undef SWRITE
#undef SWAIT
#undef RESC
}
#undef KSWZ
#undef SBAR
}

__device__ __forceinline__ void ph_attn(const Args& a, bool ctx_out, char* lds, int widx, int wstride) {
    const unsigned short* QK = (const unsigned short*)(a.ws + WS_QK); const unsigned short* P = (const unsigned short*)(a.ws + WS_P); float* OJ = (float*)(a.ws + WS_OJ);
    const int nunits = ctx_out ? 544 : 512;
    for (int u = widx; u < nunits; u += wstride) {
        int b, hj, qrow0, NT, ntl;
        if (u < 512) { b = u >> 8; hj = (u >> 4) & 15; qrow0 = b * TSEQ + (u & 15) * 256; NT = 68; ntl = 64; }
        else { const int uu = u - 512; b = uu >> 4; hj = uu & 15; qrow0 = NLAT + b * TCTX; NT = 4; ntl = 0; }
        att::attn_unit(QK + (size_t)qrow0 * DM + hj * 64, QK + 1024 + hj * 64, P + P_QKV + 2048 + (hj >> 1) * 128,
                       OJ + ((size_t)(hj & 1) * MT + qrow0) * 1024 + (hj >> 1) * 128, NT, ntl, b * TSEQ, NLAT + b * TCTX, lds);
    }
}

constexpr int SC_STEP = 768, SC_BLK = 32, SC_BUF = SC_BLK * SC_STEP + 256, SC_Y = 2 * SC_BUF, SC_LDS = SC_Y + 2 * SC_BLK * 64 * 4 + 256;
__device__ __forceinline__ int scan_row(int i, int b, int d) { return i < TCTX ? NLAT + b * TCTX + (d ? TCTX - 1 - i : i) : b * TSEQ + (d ? TSEQ - 1 - (i - TCTX) : (i - TCTX)); }
typedef __amdgpu_buffer_rsrc_t rsrc_t;
typedef __bf16 bf16x2_t __attribute__((ext_vector_type(2)));
typedef float f32x2_t __attribute__((ext_vector_type(2)));
__device__ __forceinline__ unsigned cvtpk_c(float lo, float hi) { f32x2_t v = {lo, hi}; bf16x2_t b = __builtin_convertvector(v, bf16x2_t); return __builtin_bit_cast(unsigned, b); }
__device__ __forceinline__ void scan_fill(rsrc_t LOr, rsrc_t RKr, float kav, LAS unsigned char* buf, int blk, int b, int h, int d, int hw, int lane) {
    const int i0 = blk * SC_BLK, m0 = scan_row(i0, b, d), dir = d ? -1 : 1;
    const int lo0 = (m0 * LOW + 1024 + d * 1024 + h * 64) * 4, lostep = dir * LOW * 4;
    const int rk0 = (m0 * 16 + h) * 512, rkstep = dir * 8192;
    const int inext = i0 + 8 * hw + 8, mn = inext < TCTX + TSEQ ? scan_row(inext, b, d) : m0;
    const int pp = (((lane >> 5) * 4 + ((lane >> 2) & 3)) * 8 + 4 * ((lane >> 4) & 1) + (lane & 3)) * 2;
    float wv[SC_BLK], av[8]; v2u rec[9];
#pragma unroll
    for (int st = 0; st < SC_BLK; ++st) wv[st] = __builtin_bit_cast(float, __builtin_amdgcn_raw_buffer_load_b32(LOr, lane * 4, lo0 + st * lostep, 0));
#pragma unroll
    for (int q = 0; q < 8; ++q) { av[q] = __builtin_bit_cast(float, __builtin_amdgcn_raw_buffer_load_b32(LOr, lane * 4, lo0 + 8192 + (8 * hw + q) * lostep, 0));
        rec[q] = __builtin_amdgcn_raw_buffer_load_b64(RKr, lane * 8, rk0 + (8 * hw + q) * rkstep, 0); }
    rec[8] = __builtin_amdgcn_raw_buffer_load_b64(RKr, lane * 8, (mn * 16 + h) * 512, 0);
    asm volatile("" ::: "memory");
    float g = 1.f;
#pragma unroll
    for (int st = 0; st < SC_BLK; ++st) { if (st < 8 * hw) g *= wv[st]; }
    float gl = 1.f;
#pragma unroll
    for (int st = 0; st < SC_BLK; ++st) gl *= wv[st];
#pragma unroll
    for (int q = 0; q < 8; ++q) {
        const float wq = hw == 0 ? wv[q] : (hw == 1 ? wv[8 + q] : (hw == 2 ? wv[16 + q] : wv[24 + q]));
        g *= wq;
        const float ig = __builtin_amdgcn_rcpf(g);
        const float rv = bflo(rec[q].x), kv = bfhi(rec[q].x), vv = bflo(rec[q].y), kkv = bfhi(rec[q].y), kkn = bfhi(rec[q + 1].y);
        LAS unsigned char* o = buf + (8 * hw + q) * SC_STEP;
        ((LAS unsigned*)o)[lane] = pg8::cvt_pk_bf16(kv * (1.f + (av[q] - 1.f) * kav) * ig, -(kkv * av[q] * ig));
        *(LAS bf16*)(o + 256 + pp) = (bf16)f2bf(kkn * g); *(LAS bf16*)(o + 384 + pp) = (bf16)f2bf(rv * g);
        ((LAS float*)(o + 512))[lane] = vv;
    }
    if (hw == 0) ((LAS float*)(buf + SC_BLK * SC_STEP))[lane] = gl;
}
__device__ __forceinline__ void scan_unit(const Args& a, int l, int u, LAS unsigned char* lds, int tid) {
    const rsrc_t LOr = __builtin_amdgcn_make_buffer_rsrc((void*)(a.ws + WS_R1), 0, MT * LOW * 4, 0x00020000);
    const rsrc_t RKr = __builtin_amdgcn_make_buffer_rsrc((void*)(a.ws + WS_RKVK), 0, MT * 4096 * 2, 0x00020000);
    const rsrc_t YSr = __builtin_amdgcn_make_buffer_rsrc((void*)(a.ws + WS_YS), 0, 2 * MT * 1024 * 4, 0x00020000);
    const int lane = tid & 63, w = __builtin_amdgcn_readfirstlane(tid >> 6), fr = lane & 15, fq = lane >> 4;
    const int b = u >> 5, h = (u >> 1) & 15, d = u & 1;
    const float kav = a.in[I_KA][l * 1024 + h * 64 + lane];
    constexpr int NBLK = (TCTX + TSEQ) / SC_BLK;
    pg8::f32x4 S0 = (pg8::f32x4){0.f, 0.f, 0.f, 0.f}, S1 = S0, S2 = S0, S3 = S0, acc0 = S0, acc1 = S0;
    const unsigned mk0 = fq == 0 ? 0xffffffffu : 0u, mk1 = fq == 1 ? 0xffffffffu : 0u, mk2 = fq == 2 ? 0xffffffffu : 0u, mk3 = fq == 3 ? 0xffffffffu : 0u;
    if (w >= 4) scan_fill(LOr, RKr, kav, lds, 0, b, h, d, w - 4, lane);
    __syncthreads();
    for (int blk = 0; blk < NBLK; ++blk) {
        LAS unsigned char* buf = lds + (blk & 1) * SC_BUF;
        LAS float* yb = (LAS float*)(lds + SC_Y) + (blk & 1) * SC_BLK * 64;
        if (w < 4) {
            const int aoff = 256 + ((fr & 2) ? 128 : 0) + 16 * fq;
            int yoff = 2 * SC_BLK * 64 - (blk & 1) * SC_BLK * 64 + lane;
            unsigned Ua, Ub_; float va, vb_; bf16x8 A0a, A1a, A0b_, A1b_;
#define SC_LOAD(S, st_) do { LAS unsigned char* nb_ = buf + (st_) * SC_STEP; U##S = ((LAS unsigned*)nb_)[lane]; v##S = ((LAS float*)(nb_ + 512))[16 * w + fr]; \
        A0##S = *(const LAS bf16x8*)(nb_ + aoff); A1##S = *(const LAS bf16x8*)(nb_ + aoff + 64); } while (0)
#define SC_DO(S, st_) do { \
        const float sa_ = acc0[0] + acc1[0]; yb[yoff] = acc0[2] + acc1[2]; yoff = (st_) * 64 + 16 * w + fr; \
        const unsigned p_ = cvtpk_c(v##S, sa_); \
        UA.x = U##S; B0v.x = p_ & mk0; B1v.x = p_ & mk1; B2v.x = p_ & mk2; B3v.x = p_ & mk3; \
        const bf16x8 ua_ = __builtin_bit_cast(bf16x8, UA); \
        S0 = __builtin_amdgcn_mfma_f32_16x16x32_bf16(ua_, __builtin_bit_cast(bf16x8, B0v), S0, 0, 0, 0); \
        S1 = __builtin_amdgcn_mfma_f32_16x16x32_bf16(ua_, __builtin_bit_cast(bf16x8, B1v), S1, 0, 0, 0); \
        S2 = __builtin_amdgcn_mfma_f32_16x16x32_bf16(ua_, __builtin_bit_cast(bf16x8, B2v), S2, 0, 0, 0); \
        S3 = __builtin_amdgcn_mfma_f32_16x16x32_bf16(ua_, __builtin_bit_cast(bf16x8, B3v), S3, 0, 0, 0); \
        v4u p0_, p1_; \
        p0_.x = cvtpk_c(S0[0], S0[1]); p0_.y = cvtpk_c(S0[2], S0[3]); p0_.z = cvtpk_c(S1[0], S1[1]); p0_.w = cvtpk_c(S1[2], S1[3]); \
        p1_.x = cvtpk_c(S2[0], S2[1]); p1_.y = cvtpk_c(S2[2], S2[3]); p1_.z = cvtpk_c(S3[0], S3[1]); p1_.w = cvtpk_c(S3[2], S3[3]); \
        acc0 = __builtin_amdgcn_mfma_f32_16x16x32_bf16(A0##S, __builtin_bit_cast(bf16x8, p0_), (pg8::f32x4){0.f, 0.f, 0.f, 0.f}, 0, 0, 0); \
        acc1 = __builtin_amdgcn_mfma_f32_16x16x32_bf16(A1##S, __builtin_bit_cast(bf16x8, p1_), (pg8::f32x4){0.f, 0.f, 0.f, 0.f}, 0, 0, 0); } while (0)
            v4u UA = (v4u){0u, 0u, 0u, 0u}, B0v = UA, B1v = UA, B2v = UA, B3v = UA;
            SC_LOAD(a, 0);
            for (int st = 0; st < SC_BLK; st += 2) {
                SC_LOAD(b_, st + 1);
                SC_DO(a, st);
                if (st + 2 < SC_BLK) SC_LOAD(a, st + 2);
                SC_DO(b_, st + 1);
            }
#undef SC_LOAD
#undef SC_DO
            { const LAS float* G = (const LAS float*)(buf + SC_BLK * SC_STEP) + 4 * fq;
              S0 = S0 * *(const LAS pg8::f32x4*)(G); S1 = S1 * *(const LAS pg8::f32x4*)(G + 16); S2 = S2 * *(const LAS pg8::f32x4*)(G + 32); S3 = S3 * *(const LAS pg8::f32x4*)(G + 48); }
            yb[yoff] = acc0[2] + acc1[2];
        } else {
            const int hw = w - 4;
            if (blk > 0) { const LAS float* ypb = (const LAS float*)(lds + SC_Y) + ((blk - 1) & 1) * SC_BLK * 64;
                const int mp = scan_row((blk - 1) * SC_BLK, b, d), y0 = ((d * MT + mp) * 1024 + h * 64) * 4, ystep = (d ? -1 : 1) * 4096;
#pragma unroll
                for (int q = 0; q < 8; ++q) __builtin_amdgcn_raw_buffer_store_b32(__builtin_bit_cast(unsigned, ypb[(8 * hw + q) * 64 + lane]), YSr, lane * 4, y0 + (8 * hw + q) * ystep, 0); }
            if (blk + 1 < NBLK) scan_fill(LOr, RKr, kav, lds + ((blk + 1) & 1) * SC_BUF, blk + 1, b, h, d, hw, lane);
        }
        __syncthreads();
    }
    if (w >= 4) { const int hw = w - 4; const LAS float* ypb = (const LAS float*)(lds + SC_Y) + ((NBLK - 1) & 1) * SC_BLK * 64;
        const int mp = scan_row((NBLK - 1) * SC_BLK, b, d), y0 = ((d * MT + mp) * 1024 + h * 64) * 4, ystep = (d ? -1 : 1) * 4096;
#pragma unroll
        for (int q = 0; q < 8; ++q) __builtin_amdgcn_raw_buffer_store_b32(__builtin_bit_cast(unsigned, ypb[(8 * hw + q) * 64 + lane]), YSr, lane * 4, y0 + (8 * hw + q) * ystep, 0); }
    __syncthreads();
}

__device__ __forceinline__ void ph_rwkv_out(const Args& a, int l, int gt, int NGT) {
    const float* OJ = (const float*)(a.ws + WS_OJ); bf16* YC = (bf16*)(a.ws + WS_Y3) + (size_t)2 * MT * 1024;
    const float* subln = a.in[I_SUBLN] + l * 128;
    float lam, lam_init;
    { const int lane = threadIdx.x & 63; const float* lv = a.in[I_LAM] + l * 256;
      float l1 = lv[lane] * lv[64 + lane], l2 = lv[128 + lane] * lv[192 + lane]; l1 = wave_sum(l1); l2 = wave_sum(l2);
      lam_init = 0.8f - 0.6f * __expf(-0.3f * (float)l); lam = __expf(l1) - __expf(l2) + lam_init; }
    const float* LO = (const float*)(a.ws + WS_R1); const bf16* RK = (const bf16*)(a.ws + WS_RKVK); const float* YS = (const float*)(a.ws + WS_YS);
    bf16* YB = (bf16*)(a.ws + WS_Y3) + (size_t)MT * 1024;
    const float* ka = a.in[I_KA] + l * 1024; const float* rkw = a.in[I_RK] + l * 1024; const float* lng = a.in[I_LNG] + l * 1024; const float* lnb = a.in[I_LNB] + l * 1024;
    for (int i = gt; i < MT * 128; i += NGT) {
        const int m = i >> 7, c0 = (i & 127) * 8;
        float y[8]; float s1 = 0.f;
        { const f32x4 a0 = *(const GAS f32x4*)(YS + (size_t)m * 1024 + c0), a1 = *(const GAS f32x4*)(YS + (size_t)m * 1024 + c0 + 4),
                      b0 = *(const GAS f32x4*)(YS + ((size_t)MT + m) * 1024 + c0), b1 = *(const GAS f32x4*)(YS + ((size_t)MT + m) * 1024 + c0 + 4);
            y[0] = a0.x + b0.x; y[1] = a0.y + b0.y; y[2] = a0.z + b0.z; y[3] = a0.w + b0.w; y[4] = a1.x + b1.x; y[5] = a1.y + b1.y; y[6] = a1.z + b1.z; y[7] = a1.w + b1.w; }
#pragma unroll
        for (int e = 0; e < 8; ++e) s1 += y[e];
        s1 += __shfl_xor(s1, 1); s1 += __shfl_xor(s1, 2); s1 += __shfl_xor(s1, 4);
        const float mu = s1 * (1.f / 64.f); float s2 = 0.f;
#pragma unroll
        for (int e = 0; e < 8; ++e) { y[e] -= mu; s2 += y[e] * y[e]; }
        s2 += __shfl_xor(s2, 1); s2 += __shfl_xor(s2, 2); s2 += __shfl_xor(s2, 4);
        const float rstd = 1.f / sqrtf(s2 * (1.f / 64.f) + 64e-5f);
        float r[8], k[8], v[8];
        { const GAS v4u* rp = (const GAS v4u*)(RK + (size_t)m * 4096 + c0 * 4);
#pragma unroll
          for (int j = 0; j < 4; ++j) { const v4u q = rp[j]; r[2 * j] = bflo(q.x); k[2 * j] = bfhi(q.x); v[2 * j] = bflo(q.y); r[2 * j + 1] = bflo(q.z); k[2 * j + 1] = bfhi(q.z); v[2 * j + 1] = bflo(q.w); } }
        float rk = 0.f;
#pragma unroll
        for (int e = 0; e < 8; ++e) { const int c = c0 + e; const float am = 0.5f * (LO[(size_t)m * LOW + 3072 + c] + LO[(size_t)m * LOW + 4096 + c]);
            rk += r[e] * (k[e] * (1.f + (am - 1.f) * ka[c])) * rkw[c]; }
        rk += __shfl_xor(rk, 1); rk += __shfl_xor(rk, 2); rk += __shfl_xor(rk, 4);
        float o[8];
#pragma unroll
        for (int e = 0; e < 8; ++e) { const int c = c0 + e; o[e] = (y[e] * rstd * lng[c] + lnb[c] + rk * v[e]) * LO[(size_t)m * LOW + c]; }
        *(GAS v4u*)(YB + (size_t)m * 1024 + c0) = pack8(o);
        { const f32x4 p0 = *(const GAS f32x4*)(OJ + (size_t)m * 1024 + c0), p1 = *(const GAS f32x4*)(OJ + (size_t)m * 1024 + c0 + 4),
                      q0 = *(const GAS f32x4*)(OJ + ((size_t)MT + m) * 1024 + c0), q1 = *(const GAS f32x4*)(OJ + ((size_t)MT + m) * 1024 + c0 + 4);
          float d[8]; d[0] = p0.x - lam * q0.x; d[1] = p0.y - lam * q0.y; d[2] = p0.z - lam * q0.z; d[3] = p0.w - lam * q0.w; d[4] = p1.x - lam * q1.x; d[5] = p1.y - lam * q1.y; d[6] = p1.z - lam * q1.z; d[7] = p1.w - lam * q1.w;
          float ss = 0.f;
#pragma unroll
          for (int e = 0; e < 8; ++e) ss += d[e] * d[e];
          ss += __shfl_xor(ss, 1); ss += __shfl_xor(ss, 2); ss += __shfl_xor(ss, 4); ss += __shfl_xor(ss, 8);
          const float rinv = (1.f - lam_init) / sqrtf(ss * (1.f / 128.f) + 1e-6f);
#pragma unroll
          for (int e = 0; e < 8; ++e) d[e] = d[e] * rinv * subln[(c0 & 127) + e];
          *(GAS v4u*)(YC + (size_t)m * 1024 + c0) = pack8(d); }
    }
}

constexpr int PH_PER_LAYER = 14, NPH = 1 + NLAYER * PH_PER_LAYER;
#define IN(k) (lo <= (k) && (k) < hi)
#define SEAM(k) do { if (IN(k) && IN((k) + 1)) xcd_barrier(bar); } while (0)
#ifndef ONLY_PH
#define ONLY_PH -1
#endif
#define INL(k) ((ONLY_PH < 0 || ONLY_PH == (k)) && IN(pb + (k)))
#define SEAML(k) SEAM(pb + (k))
#ifndef PROBE_REP
#define PROBE_REP 0
#endif
#define REPL(k) for (int rep_ = 0; rep_ < (((PROBE_REP) >> (k)) & 1) + 1; ++rep_)
template <int l> __device__ __forceinline__ void layer_body(const Args& args, LAS unsigned char* lds, unsigned char* lds_raw, unsigned char* ws, const XcdBarrier& bar, int lo, int hi, int tid, int lane, int G, int bx, int vcu, int gw, int NGW, int gt, int NGT) {
        const int pb = 1 + l * PH_PER_LAYER;
        const bool last = (l == NLAYER - 1);
        float* XS = (float*)(ws + WS_XS); float* PART = (float*)(ws + WS_PART);
        const float* mods = (const float*)(ws + WS_MODS) + (size_t)l * 3 * NMOD * DM;
        const float* normg = args.in[I_NORMG] + (size_t)l * 3 * DM;
        pg8::bf16_t* XN = (pg8::bf16_t*)(ws + WS_XN);
        pg8::bf16_t* Hb = (pg8::bf16_t*)(ws + WS_R1);
        const float* xl0 = (l == 0) ? args.in[I_X] : XS; const float* xc0 = (l == 0) ? args.in[I_CTX] : XS + (size_t)NLAT * DM;

        if (INL(0)) REPL(0) ph_norm(xl0, xc0, normg, mods, 0, (bf16*)XN, XS, l == 0 ? nullptr : PART, 16, MT, gw, NGW, lane);
        SEAML(0);
        if (INL(1)) REPL(1) { pg8::Gemm g{XN, (const pg8::bf16_t*)(ws + WS_WF1 + (size_t)(l * 2 + 0) * SZ_WF1), MT, FF2, DM}; pg8::StaticOrder S; S.init(MT, FF2, G, bx);
            pg8::EpiSwiglu E{Hb, FF}; pg8::gemm_phase<pg8::EpiSwiglu, pg8::StaticOrder, true, true>(lds, g, S, E); }
        SEAML(1);
        if (INL(2)) REPL(2) { pg8::Gemm g{Hb, (const pg8::bf16_t*)(ws + WS_WF2 + (size_t)(l * 2 + 0) * SZ_WF2), MT, DM, FF}; pg8::SplitCtxOrder S{G, vcu, NLAT / 256, NCTX / 256, 16, FF / 64};
            pg8::EpiResid E{xl0, (long)((xc0 - (size_t)NLAT * DM) - xl0), XS, 0L, mods + 2 * DM, NMOD * DM, 0.5f, NLAT / 256, TSEQ / 256, PART, NCTX};
            pg8::gemm_phase<pg8::EpiResid, pg8::SplitCtxOrder, true, true>(lds, g, S, E); }
        SEAML(2);
        if (INL(3)) REPL(3) ph_norm(XS, XS + (size_t)NLAT * DM, normg + DM, mods, 3, (bf16*)XN, XS, PART, 16, MT, gw, NGW, lane);
        SEAML(3);
        if (INL(4)) REPL(4) { pg8::Gemm g{XN, (const pg8::bf16_t*)(ws + WS_WIN + (size_t)l * SZ_WIN), MT, PROJP, DM}; pg8::StaticOrder S; S.init(MT, PROJP, G, bx);
            pg8::EpiRawBf16 E{(pg8::bf16_t*)(ws + WS_P), PROJP}; pg8::gemm_phase<pg8::EpiRawBf16, pg8::StaticOrder, true, true>(lds, g, S, E); }
        SEAML(4);
        if (INL(5)) REPL(5) ph_e1(args, l, gt, NGT);
        SEAML(5);
        if (INL(6)) REPL(6) { pg8::Gemm g{(const pg8::bf16_t*)(ws + WS_ACT), (const pg8::bf16_t*)(ws + WS_WLO + (size_t)l * SZ_WLO), MT, LOW, ACTW}; pg8::LoraOrder S; S.init(MT, LOW, G, bx);
            pg8::EpiLora E{(float*)(ws + WS_R1), args.in[I_W0] + l * 2048, args.in[I_A0] + l * 2048}; pg8::gemm_phase<pg8::EpiLora, pg8::LoraOrder, true, true>(lds, g, S, E); }
        SEAML(6);
        if (INL(7)) REPL(7) {
            if (bx < 64) scan_unit(args, l, bx, lds, tid);
            else { ph_attn(args, !last, (char*)lds_raw, bx - 64, G - 64); __syncthreads(); ph_gmlp(args, l, lds, tid, bx - 64, G - 64); }
        }
        SEAML(7);
        if (INL(8)) REPL(8) ph_rwkv_out(args, l, gt, NGT);
        SEAML(8);
        if (INL(9)) REPL(9) { pg8::Gemm g{(const pg8::bf16_t*)(ws + WS_Y3), (const pg8::bf16_t*)(ws + WS_WBR + (size_t)l * SZ_WBR), 3 * MT, 3 * DM, 1024}; pg8::MergeOrder S{G, bx, MT / 256, last ? NLAT / 256 : MT / 256};
            pg8::EpiMerge E{(const pg8::bf16_t*)(ws + WS_P) + P_GATE, PROJP, args.in[I_BGATE] + (size_t)l * 3 * DM, (float*)(ws + WS_YS), XN, MT / 256};
            pg8::gemm_phase<pg8::EpiMerge, pg8::MergeOrder, true, true>(lds, g, S, E); }
        SEAML(9);
        if (INL(10)) REPL(10) { pg8::Gemm g{XN, (const pg8::bf16_t*)(ws + WS_WOUT + (size_t)l * SZ_WOUT), MT, DM, DM}; pg8::SplitCtxOrder S{G, vcu, NLAT / 256, last ? 0 : NCTX / 256, 8, DM / 64};
            pg8::EpiResid E{XS, 0L, XS, 0L, mods + 5 * DM, NMOD * DM, 1.0f, NLAT / 256, TSEQ / 256, PART, NCTX};
            pg8::gemm_phase<pg8::EpiResid, pg8::SplitCtxOrder, true, true>(lds, g, S, E); }
        SEAML(10);
        if (INL(11)) REPL(11) ph_norm(XS, XS + (size_t)NLAT * DM, normg + 2 * DM, mods, 6, (bf16*)XN, XS, PART, 8, last ? NLAT : MT, gw, NGW, lane);
        SEAML(11);
        if (INL(12)) REPL(12) { pg8::Gemm g{XN, (const pg8::bf16_t*)(ws + WS_WF1 + (size_t)(l * 2 + 1) * SZ_WF1), MT, FF2, DM}; pg8::StaticOrder S; S.init(last ? NLAT : MT, FF2, G, bx);
            pg8::EpiSwiglu E{Hb, FF}; pg8::gemm_phase<pg8::EpiSwiglu, pg8::StaticOrder, true, true>(lds, g, S, E); }
        SEAML(12);
        if (INL(13)) REPL(13) { pg8::Gemm g{Hb, (const pg8::bf16_t*)(ws + WS_WF2 + (size_t)(l * 2 + 1) * SZ_WF2), MT, DM, FF}; pg8::SplitCtxOrder S{G, vcu, NLAT / 256, last ? 0 : NCTX / 256, 16, FF / 64};
            pg8::EpiResid E{XS, 0L, last ? args.out : XS, 0L, mods + 8 * DM, NMOD * DM, 0.5f, NLAT / 256, TSEQ / 256, PART, NCTX};
            pg8::gemm_phase<pg8::EpiResid, pg8::SplitCtxOrder, true, true>(lds, g, S, E); }
        SEAML(13);
    }
__global__ void __launch_bounds__(NTHR, 2) fwd(Args args) {
    extern __shared__ __attribute__((aligned(16))) unsigned char lds_raw[];
    LAS unsigned char* lds = (LAS unsigned char*)lds_raw;
    const int tid = threadIdx.x, lane = tid & 63, wave = __builtin_amdgcn_readfirstlane(tid >> 6);
    const int G = gridDim.x; const int bx = blockIdx.x; const int vcu = (G % 8 == 0) ? (bx % 8) * (G / 8) + bx / 8 : bx;
    const int gw = vcu * NWAVES + wave, NGW = G * NWAVES, gt = vcu * NTHR + tid, NGT = G * NTHR;
    unsigned char* ws = args.ws;
    volatile LAS unsigned* MISC = (volatile LAS unsigned*)(lds + MISC_OFF);
    for (int u = tid; u < (LDS_BYTES - LDSCTL_OFF) / 4; u += NTHR) ((LAS unsigned*)(lds + LDSCTL_OFF))[u] = 0u;
    __syncthreads();
    const int lo = args.ph_lo, hi = args.ph_hi;
    const bool multi = (hi - lo) > 1;
    XcdBarrier bar; bar.bar = (unsigned*)(ws + WS_CTL) + CW_BAR; bar.x = 0; bar.st = nullptr;
    if (multi) bar = xcd_barrier_post((unsigned*)(ws + WS_CTL) + CW_BAR, MISC + 8);

    if ((ONLY_PH < 0 || ONLY_PH == 100) && IN(0)) REPL(16) { ph_ada(args, lds, tid, vcu, G); __syncthreads(); ph_weights(args, lds, tid, vcu, G); }
    SEAM(0);

    layer_body<0>(args, lds, lds_raw, ws, bar, lo, hi, tid, lane, G, bx, vcu, gw, NGW, gt, NGT);
    layer_body<1>(args, lds, lds_raw, ws, bar, lo, hi, tid, lane, G, bx, vcu, gw, NGW, gt, NGT);
#undef IN
#undef SEAM
}

#ifndef MK_PER_PHASE
#define MK_PER_PHASE 0
#endif
extern "C" void kernel_launch(void* const* d_in, const int* in_sizes, int n_in, void* d_out, int out_size, void* d_ws, size_t ws_size, hipStream_t stream) {
    static int grid = 0;
    if (grid == 0) {
        if (n_in != 31 || in_sizes[0] != NLAT * DM || out_size != NLAT * DM || ws_size < WS_END) {
            fprintf(stderr, "kernel_launch: unexpected shapes: n_in %d in0 %d out %d ws %zu (need %zu); nothing launched\n", n_in, n_in > 0 ? in_sizes[0] : -1, out_size, ws_size, (size_t)WS_END); grid = -1; return; }
        int dev = 0, cus = 0, per_cu = 0;
        if (hipGetDevice(&dev) != hipSuccess || hipDeviceGetAttribute(&cus, hipDeviceAttributeMultiprocessorCount, dev) != hipSuccess) { grid = -1; return; }
        if (hipFuncSetAttribute((const void*)fwd, hipFuncAttributeMaxDynamicSharedMemorySize, LDS_BYTES) != hipSuccess) { fprintf(stderr, "kernel_launch: hipFuncSetAttribute failed\n"); grid = -1; return; }
        if (hipOccupancyMaxActiveBlocksPerMultiprocessor(&per_cu, (const void*)fwd, NTHR, LDS_BYTES) != hipSuccess || per_cu < 1) fprintf(stderr, "kernel_launch: occupancy query says %d\n", per_cu);
        (void)hipGetLastError();
        grid = cus;
    }
    if (grid < 0) return;
    (void)hipMemsetAsync((char*)d_ws + WS_CTL, 0, CTL_ZERO_BYTES, stream);
    Args a{};
    for (int i = 0; i < 31; ++i) a.in[i] = (const float*)d_in[i];
    a.out = (float*)d_out; a.ws = (unsigned char*)d_ws;
#if MK_PER_PHASE
    for (int p = 0; p < NPH; ++p) { a.ph_lo = p; a.ph_hi = p + 1; hipLaunchKernelGGL(fwd, dim3(grid), dim3(NTHR), LDS_BYTES, stream, a); }
#else
    a.ph_lo = 0; a.ph_hi = NPH; hipLaunchKernelGGL(fwd, dim3(grid), dim3(NTHR), LDS_BYTES, stream, a);
#endif
}
```

```cpp
#include <hip/hip_runtime.h>
#include <cstdio>
#include <cstdint>
namespace pg8 {
#define PG8_LAS __attribute__((address_space(3)))
typedef unsigned short bf16_t;
typedef short bf16x8 __attribute__((ext_vector_type(8)));
typedef float f32x4 __attribute__((ext_vector_type(4)));
typedef unsigned u32x4 __attribute__((ext_vector_type(4)));
constexpr int BM = 256, BK = 64, HALF = 128, HTB = HALF * BK * 2  , STAGE_BYTES = 8 * HTB, NXCD = 8, WGM = 8;

__host__ __device__ __forceinline__ int lds_byte(int r, int c) { const int st = (r >> 4) * 2 + (c >> 5), rr = r & 15, cc = c & 31, ob = rr * 64 + cc * 2; return st * 1024 + (ob ^ (((ob >> 9) & 1) << 5)); }
__host__ __device__ __forceinline__ void stage_rc(int b, int& R, int& C) { const int st = b / 1024, sb = b % 1024, swz = sb ^ (((sb >> 9) & 1) << 5); R = (st >> 1) * 16 + swz / 64; C = (st & 1) * 32 + (swz % 64) / 2; }
__host__ __device__ __forceinline__ int perm32(int rho) { const int n = rho >> 4, i = rho & 15; return 8 * (i >> 2) + 4 * n + (i & 3); }

struct Unit { int pm, pn, ks, kn, aux; };
struct Gemm { const bf16_t* A; const bf16_t* Bt; int M, N, K; };

struct StaticOrder {
    int nM, nN, nwg, G, c;
    __host__ __device__ void init(int M, int N, int G_, int c_) { nM = M / BM; nN = N / BM; nwg = nM * nN; G = G_; c = c_; }
    __host__ __device__ bool next(int i, Unit& u) const {
        const long L = (long)i * G + c; if (L >= nwg) return false;
        int wgid = (int)L; { const int q = nwg / NXCD, r = nwg % NXCD, xcd = wgid % NXCD, off = wgid / NXCD; wgid = (xcd < r ? xcd * (q + 1) : r * (q + 1) + (xcd - r) * q) + off; }
        const int nig = WGM * nN, gid = wgid / nig, fm = gid * WGM, gsz = (nM - fm) < WGM ? (nM - fm) : WGM;
        u.pm = fm + ((wgid % nig) % gsz); u.pn = (wgid % nig) / gsz; u.ks = 0; u.kn = 0; u.aux = 0; return true;
    }
    __device__ __forceinline__ void a_ready(const Unit&) const {}
    __device__ __forceinline__ void done(const Unit&) const {}
};

__device__ __forceinline__ unsigned cvt_pk_bf16(float lo, float hi) { unsigned r; asm volatile("v_cvt_pk_bf16_f32 %0, %1, %2" : "=v"(r) : "v"(lo), "v"(hi)); return r; }
typedef float f32x2 __attribute__((ext_vector_type(2)));
typedef unsigned u32x2 __attribute__((ext_vector_type(2)));
__device__ __forceinline__ float fsigmoid(float x) { return __builtin_amdgcn_rcpf(1.f + __expf(-x)); }
__device__ __forceinline__ float bflo(unsigned w) { return __builtin_bit_cast(float, w << 16); }
__device__ __forceinline__ float bfhi(unsigned w) { return __builtin_bit_cast(float, w & 0xffff0000u); }

struct EpiSwiglu {
    static constexpr bool PERM = true, AFTER_DRAIN = false;
    bf16_t* H; int ldh;
    __device__ __forceinline__ void operator()(const f32x4 (&acc)[2][2][4][2], const Unit& u, int wr, int wc, int fr, int fq) const {
        const int col0 = u.pn * HALF + wc * 32 + 8 * fq, row0 = u.pm * BM + wr * 64 + fr;
#pragma unroll
        for (int ai = 0; ai < 2; ++ai)
#pragma unroll
            for (int m = 0; m < 4; ++m) {
                const f32x4 g0 = acc[ai][0][m][0], g1 = acc[ai][0][m][1], u0 = acc[ai][1][m][0], u1 = acc[ai][1][m][1];
                float o[8];
#pragma unroll
                for (int e = 0; e < 4; ++e) { o[e] = g0[e] * fsigmoid(g0[e]) * u0[e]; o[4 + e] = g1[e] * fsigmoid(g1[e]) * u1[e]; }
                u32x4 w; w.x = cvt_pk_bf16(o[0], o[1]); w.y = cvt_pk_bf16(o[2], o[3]); w.z = cvt_pk_bf16(o[4], o[5]); w.w = cvt_pk_bf16(o[6], o[7]);
                *(u32x4*)(H + (size_t)(row0 + ai * HALF + m * 16) * ldh + col0) = w;
            }
    }
};

struct EpiResid {
    static constexpr bool PERM = true, AFTER_DRAIN = false;
    const float* xin; long din; float* out; long dout; const float* gvec; int gstride; float scale; int nlat_tiles, tiles_per_set; float* part; int nctx_rows;
    __device__ __forceinline__ void operator()(const f32x4 (&acc)[2][2][4][2], const Unit& u, int wr, int wc, int fr, int fq) const {
        const bool isctx = u.pm >= nlat_tiles;
        const int set = isctx ? 2 : (u.pm / tiles_per_set);
        const float* gv = gvec + (size_t)set * gstride;
        const int colb = u.pn * BM + wc * 32 + 8 * fq;
        const long rbase = (long)(u.pm * BM + wr * 64 + fr) * 2048 + colb;
        const float* xi = xin + rbase + (isctx ? din : 0L); float* xo = out + rbase + (isctx ? dout : 0L);
        f32x4 gg[2][2];
#pragma unroll
        for (int bj = 0; bj < 2; ++bj)
#pragma unroll
            for (int n = 0; n < 2; ++n) gg[bj][n] = *(const f32x4*)(gv + colb + bj * HALF + 4 * n) * scale;
        if (u.kn != 0) {
            float* pp = part + ((size_t)u.aux * (size_t)nctx_rows + (size_t)((u.pm - nlat_tiles) * BM + wr * 64 + fr)) * 2048 + colb;
#pragma unroll
            for (int ai = 0; ai < 2; ++ai)
#pragma unroll
                for (int m = 0; m < 4; ++m)
#pragma unroll
                    for (int bj = 0; bj < 2; ++bj)
#pragma unroll
                        for (int n = 0; n < 2; ++n) *(f32x4*)(pp + (size_t)(ai * HALF + m * 16) * 2048 + bj * HALF + 4 * n) = gg[bj][n] * acc[ai][bj][m][n];
            return;
        }
#pragma unroll
        for (int ai = 0; ai < 2; ++ai) {
            f32x4 xv[4][2][2];
#pragma unroll
            for (int m = 0; m < 4; ++m)
#pragma unroll
                for (int bj = 0; bj < 2; ++bj)
#pragma unroll
                    for (int n = 0; n < 2; ++n) xv[m][bj][n] = *(const f32x4*)(xi + (size_t)(ai * HALF + m * 16) * 2048 + bj * HALF + 4 * n);
#pragma unroll
            for (int m = 0; m < 4; ++m)
#pragma unroll
                for (int bj = 0; bj < 2; ++bj)
#pragma unroll
                    for (int n = 0; n < 2; ++n) *(f32x4*)(xo + (size_t)(ai * HALF + m * 16) * 2048 + bj * HALF + 4 * n) = xv[m][bj][n] + gg[bj][n] * acc[ai][bj][m][n];
        }
    }
};
struct SplitCtxOrder {
    int G, c, nlat_tiles, nctx_tiles, nsplit, ntk;
    __device__ __forceinline__ bool next(int i, Unit& u) const {
        const int e = i * G + c, nl = nlat_tiles * 8;
        if (e < nl) { u.pm = e >> 3; u.pn = e & 7; u.ks = 0; u.kn = 0; u.aux = 0; return true; }
        const int f = e - nl; if (f >= nctx_tiles * 8 * nsplit) return false;
        const int sp = f % nsplit, t = f / nsplit, np = ntk >> 1, p0 = sp * np / nsplit, p1 = (sp + 1) * np / nsplit;
        u.pm = nlat_tiles + (t >> 3); u.pn = t & 7; u.ks = 2 * p0; u.kn = 2 * (p1 - p0); u.aux = sp; return true;
    }
    __device__ __forceinline__ void a_ready(const Unit&) const {}
    __device__ __forceinline__ void done(const Unit&) const {}
};
struct LoraOrder : StaticOrder {
    __device__ __forceinline__ bool next(int i, Unit& u) const {
        if (!StaticOrder::next(i, u)) return false;
        const int sec = u.pn >> 2; int k4 = 4; asm volatile("" : "+s"(k4));
        u.ks = sec == 0 ? 0 : (sec <= 2 ? 4 : 8); u.kn = k4; return true;
    }
};

__device__ __forceinline__ float ftanh_e(float x) { return 1.f - 2.f * __builtin_amdgcn_rcpf(__expf(2.f * x) + 1.f); }
__device__ __forceinline__ float gelu_e(float x) { return 0.5f * x * (1.f + ftanh_e(0.7978845608f * (x + 0.044715f * x * x * x))); }
struct EpiProj {
    static constexpr bool PERM = true, AFTER_DRAIN = false;
    bf16_t* P; int ldp; bf16_t* ACT; bf16_t* QK; const float* qn; const float* kn; const float* rope; int nlat_rows, tseq;
    __device__ __forceinline__ void operator()(const f32x4 (&acc)[2][2][4][2], const Unit& u, int wr, int wc, int fr, int fq) const {
        const int pn = u.pn, row0 = u.pm * BM + wr * 64 + fr;
        if (pn >= 23 && pn <= 30) {
            const bool isq = pn <= 26; const int gi = (pn - 23) * 4 + wc;
            const float* gain = isq ? qn : kn;
            f32x4 gg[2][2];
#pragma unroll
            for (int bj = 0; bj < 2; ++bj)
#pragma unroll
                for (int n = 0; n < 2; ++n) gg[bj][n] = *(const f32x4*)(gain + bj * 32 + n * 16 + 4 * fq);
            const float qs = isq ? 0.18033688011112042f : 1.f;
#pragma unroll
            for (int ai = 0; ai < 2; ++ai)
#pragma unroll
                for (int m = 0; m < 4; ++m) {
                    const int row = row0 + ai * HALF + m * 16;
                    f32x4 x[2][2]; float ss = 0.f;
#pragma unroll
                    for (int bj = 0; bj < 2; ++bj)
#pragma unroll
                        for (int n = 0; n < 2; ++n) { x[bj][n] = acc[ai][bj][m][n]; ss += (x[bj][n][0] * x[bj][n][0] + x[bj][n][1] * x[bj][n][1]) + (x[bj][n][2] * x[bj][n][2] + x[bj][n][3] * x[bj][n][3]); }
                    ss += __shfl_xor(ss, 16); ss += __shfl_xor(ss, 32);
                    const float rinv = __builtin_amdgcn_rsqf(ss * (1.f / 64.f) + 1e-6f);
#pragma unroll
                    for (int bj = 0; bj < 2; ++bj)
#pragma unroll
                        for (int n = 0; n < 2; ++n) x[bj][n] = x[bj][n] * rinv * gg[bj][n];
                    if (row < nlat_rows) { const int t = row & (tseq - 1);
#pragma unroll
                        for (int bj = 0; bj < 2; ++bj) { const int p = bj == 0 ? (t >> 6) : (t & 63);
                            const f32x4 cs0 = *(const f32x4*)(rope + (p * 16 + 4 * fq) * 2), cs1 = *(const f32x4*)(rope + (p * 16 + 4 * fq) * 2 + 4);
                            const f32x4 c = {cs0[0], cs0[2], cs1[0], cs1[2]}, s = {cs0[1], cs0[3], cs1[1], cs1[3]};
                            const f32x4 a = x[bj][0], b2 = x[bj][1];
                            x[bj][0] = a * c - b2 * s; x[bj][1] = b2 * c + a * s; } }
                    bf16_t* dst = QK + (size_t)row * 2048 + gi * 64 + 8 * fq;
#pragma unroll
                    for (int bj = 0; bj < 2; ++bj) { const f32x4 v0 = x[bj][0] * qs, v1 = x[bj][1] * qs;
                        u32x4 w; w.x = cvt_pk_bf16(v0[0], v0[1]); w.y = cvt_pk_bf16(v0[2], v0[3]); w.z = cvt_pk_bf16(v1[0], v1[1]); w.w = cvt_pk_bf16(v1[2], v1[3]);
                        *(u32x4*)(dst + bj * 32) = w; }
                }
            return;
        }
        if (pn >= 20 && pn <= 22) {
#pragma unroll
            for (int bj = 0; bj < 2; ++bj) {
                const int cc = bj * HALF + wc * 32 + 8 * fq;
                int dcol, fn;
                if (pn == 20) { dcol = cc; fn = 1; }
                else if (pn == 21) { if (cc < 96) { dcol = 256 + cc; fn = 2; } else if (cc < 192) { dcol = 384 + (cc - 96); fn = 2; } else { dcol = 512 + (cc - 192); fn = 0; } }
                else { if (cc < 32) { dcol = 576 + cc; fn = 0; } else if (cc < 128) { dcol = 640 + (cc - 32); fn = 0; } else { dcol = -1; fn = 0; } }
                if (dcol < 0) continue;
#pragma unroll
                for (int ai = 0; ai < 2; ++ai)
#pragma unroll
                    for (int m = 0; m < 4; ++m) {
                        f32x4 v0 = acc[ai][bj][m][0], v1 = acc[ai][bj][m][1];
                        if (fn != 0) {
#pragma unroll
                            for (int e = 0; e < 4; ++e) { v0[e] = fn == 1 ? fsigmoid(v0[e]) : ftanh_e(v0[e]); v1[e] = fn == 1 ? fsigmoid(v1[e]) : ftanh_e(v1[e]); } }
                        u32x4 w; w.x = cvt_pk_bf16(v0[0], v0[1]); w.y = cvt_pk_bf16(v0[2], v0[3]); w.z = cvt_pk_bf16(v1[0], v1[1]); w.w = cvt_pk_bf16(v1[2], v1[3]);
                        *(u32x4*)(ACT + (size_t)(row0 + ai * HALF + m * 16) * 768 + dcol) = w;
                    }
            }
            return;
        }
        const bool dogelu = pn < 8;
        const int col0 = pn * BM + wc * 32 + 8 * fq;
#pragma unroll
        for (int ai = 0; ai < 2; ++ai)
#pragma unroll
            for (int m = 0; m < 4; ++m) {
                bf16_t* rowp = P + (size_t)(row0 + ai * HALF + m * 16) * ldp + col0;
#pragma unroll
                for (int bj = 0; bj < 2; ++bj) {
                    f32x4 v0 = acc[ai][bj][m][0], v1 = acc[ai][bj][m][1];
                    if (dogelu) {
#pragma unroll
                        for (int e = 0; e < 4; ++e) { v0[e] = gelu_e(v0[e]); v1[e] = gelu_e(v1[e]); } }
                    u32x4 w; w.x = cvt_pk_bf16(v0[0], v0[1]); w.y = cvt_pk_bf16(v0[2], v0[3]); w.z = cvt_pk_bf16(v1[0], v1[1]); w.w = cvt_pk_bf16(v1[2], v1[3]);
                    *(u32x4*)(rowp + bj * HALF) = w;
                }
            }
    }
};

struct EpiLora {
    static constexpr bool PERM = true, AFTER_DRAIN = false;
    float* LO; const float* w0; const float* a0;
    __device__ __forceinline__ void operator()(const f32x4 (&acc)[2][2][4][2], const Unit& u, int wr, int wc, int fr, int fq) const {
        const int sec = u.pn >> 2;
        const int col0 = u.pn * BM + wc * 32 + 8 * fq, row0 = u.pm * BM + wr * 64 + fr, c0 = col0 - sec * 1024;
        const float* bp = (sec <= 2 ? w0 + (sec <= 1 ? 0 : 1024) : a0 + (sec - 3) * 1024) + c0;
#pragma unroll
        for (int ai = 0; ai < 2; ++ai)
#pragma unroll
            for (int m = 0; m < 4; ++m) {
                float* rowp = LO + (size_t)(row0 + ai * HALF + m * 16) * 5120 + col0;
#pragma unroll
                for (int bj = 0; bj < 2; ++bj)
#pragma unroll
                    for (int n = 0; n < 2; ++n) {
                        f32x4 v = acc[ai][bj][m][n];
                        if (sec >= 1) { v = v + *(const f32x4*)(bp + bj * HALF + 4 * n);
#pragma unroll
                            for (int e = 0; e < 4; ++e) { const float s = fsigmoid(v[e]); v[e] = (sec <= 2) ? __expf(-0.60653066f * s) : s; }
                        }
                        *(f32x4*)(rowp + bj * HALF + 4 * n) = v;
                    }
                asm volatile("" ::: "memory");
            }
    }
};

struct EpiMerge {
    static constexpr bool PERM = true, AFTER_DRAIN = false;
    const bf16_t* pgate; int ldp;
    const float* bgate;
    float* ZF; bf16_t* Z; int mtiles;
    __device__ __forceinline__ void operator()(const f32x4 (&acc)[2][2][4][2], const Unit& u, int wr, int wc, int fr, int fq) const {
        const int br = u.pn >> 3, pn = u.pn & 7, pm = u.pm - mtiles * br;
        const int col0 = pn * BM + wc * 32 + 8 * fq, row0 = pm * BM + wr * 64 + fr;
        f32x4 bb[2][2];
#pragma unroll
        for (int bj = 0; bj < 2; ++bj)
#pragma unroll
            for (int n = 0; n < 2; ++n) bb[bj][n] = *(const f32x4*)(bgate + br * 2048 + col0 + bj * HALF + 4 * n);
#pragma unroll
        for (int ai = 0; ai < 2; ++ai)
#pragma unroll
            for (int mp = 0; mp < 2; ++mp) {
                u32x4 pg[2][2]; f32x4 zf[2][2][2];
#pragma unroll
                for (int mm = 0; mm < 2; ++mm)
#pragma unroll
                    for (int bj = 0; bj < 2; ++bj) { const size_t row = (size_t)(row0 + ai * HALF + (2 * mp + mm) * 16);
                        pg[mm][bj] = *(const u32x4*)(pgate + row * ldp + br * 2048 + col0 + bj * HALF);
                        if (br >= 1) { zf[mm][bj][0] = *(const f32x4*)(ZF + row * 2048 + col0 + bj * HALF); zf[mm][bj][1] = *(const f32x4*)(ZF + row * 2048 + col0 + bj * HALF + 4); } }
#pragma unroll
                for (int mm = 0; mm < 2; ++mm)
#pragma unroll
                    for (int bj = 0; bj < 2; ++bj) { const int m = 2 * mp + mm; const size_t row = (size_t)(row0 + ai * HALF + m * 16); const u32x4 q = pg[mm][bj];
                        f32x4 g0, g1;
                        g0[0] = bflo(q.x); g0[1] = bfhi(q.x); g0[2] = bflo(q.y); g0[3] = bfhi(q.y); g1[0] = bflo(q.z); g1[1] = bfhi(q.z); g1[2] = bflo(q.w); g1[3] = bfhi(q.w);
                        g0 = g0 + bb[bj][0]; g1 = g1 + bb[bj][1];
                        f32x4 v0, v1;
#pragma unroll
                        for (int e = 0; e < 4; ++e) { v0[e] = fsigmoid(g0[e]) * acc[ai][bj][m][0][e]; v1[e] = fsigmoid(g1[e]) * acc[ai][bj][m][1][e]; }
                        float* zp = ZF + row * 2048 + col0 + bj * HALF;
                        if (br >= 1) { v0 = v0 + zf[mm][bj][0]; v1 = v1 + zf[mm][bj][1]; }
                        if (br <= 1) { *(f32x4*)zp = v0; *(f32x4*)(zp + 4) = v1; }
                        else { u32x4 w; w.x = cvt_pk_bf16(v0[0], v0[1]); w.y = cvt_pk_bf16(v0[2], v0[3]); w.z = cvt_pk_bf16(v1[0], v1[1]); w.w = cvt_pk_bf16(v1[2], v1[3]);
                            *(u32x4*)(Z + row * 2048 + col0 + bj * HALF) = w; } }
            }
    }
};
struct MergeOrder {
    int G, c, mtiles, mactive;
    __device__ __forceinline__ bool next(int i, Unit& u) const {
        const int t = (i / 3) * G + c, br = i % 3; if (t >= mactive * 8) return false;
        u.pm = (t >> 3) + mtiles * br; u.pn = (t & 7) + 8 * br; u.ks = 0; u.kn = 0; u.aux = 0; return true;
    }
    __device__ __forceinline__ void a_ready(const Unit&) const {}
    __device__ __forceinline__ void done(const Unit&) const {}
};

template <class Epi, class Sched, bool ALIGN_EPI = false, bool SP2 = false>
__device__ __forceinline__ void gemm_phase(PG8_LAS unsigned char* lds, const Gemm g, const Sched& S, const Epi& E) {
    const int tid = threadIdx.x, wid = __builtin_amdgcn_readfirstlane(tid >> 6), lane = tid & 63, wr = wid >> 2, wc = wid & 3, fr = lane & 15, fq = lane >> 4;
    const int K = g.K, nt = K / BK;
    unsigned voffA[2], voffB[2];
#pragma unroll
    for (int i = 0; i < 2; ++i) { int R, C; stage_rc(tid * 16 + i * 8192, R, C); const int Rb = Epi::PERM ? ((R & ~31) + perm32(R & 31)) : R;
        voffA[i] = (unsigned)(R * K + C) * 2u; voffB[i] = (unsigned)(Rb * K + C) * 2u; }
    const size_t kstep = (size_t)(BK * 2);
    const size_t hstep = (size_t)HALF * K * 2;
    const size_t tstep = 2 * hstep;
    const unsigned ldsw = (unsigned)wid * 1024u;
    const int aoff = lds_byte(wr * 64 + fr, fq * 8), boff = lds_byte(wc * 32 + fr, fq * 8);
#define PG8_SA(b, h) (((b) * 2 + (h)) * HTB)
#define PG8_SB(b, h) ((4 + (b) * 2 + (h)) * HTB)
#define PG8_STAGE(bufoff, gbase, voff) do { _Pragma("unroll") for (int _i = 0; _i < 2; ++_i) \
        __builtin_amdgcn_global_load_lds((const unsigned*)((const char*)(gbase) + (voff)[_i]), (PG8_LAS unsigned*)(lds + (bufoff) + ldsw + _i * 8192), 16, 0, 0); } while (0)
#define PG8_LDA(dst, b, h) do { _Pragma("unroll") for (int m = 0; m < 4; ++m) _Pragma("unroll") for (int k = 0; k < 2; ++k) dst[m][k] = *(const PG8_LAS bf16x8*)(lds + PG8_SA(b, h) + aoff + m * 2048 + k * 1024); } while (0)
#define PG8_LDB(dst, b, h) do { _Pragma("unroll") for (int n = 0; n < 2; ++n) _Pragma("unroll") for (int k = 0; k < 2; ++k) dst[n][k] = *(const PG8_LAS bf16x8*)(lds + PG8_SB(b, h) + boff + n * 2048 + k * 1024); } while (0)
#define PG8_MMA(ai, bj, At, Bt) do { __builtin_amdgcn_s_setprio(1); _Pragma("unroll") for (int m = 0; m < 4; ++m) _Pragma("unroll") for (int n = 0; n < 2; ++n) _Pragma("unroll") for (int k = 0; k < 2; ++k) \
        acc[ai][bj][m][n] = __builtin_amdgcn_mfma_f32_16x16x32_bf16(Bt[n][k], At[m][k], acc[ai][bj][m][n], 0, 0, 0); __builtin_amdgcn_s_setprio(0); } while (0)
#define PG8_WAIT_V(n) asm volatile("s_waitcnt vmcnt(" #n ")" ::: "memory")
#define PG8_WAIT_L(n) asm volatile("s_waitcnt lgkmcnt(" #n ")" ::: "memory")
#define PG8_BAR __builtin_amdgcn_s_barrier()
#define PG8_SCHED __builtin_amdgcn_sched_barrier(0)
    Unit cur, nxt; int ui = 0;
    if (!S.next(0, cur)) return;
    f32x4 acc[2][2][4][2];
#pragma unroll
    for (int a = 0; a < 2; ++a)
#pragma unroll
        for (int b = 0; b < 2; ++b)
#pragma unroll
            for (int m = 0; m < 4; ++m)
#pragma unroll
                for (int n = 0; n < 2; ++n) acc[a][b][m][n] = (f32x4){0.f, 0.f, 0.f, 0.f};
    bf16x8 At[4][2], B0[2][2], B1[2][2];
    const char* cA = (const char*)g.A + (size_t)cur.pm * tstep + (size_t)cur.ks * kstep; const char* cB = (const char*)g.Bt + (size_t)cur.pn * tstep + (size_t)cur.ks * kstep;
    int ntc = cur.kn ? cur.kn : nt;
    S.a_ready(cur);
    if constexpr (SP2) {
        PG8_STAGE(PG8_SB(0, 0), cB, voffB); PG8_STAGE(PG8_SB(0, 1), cB + hstep, voffB); PG8_STAGE(PG8_SA(0, 0), cA, voffA); PG8_STAGE(PG8_SA(0, 1), cA + hstep, voffA);
        if (wr == 1) PG8_BAR;
        PG8_WAIT_V(2); PG8_BAR;
        PG8_STAGE(PG8_SB(1, 0), cB + kstep, voffB); PG8_STAGE(PG8_SA(1, 0), cA + kstep, voffA); PG8_STAGE(PG8_SB(1, 1), cB + hstep + kstep, voffB);
        PG8_WAIT_V(6); PG8_BAR;
    } else {
        PG8_STAGE(PG8_SB(0, 0), cB, voffB); PG8_STAGE(PG8_SA(0, 0), cA, voffA); PG8_STAGE(PG8_SB(0, 1), cB + hstep, voffB); PG8_STAGE(PG8_SA(0, 1), cA + hstep, voffA);
        if (wr == 1) PG8_BAR;
        PG8_WAIT_V(4); PG8_BAR;
        PG8_STAGE(PG8_SB(1, 0), cB + kstep, voffB); PG8_STAGE(PG8_SA(1, 0), cA + kstep, voffA); PG8_STAGE(PG8_SB(1, 1), cB + hstep + kstep, voffB);
        PG8_WAIT_V(6); PG8_BAR;
    }
    for (;;) {
        const bool has_next = S.next(ui + 1, nxt);
        const char* nA = has_next ? (const char*)g.A + (size_t)nxt.pm * tstep + (size_t)nxt.ks * kstep : cA; const char* nB = has_next ? (const char*)g.Bt + (size_t)nxt.pn * tstep + (size_t)nxt.ks * kstep : cB;
        for (int t = 0; t < ntc; t += 2) {
            const bool last = (t == ntc - 2);
            const char* a1 = cA + (size_t)(t + 1) * kstep;
            const char* a2 = last ? nA : cA + (size_t)(t + 2) * kstep; const char* b2 = last ? nB : cB + (size_t)(t + 2) * kstep;
            const char* a3 = a2 + kstep; const char* b3 = b2 + kstep;
            if (last && has_next) S.a_ready(nxt);
            if constexpr (SP2) {
            PG8_LDB(B0, 0, 0); PG8_LDB(B1, 0, 1); PG8_SCHED; PG8_LDA(At, 0, 0); PG8_STAGE(PG8_SA(1, 1), a1 + hstep, voffA);
            PG8_WAIT_V(8); PG8_WAIT_L(0); PG8_BAR; PG8_MMA(0, 0, At, B0); PG8_MMA(0, 1, At, B1); PG8_BAR; PG8_SCHED;
            PG8_LDA(At, 0, 1); PG8_STAGE(PG8_SB(0, 0), b2, voffB); PG8_STAGE(PG8_SB(0, 1), b2 + hstep, voffB); PG8_STAGE(PG8_SA(0, 0), a2, voffA);
            PG8_WAIT_V(8); PG8_WAIT_L(0); PG8_BAR; PG8_MMA(1, 0, At, B0); PG8_MMA(1, 1, At, B1); PG8_BAR; PG8_SCHED;
            PG8_LDB(B0, 1, 0); PG8_LDB(B1, 1, 1); PG8_SCHED; PG8_LDA(At, 1, 0); PG8_STAGE(PG8_SA(0, 1), a2 + hstep, voffA);
            PG8_WAIT_V(8); PG8_WAIT_L(0); PG8_BAR; PG8_MMA(0, 0, At, B0); PG8_MMA(0, 1, At, B1); PG8_BAR; PG8_SCHED;
            PG8_LDA(At, 1, 1); PG8_STAGE(PG8_SB(1, 0), b3, voffB); PG8_STAGE(PG8_SB(1, 1), b3 + hstep, voffB); PG8_STAGE(PG8_SA(1, 0), a3, voffA);
            PG8_WAIT_V(8); PG8_WAIT_L(0); PG8_BAR; PG8_MMA(1, 0, At, B0); PG8_MMA(1, 1, At, B1); PG8_BAR; PG8_SCHED;
            } else {
            PG8_LDB(B0, 0, 0); PG8_SCHED; PG8_LDA(At, 0, 0); PG8_STAGE(PG8_SA(1, 1), a1 + hstep, voffA);
            PG8_WAIT_L(8); PG8_BAR; PG8_WAIT_L(0); PG8_MMA(0, 0, At, B0); PG8_BAR; PG8_SCHED;
            PG8_LDB(B1, 0, 1); PG8_STAGE(PG8_SB(0, 0), b2, voffB);
            PG8_BAR; PG8_WAIT_L(0); PG8_MMA(0, 1, At, B1); PG8_BAR;
            PG8_LDA(At, 0, 1); PG8_STAGE(PG8_SA(0, 0), a2, voffA);
            PG8_BAR; PG8_WAIT_L(0); PG8_MMA(1, 0, At, B0); PG8_BAR; PG8_SCHED;
            PG8_STAGE(PG8_SB(0, 1), b2 + hstep, voffB);
            PG8_WAIT_V(6); PG8_BAR; PG8_MMA(1, 1, At, B1); PG8_BAR;
            PG8_LDB(B0, 1, 0); PG8_SCHED; PG8_LDA(At, 1, 0); PG8_STAGE(PG8_SA(0, 1), a2 + hstep, voffA);
            PG8_WAIT_L(8); PG8_BAR; PG8_WAIT_L(0); PG8_MMA(0, 0, At, B0); PG8_BAR; PG8_SCHED;
            PG8_LDB(B1, 1, 1); PG8_STAGE(PG8_SB(1, 0), b3, voffB);
            PG8_BAR; PG8_WAIT_L(0); PG8_MMA(0, 1, At, B1); PG8_BAR;
            PG8_LDA(At, 1, 1); PG8_STAGE(PG8_SA(1, 0), a3, voffA);
            PG8_BAR; PG8_WAIT_L(0); PG8_MMA(1, 0, At, B0); PG8_BAR; PG8_SCHED;
            PG8_STAGE(PG8_SB(1, 1), b3 + hstep, voffB);
            PG8_WAIT_V(6); PG8_BAR; PG8_MMA(1, 1, At, B1); PG8_BAR;
            }
        }
        if constexpr (ALIGN_EPI) { if (wr == 0) PG8_BAR; }
        if constexpr (!Epi::AFTER_DRAIN) { E(acc, cur, wr, wc, fr, fq); S.done(cur); }
        if (!has_next) break;
#pragma unroll
        for (int a = 0; a < 2; ++a)
#pragma unroll
            for (int b = 0; b < 2; ++b)
#pragma unroll
                for (int m = 0; m < 4; ++m)
#pragma unroll
                    for (int n = 0; n < 2; ++n) acc[a][b][m][n] = (f32x4){0.f, 0.f, 0.f, 0.f};
        cur = nxt; cA = nA; cB = nB; ++ui; ntc = cur.kn ? cur.kn : nt;
        if constexpr (ALIGN_EPI) { if (wr == 1) PG8_BAR; }
    }
    PG8_WAIT_V(0);
    if constexpr (!ALIGN_EPI) { if (wr == 0) PG8_BAR; }
    PG8_BAR;
    if constexpr (Epi::AFTER_DRAIN) { E.fused(acc, cur, wr, wc, fr, fq, lds, wid, lane); S.done(cur); }
#undef PG8_SA
#undef PG8_SB
#undef PG8_STAGE
#undef PG8_LDA
#undef PG8_LDB
#undef PG8_MMA
#undef PG8_WAIT_V
#undef PG8_WAIT_L
#undef PG8_BAR
#undef PG8_SCHED
}
}

constexpr int NWAVES = 8, NTHR = NWAVES * 64;
constexpr int DM = 2048, FF = 5504, FF2 = 2 * FF, NLAT = 8192, NCTX = 512, MT = NLAT + NCTX, TSEQ = 4096, TCTX = 256;
constexpr int PROJ = 14976, PROJP = 15104;
constexpr int P_U = 0, P_V = 1024, P_RKV = 2048, P_G = 5120, P_W = 5376, P_A = 5568, P_QKV = 5760, P_GATE = 8832;
constexpr int P_V2 = 31 * 256, P_GATE2 = 35 * 256;
constexpr int ACTW = 768, LOW = 5120;
constexpr int NLAYER = 2, NMOD = 9;

constexpr size_t MiB = 1u << 20;
constexpr size_t al(size_t x) { return (x + MiB - 1) / MiB * MiB; }
constexpr size_t WS_CTL = 0, CTL_ZERO_BYTES = 1 * MiB;
constexpr size_t WS_MODS = 1 * MiB;
constexpr size_t WS_ROPE = WS_MODS + al((size_t)NLAYER * 3 * NMOD * DM * 4);
constexpr size_t WS_WF1 = WS_ROPE + MiB;
constexpr size_t SZ_WF1 = (size_t)FF2 * DM * 2;
constexpr size_t WS_WF2 = WS_WF1 + al(4 * SZ_WF1);
constexpr size_t SZ_WF2 = (size_t)DM * FF * 2;
constexpr size_t WS_WIN = WS_WF2 + al(4 * SZ_WF2);
constexpr size_t SZ_WIN = (size_t)PROJP * DM * 2;
constexpr size_t WS_WLO = WS_WIN + al(2 * SZ_WIN);
constexpr size_t SZ_WLO = (size_t)LOW * ACTW * 2;
constexpr size_t WS_WBR = WS_WLO + al(2 * SZ_WLO);
constexpr size_t SZ_WBR = (size_t)3 * DM * 1024 * 2;
constexpr size_t WS_WOUT = WS_WBR + al(2 * SZ_WBR);
constexpr size_t SZ_WOUT = (size_t)DM * DM * 2;
constexpr size_t WS_XS = WS_WOUT + al(2 * SZ_WOUT);
constexpr size_t WS_XN = WS_XS + al((size_t)MT * DM * 4);
constexpr size_t WS_P = WS_XN + al((size_t)MT * DM * 2);
constexpr size_t WS_R1 = WS_P + al((size_t)MT * PROJP * 2);
constexpr size_t WS_ACT = WS_R1 + al((size_t)MT * LOW * 4);
constexpr size_t WS_RKVK = WS_ACT + al((size_t)MT * ACTW * 2);
constexpr size_t WS_QK = WS_RKVK + al((size_t)MT * 4096 * 2);
constexpr size_t WS_YS = WS_QK + al((size_t)MT * DM * 2);
constexpr size_t WS_Y3 = WS_YS + al((size_t)2 * MT * 1024 * 4);
constexpr size_t WS_OJ = WS_Y3 + al((size_t)3 * MT * 1024 * 2);
constexpr size_t WS_PART = WS_OJ + al((size_t)2 * MT * 1024 * 4);
constexpr size_t WS_END = WS_PART + al((size_t)16 * NCTX * DM * 4);

constexpr int CW_TMO = 0, CW_CODE = 1, CW_BAR = 4096;

constexpr int RING_BYTES = 131072, LDSCTL_OFF = RING_BYTES, MISC_OFF = LDSCTL_OFF + 320, LDS_BYTES = 147456;

#define GAS __attribute__((address_space(1)))
#define LAS __attribute__((address_space(3)))
typedef unsigned short bf16;
typedef unsigned v4u __attribute__((ext_vector_type(4)));
typedef unsigned v2u __attribute__((ext_vector_type(2)));
typedef float f32x4 __attribute__((ext_vector_type(4)));
typedef short bf16x8 __attribute__((ext_vector_type(8)));
typedef GAS unsigned gu32;
#define RLX_AGENT __ATOMIC_RELAXED, __HIP_MEMORY_SCOPE_AGENT
__device__ __forceinline__ unsigned f2bf(float f) { unsigned u = __builtin_bit_cast(unsigned, f); return (u + 0x7fffu + ((u >> 16) & 1u)) >> 16; }
__device__ __forceinline__ unsigned pk2(float lo, float hi) { return f2bf(lo) | (f2bf(hi) << 16); }
__device__ __forceinline__ float bflo(unsigned w) { return __builtin_bit_cast(float, w << 16); }
__device__ __forceinline__ float bfhi(unsigned w) { return __builtin_bit_cast(float, w & 0xffff0000u); }
__device__ __forceinline__ float bf1(bf16 h) { return __builtin_bit_cast(float, (unsigned)h << 16); }
__device__ __forceinline__ void unpack8(const v4u w, float (&f)[8]) { f[0] = bflo(w.x); f[1] = bfhi(w.x); f[2] = bflo(w.y); f[3] = bfhi(w.y); f[4] = bflo(w.z); f[5] = bfhi(w.z); f[6] = bflo(w.w); f[7] = bfhi(w.w); }
__device__ __forceinline__ v4u pack8(const float (&f)[8]) { v4u w; w.x = pk2(f[0], f[1]); w.y = pk2(f[2], f[3]); w.z = pk2(f[4], f[5]); w.w = pk2(f[6], f[7]); return w; }
__device__ __forceinline__ float fsigm(float x) { return __builtin_amdgcn_rcpf(1.f + __expf(-x)); }
__device__ __forceinline__ float ftanh(float x) { return 1.f - 2.f * __builtin_amdgcn_rcpf(__expf(2.f * x) + 1.f); }
__device__ __forceinline__ float gelu_t(float x) { return 0.5f * x * (1.f + ftanh(0.7978845608f * (x + 0.044715f * x * x * x))); }
__device__ __forceinline__ float wave_sum(float v) {
#pragma unroll
    for (int o = 1; o < 64; o <<= 1) v += __shfl_xor(v, o);
    return v;
}
#define XB_TMO      128
#define XB_XCNT(j)  (256  + 64 * (j))
#define XB_XSUB(j)  (1280 + 64 * (j))
#define XB_XGEN(j)  (2304 + 64 * (j))
#define XB_TOP      3328
#define XB_TOPGEN   3392
#define XCD_BAR_WORDS 3456
#define XB_SPIN_CAP (1u << 18)

__device__ __forceinline__ unsigned xb_ld(unsigned* p)              { return __hip_atomic_load(p, __ATOMIC_RELAXED, __HIP_MEMORY_SCOPE_AGENT); }
__device__ __forceinline__ unsigned xb_add(unsigned* p, unsigned v) { return __hip_atomic_fetch_add(p, v, __ATOMIC_RELAXED, __HIP_MEMORY_SCOPE_AGENT); }
__device__ __forceinline__ unsigned xb_xcc_id() { return (unsigned)__builtin_amdgcn_s_getreg((3 << 11) | 20) & 0xFu; }
#define XB_SPIN(cond, bar) do { unsigned _sp = 0; while (cond) { __builtin_amdgcn_s_sleep(1); \
    if ((++_sp & 255u) == 0u) { if (xb_ld(&(bar)[XB_TMO])) break; if (_sp > XB_SPIN_CAP) { atomicAdd(&(bar)[XB_TMO], 1u); break; } } } } while (0)

struct XcdBarrier {
    unsigned* bar; unsigned x;
    volatile LAS unsigned* st;
};

__device__ __forceinline__ XcdBarrier xcd_barrier_post(unsigned* bar, volatile LAS unsigned* st) {
    XcdBarrier b; b.bar = bar; b.x = xb_xcc_id(); b.st = st;
    if (threadIdx.x == 0) (void)xb_add(&bar[XB_XCNT(b.x)], 1u);
    return b;
}
__device__ __forceinline__ void xcd_barrier_complete(unsigned* bar, unsigned x, unsigned& nloc, unsigned& nx) {
    const unsigned G = gridDim.x * gridDim.y * gridDim.z;
    unsigned sum, cnt, mine, sp = 0u;
    for (;;) {
        sum = 0u; cnt = 0u; mine = 0u;
#pragma unroll
        for (unsigned j = 0; j < 16; ++j) { const unsigned c = xb_ld(&bar[XB_XCNT(j)]); sum += c; cnt += (c > 0u) ? 1u : 0u; mine = (j == x) ? c : mine; }
        if (sum == G) break;
        __builtin_amdgcn_s_sleep(1);
        if ((++sp & 255u) == 0u) { if (xb_ld(&bar[XB_TMO])) break; if (sp > XB_SPIN_CAP) { atomicAdd(&bar[XB_TMO], 1u); break; } }
    }
    nloc = mine > 0u ? mine : 1u; nx = cnt > 0u ? cnt : 1u;
}

__device__ __forceinline__ void xcd_barrier(const XcdBarrier& b) {
    asm volatile("s_waitcnt vmcnt(0)" ::: "memory");
    __syncthreads();
    if (threadIdx.x == 0) {
        unsigned* bar = b.bar;
        __builtin_amdgcn_s_waitcnt(0);
        unsigned nloc = b.st[0], nx = b.st[1];
        if (nloc == 0u) { xcd_barrier_complete(bar, b.x, nloc, nx); b.st[0] = nloc; b.st[1] = nx; }
        const unsigned old = xb_add(&bar[XB_XSUB(b.x)], 1u);
        const unsigned gen = old / nloc;
        if (old + 1u == (gen + 1u) * nloc) {
            __builtin_amdgcn_fence(__ATOMIC_RELEASE, "agent");
            asm volatile("s_waitcnt vmcnt(0)" ::: "memory");
            const unsigned og = xb_add(&bar[XB_TOP], 1u);
            const unsigned tg = og / nx;
            if (og + 1u == (tg + 1u) * nx) xb_add(&bar[XB_TOPGEN], 1u);
            else XB_SPIN(xb_ld(&bar[XB_TOPGEN]) == tg, bar);
            __builtin_amdgcn_fence(__ATOMIC_ACQUIRE, "agent");
            xb_add(&bar[XB_XGEN(b.x)], 1u);
            asm volatile("s_waitcnt vmcnt(0)" ::: "memory");
        } else {
            XB_SPIN(xb_ld(&bar[XB_XGEN(b.x)]) == gen, bar);
            __builtin_amdgcn_fence(__ATOMIC_ACQUIRE, "agent");
            asm volatile("s_waitcnt vmcnt(0)" ::: "memory");
        }
    }
    __syncthreads();
}

struct Args { const float* in[31]; float* out; unsigned char* ws; int ph_lo, ph_hi; };
enum In { I_X = 0, I_C, I_CTX, I_CCTX, I_WADA, I_BADA, I_NORMG, I_FFNIN, I_FFNOUT, I_WIN, I_GMVN, I_GMWS, I_GMBS, I_CONV, I_W0, I_WUP, I_A0, I_AUP, I_GUP, I_KK, I_KA, I_RK, I_LNG, I_LNB,
          I_QN, I_KN, I_LAM, I_SUBLN, I_WBR, I_BGATE, I_WOUT };

__device__ __forceinline__ void ph_ada(const Args& a, LAS unsigned char* lds, int tid, int vcu, int G) {
    LAS float* sc = (LAS float*)lds;
    LAS float* red = sc + 3 * 2048;
    const float* c = a.in[I_C]; const float* cc = a.in[I_CCTX];
    for (int i = tid; i < 3 * 2048; i += NTHR) { const float x = i < 4096 ? c[i] : cc[i - 4096]; sc[i] = x * fsigm(x); }
    __syncthreads();
    const int lane = tid & 63, wave = tid >> 6;
    float* mods = (float*)(a.ws + WS_MODS);
    for (int u = vcu; u < 576; u += G) {
        const int l = u / 288, jc = u % 288, j = jc * 64 + lane;
        const float* W = a.in[I_WADA] + (size_t)l * 2048 * 18432 + j;
        float s0 = 0.f, s1 = 0.f, s2 = 0.f;
        const int k0 = wave * 256;
#pragma unroll 8
        for (int k = 0; k < 256; ++k) { const float w = W[(size_t)(k0 + k) * 18432]; s0 += sc[k0 + k] * w; s1 += sc[2048 + k0 + k] * w; s2 += sc[4096 + k0 + k] * w; }
        red[(wave * 3 + 0) * 64 + lane] = s0; red[(wave * 3 + 1) * 64 + lane] = s1; red[(wave * 3 + 2) * 64 + lane] = s2;
        __syncthreads();
        if (wave < 3) { float s = a.in[I_BADA][(size_t)l * 18432 + j];
#pragma unroll
            for (int w8 = 0; w8 < 8; ++w8) s += red[(w8 * 3 + wave) * 64 + lane];
            mods[(size_t)(l * 3 + wave) * 18432 + j] = s; }
        __syncthreads();
    }
}
__device__ __forceinline__ void transpose_item(const float* W, int N, int sc0, bf16* WT, int Kd, int nd0, int k0, LAS float* scr, int lane, bool permq = false) {
    if (sc0 >= 0) {
#pragma unroll 8
        for (int i = 0; i < 32; ++i) { const int kk = 2 * i + (lane >> 5); scr[kk * 33 + (lane & 31)] = W[(size_t)(k0 + kk) * N + sc0 + (lane & 31)]; }
    } else {
#pragma unroll 8
        for (int i = 0; i < 32; ++i) { const int kk = 2 * i + (lane >> 5); scr[kk * 33 + (lane & 31)] = 0.f; }
    }
    asm volatile("s_waitcnt lgkmcnt(0)" ::: "memory");
    const int c = lane & 7;
#pragma unroll
    for (int j = 0; j < 4; ++j) { const int n = (lane >> 3) + 8 * j;
        const int ns = permq ? (((n & 7) < 4) ? 4 * (n >> 3) + (n & 7) : 16 + 4 * (n >> 3) + (n & 7) - 4) : n;
        const LAS float* s = scr + (8 * c) * 33 + ns;
        v4u o; o.x = pk2(s[0 * 33], s[1 * 33]); o.y = pk2(s[2 * 33], s[3 * 33]); o.z = pk2(s[4 * 33], s[5 * 33]); o.w = pk2(s[6 * 33], s[7 * 33]);
        *(GAS v4u*)(WT + (size_t)(nd0 + n) * Kd + k0 + 8 * c) = o; }
    asm volatile("s_waitcnt lgkmcnt(0)" ::: "memory");
}
__device__ __forceinline__ void ph_weights(const Args& a, LAS unsigned char* lds, int tid, int vcu, int G) {
    const int lane = tid & 63, wave = tid >> 6;
    LAS float* scr = (LAS float*)(lds + wave * 16384);
    const int gw = vcu * NWAVES + wave, NGW = G * NWAVES;
    constexpr int I_F1 = 32 * (FF2 / 32), I_F2 = (FF / 64) * (DM / 32), I_IN = 32 * (PROJP / 32), I_BR = 16 * (DM / 32), I_WO = 32 * (DM / 32);
    constexpr int NITEMS = 4 * I_F1 + 4 * I_F2 + 2 * I_IN + 6 * I_BR + 2 * I_WO;
    unsigned char* ws = a.ws;
    for (int it = gw; it < NITEMS; it += NGW) {
        int r = it;
        if (r < 4 * I_F1) { const int mi = r / I_F1, q = r % I_F1, nb = q % (FF2 / 32), kb = q / (FF2 / 32), nd0 = 32 * nb, pn = nd0 >> 8, rr = nd0 & 255;
            const int sc0 = rr < 128 ? pn * 128 + rr : FF + pn * 128 + (rr - 128);
            transpose_item(a.in[I_FFNIN] + (size_t)mi * DM * FF2, FF2, sc0, (bf16*)(ws + WS_WF1 + (size_t)mi * SZ_WF1), DM, nd0, 64 * kb, scr, lane); continue; }
        r -= 4 * I_F1;
        if (r < 4 * I_F2) { const int mi = r / I_F2, q = r % I_F2, nb = q % (DM / 32), kb = q / (DM / 32);
            transpose_item(a.in[I_FFNOUT] + (size_t)mi * FF * DM, DM, 32 * nb, (bf16*)(ws + WS_WF2 + (size_t)mi * SZ_WF2), FF, 32 * nb, 64 * kb, scr, lane); continue; }
        r -= 4 * I_F2;
        if (r < 2 * I_IN) { const int mi = r / I_IN, q = r % I_IN, nb = q % (PROJP / 32), kb = q / (PROJP / 32), nd0 = 32 * nb, T = nd0 >> 8, cc = nd0 & 255;
            int sc0; bool pq = false;
            if (T <= 21) sc0 = nd0;
            else if (T == 22) sc0 = cc < 128 ? nd0 : -1;
            else if (T <= 30) { sc0 = P_QKV + ((T - 23) * 4 + ((cc >> 5) & 3)) * 64 + (cc >> 7) * 32; pq = true; }
            else if (T <= 34) sc0 = P_QKV + 2048 + (nd0 - 31 * 256);
            else sc0 = P_GATE + (nd0 - 35 * 256);
            transpose_item(a.in[I_WIN] + (size_t)mi * DM * PROJ, PROJ, sc0, (bf16*)(ws + WS_WIN + (size_t)mi * SZ_WIN), DM, nd0, 64 * kb, scr, lane, pq); continue; }
        r -= 2 * I_IN;
        if (r < 6 * I_BR) { const int mi = r / I_BR, q = r % I_BR, nb = q % (DM / 32), kb = q / (DM / 32);
            transpose_item(a.in[I_WBR] + (size_t)mi * 1024 * DM, DM, 32 * nb, (bf16*)(ws + WS_WBR + (size_t)mi * ((size_t)DM * 1024 * 2)), 1024, 32 * nb, 64 * kb, scr, lane); continue; }
        r -= 6 * I_BR;
        { const int mi = r / I_WO, q = r % I_WO, nb = q % (DM / 32), kb = q / (DM / 32);
            transpose_item(a.in[I_WOUT] + (size_t)mi * DM * DM, DM, 32 * nb, (bf16*)(ws + WS_WOUT + (size_t)mi * SZ_WOUT), DM, 32 * nb, 64 * kb, scr, lane); }
    }
    const int gt = vcu * NTHR + tid, NGT = G * NTHR;
    for (int i = gt; i < NLAYER * LOW * (ACTW / 8); i += NGT) {
        const int l = i / (LOW * (ACTW / 8)), q = i % (LOW * (ACTW / 8)), n = q / (ACTW / 8), k0 = (q % (ACTW / 8)) * 8, sec = n >> 10, cc = n & 1023;
        float f[8];
#pragma unroll
        for (int e = 0; e < 8; ++e) { const int k = k0 + e; float v = 0.f;
            if (sec == 0) { if (k < 256) v = a.in[I_GUP][((size_t)l * 256 + k) * 1024 + cc]; }
            else if (sec <= 2) { const int d = sec - 1, kb = 256 + 128 * d; if (k >= kb && k < kb + 96) v = a.in[I_WUP][((size_t)(l * 2 + d) * 96 + (k - kb)) * 1024 + cc]; }
            else { const int d = sec - 3, kb = 512 + 128 * d; if (k >= kb && k < kb + 96) v = a.in[I_AUP][((size_t)(l * 2 + d) * 96 + (k - kb)) * 1024 + cc]; }
            f[e] = v; }
        *(GAS v4u*)((bf16*)(ws + WS_WLO) + ((size_t)l * LOW + n) * ACTW + k0) = pack8(f);
    }
    for (int i = gt; i < 64 * 16; i += NGT) { const int p = i >> 4, ii = i & 15;
        const float inv = exp2f(-(float)(2 * ii) * (1.f / 32.f) * 13.287712379549449f);
        const float rev = (float)p * inv * 0.15915494309189535f;
        float* rt = (float*)(ws + WS_ROPE) + 2 * i; rt[0] = __builtin_amdgcn_cosf(rev); rt[1] = __builtin_amdgcn_sinf(rev); }
}

__device__ __forceinline__ void ph_norm(const float* xl, const float* xc, const float* gain, const float* mods  , int si, bf16* XN, float* xs_out  , const float* part, int nsplit, int nrows, int gw, int NGW, int lane) {
    for (int m = gw; m < nrows; m += NGW) {
        const float* xr = m < NLAT ? xl + (size_t)m * DM : xc + (size_t)(m - NLAT) * DM;
        const int set = m < TSEQ ? 0 : (m < NLAT ? 1 : 2);
        const float* sh = mods + (size_t)(set * NMOD + si) * DM; const float* scl = sh + DM;
        f32x4 v[8]; float ss = 0.f;
#pragma unroll
        for (int j = 0; j < 8; ++j) v[j] = *(const GAS f32x4*)(xr + 4 * lane + 256 * j);
        if (m >= NLAT) {
            if (part != nullptr) for (int s = 0; s < nsplit; ++s) { const float* pr = part + ((size_t)s * NCTX + (m - NLAT)) * DM + 4 * lane;
#pragma unroll
                for (int j = 0; j < 8; ++j) v[j] = v[j] + *(const GAS f32x4*)(pr + 256 * j); }
#pragma unroll
            for (int j = 0; j < 8; ++j) *(GAS f32x4*)(xs_out + (size_t)m * DM + 4 * lane + 256 * j) = v[j];
        }
#pragma unroll
        for (int j = 0; j < 8; ++j) ss += (v[j].x * v[j].x + v[j].y * v[j].y) + (v[j].z * v[j].z + v[j].w * v[j].w);
        const float rinv = 1.f / sqrtf(wave_sum(ss) * (1.f / DM) + 1e-6f);
#pragma unroll
        for (int j = 0; j < 8; ++j) { const int col = 4 * lane + 256 * j;
            const f32x4 g = *(const GAS f32x4*)(gain + col), s1 = *(const GAS f32x4*)(scl + col), s0 = *(const GAS f32x4*)(sh + col);
            const f32x4 o = (v[j] * rinv * g) * (s1 + 1.f) + s0;
            v2u w; w.x = pk2(o.x, o.y); w.y = pk2(o.z, o.w);
            *(GAS v2u*)(XN + (size_t)m * DM + col) = w; }
    }
}

__device__ __forceinline__ void ph_e1(const Args& a, int l, int gt, int NGT) {
    unsigned char* ws = a.ws;
    const bf16* P = (const bf16*)(ws + WS_P);
    bf16* RK = (bf16*)(ws + WS_RKVK);
    const float* cw = a.in[I_CONV] + (size_t)l * 3 * 3072; const float* kkw = a.in[I_KK] + l * 1024;
    for (int i = gt; i < MT * 128; i += NGT) {
        const int m = i >> 7, c0 = (i & 127) * 8;
        const int t = m < NLAT ? (m & (TSEQ - 1)) : ((m - NLAT) & (TCTX - 1)), tl = m < NLAT ? TSEQ : TCTX;
        const bool hp = t > 0, hn = t < tl - 1;
        float rkv[3][8];
#pragma unroll
        for (int sec = 0; sec < 3; ++sec) {
            const int col = sec * 1024 + c0; const bf16* pc = P + (size_t)m * PROJP + P_RKV + col;
            float x0[8], x1[8], x2[8];
            unpack8(*(const GAS v4u*)pc, x1);
            if (hp) unpack8(*(const GAS v4u*)(pc - PROJP), x0);
            if (hn) unpack8(*(const GAS v4u*)(pc + PROJP), x2);
#pragma unroll
            for (int e = 0; e < 8; ++e) { float v = x1[e] * cw[3072 + col + e]; if (hp) v += x0[e] * cw[col + e]; if (hn) v += x2[e] * cw[2 * 3072 + col + e]; rkv[sec][e] = v; }
        }
        float kk8[8]; float ss = 0.f;
#pragma unroll
        for (int e = 0; e < 8; ++e) { kk8[e] = rkv[1][e] * kkw[c0 + e]; ss += kk8[e] * kk8[e]; }
        ss += __shfl_xor(ss, 1); ss += __shfl_xor(ss, 2); ss += __shfl_xor(ss, 4);
        const float rinv = 1.f / sqrtf(ss + 1e-12f);
        GAS v4u* dst = (GAS v4u*)(RK + (size_t)m * 4096 + c0 * 4);
#pragma unroll
        for (int j = 0; j < 4; ++j) { v4u o; o.x = pk2(rkv[0][2 * j], rkv[1][2 * j]); o.y = pk2(rkv[2][2 * j], kk8[2 * j] * rinv); o.z = pk2(rkv[0][2 * j + 1], rkv[1][2 * j + 1]); o.w = pk2(rkv[2][2 * j + 1], kk8[2 * j + 1] * rinv); dst[j] = o; }
    }
}

__device__ __forceinline__ void ph_gmlp(const Args& a, int l, LAS unsigned char* lds, int tid, int vcu, int G) {
    constexpr int VP = 136;
    LAS bf16* vnT = (LAS bf16*)lds;
    const bf16* P = (const bf16*)(a.ws + WS_P); bf16* YA = (bf16*)(a.ws + WS_Y3);
    const float* vng = a.in[I_GMVN] + l * 1024; const float* wsm = a.in[I_GMWS] + (size_t)l * 8 * 128 * 128; const float* bs = a.in[I_GMBS] + l * 8 * 128;
    const int lane = tid & 63, w = tid >> 6, fr = lane & 15, fq = lane >> 4;
    for (int u = vcu; u < (MT / 128) * 8; u += G) {
        const int n = u >> 3, g = u & 7, m0 = n * 128;
        { const int q = tid >> 2, qt = tid & 3; const bf16* src = P + (size_t)(m0 + q) * PROJP + P_V + g * 128 + qt * 32;
            float v[32]; float ss = 0.f;
#pragma unroll
            for (int j = 0; j < 4; ++j) { float f[8]; unpack8(*(const GAS v4u*)(src + 8 * j), f);
#pragma unroll
                for (int e = 0; e < 8; ++e) { const float x = f[e]; v[8 * j + e] = x; ss += x * x; } }
            ss += __shfl_xor(ss, 1); ss += __shfl_xor(ss, 2);
            const float rinv = 1.f / sqrtf(ss * (1.f / 128.f) + 1e-6f);
#pragma unroll
            for (int e = 0; e < 32; ++e) { const int c = qt * 32 + e; vnT[c * VP + q] = (bf16)f2bf(v[e] * rinv * vng[g * 128 + c]); } }
        __syncthreads();
        pg8::f32x4 acc[8];
#pragma unroll
        for (int cb = 0; cb < 8; ++cb) acc[cb] = (pg8::f32x4){0.f, 0.f, 0.f, 0.f};
#pragma unroll
        for (int ks = 0; ks < 4; ++ks) {
            const float* wr = wsm + ((size_t)g * 128 + 16 * w + fr) * 128 + ks * 32 + 8 * fq;
            const f32x4 w0 = *(const GAS f32x4*)wr, w1 = *(const GAS f32x4*)(wr + 4);
            v4u aw; aw.x = pk2(w0.x, w0.y); aw.y = pk2(w0.z, w0.w); aw.z = pk2(w1.x, w1.y); aw.w = pk2(w1.z, w1.w);
            const bf16x8 af = __builtin_bit_cast(bf16x8, aw);
#pragma unroll
            for (int cb = 0; cb < 8; ++cb) { const bf16x8 bfr = *(const LAS bf16x8*)(vnT + (cb * 16 + fr) * VP + ks * 32 + 8 * fq);
                acc[cb] = __builtin_amdgcn_mfma_f32_16x16x32_bf16(af, bfr, acc[cb], 0, 0, 0); }
        }
#pragma unroll
        for (int cb = 0; cb < 8; ++cb)
#pragma unroll
            for (int i = 0; i < 4; ++i) { const int p = 16 * w + 4 * fq + i, c = cb * 16 + fr;
                const float pu = bf1(P[(size_t)(m0 + p) * PROJP + P_U + g * 128 + c]);
                YA[(size_t)(m0 + p) * 1024 + g * 128 + c] = (bf16)f2bf(pu * (acc[cb][i] + bs[g * 128 + p])); }
        __syncthreads();
    }
}

namespace att {
using bf16x8 = __attribute__((ext_vector_type(8))) short;
using s16x4  = __attribute__((ext_vector_type(4))) short;
using f32x16 = __attribute__((ext_vector_type(16))) float;
using u32x4  = __attribute__((ext_vector_type(4))) unsigned;
constexpr int NW = 8, QBLK = 32, KVBLK = 64;
constexpr float THRL = 11.5f;
constexpr int SHM_V = KVBLK * 128 * 2, SHM_K = KVBLK * 64 * 2, SHM_ATTN = 2 * SHM_V + 2 * SHM_K + NW * 64 * 4;
#define KSWZ(row, colB) ((row) * 128 + ((colB) ^ ((((row) >> 1) & 7) << 4)))
#define SBAR() __builtin_amdgcn_sched_barrier(0)
__device__ __forceinline__ int crow(int r, int hi) { return (r & 3) + 8 * (r >> 2) + 4 * hi; }
__device__ __forceinline__ unsigned cvtpk(float lo, float hi) { unsigned r; asm volatile("v_cvt_pk_bf16_f32 %0, %1, %2" : "=v"(r) : "v"(lo), "v"(hi)); return r; }
__device__ __forceinline__ void partialSM(f32x16& p0, f32x16& p1, float& m_reg, float& mn, float& alpha) {
  float pmax = p0[0];
#pragma unroll
  for (int r = 1; r < 16; ++r) pmax = fmaxf(pmax, p0[r]);
#pragma unroll
  for (int r = 0; r < 16; ++r) pmax = fmaxf(pmax, p1[r]);
  { auto rr = __builtin_amdgcn_permlane32_swap(__float_as_uint(pmax), __float_as_uint(pmax), false, false);
    pmax = fmaxf(__uint_as_float(rr[0]), __uint_as_float(rr[1])); }
  if (__builtin_expect(__all(pmax - m_reg <= THRL), 1)) { mn = m_reg; alpha = 1.f; }
  else { mn = fmaxf(m_reg, pmax); alpha = __builtin_amdgcn_exp2f(m_reg - mn); m_reg = mn; }
#pragma unroll
  for (int r = 0; r < 16; ++r) p0[r] = p0[r] - mn;
#pragma unroll
  for (int r = 0; r < 16; ++r) p1[r] = p1[r] - mn;
#pragma unroll
  for (int r = 0; r < 16; ++r) p0[r] = __builtin_amdgcn_exp2f(p0[r]);
}
__device__ __forceinline__ void finishSM(f32x16& p0, f32x16& p1, float alpha, float& l_reg, bf16x8& pa0, bf16x8& pa1, bf16x8& pa2, bf16x8& pa3) {
#pragma unroll
  for (int r = 0; r < 16; ++r) p1[r] = __builtin_amdgcn_exp2f(p1[r]);
  float ps = 0;
#pragma unroll
  for (int r = 0; r < 16; ++r) ps += p0[r];
#pragma unroll
  for (int r = 0; r < 16; ++r) ps += p1[r];
  { auto rr = __builtin_amdgcn_permlane32_swap(__float_as_uint(ps), __float_as_uint(ps), false, false);
    ps = __uint_as_float(rr[0]) + __uint_as_float(rr[1]); }
  l_reg = l_reg * alpha + ps;
#define PK4(P, BASE, OUT) do { unsigned a0 = cvtpk(P[BASE + 0], P[BASE + 1]), a1 = cvtpk(P[BASE + 2], P[BASE + 3]);   \
    unsigned b0 = cvtpk(P[BASE + 4], P[BASE + 5]), b1 = cvtpk(P[BASE + 6], P[BASE + 7]);                              \
    auto r0 = __builtin_amdgcn_permlane32_swap(a0, b0, false, false); auto r1 = __builtin_amdgcn_permlane32_swap(a1, b1, false, false); \
    u32x4 w = {r0[0], r1[0], r0[1], r1[1]}; OUT = *reinterpret_cast<bf16x8*>(&w); } while (0)
  PK4(p0, 0, pa0); PK4(p0, 8, pa1); PK4(p1, 0, pa2); PK4(p1, 8, pa3);
#undef PK4
}
__device__ __forceinline__ void qkt(f32x16& p0, f32x16& p1, const unsigned short* Ks, const bf16x8* qr, int r32, int hi) {
  p0 = f32x16{}; p1 = f32x16{};
#pragma unroll
  for (int d0 = 0; d0 < 4; ++d0) { int cb = (d0 * 16 + hi * 8) * 2;
    bf16x8 b0 = *reinterpret_cast<const bf16x8*>((const char*)Ks + KSWZ(r32, cb));
    bf16x8 b1 = *reinterpret_cast<const bf16x8*>((const char*)Ks + KSWZ(32 + r32, cb));
    p0 = __builtin_amdgcn_mfma_f32_32x32x16_bf16(b0, qr[d0], p0, 0, 0, 0);
    p1 = __builtin_amdgcn_mfma_f32_32x32x16_bf16(b1, qr[d0], p1, 0, 0, 0); }
}
__device__ __forceinline__ int v_st(int k, int c) { const int kk = (k & ~0xC) | ((k & 4) << 1) | ((k & 8) >> 1); return ((kk >> 3) * 4 + (c >> 5)) * 512 + ((kk & 7) * 32 + (c & 31)) * 2; }
__device__ __forceinline__ int v_rd_base(int lane) { return ((lane & 3) << 3) | (((lane >> 2) & 3) << 6) | (((lane >> 4) & 1) << 5) | (((lane >> 5) & 1) << 8); }
constexpr int v_rd_off(int d0, int ks, int half) { return d0 * 512 + ks * 4096 + half * 2048; }
template <int OFF> __device__ __forceinline__ s16x4 tr_read(int vb) {
  s16x4 r; asm volatile("ds_read_b64_tr_b16 %0, %1 offset:%2" : "=&v"(r) : "v"(vb), "i"(OFF) : "memory"); return r;
}
template <int D0> __device__ __forceinline__ void pv_one(f32x16& od, int vb, bf16x8 pa0, bf16x8 pa1, bf16x8 pa2, bf16x8 pa3) {
  const s16x4 l0 = tr_read<v_rd_off(D0, 0, 0)>(vb), h0 = tr_read<v_rd_off(D0, 0, 1)>(vb), l1 = tr_read<v_rd_off(D0, 1, 0)>(vb), h1 = tr_read<v_rd_off(D0, 1, 1)>(vb);
  const s16x4 l2 = tr_read<v_rd_off(D0, 2, 0)>(vb), h2 = tr_read<v_rd_off(D0, 2, 1)>(vb), l3 = tr_read<v_rd_off(D0, 3, 0)>(vb), h3 = tr_read<v_rd_off(D0, 3, 1)>(vb);
  asm volatile("s_waitcnt lgkmcnt(0)" ::: "memory"); SBAR();
#define PK(L, H) (bf16x8){L[0], L[1], L[2], L[3], H[0], H[1], H[2], H[3]}
  od = __builtin_amdgcn_mfma_f32_32x32x16_bf16(pa0, PK(l0, h0), od, 0, 0, 0);
  od = __builtin_amdgcn_mfma_f32_32x32x16_bf16(pa1, PK(l1, h1), od, 0, 0, 0);
  od = __builtin_amdgcn_mfma_f32_32x32x16_bf16(pa2, PK(l2, h2), od, 0, 0, 0);
  od = __builtin_amdgcn_mfma_f32_32x32x16_bf16(pa3, PK(l3, h3), od, 0, 0, 0);
#undef PK
}
__device__ __forceinline__ void pv_d0(f32x16* o, int vb, bf16x8 pa0, bf16x8 pa1, bf16x8 pa2, bf16x8 pa3) {
  pv_one<0>(o[0], vb, pa0, pa1, pa2, pa3); pv_one<1>(o[1], vb, pa0, pa1, pa2, pa3); pv_one<2>(o[2], vb, pa0, pa1, pa2, pa3); pv_one<3>(o[3], vb, pa0, pa1, pa2, pa3);
}
__device__ __forceinline__ void attn_unit(const unsigned short* __restrict__ Qb, const unsigned short* __restrict__ Kb, const unsigned short* __restrict__ Vb,
                                          float* __restrict__ Ob, int NT, int ntl, int klat, int kctx, char* lds) {
  constexpr int LDQ = 2048, LDKK = 2048, LDV = 15104, LDO = 1024;
  const int tid = threadIdx.x, wid = tid >> 6, lane = tid & 63, r32 = lane & 31, hi = lane >> 5;
  unsigned short* V_lds = (unsigned short*)lds; unsigned short* K_lds = (unsigned short*)(lds + 2 * SHM_V);
  float* ws = (float*)(lds + 2 * SHM_V + 2 * SHM_K) + wid * 64; float* li_l = ws; float* al_l = ws + 32;
  float m_reg = -1e30f, l_reg = 0; f32x16 o[4] = {}; bf16x8 qr[4];
  const unsigned short* Qw = Qb + (long)(wid * QBLK + r32) * LDQ + hi * 8;
#pragma unroll
  for (int d0 = 0; d0 < 4; ++d0) qr[d0] = *reinterpret_cast<const bf16x8*>(Qw + d0 * 16);
  const int sr = tid >> 4, sc = (tid & 15) * 8, vst0 = v_st(sr, sc), vst1 = v_st(32 + sr, sc);
  const int kr = tid >> 3, kc = (tid & 7) * 8, kst = KSWZ(kr, kc * 2);
  const int vb0 = (int)(uintptr_t)V_lds + v_rd_base(lane);
  struct { bf16x8 vs0, vs1, ks0; } sr_[2];
#define KROW(t) ((t) < ntl ? klat + 64 * (t) : kctx + 64 * ((t) - ntl))
#define SLOAD(i, t) do { const long k0_ = KROW(t); sr_[i].vs0 = *reinterpret_cast<const bf16x8*>(&Vb[(k0_ + sr) * LDV + sc]); sr_[i].vs1 = *reinterpret_cast<const bf16x8*>(&Vb[(k0_ + 32 + sr) * LDV + sc]); \
    sr_[i].ks0 = *reinterpret_cast<const bf16x8*>(&Kb[(k0_ + kr) * LDKK + kc]); } while (0)
#define SWRITE(b, i) do { *(bf16x8*)((char*)V_lds + (b) * SHM_V + vst0) = sr_[i].vs0; *(bf16x8*)((char*)V_lds + (b) * SHM_V + vst1) = sr_[i].vs1; \
    *(bf16x8*)((char*)K_lds + (b) * SHM_K + kst) = sr_[i].ks0; } while (0)
#define SWAIT() asm volatile("s_waitcnt vmcnt(3)" ::: "memory")
#define RESC(a) do { if (__any((a) < 1.f)) { if (hi == 0) al_l[r32] = (a); asm volatile("s_waitcnt lgkmcnt(0)" ::: "memory"); \
    _Pragma("unroll") for (int d = 0; d < 4; ++d) _Pragma("unroll") for (int r = 0; r < 16; ++r) o[d][r] *= al_l[crow(r, hi)]; } } while (0)
  f32x16 pA0, pA1, pB0, pB1; float mnA, mnB, alA, alB; bf16x8 pa0, pa1, pa2, pa3;
  constexpr int SE = 0, SO = 1;
  SLOAD(SE, 0); asm volatile("s_waitcnt vmcnt(0)" ::: "memory"); SWRITE(0, SE); __syncthreads();
  qkt(pA0, pA1, K_lds, qr, r32, hi); partialSM(pA0, pA1, m_reg, mnA, alA);
  SLOAD(SO, 1); if (2 < NT) SLOAD(SE, 2);
  SWAIT(); SWRITE(1, SO); __syncthreads();
  for (int j = 1; j + 1 < NT; j += 2) {
    SBAR(); qkt(pB0, pB1, (const unsigned short*)((char*)K_lds + SHM_K), qr, r32, hi);
    finishSM(pA0, pA1, alA, l_reg, pa0, pa1, pa2, pa3); SBAR();
    SLOAD(SO, j + 2); SBAR();
    pv_d0(o, vb0, pa0, pa1, pa2, pa3); partialSM(pB0, pB1, m_reg, mnB, alB);
    __syncthreads(); SWAIT(); SWRITE(0, SE);
    RESC(alB); __syncthreads();
    SBAR(); qkt(pA0, pA1, K_lds, qr, r32, hi);
    finishSM(pB0, pB1, alB, l_reg, pa0, pa1, pa2, pa3); SBAR();
    if (j + 3 < NT) SLOAD(SE, j + 3); SBAR();
    pv_d0(o, vb0 + (int)SHM_V, pa0, pa1, pa2, pa3); partialSM(pA0, pA1, m_reg, mnA, alA);
    __syncthreads(); SWAIT(); SWRITE(1, SO);
    RESC(alA); __syncthreads();
  }
  SBAR(); qkt(pB0, pB1, (const unsigned short*)((char*)K_lds + SHM_K), qr, r32, hi);
  finishSM(pA0, pA1, alA, l_reg, pa0, pa1, pa2, pa3); SBAR();
  pv_d0(o, vb0, pa0, pa1, pa2, pa3); partialSM(pB0, pB1, m_reg, mnB, alB);
  __syncthreads(); RESC(alB);
  finishSM(pB0, pB1, alB, l_reg, pa0, pa1, pa2, pa3); SBAR();
  pv_d0(o, vb0 + (int)SHM_V, pa0, pa1, pa2, pa3);
  if (hi == 0) li_l[r32] = l_reg; asm volatile("s_waitcnt lgkmcnt(0)" ::: "memory");
  float rli[16];
#pragma unroll
  for (int r = 0; r < 16; ++r) rli[r] = __builtin_amdgcn_rcpf(li_l[crow(r, hi)]);
  float* Ow = Ob + (long)(wid * QBLK) * LDO;
#pragma unroll
  for (int r = 0; r < 16; ++r) { int orow = crow(r, hi);
#pragma unroll
    for (int d0 = 0; d0 < 4; ++d0) Ow[(long)orow * LDO + d0 * 32 + r32] = o[d0][r] * rli[r]; }
  __syncthreads();
#undef KROW
#undef SLOAD
#undef SWRITE
#undef SWAIT
#undef RESC
}
#undef KSWZ
#undef SBAR
}

__device__ __forceinline__ void ph_attn(const Args& a, bool ctx_out, char* lds, int widx, int wstride) {
    const unsigned short* QK = (const unsigned short*)(a.ws + WS_QK); const unsigned short* P = (const unsigned short*)(a.ws + WS_P); float* OJ = (float*)(a.ws + WS_OJ);
    const int nunits = ctx_out ? 544 : 512;
    for (int u = widx; u < nunits; u += wstride) {
        int b, hj, qrow0, NT, ntl;
        if (u < 512) { b = u >> 8; hj = (u >> 4) & 15; qrow0 = b * TSEQ + (u & 15) * 256; NT = 68; ntl = 64; }
        else { const int uu = u - 512; b = uu >> 4; hj = uu & 15; qrow0 = NLAT + b * TCTX; NT = 4; ntl = 0; }
        att::attn_unit(QK + (size_t)qrow0 * DM + hj * 64, QK + 1024 + hj * 64, P + P_V2 + (hj >> 1) * 128,
                       OJ + ((size_t)(hj & 1) * MT + qrow0) * 1024 + (hj >> 1) * 128, NT, ntl, b * TSEQ, NLAT + b * TCTX, lds);
    }
}

constexpr int SC_STEP = 768, SC_BLK = 32, SC_BUF = SC_BLK * SC_STEP + 256, SC_Y = 2 * SC_BUF, SC_LDS = SC_Y + 2 * SC_BLK * 64 * 4 + 256;
__device__ __forceinline__ int scan_row(int i, int b, int d) { return i < TCTX ? NLAT + b * TCTX + (d ? TCTX - 1 - i : i) : b * TSEQ + (d ? TSEQ - 1 - (i - TCTX) : (i - TCTX)); }
typedef __amdgpu_buffer_rsrc_t rsrc_t;
typedef short s16x4 __attribute__((ext_vector_type(4)));
typedef __bf16 bf16x2_t __attribute__((ext_vector_type(2)));
typedef float f32x2_t __attribute__((ext_vector_type(2)));
__device__ __forceinline__ unsigned cvtpk_c(float lo, float hi) { f32x2_t v = {lo, hi}; bf16x2_t b = __builtin_convertvector(v, bf16x2_t); return __builtin_bit_cast(unsigned, b); }
__device__ __forceinline__ void scan_fill(rsrc_t LOr, rsrc_t RKr, float kav, LAS unsigned char* buf, int blk, int b, int h, int d, int hw, int lane) {
    const int i0 = blk * SC_BLK, m0 = scan_row(i0, b, d), dir = d ? -1 : 1;
    const int lo0 = (m0 * LOW + 1024 + d * 1024 + h * 64) * 4, lostep = dir * LOW * 4;
    const int rk0 = (m0 * 16 + h) * 512, rkstep = dir * 8192;
    const int inext = i0 + 8 * hw + 8, mn = inext < TCTX + TSEQ ? scan_row(inext, b, d) : m0;
    const int pp = (((lane >> 5) * 4 + ((lane >> 2) & 3)) * 8 + 4 * ((lane >> 4) & 1) + (lane & 3)) * 2;
    float wv[SC_BLK], av[8]; v2u rec[9];
#pragma unroll
    for (int st = 0; st < SC_BLK; ++st) wv[st] = __builtin_bit_cast(float, __builtin_amdgcn_raw_buffer_load_b32(LOr, lane * 4, lo0 + st * lostep, 0));
#pragma unroll
    for (int q = 0; q < 8; ++q) { av[q] = __builtin_bit_cast(float, __builtin_amdgcn_raw_buffer_load_b32(LOr, lane * 4, lo0 + 8192 + (8 * hw + q) * lostep, 0));
        rec[q] = __builtin_amdgcn_raw_buffer_load_b64(RKr, lane * 8, rk0 + (8 * hw + q) * rkstep, 0); }
    rec[8] = __builtin_amdgcn_raw_buffer_load_b64(RKr, lane * 8, (mn * 16 + h) * 512, 0);
    asm volatile("" ::: "memory");
    float g = 1.f;
#pragma unroll
    for (int st = 0; st < SC_BLK; ++st) { if (st < 8 * hw) g *= wv[st]; }
    float gl = 1.f;
#pragma unroll
    for (int st = 0; st < SC_BLK; ++st) gl *= wv[st];
#pragma unroll
    for (int q = 0; q < 8; ++q) {
        const float wq = hw == 0 ? wv[q] : (hw == 1 ? wv[8 + q] : (hw == 2 ? wv[16 + q] : wv[24 + q]));
        g *= wq;
        const float ig = __builtin_amdgcn_rcpf(g);
        const float rv = bflo(rec[q].x), kv = bfhi(rec[q].x), vv = bflo(rec[q].y), kkv = bfhi(rec[q].y), kkn = bfhi(rec[q + 1].y);
        LAS unsigned char* o = buf + (8 * hw + q) * SC_STEP;
        ((LAS unsigned*)o)[lane] = pg8::cvt_pk_bf16(kv * (1.f + (av[q] - 1.f) * kav) * ig, -(kkv * av[q] * ig));
        *(LAS bf16*)(o + 256 + pp) = (bf16)f2bf(kkn * g); *(LAS bf16*)(o + 384 + pp) = (bf16)f2bf(rv * g);
        ((LAS float*)(o + 512))[lane] = vv;
    }
    if (hw == 0) ((LAS float*)(buf + SC_BLK * SC_STEP))[lane] = gl;
}
__device__ __forceinline__ void scan_unit(const Args& a, int l, int u, LAS unsigned char* lds, int tid) {
    const rsrc_t LOr = __builtin_amdgcn_make_buffer_rsrc((void*)(a.ws + WS_R1), 0, MT * LOW * 4, 0x00020000);
    const rsrc_t RKr = __builtin_amdgcn_make_buffer_rsrc((void*)(a.ws + WS_RKVK), 0, MT * 4096 * 2, 0x00020000);
    const rsrc_t YSr = __builtin_amdgcn_make_buffer_rsrc((void*)(a.ws + WS_YS), 0, 2 * MT * 1024 * 4, 0x00020000);
    const int lane = tid & 63, w = __builtin_amdgcn_readfirstlane(tid >> 6), fr = lane & 15, fq = lane >> 4;
    const int b = u >> 5, h = (u >> 1) & 15, d = u & 1;
    const float kav = a.in[I_KA][l * 1024 + h * 64 + lane];
    constexpr int NBLK = (TCTX + TSEQ) / SC_BLK;
    pg8::f32x4 S0 = (pg8::f32x4){0.f, 0.f, 0.f, 0.f}, S1 = S0, S2 = S0, S3 = S0, acc0 = S0, acc1 = S0;
    const unsigned mk0 = fq == 0 ? 0xffffffffu : 0u, mk1 = fq == 1 ? 0xffffffffu : 0u, mk2 = fq == 2 ? 0xffffffffu : 0u, mk3 = fq == 3 ? 0xffffffffu : 0u;
    if (w >= 4) scan_fill(LOr, RKr, kav, lds, 0, b, h, d, w - 4, lane);
    __syncthreads();
    for (int blk = 0; blk < NBLK; ++blk) {
        LAS unsigned char* buf = lds + (blk & 1) * SC_BUF;
        LAS float* yb = (LAS float*)(lds + SC_Y) + (blk & 1) * SC_BLK * 64;
        if (w < 4) {
            const int aoff = 256 + ((fr & 2) ? 128 : 0) + 16 * fq;
            int yoff = 2 * SC_BLK * 64 - (blk & 1) * SC_BLK * 64 + lane;
            unsigned Ua, Ub_; float va, vb_; bf16x8 A0a, A1a, A0b_, A1b_;
#define SC_LOAD(S, st_) do { LAS unsigned char* nb_ = buf + (st_) * SC_STEP; U##S = ((LAS unsigned*)nb_)[lane]; v##S = ((LAS float*)(nb_ + 512))[16 * w + fr]; \
        A0##S = *(const LAS bf16x8*)(nb_ + aoff); A1##S = *(const LAS bf16x8*)(nb_ + aoff + 64); } while (0)
#define SC_DO(S, st_) do { \
        const float sa_ = acc0[0] + acc1[0]; yb[yoff] = acc0[2] + acc1[2]; yoff = (st_) * 64 + 16 * w + fr; \
        const unsigned p_ = cvtpk_c(v##S, sa_); \
        const s16x4 ua_ = __builtin_bit_cast(s16x4, (v2u){U##S, 0u}); \
        S0 = __builtin_amdgcn_mfma_f32_16x16x16bf16_1k(ua_, __builtin_bit_cast(s16x4, (v2u){p_ & mk0, 0u}), S0, 0, 0, 0); \
        S1 = __builtin_amdgcn_mfma_f32_16x16x16bf16_1k(ua_, __builtin_bit_cast(s16x4, (v2u){p_ & mk1, 0u}), S1, 0, 0, 0); \
        S2 = __builtin_amdgcn_mfma_f32_16x16x16bf16_1k(ua_, __builtin_bit_cast(s16x4, (v2u){p_ & mk2, 0u}), S2, 0, 0, 0); \
        S3 = __builtin_amdgcn_mfma_f32_16x16x16bf16_1k(ua_, __builtin_bit_cast(s16x4, (v2u){p_ & mk3, 0u}), S3, 0, 0, 0); \
        v4u p0_, p1_; \
        p0_.x = cvtpk_c(S0[0], S0[1]); p0_.y = cvtpk_c(S0[2], S0[3]); p0_.z = cvtpk_c(S1[0], S1[1]); p0_.w = cvtpk_c(S1[2], S1[3]); \
        p1_.x = cvtpk_c(S2[0], S2[1]); p1_.y = cvtpk_c(S2[2], S2[3]); p1_.z = cvtpk_c(S3[0], S3[1]); p1_.w = cvtpk_c(S3[2], S3[3]); \
        acc0 = __builtin_amdgcn_mfma_f32_16x16x32_bf16(A0##S, __builtin_bit_cast(bf16x8, p0_), (pg8::f32x4){0.f, 0.f, 0.f, 0.f}, 0, 0, 0); \
        acc1 = __builtin_amdgcn_mfma_f32_16x16x32_bf16(A1##S, __builtin_bit_cast(bf16x8, p1_), (pg8::f32x4){0.f, 0.f, 0.f, 0.f}, 0, 0, 0); } while (0)
            SC_LOAD(a, 0);
            for (int st = 0; st < SC_BLK; st += 2) {
                SC_LOAD(b_, st + 1);
                SC_DO(a, st);
                if (st + 2 < SC_BLK) SC_LOAD(a, st + 2);
                SC_DO(b_, st + 1);
            }
#undef SC_LOAD
#undef SC_DO
            { const LAS float* G = (const LAS float*)(buf + SC_BLK * SC_STEP) + 4 * fq;
              S0 = S0 * *(const LAS pg8::f32x4*)(G); S1 = S1 * *(const LAS pg8::f32x4*)(G + 16); S2 = S2 * *(const LAS pg8::f32x4*)(G + 32); S3 = S3 * *(const LAS pg8::f32x4*)(G + 48); }
            yb[yoff] = acc0[2] + acc1[2];
        } else {
            const int hw = w - 4;
            if (blk > 0) { const LAS float* ypb = (const LAS float*)(lds + SC_Y) + ((blk - 1) & 1) * SC_BLK * 64;
                const int mp = scan_row((blk - 1) * SC_BLK, b, d), y0 = ((d * MT + mp) * 1024 + h * 64) * 4, ystep = (d ? -1 : 1) * 4096;
#pragma unroll
                for (int q = 0; q < 8; ++q) __builtin_amdgcn_raw_buffer_store_b32(__builtin_bit_cast(unsigned, ypb[(8 * hw + q) * 64 + lane]), YSr, lane * 4, y0 + (8 * hw + q) * ystep, 0); }
            if (blk + 1 < NBLK) scan_fill(LOr, RKr, kav, lds + ((blk + 1) & 1) * SC_BUF, blk + 1, b, h, d, hw, lane);
        }
        __syncthreads();
    }
    if (w >= 4) { const int hw = w - 4; const LAS float* ypb = (const LAS float*)(lds + SC_Y) + ((NBLK - 1) & 1) * SC_BLK * 64;
        const int mp = scan_row((NBLK - 1) * SC_BLK, b, d), y0 = ((d * MT + mp) * 1024 + h * 64) * 4, ystep = (d ? -1 : 1) * 4096;
#pragma unroll
        for (int q = 0; q < 8; ++q) __builtin_amdgcn_raw_buffer_store_b32(__builtin_bit_cast(unsigned, ypb[(8 * hw + q) * 64 + lane]), YSr, lane * 4, y0 + (8 * hw + q) * ystep, 0); }
    __syncthreads();
}

__device__ __forceinline__ void ph_rwkv_out(const Args& a, int l, int gt, int NGT) {
    const float* OJ = (const float*)(a.ws + WS_OJ); bf16* YC = (bf16*)(a.ws + WS_Y3) + (size_t)2 * MT * 1024;
    const float* subln = a.in[I_SUBLN] + l * 128;
    float lam, lam_init;
    { const int lane = threadIdx.x & 63; const float* lv = a.in[I_LAM] + l * 256;
      float l1 = lv[lane] * lv[64 + lane], l2 = lv[128 + lane] * lv[192 + lane]; l1 = wave_sum(l1); l2 = wave_sum(l2);
      lam_init = 0.8f - 0.6f * __expf(-0.3f * (float)l); lam = __expf(l1) - __expf(l2) + lam_init; }
    const float* LO = (const float*)(a.ws + WS_R1); const bf16* RK = (const bf16*)(a.ws + WS_RKVK); const float* YS = (const float*)(a.ws + WS_YS);
    bf16* YB = (bf16*)(a.ws + WS_Y3) + (size_t)MT * 1024;
    const float* ka = a.in[I_KA] + l * 1024; const float* rkw = a.in[I_RK] + l * 1024; const float* lng = a.in[I_LNG] + l * 1024; const float* lnb = a.in[I_LNB] + l * 1024;
    for (int i = gt; i < MT * 128; i += NGT) {
        const int m = i >> 7, c0 = (i & 127) * 8;
        float y[8]; float s1 = 0.f;
        { const f32x4 a0 = *(const GAS f32x4*)(YS + (size_t)m * 1024 + c0), a1 = *(const GAS f32x4*)(YS + (size_t)m * 1024 + c0 + 4),
                      b0 = *(const GAS f32x4*)(YS + ((size_t)MT + m) * 1024 + c0), b1 = *(const GAS f32x4*)(YS + ((size_t)MT + m) * 1024 + c0 + 4);
            y[0] = a0.x + b0.x; y[1] = a0.y + b0.y; y[2] = a0.z + b0.z; y[3] = a0.w + b0.w; y[4] = a1.x + b1.x; y[5] = a1.y + b1.y; y[6] = a1.z + b1.z; y[7] = a1.w + b1.w; }
#pragma unroll
        for (int e = 0; e < 8; ++e) s1 += y[e];
        s1 += __shfl_xor(s1, 1); s1 += __shfl_xor(s1, 2); s1 += __shfl_xor(s1, 4);
        const float mu = s1 * (1.f / 64.f); float s2 = 0.f;
#pragma unroll
        for (int e = 0; e < 8; ++e) { y[e] -= mu; s2 += y[e] * y[e]; }
        s2 += __shfl_xor(s2, 1); s2 += __shfl_xor(s2, 2); s2 += __shfl_xor(s2, 4);
        const float rstd = 1.f / sqrtf(s2 * (1.f / 64.f) + 64e-5f);
        float r[8], k[8], v[8];
        { const GAS v4u* rp = (const GAS v4u*)(RK + (size_t)m * 4096 + c0 * 4);
#pragma unroll
          for (int j = 0; j < 4; ++j) { const v4u q = rp[j]; r[2 * j] = bflo(q.x); k[2 * j] = bfhi(q.x); v[2 * j] = bflo(q.y); r[2 * j + 1] = bflo(q.z); k[2 * j + 1] = bfhi(q.z); v[2 * j + 1] = bflo(q.w); } }
        float rk = 0.f;
#pragma unroll
        for (int e = 0; e < 8; ++e) { const int c = c0 + e; const float am = 0.5f * (LO[(size_t)m * LOW + 3072 + c] + LO[(size_t)m * LOW + 4096 + c]);
            rk += r[e] * (k[e] * (1.f + (am - 1.f) * ka[c])) * rkw[c]; }
        rk += __shfl_xor(rk, 1); rk += __shfl_xor(rk, 2); rk += __shfl_xor(rk, 4);
        float o[8];
#pragma unroll
        for (int e = 0; e < 8; ++e) { const int c = c0 + e; o[e] = (y[e] * rstd * lng[c] + lnb[c] + rk * v[e]) * LO[(size_t)m * LOW + c]; }
        *(GAS v4u*)(YB + (size_t)m * 1024 + c0) = pack8(o);
        { const f32x4 p0 = *(const GAS f32x4*)(OJ + (size_t)m * 1024 + c0), p1 = *(const GAS f32x4*)(OJ + (size_t)m * 1024 + c0 + 4),
                      q0 = *(const GAS f32x4*)(OJ + ((size_t)MT + m) * 1024 + c0), q1 = *(const GAS f32x4*)(OJ + ((size_t)MT + m) * 1024 + c0 + 4);
          float d[8]; d[0] = p0.x - lam * q0.x; d[1] = p0.y - lam * q0.y; d[2] = p0.z - lam * q0.z; d[3] = p0.w - lam * q0.w; d[4] = p1.x - lam * q1.x; d[5] = p1.y - lam * q1.y; d[6] = p1.z - lam * q1.z; d[7] = p1.w - lam * q1.w;
          float ss = 0.f;
#pragma unroll
          for (int e = 0; e < 8; ++e) ss += d[e] * d[e];
          ss += __shfl_xor(ss, 1); ss += __shfl_xor(ss, 2); ss += __shfl_xor(ss, 4); ss += __shfl_xor(ss, 8);
          const float rinv = (1.f - lam_init) / sqrtf(ss * (1.f / 128.f) + 1e-6f);
#pragma unroll
          for (int e = 0; e < 8; ++e) d[e] = d[e] * rinv * subln[(c0 & 127) + e];
          *(GAS v4u*)(YC + (size_t)m * 1024 + c0) = pack8(d); }
    }
}

constexpr int PH_PER_LAYER = 13, NPH = 1 + NLAYER * PH_PER_LAYER;
#define IN(k) (lo <= (k) && (k) < hi)
#define SEAM(k) do { if (IN(k) && IN((k) + 1)) xcd_barrier(bar); } while (0)
#ifndef ONLY_PH
#define ONLY_PH -1
#endif
#define INL(k) ((ONLY_PH < 0 || ONLY_PH == (k)) && IN(pb + (k)))
#define SEAML(k) SEAM(pb + (k))
#ifndef PROBE_REP
#define PROBE_REP 0
#endif
#define REPL(k) for (int rep_ = 0; rep_ < (((PROBE_REP) >> (k)) & 1) + 1; ++rep_)
template <int l> __device__ __forceinline__ void layer_body(const Args& args, LAS unsigned char* lds, unsigned char* lds_raw, unsigned char* ws, const XcdBarrier& bar, int lo, int hi, int tid, int lane, int G, int bx, int vcu, int gw, int NGW, int gt, int NGT) {
        const int pb = 1 + l * PH_PER_LAYER;
        const bool last = (l == NLAYER - 1);
        float* XS = (float*)(ws + WS_XS); float* PART = (float*)(ws + WS_PART);
        const float* mods = (const float*)(ws + WS_MODS) + (size_t)l * 3 * NMOD * DM;
        const float* normg = args.in[I_NORMG] + (size_t)l * 3 * DM;
        pg8::bf16_t* XN = (pg8::bf16_t*)(ws + WS_XN);
        pg8::bf16_t* Hb = (pg8::bf16_t*)(ws + WS_R1);
        const float* xl0 = (l == 0) ? args.in[I_X] : XS; const float* xc0 = (l == 0) ? args.in[I_CTX] : XS + (size_t)NLAT * DM;

        if (INL(0)) REPL(0) ph_norm(xl0, xc0, normg, mods, 0, (bf16*)XN, XS, l == 0 ? nullptr : PART, 16, MT, gw, NGW, lane);
        SEAML(0);
        if (INL(1)) REPL(1) { pg8::Gemm g{XN, (const pg8::bf16_t*)(ws + WS_WF1 + (size_t)(l * 2 + 0) * SZ_WF1), MT, FF2, DM}; pg8::StaticOrder S; S.init(MT, FF2, G, bx);
            pg8::EpiSwiglu E{Hb, FF}; pg8::gemm_phase<pg8::EpiSwiglu, pg8::StaticOrder, true, true>(lds, g, S, E); }
        SEAML(1);
        if (INL(2)) REPL(2) { pg8::Gemm g{Hb, (const pg8::bf16_t*)(ws + WS_WF2 + (size_t)(l * 2 + 0) * SZ_WF2), MT, DM, FF}; pg8::SplitCtxOrder S{G, vcu, NLAT / 256, NCTX / 256, 16, FF / 64};
            pg8::EpiResid E{xl0, (long)((xc0 - (size_t)NLAT * DM) - xl0), XS, 0L, mods + 2 * DM, NMOD * DM, 0.5f, NLAT / 256, TSEQ / 256, PART, NCTX};
            pg8::gemm_phase<pg8::EpiResid, pg8::SplitCtxOrder, true, true>(lds, g, S, E); }
        SEAML(2);
        if (INL(3)) REPL(3) ph_norm(XS, XS + (size_t)NLAT * DM, normg + DM, mods, 3, (bf16*)XN, XS, PART, 16, MT, gw, NGW, lane);
        SEAML(3);
        if (INL(4)) REPL(4) { pg8::Gemm g{XN, (const pg8::bf16_t*)(ws + WS_WIN + (size_t)l * SZ_WIN), MT, PROJP, DM}; pg8::StaticOrder S; S.init(MT, PROJP, G, bx);
            pg8::EpiProj E{(pg8::bf16_t*)(ws + WS_P), PROJP, (pg8::bf16_t*)(ws + WS_ACT), (pg8::bf16_t*)(ws + WS_QK), args.in[I_QN] + l * 64, args.in[I_KN] + l * 64, (const float*)(ws + WS_ROPE), NLAT, TSEQ};
            pg8::gemm_phase<pg8::EpiProj, pg8::StaticOrder, true, true>(lds, g, S, E); }
        SEAML(4);
        if (INL(5)) REPL(5) { pg8::Gemm g{(const pg8::bf16_t*)(ws + WS_ACT), (const pg8::bf16_t*)(ws + WS_WLO + (size_t)l * SZ_WLO), MT, LOW, ACTW}; pg8::LoraOrder S; S.init(MT, LOW, G, bx);
            pg8::EpiLora E{(float*)(ws + WS_R1), args.in[I_W0] + l * 2048, args.in[I_A0] + l * 2048}; pg8::gemm_phase<pg8::EpiLora, pg8::LoraOrder, true, true>(lds, g, S, E);
            ph_e1(args, l, gt, NGT); }
        SEAML(5);
        if (INL(6)) REPL(6) {
            if (bx < 64) scan_unit(args, l, bx, lds, tid);
            else { ph_attn(args, !last, (char*)lds_raw, bx - 64, G - 64); __syncthreads(); ph_gmlp(args, l, lds, tid, bx - 64, G - 64); }
        }
        SEAML(6);
        if (INL(7)) REPL(7) ph_rwkv_out(args, l, gt, NGT);
        SEAML(7);
        if (INL(8)) REPL(8) { pg8::Gemm g{(const pg8::bf16_t*)(ws + WS_Y3), (const pg8::bf16_t*)(ws + WS_WBR + (size_t)l * SZ_WBR), 3 * MT, 3 * DM, 1024}; pg8::MergeOrder S{G, bx, MT / 256, last ? NLAT / 256 : MT / 256};
            pg8::EpiMerge E{(const pg8::bf16_t*)(ws + WS_P) + P_GATE2, PROJP, args.in[I_BGATE] + (size_t)l * 3 * DM, (float*)(ws + WS_YS), XN, MT / 256};
            pg8::gemm_phase<pg8::EpiMerge, pg8::MergeOrder, true, true>(lds, g, S, E); }
        SEAML(8);
        if (INL(9)) REPL(9) { pg8::Gemm g{XN, (const pg8::bf16_t*)(ws + WS_WOUT + (size_t)l * SZ_WOUT), MT, DM, DM}; pg8::SplitCtxOrder S{G, vcu, NLAT / 256, last ? 0 : NCTX / 256, 8, DM / 64};
            pg8::EpiResid E{XS, 0L, XS, 0L, mods + 5 * DM, NMOD * DM, 1.0f, NLAT / 256, TSEQ / 256, PART, NCTX};
            pg8::gemm_phase<pg8::EpiResid, pg8::SplitCtxOrder, true, true>(lds, g, S, E); }
        SEAML(9);
        if (INL(10)) REPL(10) ph_norm(XS, XS + (size_t)NLAT * DM, normg + 2 * DM, mods, 6, (bf16*)XN, XS, PART, 8, last ? NLAT : MT, gw, NGW, lane);
        SEAML(10);
        if (INL(11)) REPL(11) { pg8::Gemm g{XN, (const pg8::bf16_t*)(ws + WS_WF1 + (size_t)(l * 2 + 1) * SZ_WF1), MT, FF2, DM}; pg8::StaticOrder S; S.init(last ? NLAT : MT, FF2, G, bx);
            pg8::EpiSwiglu E{Hb, FF}; pg8::gemm_phase<pg8::EpiSwiglu, pg8::StaticOrder, true, true>(lds, g, S, E); }
        SEAML(11);
        if (INL(12)) REPL(12) { pg8::Gemm g{Hb, (const pg8::bf16_t*)(ws + WS_WF2 + (size_t)(l * 2 + 1) * SZ_WF2), MT, DM, FF}; pg8::SplitCtxOrder S{G, vcu, NLAT / 256, last ? 0 : NCTX / 256, 16, FF / 64};
            pg8::EpiResid E{XS, 0L, last ? args.out : XS, 0L, mods + 8 * DM, NMOD * DM, 0.5f, NLAT / 256, TSEQ / 256, PART, NCTX};
            pg8::gemm_phase<pg8::EpiResid, pg8::SplitCtxOrder, true, true>(lds, g, S, E); }
        SEAML(12);
    }
__global__ void __launch_bounds__(NTHR, 2) fwd(Args args) {
    extern __shared__ __attribute__((aligned(16))) unsigned char lds_raw[];
    LAS unsigned char* lds = (LAS unsigned char*)lds_raw;
    const int tid = threadIdx.x, lane = tid & 63, wave = __builtin_amdgcn_readfirstlane(tid >> 6);
    const int G = gridDim.x; const int bx = blockIdx.x; const int vcu = (G % 8 == 0) ? (bx % 8) * (G / 8) + bx / 8 : bx;
    const int gw = vcu * NWAVES + wave, NGW = G * NWAVES, gt = vcu * NTHR + tid, NGT = G * NTHR;
    unsigned char* ws = args.ws;
    volatile LAS unsigned* MISC = (volatile LAS unsigned*)(lds + MISC_OFF);
    for (int u = tid; u < (LDS_BYTES - LDSCTL_OFF) / 4; u += NTHR) ((LAS unsigned*)(lds + LDSCTL_OFF))[u] = 0u;
    __syncthreads();
    const int lo = args.ph_lo, hi = args.ph_hi;
    const bool multi = (hi - lo) > 1;
    XcdBarrier bar; bar.bar = (unsigned*)(ws + WS_CTL) + CW_BAR; bar.x = 0; bar.st = nullptr;
    if (multi) bar = xcd_barrier_post((unsigned*)(ws + WS_CTL) + CW_BAR, MISC + 8);

    if ((ONLY_PH < 0 || ONLY_PH == 100) && IN(0)) REPL(16) { ph_ada(args, lds, tid, vcu, G); __syncthreads(); ph_weights(args, lds, tid, vcu, G); }
    SEAM(0);

    layer_body<0>(args, lds, lds_raw, ws, bar, lo, hi, tid, lane, G, bx, vcu, gw, NGW, gt, NGT);
    layer_body<1>(args, lds, lds_raw, ws, bar, lo, hi, tid, lane, G, bx, vcu, gw, NGW, gt, NGT);
#undef IN
#undef SEAM
}

#ifndef MK_PER_PHASE
#define MK_PER_PHASE 0
#endif
extern "C" void kernel_launch(void* const* d_in, const int* in_sizes, int n_in, void* d_out, int out_size, void* d_ws, size_t ws_size, hipStream_t stream) {
    static int grid = 0;
    if (grid == 0) {
        if (n_in != 31 || in_sizes[0] != NLAT * DM || out_size != NLAT * DM || ws_size < WS_END) {
            fprintf(stderr, "kernel_launch: unexpected shapes: n_in %d in0 %d out %d ws %zu (need %zu); nothing launched\n", n_in, n_in > 0 ? in_sizes[0] : -1, out_size, ws_size, (size_t)WS_END); grid = -1; return; }
        int dev = 0, cus = 0, per_cu = 0;
        if (hipGetDevice(&dev) != hipSuccess || hipDeviceGetAttribute(&cus, hipDeviceAttributeMultiprocessorCount, dev) != hipSuccess) { grid = -1; return; }
        if (hipFuncSetAttribute((const void*)fwd, hipFuncAttributeMaxDynamicSharedMemorySize, LDS_BYTES) != hipSuccess) { fprintf(stderr, "kernel_launch: hipFuncSetAttribute failed\n"); grid = -1; return; }
        if (hipOccupancyMaxActiveBlocksPerMultiprocessor(&per_cu, (const void*)fwd, NTHR, LDS_BYTES) != hipSuccess || per_cu < 1) fprintf(stderr, "kernel_launch: occupancy query says %d\n", per_cu);
        (void)hipGetLastError();
        grid = cus;
    }
    if (grid < 0) return;
    (void)hipMemsetAsync((char*)d_ws + WS_CTL, 0, CTL_ZERO_BYTES, stream);
    Args a{};
    for (int i = 0; i < 31; ++i) a.in[i] = (const float*)d_in[i];
    a.out = (float*)d_out; a.ws = (unsigned char*)d_ws;
#if MK_PER_PHASE
    for (int p = 0; p < NPH; ++p) { a.ph_lo = p; a.ph_hi = p + 1; hipLaunchKernelGGL(fwd, dim3(grid), dim3(NTHR), LDS_BYTES, stream, a); }
#else
    a.ph_lo = 0; a.ph_hi = NPH; hipLaunchKernelGGL(fwd, dim3(grid), dim3(NTHR), LDS_BYTES, stream, a);
#endif
}
```

```cpp
#include <hip/hip_runtime.h>
#include <cstdio>
#include <cstdint>
namespace pg8 {
#define PG8_LAS __attribute__((address_space(3)))
typedef unsigned short bf16_t;
typedef short bf16x8 __attribute__((ext_vector_type(8)));
typedef float f32x4 __attribute__((ext_vector_type(4)));
typedef unsigned u32x4 __attribute__((ext_vector_type(4)));
constexpr int BM = 256, BK = 64, HALF = 128, HTB = HALF * BK * 2  , STAGE_BYTES = 8 * HTB, NXCD = 8, WGM = 8;

__host__ __device__ __forceinline__ int lds_byte(int r, int c) { const int st = (r >> 4) * 2 + (c >> 5), rr = r & 15, cc = c & 31, ob = rr * 64 + cc * 2; return st * 1024 + (ob ^ (((ob >> 9) & 1) << 5)); }
__host__ __device__ __forceinline__ void stage_rc(int b, int& R, int& C) { const int st = b / 1024, sb = b % 1024, swz = sb ^ (((sb >> 9) & 1) << 5); R = (st >> 1) * 16 + swz / 64; C = (st & 1) * 32 + (swz % 64) / 2; }
__host__ __device__ __forceinline__ int perm32(int rho) { const int n = rho >> 4, i = rho & 15; return 8 * (i >> 2) + 4 * n + (i & 3); }

struct Unit { int pm, pn, ks, kn, aux; };
struct Gemm { const bf16_t* A; const bf16_t* Bt; int M, N, K; };

struct StaticOrder {
    int nM, nN, nwg, G, c;
    __host__ __device__ void init(int M, int N, int G_, int c_) { nM = M / BM; nN = N / BM; nwg = nM * nN; G = G_; c = c_; }
    __host__ __device__ bool next(int i, Unit& u) const {
        const long L = (long)i * G + c; if (L >= nwg) return false;
        int wgid = (int)L; { const int q = nwg / NXCD, r = nwg % NXCD, xcd = wgid % NXCD, off = wgid / NXCD; wgid = (xcd < r ? xcd * (q + 1) : r * (q + 1) + (xcd - r) * q) + off; }
        const int nig = WGM * nN, gid = wgid / nig, fm = gid * WGM, gsz = (nM - fm) < WGM ? (nM - fm) : WGM;
        u.pm = fm + ((wgid % nig) % gsz); u.pn = (wgid % nig) / gsz; u.ks = 0; u.kn = 0; u.aux = 0; return true;
    }
    __device__ __forceinline__ void a_ready(const Unit&) const {}
    __device__ __forceinline__ void done(const Unit&) const {}
};

__device__ __forceinline__ unsigned cvt_pk_bf16(float lo, float hi) { unsigned r; asm volatile("v_cvt_pk_bf16_f32 %0, %1, %2" : "=v"(r) : "v"(lo), "v"(hi)); return r; }
typedef float f32x2 __attribute__((ext_vector_type(2)));
typedef unsigned u32x2 __attribute__((ext_vector_type(2)));
__device__ __forceinline__ float fsigmoid(float x) { return __builtin_amdgcn_rcpf(1.f + __expf(-x)); }
__device__ __forceinline__ float bflo(unsigned w) { return __builtin_bit_cast(float, w << 16); }
__device__ __forceinline__ float bfhi(unsigned w) { return __builtin_bit_cast(float, w & 0xffff0000u); }

struct EpiSwiglu {
    static constexpr bool PERM = true, AFTER_DRAIN = false;
    bf16_t* H; int ldh;
    __device__ __forceinline__ void operator()(const f32x4 (&acc)[2][2][4][2], const Unit& u, int wr, int wc, int fr, int fq) const {
        const int col0 = u.pn * HALF + wc * 32 + 8 * fq, row0 = u.pm * BM + wr * 64 + fr;
#pragma unroll
        for (int ai = 0; ai < 2; ++ai)
#pragma unroll
            for (int m = 0; m < 4; ++m) {
                const f32x4 g0 = acc[ai][0][m][0], g1 = acc[ai][0][m][1], u0 = acc[ai][1][m][0], u1 = acc[ai][1][m][1];
                float o[8];
#pragma unroll
                for (int e = 0; e < 4; ++e) { o[e] = g0[e] * fsigmoid(g0[e]) * u0[e]; o[4 + e] = g1[e] * fsigmoid(g1[e]) * u1[e]; }
                u32x4 w; w.x = cvt_pk_bf16(o[0], o[1]); w.y = cvt_pk_bf16(o[2], o[3]); w.z = cvt_pk_bf16(o[4], o[5]); w.w = cvt_pk_bf16(o[6], o[7]);
                *(u32x4*)(H + (size_t)(row0 + ai * HALF + m * 16) * ldh + col0) = w;
            }
    }
};

struct EpiResid {
    static constexpr bool PERM = true, AFTER_DRAIN = false;
    const float* xin; long din; float* out; long dout; const float* gvec; int gstride; float scale; int nlat_tiles, tiles_per_set; float* part; int nctx_rows;
    __device__ __forceinline__ void operator()(const f32x4 (&acc)[2][2][4][2], const Unit& u, int wr, int wc, int fr, int fq) const {
        const bool isctx = u.pm >= nlat_tiles;
        const int set = isctx ? 2 : (u.pm / tiles_per_set);
        const float* gv = gvec + (size_t)set * gstride;
        const int colb = u.pn * BM + wc * 32 + 8 * fq;
        const long rbase = (long)(u.pm * BM + wr * 64 + fr) * 2048 + colb;
        const float* xi = xin + rbase + (isctx ? din : 0L); float* xo = out + rbase + (isctx ? dout : 0L);
        f32x4 gg[2][2];
#pragma unroll
        for (int bj = 0; bj < 2; ++bj)
#pragma unroll
            for (int n = 0; n < 2; ++n) gg[bj][n] = *(const f32x4*)(gv + colb + bj * HALF + 4 * n) * scale;
        if (u.kn != 0) {
            float* pp = part + ((size_t)u.aux * (size_t)nctx_rows + (size_t)((u.pm - nlat_tiles) * BM + wr * 64 + fr)) * 2048 + colb;
#pragma unroll
            for (int ai = 0; ai < 2; ++ai)
#pragma unroll
                for (int m = 0; m < 4; ++m)
#pragma unroll
                    for (int bj = 0; bj < 2; ++bj)
#pragma unroll
                        for (int n = 0; n < 2; ++n) *(f32x4*)(pp + (size_t)(ai * HALF + m * 16) * 2048 + bj * HALF + 4 * n) = gg[bj][n] * acc[ai][bj][m][n];
            return;
        }
#pragma unroll
        for (int ai = 0; ai < 2; ++ai) {
            f32x4 xv[4][2][2];
#pragma unroll
            for (int m = 0; m < 4; ++m)
#pragma unroll
                for (int bj = 0; bj < 2; ++bj)
#pragma unroll
                    for (int n = 0; n < 2; ++n) xv[m][bj][n] = *(const f32x4*)(xi + (size_t)(ai * HALF + m * 16) * 2048 + bj * HALF + 4 * n);
#pragma unroll
            for (int m = 0; m < 4; ++m)
#pragma unroll
                for (int bj = 0; bj < 2; ++bj)
#pragma unroll
                    for (int n = 0; n < 2; ++n) *(f32x4*)(xo + (size_t)(ai * HALF + m * 16) * 2048 + bj * HALF + 4 * n) = xv[m][bj][n] + gg[bj][n] * acc[ai][bj][m][n];
        }
    }
};
struct SplitCtxOrder {
    int G, c, nlat_tiles, nctx_tiles, nsplit, ntk;
    __device__ __forceinline__ bool next(int i, Unit& u) const {
        const int e = i * G + c, nl = nlat_tiles * 8;
        if (e < nl) { u.pm = e >> 3; u.pn = e & 7; u.ks = 0; u.kn = 0; u.aux = 0; return true; }
        const int f = e - nl; if (f >= nctx_tiles * 8 * nsplit) return false;
        const int sp = f % nsplit, t = f / nsplit, np = ntk >> 1, p0 = sp * np / nsplit, p1 = (sp + 1) * np / nsplit;
        u.pm = nlat_tiles + (t >> 3); u.pn = t & 7; u.ks = 2 * p0; u.kn = 2 * (p1 - p0); u.aux = sp; return true;
    }
    __device__ __forceinline__ void a_ready(const Unit&) const {}
    __device__ __forceinline__ void done(const Unit&) const {}
};
struct LoraOrder : StaticOrder {
    __device__ __forceinline__ bool next(int i, Unit& u) const {
        if (!StaticOrder::next(i, u)) return false;
        const int sec = u.pn >> 2; int k4 = 4; asm volatile("" : "+s"(k4));
        u.ks = sec == 0 ? 0 : (sec <= 2 ? 4 : 8); u.kn = k4; return true;
    }
};

__device__ __forceinline__ float ftanh_e(float x) { return 1.f - 2.f * __builtin_amdgcn_rcpf(__expf(2.f * x) + 1.f); }
__device__ __forceinline__ float gelu_e(float x) { return 0.5f * x * (1.f + ftanh_e(0.7978845608f * (x + 0.044715f * x * x * x))); }
struct EpiProj {
    static constexpr bool PERM = true, AFTER_DRAIN = false;
    bf16_t* P; int ldp; bf16_t* ACT; bf16_t* QK; const float* qn; const float* kn; const float* rope; int nlat_rows, tseq;
    __device__ __forceinline__ void operator()(const f32x4 (&acc)[2][2][4][2], const Unit& u, int wr, int wc, int fr, int fq) const {
        const int pn = u.pn, row0 = u.pm * BM + wr * 64 + fr;
        if (pn >= 23 && pn <= 30) {
            const bool isq = pn <= 26; const int gi = (pn - 23) * 4 + wc;
            const float* gain = isq ? qn : kn;
            f32x4 gg[2][2];
#pragma unroll
            for (int bj = 0; bj < 2; ++bj)
#pragma unroll
                for (int n = 0; n < 2; ++n) gg[bj][n] = *(const f32x4*)(gain + bj * 32 + n * 16 + 4 * fq);
            const float qs = isq ? 0.18033688011112042f : 1.f;
#pragma unroll
            for (int ai = 0; ai < 2; ++ai)
#pragma unroll
                for (int m = 0; m < 4; ++m) {
                    const int row = row0 + ai * HALF + m * 16;
                    f32x4 x[2][2]; float ss = 0.f;
#pragma unroll
                    for (int bj = 0; bj < 2; ++bj)
#pragma unroll
                        for (int n = 0; n < 2; ++n) { x[bj][n] = acc[ai][bj][m][n]; ss += (x[bj][n][0] * x[bj][n][0] + x[bj][n][1] * x[bj][n][1]) + (x[bj][n][2] * x[bj][n][2] + x[bj][n][3] * x[bj][n][3]); }
                    ss += __shfl_xor(ss, 16); ss += __shfl_xor(ss, 32);
                    const float rinv = __builtin_amdgcn_rsqf(ss * (1.f / 64.f) + 1e-6f);
#pragma unroll
                    for (int bj = 0; bj < 2; ++bj)
#pragma unroll
                        for (int n = 0; n < 2; ++n) x[bj][n] = x[bj][n] * rinv * gg[bj][n];
                    if (row < nlat_rows) { const int t = row & (tseq - 1);
#pragma unroll
                        for (int bj = 0; bj < 2; ++bj) { const int p = bj == 0 ? (t >> 6) : (t & 63);
                            const f32x4 cs0 = *(const f32x4*)(rope + (p * 16 + 4 * fq) * 2), cs1 = *(const f32x4*)(rope + (p * 16 + 4 * fq) * 2 + 4);
                            const f32x4 c = {cs0[0], cs0[2], cs1[0], cs1[2]}, s = {cs0[1], cs0[3], cs1[1], cs1[3]};
                            const f32x4 a = x[bj][0], b2 = x[bj][1];
                            x[bj][0] = a * c - b2 * s; x[bj][1] = b2 * c + a * s; } }
                    bf16_t* dst = QK + (size_t)row * 2048 + gi * 64 + 8 * fq;
#pragma unroll
                    for (int bj = 0; bj < 2; ++bj) { const f32x4 v0 = x[bj][0] * qs, v1 = x[bj][1] * qs;
                        u32x4 w; w.x = cvt_pk_bf16(v0[0], v0[1]); w.y = cvt_pk_bf16(v0[2], v0[3]); w.z = cvt_pk_bf16(v1[0], v1[1]); w.w = cvt_pk_bf16(v1[2], v1[3]);
                        *(u32x4*)(dst + bj * 32) = w; }
                }
            return;
        }
        if (pn >= 20 && pn <= 22) {
#pragma unroll
            for (int bj = 0; bj < 2; ++bj) {
                const int cc = bj * HALF + wc * 32 + 8 * fq;
                int dcol, fn;
                if (pn == 20) { dcol = cc; fn = 1; }
                else if (pn == 21) { if (cc < 96) { dcol = 256 + cc; fn = 2; } else if (cc < 192) { dcol = 384 + (cc - 96); fn = 2; } else { dcol = 512 + (cc - 192); fn = 0; } }
                else { if (cc < 32) { dcol = 576 + cc; fn = 0; } else if (cc < 128) { dcol = 640 + (cc - 32); fn = 0; } else { dcol = -1; fn = 0; } }
                if (dcol < 0) continue;
#pragma unroll
                for (int ai = 0; ai < 2; ++ai)
#pragma unroll
                    for (int m = 0; m < 4; ++m) {
                        f32x4 v0 = acc[ai][bj][m][0], v1 = acc[ai][bj][m][1];
                        if (fn != 0) {
#pragma unroll
                            for (int e = 0; e < 4; ++e) { v0[e] = fn == 1 ? fsigmoid(v0[e]) : ftanh_e(v0[e]); v1[e] = fn == 1 ? fsigmoid(v1[e]) : ftanh_e(v1[e]); } }
                        u32x4 w; w.x = cvt_pk_bf16(v0[0], v0[1]); w.y = cvt_pk_bf16(v0[2], v0[3]); w.z = cvt_pk_bf16(v1[0], v1[1]); w.w = cvt_pk_bf16(v1[2], v1[3]);
                        *(u32x4*)(ACT + (size_t)(row0 + ai * HALF + m * 16) * 768 + dcol) = w;
                    }
            }
            return;
        }
        const bool dogelu = pn < 8;
        const int col0 = pn * BM + wc * 32 + 8 * fq;
#pragma unroll
        for (int ai = 0; ai < 2; ++ai)
#pragma unroll
            for (int m = 0; m < 4; ++m) {
                bf16_t* rowp = P + (size_t)(row0 + ai * HALF + m * 16) * ldp + col0;
#pragma unroll
                for (int bj = 0; bj < 2; ++bj) {
                    f32x4 v0 = acc[ai][bj][m][0], v1 = acc[ai][bj][m][1];
                    if (dogelu) {
#pragma unroll
                        for (int e = 0; e < 4; ++e) { v0[e] = gelu_e(v0[e]); v1[e] = gelu_e(v1[e]); } }
                    u32x4 w; w.x = cvt_pk_bf16(v0[0], v0[1]); w.y = cvt_pk_bf16(v0[2], v0[3]); w.z = cvt_pk_bf16(v1[0], v1[1]); w.w = cvt_pk_bf16(v1[2], v1[3]);
                    *(u32x4*)(rowp + bj * HALF) = w;
                }
            }
    }
};

struct EpiLora {
    static constexpr bool PERM = true, AFTER_DRAIN = false;
    float* LO; const float* w0; const float* a0;
    __device__ __forceinline__ void operator()(const f32x4 (&acc)[2][2][4][2], const Unit& u, int wr, int wc, int fr, int fq) const {
        const int sec = u.pn >> 2;
        const int col0 = u.pn * BM + wc * 32 + 8 * fq, row0 = u.pm * BM + wr * 64 + fr, c0 = col0 - sec * 1024;
        const float* bp = (sec <= 2 ? w0 + (sec <= 1 ? 0 : 1024) : a0 + (sec - 3) * 1024) + c0;
#pragma unroll
        for (int ai = 0; ai < 2; ++ai)
#pragma unroll
            for (int m = 0; m < 4; ++m) {
                float* rowp = LO + (size_t)(row0 + ai * HALF + m * 16) * 5120 + col0;
#pragma unroll
                for (int bj = 0; bj < 2; ++bj)
#pragma unroll
                    for (int n = 0; n < 2; ++n) {
                        f32x4 v = acc[ai][bj][m][n];
                        if (sec >= 1) { v = v + *(const f32x4*)(bp + bj * HALF + 4 * n);
#pragma unroll
                            for (int e = 0; e < 4; ++e) { const float s = fsigmoid(v[e]); v[e] = (sec <= 2) ? __expf(-0.60653066f * s) : s; }
                        }
                        *(f32x4*)(rowp + bj * HALF + 4 * n) = v;
                    }
                asm volatile("" ::: "memory");
            }
    }
};

struct EpiMerge {
    static constexpr bool PERM = true, AFTER_DRAIN = false;
    const bf16_t* pgate; int ldp;
    const float* bgate;
    float* ZF; bf16_t* Z; int mtiles;
    __device__ __forceinline__ void operator()(const f32x4 (&acc)[2][2][4][2], const Unit& u, int wr, int wc, int fr, int fq) const {
        const int br = u.pn >> 3, pn = u.pn & 7, pm = u.pm - mtiles * br;
        const int col0 = pn * BM + wc * 32 + 8 * fq, row0 = pm * BM + wr * 64 + fr;
        f32x4 bb[2][2];
#pragma unroll
        for (int bj = 0; bj < 2; ++bj)
#pragma unroll
            for (int n = 0; n < 2; ++n) bb[bj][n] = *(const f32x4*)(bgate + br * 2048 + col0 + bj * HALF + 4 * n);
#pragma unroll
        for (int ai = 0; ai < 2; ++ai)
#pragma unroll
            for (int mp = 0; mp < 2; ++mp) {
                u32x4 pg[2][2]; f32x4 zf[2][2][2];
#pragma unroll
                for (int mm = 0; mm < 2; ++mm)
#pragma unroll
                    for (int bj = 0; bj < 2; ++bj) { const size_t row = (size_t)(row0 + ai * HALF + (2 * mp + mm) * 16);
                        pg[mm][bj] = *(const u32x4*)(pgate + row * ldp + br * 2048 + col0 + bj * HALF);
                        if (br >= 1) { zf[mm][bj][0] = *(const f32x4*)(ZF + row * 2048 + col0 + bj * HALF); zf[mm][bj][1] = *(const f32x4*)(ZF + row * 2048 + col0 + bj * HALF + 4); } }
#pragma unroll
                for (int mm = 0; mm < 2; ++mm)
#pragma unroll
                    for (int bj = 0; bj < 2; ++bj) { const int m = 2 * mp + mm; const size_t row = (size_t)(row0 + ai * HALF + m * 16); const u32x4 q = pg[mm][bj];
                        f32x4 g0, g1;
                        g0[0] = bflo(q.x); g0[1] = bfhi(q.x); g0[2] = bflo(q.y); g0[3] = bfhi(q.y); g1[0] = bflo(q.z); g1[1] = bfhi(q.z); g1[2] = bflo(q.w); g1[3] = bfhi(q.w);
                        g0 = g0 + bb[bj][0]; g1 = g1 + bb[bj][1];
                        f32x4 v0, v1;
#pragma unroll
                        for (int e = 0; e < 4; ++e) { v0[e] = fsigmoid(g0[e]) * acc[ai][bj][m][0][e]; v1[e] = fsigmoid(g1[e]) * acc[ai][bj][m][1][e]; }
                        float* zp = ZF + row * 2048 + col0 + bj * HALF;
                        if (br >= 1) { v0 = v0 + zf[mm][bj][0]; v1 = v1 + zf[mm][bj][1]; }
                        if (br <= 1) { *(f32x4*)zp = v0; *(f32x4*)(zp + 4) = v1; }
                        else { u32x4 w; w.x = cvt_pk_bf16(v0[0], v0[1]); w.y = cvt_pk_bf16(v0[2], v0[3]); w.z = cvt_pk_bf16(v1[0], v1[1]); w.w = cvt_pk_bf16(v1[2], v1[3]);
                            *(u32x4*)(Z + row * 2048 + col0 + bj * HALF) = w; } }
            }
    }
};
struct MergeOrder {
    int G, c, mtiles, mactive;
    __device__ __forceinline__ bool next(int i, Unit& u) const {
        const int t = (i / 3) * G + c, br = i % 3; if (t >= mactive * 8) return false;
        u.pm = (t >> 3) + mtiles * br; u.pn = (t & 7) + 8 * br; u.ks = 0; u.kn = 0; u.aux = 0; return true;
    }
    __device__ __forceinline__ void a_ready(const Unit&) const {}
    __device__ __forceinline__ void done(const Unit&) const {}
};

template <class Epi, class Sched, bool ALIGN_EPI = false, bool SP2 = false>
__device__ __forceinline__ void gemm_phase(PG8_LAS unsigned char* lds, const Gemm g, const Sched& S, const Epi& E) {
    const int tid = threadIdx.x, wid = __builtin_amdgcn_readfirstlane(tid >> 6), lane = tid & 63, wr = wid >> 2, wc = wid & 3, fr = lane & 15, fq = lane >> 4;
    const int K = g.K, nt = K / BK;
    unsigned voffA[2], voffB[2];
#pragma unroll
    for (int i = 0; i < 2; ++i) { int R, C; stage_rc(tid * 16 + i * 8192, R, C); const int Rb = Epi::PERM ? ((R & ~31) + perm32(R & 31)) : R;
        voffA[i] = (unsigned)(R * K + C) * 2u; voffB[i] = (unsigned)(Rb * K + C) * 2u; }
    const size_t kstep = (size_t)(BK * 2);
    const size_t hstep = (size_t)HALF * K * 2;
    const size_t tstep = 2 * hstep;
    const unsigned ldsw = (unsigned)wid * 1024u;
    const int aoff = lds_byte(wr * 64 + fr, fq * 8), boff = lds_byte(wc * 32 + fr, fq * 8);
#define PG8_SA(b, h) (((b) * 2 + (h)) * HTB)
#define PG8_SB(b, h) ((4 + (b) * 2 + (h)) * HTB)
#define PG8_STAGE(bufoff, gbase, voff) do { _Pragma("unroll") for (int _i = 0; _i < 2; ++_i) \
        __builtin_amdgcn_global_load_lds((const unsigned*)((const char*)(gbase) + (voff)[_i]), (PG8_LAS unsigned*)(lds + (bufoff) + ldsw + _i * 8192), 16, 0, 0); } while (0)
#define PG8_LDA(dst, b, h) do { _Pragma("unroll") for (int m = 0; m < 4; ++m) _Pragma("unroll") for (int k = 0; k < 2; ++k) dst[m][k] = *(const PG8_LAS bf16x8*)(lds + PG8_SA(b, h) + aoff + m * 2048 + k * 1024); } while (0)
#define PG8_LDB(dst, b, h) do { _Pragma("unroll") for (int n = 0; n < 2; ++n) _Pragma("unroll") for (int k = 0; k < 2; ++k) dst[n][k] = *(const PG8_LAS bf16x8*)(lds + PG8_SB(b, h) + boff + n * 2048 + k * 1024); } while (0)
#define PG8_MMA(ai, bj, At, Bt) do { __builtin_amdgcn_s_setprio(1); _Pragma("unroll") for (int m = 0; m < 4; ++m) _Pragma("unroll") for (int n = 0; n < 2; ++n) _Pragma("unroll") for (int k = 0; k < 2; ++k) \
        acc[ai][bj][m][n] = __builtin_amdgcn_mfma_f32_16x16x32_bf16(Bt[n][k], At[m][k], acc[ai][bj][m][n], 0, 0, 0); __builtin_amdgcn_s_setprio(0); } while (0)
#define PG8_WAIT_V(n) asm volatile("s_waitcnt vmcnt(" #n ")" ::: "memory")
#define PG8_WAIT_L(n) asm volatile("s_waitcnt lgkmcnt(" #n ")" ::: "memory")
#define PG8_BAR __builtin_amdgcn_s_barrier()
#define PG8_SCHED __builtin_amdgcn_sched_barrier(0)
    Unit cur, nxt; int ui = 0;
    if (!S.next(0, cur)) return;
    f32x4 acc[2][2][4][2];
#pragma unroll
    for (int a = 0; a < 2; ++a)
#pragma unroll
        for (int b = 0; b < 2; ++b)
#pragma unroll
            for (int m = 0; m < 4; ++m)
#pragma unroll
                for (int n = 0; n < 2; ++n) acc[a][b][m][n] = (f32x4){0.f, 0.f, 0.f, 0.f};
    bf16x8 At[4][2], B0[2][2], B1[2][2];
    const char* cA = (const char*)g.A + (size_t)cur.pm * tstep + (size_t)cur.ks * kstep; const char* cB = (const char*)g.Bt + (size_t)cur.pn * tstep + (size_t)cur.ks * kstep;
    int ntc = cur.kn ? cur.kn : nt;
    S.a_ready(cur);
    if constexpr (SP2) {
        PG8_STAGE(PG8_SB(0, 0), cB, voffB); PG8_STAGE(PG8_SB(0, 1), cB + hstep, voffB); PG8_STAGE(PG8_SA(0, 0), cA, voffA); PG8_STAGE(PG8_SA(0, 1), cA + hstep, voffA);
        if (wr == 1) PG8_BAR;
        PG8_WAIT_V(2); PG8_BAR;
        PG8_STAGE(PG8_SB(1, 0), cB + kstep, voffB); PG8_STAGE(PG8_SA(1, 0), cA + kstep, voffA); PG8_STAGE(PG8_SB(1, 1), cB + hstep + kstep, voffB);
        PG8_WAIT_V(6); PG8_BAR;
    } else {
        PG8_STAGE(PG8_SB(0, 0), cB, voffB); PG8_STAGE(PG8_SA(0, 0), cA, voffA); PG8_STAGE(PG8_SB(0, 1), cB + hstep, voffB); PG8_STAGE(PG8_SA(0, 1), cA + hstep, voffA);
        if (wr == 1) PG8_BAR;
        PG8_WAIT_V(4); PG8_BAR;
        PG8_STAGE(PG8_SB(1, 0), cB + kstep, voffB); PG8_STAGE(PG8_SA(1, 0), cA + kstep, voffA); PG8_STAGE(PG8_SB(1, 1), cB + hstep + kstep, voffB);
        PG8_WAIT_V(6); PG8_BAR;
    }
    for (;;) {
        const bool has_next = S.next(ui + 1, nxt);
        const char* nA = has_next ? (const char*)g.A + (size_t)nxt.pm * tstep + (size_t)nxt.ks * kstep : cA; const char* nB = has_next ? (const char*)g.Bt + (size_t)nxt.pn * tstep + (size_t)nxt.ks * kstep : cB;
        for (int t = 0; t < ntc; t += 2) {
            const bool last = (t == ntc - 2);
            const char* a1 = cA + (size_t)(t + 1) * kstep;
            const char* a2 = last ? nA : cA + (size_t)(t + 2) * kstep; const char* b2 = last ? nB : cB + (size_t)(t + 2) * kstep;
            const char* a3 = a2 + kstep; const char* b3 = b2 + kstep;
            if (last && has_next) S.a_ready(nxt);
            if constexpr (SP2) {
            PG8_LDB(B0, 0, 0); PG8_LDB(B1, 0, 1); PG8_SCHED; PG8_LDA(At, 0, 0); PG8_STAGE(PG8_SA(1, 1), a1 + hstep, voffA);
            PG8_WAIT_V(8); PG8_WAIT_L(0); PG8_BAR; PG8_MMA(0, 0, At, B0); PG8_MMA(0, 1, At, B1); PG8_BAR; PG8_SCHED;
            PG8_LDA(At, 0, 1); PG8_STAGE(PG8_SB(0, 0), b2, voffB); PG8_STAGE(PG8_SB(0, 1), b2 + hstep, voffB); PG8_STAGE(PG8_SA(0, 0), a2, voffA);
            PG8_WAIT_V(8); PG8_WAIT_L(0); PG8_BAR; PG8_MMA(1, 0, At, B0); PG8_MMA(1, 1, At, B1); PG8_BAR; PG8_SCHED;
            PG8_LDB(B0, 1, 0); PG8_LDB(B1, 1, 1); PG8_SCHED; PG8_LDA(At, 1, 0); PG8_STAGE(PG8_SA(0, 1), a2 + hstep, voffA);
            PG8_WAIT_V(8); PG8_WAIT_L(0); PG8_BAR; PG8_MMA(0, 0, At, B0); PG8_MMA(0, 1, At, B1); PG8_BAR; PG8_SCHED;
            PG8_LDA(At, 1, 1); PG8_STAGE(PG8_SB(1, 0), b3, voffB); PG8_STAGE(PG8_SB(1, 1), b3 + hstep, voffB); PG8_STAGE(PG8_SA(1, 0), a3, voffA);
            PG8_WAIT_V(8); PG8_WAIT_L(0); PG8_BAR; PG8_MMA(1, 0, At, B0); PG8_MMA(1, 1, At, B1); PG8_BAR; PG8_SCHED;
            } else {
            PG8_LDB(B0, 0, 0); PG8_SCHED; PG8_LDA(At, 0, 0); PG8_STAGE(PG8_SA(1, 1), a1 + hstep, voffA);
            PG8_WAIT_L(8); PG8_BAR; PG8_WAIT_L(0); PG8_MMA(0, 0, At, B0); PG8_BAR; PG8_SCHED;
            PG8_LDB(B1, 0, 1); PG8_STAGE(PG8_SB(0, 0), b2, voffB);
            PG8_BAR; PG8_WAIT_L(0); PG8_MMA(0, 1, At, B1); PG8_BAR;
            PG8_LDA(At, 0, 1); PG8_STAGE(PG8_SA(0, 0), a2, voffA);
            PG8_BAR; PG8_WAIT_L(0); PG8_MMA(1, 0, At, B0); PG8_BAR; PG8_SCHED;
            PG8_STAGE(PG8_SB(0, 1), b2 + hstep, voffB);
            PG8_WAIT_V(6); PG8_BAR; PG8_MMA(1, 1, At, B1); PG8_BAR;
            PG8_LDB(B0, 1, 0); PG8_SCHED; PG8_LDA(At, 1, 0); PG8_STAGE(PG8_SA(0, 1), a2 + hstep, voffA);
            PG8_WAIT_L(8); PG8_BAR; PG8_WAIT_L(0); PG8_MMA(0, 0, At, B0); PG8_BAR; PG8_SCHED;
            PG8_LDB(B1, 1, 1); PG8_STAGE(PG8_SB(1, 0), b3, voffB);
            PG8_BAR; PG8_WAIT_L(0); PG8_MMA(0, 1, At, B1); PG8_BAR;
            PG8_LDA(At, 1, 1); PG8_STAGE(PG8_SA(1, 0), a3, voffA);
            PG8_BAR; PG8_WAIT_L(0); PG8_MMA(1, 0, At, B0); PG8_BAR; PG8_SCHED;
            PG8_STAGE(PG8_SB(1, 1), b3 + hstep, voffB);
            PG8_WAIT_V(6); PG8_BAR; PG8_MMA(1, 1, At, B1); PG8_BAR;
            }
        }
        if constexpr (ALIGN_EPI) { if (wr == 0) PG8_BAR; }
        if constexpr (!Epi::AFTER_DRAIN) { E(acc, cur, wr, wc, fr, fq); S.done(cur); }
        if (!has_next) break;
#pragma unroll
        for (int a = 0; a < 2; ++a)
#pragma unroll
            for (int b = 0; b < 2; ++b)
#pragma unroll
                for (int m = 0; m < 4; ++m)
#pragma unroll
                    for (int n = 0; n < 2; ++n) acc[a][b][m][n] = (f32x4){0.f, 0.f, 0.f, 0.f};
        cur = nxt; cA = nA; cB = nB; ++ui; ntc = cur.kn ? cur.kn : nt;
        if constexpr (ALIGN_EPI) { if (wr == 1) PG8_BAR; }
    }
    PG8_WAIT_V(0);
    if constexpr (!ALIGN_EPI) { if (wr == 0) PG8_BAR; }
    PG8_BAR;
    if constexpr (Epi::AFTER_DRAIN) { E.fused(acc, cur, wr, wc, fr, fq, lds, wid, lane); S.done(cur); }
#undef PG8_SA
#undef PG8_SB
#undef PG8_STAGE
#undef PG8_LDA
#undef PG8_LDB
#undef PG8_MMA
#undef PG8_WAIT_V
#undef PG8_WAIT_L
#undef PG8_BAR
#undef PG8_SCHED
}
}

constexpr int NWAVES = 8, NTHR = NWAVES * 64;
constexpr int DM = 2048, FF = 5504, FF2 = 2 * FF, NLAT = 8192, NCTX = 512, MT = NLAT + NCTX, TSEQ = 4096, TCTX = 256;
constexpr int PROJ = 14976, PROJP = 15104;
constexpr int P_U = 0, P_V = 1024, P_RKV = 2048, P_G = 5120, P_W = 5376, P_A = 5568, P_QKV = 5760, P_GATE = 8832;
constexpr int P_V2 = 31 * 256, P_GATE2 = 35 * 256;
constexpr int ACTW = 768, LOW = 5120;
constexpr int NLAYER = 2, NMOD = 9;

constexpr size_t MiB = 1u << 20;
constexpr size_t al(size_t x) { return (x + MiB - 1) / MiB * MiB; }
constexpr size_t WS_CTL = 0, CTL_ZERO_BYTES = 1 * MiB;
constexpr size_t WS_MODS = 1 * MiB;
constexpr size_t WS_ROPE = WS_MODS + al((size_t)NLAYER * 3 * NMOD * DM * 4);
constexpr size_t WS_WF1 = WS_ROPE + MiB;
constexpr size_t SZ_WF1 = (size_t)FF2 * DM * 2;
constexpr size_t WS_WF2 = WS_WF1 + al(4 * SZ_WF1);
constexpr size_t SZ_WF2 = (size_t)DM * FF * 2;
constexpr size_t WS_WIN = WS_WF2 + al(4 * SZ_WF2);
constexpr size_t SZ_WIN = (size_t)PROJP * DM * 2;
constexpr size_t WS_WLO = WS_WIN + al(2 * SZ_WIN);
constexpr size_t SZ_WLO = (size_t)LOW * ACTW * 2;
constexpr size_t WS_WBR = WS_WLO + al(2 * SZ_WLO);
constexpr size_t SZ_WBR = (size_t)3 * DM * 1024 * 2;
constexpr size_t WS_WOUT = WS_WBR + al(2 * SZ_WBR);
constexpr size_t SZ_WOUT = (size_t)DM * DM * 2;
constexpr size_t WS_XS = WS_WOUT + al(2 * SZ_WOUT);
constexpr size_t WS_XN = WS_XS + al((size_t)MT * DM * 4);
constexpr size_t WS_P = WS_XN + al((size_t)MT * DM * 2);
constexpr size_t WS_R1 = WS_P + al((size_t)MT * PROJP * 2);
constexpr size_t WS_ACT = WS_R1 + al((size_t)MT * LOW * 4);
constexpr size_t WS_RKVK = WS_ACT + al((size_t)MT * ACTW * 2);
constexpr size_t WS_QK = WS_RKVK + al((size_t)MT * 4096 * 2);
constexpr size_t WS_YS = WS_QK + al((size_t)MT * DM * 2);
constexpr size_t WS_Y3 = WS_YS + al((size_t)2 * MT * 1024 * 4);
constexpr size_t WS_OJ = WS_Y3 + al((size_t)3 * MT * 1024 * 2);
constexpr size_t WS_PART = WS_OJ + al((size_t)2 * MT * 1024 * 4);
constexpr size_t WS_END = WS_PART + al((size_t)16 * NCTX * DM * 4);

constexpr int CW_TMO = 0, CW_CODE = 1, CW_BAR = 4096;

constexpr int RING_BYTES = 131072, LDSCTL_OFF = RING_BYTES, MISC_OFF = LDSCTL_OFF + 320, LDS_BYTES = 147456;

#define GAS __attribute__((address_space(1)))
#define LAS __attribute__((address_space(3)))
typedef unsigned short bf16;
typedef unsigned v4u __attribute__((ext_vector_type(4)));
typedef unsigned v2u __attribute__((ext_vector_type(2)));
typedef float f32x4 __attribute__((ext_vector_type(4)));
typedef short bf16x8 __attribute__((ext_vector_type(8)));
typedef GAS unsigned gu32;
#define RLX_AGENT __ATOMIC_RELAXED, __HIP_MEMORY_SCOPE_AGENT
__device__ __forceinline__ unsigned f2bf(float f) { unsigned u = __builtin_bit_cast(unsigned, f); return (u + 0x7fffu + ((u >> 16) & 1u)) >> 16; }
__device__ __forceinline__ unsigned pk2(float lo, float hi) { return f2bf(lo) | (f2bf(hi) << 16); }
__device__ __forceinline__ float bflo(unsigned w) { return __builtin_bit_cast(float, w << 16); }
__device__ __forceinline__ float bfhi(unsigned w) { return __builtin_bit_cast(float, w & 0xffff0000u); }
__device__ __forceinline__ float bf1(bf16 h) { return __builtin_bit_cast(float, (unsigned)h << 16); }
__device__ __forceinline__ void unpack8(const v4u w, float (&f)[8]) { f[0] = bflo(w.x); f[1] = bfhi(w.x); f[2] = bflo(w.y); f[3] = bfhi(w.y); f[4] = bflo(w.z); f[5] = bfhi(w.z); f[6] = bflo(w.w); f[7] = bfhi(w.w); }
__device__ __forceinline__ v4u pack8(const float (&f)[8]) { v4u w; w.x = pk2(f[0], f[1]); w.y = pk2(f[2], f[3]); w.z = pk2(f[4], f[5]); w.w = pk2(f[6], f[7]); return w; }
__device__ __forceinline__ float fsigm(float x) { return __builtin_amdgcn_rcpf(1.f + __expf(-x)); }
__device__ __forceinline__ float ftanh(float x) { return 1.f - 2.f * __builtin_amdgcn_rcpf(__expf(2.f * x) + 1.f); }
__device__ __forceinline__ float gelu_t(float x) { return 0.5f * x * (1.f + ftanh(0.7978845608f * (x + 0.044715f * x * x * x))); }
__device__ __forceinline__ float wave_sum(float v) {
#pragma unroll
    for (int o = 1; o < 64; o <<= 1) v += __shfl_xor(v, o);
    return v;
}
#define XB_TMO      128
#define XB_XCNT(j)  (256  + 64 * (j))
#define XB_XSUB(j)  (1280 + 64 * (j))
#define XB_XGEN(j)  (2304 + 64 * (j))
#define XB_TOP      3328
#define XB_TOPGEN   3392
#define XCD_BAR_WORDS 3456
#define XB_SPIN_CAP (1u << 18)

__device__ __forceinline__ unsigned xb_ld(unsigned* p)              { return __hip_atomic_load(p, __ATOMIC_RELAXED, __HIP_MEMORY_SCOPE_AGENT); }
__device__ __forceinline__ unsigned xb_add(unsigned* p, unsigned v) { return __hip_atomic_fetch_add(p, v, __ATOMIC_RELAXED, __HIP_MEMORY_SCOPE_AGENT); }
__device__ __forceinline__ unsigned xb_xcc_id() { return (unsigned)__builtin_amdgcn_s_getreg((3 << 11) | 20) & 0xFu; }
#define XB_SPIN(cond, bar) do { unsigned _sp = 0; while (cond) { __builtin_amdgcn_s_sleep(1); \
    if ((++_sp & 255u) == 0u) { if (xb_ld(&(bar)[XB_TMO])) break; if (_sp > XB_SPIN_CAP) { atomicAdd(&(bar)[XB_TMO], 1u); break; } } } } while (0)

struct XcdBarrier {
    unsigned* bar; unsigned x;
    volatile LAS unsigned* st;
};

__device__ __forceinline__ XcdBarrier xcd_barrier_post(unsigned* bar, volatile LAS unsigned* st) {
    XcdBarrier b; b.bar = bar; b.x = xb_xcc_id(); b.st = st;
    if (threadIdx.x == 0) (void)xb_add(&bar[XB_XCNT(b.x)], 1u);
    return b;
}
__device__ __forceinline__ void xcd_barrier_complete(unsigned* bar, unsigned x, unsigned& nloc, unsigned& nx) {
    const unsigned G = gridDim.x * gridDim.y * gridDim.z;
    unsigned sum, cnt, mine, sp = 0u;
    for (;;) {
        sum = 0u; cnt = 0u; mine = 0u;
#pragma unroll
        for (unsigned j = 0; j < 16; ++j) { const unsigned c = xb_ld(&bar[XB_XCNT(j)]); sum += c; cnt += (c > 0u) ? 1u : 0u; mine = (j == x) ? c : mine; }
        if (sum == G) break;
        __builtin_amdgcn_s_sleep(1);
        if ((++sp & 255u) == 0u) { if (xb_ld(&bar[XB_TMO])) break; if (sp > XB_SPIN_CAP) { atomicAdd(&bar[XB_TMO], 1u); break; } }
    }
    nloc = mine > 0u ? mine : 1u; nx = cnt > 0u ? cnt : 1u;
}

__device__ __forceinline__ void xcd_barrier(const XcdBarrier& b) {
    asm volatile("s_waitcnt vmcnt(0)" ::: "memory");
    __syncthreads();
    if (threadIdx.x == 0) {
        unsigned* bar = b.bar;
        __builtin_amdgcn_s_waitcnt(0);
        unsigned nloc = b.st[0], nx = b.st[1];
        if (nloc == 0u) { xcd_barrier_complete(bar, b.x, nloc, nx); b.st[0] = nloc; b.st[1] = nx; }
        const unsigned old = xb_add(&bar[XB_XSUB(b.x)], 1u);
        const unsigned gen = old / nloc;
        if (old + 1u == (gen + 1u) * nloc) {
            __builtin_amdgcn_fence(__ATOMIC_RELEASE, "agent");
            asm volatile("s_waitcnt vmcnt(0)" ::: "memory");
            const unsigned og = xb_add(&bar[XB_TOP], 1u);
            const unsigned tg = og / nx;
            if (og + 1u == (tg + 1u) * nx) xb_add(&bar[XB_TOPGEN], 1u);
            else XB_SPIN(xb_ld(&bar[XB_TOPGEN]) == tg, bar);
            __builtin_amdgcn_fence(__ATOMIC_ACQUIRE, "agent");
            xb_add(&bar[XB_XGEN(b.x)], 1u);
            asm volatile("s_waitcnt vmcnt(0)" ::: "memory");
        } else {
            XB_SPIN(xb_ld(&bar[XB_XGEN(b.x)]) == gen, bar);
            __builtin_amdgcn_fence(__ATOMIC_ACQUIRE, "agent");
            asm volatile("s_waitcnt vmcnt(0)" ::: "memory");
        }
    }
    __syncthreads();
}

struct Args { const float* in[31]; float* out; unsigned char* ws; int ph_lo, ph_hi; };
enum In { I_X = 0, I_C, I_CTX, I_CCTX, I_WADA, I_BADA, I_NORMG, I_FFNIN, I_FFNOUT, I_WIN, I_GMVN, I_GMWS, I_GMBS, I_CONV, I_W0, I_WUP, I_A0, I_AUP, I_GUP, I_KK, I_KA, I_RK, I_LNG, I_LNB,
          I_QN, I_KN, I_LAM, I_SUBLN, I_WBR, I_BGATE, I_WOUT };

__device__ __forceinline__ void ph_ada(const Args& a, int l, LAS unsigned char* lds, int tid, int vcu, int G) {
    LAS float* sc = (LAS float*)lds;
    LAS float* red = sc + 3 * 2048;
    const float* c = a.in[I_C]; const float* cc = a.in[I_CCTX];
    for (int i = tid; i < 3 * 2048; i += NTHR) { const float x = i < 4096 ? c[i] : cc[i - 4096]; sc[i] = x * fsigm(x); }
    __syncthreads();
    const int lane = tid & 63, wave = tid >> 6;
    float* mods = (float*)(a.ws + WS_MODS);
    for (int u = vcu; u < 288; u += G) {
        const int jc = u, j = jc * 64 + lane;
        const float* W = a.in[I_WADA] + (size_t)l * 2048 * 18432 + j;
        float s0 = 0.f, s1 = 0.f, s2 = 0.f;
        const int k0 = wave * 256;
#pragma unroll 8
        for (int k = 0; k < 256; ++k) { const float w = W[(size_t)(k0 + k) * 18432]; s0 += sc[k0 + k] * w; s1 += sc[2048 + k0 + k] * w; s2 += sc[4096 + k0 + k] * w; }
        red[(wave * 3 + 0) * 64 + lane] = s0; red[(wave * 3 + 1) * 64 + lane] = s1; red[(wave * 3 + 2) * 64 + lane] = s2;
        __syncthreads();
        if (wave < 3) { float s = a.in[I_BADA][(size_t)l * 18432 + j];
#pragma unroll
            for (int w8 = 0; w8 < 8; ++w8) s += red[(w8 * 3 + wave) * 64 + lane];
            mods[(size_t)(l * 3 + wave) * 18432 + j] = s; }
        __syncthreads();
    }
}
__device__ __forceinline__ void transpose_item(const float* W, int N, int sc0, bf16* WT, int Kd, int nd0, int k0, LAS float* scr, int lane, bool permq = false) {
    if (sc0 >= 0) {
#pragma unroll 8
        for (int i = 0; i < 32; ++i) { const int kk = 2 * i + (lane >> 5); scr[kk * 33 + (lane & 31)] = W[(size_t)(k0 + kk) * N + sc0 + (lane & 31)]; }
    } else {
#pragma unroll 8
        for (int i = 0; i < 32; ++i) { const int kk = 2 * i + (lane >> 5); scr[kk * 33 + (lane & 31)] = 0.f; }
    }
    asm volatile("s_waitcnt lgkmcnt(0)" ::: "memory");
    const int c = lane & 7;
#pragma unroll
    for (int j = 0; j < 4; ++j) { const int n = (lane >> 3) + 8 * j;
        const int ns = permq ? (((n & 7) < 4) ? 4 * (n >> 3) + (n & 7) : 16 + 4 * (n >> 3) + (n & 7) - 4) : n;
        const LAS float* s = scr + (8 * c) * 33 + ns;
        v4u o; o.x = pk2(s[0 * 33], s[1 * 33]); o.y = pk2(s[2 * 33], s[3 * 33]); o.z = pk2(s[4 * 33], s[5 * 33]); o.w = pk2(s[6 * 33], s[7 * 33]);
        *(GAS v4u*)(WT + (size_t)(nd0 + n) * Kd + k0 + 8 * c) = o; }
    asm volatile("s_waitcnt lgkmcnt(0)" ::: "memory");
}
__device__ __forceinline__ void ph_weights(const Args& a, int l, LAS unsigned char* lds, int tid, int vcu, int G) {
    const int lane = tid & 63, wave = tid >> 6;
    LAS float* scr = (LAS float*)(lds + wave * 16384);
    const int gw = vcu * NWAVES + wave, NGW = G * NWAVES;
    constexpr int I_F1 = 32 * (FF2 / 32), I_F2 = (FF / 64) * (DM / 32), I_IN = 32 * (PROJP / 32), I_BR = 16 * (DM / 32), I_WO = 32 * (DM / 32);
    constexpr int NITEMS = 2 * I_F1 + 2 * I_F2 + I_IN + 3 * I_BR + I_WO;
    unsigned char* ws = a.ws;
    for (int it = gw; it < NITEMS; it += NGW) {
        int r = it;
        if (r < 2 * I_F1) { const int mi = l * 2 + r / I_F1, q = r % I_F1, nb = q % (FF2 / 32), kb = q / (FF2 / 32), nd0 = 32 * nb, pn = nd0 >> 8, rr = nd0 & 255;
            const int sc0 = rr < 128 ? pn * 128 + rr : FF + pn * 128 + (rr - 128);
            transpose_item(a.in[I_FFNIN] + (size_t)mi * DM * FF2, FF2, sc0, (bf16*)(ws + WS_WF1 + (size_t)mi * SZ_WF1), DM, nd0, 64 * kb, scr, lane); continue; }
        r -= 2 * I_F1;
        if (r < 2 * I_F2) { const int mi = l * 2 + r / I_F2, q = r % I_F2, nb = q % (DM / 32), kb = q / (DM / 32);
            transpose_item(a.in[I_FFNOUT] + (size_t)mi * FF * DM, DM, 32 * nb, (bf16*)(ws + WS_WF2 + (size_t)mi * SZ_WF2), FF, 32 * nb, 64 * kb, scr, lane); continue; }
        r -= 2 * I_F2;
        if (r < I_IN) { const int mi = l, q = r, nb = q % (PROJP / 32), kb = q / (PROJP / 32), nd0 = 32 * nb, T = nd0 >> 8, cc = nd0 & 255;
            int sc0; bool pq = false;
            if (T <= 21) sc0 = nd0;
            else if (T == 22) sc0 = cc < 128 ? nd0 : -1;
            else if (T <= 30) { sc0 = P_QKV + ((T - 23) * 4 + ((cc >> 5) & 3)) * 64 + (cc >> 7) * 32; pq = true; }
            else if (T <= 34) sc0 = P_QKV + 2048 + (nd0 - 31 * 256);
            else sc0 = P_GATE + (nd0 - 35 * 256);
            transpose_item(a.in[I_WIN] + (size_t)mi * DM * PROJ, PROJ, sc0, (bf16*)(ws + WS_WIN + (size_t)mi * SZ_WIN), DM, nd0, 64 * kb, scr, lane, pq); continue; }
        r -= I_IN;
        if (r < 3 * I_BR) { const int mi = l * 3 + r / I_BR, q = r % I_BR, nb = q % (DM / 32), kb = q / (DM / 32);
            transpose_item(a.in[I_WBR] + (size_t)mi * 1024 * DM, DM, 32 * nb, (bf16*)(ws + WS_WBR + (size_t)mi * ((size_t)DM * 1024 * 2)), 1024, 32 * nb, 64 * kb, scr, lane); continue; }
        r -= 3 * I_BR;
        { const int mi = l, q = r, nb = q % (DM / 32), kb = q / (DM / 32);
            transpose_item(a.in[I_WOUT] + (size_t)mi * DM * DM, DM, 32 * nb, (bf16*)(ws + WS_WOUT + (size_t)mi * SZ_WOUT), DM, 32 * nb, 64 * kb, scr, lane); }
    }
}
__device__ __forceinline__ void ph_small(const Args& a, int tid, int vcu, int G) {
    unsigned char* ws = a.ws;
    const int gt = vcu * NTHR + tid, NGT = G * NTHR;
    for (int i = gt; i < NLAYER * LOW * (ACTW / 8); i += NGT) {
        const int l = i / (LOW * (ACTW / 8)), q = i % (LOW * (ACTW / 8)), n = q / (ACTW / 8), k0 = (q % (ACTW / 8)) * 8, sec = n >> 10, cc = n & 1023;
        float f[8];
#pragma unroll
        for (int e = 0; e < 8; ++e) { const int k = k0 + e; float v = 0.f;
            if (sec == 0) { if (k < 256) v = a.in[I_GUP][((size_t)l * 256 + k) * 1024 + cc]; }
            else if (sec <= 2) { const int d = sec - 1, kb = 256 + 128 * d; if (k >= kb && k < kb + 96) v = a.in[I_WUP][((size_t)(l * 2 + d) * 96 + (k - kb)) * 1024 + cc]; }
            else { const int d = sec - 3, kb = 512 + 128 * d; if (k >= kb && k < kb + 96) v = a.in[I_AUP][((size_t)(l * 2 + d) * 96 + (k - kb)) * 1024 + cc]; }
            f[e] = v; }
        *(GAS v4u*)((bf16*)(ws + WS_WLO) + ((size_t)l * LOW + n) * ACTW + k0) = pack8(f);
    }
    for (int i = gt; i < 64 * 16; i += NGT) { const int p = i >> 4, ii = i & 15;
        const float inv = exp2f(-(float)(2 * ii) * (1.f / 32.f) * 13.287712379549449f);
        const float rev = (float)p * inv * 0.15915494309189535f;
        float* rt = (float*)(ws + WS_ROPE) + 2 * i; rt[0] = __builtin_amdgcn_cosf(rev); rt[1] = __builtin_amdgcn_sinf(rev); }
}

__device__ __forceinline__ void norm_row_store(f32x4 (&v)[8], int m, const float* gain, const float* mods, int si, bf16* XN, int lane) {
    float ss = 0.f;
#pragma unroll
    for (int j = 0; j < 8; ++j) ss += (v[j].x * v[j].x + v[j].y * v[j].y) + (v[j].z * v[j].z + v[j].w * v[j].w);
    const float rinv = 1.f / sqrtf(wave_sum(ss) * (1.f / DM) + 1e-6f);
    const int set = m < TSEQ ? 0 : (m < NLAT ? 1 : 2);
    const float* sh = mods + (size_t)(set * NMOD + si) * DM; const float* scl = sh + DM;
#pragma unroll
    for (int j = 0; j < 8; ++j) { const int col = 4 * lane + 256 * j;
        const f32x4 g = *(const GAS f32x4*)(gain + col), s1 = *(const GAS f32x4*)(scl + col), s0 = *(const GAS f32x4*)(sh + col);
        const f32x4 o = (v[j] * rinv * g) * (s1 + 1.f) + s0;
        v2u w; w.x = pk2(o.x, o.y); w.y = pk2(o.z, o.w);
        *(GAS v2u*)(XN + (size_t)m * DM + col) = w; }
}
__device__ __forceinline__ void ph_norm(const float* xl, const float* xc, const float* gain, const float* mods  , int si, bf16* XN, float* xs_out, const float* part, int nsplit, int nrows, int gw, int NGW, int lane) {
    for (int m = gw; m < NLAT; m += 2 * NGW) {
        const int m2 = m + NGW; const bool two = m2 < NLAT;
        f32x4 v[8], u[8];
#pragma unroll
        for (int j = 0; j < 8; ++j) v[j] = *(const GAS f32x4*)(xl + (size_t)m * DM + 4 * lane + 256 * j);
        if (two) {
#pragma unroll
            for (int j = 0; j < 8; ++j) u[j] = *(const GAS f32x4*)(xl + (size_t)m2 * DM + 4 * lane + 256 * j); }
        norm_row_store(v, m, gain, mods, si, XN, lane);
        if (two) norm_row_store(u, m2, gain, mods, si, XN, lane);
    }
    if (nrows > NLAT && (gw & 3) == 0) for (int r = gw >> 2; r < NCTX; r += NGW >> 2) {
        const int m = NLAT + r;
        f32x4 v[8];
#pragma unroll
        for (int j = 0; j < 8; ++j) v[j] = *(const GAS f32x4*)(xc + (size_t)r * DM + 4 * lane + 256 * j);
        if (part != nullptr)
#pragma nounroll
        for (int s = 0; s < nsplit; s += 2) {
            f32x4 p[2][8];
#pragma unroll
            for (int q = 0; q < 2; ++q)
#pragma unroll
                for (int j = 0; j < 8; ++j) p[q][j] = *(const GAS f32x4*)(part + ((size_t)(s + q) * NCTX + r) * DM + 4 * lane + 256 * j);
#pragma unroll
            for (int q = 0; q < 2; ++q)
#pragma unroll
                for (int j = 0; j < 8; ++j) v[j] = v[j] + p[q][j]; }
#pragma unroll
        for (int j = 0; j < 8; ++j) *(GAS f32x4*)(xs_out + (size_t)m * DM + 4 * lane + 256 * j) = v[j];
        norm_row_store(v, m, gain, mods, si, XN, lane);
    }
}

struct RkvkItem { v4u x[3][3]; int m, c0; bool hp, hn; };
__device__ __forceinline__ void rkvk_load(RkvkItem& it, const bf16* P, int i) {
    const int m = i >> 7, c0 = (i & 127) * 8; it.m = m; it.c0 = c0;
    const int t = m < NLAT ? (m & (TSEQ - 1)) : ((m - NLAT) & (TCTX - 1)), tl = m < NLAT ? TSEQ : TCTX;
    it.hp = t > 0; it.hn = t < tl - 1;
#pragma unroll
    for (int sec = 0; sec < 3; ++sec) { const bf16* pc = P + (size_t)m * PROJP + P_RKV + sec * 1024 + c0;
        it.x[sec][1] = *(const GAS v4u*)pc;
        it.x[sec][0] = it.hp ? *(const GAS v4u*)(pc - PROJP) : (v4u){0u, 0u, 0u, 0u};
        it.x[sec][2] = it.hn ? *(const GAS v4u*)(pc + PROJP) : (v4u){0u, 0u, 0u, 0u}; }
}
__device__ __forceinline__ void rkvk_finish(const RkvkItem& it, bf16* RK, const float* cw, const float* kkw) {
    const int c0 = it.c0; float rkv[3][8];
#pragma unroll
    for (int sec = 0; sec < 3; ++sec) { const int col = sec * 1024 + c0; float x0[8], x1[8], x2[8];
        unpack8(it.x[sec][0], x0); unpack8(it.x[sec][1], x1); unpack8(it.x[sec][2], x2);
#pragma unroll
        for (int e = 0; e < 8; ++e) rkv[sec][e] = x1[e] * cw[3072 + col + e] + x0[e] * cw[col + e] + x2[e] * cw[2 * 3072 + col + e]; }
    float kk8[8]; float ss = 0.f;
#pragma unroll
    for (int e = 0; e < 8; ++e) { kk8[e] = rkv[1][e] * kkw[c0 + e]; ss += kk8[e] * kk8[e]; }
    ss += __shfl_xor(ss, 1); ss += __shfl_xor(ss, 2); ss += __shfl_xor(ss, 4);
    const float rinv = 1.f / sqrtf(ss + 1e-12f);
    GAS v4u* dst = (GAS v4u*)(RK + (size_t)it.m * 4096 + c0 * 4);
#pragma unroll
    for (int j = 0; j < 4; ++j) { v4u o; o.x = pk2(rkv[0][2 * j], rkv[1][2 * j]); o.y = pk2(rkv[2][2 * j], kk8[2 * j] * rinv); o.z = pk2(rkv[0][2 * j + 1], rkv[1][2 * j + 1]); o.w = pk2(rkv[2][2 * j + 1], kk8[2 * j + 1] * rinv); dst[j] = o; }
}
__device__ __forceinline__ void ph_e1(const Args& a, int l, int gt, int NGT) {
    const bf16* P = (const bf16*)(a.ws + WS_P); bf16* RK = (bf16*)(a.ws + WS_RKVK);
    const float* cw = a.in[I_CONV] + (size_t)l * 3 * 3072; const float* kkw = a.in[I_KK] + l * 1024;
    constexpr int NI = MT * 128;
    for (int i = gt; i < NI; i += 2 * NGT) {
        RkvkItem A, B; const bool two = i + NGT < NI;
        rkvk_load(A, P, i); if (two) rkvk_load(B, P, i + NGT);
        rkvk_finish(A, RK, cw, kkw); if (two) rkvk_finish(B, RK, cw, kkw);
    }
}

__device__ __forceinline__ void ph_gmlp(const Args& a, int l, LAS unsigned char* lds, int tid, int vcu, int G) {
    constexpr int VP = 136;
    LAS bf16* vnT = (LAS bf16*)lds;
    const bf16* P = (const bf16*)(a.ws + WS_P); bf16* YA = (bf16*)(a.ws + WS_Y3);
    const float* vng = a.in[I_GMVN] + l * 1024; const float* wsm = a.in[I_GMWS] + (size_t)l * 8 * 128 * 128; const float* bs = a.in[I_GMBS] + l * 8 * 128;
    const int lane = tid & 63, w = tid >> 6, fr = lane & 15, fq = lane >> 4;
    for (int u = vcu; u < (MT / 128) * 8; u += G) {
        const int n = u >> 3, g = u & 7, m0 = n * 128;
        { const int q = tid >> 2, qt = tid & 3; const bf16* src = P + (size_t)(m0 + q) * PROJP + P_V + g * 128 + qt * 32;
            float v[32]; float ss = 0.f;
#pragma unroll
            for (int j = 0; j < 4; ++j) { float f[8]; unpack8(*(const GAS v4u*)(src + 8 * j), f);
#pragma unroll
                for (int e = 0; e < 8; ++e) { const float x = f[e]; v[8 * j + e] = x; ss += x * x; } }
            ss += __shfl_xor(ss, 1); ss += __shfl_xor(ss, 2);
            const float rinv = 1.f / sqrtf(ss * (1.f / 128.f) + 1e-6f);
#pragma unroll
            for (int e = 0; e < 32; ++e) { const int c = qt * 32 + e; vnT[c * VP + q] = (bf16)f2bf(v[e] * rinv * vng[g * 128 + c]); } }
        __syncthreads();
        pg8::f32x4 acc[8];
#pragma unroll
        for (int cb = 0; cb < 8; ++cb) acc[cb] = (pg8::f32x4){0.f, 0.f, 0.f, 0.f};
#pragma unroll
        for (int ks = 0; ks < 4; ++ks) {
            const float* wr = wsm + ((size_t)g * 128 + 16 * w + fr) * 128 + ks * 32 + 8 * fq;
            const f32x4 w0 = *(const GAS f32x4*)wr, w1 = *(const GAS f32x4*)(wr + 4);
            v4u aw; aw.x = pk2(w0.x, w0.y); aw.y = pk2(w0.z, w0.w); aw.z = pk2(w1.x, w1.y); aw.w = pk2(w1.z, w1.w);
            const bf16x8 af = __builtin_bit_cast(bf16x8, aw);
#pragma unroll
            for (int cb = 0; cb < 8; ++cb) { const bf16x8 bfr = *(const LAS bf16x8*)(vnT + (cb * 16 + fr) * VP + ks * 32 + 8 * fq);
                acc[cb] = __builtin_amdgcn_mfma_f32_16x16x32_bf16(af, bfr, acc[cb], 0, 0, 0); }
        }
#pragma unroll
        for (int cb = 0; cb < 8; ++cb)
#pragma unroll
            for (int i = 0; i < 4; ++i) { const int p = 16 * w + 4 * fq + i, c = cb * 16 + fr;
                const float pu = bf1(P[(size_t)(m0 + p) * PROJP + P_U + g * 128 + c]);
                YA[(size_t)(m0 + p) * 1024 + g * 128 + c] = (bf16)f2bf(pu * (acc[cb][i] + bs[g * 128 + p])); }
        __syncthreads();
    }
}

namespace att {
using bf16x8 = __attribute__((ext_vector_type(8))) short;
using s16x4  = __attribute__((ext_vector_type(4))) short;
using f32x16 = __attribute__((ext_vector_type(16))) float;
using u32x4  = __attribute__((ext_vector_type(4))) unsigned;
constexpr int NW = 8, QBLK = 32, KVBLK = 64;
constexpr float THRL = 11.5f;
constexpr int SHM_V = KVBLK * 128 * 2, SHM_K = KVBLK * 64 * 2, SHM_ATTN = 2 * SHM_V + 2 * SHM_K + NW * 64 * 4;
#define KSWZ(row, colB) ((row) * 128 + ((colB) ^ ((((row) >> 1) & 7) << 4)))
#define SBAR() __builtin_amdgcn_sched_barrier(0)
__device__ __forceinline__ int crow(int r, int hi) { return (r & 3) + 8 * (r >> 2) + 4 * hi; }
__device__ __forceinline__ unsigned cvtpk(float lo, float hi) { unsigned r; asm volatile("v_cvt_pk_bf16_f32 %0, %1, %2" : "=v"(r) : "v"(lo), "v"(hi)); return r; }
__device__ __forceinline__ void partialSM(f32x16& p0, f32x16& p1, float& m_reg, float& mn, float& alpha) {
  float pmax = p0[0];
#pragma unroll
  for (int r = 1; r < 16; ++r) pmax = fmaxf(pmax, p0[r]);
#pragma unroll
  for (int r = 0; r < 16; ++r) pmax = fmaxf(pmax, p1[r]);
  { auto rr = __builtin_amdgcn_permlane32_swap(__float_as_uint(pmax), __float_as_uint(pmax), false, false);
    pmax = fmaxf(__uint_as_float(rr[0]), __uint_as_float(rr[1])); }
  if (__builtin_expect(__all(pmax - m_reg <= THRL), 1)) { mn = m_reg; alpha = 1.f; }
  else { mn = fmaxf(m_reg, pmax); alpha = __builtin_amdgcn_exp2f(m_reg - mn); m_reg = mn; }
#pragma unroll
  for (int r = 0; r < 16; ++r) p0[r] = p0[r] - mn;
#pragma unroll
  for (int r = 0; r < 16; ++r) p1[r] = p1[r] - mn;
#pragma unroll
  for (int r = 0; r < 16; ++r) p0[r] = __builtin_amdgcn_exp2f(p0[r]);
}
__device__ __forceinline__ void finishSM(f32x16& p0, f32x16& p1, float alpha, float& l_reg, bf16x8& pa0, bf16x8& pa1, bf16x8& pa2, bf16x8& pa3) {
#pragma unroll
  for (int r = 0; r < 16; ++r) p1[r] = __builtin_amdgcn_exp2f(p1[r]);
  float ps = 0;
#pragma unroll
  for (int r = 0; r < 16; ++r) ps += p0[r];
#pragma unroll
  for (int r = 0; r < 16; ++r) ps += p1[r];
  { auto rr = __builtin_amdgcn_permlane32_swap(__float_as_uint(ps), __float_as_uint(ps), false, false);
    ps = __uint_as_float(rr[0]) + __uint_as_float(rr[1]); }
  l_reg = l_reg * alpha + ps;
#define PK4(P, BASE, OUT) do { unsigned a0 = cvtpk(P[BASE + 0], P[BASE + 1]), a1 = cvtpk(P[BASE + 2], P[BASE + 3]);   \
    unsigned b0 = cvtpk(P[BASE + 4], P[BASE + 5]), b1 = cvtpk(P[BASE + 6], P[BASE + 7]);                              \
    auto r0 = __builtin_amdgcn_permlane32_swap(a0, b0, false, false); auto r1 = __builtin_amdgcn_permlane32_swap(a1, b1, false, false); \
    u32x4 w = {r0[0], r1[0], r0[1], r1[1]}; OUT = *reinterpret_cast<bf16x8*>(&w); } while (0)
  PK4(p0, 0, pa0); PK4(p0, 8, pa1); PK4(p1, 0, pa2); PK4(p1, 8, pa3);
#undef PK4
}
__device__ __forceinline__ void qkt(f32x16& p0, f32x16& p1, const unsigned short* Ks, const bf16x8* qr, int r32, int hi) {
  p0 = f32x16{}; p1 = f32x16{};
#pragma unroll
  for (int d0 = 0; d0 < 4; ++d0) { int cb = (d0 * 16 + hi * 8) * 2;
    bf16x8 b0 = *reinterpret_cast<const bf16x8*>((const char*)Ks + KSWZ(r32, cb));
    bf16x8 b1 = *reinterpret_cast<const bf16x8*>((const char*)Ks + KSWZ(32 + r32, cb));
    p0 = __builtin_amdgcn_mfma_f32_32x32x16_bf16(b0, qr[d0], p0, 0, 0, 0);
    p1 = __builtin_amdgcn_mfma_f32_32x32x16_bf16(b1, qr[d0], p1, 0, 0, 0); }
}
__device__ __forceinline__ int v_st(int k, int c) { const int kk = (k & ~0xC) | ((k & 4) << 1) | ((k & 8) >> 1); return ((kk >> 3) * 4 + (c >> 5)) * 512 + ((kk & 7) * 32 + (c & 31)) * 2; }
__device__ __forceinline__ int v_rd_base(int lane) { return ((lane & 3) << 3) | (((lane >> 2) & 3) << 6) | (((lane >> 4) & 1) << 5) | (((lane >> 5) & 1) << 8); }
constexpr int v_rd_off(int d0, int ks, int half) { return d0 * 512 + ks * 4096 + half * 2048; }
template <int OFF> __device__ __forceinline__ s16x4 tr_read(int vb) {
  s16x4 r; asm volatile("ds_read_b64_tr_b16 %0, %1 offset:%2" : "=&v"(r) : "v"(vb), "i"(OFF) : "memory"); return r;
}
template <int D0> __device__ __forceinline__ void pv_one(f32x16& od, int vb, bf16x8 pa0, bf16x8 pa1, bf16x8 pa2, bf16x8 pa3) {
  const s16x4 l0 = tr_read<v_rd_off(D0, 0, 0)>(vb), h0 = tr_read<v_rd_off(D0, 0, 1)>(vb), l1 = tr_read<v_rd_off(D0, 1, 0)>(vb), h1 = tr_read<v_rd_off(D0, 1, 1)>(vb);
  const s16x4 l2 = tr_read<v_rd_off(D0, 2, 0)>(vb), h2 = tr_read<v_rd_off(D0, 2, 1)>(vb), l3 = tr_read<v_rd_off(D0, 3, 0)>(vb), h3 = tr_read<v_rd_off(D0, 3, 1)>(vb);
  asm volatile("s_waitcnt lgkmcnt(0)" ::: "memory"); SBAR();
#define PK(L, H) (bf16x8){L[0], L[1], L[2], L[3], H[0], H[1], H[2], H[3]}
  od = __builtin_amdgcn_mfma_f32_32x32x16_bf16(pa0, PK(l0, h0), od, 0, 0, 0);
  od = __builtin_amdgcn_mfma_f32_32x32x16_bf16(pa1, PK(l1, h1), od, 0, 0, 0);
  od = __builtin_amdgcn_mfma_f32_32x32x16_bf16(pa2, PK(l2, h2), od, 0, 0, 0);
  od = __builtin_amdgcn_mfma_f32_32x32x16_bf16(pa3, PK(l3, h3), od, 0, 0, 0);
#undef PK
}
__device__ __forceinline__ void pv_d0(f32x16* o, int vb, bf16x8 pa0, bf16x8 pa1, bf16x8 pa2, bf16x8 pa3) {
  pv_one<0>(o[0], vb, pa0, pa1, pa2, pa3); pv_one<1>(o[1], vb, pa0, pa1, pa2, pa3); pv_one<2>(o[2], vb, pa0, pa1, pa2, pa3); pv_one<3>(o[3], vb, pa0, pa1, pa2, pa3);
}
__device__ __forceinline__ void attn_unit(const unsigned short* __restrict__ Qb, const unsigned short* __restrict__ Kb, const unsigned short* __restrict__ Vb,
                                          float* __restrict__ Ob, int NT, int ntl, int klat, int kctx, char* lds) {
  constexpr int LDQ = 2048, LDKK = 2048, LDV = 15104, LDO = 1024;
  const int tid = threadIdx.x, wid = tid >> 6, lane = tid & 63, r32 = lane & 31, hi = lane >> 5;
  unsigned short* V_lds = (unsigned short*)lds; unsigned short* K_lds = (unsigned short*)(lds + 2 * SHM_V);
  float* ws = (float*)(lds + 2 * SHM_V + 2 * SHM_K) + wid * 64; float* li_l = ws; float* al_l = ws + 32;
  float m_reg = -1e30f, l_reg = 0; f32x16 o[4] = {}; bf16x8 qr[4];
  const unsigned short* Qw = Qb + (long)(wid * QBLK + r32) * LDQ + hi * 8;
#pragma unroll
  for (int d0 = 0; d0 < 4; ++d0) qr[d0] = *reinterpret_cast<const bf16x8*>(Qw + d0 * 16);
  const int sr = tid >> 4, sc = (tid & 15) * 8, vst0 = v_st(sr, sc), vst1 = v_st(32 + sr, sc);
  const int kr = tid >> 3, kc = (tid & 7) * 8, kst = KSWZ(kr, kc * 2);
  const int vb0 = (int)(uintptr_t)V_lds + v_rd_base(lane);
  struct { bf16x8 vs0, vs1, ks0; } sr_[2];
#define KROW(t) ((t) < ntl ? klat + 64 * (t) : kctx + 64 * ((t) - ntl))
#define SLOAD(i, t) do { const long k0_ = KROW(t); sr_[i].vs0 = *reinterpret_cast<const bf16x8*>(&Vb[(k0_ + sr) * LDV + sc]); sr_[i].vs1 = *reinterpret_cast<const bf16x8*>(&Vb[(k0_ + 32 + sr) * LDV + sc]); \
    sr_[i].ks0 = *reinterpret_cast<const bf16x8*>(&Kb[(k0_ + kr) * LDKK + kc]); } while (0)
#define SWRITE(b, i) do { *(bf16x8*)((char*)V_lds + (b) * SHM_V + vst0) = sr_[i].vs0; *(bf16x8*)((char*)V_lds + (b) * SHM_V + vst1) = sr_[i].vs1; \
    *(bf16x8*)((char*)K_lds + (b) * SHM_K + kst) = sr_[i].ks0; } while (0)
#define SWAIT() asm volatile("s_waitcnt vmcnt(3)" ::: "memory")
#define RESC(a) do { if (__any((a) < 1.f)) { if (hi == 0) al_l[r32] = (a); asm volatile("s_waitcnt lgkmcnt(0)" ::: "memory"); \
    _Pragma("unroll") for (int d = 0; d < 4; ++d) _Pragma("unroll") for (int r = 0; r < 16; ++r) o[d][r] *= al_l[crow(r, hi)]; } } while (0)
  f32x16 pA0, pA1, pB0, pB1; float mnA, mnB, alA, alB; bf16x8 pa0, pa1, pa2, pa3;
  constexpr int SE = 0, SO = 1;
  SLOAD(SE, 0); asm volatile("s_waitcnt vmcnt(0)" ::: "memory"); SWRITE(0, SE); __syncthreads();
  qkt(pA0, pA1, K_lds, qr, r32, hi); partialSM(pA0, pA1, m_reg, mnA, alA);
  SLOAD(SO, 1); if (2 < NT) SLOAD(SE, 2);
  SWAIT(); SWRITE(1, SO); __syncthreads();
  for (int j = 1; j + 1 < NT; j += 2) {
    SBAR(); qkt(pB0, pB1, (const unsigned short*)((char*)K_lds + SHM_K), qr, r32, hi);
    finishSM(pA0, pA1, alA, l_reg, pa0, pa1, pa2, pa3); SBAR();
    SLOAD(SO, j + 2); SBAR();
    pv_d0(o, vb0, pa0, pa1, pa2, pa3); partialSM(pB0, pB1, m_reg, mnB, alB);
    __syncthreads(); SWAIT(); SWRITE(0, SE);
    RESC(alB); __syncthreads();
    SBAR(); qkt(pA0, pA1, K_lds, qr, r32, hi);
    finishSM(pB0, pB1, alB, l_reg, pa0, pa1, pa2, pa3); SBAR();
    if (j + 3 < NT) SLOAD(SE, j + 3); SBAR();
    pv_d0(o, vb0 + (int)SHM_V, pa0, pa1, pa2, pa3); partialSM(pA0, pA1, m_reg, mnA, alA);
    __syncthreads(); SWAIT(); SWRITE(1, SO);
    RESC(alA); __syncthreads();
  }
  SBAR(); qkt(pB0, pB1, (const unsigned short*)((char*)K_lds + SHM_K), qr, r32, hi);
  finishSM(pA0, pA1, alA, l_reg, pa0, pa1, pa2, pa3); SBAR();
  pv_d0(o, vb0, pa0, pa1, pa2, pa3); partialSM(pB0, pB1, m_reg, mnB, alB);
  __syncthreads(); RESC(alB);
  finishSM(pB0, pB1, alB, l_reg, pa0, pa1, pa2, pa3); SBAR();
  pv_d0(o, vb0 + (int)SHM_V, pa0, pa1, pa2, pa3);
  if (hi == 0) li_l[r32] = l_reg; asm volatile("s_waitcnt lgkmcnt(0)" ::: "memory");
  float rli[16];
#pragma unroll
  for (int r = 0; r < 16; ++r) rli[r] = __builtin_amdgcn_rcpf(li_l[crow(r, hi)]);
  float* Ow = Ob + (long)(wid * QBLK) * LDO;
#pragma unroll
  for (int r = 0; r < 16; ++r) { int orow = crow(r, hi);
#pragma unroll
    for (int d0 = 0; d0 < 4; ++d0) Ow[(long)orow * LDO + d0 * 32 + r32] = o[d0][r] * rli[r]; }
  __syncthreads();
#undef KROW
#undef SLOAD
#undef SWRITE
#undef SWAIT
#undef RESC
}
#undef KSWZ
#undef SBAR
}

__device__ __forceinline__ void ph_attn(const Args& a, bool ctx_out, char* lds, int widx, int wstride) {
    const unsigned short* QK = (const unsigned short*)(a.ws + WS_QK); const unsigned short* P = (const unsigned short*)(a.ws + WS_P); float* OJ = (float*)(a.ws + WS_OJ);
    const int nunits = ctx_out ? 544 : 512;
    for (int u = widx; u < nunits; u += wstride) {
        int b, hj, qrow0, NT, ntl;
        if (u < 512) { b = u >> 8; hj = (u >> 4) & 15; qrow0 = b * TSEQ + (u & 15) * 256; NT = 68; ntl = 64; }
        else { const int uu = u - 512; b = uu >> 4; hj = uu & 15; qrow0 = NLAT + b * TCTX; NT = 4; ntl = 0; }
        att::attn_unit(QK + (size_t)qrow0 * DM + hj * 64, QK + 1024 + hj * 64, P + P_V2 + (hj >> 1) * 128,
                       OJ + ((size_t)(hj & 1) * MT + qrow0) * 1024 + (hj >> 1) * 128, NT, ntl, b * TSEQ, NLAT + b * TCTX, lds);
    }
}

constexpr int SC_STEP = 768, SC_BLK = 32, SC_BUF = SC_BLK * SC_STEP + 256, SC_Y = 2 * SC_BUF, SC_LDS = SC_Y + 2 * SC_BLK * 64 * 4 + 256;
__device__ __forceinline__ int scan_row(int i, int b, int d) { return i < TCTX ? NLAT + b * TCTX + (d ? TCTX - 1 - i : i) : b * TSEQ + (d ? TSEQ - 1 - (i - TCTX) : (i - TCTX)); }
typedef __amdgpu_buffer_rsrc_t rsrc_t;
typedef short s16x4 __attribute__((ext_vector_type(4)));
typedef __bf16 bf16x2_t __attribute__((ext_vector_type(2)));
typedef float f32x2_t __attribute__((ext_vector_type(2)));
__device__ __forceinline__ unsigned cvtpk_c(float lo, float hi) { f32x2_t v = {lo, hi}; bf16x2_t b = __builtin_convertvector(v, bf16x2_t); return __builtin_bit_cast(unsigned, b); }
__device__ __forceinline__ void scan_fill(rsrc_t LOr, rsrc_t RKr, float kav, LAS unsigned char* buf, int blk, int b, int h, int d, int hw, int lane) {
    const int i0 = blk * SC_BLK, m0 = scan_row(i0, b, d), dir = d ? -1 : 1;
    const int lo0 = (m0 * LOW + 1024 + d * 1024 + h * 64) * 4, lostep = dir * LOW * 4;
    const int rk0 = (m0 * 16 + h) * 512, rkstep = dir * 8192;
    const int inext = i0 + 8 * hw + 8, mn = inext < TCTX + TSEQ ? scan_row(inext, b, d) : m0;
    const int pp = (((lane >> 5) * 4 + ((lane >> 2) & 3)) * 8 + 4 * ((lane >> 4) & 1) + (lane & 3)) * 2;
    float wv[SC_BLK], av[8]; v2u rec[9];
#pragma unroll
    for (int st = 0; st < SC_BLK; ++st) wv[st] = __builtin_bit_cast(float, __builtin_amdgcn_raw_buffer_load_b32(LOr, lane * 4, lo0 + st * lostep, 0));
#pragma unroll
    for (int q = 0; q < 8; ++q) { av[q] = __builtin_bit_cast(float, __builtin_amdgcn_raw_buffer_load_b32(LOr, lane * 4, lo0 + 8192 + (8 * hw + q) * lostep, 0));
        rec[q] = __builtin_amdgcn_raw_buffer_load_b64(RKr, lane * 8, rk0 + (8 * hw + q) * rkstep, 0); }
    rec[8] = __builtin_amdgcn_raw_buffer_load_b64(RKr, lane * 8, (mn * 16 + h) * 512, 0);
    asm volatile("" ::: "memory");
    float g = 1.f;
#pragma unroll
    for (int st = 0; st < SC_BLK; ++st) { if (st < 8 * hw) g *= wv[st]; }
    float gl = 1.f;
#pragma unroll
    for (int st = 0; st < SC_BLK; ++st) gl *= wv[st];
#pragma unroll
    for (int q = 0; q < 8; ++q) {
        const float wq = hw == 0 ? wv[q] : (hw == 1 ? wv[8 + q] : (hw == 2 ? wv[16 + q] : wv[24 + q]));
        g *= wq;
        const float ig = __builtin_amdgcn_rcpf(g);
        const float rv = bflo(rec[q].x), kv = bfhi(rec[q].x), vv = bflo(rec[q].y), kkv = bfhi(rec[q].y), kkn = bfhi(rec[q + 1].y);
        LAS unsigned char* o = buf + (8 * hw + q) * SC_STEP;
        ((LAS unsigned*)o)[lane] = pg8::cvt_pk_bf16(kv * (1.f + (av[q] - 1.f) * kav) * ig, -(kkv * av[q] * ig));
        *(LAS bf16*)(o + 256 + pp) = (bf16)f2bf(kkn * g); *(LAS bf16*)(o + 384 + pp) = (bf16)f2bf(rv * g);
        ((LAS float*)(o + 512))[lane] = vv;
    }
    if (hw == 0) ((LAS float*)(buf + SC_BLK * SC_STEP))[lane] = gl;
}
__device__ __forceinline__ void scan_unit(const Args& a, int l, int u, LAS unsigned char* lds, int tid) {
    const rsrc_t LOr = __builtin_amdgcn_make_buffer_rsrc((void*)(a.ws + WS_R1), 0, MT * LOW * 4, 0x00020000);
    const rsrc_t RKr = __builtin_amdgcn_make_buffer_rsrc((void*)(a.ws + WS_RKVK), 0, MT * 4096 * 2, 0x00020000);
    const rsrc_t YSr = __builtin_amdgcn_make_buffer_rsrc((void*)(a.ws + WS_YS), 0, 2 * MT * 1024 * 4, 0x00020000);
    const int lane = tid & 63, w = __builtin_amdgcn_readfirstlane(tid >> 6), fr = lane & 15, fq = lane >> 4;
    const int b = u >> 5, h = (u >> 1) & 15, d = u & 1;
    const float kav = a.in[I_KA][l * 1024 + h * 64 + lane];
    constexpr int NBLK = (TCTX + TSEQ) / SC_BLK;
    pg8::f32x4 S0 = (pg8::f32x4){0.f, 0.f, 0.f, 0.f}, S1 = S0, S2 = S0, S3 = S0, acc0 = S0, acc1 = S0;
    const unsigned mk0 = fq == 0 ? 0xffffffffu : 0u, mk1 = fq == 1 ? 0xffffffffu : 0u, mk2 = fq == 2 ? 0xffffffffu : 0u, mk3 = fq == 3 ? 0xffffffffu : 0u;
    if (w >= 4) scan_fill(LOr, RKr, kav, lds, 0, b, h, d, w - 4, lane);
    __syncthreads();
    for (int blk = 0; blk < NBLK; ++blk) {
        LAS unsigned char* buf = lds + (blk & 1) * SC_BUF;
        LAS float* yb = (LAS float*)(lds + SC_Y) + (blk & 1) * SC_BLK * 64;
        if (w < 4) {
            const int aoff = 256 + ((fr & 2) ? 128 : 0) + 16 * fq;
            int yoff = 2 * SC_BLK * 64 - (blk & 1) * SC_BLK * 64 + lane;
            unsigned Ua, Ub_; float va, vb_; bf16x8 A0a, A1a, A0b_, A1b_;
#define SC_LOAD(S, st_) do { LAS unsigned char* nb_ = buf + (st_) * SC_STEP; U##S = ((LAS unsigned*)nb_)[lane]; v##S = ((LAS float*)(nb_ + 512))[16 * w + fr]; \
        A0##S = *(const LAS bf16x8*)(nb_ + aoff); A1##S = *(const LAS bf16x8*)(nb_ + aoff + 64); } while (0)
#define SC_DO(S, st_) do { \
        const float sa_ = acc0[0] + acc1[0]; yb[yoff] = acc0[2] + acc1[2]; yoff = (st_) * 64 + 16 * w + fr; \
        const unsigned p_ = cvtpk_c(v##S, sa_); \
        const s16x4 ua_ = __builtin_bit_cast(s16x4, (v2u){U##S, 0u}); \
        S0 = __builtin_amdgcn_mfma_f32_16x16x16bf16_1k(ua_, __builtin_bit_cast(s16x4, (v2u){p_ & mk0, 0u}), S0, 0, 0, 0); \
        S1 = __builtin_amdgcn_mfma_f32_16x16x16bf16_1k(ua_, __builtin_bit_cast(s16x4, (v2u){p_ & mk1, 0u}), S1, 0, 0, 0); \
        S2 = __builtin_amdgcn_mfma_f32_16x16x16bf16_1k(ua_, __builtin_bit_cast(s16x4, (v2u){p_ & mk2, 0u}), S2, 0, 0, 0); \
        S3 = __builtin_amdgcn_mfma_f32_16x16x16bf16_1k(ua_, __builtin_bit_cast(s16x4, (v2u){p_ & mk3, 0u}), S3, 0, 0, 0); \
        v4u p0_, p1_; \
        p0_.x = cvtpk_c(S0[0], S0[1]); p0_.y = cvtpk_c(S0[2], S0[3]); p0_.z = cvtpk_c(S1[0], S1[1]); p0_.w = cvtpk_c(S1[2], S1[3]); \
        p1_.x = cvtpk_c(S2[0], S2[1]); p1_.y = cvtpk_c(S2[2], S2[3]); p1_.z = cvtpk_c(S3[0], S3[1]); p1_.w = cvtpk_c(S3[2], S3[3]); \
        acc0 = __builtin_amdgcn_mfma_f32_16x16x32_bf16(A0##S, __builtin_bit_cast(bf16x8, p0_), (pg8::f32x4){0.f, 0.f, 0.f, 0.f}, 0, 0, 0); \
        acc1 = __builtin_amdgcn_mfma_f32_16x16x32_bf16(A1##S, __builtin_bit_cast(bf16x8, p1_), (pg8::f32x4){0.f, 0.f, 0.f, 0.f}, 0, 0, 0); } while (0)
            SC_LOAD(a, 0);
            for (int st = 0; st < SC_BLK; st += 2) {
                SC_LOAD(b_, st + 1);
                SC_DO(a, st);
                if (st + 2 < SC_BLK) SC_LOAD(a, st + 2);
                SC_DO(b_, st + 1);
            }
#undef SC_LOAD
#undef SC_DO
            { const LAS float* G = (const LAS float*)(buf + SC_BLK * SC_STEP) + 4 * fq;
              S0 = S0 * *(const LAS pg8::f32x4*)(G); S1 = S1 * *(const LAS pg8::f32x4*)(G + 16); S2 = S2 * *(const LAS pg8::f32x4*)(G + 32); S3 = S3 * *(const LAS pg8::f32x4*)(G + 48); }
            yb[yoff] = acc0[2] + acc1[2];
        } else {
            const int hw = w - 4;
            if (blk > 0) { const LAS float* ypb = (const LAS float*)(lds + SC_Y) + ((blk - 1) & 1) * SC_BLK * 64;
                const int mp = scan_row((blk - 1) * SC_BLK, b, d), y0 = ((d * MT + mp) * 1024 + h * 64) * 4, ystep = (d ? -1 : 1) * 4096;
#pragma unroll
                for (int q = 0; q < 8; ++q) __builtin_amdgcn_raw_buffer_store_b32(__builtin_bit_cast(unsigned, ypb[(8 * hw + q) * 64 + lane]), YSr, lane * 4, y0 + (8 * hw + q) * ystep, 0); }
            if (blk + 1 < NBLK) scan_fill(LOr, RKr, kav, lds + ((blk + 1) & 1) * SC_BUF, blk + 1, b, h, d, hw, lane);
        }
        __syncthreads();
    }
    if (w >= 4) { const int hw = w - 4; const LAS float* ypb = (const LAS float*)(lds + SC_Y) + ((NBLK - 1) & 1) * SC_BLK * 64;
        const int mp = scan_row((NBLK - 1) * SC_BLK, b, d), y0 = ((d * MT + mp) * 1024 + h * 64) * 4, ystep = (d ? -1 : 1) * 4096;
#pragma unroll
        for (int q = 0; q < 8; ++q) __builtin_amdgcn_raw_buffer_store_b32(__builtin_bit_cast(unsigned, ypb[(8 * hw + q) * 64 + lane]), YSr, lane * 4, y0 + (8 * hw + q) * ystep, 0); }
    __syncthreads();
}

__device__ __forceinline__ void ph_rwkv_out(const Args& a, int l, int nrows, int gt, int NGT) {
    const float* OJ = (const float*)(a.ws + WS_OJ); bf16* YC = (bf16*)(a.ws + WS_Y3) + (size_t)2 * MT * 1024;
    const float* subln = a.in[I_SUBLN] + l * 128;
    float lam, lam_init;
    { const int lane = threadIdx.x & 63; const float* lv = a.in[I_LAM] + l * 256;
      float l1 = lv[lane] * lv[64 + lane], l2 = lv[128 + lane] * lv[192 + lane]; l1 = wave_sum(l1); l2 = wave_sum(l2);
      lam_init = 0.8f - 0.6f * __expf(-0.3f * (float)l); lam = __expf(l1) - __expf(l2) + lam_init; }
    const float* LO = (const float*)(a.ws + WS_R1); const bf16* RK = (const bf16*)(a.ws + WS_RKVK); const float* YS = (const float*)(a.ws + WS_YS);
    bf16* YB = (bf16*)(a.ws + WS_Y3) + (size_t)MT * 1024;
    const float* ka = a.in[I_KA] + l * 1024; const float* rkw = a.in[I_RK] + l * 1024; const float* lng = a.in[I_LNG] + l * 1024; const float* lnb = a.in[I_LNB] + l * 1024;
    for (int i = gt; i < nrows * 128; i += NGT) {
        const int m = i >> 7, c0 = (i & 127) * 8;
        const f32x4 ya0 = *(const GAS f32x4*)(YS + (size_t)m * 1024 + c0), ya1 = *(const GAS f32x4*)(YS + (size_t)m * 1024 + c0 + 4),
                    yb0 = *(const GAS f32x4*)(YS + ((size_t)MT + m) * 1024 + c0), yb1 = *(const GAS f32x4*)(YS + ((size_t)MT + m) * 1024 + c0 + 4);
        const GAS v4u* rp = (const GAS v4u*)(RK + (size_t)m * 4096 + c0 * 4);
        const v4u q0 = rp[0], q1 = rp[1], q2 = rp[2], q3 = rp[3];
        const float* lo = LO + (size_t)m * LOW + c0;
        const f32x4 g0 = *(const GAS f32x4*)lo, g1 = *(const GAS f32x4*)(lo + 4), aa0 = *(const GAS f32x4*)(lo + 3072), aa1 = *(const GAS f32x4*)(lo + 3076), ab0 = *(const GAS f32x4*)(lo + 4096), ab1 = *(const GAS f32x4*)(lo + 4100);
        const f32x4 p0 = *(const GAS f32x4*)(OJ + (size_t)m * 1024 + c0), p1 = *(const GAS f32x4*)(OJ + (size_t)m * 1024 + c0 + 4),
                    o0 = *(const GAS f32x4*)(OJ + ((size_t)MT + m) * 1024 + c0), o1 = *(const GAS f32x4*)(OJ + ((size_t)MT + m) * 1024 + c0 + 4);
        float y[8]; float s1 = 0.f;
        y[0] = ya0.x + yb0.x; y[1] = ya0.y + yb0.y; y[2] = ya0.z + yb0.z; y[3] = ya0.w + yb0.w; y[4] = ya1.x + yb1.x; y[5] = ya1.y + yb1.y; y[6] = ya1.z + yb1.z; y[7] = ya1.w + yb1.w;
#pragma unroll
        for (int e = 0; e < 8; ++e) s1 += y[e];
        s1 += __shfl_xor(s1, 1); s1 += __shfl_xor(s1, 2); s1 += __shfl_xor(s1, 4);
        const float mu = s1 * (1.f / 64.f); float s2 = 0.f;
#pragma unroll
        for (int e = 0; e < 8; ++e) { y[e] -= mu; s2 += y[e] * y[e]; }
        s2 += __shfl_xor(s2, 1); s2 += __shfl_xor(s2, 2); s2 += __shfl_xor(s2, 4);
        const float rstd = 1.f / sqrtf(s2 * (1.f / 64.f) + 64e-5f);
        float r[8], k[8], v[8];
        r[0] = bflo(q0.x); k[0] = bfhi(q0.x); v[0] = bflo(q0.y); r[1] = bflo(q0.z); k[1] = bfhi(q0.z); v[1] = bflo(q0.w);
        r[2] = bflo(q1.x); k[2] = bfhi(q1.x); v[2] = bflo(q1.y); r[3] = bflo(q1.z); k[3] = bfhi(q1.z); v[3] = bflo(q1.w);
        r[4] = bflo(q2.x); k[4] = bfhi(q2.x); v[4] = bflo(q2.y); r[5] = bflo(q2.z); k[5] = bfhi(q2.z); v[5] = bflo(q2.w);
        r[6] = bflo(q3.x); k[6] = bfhi(q3.x); v[6] = bflo(q3.y); r[7] = bflo(q3.z); k[7] = bfhi(q3.z); v[7] = bflo(q3.w);
        const float am[8] = {0.5f * (aa0.x + ab0.x), 0.5f * (aa0.y + ab0.y), 0.5f * (aa0.z + ab0.z), 0.5f * (aa0.w + ab0.w), 0.5f * (aa1.x + ab1.x), 0.5f * (aa1.y + ab1.y), 0.5f * (aa1.z + ab1.z), 0.5f * (aa1.w + ab1.w)};
        const float gv[8] = {g0.x, g0.y, g0.z, g0.w, g1.x, g1.y, g1.z, g1.w};
        float rk = 0.f;
#pragma unroll
        for (int e = 0; e < 8; ++e) { const int c = c0 + e; rk += r[e] * (k[e] * (1.f + (am[e] - 1.f) * ka[c])) * rkw[c]; }
        rk += __shfl_xor(rk, 1); rk += __shfl_xor(rk, 2); rk += __shfl_xor(rk, 4);
        float o[8];
#pragma unroll
        for (int e = 0; e < 8; ++e) { const int c = c0 + e; o[e] = (y[e] * rstd * lng[c] + lnb[c] + rk * v[e]) * gv[e]; }
        *(GAS v4u*)(YB + (size_t)m * 1024 + c0) = pack8(o);
        { float d[8]; d[0] = p0.x - lam * o0.x; d[1] = p0.y - lam * o0.y; d[2] = p0.z - lam * o0.z; d[3] = p0.w - lam * o0.w; d[4] = p1.x - lam * o1.x; d[5] = p1.y - lam * o1.y; d[6] = p1.z - lam * o1.z; d[7] = p1.w - lam * o1.w;
          float ss = 0.f;
#pragma unroll
          for (int e = 0; e < 8; ++e) ss += d[e] * d[e];
          ss += __shfl_xor(ss, 1); ss += __shfl_xor(ss, 2); ss += __shfl_xor(ss, 4); ss += __shfl_xor(ss, 8);
          const float rinv = (1.f - lam_init) / sqrtf(ss * (1.f / 128.f) + 1e-6f);
#pragma unroll
          for (int e = 0; e < 8; ++e) d[e] = d[e] * rinv * subln[(c0 & 127) + e];
          *(GAS v4u*)(YC + (size_t)m * 1024 + c0) = pack8(d); }
    }
}

constexpr int PH_PER_LAYER = 13, NPH = 1 + NLAYER * PH_PER_LAYER;
#define IN(k) (lo <= (k) && (k) < hi)
#define SEAM(k) do { if (IN(k) && IN((k) + 1)) xcd_barrier(bar); } while (0)
#ifndef ONLY_PH
#define ONLY_PH -1
#endif
#define INL(k) ((ONLY_PH < 0 || ONLY_PH == (k)) && IN(pb + (k)))
#define SEAML(k) SEAM(pb + (k))
#ifndef PROBE_REP
#define PROBE_REP 0
#endif
#define REPL(k) for (int rep_ = 0; rep_ < (((PROBE_REP) >> (k)) & 1) + 1; ++rep_)
template <int l> __device__ __forceinline__ void layer_body(const Args& args, LAS unsigned char* lds, unsigned char* lds_raw, unsigned char* ws, const XcdBarrier& bar, int lo, int hi, int tid, int lane, int G, int bx, int vcu, int gw, int NGW, int gt, int NGT) {
        const int pb = 1 + l * PH_PER_LAYER;
        const bool last = (l == NLAYER - 1);
        float* XS = (float*)(ws + WS_XS); float* PART = (float*)(ws + WS_PART);
        const float* mods = (const float*)(ws + WS_MODS) + (size_t)l * 3 * NMOD * DM;
        const float* normg = args.in[I_NORMG] + (size_t)l * 3 * DM;
        pg8::bf16_t* XN = (pg8::bf16_t*)(ws + WS_XN);
        pg8::bf16_t* Hb = (pg8::bf16_t*)(ws + WS_R1);
        const float* xl0 = (l == 0) ? args.in[I_X] : XS; const float* xc0 = (l == 0) ? args.in[I_CTX] : XS + (size_t)NLAT * DM;

        if (INL(0)) REPL(0) ph_norm(xl0, xc0, normg, mods, 0, (bf16*)XN, XS, l == 0 ? nullptr : PART, 16, MT, gw, NGW, lane);
        SEAML(0);
        if (INL(1)) REPL(1) { pg8::Gemm g{XN, (const pg8::bf16_t*)(ws + WS_WF1 + (size_t)(l * 2 + 0) * SZ_WF1), MT, FF2, DM}; pg8::StaticOrder S; S.init(MT, FF2, G, bx);
            pg8::EpiSwiglu E{Hb, FF}; pg8::gemm_phase<pg8::EpiSwiglu, pg8::StaticOrder, true, true>(lds, g, S, E); }
        SEAML(1);
        if (INL(2)) REPL(2) { pg8::Gemm g{Hb, (const pg8::bf16_t*)(ws + WS_WF2 + (size_t)(l * 2 + 0) * SZ_WF2), MT, DM, FF}; pg8::SplitCtxOrder S{G, vcu, NLAT / 256, NCTX / 256, 16, FF / 64};
            pg8::EpiResid E{xl0, (long)((xc0 - (size_t)NLAT * DM) - xl0), XS, 0L, mods + 2 * DM, NMOD * DM, 0.5f, NLAT / 256, TSEQ / 256, PART, NCTX};
            pg8::gemm_phase<pg8::EpiResid, pg8::SplitCtxOrder, true, true>(lds, g, S, E); }
        SEAML(2);
        if (INL(3)) REPL(3) ph_norm(XS, XS + (size_t)NLAT * DM, normg + DM, mods, 3, (bf16*)XN, XS, PART, 16, MT, gw, NGW, lane);
        SEAML(3);
        if (INL(4)) REPL(4) { pg8::Gemm g{XN, (const pg8::bf16_t*)(ws + WS_WIN + (size_t)l * SZ_WIN), MT, PROJP, DM}; pg8::StaticOrder S; S.init(MT, PROJP, G, bx);
            pg8::EpiProj E{(pg8::bf16_t*)(ws + WS_P), PROJP, (pg8::bf16_t*)(ws + WS_ACT), (pg8::bf16_t*)(ws + WS_QK), args.in[I_QN] + l * 64, args.in[I_KN] + l * 64, (const float*)(ws + WS_ROPE), NLAT, TSEQ};
            pg8::gemm_phase<pg8::EpiProj, pg8::StaticOrder, true, true>(lds, g, S, E); }
        SEAML(4);
        if (INL(5)) REPL(5) { pg8::Gemm g{(const pg8::bf16_t*)(ws + WS_ACT), (const pg8::bf16_t*)(ws + WS_WLO + (size_t)l * SZ_WLO), MT, LOW, ACTW}; pg8::LoraOrder S; S.init(MT, LOW, G, bx);
            pg8::EpiLora E{(float*)(ws + WS_R1), args.in[I_W0] + l * 2048, args.in[I_A0] + l * 2048}; pg8::gemm_phase<pg8::EpiLora, pg8::LoraOrder, true, true>(lds, g, S, E);
            ph_e1(args, l, gt, NGT); }
        SEAML(5);
        if (INL(6)) REPL(6) {
            if (bx < 64) scan_unit(args, l, bx, lds, tid);
            else { ph_attn(args, !last, (char*)lds_raw, bx - 64, G - 64); __syncthreads(); ph_gmlp(args, l, lds, tid, bx - 64, G - 64); }
        }
        SEAML(6);
        if (INL(7)) REPL(7) ph_rwkv_out(args, l, last ? NLAT : MT, gt, NGT);
        SEAML(7);
        if (INL(8)) REPL(8) { pg8::Gemm g{(const pg8::bf16_t*)(ws + WS_Y3), (const pg8::bf16_t*)(ws + WS_WBR + (size_t)l * SZ_WBR), 3 * MT, 3 * DM, 1024}; pg8::MergeOrder S{G, bx, MT / 256, last ? NLAT / 256 : MT / 256};
            pg8::EpiMerge E{(const pg8::bf16_t*)(ws + WS_P) + P_GATE2, PROJP, args.in[I_BGATE] + (size_t)l * 3 * DM, (float*)(ws + WS_YS), XN, MT / 256};
            pg8::gemm_phase<pg8::EpiMerge, pg8::MergeOrder, true, true>(lds, g, S, E); }
        SEAML(8);
        if (INL(9)) REPL(9) { pg8::Gemm g{XN, (const pg8::bf16_t*)(ws + WS_WOUT + (size_t)l * SZ_WOUT), MT, DM, DM}; pg8::SplitCtxOrder S{G, vcu, NLAT / 256, last ? 0 : NCTX / 256, 8, DM / 64};
            pg8::EpiResid E{XS, 0L, XS, 0L, mods + 5 * DM, NMOD * DM, 1.0f, NLAT / 256, TSEQ / 256, PART, NCTX};
            pg8::gemm_phase<pg8::EpiResid, pg8::SplitCtxOrder, true, true>(lds, g, S, E); }
        SEAML(9);
        if (INL(10)) REPL(10) ph_norm(XS, XS + (size_t)NLAT * DM, normg + 2 * DM, mods, 6, (bf16*)XN, XS, PART, 8, last ? NLAT : MT, gw, NGW, lane);
        SEAML(10);
        if (INL(11)) REPL(11) { pg8::Gemm g{XN, (const pg8::bf16_t*)(ws + WS_WF1 + (size_t)(l * 2 + 1) * SZ_WF1), MT, FF2, DM}; pg8::StaticOrder S; S.init(last ? NLAT : MT, FF2, G, bx);
            pg8::EpiSwiglu E{Hb, FF}; pg8::gemm_phase<pg8::EpiSwiglu, pg8::StaticOrder, true, true>(lds, g, S, E); }
        SEAML(11);
        if (INL(12)) REPL(12) { pg8::Gemm g{Hb, (const pg8::bf16_t*)(ws + WS_WF2 + (size_t)(l * 2 + 1) * SZ_WF2), MT, DM, FF}; pg8::SplitCtxOrder S{G, vcu, NLAT / 256, last ? 0 : NCTX / 256, 16, FF / 64};
            pg8::EpiResid E{XS, 0L, last ? args.out : XS, 0L, mods + 8 * DM, NMOD * DM, 0.5f, NLAT / 256, TSEQ / 256, PART, NCTX};
            pg8::gemm_phase<pg8::EpiResid, pg8::SplitCtxOrder, true, true>(lds, g, S, E); }
        SEAML(12);
    }
__global__ void __launch_bounds__(NTHR, 2) fwd(Args args) {
    extern __shared__ __attribute__((aligned(16))) unsigned char lds_raw[];
    LAS unsigned char* lds = (LAS unsigned char*)lds_raw;
    const int tid = threadIdx.x, lane = tid & 63, wave = __builtin_amdgcn_readfirstlane(tid >> 6);
    const int G = gridDim.x; const int bx = blockIdx.x; const int vcu = (G % 8 == 0) ? (bx % 8) * (G / 8) + bx / 8 : bx;
    const int gw = vcu * NWAVES + wave, NGW = G * NWAVES, gt = vcu * NTHR + tid, NGT = G * NTHR;
    unsigned char* ws = args.ws;
    volatile LAS unsigned* MISC = (volatile LAS unsigned*)(lds + MISC_OFF);
    for (int u = tid; u < (LDS_BYTES - LDSCTL_OFF) / 4; u += NTHR) ((LAS unsigned*)(lds + LDSCTL_OFF))[u] = 0u;
    __syncthreads();
    const int lo = args.ph_lo, hi = args.ph_hi;
    const bool multi = (hi - lo) > 1;
    XcdBarrier bar; bar.bar = (unsigned*)(ws + WS_CTL) + CW_BAR; bar.x = 0; bar.st = nullptr;
    if (multi) bar = xcd_barrier_post((unsigned*)(ws + WS_CTL) + CW_BAR, MISC + 8);

    if ((ONLY_PH < 0 || ONLY_PH == 100) && IN(0)) REPL(16) {
        ph_ada(args, 0, lds, tid, vcu, G); __syncthreads(); ph_ada(args, 1, lds, tid, vcu, G); __syncthreads(); ph_weights(args, 0, lds, tid, vcu, G); ph_weights(args, 1, lds, tid, vcu, G); ph_small(args, tid, vcu, G); }
    SEAM(0);

    layer_body<0>(args, lds, lds_raw, ws, bar, lo, hi, tid, lane, G, bx, vcu, gw, NGW, gt, NGT);
    layer_body<1>(args, lds, lds_raw, ws, bar, lo, hi, tid, lane, G, bx, vcu, gw, NGW, gt, NGT);
#undef IN
#undef SEAM
}

#ifndef MK_PER_PHASE
#define MK_PER_PHASE 0
#endif
extern "C" void kernel_launch(void* const* d_in, const int* in_sizes, int n_in, void* d_out, int out_size, void* d_ws, size_t ws_size, hipStream_t stream) {
    static int grid = 0;
    if (grid == 0) {
        if (n_in != 31 || in_sizes[0] != NLAT * DM || out_size != NLAT * DM || ws_size < WS_END) {
            fprintf(stderr, "kernel_launch: unexpected shapes: n_in %d in0 %d out %d ws %zu (need %zu); nothing launched\n", n_in, n_in > 0 ? in_sizes[0] : -1, out_size, ws_size, (size_t)WS_END); grid = -1; return; }
        int dev = 0, cus = 0, per_cu = 0;
        if (hipGetDevice(&dev) != hipSuccess || hipDeviceGetAttribute(&cus, hipDeviceAttributeMultiprocessorCount, dev) != hipSuccess) { grid = -1; return; }
        if (hipFuncSetAttribute((const void*)fwd, hipFuncAttributeMaxDynamicSharedMemorySize, LDS_BYTES) != hipSuccess) { fprintf(stderr, "kernel_launch: hipFuncSetAttribute failed\n"); grid = -1; return; }
        if (hipOccupancyMaxActiveBlocksPerMultiprocessor(&per_cu, (const void*)fwd, NTHR, LDS_BYTES) != hipSuccess || per_cu < 1) fprintf(stderr, "kernel_launch: occupancy query says %d\n", per_cu);
        (void)hipGetLastError();
        grid = cus;
    }
    if (grid < 0) return;
    (void)hipMemsetAsync((char*)d_ws + WS_CTL, 0, CTL_ZERO_BYTES, stream);
    Args a{};
    for (int i = 0; i < 31; ++i) a.in[i] = (const float*)d_in[i];
    a.out = (float*)d_out; a.ws = (unsigned char*)d_ws;
#if MK_PER_PHASE
    for (int p = 0; p < NPH; ++p) { a.ph_lo = p; a.ph_hi = p + 1; hipLaunchKernelGGL(fwd, dim3(grid), dim3(NTHR), LDS_BYTES, stream, a); }
#else
    a.ph_lo = 0; a.ph_hi = NPH; hipLaunchKernelGGL(fwd, dim3(grid), dim3(NTHR), LDS_BYTES, stream, a);
#endif
}
```

```cpp
#include <hip/hip_runtime.h>
#include <cstdio>
#include <cstdint>
namespace pg8 {
#define PG8_LAS __attribute__((address_space(3)))
typedef unsigned short bf16_t;
typedef short bf16x8 __attribute__((ext_vector_type(8)));
typedef float f32x4 __attribute__((ext_vector_type(4)));
typedef unsigned u32x4 __attribute__((ext_vector_type(4)));
constexpr int BM = 256, BK = 64, HALF = 128, HTB = HALF * BK * 2  , STAGE_BYTES = 8 * HTB, NXCD = 8, WGM = 8;

__host__ __device__ __forceinline__ int lds_byte(int r, int c) { const int st = (r >> 4) * 2 + (c >> 5), rr = r & 15, cc = c & 31, ob = rr * 64 + cc * 2; return st * 1024 + (ob ^ (((ob >> 9) & 1) << 5)); }
__host__ __device__ __forceinline__ void stage_rc(int b, int& R, int& C) { const int st = b / 1024, sb = b % 1024, swz = sb ^ (((sb >> 9) & 1) << 5); R = (st >> 1) * 16 + swz / 64; C = (st & 1) * 32 + (swz % 64) / 2; }
__host__ __device__ __forceinline__ int perm32(int rho) { const int n = rho >> 4, i = rho & 15; return 8 * (i >> 2) + 4 * n + (i & 3); }

struct Unit { int pm, pn, ks, kn, aux; };
struct Gemm { const bf16_t* A; const bf16_t* Bt; int M, N, K; };

struct StaticOrder {
    int nM, nN, nwg, G, c;
    __host__ __device__ void init(int M, int N, int G_, int c_) { nM = M / BM; nN = N / BM; nwg = nM * nN; G = G_; c = c_; }
    __host__ __device__ bool next(int i, Unit& u) const {
        const long L = (long)i * G + c; if (L >= nwg) return false;
        int wgid = (int)L; { const int q = nwg / NXCD, r = nwg % NXCD, xcd = wgid % NXCD, off = wgid / NXCD; wgid = (xcd < r ? xcd * (q + 1) : r * (q + 1) + (xcd - r) * q) + off; }
        const int nig = WGM * nN, gid = wgid / nig, fm = gid * WGM, gsz = (nM - fm) < WGM ? (nM - fm) : WGM;
        u.pm = fm + ((wgid % nig) % gsz); u.pn = (wgid % nig) / gsz; u.ks = 0; u.kn = 0; u.aux = 0; return true;
    }
    __device__ __forceinline__ void a_ready(const Unit&) const {}
    __device__ __forceinline__ void done(const Unit&) const {}
};

__device__ __forceinline__ unsigned cvt_pk_bf16(float lo, float hi) { unsigned r; asm volatile("v_cvt_pk_bf16_f32 %0, %1, %2" : "=v"(r) : "v"(lo), "v"(hi)); return r; }
typedef float f32x2 __attribute__((ext_vector_type(2)));
typedef unsigned u32x2 __attribute__((ext_vector_type(2)));
__device__ __forceinline__ float fsigmoid(float x) { return __builtin_amdgcn_rcpf(1.f + __expf(-x)); }
__device__ __forceinline__ float bflo(unsigned w) { return __builtin_bit_cast(float, w << 16); }
__device__ __forceinline__ float bfhi(unsigned w) { return __builtin_bit_cast(float, w & 0xffff0000u); }

struct EpiSwiglu {
    static constexpr bool PERM = true, AFTER_DRAIN = false;
    bf16_t* H; int ldh;
    __device__ __forceinline__ void operator()(const f32x4 (&acc)[2][2][4][2], const Unit& u, int wr, int wc, int fr, int fq) const {
        const int col0 = u.pn * HALF + wc * 32 + 8 * fq, row0 = u.pm * BM + wr * 64 + fr;
#pragma unroll
        for (int ai = 0; ai < 2; ++ai)
#pragma unroll
            for (int m = 0; m < 4; ++m) {
                const f32x4 g0 = acc[ai][0][m][0], g1 = acc[ai][0][m][1], u0 = acc[ai][1][m][0], u1 = acc[ai][1][m][1];
                float o[8];
#pragma unroll
                for (int e = 0; e < 4; ++e) { o[e] = g0[e] * fsigmoid(g0[e]) * u0[e]; o[4 + e] = g1[e] * fsigmoid(g1[e]) * u1[e]; }
                u32x4 w; w.x = cvt_pk_bf16(o[0], o[1]); w.y = cvt_pk_bf16(o[2], o[3]); w.z = cvt_pk_bf16(o[4], o[5]); w.w = cvt_pk_bf16(o[6], o[7]);
                *(u32x4*)(H + (size_t)(row0 + ai * HALF + m * 16) * ldh + col0) = w;
            }
    }
};

struct EpiResid {
    static constexpr bool PERM = true, AFTER_DRAIN = false;
    const float* xin; long din; float* out; long dout; const float* gvec; int gstride; float scale; int nlat_tiles, tiles_per_set; bf16_t* part; int nctx_rows;
    __device__ __forceinline__ void operator()(const f32x4 (&acc)[2][2][4][2], const Unit& u, int wr, int wc, int fr, int fq) const {
        const bool isctx = u.pm >= nlat_tiles;
        const int set = isctx ? 2 : (u.pm / tiles_per_set);
        const float* gv = gvec + (size_t)set * gstride;
        const int colb = u.pn * BM + wc * 32 + 8 * fq;
        const long rbase = (long)(u.pm * BM + wr * 64 + fr) * 2048 + colb;
        const float* xi = xin + rbase + (isctx ? din : 0L); float* xo = out + rbase + (isctx ? dout : 0L);
        f32x4 gg[2][2];
#pragma unroll
        for (int bj = 0; bj < 2; ++bj)
#pragma unroll
            for (int n = 0; n < 2; ++n) gg[bj][n] = *(const f32x4*)(gv + colb + bj * HALF + 4 * n) * scale;
        if (u.kn != 0) {
            bf16_t* pp = part + ((size_t)u.aux * (size_t)nctx_rows + (size_t)((u.pm - nlat_tiles) * BM + wr * 64 + fr)) * 2048 + colb;
#pragma unroll
            for (int ai = 0; ai < 2; ++ai)
#pragma unroll
                for (int m = 0; m < 4; ++m)
#pragma unroll
                    for (int bj = 0; bj < 2; ++bj) { const f32x4 v0 = gg[bj][0] * acc[ai][bj][m][0], v1 = gg[bj][1] * acc[ai][bj][m][1];
                        u32x4 w; w.x = cvt_pk_bf16(v0[0], v0[1]); w.y = cvt_pk_bf16(v0[2], v0[3]); w.z = cvt_pk_bf16(v1[0], v1[1]); w.w = cvt_pk_bf16(v1[2], v1[3]);
                        *(u32x4*)(pp + (size_t)(ai * HALF + m * 16) * 2048 + bj * HALF) = w; }
            return;
        }
#pragma unroll
        for (int ai = 0; ai < 2; ++ai) {
            f32x4 xv[4][2][2];
#pragma unroll
            for (int m = 0; m < 4; ++m)
#pragma unroll
                for (int bj = 0; bj < 2; ++bj)
#pragma unroll
                    for (int n = 0; n < 2; ++n) xv[m][bj][n] = *(const f32x4*)(xi + (size_t)(ai * HALF + m * 16) * 2048 + bj * HALF + 4 * n);
#pragma unroll
            for (int m = 0; m < 4; ++m)
#pragma unroll
                for (int bj = 0; bj < 2; ++bj)
#pragma unroll
                    for (int n = 0; n < 2; ++n) *(f32x4*)(xo + (size_t)(ai * HALF + m * 16) * 2048 + bj * HALF + 4 * n) = xv[m][bj][n] + gg[bj][n] * acc[ai][bj][m][n];
        }
    }
};
struct SplitCtxOrder {
    int G, c, nlat_tiles, nctx_tiles, nsplit, ntk;
    __device__ __forceinline__ bool next(int i, Unit& u) const {
        const int e = i * G + c, nl = nlat_tiles * 8;
        if (e < nl) { u.pm = e >> 3; u.pn = e & 7; u.ks = 0; u.kn = 0; u.aux = 0; return true; }
        const int f = e - nl; if (f >= nctx_tiles * 8 * nsplit) return false;
        const int sp = f % nsplit, t = f / nsplit, np = ntk >> 1, p0 = sp * np / nsplit, p1 = (sp + 1) * np / nsplit;
        u.pm = nlat_tiles + (t >> 3); u.pn = t & 7; u.ks = 2 * p0; u.kn = 2 * (p1 - p0); u.aux = sp; return true;
    }
    __device__ __forceinline__ void a_ready(const Unit&) const {}
    __device__ __forceinline__ void done(const Unit&) const {}
};
struct LoraOrder : StaticOrder {
    __device__ __forceinline__ bool next(int i, Unit& u) const {
        if (!StaticOrder::next(i, u)) return false;
        const int sec = u.pn >> 2; int k4 = 4; asm volatile("" : "+s"(k4));
        u.ks = sec == 0 ? 0 : (sec <= 2 ? 4 : 8); u.kn = k4; return true;
    }
};

__device__ __forceinline__ float ftanh_e(float x) { return 1.f - 2.f * __builtin_amdgcn_rcpf(__expf(2.f * x) + 1.f); }
__device__ __forceinline__ float gelu_e(float x) { return 0.5f * x * (1.f + ftanh_e(0.7978845608f * (x + 0.044715f * x * x * x))); }
struct EpiProj {
    static constexpr bool PERM = true, AFTER_DRAIN = false;
    bf16_t* P; int ldp; bf16_t* ACT; bf16_t* QK; const float* qn; const float* kn; const float* rope; int nlat_rows, tseq;
    __device__ __forceinline__ void operator()(const f32x4 (&acc)[2][2][4][2], const Unit& u, int wr, int wc, int fr, int fq) const {
        const int pn = u.pn, row0 = u.pm * BM + wr * 64 + fr;
        if (pn >= 23 && pn <= 30) {
            const bool isq = pn <= 26; const int gi = (pn - 23) * 4 + wc;
            const float* gain = isq ? qn : kn;
            f32x4 gg[2][2];
#pragma unroll
            for (int bj = 0; bj < 2; ++bj)
#pragma unroll
                for (int n = 0; n < 2; ++n) gg[bj][n] = *(const f32x4*)(gain + bj * 32 + n * 16 + 4 * fq);
            const float qs = isq ? 0.18033688011112042f : 1.f;
#pragma unroll
            for (int ai = 0; ai < 2; ++ai)
#pragma unroll
                for (int m = 0; m < 4; ++m) {
                    const int row = row0 + ai * HALF + m * 16;
                    f32x4 x[2][2]; float ss = 0.f;
#pragma unroll
                    for (int bj = 0; bj < 2; ++bj)
#pragma unroll
                        for (int n = 0; n < 2; ++n) { x[bj][n] = acc[ai][bj][m][n]; ss += (x[bj][n][0] * x[bj][n][0] + x[bj][n][1] * x[bj][n][1]) + (x[bj][n][2] * x[bj][n][2] + x[bj][n][3] * x[bj][n][3]); }
                    ss += __shfl_xor(ss, 16); ss += __shfl_xor(ss, 32);
                    const float rinv = __builtin_amdgcn_rsqf(ss * (1.f / 64.f) + 1e-6f);
#pragma unroll
                    for (int bj = 0; bj < 2; ++bj)
#pragma unroll
                        for (int n = 0; n < 2; ++n) x[bj][n] = x[bj][n] * rinv * gg[bj][n];
                    if (row < nlat_rows) { const int t = row & (tseq - 1);
#pragma unroll
                        for (int bj = 0; bj < 2; ++bj) { const int p = bj == 0 ? (t >> 6) : (t & 63);
                            const f32x4 cs0 = *(const f32x4*)(rope + (p * 16 + 4 * fq) * 2), cs1 = *(const f32x4*)(rope + (p * 16 + 4 * fq) * 2 + 4);
                            const f32x4 c = {cs0[0], cs0[2], cs1[0], cs1[2]}, s = {cs0[1], cs0[3], cs1[1], cs1[3]};
                            const f32x4 a = x[bj][0], b2 = x[bj][1];
                            x[bj][0] = a * c - b2 * s; x[bj][1] = b2 * c + a * s; } }
                    bf16_t* dst = QK + (size_t)row * 2048 + gi * 64 + 8 * fq;
#pragma unroll
                    for (int bj = 0; bj < 2; ++bj) { const f32x4 v0 = x[bj][0] * qs, v1 = x[bj][1] * qs;
                        u32x4 w; w.x = cvt_pk_bf16(v0[0], v0[1]); w.y = cvt_pk_bf16(v0[2], v0[3]); w.z = cvt_pk_bf16(v1[0], v1[1]); w.w = cvt_pk_bf16(v1[2], v1[3]);
                        *(u32x4*)(dst + bj * 32) = w; }
                }
            return;
        }
        if (pn >= 20 && pn <= 22) {
#pragma unroll
            for (int bj = 0; bj < 2; ++bj) {
                const int cc = bj * HALF + wc * 32 + 8 * fq;
                int dcol, fn;
                if (pn == 20) { dcol = cc; fn = 1; }
                else if (pn == 21) { if (cc < 96) { dcol = 256 + cc; fn = 2; } else if (cc < 192) { dcol = 384 + (cc - 96); fn = 2; } else { dcol = 512 + (cc - 192); fn = 0; } }
                else { if (cc < 32) { dcol = 576 + cc; fn = 0; } else if (cc < 128) { dcol = 640 + (cc - 32); fn = 0; } else { dcol = -1; fn = 0; } }
                if (dcol < 0) continue;
#pragma unroll
                for (int ai = 0; ai < 2; ++ai)
#pragma unroll
                    for (int m = 0; m < 4; ++m) {
                        f32x4 v0 = acc[ai][bj][m][0], v1 = acc[ai][bj][m][1];
                        if (fn != 0) {
#pragma unroll
                            for (int e = 0; e < 4; ++e) { v0[e] = fn == 1 ? fsigmoid(v0[e]) : ftanh_e(v0[e]); v1[e] = fn == 1 ? fsigmoid(v1[e]) : ftanh_e(v1[e]); } }
                        u32x4 w; w.x = cvt_pk_bf16(v0[0], v0[1]); w.y = cvt_pk_bf16(v0[2], v0[3]); w.z = cvt_pk_bf16(v1[0], v1[1]); w.w = cvt_pk_bf16(v1[2], v1[3]);
                        *(u32x4*)(ACT + (size_t)(row0 + ai * HALF + m * 16) * 768 + dcol) = w;
                    }
            }
            return;
        }
        const bool dogelu = pn < 8;
        const int col0 = pn * BM + wc * 32 + 8 * fq;
#pragma unroll
        for (int ai = 0; ai < 2; ++ai)
#pragma unroll
            for (int m = 0; m < 4; ++m) {
                bf16_t* rowp = P + (size_t)(row0 + ai * HALF + m * 16) * ldp + col0;
#pragma unroll
                for (int bj = 0; bj < 2; ++bj) {
                    f32x4 v0 = acc[ai][bj][m][0], v1 = acc[ai][bj][m][1];
                    if (dogelu) {
#pragma unroll
                        for (int e = 0; e < 4; ++e) { v0[e] = gelu_e(v0[e]); v1[e] = gelu_e(v1[e]); } }
                    u32x4 w; w.x = cvt_pk_bf16(v0[0], v0[1]); w.y = cvt_pk_bf16(v0[2], v0[3]); w.z = cvt_pk_bf16(v1[0], v1[1]); w.w = cvt_pk_bf16(v1[2], v1[3]);
                    *(u32x4*)(rowp + bj * HALF) = w;
                }
            }
    }
};

struct EpiLora {
    static constexpr bool PERM = true, AFTER_DRAIN = false;
    bf16_t* LO; const float* w0; const float* a0;
    __device__ __forceinline__ void operator()(const f32x4 (&acc)[2][2][4][2], const Unit& u, int wr, int wc, int fr, int fq) const {
        const int sec = u.pn >> 2;
        const int col0 = u.pn * BM + wc * 32 + 8 * fq, row0 = u.pm * BM + wr * 64 + fr, c0 = col0 - sec * 1024;
        const float* bp = (sec <= 2 ? w0 + (sec <= 1 ? 0 : 1024) : a0 + (sec - 3) * 1024) + c0;
#pragma unroll
        for (int ai = 0; ai < 2; ++ai)
#pragma unroll
            for (int m = 0; m < 4; ++m) {
                bf16_t* rowp = LO + (size_t)(row0 + ai * HALF + m * 16) * 5120 + col0;
#pragma unroll
                for (int bj = 0; bj < 2; ++bj) {
                    f32x4 v[2];
#pragma unroll
                    for (int n = 0; n < 2; ++n) { v[n] = acc[ai][bj][m][n];
                        if (sec >= 1) { v[n] = v[n] + *(const f32x4*)(bp + bj * HALF + 4 * n);
#pragma unroll
                            for (int e = 0; e < 4; ++e) { const float s = fsigmoid(v[n][e]); v[n][e] = (sec <= 2) ? 0.8750356f * s : s; } } }
                    u32x4 w; w.x = cvt_pk_bf16(v[0][0], v[0][1]); w.y = cvt_pk_bf16(v[0][2], v[0][3]); w.z = cvt_pk_bf16(v[1][0], v[1][1]); w.w = cvt_pk_bf16(v[1][2], v[1][3]);
                    *(u32x4*)(rowp + bj * HALF) = w;
                }
                asm volatile("" ::: "memory");
            }
    }
};

struct EpiMerge {
    static constexpr bool PERM = true, AFTER_DRAIN = false;
    const bf16_t* pgate; int ldp;
    const float* bgate;
    float* ZF; bf16_t* Z; int mtiles;
    __device__ __forceinline__ void operator()(const f32x4 (&acc)[2][2][4][2], const Unit& u, int wr, int wc, int fr, int fq) const {
        const int br = u.pn >> 3, pn = u.pn & 7, pm = u.pm - mtiles * br;
        const int col0 = pn * BM + wc * 32 + 8 * fq, row0 = pm * BM + wr * 64 + fr;
        f32x4 bb[2][2];
#pragma unroll
        for (int bj = 0; bj < 2; ++bj)
#pragma unroll
            for (int n = 0; n < 2; ++n) bb[bj][n] = *(const f32x4*)(bgate + br * 2048 + col0 + bj * HALF + 4 * n);
#pragma unroll
        for (int ai = 0; ai < 2; ++ai)
#pragma unroll
            for (int mp = 0; mp < 2; ++mp) {
                u32x4 pg[2][2]; f32x4 zf[2][2][2];
#pragma unroll
                for (int mm = 0; mm < 2; ++mm)
#pragma unroll
                    for (int bj = 0; bj < 2; ++bj) { const size_t row = (size_t)(row0 + ai * HALF + (2 * mp + mm) * 16);
                        pg[mm][bj] = *(const u32x4*)(pgate + row * ldp + br * 2048 + col0 + bj * HALF);
                        if (br >= 1) { zf[mm][bj][0] = *(const f32x4*)(ZF + row * 2048 + col0 + bj * HALF); zf[mm][bj][1] = *(const f32x4*)(ZF + row * 2048 + col0 + bj * HALF + 4); } }
#pragma unroll
                for (int mm = 0; mm < 2; ++mm)
#pragma unroll
                    for (int bj = 0; bj < 2; ++bj) { const int m = 2 * mp + mm; const size_t row = (size_t)(row0 + ai * HALF + m * 16); const u32x4 q = pg[mm][bj];
                        f32x4 g0, g1;
                        g0[0] = bflo(q.x); g0[1] = bfhi(q.x); g0[2] = bflo(q.y); g0[3] = bfhi(q.y); g1[0] = bflo(q.z); g1[1] = bfhi(q.z); g1[2] = bflo(q.w); g1[3] = bfhi(q.w);
                        g0 = g0 + bb[bj][0]; g1 = g1 + bb[bj][1];
                        f32x4 v0, v1;
#pragma unroll
                        for (int e = 0; e < 4; ++e) { v0[e] = fsigmoid(g0[e]) * acc[ai][bj][m][0][e]; v1[e] = fsigmoid(g1[e]) * acc[ai][bj][m][1][e]; }
                        float* zp = ZF + row * 2048 + col0 + bj * HALF;
                        if (br >= 1) { v0 = v0 + zf[mm][bj][0]; v1 = v1 + zf[mm][bj][1]; }
                        if (br <= 1) { *(f32x4*)zp = v0; *(f32x4*)(zp + 4) = v1; }
                        else { u32x4 w; w.x = cvt_pk_bf16(v0[0], v0[1]); w.y = cvt_pk_bf16(v0[2], v0[3]); w.z = cvt_pk_bf16(v1[0], v1[1]); w.w = cvt_pk_bf16(v1[2], v1[3]);
                            *(u32x4*)(Z + row * 2048 + col0 + bj * HALF) = w; } }
            }
    }
};
struct MergeOrder {
    int G, c, mtiles, mactive;
    __device__ __forceinline__ bool next(int i, Unit& u) const {
        const int t = (i / 3) * G + c, br = i % 3; if (t >= mactive * 8) return false;
        u.pm = (t >> 3) + mtiles * br; u.pn = (t & 7) + 8 * br; u.ks = 0; u.kn = 0; u.aux = 0; return true;
    }
    __device__ __forceinline__ void a_ready(const Unit&) const {}
    __device__ __forceinline__ void done(const Unit&) const {}
};

template <class Epi, class Sched, bool ALIGN_EPI = false, bool SP2 = false>
__device__ __forceinline__ void gemm_phase(PG8_LAS unsigned char* lds, const Gemm g, const Sched& S, const Epi& E) {
    const int tid = threadIdx.x, wid = __builtin_amdgcn_readfirstlane(tid >> 6), lane = tid & 63, wr = wid >> 2, wc = wid & 3, fr = lane & 15, fq = lane >> 4;
    const int K = g.K, nt = K / BK;
    unsigned voffA[2], voffB[2];
#pragma unroll
    for (int i = 0; i < 2; ++i) { int R, C; stage_rc(tid * 16 + i * 8192, R, C); const int Rb = Epi::PERM ? ((R & ~31) + perm32(R & 31)) : R;
        voffA[i] = (unsigned)(R * K + C) * 2u; voffB[i] = (unsigned)(Rb * K + C) * 2u; }
    const size_t kstep = (size_t)(BK * 2);
    const size_t hstep = (size_t)HALF * K * 2;
    const size_t tstep = 2 * hstep;
    const unsigned ldsw = (unsigned)wid * 1024u;
    const int aoff = lds_byte(wr * 64 + fr, fq * 8), boff = lds_byte(wc * 32 + fr, fq * 8);
#define PG8_SA(b, h) (((b) * 2 + (h)) * HTB)
#define PG8_SB(b, h) ((4 + (b) * 2 + (h)) * HTB)
#define PG8_STAGE(bufoff, gbase, voff) do { _Pragma("unroll") for (int _i = 0; _i < 2; ++_i) \
        __builtin_amdgcn_global_load_lds((const unsigned*)((const char*)(gbase) + (voff)[_i]), (PG8_LAS unsigned*)(lds + (bufoff) + ldsw + _i * 8192), 16, 0, 0); } while (0)
#define PG8_LDA(dst, b, h) do { _Pragma("unroll") for (int m = 0; m < 4; ++m) _Pragma("unroll") for (int k = 0; k < 2; ++k) dst[m][k] = *(const PG8_LAS bf16x8*)(lds + PG8_SA(b, h) + aoff + m * 2048 + k * 1024); } while (0)
#define PG8_LDB(dst, b, h) do { _Pragma("unroll") for (int n = 0; n < 2; ++n) _Pragma("unroll") for (int k = 0; k < 2; ++k) dst[n][k] = *(const PG8_LAS bf16x8*)(lds + PG8_SB(b, h) + boff + n * 2048 + k * 1024); } while (0)
#define PG8_MMA(ai, bj, At, Bt) do { __builtin_amdgcn_s_setprio(1); _Pragma("unroll") for (int m = 0; m < 4; ++m) _Pragma("unroll") for (int n = 0; n < 2; ++n) _Pragma("unroll") for (int k = 0; k < 2; ++k) \
        acc[ai][bj][m][n] = __builtin_amdgcn_mfma_f32_16x16x32_bf16(Bt[n][k], At[m][k], acc[ai][bj][m][n], 0, 0, 0); __builtin_amdgcn_s_setprio(0); } while (0)
#define PG8_WAIT_V(n) asm volatile("s_waitcnt vmcnt(" #n ")" ::: "memory")
#define PG8_WAIT_L(n) asm volatile("s_waitcnt lgkmcnt(" #n ")" ::: "memory")
#define PG8_BAR __builtin_amdgcn_s_barrier()
#define PG8_SCHED __builtin_amdgcn_sched_barrier(0)
    Unit cur, nxt; int ui = 0;
    if (!S.next(0, cur)) return;
    f32x4 acc[2][2][4][2];
#pragma unroll
    for (int a = 0; a < 2; ++a)
#pragma unroll
        for (int b = 0; b < 2; ++b)
#pragma unroll
            for (int m = 0; m < 4; ++m)
#pragma unroll
                for (int n = 0; n < 2; ++n) acc[a][b][m][n] = (f32x4){0.f, 0.f, 0.f, 0.f};
    bf16x8 At[4][2], B0[2][2], B1[2][2];
    const char* cA = (const char*)g.A + (size_t)cur.pm * tstep + (size_t)cur.ks * kstep; const char* cB = (const char*)g.Bt + (size_t)cur.pn * tstep + (size_t)cur.ks * kstep;
    int ntc = cur.kn ? cur.kn : nt;
    S.a_ready(cur);
    if constexpr (SP2) {
        PG8_STAGE(PG8_SB(0, 0), cB, voffB); PG8_STAGE(PG8_SB(0, 1), cB + hstep, voffB); PG8_STAGE(PG8_SA(0, 0), cA, voffA); PG8_STAGE(PG8_SA(0, 1), cA + hstep, voffA);
        if (wr == 1) PG8_BAR;
        PG8_WAIT_V(2); PG8_BAR;
        PG8_STAGE(PG8_SB(1, 0), cB + kstep, voffB); PG8_STAGE(PG8_SA(1, 0), cA + kstep, voffA); PG8_STAGE(PG8_SB(1, 1), cB + hstep + kstep, voffB);
        PG8_WAIT_V(6); PG8_BAR;
    } else {
        PG8_STAGE(PG8_SB(0, 0), cB, voffB); PG8_STAGE(PG8_SA(0, 0), cA, voffA); PG8_STAGE(PG8_SB(0, 1), cB + hstep, voffB); PG8_STAGE(PG8_SA(0, 1), cA + hstep, voffA);
        if (wr == 1) PG8_BAR;
        PG8_WAIT_V(4); PG8_BAR;
        PG8_STAGE(PG8_SB(1, 0), cB + kstep, voffB); PG8_STAGE(PG8_SA(1, 0), cA + kstep, voffA); PG8_STAGE(PG8_SB(1, 1), cB + hstep + kstep, voffB);
        PG8_WAIT_V(6); PG8_BAR;
    }
    for (;;) {
        const bool has_next = S.next(ui + 1, nxt);
        const char* nA = has_next ? (const char*)g.A + (size_t)nxt.pm * tstep + (size_t)nxt.ks * kstep : cA; const char* nB = has_next ? (const char*)g.Bt + (size_t)nxt.pn * tstep + (size_t)nxt.ks * kstep : cB;
        for (int t = 0; t < ntc; t += 2) {
            const bool last = (t == ntc - 2);
            const char* a1 = cA + (size_t)(t + 1) * kstep;
            const char* a2 = last ? nA : cA + (size_t)(t + 2) * kstep; const char* b2 = last ? nB : cB + (size_t)(t + 2) * kstep;
            const char* a3 = a2 + kstep; const char* b3 = b2 + kstep;
            if (last && has_next) S.a_ready(nxt);
            if constexpr (SP2) {
            PG8_LDB(B0, 0, 0); PG8_LDB(B1, 0, 1); PG8_SCHED; PG8_LDA(At, 0, 0); PG8_STAGE(PG8_SA(1, 1), a1 + hstep, voffA);
            PG8_WAIT_V(8); PG8_WAIT_L(0); PG8_BAR; PG8_MMA(0, 0, At, B0); PG8_MMA(0, 1, At, B1); PG8_BAR; PG8_SCHED;
            PG8_LDA(At, 0, 1); PG8_STAGE(PG8_SB(0, 0), b2, voffB); PG8_STAGE(PG8_SB(0, 1), b2 + hstep, voffB); PG8_STAGE(PG8_SA(0, 0), a2, voffA);
            PG8_WAIT_V(8); PG8_WAIT_L(0); PG8_BAR; PG8_MMA(1, 0, At, B0); PG8_MMA(1, 1, At, B1); PG8_BAR; PG8_SCHED;
            PG8_LDB(B0, 1, 0); PG8_LDB(B1, 1, 1); PG8_SCHED; PG8_LDA(At, 1, 0); PG8_STAGE(PG8_SA(0, 1), a2 + hstep, voffA);
            PG8_WAIT_V(8); PG8_WAIT_L(0); PG8_BAR; PG8_MMA(0, 0, At, B0); PG8_MMA(0, 1, At, B1); PG8_BAR; PG8_SCHED;
            PG8_LDA(At, 1, 1); PG8_STAGE(PG8_SB(1, 0), b3, voffB); PG8_STAGE(PG8_SB(1, 1), b3 + hstep, voffB); PG8_STAGE(PG8_SA(1, 0), a3, voffA);
            PG8_WAIT_V(8); PG8_WAIT_L(0); PG8_BAR; PG8_MMA(1, 0, At, B0); PG8_MMA(1, 1, At, B1); PG8_BAR; PG8_SCHED;
            } else {
            PG8_LDB(B0, 0, 0); PG8_SCHED; PG8_LDA(At, 0, 0); PG8_STAGE(PG8_SA(1, 1), a1 + hstep, voffA);
            PG8_WAIT_L(8); PG8_BAR; PG8_WAIT_L(0); PG8_MMA(0, 0, At, B0); PG8_BAR; PG8_SCHED;
            PG8_LDB(B1, 0, 1); PG8_STAGE(PG8_SB(0, 0), b2, voffB);
            PG8_BAR; PG8_WAIT_L(0); PG8_MMA(0, 1, At, B1); PG8_BAR;
            PG8_LDA(At, 0, 1); PG8_STAGE(PG8_SA(0, 0), a2, voffA);
            PG8_BAR; PG8_WAIT_L(0); PG8_MMA(1, 0, At, B0); PG8_BAR; PG8_SCHED;
            PG8_STAGE(PG8_SB(0, 1), b2 + hstep, voffB);
            PG8_WAIT_V(6); PG8_BAR; PG8_MMA(1, 1, At, B1); PG8_BAR;
            PG8_LDB(B0, 1, 0); PG8_SCHED; PG8_LDA(At, 1, 0); PG8_STAGE(PG8_SA(0, 1), a2 + hstep, voffA);
            PG8_WAIT_L(8); PG8_BAR; PG8_WAIT_L(0); PG8_MMA(0, 0, At, B0); PG8_BAR; PG8_SCHED;
            PG8_LDB(B1, 1, 1); PG8_STAGE(PG8_SB(1, 0), b3, voffB);
            PG8_BAR; PG8_WAIT_L(0); PG8_MMA(0, 1, At, B1); PG8_BAR;
            PG8_LDA(At, 1, 1); PG8_STAGE(PG8_SA(1, 0), a3, voffA);
            PG8_BAR; PG8_WAIT_L(0); PG8_MMA(1, 0, At, B0); PG8_BAR; PG8_SCHED;
            PG8_STAGE(PG8_SB(1, 1), b3 + hstep, voffB);
            PG8_WAIT_V(6); PG8_BAR; PG8_MMA(1, 1, At, B1); PG8_BAR;
            }
        }
        if constexpr (ALIGN_EPI) { if (wr == 0) PG8_BAR; }
        if constexpr (!Epi::AFTER_DRAIN) { E(acc, cur, wr, wc, fr, fq); S.done(cur); }
        if (!has_next) break;
#pragma unroll
        for (int a = 0; a < 2; ++a)
#pragma unroll
            for (int b = 0; b < 2; ++b)
#pragma unroll
                for (int m = 0; m < 4; ++m)
#pragma unroll
                    for (int n = 0; n < 2; ++n) acc[a][b][m][n] = (f32x4){0.f, 0.f, 0.f, 0.f};
        cur = nxt; cA = nA; cB = nB; ++ui; ntc = cur.kn ? cur.kn : nt;
        if constexpr (ALIGN_EPI) { if (wr == 1) PG8_BAR; }
    }
    PG8_WAIT_V(0);
    if constexpr (!ALIGN_EPI) { if (wr == 0) PG8_BAR; }
    PG8_BAR;
    if constexpr (Epi::AFTER_DRAIN) { E.fused(acc, cur, wr, wc, fr, fq, lds, wid, lane); S.done(cur); }
#undef PG8_SA
#undef PG8_SB
#undef PG8_STAGE
#undef PG8_LDA
#undef PG8_LDB
#undef PG8_MMA
#undef PG8_WAIT_V
#undef PG8_WAIT_L
#undef PG8_BAR
#undef PG8_SCHED
}
}

constexpr int NWAVES = 8, NTHR = NWAVES * 64;
constexpr int DM = 2048, FF = 5504, FF2 = 2 * FF, NLAT = 8192, NCTX = 512, MT = NLAT + NCTX, TSEQ = 4096, TCTX = 256;
constexpr int PROJ = 14976, PROJP = 15104;
constexpr int P_U = 0, P_V = 1024, P_RKV = 2048, P_G = 5120, P_W = 5376, P_A = 5568, P_QKV = 5760, P_GATE = 8832;
constexpr int P_V2 = 31 * 256, P_GATE2 = 35 * 256;
constexpr int ACTW = 768, LOW = 5120;
constexpr int NLAYER = 2, NMOD = 9;

constexpr size_t MiB = 1u << 20;
constexpr size_t al(size_t x) { return (x + MiB - 1) / MiB * MiB; }
constexpr size_t WS_CTL = 0, CTL_ZERO_BYTES = 1 * MiB;
constexpr size_t WS_MODS = 1 * MiB;
constexpr size_t WS_ROPE = WS_MODS + al((size_t)NLAYER * 3 * NMOD * DM * 4);
constexpr size_t WS_WF1 = WS_ROPE + MiB;
constexpr size_t SZ_WF1 = (size_t)FF2 * DM * 2;
constexpr size_t WS_WF2 = WS_WF1 + al(4 * SZ_WF1);
constexpr size_t SZ_WF2 = (size_t)DM * FF * 2;
constexpr size_t WS_WIN = WS_WF2 + al(4 * SZ_WF2);
constexpr size_t SZ_WIN = (size_t)PROJP * DM * 2;
constexpr size_t WS_WLO = WS_WIN + al(2 * SZ_WIN);
constexpr size_t SZ_WLO = (size_t)LOW * ACTW * 2;
constexpr size_t WS_WBR = WS_WLO + al(2 * SZ_WLO);
constexpr size_t SZ_WBR = (size_t)3 * DM * 1024 * 2;
constexpr size_t WS_WOUT = WS_WBR + al(2 * SZ_WBR);
constexpr size_t SZ_WOUT = (size_t)DM * DM * 2;
constexpr size_t WS_XS = WS_WOUT + al(2 * SZ_WOUT);
constexpr size_t WS_XN = WS_XS + al((size_t)MT * DM * 4);
constexpr size_t WS_P = WS_XN + al((size_t)MT * DM * 2);
constexpr size_t WS_R1 = WS_P + al((size_t)MT * PROJP * 2);
constexpr size_t WS_ACT = WS_R1 + al((size_t)MT * LOW * 4);
constexpr size_t WS_RKVK = WS_ACT + al((size_t)MT * ACTW * 2);
constexpr size_t WS_QK = WS_RKVK + al((size_t)MT * 4096 * 2);
constexpr size_t WS_YS = WS_QK + al((size_t)MT * DM * 2);
constexpr size_t WS_Y3 = WS_YS + al((size_t)2 * MT * 1024 * 4);
constexpr size_t WS_OJ = WS_Y3 + al((size_t)3 * MT * 1024 * 2);
constexpr size_t WS_PART = WS_OJ + al((size_t)2 * MT * 1024 * 4);
constexpr size_t WS_END = WS_PART + al((size_t)16 * NCTX * DM * 4);

constexpr int CW_TMO = 0, CW_CODE = 1, CW_BAR = 4096;

constexpr int RING_BYTES = 131072, LDSCTL_OFF = RING_BYTES, MISC_OFF = LDSCTL_OFF + 320, LDS_BYTES = 147456;

#define GAS __attribute__((address_space(1)))
#define LAS __attribute__((address_space(3)))
typedef unsigned short bf16;
typedef unsigned v4u __attribute__((ext_vector_type(4)));
typedef unsigned v2u __attribute__((ext_vector_type(2)));
typedef float f32x4 __attribute__((ext_vector_type(4)));
typedef short bf16x8 __attribute__((ext_vector_type(8)));
typedef GAS unsigned gu32;
#define RLX_AGENT __ATOMIC_RELAXED, __HIP_MEMORY_SCOPE_AGENT
__device__ __forceinline__ unsigned f2bf(float f) { unsigned u = __builtin_bit_cast(unsigned, f); return (u + 0x7fffu + ((u >> 16) & 1u)) >> 16; }
__device__ __forceinline__ unsigned pk2(float lo, float hi) { return f2bf(lo) | (f2bf(hi) << 16); }
__device__ __forceinline__ float bflo(unsigned w) { return __builtin_bit_cast(float, w << 16); }
__device__ __forceinline__ float bfhi(unsigned w) { return __builtin_bit_cast(float, w & 0xffff0000u); }
__device__ __forceinline__ float bf1(bf16 h) { return __builtin_bit_cast(float, (unsigned)h << 16); }
__device__ __forceinline__ void unpack8(const v4u w, float (&f)[8]) { f[0] = bflo(w.x); f[1] = bfhi(w.x); f[2] = bflo(w.y); f[3] = bfhi(w.y); f[4] = bflo(w.z); f[5] = bfhi(w.z); f[6] = bflo(w.w); f[7] = bfhi(w.w); }
__device__ __forceinline__ v4u pack8(const float (&f)[8]) { v4u w; w.x = pk2(f[0], f[1]); w.y = pk2(f[2], f[3]); w.z = pk2(f[4], f[5]); w.w = pk2(f[6], f[7]); return w; }
__device__ __forceinline__ float fsigm(float x) { return __builtin_amdgcn_rcpf(1.f + __expf(-x)); }
__device__ __forceinline__ float ftanh(float x) { return 1.f - 2.f * __builtin_amdgcn_rcpf(__expf(2.f * x) + 1.f); }
__device__ __forceinline__ float gelu_t(float x) { return 0.5f * x * (1.f + ftanh(0.7978845608f * (x + 0.044715f * x * x * x))); }
__device__ __forceinline__ float wave_sum(float v) {
#pragma unroll
    for (int o = 1; o < 64; o <<= 1) v += __shfl_xor(v, o);
    return v;
}
#define XB_TMO      128
#define XB_XCNT(j)  (256  + 64 * (j))
#define XB_XSUB(j)  (1280 + 64 * (j))
#define XB_XGEN(j)  (2304 + 64 * (j))
#define XB_TOP      3328
#define XB_TOPGEN   3392
#define XCD_BAR_WORDS 3456
#define XB_SPIN_CAP (1u << 18)

__device__ __forceinline__ unsigned xb_ld(unsigned* p)              { return __hip_atomic_load(p, __ATOMIC_RELAXED, __HIP_MEMORY_SCOPE_AGENT); }
__device__ __forceinline__ unsigned xb_add(unsigned* p, unsigned v) { return __hip_atomic_fetch_add(p, v, __ATOMIC_RELAXED, __HIP_MEMORY_SCOPE_AGENT); }
__device__ __forceinline__ unsigned xb_xcc_id() { return (unsigned)__builtin_amdgcn_s_getreg((3 << 11) | 20) & 0xFu; }
#define XB_SPIN(cond, bar) do { unsigned _sp = 0; while (cond) { __builtin_amdgcn_s_sleep(1); \
    if ((++_sp & 255u) == 0u) { if (xb_ld(&(bar)[XB_TMO])) break; if (_sp > XB_SPIN_CAP) { atomicAdd(&(bar)[XB_TMO], 1u); break; } } } } while (0)

struct XcdBarrier {
    unsigned* bar; unsigned x;
    volatile LAS unsigned* st;
};

__device__ __forceinline__ XcdBarrier xcd_barrier_post(unsigned* bar, volatile LAS unsigned* st) {
    XcdBarrier b; b.bar = bar; b.x = xb_xcc_id(); b.st = st;
    if (threadIdx.x == 0) (void)xb_add(&bar[XB_XCNT(b.x)], 1u);
    return b;
}
__device__ __forceinline__ void xcd_barrier_complete(unsigned* bar, unsigned x, unsigned& nloc, unsigned& nx) {
    const unsigned G = gridDim.x * gridDim.y * gridDim.z;
    unsigned sum, cnt, mine, sp = 0u;
    for (;;) {
        sum = 0u; cnt = 0u; mine = 0u;
#pragma unroll
        for (unsigned j = 0; j < 16; ++j) { const unsigned c = xb_ld(&bar[XB_XCNT(j)]); sum += c; cnt += (c > 0u) ? 1u : 0u; mine = (j == x) ? c : mine; }
        if (sum == G) break;
        __builtin_amdgcn_s_sleep(1);
        if ((++sp & 255u) == 0u) { if (xb_ld(&bar[XB_TMO])) break; if (sp > XB_SPIN_CAP) { atomicAdd(&bar[XB_TMO], 1u); break; } }
    }
    nloc = mine > 0u ? mine : 1u; nx = cnt > 0u ? cnt : 1u;
}

__device__ __forceinline__ void xcd_barrier(const XcdBarrier& b) {
    asm volatile("s_waitcnt vmcnt(0)" ::: "memory");
    __syncthreads();
    if (threadIdx.x == 0) {
        unsigned* bar = b.bar;
        __builtin_amdgcn_s_waitcnt(0);
        unsigned nloc = b.st[0], nx = b.st[1];
        if (nloc == 0u) { xcd_barrier_complete(bar, b.x, nloc, nx); b.st[0] = nloc; b.st[1] = nx; }
        const unsigned old = xb_add(&bar[XB_XSUB(b.x)], 1u);
        const unsigned gen = old / nloc;
        if (old + 1u == (gen + 1u) * nloc) {
            __builtin_amdgcn_fence(__ATOMIC_RELEASE, "agent");
            asm volatile("s_waitcnt vmcnt(0)" ::: "memory");
            const unsigned og = xb_add(&bar[XB_TOP], 1u);
            const unsigned tg = og / nx;
            if (og + 1u == (tg + 1u) * nx) xb_add(&bar[XB_TOPGEN], 1u);
            else XB_SPIN(xb_ld(&bar[XB_TOPGEN]) == tg, bar);
            __builtin_amdgcn_fence(__ATOMIC_ACQUIRE, "agent");
            xb_add(&bar[XB_XGEN(b.x)], 1u);
            asm volatile("s_waitcnt vmcnt(0)" ::: "memory");
        } else {
            XB_SPIN(xb_ld(&bar[XB_XGEN(b.x)]) == gen, bar);
            __builtin_amdgcn_fence(__ATOMIC_ACQUIRE, "agent");
            asm volatile("s_waitcnt vmcnt(0)" ::: "memory");
        }
    }
    __syncthreads();
}

struct Args { const float* in[31]; float* out; unsigned char* ws; int ph_lo, ph_hi; };
enum In { I_X = 0, I_C, I_CTX, I_CCTX, I_WADA, I_BADA, I_NORMG, I_FFNIN, I_FFNOUT, I_WIN, I_GMVN, I_GMWS, I_GMBS, I_CONV, I_W0, I_WUP, I_A0, I_AUP, I_GUP, I_KK, I_KA, I_RK, I_LNG, I_LNB,
          I_QN, I_KN, I_LAM, I_SUBLN, I_WBR, I_BGATE, I_WOUT };

__device__ __forceinline__ void ph_ada(const Args& a, int l, LAS unsigned char* lds, int tid, int vcu, int G) {
    LAS float* sc = (LAS float*)lds;
    LAS float* red = sc + 3 * 2048;
    const float* c = a.in[I_C]; const float* cc = a.in[I_CCTX];
    for (int i = tid; i < 3 * 2048; i += NTHR) { const float x = i < 4096 ? c[i] : cc[i - 4096]; sc[i] = x * fsigm(x); }
    __syncthreads();
    const int lane = tid & 63, wave = tid >> 6;
    float* mods = (float*)(a.ws + WS_MODS);
    for (int u = vcu; u < 288; u += G) {
        const int jc = u, j = jc * 64 + lane;
        const float* W = a.in[I_WADA] + (size_t)l * 2048 * 18432 + j;
        float s0 = 0.f, s1 = 0.f, s2 = 0.f;
        const int k0 = wave * 256;
#pragma unroll 16
        for (int k = 0; k < 256; ++k) { const float w = W[(size_t)(k0 + k) * 18432]; s0 += sc[k0 + k] * w; s1 += sc[2048 + k0 + k] * w; s2 += sc[4096 + k0 + k] * w; }
        red[(wave * 3 + 0) * 64 + lane] = s0; red[(wave * 3 + 1) * 64 + lane] = s1; red[(wave * 3 + 2) * 64 + lane] = s2;
        __syncthreads();
        if (wave < 3) { float s = a.in[I_BADA][(size_t)l * 18432 + j];
#pragma unroll
            for (int w8 = 0; w8 < 8; ++w8) s += red[(w8 * 3 + wave) * 64 + lane];
            mods[(size_t)(l * 3 + wave) * 18432 + j] = s; }
        __syncthreads();
    }
}
__device__ __forceinline__ void transpose_item(const float* W, int N, int sc0, bf16* WT, int Kd, int nd0, int k0, LAS float* scr, int lane, bool permq = false) {
    if (sc0 >= 0) {
#pragma unroll
        for (int i = 0; i < 32; ++i) { const int kk = 2 * i + (lane >> 5); scr[kk * 33 + (lane & 31)] = W[(size_t)(k0 + kk) * N + sc0 + (lane & 31)]; }
    } else {
#pragma unroll 8
        for (int i = 0; i < 32; ++i) { const int kk = 2 * i + (lane >> 5); scr[kk * 33 + (lane & 31)] = 0.f; }
    }
    asm volatile("s_waitcnt lgkmcnt(0)" ::: "memory");
    const int c = lane & 7;
#pragma unroll
    for (int j = 0; j < 4; ++j) { const int n = (lane >> 3) + 8 * j;
        const int ns = permq ? (((n & 7) < 4) ? 4 * (n >> 3) + (n & 7) : 16 + 4 * (n >> 3) + (n & 7) - 4) : n;
        const LAS float* s = scr + (8 * c) * 33 + ns;
        v4u o; o.x = pk2(s[0 * 33], s[1 * 33]); o.y = pk2(s[2 * 33], s[3 * 33]); o.z = pk2(s[4 * 33], s[5 * 33]); o.w = pk2(s[6 * 33], s[7 * 33]);
        *(GAS v4u*)(WT + (size_t)(nd0 + n) * Kd + k0 + 8 * c) = o; }
    asm volatile("s_waitcnt lgkmcnt(0)" ::: "memory");
}
__device__ __forceinline__ void ph_weights(const Args& a, int l, LAS unsigned char* lds, int tid, int vcu, int G) {
    const int lane = tid & 63, wave = tid >> 6;
    LAS float* scr = (LAS float*)(lds + wave * 16384);
    const int gw = vcu * NWAVES + wave, NGW = G * NWAVES;
    constexpr int I_F1 = 32 * (FF2 / 32), I_F2 = (FF / 64) * (DM / 32), I_IN = 32 * (PROJP / 32), I_BR = 16 * (DM / 32), I_WO = 32 * (DM / 32);
    constexpr int NITEMS = 2 * I_F1 + 2 * I_F2 + I_IN + 3 * I_BR + I_WO;
    unsigned char* ws = a.ws;
    for (int it = gw; it < NITEMS; it += NGW) {
        int r = it;
        if (r < 2 * I_F1) { const int mi = l * 2 + r / I_F1, q = r % I_F1, nb = q % (FF2 / 32), kb = q / (FF2 / 32), nd0 = 32 * nb, pn = nd0 >> 8, rr = nd0 & 255;
            const int sc0 = rr < 128 ? pn * 128 + rr : FF + pn * 128 + (rr - 128);
            transpose_item(a.in[I_FFNIN] + (size_t)mi * DM * FF2, FF2, sc0, (bf16*)(ws + WS_WF1 + (size_t)mi * SZ_WF1), DM, nd0, 64 * kb, scr, lane); continue; }
        r -= 2 * I_F1;
        if (r < 2 * I_F2) { const int mi = l * 2 + r / I_F2, q = r % I_F2, nb = q % (DM / 32), kb = q / (DM / 32);
            transpose_item(a.in[I_FFNOUT] + (size_t)mi * FF * DM, DM, 32 * nb, (bf16*)(ws + WS_WF2 + (size_t)mi * SZ_WF2), FF, 32 * nb, 64 * kb, scr, lane); continue; }
        r -= 2 * I_F2;
        if (r < I_IN) { const int mi = l, q = r, nb = q % (PROJP / 32), kb = q / (PROJP / 32), nd0 = 32 * nb, T = nd0 >> 8, cc = nd0 & 255;
            int sc0; bool pq = false;
            if (T <= 21) sc0 = nd0;
            else if (T == 22) sc0 = cc < 128 ? nd0 : -1;
            else if (T <= 30) { sc0 = P_QKV + ((T - 23) * 4 + ((cc >> 5) & 3)) * 64 + (cc >> 7) * 32; pq = true; }
            else if (T <= 34) sc0 = P_QKV + 2048 + (nd0 - 31 * 256);
            else sc0 = P_GATE + (nd0 - 35 * 256);
            transpose_item(a.in[I_WIN] + (size_t)mi * DM * PROJ, PROJ, sc0, (bf16*)(ws + WS_WIN + (size_t)mi * SZ_WIN), DM, nd0, 64 * kb, scr, lane, pq); continue; }
        r -= I_IN;
        if (r < 3 * I_BR) { const int mi = l * 3 + r / I_BR, q = r % I_BR, nb = q % (DM / 32), kb = q / (DM / 32);
            transpose_item(a.in[I_WBR] + (size_t)mi * 1024 * DM, DM, 32 * nb, (bf16*)(ws + WS_WBR + (size_t)mi * ((size_t)DM * 1024 * 2)), 1024, 32 * nb, 64 * kb, scr, lane); continue; }
        r -= 3 * I_BR;
        { const int mi = l, q = r, nb = q % (DM / 32), kb = q / (DM / 32);
            transpose_item(a.in[I_WOUT] + (size_t)mi * DM * DM, DM, 32 * nb, (bf16*)(ws + WS_WOUT + (size_t)mi * SZ_WOUT), DM, 32 * nb, 64 * kb, scr, lane); }
    }
}
__device__ __forceinline__ void ph_small(const Args& a, int tid, int vcu, int G) {
    unsigned char* ws = a.ws;
    const int gt = vcu * NTHR + tid, NGT = G * NTHR;
    for (int i = gt; i < NLAYER * LOW * (ACTW / 8); i += NGT) {
        const int l = i / (LOW * (ACTW / 8)), q = i % (LOW * (ACTW / 8)), n = q / (ACTW / 8), k0 = (q % (ACTW / 8)) * 8, sec = n >> 10, cc = n & 1023;
        float f[8];
#pragma unroll
        for (int e = 0; e < 8; ++e) { const int k = k0 + e; float v = 0.f;
            if (sec == 0) { if (k < 256) v = a.in[I_GUP][((size_t)l * 256 + k) * 1024 + cc]; }
            else if (sec <= 2) { const int d = sec - 1, kb = 256 + 128 * d; if (k >= kb && k < kb + 96) v = a.in[I_WUP][((size_t)(l * 2 + d) * 96 + (k - kb)) * 1024 + cc]; }
            else { const int d = sec - 3, kb = 512 + 128 * d; if (k >= kb && k < kb + 96) v = a.in[I_AUP][((size_t)(l * 2 + d) * 96 + (k - kb)) * 1024 + cc]; }
            f[e] = v; }
        *(GAS v4u*)((bf16*)(ws + WS_WLO) + ((size_t)l * LOW + n) * ACTW + k0) = pack8(f);
    }
    for (int i = gt; i < 64 * 16; i += NGT) { const int p = i >> 4, ii = i & 15;
        const float inv = exp2f(-(float)(2 * ii) * (1.f / 32.f) * 13.287712379549449f);
        const float rev = (float)p * inv * 0.15915494309189535f;
        float* rt = (float*)(ws + WS_ROPE) + 2 * i; rt[0] = __builtin_amdgcn_cosf(rev); rt[1] = __builtin_amdgcn_sinf(rev); }
}

__device__ __forceinline__ void norm_row_store(f32x4 (&v)[8], int m, const float* gain, const float* mods, int si, bf16* XN, int lane) {
    float ss = 0.f;
#pragma unroll
    for (int j = 0; j < 8; ++j) ss += (v[j].x * v[j].x + v[j].y * v[j].y) + (v[j].z * v[j].z + v[j].w * v[j].w);
    const float rinv = 1.f / sqrtf(wave_sum(ss) * (1.f / DM) + 1e-6f);
    const int set = m < TSEQ ? 0 : (m < NLAT ? 1 : 2);
    const float* sh = mods + (size_t)(set * NMOD + si) * DM; const float* scl = sh + DM;
#pragma unroll
    for (int j = 0; j < 8; ++j) { const int col = 4 * lane + 256 * j;
        const f32x4 g = *(const GAS f32x4*)(gain + col), s1 = *(const GAS f32x4*)(scl + col), s0 = *(const GAS f32x4*)(sh + col);
        const f32x4 o = (v[j] * rinv * g) * (s1 + 1.f) + s0;
        v2u w; w.x = pk2(o.x, o.y); w.y = pk2(o.z, o.w);
        *(GAS v2u*)(XN + (size_t)m * DM + col) = w; }
}
__device__ __forceinline__ void ph_norm(const float* xl, const float* xc, const float* gain, const float* mods  , int si, bf16* XN, float* xs_out, const bf16* part, int nsplit, int nrows, int gw, int NGW, int lane) {
    for (int m = gw; m < NLAT; m += 2 * NGW) {
        const int m2 = m + NGW; const bool two = m2 < NLAT;
        f32x4 v[8], u[8];
#pragma unroll
        for (int j = 0; j < 8; ++j) v[j] = *(const GAS f32x4*)(xl + (size_t)m * DM + 4 * lane + 256 * j);
        if (two) {
#pragma unroll
            for (int j = 0; j < 8; ++j) u[j] = *(const GAS f32x4*)(xl + (size_t)m2 * DM + 4 * lane + 256 * j); }
        norm_row_store(v, m, gain, mods, si, XN, lane);
        if (two) norm_row_store(u, m2, gain, mods, si, XN, lane);
    }
    if (nrows > NLAT && (gw & 3) == 0) for (int r = gw >> 2; r < NCTX; r += NGW >> 2) {
        const int m = NLAT + r;
        f32x4 v[8];
#pragma unroll
        for (int j = 0; j < 8; ++j) v[j] = *(const GAS f32x4*)(xc + (size_t)r * DM + 4 * lane + 256 * j);
        if (part != nullptr)
#pragma nounroll
        for (int s = 0; s < nsplit; s += 4) {
            v2u p[4][8];
#pragma unroll
            for (int q = 0; q < 4; ++q)
#pragma unroll
                for (int j = 0; j < 8; ++j) p[q][j] = *(const GAS v2u*)(part + ((size_t)(s + q) * NCTX + r) * DM + 4 * lane + 256 * j);
#pragma unroll
            for (int q = 0; q < 4; ++q)
#pragma unroll
                for (int j = 0; j < 8; ++j) { v[j].x += bflo(p[q][j].x); v[j].y += bfhi(p[q][j].x); v[j].z += bflo(p[q][j].y); v[j].w += bfhi(p[q][j].y); } }
#pragma unroll
        for (int j = 0; j < 8; ++j) *(GAS f32x4*)(xs_out + (size_t)m * DM + 4 * lane + 256 * j) = v[j];
        norm_row_store(v, m, gain, mods, si, XN, lane);
    }
}

struct RkvkItem { v4u x[3][3]; int m, c0; bool hp, hn; };
__device__ __forceinline__ void rkvk_load(RkvkItem& it, const bf16* P, int i) {
    const int m = i >> 7, c0 = (i & 127) * 8; it.m = m; it.c0 = c0;
    const int t = m < NLAT ? (m & (TSEQ - 1)) : ((m - NLAT) & (TCTX - 1)), tl = m < NLAT ? TSEQ : TCTX;
    it.hp = t > 0; it.hn = t < tl - 1;
#pragma unroll
    for (int sec = 0; sec < 3; ++sec) { const bf16* pc = P + (size_t)m * PROJP + P_RKV + sec * 1024 + c0;
        it.x[sec][1] = *(const GAS v4u*)pc;
        it.x[sec][0] = it.hp ? *(const GAS v4u*)(pc - PROJP) : (v4u){0u, 0u, 0u, 0u};
        it.x[sec][2] = it.hn ? *(const GAS v4u*)(pc + PROJP) : (v4u){0u, 0u, 0u, 0u}; }
}
__device__ __forceinline__ void rkvk_finish(const RkvkItem& it, bf16* RK, const float* cw, const float* kkw) {
    const int c0 = it.c0; float rkv[3][8];
#pragma unroll
    for (int sec = 0; sec < 3; ++sec) { const int col = sec * 1024 + c0; float x0[8], x1[8], x2[8];
        unpack8(it.x[sec][0], x0); unpack8(it.x[sec][1], x1); unpack8(it.x[sec][2], x2);
#pragma unroll
        for (int e = 0; e < 8; ++e) rkv[sec][e] = x1[e] * cw[3072 + col + e] + x0[e] * cw[col + e] + x2[e] * cw[2 * 3072 + col + e]; }
    float kk8[8]; float ss = 0.f;
#pragma unroll
    for (int e = 0; e < 8; ++e) { kk8[e] = rkv[1][e] * kkw[c0 + e]; ss += kk8[e] * kk8[e]; }
    ss += __shfl_xor(ss, 1); ss += __shfl_xor(ss, 2); ss += __shfl_xor(ss, 4);
    const float rinv = 1.f / sqrtf(ss + 1e-12f);
    GAS v4u* dst = (GAS v4u*)(RK + (size_t)it.m * 4096 + c0 * 4);
#pragma unroll
    for (int j = 0; j < 4; ++j) { v4u o; o.x = pk2(rkv[0][2 * j], rkv[1][2 * j]); o.y = pk2(rkv[2][2 * j], kk8[2 * j] * rinv); o.z = pk2(rkv[0][2 * j + 1], rkv[1][2 * j + 1]); o.w = pk2(rkv[2][2 * j + 1], kk8[2 * j + 1] * rinv); dst[j] = o; }
}
__device__ __forceinline__ void ph_e1(const Args& a, int l, int gt, int NGT) {
    const bf16* P = (const bf16*)(a.ws + WS_P); bf16* RK = (bf16*)(a.ws + WS_RKVK);
    const float* cw = a.in[I_CONV] + (size_t)l * 3 * 3072; const float* kkw = a.in[I_KK] + l * 1024;
    constexpr int NI = MT * 128;
    for (int i = gt; i < NI; i += 2 * NGT) {
        RkvkItem A, B; const bool two = i + NGT < NI;
        rkvk_load(A, P, i); if (two) rkvk_load(B, P, i + NGT);
        rkvk_finish(A, RK, cw, kkw); if (two) rkvk_finish(B, RK, cw, kkw);
    }
}

__device__ __forceinline__ void ph_gmlp(const Args& a, int l, LAS unsigned char* lds, int tid, int vcu, int G) {
    constexpr int VP = 136;
    LAS bf16* vnT = (LAS bf16*)lds;
    const bf16* P = (const bf16*)(a.ws + WS_P); bf16* YA = (bf16*)(a.ws + WS_Y3);
    const float* vng = a.in[I_GMVN] + l * 1024; const float* wsm = a.in[I_GMWS] + (size_t)l * 8 * 128 * 128; const float* bs = a.in[I_GMBS] + l * 8 * 128;
    const int lane = tid & 63, w = tid >> 6, fr = lane & 15, fq = lane >> 4;
    for (int u = vcu; u < (MT / 128) * 8; u += G) {
        const int n = u >> 3, g = u & 7, m0 = n * 128;
        { const int q = tid >> 2, qt = tid & 3; const bf16* src = P + (size_t)(m0 + q) * PROJP + P_V + g * 128 + qt * 32;
            float v[32]; float ss = 0.f;
#pragma unroll
            for (int j = 0; j < 4; ++j) { float f[8]; unpack8(*(const GAS v4u*)(src + 8 * j), f);
#pragma unroll
                for (int e = 0; e < 8; ++e) { const float x = f[e]; v[8 * j + e] = x; ss += x * x; } }
            ss += __shfl_xor(ss, 1); ss += __shfl_xor(ss, 2);
            const float rinv = 1.f / sqrtf(ss * (1.f / 128.f) + 1e-6f);
#pragma unroll
            for (int e = 0; e < 32; ++e) { const int c = qt * 32 + e; vnT[c * VP + q] = (bf16)f2bf(v[e] * rinv * vng[g * 128 + c]); } }
        __syncthreads();
        pg8::f32x4 acc[8];
#pragma unroll
        for (int cb = 0; cb < 8; ++cb) acc[cb] = (pg8::f32x4){0.f, 0.f, 0.f, 0.f};
#pragma unroll
        for (int ks = 0; ks < 4; ++ks) {
            const float* wr = wsm + ((size_t)g * 128 + 16 * w + fr) * 128 + ks * 32 + 8 * fq;
            const f32x4 w0 = *(const GAS f32x4*)wr, w1 = *(const GAS f32x4*)(wr + 4);
            v4u aw; aw.x = pk2(w0.x, w0.y); aw.y = pk2(w0.z, w0.w); aw.z = pk2(w1.x, w1.y); aw.w = pk2(w1.z, w1.w);
            const bf16x8 af = __builtin_bit_cast(bf16x8, aw);
#pragma unroll
            for (int cb = 0; cb < 8; ++cb) { const bf16x8 bfr = *(const LAS bf16x8*)(vnT + (cb * 16 + fr) * VP + ks * 32 + 8 * fq);
                acc[cb] = __builtin_amdgcn_mfma_f32_16x16x32_bf16(af, bfr, acc[cb], 0, 0, 0); }
        }
#pragma unroll
        for (int cb = 0; cb < 8; ++cb)
#pragma unroll
            for (int i = 0; i < 4; ++i) { const int p = 16 * w + 4 * fq + i, c = cb * 16 + fr;
                const float pu = bf1(P[(size_t)(m0 + p) * PROJP + P_U + g * 128 + c]);
                YA[(size_t)(m0 + p) * 1024 + g * 128 + c] = (bf16)f2bf(pu * (acc[cb][i] + bs[g * 128 + p])); }
        __syncthreads();
    }
}

namespace att {
using bf16x8 = __attribute__((ext_vector_type(8))) short;
using s16x4  = __attribute__((ext_vector_type(4))) short;
using f32x16 = __attribute__((ext_vector_type(16))) float;
using u32x4  = __attribute__((ext_vector_type(4))) unsigned;
constexpr int NW = 8, QBLK = 32, KVBLK = 64;
constexpr float THRL = 11.5f;
constexpr int SHM_V = KVBLK * 128 * 2, SHM_K = KVBLK * 64 * 2, SHM_ATTN = 2 * SHM_V + 2 * SHM_K + NW * 64 * 4;
#define KSWZ(row, colB) ((row) * 128 + ((colB) ^ ((((row) >> 1) & 7) << 4)))
#define SBAR() __builtin_amdgcn_sched_barrier(0)
__device__ __forceinline__ int crow(int r, int hi) { return (r & 3) + 8 * (r >> 2) + 4 * hi; }
__device__ __forceinline__ unsigned cvtpk(float lo, float hi) { unsigned r; asm volatile("v_cvt_pk_bf16_f32 %0, %1, %2" : "=v"(r) : "v"(lo), "v"(hi)); return r; }
__device__ __forceinline__ void partialSM(f32x16& p0, f32x16& p1, float& m_reg, float& mn, float& alpha) {
  float pmax = p0[0];
#pragma unroll
  for (int r = 1; r < 16; ++r) pmax = fmaxf(pmax, p0[r]);
#pragma unroll
  for (int r = 0; r < 16; ++r) pmax = fmaxf(pmax, p1[r]);
  { auto rr = __builtin_amdgcn_permlane32_swap(__float_as_uint(pmax), __float_as_uint(pmax), false, false);
    pmax = fmaxf(__uint_as_float(rr[0]), __uint_as_float(rr[1])); }
  if (__builtin_expect(__all(pmax - m_reg <= THRL), 1)) { mn = m_reg; alpha = 1.f; }
  else { mn = fmaxf(m_reg, pmax); alpha = __builtin_amdgcn_exp2f(m_reg - mn); m_reg = mn; }
#pragma unroll
  for (int r = 0; r < 16; ++r) p0[r] = p0[r] - mn;
#pragma unroll
  for (int r = 0; r < 16; ++r) p1[r] = p1[r] - mn;
#pragma unroll
  for (int r = 0; r < 16; ++r) p0[r] = __builtin_amdgcn_exp2f(p0[r]);
}
__device__ __forceinline__ void finishSM(f32x16& p0, f32x16& p1, float alpha, float& l_reg, bf16x8& pa0, bf16x8& pa1, bf16x8& pa2, bf16x8& pa3) {
#pragma unroll
  for (int r = 0; r < 16; ++r) p1[r] = __builtin_amdgcn_exp2f(p1[r]);
  float ps = 0;
#pragma unroll
  for (int r = 0; r < 16; ++r) ps += p0[r];
#pragma unroll
  for (int r = 0; r < 16; ++r) ps += p1[r];
  { auto rr = __builtin_amdgcn_permlane32_swap(__float_as_uint(ps), __float_as_uint(ps), false, false);
    ps = __uint_as_float(rr[0]) + __uint_as_float(rr[1]); }
  l_reg = l_reg * alpha + ps;
#define PK4(P, BASE, OUT) do { unsigned a0 = cvtpk(P[BASE + 0], P[BASE + 1]), a1 = cvtpk(P[BASE + 2], P[BASE + 3]);   \
    unsigned b0 = cvtpk(P[BASE + 4], P[BASE + 5]), b1 = cvtpk(P[BASE + 6], P[BASE + 7]);                              \
    auto r0 = __builtin_amdgcn_permlane32_swap(a0, b0, false, false); auto r1 = __builtin_amdgcn_permlane32_swap(a1, b1, false, false); \
    u32x4 w = {r0[0], r1[0], r0[1], r1[1]}; OUT = *reinterpret_cast<bf16x8*>(&w); } while (0)
  PK4(p0, 0, pa0); PK4(p0, 8, pa1); PK4(p1, 0, pa2); PK4(p1, 8, pa3);
#undef PK4
}
__device__ __forceinline__ void qkt(f32x16& p0, f32x16& p1, const unsigned short* Ks, const bf16x8* qr, int r32, int hi) {
  p0 = f32x16{}; p1 = f32x16{};
#pragma unroll
  for (int d0 = 0; d0 < 4; ++d0) { int cb = (d0 * 16 + hi * 8) * 2;
    bf16x8 b0 = *reinterpret_cast<const bf16x8*>((const char*)Ks + KSWZ(r32, cb));
    bf16x8 b1 = *reinterpret_cast<const bf16x8*>((const char*)Ks + KSWZ(32 + r32, cb));
    p0 = __builtin_amdgcn_mfma_f32_32x32x16_bf16(b0, qr[d0], p0, 0, 0, 0);
    p1 = __builtin_amdgcn_mfma_f32_32x32x16_bf16(b1, qr[d0], p1, 0, 0, 0); }
}
__device__ __forceinline__ int v_st(int k, int c) { const int kk = (k & ~0xC) | ((k & 4) << 1) | ((k & 8) >> 1); return ((kk >> 3) * 4 + (c >> 5)) * 512 + ((kk & 7) * 32 + (c & 31)) * 2; }
__device__ __forceinline__ int v_rd_base(int lane) { return ((lane & 3) << 3) | (((lane >> 2) & 3) << 6) | (((lane >> 4) & 1) << 5) | (((lane >> 5) & 1) << 8); }
constexpr int v_rd_off(int d0, int ks, int half) { return d0 * 512 + ks * 4096 + half * 2048; }
template <int OFF> __device__ __forceinline__ s16x4 tr_read(int vb) {
  s16x4 r; asm volatile("ds_read_b64_tr_b16 %0, %1 offset:%2" : "=&v"(r) : "v"(vb), "i"(OFF) : "memory"); return r;
}
template <int D0> __device__ __forceinline__ void pv_one(f32x16& od, int vb, bf16x8 pa0, bf16x8 pa1, bf16x8 pa2, bf16x8 pa3) {
  const s16x4 l0 = tr_read<v_rd_off(D0, 0, 0)>(vb), h0 = tr_read<v_rd_off(D0, 0, 1)>(vb), l1 = tr_read<v_rd_off(D0, 1, 0)>(vb), h1 = tr_read<v_rd_off(D0, 1, 1)>(vb);
  const s16x4 l2 = tr_read<v_rd_off(D0, 2, 0)>(vb), h2 = tr_read<v_rd_off(D0, 2, 1)>(vb), l3 = tr_read<v_rd_off(D0, 3, 0)>(vb), h3 = tr_read<v_rd_off(D0, 3, 1)>(vb);
  asm volatile("s_waitcnt lgkmcnt(0)" ::: "memory"); SBAR();
#define PK(L, H) (bf16x8){L[0], L[1], L[2], L[3], H[0], H[1], H[2], H[3]}
  od = __builtin_amdgcn_mfma_f32_32x32x16_bf16(pa0, PK(l0, h0), od, 0, 0, 0);
  od = __builtin_amdgcn_mfma_f32_32x32x16_bf16(pa1, PK(l1, h1), od, 0, 0, 0);
  od = __builtin_amdgcn_mfma_f32_32x32x16_bf16(pa2, PK(l2, h2), od, 0, 0, 0);
  od = __builtin_amdgcn_mfma_f32_32x32x16_bf16(pa3, PK(l3, h3), od, 0, 0, 0);
#undef PK
}
__device__ __forceinline__ void pv_d0(f32x16* o, int vb, bf16x8 pa0, bf16x8 pa1, bf16x8 pa2, bf16x8 pa3) {
  pv_one<0>(o[0], vb, pa0, pa1, pa2, pa3); pv_one<1>(o[1], vb, pa0, pa1, pa2, pa3); pv_one<2>(o[2], vb, pa0, pa1, pa2, pa3); pv_one<3>(o[3], vb, pa0, pa1, pa2, pa3);
}
__device__ __forceinline__ void attn_unit(const unsigned short* __restrict__ Qb, const unsigned short* __restrict__ Kb, const unsigned short* __restrict__ Vb,
                                          unsigned short* __restrict__ Ob, int NT, int ntl, int klat, int kctx, char* lds) {
  constexpr int LDQ = 2048, LDKK = 2048, LDV = 15104, LDO = 1024;
  const int tid = threadIdx.x, wid = tid >> 6, lane = tid & 63, r32 = lane & 31, hi = lane >> 5;
  unsigned short* V_lds = (unsigned short*)lds; unsigned short* K_lds = (unsigned short*)(lds + 2 * SHM_V);
  float* ws = (float*)(lds + 2 * SHM_V + 2 * SHM_K) + wid * 64; float* li_l = ws; float* al_l = ws + 32;
  float m_reg = -1e30f, l_reg = 0; f32x16 o[4] = {}; bf16x8 qr[4];
  const unsigned short* Qw = Qb + (long)(wid * QBLK + r32) * LDQ + hi * 8;
#pragma unroll
  for (int d0 = 0; d0 < 4; ++d0) qr[d0] = *reinterpret_cast<const bf16x8*>(Qw + d0 * 16);
  const int sr = tid >> 4, sc = (tid & 15) * 8, vst0 = v_st(sr, sc), vst1 = v_st(32 + sr, sc);
  const int kr = tid >> 3, kc = (tid & 7) * 8, kst = KSWZ(kr, kc * 2);
  const int vb0 = (int)(uintptr_t)V_lds + v_rd_base(lane);
  struct { bf16x8 vs0, vs1, ks0; } sr_[2];
#define KROW(t) ((t) < ntl ? klat + 64 * (t) : kctx + 64 * ((t) - ntl))
#define SLOAD(i, t) do { const long k0_ = KROW(t); sr_[i].vs0 = *reinterpret_cast<const bf16x8*>(&Vb[(k0_ + sr) * LDV + sc]); sr_[i].vs1 = *reinterpret_cast<const bf16x8*>(&Vb[(k0_ + 32 + sr) * LDV + sc]); \
    sr_[i].ks0 = *reinterpret_cast<const bf16x8*>(&Kb[(k0_ + kr) * LDKK + kc]); } while (0)
#define SWRITE(b, i) do { *(bf16x8*)((char*)V_lds + (b) * SHM_V + vst0) = sr_[i].vs0; *(bf16x8*)((char*)V_lds + (b) * SHM_V + vst1) = sr_[i].vs1; \
    *(bf16x8*)((char*)K_lds + (b) * SHM_K + kst) = sr_[i].ks0; } while (0)
#define SWAIT() asm volatile("s_waitcnt vmcnt(3)" ::: "memory")
#define RESC(a) do { if (__any((a) < 1.f)) { if (hi == 0) al_l[r32] = (a); asm volatile("s_waitcnt lgkmcnt(0)" ::: "memory"); \
    _Pragma("unroll") for (int d = 0; d < 4; ++d) _Pragma("unroll") for (int r = 0; r < 16; ++r) o[d][r] *= al_l[crow(r, hi)]; } } while (0)
  f32x16 pA0, pA1, pB0, pB1; float mnA, mnB, alA, alB; bf16x8 pa0, pa1, pa2, pa3;
  constexpr int SE = 0, SO = 1;
  SLOAD(SE, 0); asm volatile("s_waitcnt vmcnt(0)" ::: "memory"); SWRITE(0, SE); __syncthreads();
  qkt(pA0, pA1, K_lds, qr, r32, hi); partialSM(pA0, pA1, m_reg, mnA, alA);
  SLOAD(SO, 1); if (2 < NT) SLOAD(SE, 2);
  SWAIT(); SWRITE(1, SO); __syncthreads();
  for (int j = 1; j + 1 < NT; j += 2) {
    SBAR(); qkt(pB0, pB1, (const unsigned short*)((char*)K_lds + SHM_K), qr, r32, hi);
    finishSM(pA0, pA1, alA, l_reg, pa0, pa1, pa2, pa3); SBAR();
    SLOAD(SO, j + 2); SBAR();
    pv_d0(o, vb0, pa0, pa1, pa2, pa3); partialSM(pB0, pB1, m_reg, mnB, alB);
    __syncthreads(); SWAIT(); SWRITE(0, SE);
    RESC(alB); __syncthreads();
    SBAR(); qkt(pA0, pA1, K_lds, qr, r32, hi);
    finishSM(pB0, pB1, alB, l_reg, pa0, pa1, pa2, pa3); SBAR();
    if (j + 3 < NT) SLOAD(SE, j + 3); SBAR();
    pv_d0(o, vb0 + (int)SHM_V, pa0, pa1, pa2, pa3); partialSM(pA0, pA1, m_reg, mnA, alA);
    __syncthreads(); SWAIT(); SWRITE(1, SO);
    RESC(alA); __syncthreads();
  }
  SBAR(); qkt(pB0, pB1, (const unsigned short*)((char*)K_lds + SHM_K), qr, r32, hi);
  finishSM(pA0, pA1, alA, l_reg, pa0, pa1, pa2, pa3); SBAR();
  pv_d0(o, vb0, pa0, pa1, pa2, pa3); partialSM(pB0, pB1, m_reg, mnB, alB);
  __syncthreads(); RESC(alB);
  finishSM(pB0, pB1, alB, l_reg, pa0, pa1, pa2, pa3); SBAR();
  pv_d0(o, vb0 + (int)SHM_V, pa0, pa1, pa2, pa3);
  if (hi == 0) li_l[r32] = l_reg; asm volatile("s_waitcnt lgkmcnt(0)" ::: "memory");
  float rli[16];
#pragma unroll
  for (int r = 0; r < 16; ++r) rli[r] = __builtin_amdgcn_rcpf(li_l[crow(r, hi)]);
  unsigned short* Ow = Ob + (long)(wid * QBLK) * LDO;
#pragma unroll
  for (int r = 0; r < 16; ++r) { int orow = crow(r, hi);
#pragma unroll
    for (int d0 = 0; d0 < 4; ++d0) Ow[(long)orow * LDO + d0 * 32 + r32] = (unsigned short)(cvtpk(o[d0][r] * rli[r], 0.f) & 0xffffu); }
  __syncthreads();
#undef KROW
#undef SLOAD
#undef SWRITE
#undef SWAIT
#undef RESC
}
#undef KSWZ
#undef SBAR
}

__device__ __forceinline__ void ph_attn(const Args& a, bool ctx_out, char* lds, int widx, int wstride) {
    const unsigned short* QK = (const unsigned short*)(a.ws + WS_QK); const unsigned short* P = (const unsigned short*)(a.ws + WS_P); unsigned short* OJ = (unsigned short*)(a.ws + WS_OJ);
    const int nunits = ctx_out ? 544 : 512;
    for (int u = widx; u < nunits; u += wstride) {
        int b, hj, qrow0, NT, ntl;
        if (u < 512) { b = u >> 8; hj = (u >> 4) & 15; qrow0 = b * TSEQ + (u & 15) * 256; NT = 68; ntl = 64; }
        else { const int uu = u - 512; b = uu >> 4; hj = uu & 15; qrow0 = NLAT + b * TCTX; NT = 4; ntl = 0; }
        att::attn_unit(QK + (size_t)qrow0 * DM + hj * 64, QK + 1024 + hj * 64, P + P_V2 + (hj >> 1) * 128,
                       OJ + ((size_t)(hj & 1) * MT + qrow0) * 1024 + (hj >> 1) * 128, NT, ntl, b * TSEQ, NLAT + b * TCTX, lds);
    }
}

constexpr int SC_STEP = 768, SC_BLK = 32, SC_BUF = SC_BLK * SC_STEP + 256, SC_Y = 2 * SC_BUF, SC_LDS = SC_Y + 2 * SC_BLK * 64 * 4 + 256;
__device__ __forceinline__ int scan_row(int i, int b, int d) { return i < TCTX ? NLAT + b * TCTX + (d ? TCTX - 1 - i : i) : b * TSEQ + (d ? TSEQ - 1 - (i - TCTX) : (i - TCTX)); }
typedef __amdgpu_buffer_rsrc_t rsrc_t;
typedef short s16x4 __attribute__((ext_vector_type(4)));
typedef __bf16 bf16x2_t __attribute__((ext_vector_type(2)));
typedef float f32x2_t __attribute__((ext_vector_type(2)));
__device__ __forceinline__ unsigned cvtpk_c(float lo, float hi) { f32x2_t v = {lo, hi}; bf16x2_t b = __builtin_convertvector(v, bf16x2_t); return __builtin_bit_cast(unsigned, b); }
__device__ __forceinline__ void scan_fill(rsrc_t LOr, rsrc_t RKr, float kav, LAS unsigned char* buf, int blk, int b, int h, int d, int hw, int lane) {
    const int i0 = blk * SC_BLK, m0 = scan_row(i0, b, d), dir = d ? -1 : 1;
    const int lo0 = (m0 * LOW + 1024 + d * 1024 + h * 64) * 2, lostep = dir * LOW * 2;
    const int rk0 = (m0 * 16 + h) * 512, rkstep = dir * 8192;
    const int inext = i0 + 8 * hw + 8, mn = inext < TCTX + TSEQ ? scan_row(inext, b, d) : m0;
    const int pp = (((lane >> 5) * 4 + ((lane >> 2) & 3)) * 8 + 4 * ((lane >> 4) & 1) + (lane & 3)) * 2;
    float wv[SC_BLK], av[8]; v2u rec[9];
#pragma unroll
    for (int st = 0; st < SC_BLK; ++st) wv[st] = bf1((bf16)__builtin_amdgcn_raw_buffer_load_b16(LOr, lane * 2, lo0 + st * lostep, 0));
#pragma unroll
    for (int q = 0; q < 8; ++q) { av[q] = bf1((bf16)__builtin_amdgcn_raw_buffer_load_b16(LOr, lane * 2, lo0 + 4096 + (8 * hw + q) * lostep, 0));
        rec[q] = __builtin_amdgcn_raw_buffer_load_b64(RKr, lane * 8, rk0 + (8 * hw + q) * rkstep, 0); }
    rec[8] = __builtin_amdgcn_raw_buffer_load_b64(RKr, lane * 8, (mn * 16 + h) * 512, 0);
    asm volatile("" ::: "memory");
#pragma unroll
    for (int st = 0; st < SC_BLK; ++st) wv[st] = __builtin_amdgcn_exp2f(-wv[st]);
    float g = 1.f;
#pragma unroll
    for (int st = 0; st < SC_BLK; ++st) { if (st < 8 * hw) g *= wv[st]; }
    float gl = 1.f;
#pragma unroll
    for (int st = 0; st < SC_BLK; ++st) gl *= wv[st];
#pragma unroll
    for (int q = 0; q < 8; ++q) {
        const float wq = hw == 0 ? wv[q] : (hw == 1 ? wv[8 + q] : (hw == 2 ? wv[16 + q] : wv[24 + q]));
        g *= wq;
        const float ig = __builtin_amdgcn_rcpf(g);
        const float rv = bflo(rec[q].x), kv = bfhi(rec[q].x), vv = bflo(rec[q].y), kkv = bfhi(rec[q].y), kkn = bfhi(rec[q + 1].y);
        LAS unsigned char* o = buf + (8 * hw + q) * SC_STEP;
        ((LAS unsigned*)o)[lane] = pg8::cvt_pk_bf16(kv * (1.f + (av[q] - 1.f) * kav) * ig, -(kkv * av[q] * ig));
        *(LAS bf16*)(o + 256 + pp) = (bf16)f2bf(kkn * g); *(LAS bf16*)(o + 384 + pp) = (bf16)f2bf(rv * g);
        ((LAS float*)(o + 512))[lane] = vv;
    }
    if (hw == 0) ((LAS float*)(buf + SC_BLK * SC_STEP))[lane] = gl;
}
__device__ __forceinline__ void scan_unit(const Args& a, int l, int u, LAS unsigned char* lds, int tid) {
    const rsrc_t LOr = __builtin_amdgcn_make_buffer_rsrc((void*)(a.ws + WS_R1), 0, MT * LOW * 2, 0x00020000);
    const rsrc_t RKr = __builtin_amdgcn_make_buffer_rsrc((void*)(a.ws + WS_RKVK), 0, MT * 4096 * 2, 0x00020000);
    const rsrc_t YSr = __builtin_amdgcn_make_buffer_rsrc((void*)(a.ws + WS_YS), 0, 2 * MT * 1024 * 2, 0x00020000);
    const int lane = tid & 63, w = __builtin_amdgcn_readfirstlane(tid >> 6), fr = lane & 15, fq = lane >> 4;
    const int b = u >> 5, h = (u >> 1) & 15, d = u & 1;
    const float kav = a.in[I_KA][l * 1024 + h * 64 + lane];
    constexpr int NBLK = (TCTX + TSEQ) / SC_BLK;
    pg8::f32x4 S0 = (pg8::f32x4){0.f, 0.f, 0.f, 0.f}, S1 = S0, S2 = S0, S3 = S0, acc0 = S0, acc1 = S0;
    const unsigned mk0 = fq == 0 ? 0xffffffffu : 0u, mk1 = fq == 1 ? 0xffffffffu : 0u, mk2 = fq == 2 ? 0xffffffffu : 0u, mk3 = fq == 3 ? 0xffffffffu : 0u;
    if (w >= 4) scan_fill(LOr, RKr, kav, lds, 0, b, h, d, w - 4, lane);
    __syncthreads();
    for (int blk = 0; blk < NBLK; ++blk) {
        LAS unsigned char* buf = lds + (blk & 1) * SC_BUF;
        LAS float* yb = (LAS float*)(lds + SC_Y) + (blk & 1) * SC_BLK * 64;
        if (w < 4) {
            const int aoff = 256 + ((fr & 2) ? 128 : 0) + 16 * fq;
            int yoff = 2 * SC_BLK * 64 - (blk & 1) * SC_BLK * 64 + lane;
            unsigned Ua, Ub_; float va, vb_; bf16x8 A0a, A1a, A0b_, A1b_;
#define SC_LOAD(S, st_) do { LAS unsigned char* nb_ = buf + (st_) * SC_STEP; U##S = ((LAS unsigned*)nb_)[lane]; v##S = ((LAS float*)(nb_ + 512))[16 * w + fr]; \
        A0##S = *(const LAS bf16x8*)(nb_ + aoff); A1##S = *(const LAS bf16x8*)(nb_ + aoff + 64); } while (0)
#define SC_DO(S, st_) do { \
        const float sa_ = acc0[0] + acc1[0]; yb[yoff] = acc0[2] + acc1[2]; yoff = (st_) * 64 + 16 * w + fr; \
        const unsigned p_ = cvtpk_c(v##S, sa_); \
        const s16x4 ua_ = __builtin_bit_cast(s16x4, (v2u){U##S, 0u}); \
        S0 = __builtin_amdgcn_mfma_f32_16x16x16bf16_1k(ua_, __builtin_bit_cast(s16x4, (v2u){p_ & mk0, 0u}), S0, 0, 0, 0); \
        S1 = __builtin_amdgcn_mfma_f32_16x16x16bf16_1k(ua_, __builtin_bit_cast(s16x4, (v2u){p_ & mk1, 0u}), S1, 0, 0, 0); \
        S2 = __builtin_amdgcn_mfma_f32_16x16x16bf16_1k(ua_, __builtin_bit_cast(s16x4, (v2u){p_ & mk2, 0u}), S2, 0, 0, 0); \
        S3 = __builtin_amdgcn_mfma_f32_16x16x16bf16_1k(ua_, __builtin_bit_cast(s16x4, (v2u){p_ & mk3, 0u}), S3, 0, 0, 0); \
        v4u p0_, p1_; \
        p0_.x = cvtpk_c(S0[0], S0[1]); p0_.y = cvtpk_c(S0[2], S0[3]); p0_.z = cvtpk_c(S1[0], S1[1]); p0_.w = cvtpk_c(S1[2], S1[3]); \
        p1_.x = cvtpk_c(S2[0], S2[1]); p1_.y = cvtpk_c(S2[2], S2[3]); p1_.z = cvtpk_c(S3[0], S3[1]); p1_.w = cvtpk_c(S3[2], S3[3]); \
        acc0 = __builtin_amdgcn_mfma_f32_16x16x32_bf16(A0##S, __builtin_bit_cast(bf16x8, p0_), (pg8::f32x4){0.f, 0.f, 0.f, 0.f}, 0, 0, 0); \
        acc1 = __builtin_amdgcn_mfma_f32_16x16x32_bf16(A1##S, __builtin_bit_cast(bf16x8, p1_), (pg8::f32x4){0.f, 0.f, 0.f, 0.f}, 0, 0, 0); } while (0)
            SC_LOAD(a, 0);
            for (int st = 0; st < SC_BLK; st += 2) {
                SC_LOAD(b_, st + 1);
                SC_DO(a, st);
                if (st + 2 < SC_BLK) SC_LOAD(a, st + 2);
                SC_DO(b_, st + 1);
            }
#undef SC_LOAD
#undef SC_DO
            { const LAS float* G = (const LAS float*)(buf + SC_BLK * SC_STEP) + 4 * fq;
              S0 = S0 * *(const LAS pg8::f32x4*)(G); S1 = S1 * *(const LAS pg8::f32x4*)(G + 16); S2 = S2 * *(const LAS pg8::f32x4*)(G + 32); S3 = S3 * *(const LAS pg8::f32x4*)(G + 48); }
            yb[yoff] = acc0[2] + acc1[2];
        } else {
            const int hw = w - 4;
            if (blk > 0) { const LAS float* ypb = (const LAS float*)(lds + SC_Y) + ((blk - 1) & 1) * SC_BLK * 64;
                const int mp = scan_row((blk - 1) * SC_BLK, b, d), y0 = ((d * MT + mp) * 1024 + h * 64) * 2, ystep = (d ? -1 : 1) * 2048;
#pragma unroll
                for (int q = 0; q < 8; ++q) __builtin_amdgcn_raw_buffer_store_b16((unsigned short)f2bf(ypb[(8 * hw + q) * 64 + lane]), YSr, lane * 2, y0 + (8 * hw + q) * ystep, 0); }
            if (blk + 1 < NBLK) scan_fill(LOr, RKr, kav, lds + ((blk + 1) & 1) * SC_BUF, blk + 1, b, h, d, hw, lane);
        }
        __syncthreads();
    }
    if (w >= 4) { const int hw = w - 4; const LAS float* ypb = (const LAS float*)(lds + SC_Y) + ((NBLK - 1) & 1) * SC_BLK * 64;
        const int mp = scan_row((NBLK - 1) * SC_BLK, b, d), y0 = ((d * MT + mp) * 1024 + h * 64) * 2, ystep = (d ? -1 : 1) * 2048;
#pragma unroll
        for (int q = 0; q < 8; ++q) __builtin_amdgcn_raw_buffer_store_b16((unsigned short)f2bf(ypb[(8 * hw + q) * 64 + lane]), YSr, lane * 2, y0 + (8 * hw + q) * ystep, 0); }
    __syncthreads();
}

__device__ __forceinline__ void ph_rwkv_out(const Args& a, int l, int nrows, int gt, int NGT) {
    const bf16* OJ = (const bf16*)(a.ws + WS_OJ); bf16* YC = (bf16*)(a.ws + WS_Y3) + (size_t)2 * MT * 1024;
    const float* subln = a.in[I_SUBLN] + l * 128;
    float lam, lam_init;
    { const int lane = threadIdx.x & 63; const float* lv = a.in[I_LAM] + l * 256;
      float l1 = lv[lane] * lv[64 + lane], l2 = lv[128 + lane] * lv[192 + lane]; l1 = wave_sum(l1); l2 = wave_sum(l2);
      lam_init = 0.8f - 0.6f * __expf(-0.3f * (float)l); lam = __expf(l1) - __expf(l2) + lam_init; }
    const bf16* LO = (const bf16*)(a.ws + WS_R1); const bf16* RK = (const bf16*)(a.ws + WS_RKVK); const bf16* YS = (const bf16*)(a.ws + WS_YS);
    bf16* YB = (bf16*)(a.ws + WS_Y3) + (size_t)MT * 1024;
    const float* ka = a.in[I_KA] + l * 1024; const float* rkw = a.in[I_RK] + l * 1024; const float* lng = a.in[I_LNG] + l * 1024; const float* lnb = a.in[I_LNB] + l * 1024;
    for (int i = gt; i < nrows * 128; i += NGT) {
        const int m = i >> 7, c0 = (i & 127) * 8;
        const v4u ya = *(const GAS v4u*)(YS + (size_t)m * 1024 + c0), yb = *(const GAS v4u*)(YS + ((size_t)MT + m) * 1024 + c0);
        const GAS v4u* rp = (const GAS v4u*)(RK + (size_t)m * 4096 + c0 * 4);
        const v4u q0 = rp[0], q1 = rp[1], q2 = rp[2], q3 = rp[3];
        const bf16* lo = LO + (size_t)m * LOW + c0;
        const v4u gw_ = *(const GAS v4u*)lo, aw0 = *(const GAS v4u*)(lo + 3072), aw1 = *(const GAS v4u*)(lo + 4096);
        const v4u pw = *(const GAS v4u*)(OJ + (size_t)m * 1024 + c0), ow = *(const GAS v4u*)(OJ + ((size_t)MT + m) * 1024 + c0);
        float yA[8], yB[8], gv[8], a0v[8], a1v[8], pv[8], ov[8];
        unpack8(ya, yA); unpack8(yb, yB); unpack8(gw_, gv); unpack8(aw0, a0v); unpack8(aw1, a1v); unpack8(pw, pv); unpack8(ow, ov);
        float y[8]; float s1 = 0.f;
#pragma unroll
        for (int e = 0; e < 8; ++e) y[e] = yA[e] + yB[e];
#pragma unroll
        for (int e = 0; e < 8; ++e) s1 += y[e];
        s1 += __shfl_xor(s1, 1); s1 += __shfl_xor(s1, 2); s1 += __shfl_xor(s1, 4);
        const float mu = s1 * (1.f / 64.f); float s2 = 0.f;
#pragma unroll
        for (int e = 0; e < 8; ++e) { y[e] -= mu; s2 += y[e] * y[e]; }
        s2 += __shfl_xor(s2, 1); s2 += __shfl_xor(s2, 2); s2 += __shfl_xor(s2, 4);
        const float rstd = 1.f / sqrtf(s2 * (1.f / 64.f) + 64e-5f);
        float r[8], k[8], v[8];
        r[0] = bflo(q0.x); k[0] = bfhi(q0.x); v[0] = bflo(q0.y); r[1] = bflo(q0.z); k[1] = bfhi(q0.z); v[1] = bflo(q0.w);
        r[2] = bflo(q1.x); k[2] = bfhi(q1.x); v[2] = bflo(q1.y); r[3] = bflo(q1.z); k[3] = bfhi(q1.z); v[3] = bflo(q1.w);
        r[4] = bflo(q2.x); k[4] = bfhi(q2.x); v[4] = bflo(q2.y); r[5] = bflo(q2.z); k[5] = bfhi(q2.z); v[5] = bflo(q2.w);
        r[6] = bflo(q3.x); k[6] = bfhi(q3.x); v[6] = bflo(q3.y); r[7] = bflo(q3.z); k[7] = bfhi(q3.z); v[7] = bflo(q3.w);
        float am[8];
#pragma unroll
        for (int e = 0; e < 8; ++e) am[e] = 0.5f * (a0v[e] + a1v[e]);
        float rk = 0.f;
#pragma unroll
        for (int e = 0; e < 8; ++e) { const int c = c0 + e; rk += r[e] * (k[e] * (1.f + (am[e] - 1.f) * ka[c])) * rkw[c]; }
        rk += __shfl_xor(rk, 1); rk += __shfl_xor(rk, 2); rk += __shfl_xor(rk, 4);
        float o[8];
#pragma unroll
        for (int e = 0; e < 8; ++e) { const int c = c0 + e; o[e] = (y[e] * rstd * lng[c] + lnb[c] + rk * v[e]) * gv[e]; }
        *(GAS v4u*)(YB + (size_t)m * 1024 + c0) = pack8(o);
        { float d[8];
#pragma unroll
          for (int e = 0; e < 8; ++e) d[e] = pv[e] - lam * ov[e];
          float ss = 0.f;
#pragma unroll
          for (int e = 0; e < 8; ++e) ss += d[e] * d[e];
          ss += __shfl_xor(ss, 1); ss += __shfl_xor(ss, 2); ss += __shfl_xor(ss, 4); ss += __shfl_xor(ss, 8);
          const float rinv = (1.f - lam_init) / sqrtf(ss * (1.f / 128.f) + 1e-6f);
#pragma unroll
          for (int e = 0; e < 8; ++e) d[e] = d[e] * rinv * subln[(c0 & 127) + e];
          *(GAS v4u*)(YC + (size_t)m * 1024 + c0) = pack8(d); }
    }
}

constexpr int PH_PER_LAYER = 13, NPH = 1 + NLAYER * PH_PER_LAYER;
#define IN(k) (lo <= (k) && (k) < hi)
#define SEAM(k) do { if (IN(k) && IN((k) + 1)) xcd_barrier(bar); } while (0)
#ifndef ONLY_PH
#define ONLY_PH -1
#endif
#define INL(k) ((ONLY_PH < 0 || ONLY_PH == (k)) && IN(pb + (k)))
#define SEAML(k) SEAM(pb + (k))
#ifndef PROBE_REP
#define PROBE_REP 0
#endif
#define REPL(k) for (int rep_ = 0; rep_ < (((PROBE_REP) >> (k)) & 1) + 1; ++rep_)
template <int l> __device__ __forceinline__ void layer_body(const Args& args, LAS unsigned char* lds, unsigned char* lds_raw, unsigned char* ws, const XcdBarrier& bar, int lo, int hi, int tid, int lane, int G, int bx, int vcu, int gw, int NGW, int gt, int NGT) {
        const int pb = 1 + l * PH_PER_LAYER;
        const bool last = (l == NLAYER - 1);
        float* XS = (float*)(ws + WS_XS); pg8::bf16_t* PART = (pg8::bf16_t*)(ws + WS_PART);
        const float* mods = (const float*)(ws + WS_MODS) + (size_t)l * 3 * NMOD * DM;
        const float* normg = args.in[I_NORMG] + (size_t)l * 3 * DM;
        pg8::bf16_t* XN = (pg8::bf16_t*)(ws + WS_XN);
        pg8::bf16_t* Hb = (pg8::bf16_t*)(ws + WS_R1);
        const float* xl0 = (l == 0) ? args.in[I_X] : XS; const float* xc0 = (l == 0) ? args.in[I_CTX] : XS + (size_t)NLAT * DM;

        if (INL(0)) REPL(0) ph_norm(xl0, xc0, normg, mods, 0, (bf16*)XN, XS, l == 0 ? nullptr : PART, 16, MT, gw, NGW, lane);
        SEAML(0);
        if (INL(1)) REPL(1) { pg8::Gemm g{XN, (const pg8::bf16_t*)(ws + WS_WF1 + (size_t)(l * 2 + 0) * SZ_WF1), MT, FF2, DM}; pg8::StaticOrder S; S.init(MT, FF2, G, bx);
            pg8::EpiSwiglu E{Hb, FF}; pg8::gemm_phase<pg8::EpiSwiglu, pg8::StaticOrder, true, true>(lds, g, S, E); }
        SEAML(1);
        if (INL(2)) REPL(2) { pg8::Gemm g{Hb, (const pg8::bf16_t*)(ws + WS_WF2 + (size_t)(l * 2 + 0) * SZ_WF2), MT, DM, FF}; pg8::SplitCtxOrder S{G, vcu, NLAT / 256, NCTX / 256, 16, FF / 64};
            pg8::EpiResid E{xl0, (long)((xc0 - (size_t)NLAT * DM) - xl0), XS, 0L, mods + 2 * DM, NMOD * DM, 0.5f, NLAT / 256, TSEQ / 256, PART, NCTX};
            pg8::gemm_phase<pg8::EpiResid, pg8::SplitCtxOrder, true, true>(lds, g, S, E); }
        SEAML(2);
        if (INL(3)) REPL(3) ph_norm(XS, XS + (size_t)NLAT * DM, normg + DM, mods, 3, (bf16*)XN, XS, PART, 16, MT, gw, NGW, lane);
        SEAML(3);
        if (INL(4)) REPL(4) { pg8::Gemm g{XN, (const pg8::bf16_t*)(ws + WS_WIN + (size_t)l * SZ_WIN), MT, PROJP, DM}; pg8::StaticOrder S; S.init(MT, PROJP, G, bx);
            pg8::EpiProj E{(pg8::bf16_t*)(ws + WS_P), PROJP, (pg8::bf16_t*)(ws + WS_ACT), (pg8::bf16_t*)(ws + WS_QK), args.in[I_QN] + l * 64, args.in[I_KN] + l * 64, (const float*)(ws + WS_ROPE), NLAT, TSEQ};
            pg8::gemm_phase<pg8::EpiProj, pg8::StaticOrder, true, true>(lds, g, S, E); }
        SEAML(4);
        if (INL(5)) REPL(5) { pg8::Gemm g{(const pg8::bf16_t*)(ws + WS_ACT), (const pg8::bf16_t*)(ws + WS_WLO + (size_t)l * SZ_WLO), MT, LOW, ACTW}; pg8::LoraOrder S; S.init(MT, LOW, G, bx);
            pg8::EpiLora E{(pg8::bf16_t*)(ws + WS_R1), args.in[I_W0] + l * 2048, args.in[I_A0] + l * 2048}; pg8::gemm_phase<pg8::EpiLora, pg8::LoraOrder, true, true>(lds, g, S, E);
            ph_e1(args, l, gt, NGT); }
        SEAML(5);
        if (INL(6)) REPL(6) {
            if (bx < 64) scan_unit(args, l, bx, lds, tid);
            else { ph_attn(args, !last, (char*)lds_raw, bx - 64, G - 64); __syncthreads(); ph_gmlp(args, l, lds, tid, bx - 64, G - 64); }
        }
        SEAML(6);
        if (INL(7)) REPL(7) ph_rwkv_out(args, l, last ? NLAT : MT, gt, NGT);
        SEAML(7);
        if (INL(8)) REPL(8) { pg8::Gemm g{(const pg8::bf16_t*)(ws + WS_Y3), (const pg8::bf16_t*)(ws + WS_WBR + (size_t)l * SZ_WBR), 3 * MT, 3 * DM, 1024}; pg8::MergeOrder S{G, bx, MT / 256, last ? NLAT / 256 : MT / 256};
            pg8::EpiMerge E{(const pg8::bf16_t*)(ws + WS_P) + P_GATE2, PROJP, args.in[I_BGATE] + (size_t)l * 3 * DM, (float*)(ws + WS_YS), XN, MT / 256};
            pg8::gemm_phase<pg8::EpiMerge, pg8::MergeOrder, true, true>(lds, g, S, E); }
        SEAML(8);
        if (INL(9)) REPL(9) { pg8::Gemm g{XN, (const pg8::bf16_t*)(ws + WS_WOUT + (size_t)l * SZ_WOUT), MT, DM, DM}; pg8::SplitCtxOrder S{G, vcu, NLAT / 256, last ? 0 : NCTX / 256, 8, DM / 64};
            pg8::EpiResid E{XS, 0L, XS, 0L, mods + 5 * DM, NMOD * DM, 1.0f, NLAT / 256, TSEQ / 256, PART, NCTX};
            pg8::gemm_phase<pg8::EpiResid, pg8::SplitCtxOrder, true, true>(lds, g, S, E); }
        SEAML(9);
        if (INL(10)) REPL(10) ph_norm(XS, XS + (size_t)NLAT * DM, normg + 2 * DM, mods, 6, (bf16*)XN, XS, PART, 8, last ? NLAT : MT, gw, NGW, lane);
        SEAML(10);
        if (INL(11)) REPL(11) { pg8::Gemm g{XN, (const pg8::bf16_t*)(ws + WS_WF1 + (size_t)(l * 2 + 1) * SZ_WF1), MT, FF2, DM}; pg8::StaticOrder S; S.init(last ? NLAT : MT, FF2, G, bx);
            pg8::EpiSwiglu E{Hb, FF}; pg8::gemm_phase<pg8::EpiSwiglu, pg8::StaticOrder, true, true>(lds, g, S, E); }
        SEAML(11);
        if (INL(12)) REPL(12) { pg8::Gemm g{Hb, (const pg8::bf16_t*)(ws + WS_WF2 + (size_t)(l * 2 + 1) * SZ_WF2), MT, DM, FF}; pg8::SplitCtxOrder S{G, vcu, NLAT / 256, last ? 0 : NCTX / 256, 16, FF / 64};
            pg8::EpiResid E{XS, 0L, last ? args.out : XS, 0L, mods + 8 * DM, NMOD * DM, 0.5f, NLAT / 256, TSEQ / 256, PART, NCTX};
            pg8::gemm_phase<pg8::EpiResid, pg8::SplitCtxOrder, true, true>(lds, g, S, E); }
        SEAML(12);
    }
__global__ void __launch_bounds__(NTHR, 2) fwd(Args args) {
    extern __shared__ __attribute__((aligned(16))) unsigned char lds_raw[];
    LAS unsigned char* lds = (LAS unsigned char*)lds_raw;
    const int tid = threadIdx.x, lane = tid & 63, wave = __builtin_amdgcn_readfirstlane(tid >> 6);
    const int G = gridDim.x; const int bx = blockIdx.x; const int vcu = (G % 8 == 0) ? (bx % 8) * (G / 8) + bx / 8 : bx;
    const int gw = vcu * NWAVES + wave, NGW = G * NWAVES, gt = vcu * NTHR + tid, NGT = G * NTHR;
    unsigned char* ws = args.ws;
    volatile LAS unsigned* MISC = (volatile LAS unsigned*)(lds + MISC_OFF);
    for (int u = tid; u < (LDS_BYTES - LDSCTL_OFF) / 4; u += NTHR) ((LAS unsigned*)(lds + LDSCTL_OFF))[u] = 0u;
    __syncthreads();
    const int lo = args.ph_lo, hi = args.ph_hi;
    const bool multi = (hi - lo) > 1;
    XcdBarrier bar; bar.bar = (unsigned*)(ws + WS_CTL) + CW_BAR; bar.x = 0; bar.st = nullptr;
    if (multi) bar = xcd_barrier_post((unsigned*)(ws + WS_CTL) + CW_BAR, MISC + 8);

    if ((ONLY_PH < 0 || ONLY_PH == 100) && IN(0)) REPL(16) {
        ph_ada(args, 0, lds, tid, vcu, G); __syncthreads(); ph_ada(args, 1, lds, tid, vcu, G); __syncthreads(); ph_weights(args, 0, lds, tid, vcu, G); ph_weights(args, 1, lds, tid, vcu, G); ph_small(args, tid, vcu, G); }
    SEAM(0);

    layer_body<0>(args, lds, lds_raw, ws, bar, lo, hi, tid, lane, G, bx, vcu, gw, NGW, gt, NGT);
    layer_body<1>(args, lds, lds_raw, ws, bar, lo, hi, tid, lane, G, bx, vcu, gw, NGW, gt, NGT);
#undef IN
#undef SEAM
}

#ifndef MK_PER_PHASE
#define MK_PER_PHASE 0
#endif
extern "C" void kernel_launch(void* const* d_in, const int* in_sizes, int n_in, void* d_out, int out_size, void* d_ws, size_t ws_size, hipStream_t stream) {
    static int grid = 0;
    if (grid == 0) {
        if (n_in != 31 || in_sizes[0] != NLAT * DM || out_size != NLAT * DM || ws_size < WS_END) {
            fprintf(stderr, "kernel_launch: unexpected shapes: n_in %d in0 %d out %d ws %zu (need %zu); nothing launched\n", n_in, n_in > 0 ? in_sizes[0] : -1, out_size, ws_size, (size_t)WS_END); grid = -1; return; }
        int dev = 0, cus = 0, per_cu = 0;
        if (hipGetDevice(&dev) != hipSuccess || hipDeviceGetAttribute(&cus, hipDeviceAttributeMultiprocessorCount, dev) != hipSuccess) { grid = -1; return; }
        if (hipFuncSetAttribute((const void*)fwd, hipFuncAttributeMaxDynamicSharedMemorySize, LDS_BYTES) != hipSuccess) { fprintf(stderr, "kernel_launch: hipFuncSetAttribute failed\n"); grid = -1; return; }
        if (hipOccupancyMaxActiveBlocksPerMultiprocessor(&per_cu, (const void*)fwd, NTHR, LDS_BYTES) != hipSuccess || per_cu < 1) fprintf(stderr, "kernel_launch: occupancy query says %d\n", per_cu);
        (void)hipGetLastError();
        grid = cus;
    }
    if (grid < 0) return;
    (void)hipMemsetAsync((char*)d_ws + WS_CTL, 0, CTL_ZERO_BYTES, stream);
    Args a{};
    for (int i = 0; i < 31; ++i) a.in[i] = (const float*)d_in[i];
    a.out = (float*)d_out; a.ws = (unsigned char*)d_ws;
#if MK_PER_PHASE
    for (int p = 0; p < NPH; ++p) { a.ph_lo = p; a.ph_hi = p + 1; hipLaunchKernelGGL(fwd, dim3(grid), dim3(NTHR), LDS_BYTES, stream, a); }
#else
    a.ph_lo = 0; a.ph_hi = NPH; hipLaunchKernelGGL(fwd, dim3(grid), dim3(NTHR), LDS_BYTES, stream, a);
#endif
}
```

```cpp
#include <hip/hip_runtime.h>
#include <cstdio>
#include <cstdint>
namespace pg8 {
#define PG8_LAS __attribute__((address_space(3)))
typedef unsigned short bf16_t;
typedef short bf16x8 __attribute__((ext_vector_type(8)));
typedef float f32x4 __attribute__((ext_vector_type(4)));
typedef unsigned u32x4 __attribute__((ext_vector_type(4)));
constexpr int BM = 256, BK = 64, HALF = 128, HTB = HALF * BK * 2  , STAGE_BYTES = 8 * HTB, NXCD = 8, WGM = 8;

__host__ __device__ __forceinline__ int lds_byte(int r, int c) { const int st = (r >> 4) * 2 + (c >> 5), rr = r & 15, cc = c & 31, ob = rr * 64 + cc * 2; return st * 1024 + (ob ^ (((ob >> 9) & 1) << 5)); }
__host__ __device__ __forceinline__ void stage_rc(int b, int& R, int& C) { const int st = b / 1024, sb = b % 1024, swz = sb ^ (((sb >> 9) & 1) << 5); R = (st >> 1) * 16 + swz / 64; C = (st & 1) * 32 + (swz % 64) / 2; }
__host__ __device__ __forceinline__ int perm32(int rho) { const int n = rho >> 4, i = rho & 15; return 8 * (i >> 2) + 4 * n + (i & 3); }

struct Unit { int pm, pn, ks, kn, aux; };
struct Gemm { const bf16_t* A; const bf16_t* Bt; int M, N, K; };

struct StaticOrder {
    int nM, nN, nwg, G, c;
    __host__ __device__ void init(int M, int N, int G_, int c_) { nM = M / BM; nN = N / BM; nwg = nM * nN; G = G_; c = c_; }
    __host__ __device__ bool next(int i, Unit& u) const {
        const long L = (long)i * G + c; if (L >= nwg) return false;
        int wgid = (int)L; { const int q = nwg / NXCD, r = nwg % NXCD, xcd = wgid % NXCD, off = wgid / NXCD; wgid = (xcd < r ? xcd * (q + 1) : r * (q + 1) + (xcd - r) * q) + off; }
        const int nig = WGM * nN, gid = wgid / nig, fm = gid * WGM, gsz = (nM - fm) < WGM ? (nM - fm) : WGM;
        u.pm = fm + ((wgid % nig) % gsz); u.pn = (wgid % nig) / gsz; u.ks = 0; u.kn = 0; u.aux = 0; return true;
    }
    __device__ __forceinline__ void a_ready(const Unit&) const {}
    __device__ __forceinline__ void done(const Unit&) const {}
};

__device__ __forceinline__ unsigned cvt_pk_bf16(float lo, float hi) { unsigned r; asm volatile("v_cvt_pk_bf16_f32 %0, %1, %2" : "=v"(r) : "v"(lo), "v"(hi)); return r; }
typedef float f32x2 __attribute__((ext_vector_type(2)));
typedef unsigned u32x2 __attribute__((ext_vector_type(2)));
__device__ __forceinline__ float fsigmoid(float x) { return __builtin_amdgcn_rcpf(1.f + __expf(-x)); }
__device__ __forceinline__ float bflo(unsigned w) { return __builtin_bit_cast(float, w << 16); }
__device__ __forceinline__ float bfhi(unsigned w) { return __builtin_bit_cast(float, w & 0xffff0000u); }

struct EpiSwiglu {
    static constexpr bool PERM = true, AFTER_DRAIN = false;
    bf16_t* H; int ldh;
    __device__ __forceinline__ void operator()(const f32x4 (&acc)[2][2][4][2], const Unit& u, int wr, int wc, int fr, int fq) const {
        const int col0 = u.pn * HALF + wc * 32 + 8 * fq, row0 = u.pm * BM + wr * 64 + fr;
#pragma unroll
        for (int ai = 0; ai < 2; ++ai)
#pragma unroll
            for (int m = 0; m < 4; ++m) {
                const f32x4 g0 = acc[ai][0][m][0], g1 = acc[ai][0][m][1], u0 = acc[ai][1][m][0], u1 = acc[ai][1][m][1];
                float o[8];
#pragma unroll
                for (int e = 0; e < 4; ++e) { o[e] = g0[e] * fsigmoid(g0[e]) * u0[e]; o[4 + e] = g1[e] * fsigmoid(g1[e]) * u1[e]; }
                u32x4 w; w.x = cvt_pk_bf16(o[0], o[1]); w.y = cvt_pk_bf16(o[2], o[3]); w.z = cvt_pk_bf16(o[4], o[5]); w.w = cvt_pk_bf16(o[6], o[7]);
                *(u32x4*)(H + (size_t)(row0 + ai * HALF + m * 16) * ldh + col0) = w;
            }
    }
};

struct EpiResid {
    static constexpr bool PERM = true, AFTER_DRAIN = false;
    const float* xin; long din; float* out; long dout; const float* gvec; int gstride; float scale; int nlat_tiles, tiles_per_set; bf16_t* part; int nctx_rows;
    __device__ __forceinline__ void operator()(const f32x4 (&acc)[2][2][4][2], const Unit& u, int wr, int wc, int fr, int fq) const {
        const bool isctx = u.pm >= nlat_tiles;
        const int set = isctx ? 2 : (u.pm / tiles_per_set);
        const float* gv = gvec + (size_t)set * gstride;
        const int colb = u.pn * BM + wc * 32 + 8 * fq;
        const long rbase = (long)(u.pm * BM + wr * 64 + fr) * 2048 + colb;
        const float* xi = xin + rbase + (isctx ? din : 0L); float* xo = out + rbase + (isctx ? dout : 0L);
        f32x4 gg[2][2];
#pragma unroll
        for (int bj = 0; bj < 2; ++bj)
#pragma unroll
            for (int n = 0; n < 2; ++n) gg[bj][n] = *(const f32x4*)(gv + colb + bj * HALF + 4 * n) * scale;
        if (u.kn != 0) {
            bf16_t* pp = part + ((size_t)u.aux * (size_t)nctx_rows + (size_t)((u.pm - nlat_tiles) * BM + wr * 64 + fr)) * 2048 + colb;
#pragma unroll
            for (int ai = 0; ai < 2; ++ai)
#pragma unroll
                for (int m = 0; m < 4; ++m)
#pragma unroll
                    for (int bj = 0; bj < 2; ++bj) { const f32x4 v0 = gg[bj][0] * acc[ai][bj][m][0], v1 = gg[bj][1] * acc[ai][bj][m][1];
                        u32x4 w; w.x = cvt_pk_bf16(v0[0], v0[1]); w.y = cvt_pk_bf16(v0[2], v0[3]); w.z = cvt_pk_bf16(v1[0], v1[1]); w.w = cvt_pk_bf16(v1[2], v1[3]);
                        *(u32x4*)(pp + (size_t)(ai * HALF + m * 16) * 2048 + bj * HALF) = w; }
            return;
        }
#pragma unroll
        for (int ai = 0; ai < 2; ++ai) {
            f32x4 xv[4][2][2];
#pragma unroll
            for (int m = 0; m < 4; ++m)
#pragma unroll
                for (int bj = 0; bj < 2; ++bj)
#pragma unroll
                    for (int n = 0; n < 2; ++n) xv[m][bj][n] = *(const f32x4*)(xi + (size_t)(ai * HALF + m * 16) * 2048 + bj * HALF + 4 * n);
#pragma unroll
            for (int m = 0; m < 4; ++m)
#pragma unroll
                for (int bj = 0; bj < 2; ++bj)
#pragma unroll
                    for (int n = 0; n < 2; ++n) *(f32x4*)(xo + (size_t)(ai * HALF + m * 16) * 2048 + bj * HALF + 4 * n) = xv[m][bj][n] + gg[bj][n] * acc[ai][bj][m][n];
        }
    }
};
struct SplitCtxOrder {
    int G, c, nlat_tiles, nctx_tiles, nsplit, ntk;
    __device__ __forceinline__ bool next(int i, Unit& u) const {
        const int e = i * G + c, nl = nlat_tiles * 8;
        if (e < nl) { u.pm = e >> 3; u.pn = e & 7; u.ks = 0; u.kn = 0; u.aux = 0; return true; }
        const int f = e - nl; if (f >= nctx_tiles * 8 * nsplit) return false;
        const int sp = f % nsplit, t = f / nsplit, np = ntk >> 1, p0 = sp * np / nsplit, p1 = (sp + 1) * np / nsplit;
        u.pm = nlat_tiles + (t >> 3); u.pn = t & 7; u.ks = 2 * p0; u.kn = 2 * (p1 - p0); u.aux = sp; return true;
    }
    __device__ __forceinline__ void a_ready(const Unit&) const {}
    __device__ __forceinline__ void done(const Unit&) const {}
};
struct ProjOrder : StaticOrder {
    int skip_ctx;
    __device__ __forceinline__ bool next(int i, Unit& u) const {
        if (StaticOrder::next(i, u)) return true;
        if (!skip_ctx) return false;
        const long L = (long)i * G + c - nwg; if (L >= 2 * 23) return false;
        const int x = (int)L % 23; u.pm = nM + (int)L / 23; u.pn = x < 15 ? 8 + x : 27 + (x - 15); u.ks = 0; u.kn = 0; u.aux = 0; return true;
    }
};
struct LoraOrder : StaticOrder {
    __device__ __forceinline__ bool next(int i, Unit& u) const {
        if (!StaticOrder::next(i, u)) return false;
        const int sec = u.pn >> 2; int k4 = 4; asm volatile("" : "+s"(k4));
        u.ks = sec == 0 ? 0 : (sec <= 2 ? 4 : 8); u.kn = k4; return true;
    }
};

__device__ __forceinline__ float ftanh_e(float x) { return 1.f - 2.f * __builtin_amdgcn_rcpf(__expf(2.f * x) + 1.f); }
__device__ __forceinline__ float gelu_e(float x) { return 0.5f * x * (1.f + ftanh_e(0.7978845608f * (x + 0.044715f * x * x * x))); }
struct EpiProj {
    static constexpr bool PERM = true, AFTER_DRAIN = false;
    bf16_t* P; int ldp; bf16_t* ACT; bf16_t* QK; const float* qn; const float* kn; const float* rope; int nlat_rows, tseq;
    __device__ __forceinline__ void operator()(const f32x4 (&acc)[2][2][4][2], const Unit& u, int wr, int wc, int fr, int fq) const {
        const int pn = u.pn, row0 = u.pm * BM + wr * 64 + fr;
        if (pn >= 23 && pn <= 30) {
            const bool isq = pn <= 26; const int gi = (pn - 23) * 4 + wc;
            const float* gain = isq ? qn : kn;
            f32x4 gg[2][2];
#pragma unroll
            for (int bj = 0; bj < 2; ++bj)
#pragma unroll
                for (int n = 0; n < 2; ++n) gg[bj][n] = *(const f32x4*)(gain + bj * 32 + n * 16 + 4 * fq);
            const float qs = isq ? 0.18033688011112042f : 1.f;
#pragma unroll
            for (int ai = 0; ai < 2; ++ai)
#pragma unroll
                for (int m = 0; m < 4; ++m) {
                    const int row = row0 + ai * HALF + m * 16;
                    f32x4 x[2][2]; float ss = 0.f;
#pragma unroll
                    for (int bj = 0; bj < 2; ++bj)
#pragma unroll
                        for (int n = 0; n < 2; ++n) { x[bj][n] = acc[ai][bj][m][n]; ss += (x[bj][n][0] * x[bj][n][0] + x[bj][n][1] * x[bj][n][1]) + (x[bj][n][2] * x[bj][n][2] + x[bj][n][3] * x[bj][n][3]); }
                    ss += __shfl_xor(ss, 16); ss += __shfl_xor(ss, 32);
                    const float rinv = __builtin_amdgcn_rsqf(ss * (1.f / 64.f) + 1e-6f);
#pragma unroll
                    for (int bj = 0; bj < 2; ++bj)
#pragma unroll
                        for (int n = 0; n < 2; ++n) x[bj][n] = x[bj][n] * rinv * gg[bj][n];
                    if (row < nlat_rows) { const int t = row & (tseq - 1);
#pragma unroll
                        for (int bj = 0; bj < 2; ++bj) { const int p = bj == 0 ? (t >> 6) : (t & 63);
                            const f32x4 cs0 = *(const f32x4*)(rope + (p * 16 + 4 * fq) * 2), cs1 = *(const f32x4*)(rope + (p * 16 + 4 * fq) * 2 + 4);
                            const f32x4 c = {cs0[0], cs0[2], cs1[0], cs1[2]}, s = {cs0[1], cs0[3], cs1[1], cs1[3]};
                            const f32x4 a = x[bj][0], b2 = x[bj][1];
                            x[bj][0] = a * c - b2 * s; x[bj][1] = b2 * c + a * s; } }
                    bf16_t* dst = QK + (size_t)row * 2048 + gi * 64 + 8 * fq;
#pragma unroll
                    for (int bj = 0; bj < 2; ++bj) { const f32x4 v0 = x[bj][0] * qs, v1 = x[bj][1] * qs;
                        u32x4 w; w.x = cvt_pk_bf16(v0[0], v0[1]); w.y = cvt_pk_bf16(v0[2], v0[3]); w.z = cvt_pk_bf16(v1[0], v1[1]); w.w = cvt_pk_bf16(v1[2], v1[3]);
                        *(u32x4*)(dst + bj * 32) = w; }
                }
            return;
        }
        if (pn >= 20 && pn <= 22) {
#pragma unroll
            for (int bj = 0; bj < 2; ++bj) {
                const int cc = bj * HALF + wc * 32 + 8 * fq;
                int dcol, fn;
                if (pn == 20) { dcol = cc; fn = 1; }
                else if (pn == 21) { if (cc < 96) { dcol = 256 + cc; fn = 2; } else if (cc < 192) { dcol = 384 + (cc - 96); fn = 2; } else { dcol = 512 + (cc - 192); fn = 0; } }
                else { if (cc < 32) { dcol = 576 + cc; fn = 0; } else if (cc < 128) { dcol = 640 + (cc - 32); fn = 0; } else { dcol = -1; fn = 0; } }
                if (dcol < 0) continue;
#pragma unroll
                for (int ai = 0; ai < 2; ++ai)
#pragma unroll
                    for (int m = 0; m < 4; ++m) {
                        f32x4 v0 = acc[ai][bj][m][0], v1 = acc[ai][bj][m][1];
                        if (fn != 0) {
#pragma unroll
                            for (int e = 0; e < 4; ++e) { v0[e] = fn == 1 ? fsigmoid(v0[e]) : ftanh_e(v0[e]); v1[e] = fn == 1 ? fsigmoid(v1[e]) : ftanh_e(v1[e]); } }
                        u32x4 w; w.x = cvt_pk_bf16(v0[0], v0[1]); w.y = cvt_pk_bf16(v0[2], v0[3]); w.z = cvt_pk_bf16(v1[0], v1[1]); w.w = cvt_pk_bf16(v1[2], v1[3]);
                        *(u32x4*)(ACT + (size_t)(row0 + ai * HALF + m * 16) * 768 + dcol) = w;
                    }
            }
            return;
        }
        const bool dogelu = pn < 8;
        const int col0 = pn * BM + wc * 32 + 8 * fq;
#pragma unroll
        for (int ai = 0; ai < 2; ++ai)
#pragma unroll
            for (int m = 0; m < 4; ++m) {
                bf16_t* rowp = P + (size_t)(row0 + ai * HALF + m * 16) * ldp + col0;
#pragma unroll
                for (int bj = 0; bj < 2; ++bj) {
                    f32x4 v0 = acc[ai][bj][m][0], v1 = acc[ai][bj][m][1];
                    if (dogelu) {
#pragma unroll
                        for (int e = 0; e < 4; ++e) { v0[e] = gelu_e(v0[e]); v1[e] = gelu_e(v1[e]); } }
                    u32x4 w; w.x = cvt_pk_bf16(v0[0], v0[1]); w.y = cvt_pk_bf16(v0[2], v0[3]); w.z = cvt_pk_bf16(v1[0], v1[1]); w.w = cvt_pk_bf16(v1[2], v1[3]);
                    *(u32x4*)(rowp + bj * HALF) = w;
                }
            }
    }
};

struct EpiLora {
    static constexpr bool PERM = true, AFTER_DRAIN = false;
    bf16_t* LO; const float* w0; const float* a0;
    __device__ __forceinline__ void operator()(const f32x4 (&acc)[2][2][4][2], const Unit& u, int wr, int wc, int fr, int fq) const {
        const int sec = u.pn >> 2;
        const int col0 = u.pn * BM + wc * 32 + 8 * fq, row0 = u.pm * BM + wr * 64 + fr, c0 = col0 - sec * 1024;
        const float* bp = (sec <= 2 ? w0 + (sec <= 1 ? 0 : 1024) : a0 + (sec - 3) * 1024) + c0;
#pragma unroll
        for (int ai = 0; ai < 2; ++ai)
#pragma unroll
            for (int m = 0; m < 4; ++m) {
                bf16_t* rowp = LO + (size_t)(row0 + ai * HALF + m * 16) * 5120 + col0;
#pragma unroll
                for (int bj = 0; bj < 2; ++bj) {
                    f32x4 v[2];
#pragma unroll
                    for (int n = 0; n < 2; ++n) { v[n] = acc[ai][bj][m][n];
                        if (sec >= 1) { v[n] = v[n] + *(const f32x4*)(bp + bj * HALF + 4 * n);
#pragma unroll
                            for (int e = 0; e < 4; ++e) { const float s = fsigmoid(v[n][e]); v[n][e] = (sec <= 2) ? 0.8750356f * s : s; } } }
                    u32x4 w; w.x = cvt_pk_bf16(v[0][0], v[0][1]); w.y = cvt_pk_bf16(v[0][2], v[0][3]); w.z = cvt_pk_bf16(v[1][0], v[1][1]); w.w = cvt_pk_bf16(v[1][2], v[1][3]);
                    *(u32x4*)(rowp + bj * HALF) = w;
                }
                asm volatile("" ::: "memory");
            }
    }
};

struct EpiMerge {
    static constexpr bool PERM = true, AFTER_DRAIN = false;
    const bf16_t* pgate; int ldp;
    const float* bgate;
    bf16_t* ZF; bf16_t* Z; int mtiles;
    __device__ __forceinline__ void operator()(const f32x4 (&acc)[2][2][4][2], const Unit& u, int wr, int wc, int fr, int fq) const {
        const int br = u.pn >> 3, pn = u.pn & 7, pm = u.pm - mtiles * br;
        const int col0 = pn * BM + wc * 32 + 8 * fq, row0 = pm * BM + wr * 64 + fr;
        f32x4 bb[2][2];
#pragma unroll
        for (int bj = 0; bj < 2; ++bj)
#pragma unroll
            for (int n = 0; n < 2; ++n) bb[bj][n] = *(const f32x4*)(bgate + br * 2048 + col0 + bj * HALF + 4 * n);
        bf16_t* dstb = br == 2 ? Z : ZF;
#pragma unroll
        for (int ai = 0; ai < 2; ++ai) {
            u32x4 pg[4][2], zf[4][2];
#pragma unroll
            for (int m = 0; m < 4; ++m)
#pragma unroll
                for (int bj = 0; bj < 2; ++bj) { const size_t row = (size_t)(row0 + ai * HALF + m * 16);
                    pg[m][bj] = *(const u32x4*)(pgate + row * ldp + br * 2048 + col0 + bj * HALF);
                    if (br >= 1) zf[m][bj] = *(const u32x4*)(ZF + row * 2048 + col0 + bj * HALF); }
#pragma unroll
            for (int m = 0; m < 4; ++m)
#pragma unroll
                for (int bj = 0; bj < 2; ++bj) { const size_t row = (size_t)(row0 + ai * HALF + m * 16); const u32x4 q = pg[m][bj];
                    f32x4 g0, g1;
                    g0[0] = bflo(q.x); g0[1] = bfhi(q.x); g0[2] = bflo(q.y); g0[3] = bfhi(q.y); g1[0] = bflo(q.z); g1[1] = bfhi(q.z); g1[2] = bflo(q.w); g1[3] = bfhi(q.w);
                    g0 = g0 + bb[bj][0]; g1 = g1 + bb[bj][1];
                    f32x4 v0, v1;
#pragma unroll
                    for (int e = 0; e < 4; ++e) { v0[e] = fsigmoid(g0[e]) * acc[ai][bj][m][0][e]; v1[e] = fsigmoid(g1[e]) * acc[ai][bj][m][1][e]; }
                    if (br >= 1) { const u32x4 z = zf[m][bj];
                        v0[0] += bflo(z.x); v0[1] += bfhi(z.x); v0[2] += bflo(z.y); v0[3] += bfhi(z.y); v1[0] += bflo(z.z); v1[1] += bfhi(z.z); v1[2] += bflo(z.w); v1[3] += bfhi(z.w); }
                    u32x4 w; w.x = cvt_pk_bf16(v0[0], v0[1]); w.y = cvt_pk_bf16(v0[2], v0[3]); w.z = cvt_pk_bf16(v1[0], v1[1]); w.w = cvt_pk_bf16(v1[2], v1[3]);
                    *(u32x4*)(dstb + row * 2048 + col0 + bj * HALF) = w; }
        }
    }
};
struct MergeOrder {
    int G, c, mtiles, mactive;
    __device__ __forceinline__ bool next(int i, Unit& u) const {
        const int t = (i / 3) * G + c, br = i % 3; if (t >= mactive * 8) return false;
        u.pm = (t >> 3) + mtiles * br; u.pn = (t & 7) + 8 * br; u.ks = 0; u.kn = 0; u.aux = 0; return true;
    }
    __device__ __forceinline__ void a_ready(const Unit&) const {}
    __device__ __forceinline__ void done(const Unit&) const {}
};

template <class Epi, class Sched, bool ALIGN_EPI = false, bool SP2 = false>
__device__ __forceinline__ void gemm_phase(PG8_LAS unsigned char* lds, const Gemm g, const Sched& S, const Epi& E) {
    const int tid = threadIdx.x, wid = __builtin_amdgcn_readfirstlane(tid >> 6), lane = tid & 63, wr = wid >> 2, wc = wid & 3, fr = lane & 15, fq = lane >> 4;
    const int K = g.K, nt = K / BK;
    unsigned voffA[2], voffB[2];
#pragma unroll
    for (int i = 0; i < 2; ++i) { int R, C; stage_rc(tid * 16 + i * 8192, R, C); const int Rb = Epi::PERM ? ((R & ~31) + perm32(R & 31)) : R;
        voffA[i] = (unsigned)(R * K + C) * 2u; voffB[i] = (unsigned)(Rb * K + C) * 2u; }
    const size_t kstep = (size_t)(BK * 2);
    const size_t hstep = (size_t)HALF * K * 2;
    const size_t tstep = 2 * hstep;
    const unsigned ldsw = (unsigned)wid * 1024u;
    const int aoff = lds_byte(wr * 64 + fr, fq * 8), boff = lds_byte(wc * 32 + fr, fq * 8);
#define PG8_SA(b, h) (((b) * 2 + (h)) * HTB)
#define PG8_SB(b, h) ((4 + (b) * 2 + (h)) * HTB)
#define PG8_STAGE(bufoff, gbase, voff) do { _Pragma("unroll") for (int _i = 0; _i < 2; ++_i) \
        __builtin_amdgcn_global_load_lds((const unsigned*)((const char*)(gbase) + (voff)[_i]), (PG8_LAS unsigned*)(lds + (bufoff) + ldsw + _i * 8192), 16, 0, 0); } while (0)
#define PG8_LDA(dst, b, h) do { _Pragma("unroll") for (int m = 0; m < 4; ++m) _Pragma("unroll") for (int k = 0; k < 2; ++k) dst[m][k] = *(const PG8_LAS bf16x8*)(lds + PG8_SA(b, h) + aoff + m * 2048 + k * 1024); } while (0)
#define PG8_LDB(dst, b, h) do { _Pragma("unroll") for (int n = 0; n < 2; ++n) _Pragma("unroll") for (int k = 0; k < 2; ++k) dst[n][k] = *(const PG8_LAS bf16x8*)(lds + PG8_SB(b, h) + boff + n * 2048 + k * 1024); } while (0)
#define PG8_MMA(ai, bj, At, Bt) do { __builtin_amdgcn_s_setprio(1); _Pragma("unroll") for (int m = 0; m < 4; ++m) _Pragma("unroll") for (int n = 0; n < 2; ++n) _Pragma("unroll") for (int k = 0; k < 2; ++k) \
        acc[ai][bj][m][n] = __builtin_amdgcn_mfma_f32_16x16x32_bf16(Bt[n][k], At[m][k], acc[ai][bj][m][n], 0, 0, 0); __builtin_amdgcn_s_setprio(0); } while (0)
#define PG8_WAIT_V(n) asm volatile("s_waitcnt vmcnt(" #n ")" ::: "memory")
#define PG8_WAIT_L(n) asm volatile("s_waitcnt lgkmcnt(" #n ")" ::: "memory")
#define PG8_BAR __builtin_amdgcn_s_barrier()
#define PG8_SCHED __builtin_amdgcn_sched_barrier(0)
    Unit cur, nxt; int ui = 0;
    if (!S.next(0, cur)) return;
    f32x4 acc[2][2][4][2];
#pragma unroll
    for (int a = 0; a < 2; ++a)
#pragma unroll
        for (int b = 0; b < 2; ++b)
#pragma unroll
            for (int m = 0; m < 4; ++m)
#pragma unroll
                for (int n = 0; n < 2; ++n) acc[a][b][m][n] = (f32x4){0.f, 0.f, 0.f, 0.f};
    bf16x8 At[4][2], B0[2][2], B1[2][2];
    const char* cA = (const char*)g.A + (size_t)cur.pm * tstep + (size_t)cur.ks * kstep; const char* cB = (const char*)g.Bt + (size_t)cur.pn * tstep + (size_t)cur.ks * kstep;
    int ntc = cur.kn ? cur.kn : nt;
    S.a_ready(cur);
    if constexpr (SP2) {
        PG8_STAGE(PG8_SB(0, 0), cB, voffB); PG8_STAGE(PG8_SB(0, 1), cB + hstep, voffB); PG8_STAGE(PG8_SA(0, 0), cA, voffA); PG8_STAGE(PG8_SA(0, 1), cA + hstep, voffA);
        if (wr == 1) PG8_BAR;
        PG8_WAIT_V(2); PG8_BAR;
        PG8_STAGE(PG8_SB(1, 0), cB + kstep, voffB); PG8_STAGE(PG8_SA(1, 0), cA + kstep, voffA); PG8_STAGE(PG8_SB(1, 1), cB + hstep + kstep, voffB);
        PG8_WAIT_V(6); PG8_BAR;
    } else {
        PG8_STAGE(PG8_SB(0, 0), cB, voffB); PG8_STAGE(PG8_SA(0, 0), cA, voffA); PG8_STAGE(PG8_SB(0, 1), cB + hstep, voffB); PG8_STAGE(PG8_SA(0, 1), cA + hstep, voffA);
        if (wr == 1) PG8_BAR;
        PG8_WAIT_V(4); PG8_BAR;
        PG8_STAGE(PG8_SB(1, 0), cB + kstep, voffB); PG8_STAGE(PG8_SA(1, 0), cA + kstep, voffA); PG8_STAGE(PG8_SB(1, 1), cB + hstep + kstep, voffB);
        PG8_WAIT_V(6); PG8_BAR;
    }
    for (;;) {
        const bool has_next = S.next(ui + 1, nxt);
        const char* nA = has_next ? (const char*)g.A + (size_t)nxt.pm * tstep + (size_t)nxt.ks * kstep : cA; const char* nB = has_next ? (const char*)g.Bt + (size_t)nxt.pn * tstep + (size_t)nxt.ks * kstep : cB;
        for (int t = 0; t < ntc; t += 2) {
            const bool last = (t == ntc - 2);
            const char* a1 = cA + (size_t)(t + 1) * kstep;
            const char* a2 = last ? nA : cA + (size_t)(t + 2) * kstep; const char* b2 = last ? nB : cB + (size_t)(t + 2) * kstep;
            const char* a3 = a2 + kstep; const char* b3 = b2 + kstep;
            if (last && has_next) S.a_ready(nxt);
            if constexpr (SP2) {
            PG8_LDB(B0, 0, 0); PG8_LDB(B1, 0, 1); PG8_SCHED; PG8_LDA(At, 0, 0); PG8_STAGE(PG8_SA(1, 1), a1 + hstep, voffA);
            PG8_WAIT_V(8); PG8_WAIT_L(0); PG8_BAR; PG8_MMA(0, 0, At, B0); PG8_MMA(0, 1, At, B1); PG8_BAR; PG8_SCHED;
            PG8_LDA(At, 0, 1); PG8_STAGE(PG8_SB(0, 0), b2, voffB); PG8_STAGE(PG8_SB(0, 1), b2 + hstep, voffB); PG8_STAGE(PG8_SA(0, 0), a2, voffA);
            PG8_WAIT_V(8); PG8_WAIT_L(0); PG8_BAR; PG8_MMA(1, 0, At, B0); PG8_MMA(1, 1, At, B1); PG8_BAR; PG8_SCHED;
            PG8_LDB(B0, 1, 0); PG8_LDB(B1, 1, 1); PG8_SCHED; PG8_LDA(At, 1, 0); PG8_STAGE(PG8_SA(0, 1), a2 + hstep, voffA);
            PG8_WAIT_V(8); PG8_WAIT_L(0); PG8_BAR; PG8_MMA(0, 0, At, B0); PG8_MMA(0, 1, At, B1); PG8_BAR; PG8_SCHED;
            PG8_LDA(At, 1, 1); PG8_STAGE(PG8_SB(1, 0), b3, voffB); PG8_STAGE(PG8_SB(1, 1), b3 + hstep, voffB); PG8_STAGE(PG8_SA(1, 0), a3, voffA);
            PG8_WAIT_V(8); PG8_WAIT_L(0); PG8_BAR; PG8_MMA(1, 0, At, B0); PG8_MMA(1, 1, At, B1); PG8_BAR; PG8_SCHED;
            } else {
            PG8_LDB(B0, 0, 0); PG8_SCHED; PG8_LDA(At, 0, 0); PG8_STAGE(PG8_SA(1, 1), a1 + hstep, voffA);
            PG8_WAIT_L(8); PG8_BAR; PG8_WAIT_L(0); PG8_MMA(0, 0, At, B0); PG8_BAR; PG8_SCHED;
            PG8_LDB(B1, 0, 1); PG8_STAGE(PG8_SB(0, 0), b2, voffB);
            PG8_BAR; PG8_WAIT_L(0); PG8_MMA(0, 1, At, B1); PG8_BAR;
            PG8_LDA(At, 0, 1); PG8_STAGE(PG8_SA(0, 0), a2, voffA);
            PG8_BAR; PG8_WAIT_L(0); PG8_MMA(1, 0, At, B0); PG8_BAR; PG8_SCHED;
            PG8_STAGE(PG8_SB(0, 1), b2 + hstep, voffB);
            PG8_WAIT_V(6); PG8_BAR; PG8_MMA(1, 1, At, B1); PG8_BAR;
            PG8_LDB(B0, 1, 0); PG8_SCHED; PG8_LDA(At, 1, 0); PG8_STAGE(PG8_SA(0, 1), a2 + hstep, voffA);
            PG8_WAIT_L(8); PG8_BAR; PG8_WAIT_L(0); PG8_MMA(0, 0, At, B0); PG8_BAR; PG8_SCHED;
            PG8_LDB(B1, 1, 1); PG8_STAGE(PG8_SB(1, 0), b3, voffB);
            PG8_BAR; PG8_WAIT_L(0); PG8_MMA(0, 1, At, B1); PG8_BAR;
            PG8_LDA(At, 1, 1); PG8_STAGE(PG8_SA(1, 0), a3, voffA);
            PG8_BAR; PG8_WAIT_L(0); PG8_MMA(1, 0, At, B0); PG8_BAR; PG8_SCHED;
            PG8_STAGE(PG8_SB(1, 1), b3 + hstep, voffB);
            PG8_WAIT_V(6); PG8_BAR; PG8_MMA(1, 1, At, B1); PG8_BAR;
            }
        }
        if constexpr (ALIGN_EPI) { if (wr == 0) PG8_BAR; }
        if constexpr (!Epi::AFTER_DRAIN) { E(acc, cur, wr, wc, fr, fq); S.done(cur); }
        if (!has_next) break;
#pragma unroll
        for (int a = 0; a < 2; ++a)
#pragma unroll
            for (int b = 0; b < 2; ++b)
#pragma unroll
                for (int m = 0; m < 4; ++m)
#pragma unroll
                    for (int n = 0; n < 2; ++n) acc[a][b][m][n] = (f32x4){0.f, 0.f, 0.f, 0.f};
        cur = nxt; cA = nA; cB = nB; ++ui; ntc = cur.kn ? cur.kn : nt;
        if constexpr (ALIGN_EPI) { if (wr == 1) PG8_BAR; }
    }
    PG8_WAIT_V(0);
    if constexpr (!ALIGN_EPI) { if (wr == 0) PG8_BAR; }
    PG8_BAR;
    if constexpr (Epi::AFTER_DRAIN) { E.fused(acc, cur, wr, wc, fr, fq, lds, wid, lane); S.done(cur); }
#undef PG8_SA
#undef PG8_SB
#undef PG8_STAGE
#undef PG8_LDA
#undef PG8_LDB
#undef PG8_MMA
#undef PG8_WAIT_V
#undef PG8_WAIT_L
#undef PG8_BAR
#undef PG8_SCHED
}
}

constexpr int NWAVES = 8, NTHR = NWAVES * 64;
constexpr int DM = 2048, FF = 5504, FF2 = 2 * FF, NLAT = 8192, NCTX = 512, MT = NLAT + NCTX, TSEQ = 4096, TCTX = 256;
constexpr int PROJ = 14976, PROJP = 15104;
constexpr int P_U = 0, P_V = 1024, P_RKV = 2048, P_G = 5120, P_W = 5376, P_A = 5568, P_QKV = 5760, P_GATE = 8832;
constexpr int P_V2 = 31 * 256, P_GATE2 = 35 * 256;
constexpr int ACTW = 768, LOW = 5120;
constexpr int NLAYER = 2, NMOD = 9;

constexpr size_t MiB = 1u << 20;
constexpr size_t al(size_t x) { return (x + MiB - 1) / MiB * MiB; }
constexpr size_t WS_CTL = 0, CTL_ZERO_BYTES = 1 * MiB;
constexpr size_t WS_MODS = 1 * MiB;
constexpr size_t WS_ROPE = WS_MODS + al((size_t)NLAYER * 3 * NMOD * DM * 4);
constexpr size_t WS_WF1 = WS_ROPE + MiB;
constexpr size_t SZ_WF1 = (size_t)FF2 * DM * 2;
constexpr size_t WS_WF2 = WS_WF1 + al(4 * SZ_WF1);
constexpr size_t SZ_WF2 = (size_t)DM * FF * 2;
constexpr size_t WS_WIN = WS_WF2 + al(4 * SZ_WF2);
constexpr size_t SZ_WIN = (size_t)PROJP * DM * 2;
constexpr size_t WS_WLO = WS_WIN + al(2 * SZ_WIN);
constexpr size_t SZ_WLO = (size_t)LOW * ACTW * 2;
constexpr size_t WS_WBR = WS_WLO + al(2 * SZ_WLO);
constexpr size_t SZ_WBR = (size_t)3 * DM * 1024 * 2;
constexpr size_t WS_WOUT = WS_WBR + al(2 * SZ_WBR);
constexpr size_t SZ_WOUT = (size_t)DM * DM * 2;
constexpr size_t WS_XS = WS_WOUT + al(2 * SZ_WOUT);
constexpr size_t WS_XN = WS_XS + al((size_t)MT * DM * 4);
constexpr size_t WS_P = WS_XN + al((size_t)MT * DM * 2);
constexpr size_t WS_R1 = WS_P + al((size_t)MT * PROJP * 2);
constexpr size_t WS_ACT = WS_R1 + al((size_t)MT * FF * 2);
constexpr size_t WS_RKVK = WS_ACT + al((size_t)MT * ACTW * 2);
constexpr size_t WS_QK = WS_RKVK + al((size_t)MT * 4096 * 2);
constexpr size_t WS_YS = WS_QK + al((size_t)MT * DM * 2);
constexpr size_t WS_Y3 = WS_YS + al((size_t)2 * MT * 1024 * 2);
constexpr size_t WS_OJ = WS_Y3 + al((size_t)3 * MT * 1024 * 2);
constexpr size_t WS_PART = WS_OJ + al((size_t)2 * MT * 1024 * 2);
constexpr size_t WS_ZF = WS_PART + al((size_t)16 * NCTX * DM * 2);
constexpr size_t WS_IMG = WS_ZF + al((size_t)MT * DM * 2);
constexpr size_t WS_END = WS_IMG + al((size_t)64 * 136 * 22528);

constexpr int CW_TMO = 0, CW_CODE = 1, CW_BAR = 4096;

constexpr int RING_BYTES = 131072, LDSCTL_OFF = RING_BYTES, MISC_OFF = LDSCTL_OFF + 320, LDS_BYTES = 147456;

#define GAS __attribute__((address_space(1)))
#define LAS __attribute__((address_space(3)))
typedef unsigned short bf16;
typedef unsigned v4u __attribute__((ext_vector_type(4)));
typedef unsigned v2u __attribute__((ext_vector_type(2)));
typedef float f32x4 __attribute__((ext_vector_type(4)));
typedef short bf16x8 __attribute__((ext_vector_type(8)));
typedef GAS unsigned gu32;
#define RLX_AGENT __ATOMIC_RELAXED, __HIP_MEMORY_SCOPE_AGENT
__device__ __forceinline__ unsigned f2bf(float f) { unsigned u = __builtin_bit_cast(unsigned, f); return (u + 0x7fffu + ((u >> 16) & 1u)) >> 16; }
__device__ __forceinline__ unsigned pk2(float lo, float hi) { return f2bf(lo) | (f2bf(hi) << 16); }
__device__ __forceinline__ float bflo(unsigned w) { return __builtin_bit_cast(float, w << 16); }
__device__ __forceinline__ float bfhi(unsigned w) { return __builtin_bit_cast(float, w & 0xffff0000u); }
__device__ __forceinline__ float bf1(bf16 h) { return __builtin_bit_cast(float, (unsigned)h << 16); }
__device__ __forceinline__ void unpack8(const v4u w, float (&f)[8]) { f[0] = bflo(w.x); f[1] = bfhi(w.x); f[2] = bflo(w.y); f[3] = bfhi(w.y); f[4] = bflo(w.z); f[5] = bfhi(w.z); f[6] = bflo(w.w); f[7] = bfhi(w.w); }
__device__ __forceinline__ v4u pack8(const float (&f)[8]) { v4u w; w.x = pk2(f[0], f[1]); w.y = pk2(f[2], f[3]); w.z = pk2(f[4], f[5]); w.w = pk2(f[6], f[7]); return w; }
__device__ __forceinline__ float fsigm(float x) { return __builtin_amdgcn_rcpf(1.f + __expf(-x)); }
__device__ __forceinline__ float ftanh(float x) { return 1.f - 2.f * __builtin_amdgcn_rcpf(__expf(2.f * x) + 1.f); }
__device__ __forceinline__ float gelu_t(float x) { return 0.5f * x * (1.f + ftanh(0.7978845608f * (x + 0.044715f * x * x * x))); }
__device__ __forceinline__ float wave_sum(float v) {
#pragma unroll
    for (int o = 1; o < 64; o <<= 1) v += __shfl_xor(v, o);
    return v;
}
#define XB_TMO      128
#define XB_XCNT(j)  (256  + 64 * (j))
#define XB_XSUB(j)  (1280 + 64 * (j))
#define XB_XGEN(j)  (2304 + 64 * (j))
#define XB_TOP      3328
#define XB_TOPGEN   3392
#define XCD_BAR_WORDS 3456
#define XB_SPIN_CAP (1u << 18)

__device__ __forceinline__ unsigned xb_ld(unsigned* p)              { return __hip_atomic_load(p, __ATOMIC_RELAXED, __HIP_MEMORY_SCOPE_AGENT); }
__device__ __forceinline__ unsigned xb_add(unsigned* p, unsigned v) { return __hip_atomic_fetch_add(p, v, __ATOMIC_RELAXED, __HIP_MEMORY_SCOPE_AGENT); }
__device__ __forceinline__ unsigned xb_xcc_id() { return (unsigned)__builtin_amdgcn_s_getreg((3 << 11) | 20) & 0xFu; }
#define XB_SPIN(cond, bar) do { unsigned _sp = 0; while (cond) { __builtin_amdgcn_s_sleep(1); \
    if ((++_sp & 255u) == 0u) { if (xb_ld(&(bar)[XB_TMO])) break; if (_sp > XB_SPIN_CAP) { atomicAdd(&(bar)[XB_TMO], 1u); break; } } } } while (0)

struct XcdBarrier {
    unsigned* bar; unsigned x;
    volatile LAS unsigned* st;
};

__device__ __forceinline__ XcdBarrier xcd_barrier_post(unsigned* bar, volatile LAS unsigned* st) {
    XcdBarrier b; b.bar = bar; b.x = xb_xcc_id(); b.st = st;
    if (threadIdx.x == 0) (void)xb_add(&bar[XB_XCNT(b.x)], 1u);
    return b;
}
__device__ __forceinline__ void xcd_barrier_complete(unsigned* bar, unsigned x, unsigned& nloc, unsigned& nx) {
    const unsigned G = gridDim.x * gridDim.y * gridDim.z;
    unsigned sum, cnt, mine, sp = 0u;
    for (;;) {
        sum = 0u; cnt = 0u; mine = 0u;
#pragma unroll
        for (unsigned j = 0; j < 16; ++j) { const unsigned c = xb_ld(&bar[XB_XCNT(j)]); sum += c; cnt += (c > 0u) ? 1u : 0u; mine = (j == x) ? c : mine; }
        if (sum == G) break;
        __builtin_amdgcn_s_sleep(1);
        if ((++sp & 255u) == 0u) { if (xb_ld(&bar[XB_TMO])) break; if (sp > XB_SPIN_CAP) { atomicAdd(&bar[XB_TMO], 1u); break; } }
    }
    nloc = mine > 0u ? mine : 1u; nx = cnt > 0u ? cnt : 1u;
}

__device__ __forceinline__ void xcd_barrier(const XcdBarrier& b) {
    asm volatile("s_waitcnt vmcnt(0)" ::: "memory");
    __syncthreads();
    if (threadIdx.x == 0) {
        unsigned* bar = b.bar;
        __builtin_amdgcn_s_waitcnt(0);
        unsigned nloc = b.st[0], nx = b.st[1];
        if (nloc == 0u) { xcd_barrier_complete(bar, b.x, nloc, nx); b.st[0] = nloc; b.st[1] = nx; }
        const unsigned old = xb_add(&bar[XB_XSUB(b.x)], 1u);
        const unsigned gen = old / nloc;
        if (old + 1u == (gen + 1u) * nloc) {
            __builtin_amdgcn_fence(__ATOMIC_RELEASE, "agent");
            asm volatile("s_waitcnt vmcnt(0)" ::: "memory");
            const unsigned og = xb_add(&bar[XB_TOP], 1u);
            const unsigned tg = og / nx;
            if (og + 1u == (tg + 1u) * nx) xb_add(&bar[XB_TOPGEN], 1u);
            else XB_SPIN(xb_ld(&bar[XB_TOPGEN]) == tg, bar);
            __builtin_amdgcn_fence(__ATOMIC_ACQUIRE, "agent");
            xb_add(&bar[XB_XGEN(b.x)], 1u);
            asm volatile("s_waitcnt vmcnt(0)" ::: "memory");
        } else {
            XB_SPIN(xb_ld(&bar[XB_XGEN(b.x)]) == gen, bar);
            __builtin_amdgcn_fence(__ATOMIC_ACQUIRE, "agent");
            asm volatile("s_waitcnt vmcnt(0)" ::: "memory");
        }
    }
    __syncthreads();
}

struct Args { const float* in[31]; float* out; unsigned char* ws; int ph_lo, ph_hi; };
enum In { I_X = 0, I_C, I_CTX, I_CCTX, I_WADA, I_BADA, I_NORMG, I_FFNIN, I_FFNOUT, I_WIN, I_GMVN, I_GMWS, I_GMBS, I_CONV, I_W0, I_WUP, I_A0, I_AUP, I_GUP, I_KK, I_KA, I_RK, I_LNG, I_LNB,
          I_QN, I_KN, I_LAM, I_SUBLN, I_WBR, I_BGATE, I_WOUT };

__device__ __forceinline__ void ph_ada(const Args& a, int l, LAS unsigned char* lds, int tid, int vcu, int G) {
    LAS float* sc = (LAS float*)lds;
    LAS float* red = sc + 3 * 2048;
    const float* c = a.in[I_C]; const float* cc = a.in[I_CCTX];
    for (int i = tid; i < 3 * 2048; i += NTHR) { const float x = i < 4096 ? c[i] : cc[i - 4096]; sc[i] = x * fsigm(x); }
    __syncthreads();
    const int lane = tid & 63, wave = tid >> 6;
    float* mods = (float*)(a.ws + WS_MODS);
    for (int u = vcu; u < 288; u += G) {
        const int jc = u, j = jc * 64 + lane;
        const float* W = a.in[I_WADA] + (size_t)l * 2048 * 18432 + j;
        float s0 = 0.f, s1 = 0.f, s2 = 0.f;
        const int k0 = wave * 256;
#pragma unroll 16
        for (int k = 0; k < 256; ++k) { const float w = W[(size_t)(k0 + k) * 18432]; s0 += sc[k0 + k] * w; s1 += sc[2048 + k0 + k] * w; s2 += sc[4096 + k0 + k] * w; }
        red[(wave * 3 + 0) * 64 + lane] = s0; red[(wave * 3 + 1) * 64 + lane] = s1; red[(wave * 3 + 2) * 64 + lane] = s2;
        __syncthreads();
        if (wave < 3) { float s = a.in[I_BADA][(size_t)l * 18432 + j];
#pragma unroll
            for (int w8 = 0; w8 < 8; ++w8) s += red[(w8 * 3 + wave) * 64 + lane];
            mods[(size_t)(l * 3 + wave) * 18432 + j] = s; }
        __syncthreads();
    }
}
__device__ __forceinline__ void transpose_item(const float* W, int N, int sc0, bf16* WT, int Kd, int nd0, int k0, LAS float* scr, int lane, bool permq = false) {
    if (sc0 >= 0) {
#pragma unroll
        for (int i = 0; i < 32; ++i) { const int kk = 2 * i + (lane >> 5); scr[kk * 33 + (lane & 31)] = W[(size_t)(k0 + kk) * N + sc0 + (lane & 31)]; }
    } else {
#pragma unroll 8
        for (int i = 0; i < 32; ++i) { const int kk = 2 * i + (lane >> 5); scr[kk * 33 + (lane & 31)] = 0.f; }
    }
    asm volatile("s_waitcnt lgkmcnt(0)" ::: "memory");
    const int c = lane & 7;
#pragma unroll
    for (int j = 0; j < 4; ++j) { const int n = (lane >> 3) + 8 * j;
        const int ns = permq ? (((n & 7) < 4) ? 4 * (n >> 3) + (n & 7) : 16 + 4 * (n >> 3) + (n & 7) - 4) : n;
        const LAS float* s = scr + (8 * c) * 33 + ns;
        v4u o; o.x = pk2(s[0 * 33], s[1 * 33]); o.y = pk2(s[2 * 33], s[3 * 33]); o.z = pk2(s[4 * 33], s[5 * 33]); o.w = pk2(s[6 * 33], s[7 * 33]);
        *(GAS v4u*)(WT + (size_t)(nd0 + n) * Kd + k0 + 8 * c) = o; }
    asm volatile("s_waitcnt lgkmcnt(0)" ::: "memory");
}
__device__ __forceinline__ void ph_weights(const Args& a, int l, LAS unsigned char* lds, int tid, int vcu, int G) {
    const int lane = tid & 63, wave = tid >> 6;
    LAS float* scr = (LAS float*)(lds + wave * 16384);
    const int gw = vcu * NWAVES + wave, NGW = G * NWAVES;
    constexpr int I_F1 = 32 * (FF2 / 32), I_F2 = (FF / 64) * (DM / 32), I_IN = 32 * (PROJP / 32), I_BR = 16 * (DM / 32), I_WO = 32 * (DM / 32);
    constexpr int NITEMS = 2 * I_F1 + 2 * I_F2 + I_IN + 3 * I_BR + I_WO;
    unsigned char* ws = a.ws;
    for (int it = gw; it < NITEMS; it += NGW) {
        int r = it;
        if (r < 2 * I_F1) { const int mi = l * 2 + r / I_F1, q = r % I_F1, nb = q % (FF2 / 32), kb = q / (FF2 / 32), nd0 = 32 * nb, pn = nd0 >> 8, rr = nd0 & 255;
            const int sc0 = rr < 128 ? pn * 128 + rr : FF + pn * 128 + (rr - 128);
            transpose_item(a.in[I_FFNIN] + (size_t)mi * DM * FF2, FF2, sc0, (bf16*)(ws + WS_WF1 + (size_t)mi * SZ_WF1), DM, nd0, 64 * kb, scr, lane); continue; }
        r -= 2 * I_F1;
        if (r < 2 * I_F2) { const int mi = l * 2 + r / I_F2, q = r % I_F2, nb = q % (DM / 32), kb = q / (DM / 32);
            transpose_item(a.in[I_FFNOUT] + (size_t)mi * FF * DM, DM, 32 * nb, (bf16*)(ws + WS_WF2 + (size_t)mi * SZ_WF2), FF, 32 * nb, 64 * kb, scr, lane); continue; }
        r -= 2 * I_F2;
        if (r < I_IN) { const int mi = l, q = r, nb = q % (PROJP / 32), kb = q / (PROJP / 32), nd0 = 32 * nb, T = nd0 >> 8, cc = nd0 & 255;
            int sc0; bool pq = false;
            if (T <= 21) sc0 = nd0;
            else if (T == 22) sc0 = cc < 128 ? nd0 : -1;
            else if (T <= 30) { sc0 = P_QKV + ((T - 23) * 4 + ((cc >> 5) & 3)) * 64 + (cc >> 7) * 32; pq = true; }
            else if (T <= 34) sc0 = P_QKV + 2048 + (nd0 - 31 * 256);
            else sc0 = P_GATE + (nd0 - 35 * 256);
            transpose_item(a.in[I_WIN] + (size_t)mi * DM * PROJ, PROJ, sc0, (bf16*)(ws + WS_WIN + (size_t)mi * SZ_WIN), DM, nd0, 64 * kb, scr, lane, pq); continue; }
        r -= I_IN;
        if (r < 3 * I_BR) { const int mi = l * 3 + r / I_BR, q = r % I_BR, nb = q % (DM / 32), kb = q / (DM / 32);
            transpose_item(a.in[I_WBR] + (size_t)mi * 1024 * DM, DM, 32 * nb, (bf16*)(ws + WS_WBR + (size_t)mi * ((size_t)DM * 1024 * 2)), 1024, 32 * nb, 64 * kb, scr, lane); continue; }
        r -= 3 * I_BR;
        { const int mi = l, q = r, nb = q % (DM / 32), kb = q / (DM / 32);
            transpose_item(a.in[I_WOUT] + (size_t)mi * DM * DM, DM, 32 * nb, (bf16*)(ws + WS_WOUT + (size_t)mi * SZ_WOUT), DM, 32 * nb, 64 * kb, scr, lane); }
    }
}
__device__ __forceinline__ void ph_small(const Args& a, int tid, int vcu, int G) {
    unsigned char* ws = a.ws;
    const int gt = vcu * NTHR + tid, NGT = G * NTHR;
    for (int i = gt; i < NLAYER * LOW * (ACTW / 8); i += NGT) {
        const int l = i / (LOW * (ACTW / 8)), q = i % (LOW * (ACTW / 8)), n = q / (ACTW / 8), k0 = (q % (ACTW / 8)) * 8, sec = n >> 10, cc = n & 1023;
        float f[8];
#pragma unroll
        for (int e = 0; e < 8; ++e) { const int k = k0 + e; float v = 0.f;
            if (sec == 0) { if (k < 256) v = a.in[I_GUP][((size_t)l * 256 + k) * 1024 + cc]; }
            else if (sec <= 2) { const int d = sec - 1, kb = 256 + 128 * d; if (k >= kb && k < kb + 96) v = a.in[I_WUP][((size_t)(l * 2 + d) * 96 + (k - kb)) * 1024 + cc]; }
            else { const int d = sec - 3, kb = 512 + 128 * d; if (k >= kb && k < kb + 96) v = a.in[I_AUP][((size_t)(l * 2 + d) * 96 + (k - kb)) * 1024 + cc]; }
            f[e] = v; }
        *(GAS v4u*)((bf16*)(ws + WS_WLO) + ((size_t)l * LOW + n) * ACTW + k0) = pack8(f);
    }
    for (int i = gt; i < 64 * 16; i += NGT) { const int p = i >> 4, ii = i & 15;
        const float inv = exp2f(-(float)(2 * ii) * (1.f / 32.f) * 13.287712379549449f);
        const float rev = (float)p * inv * 0.15915494309189535f;
        float* rt = (float*)(ws + WS_ROPE) + 2 * i; rt[0] = __builtin_amdgcn_cosf(rev); rt[1] = __builtin_amdgcn_sinf(rev); }
}

__device__ __forceinline__ void norm_row_store(f32x4 (&v)[8], int m, const float* gain, const float* mods, int si, bf16* XN, int lane) {
    float ss = 0.f;
#pragma unroll
    for (int j = 0; j < 8; ++j) ss += (v[j].x * v[j].x + v[j].y * v[j].y) + (v[j].z * v[j].z + v[j].w * v[j].w);
    const float rinv = 1.f / sqrtf(wave_sum(ss) * (1.f / DM) + 1e-6f);
    const int set = m < TSEQ ? 0 : (m < NLAT ? 1 : 2);
    const float* sh = mods + (size_t)(set * NMOD + si) * DM; const float* scl = sh + DM;
#pragma unroll
    for (int j = 0; j < 8; ++j) { const int col = 4 * lane + 256 * j;
        const f32x4 g = *(const GAS f32x4*)(gain + col), s1 = *(const GAS f32x4*)(scl + col), s0 = *(const GAS f32x4*)(sh + col);
        const f32x4 o = (v[j] * rinv * g) * (s1 + 1.f) + s0;
        v2u w; w.x = pk2(o.x, o.y); w.y = pk2(o.z, o.w);
        *(GAS v2u*)(XN + (size_t)m * DM + col) = w; }
}
__device__ __forceinline__ void ph_norm(const float* xl, const float* xc, const float* gain, const float* mods  , int si, bf16* XN, float* xs_out, const bf16* part, int nsplit, int nrows, int gw, int NGW, int lane) {
    for (int m = gw; m < NLAT; m += 2 * NGW) {
        const int m2 = m + NGW; const bool two = m2 < NLAT;
        f32x4 v[8], u[8];
#pragma unroll
        for (int j = 0; j < 8; ++j) v[j] = *(const GAS f32x4*)(xl + (size_t)m * DM + 4 * lane + 256 * j);
        if (two) {
#pragma unroll
            for (int j = 0; j < 8; ++j) u[j] = *(const GAS f32x4*)(xl + (size_t)m2 * DM + 4 * lane + 256 * j); }
        norm_row_store(v, m, gain, mods, si, XN, lane);
        if (two) norm_row_store(u, m2, gain, mods, si, XN, lane);
    }
    if (nrows > NLAT && (gw & 3) == 0) for (int r = gw >> 2; r < NCTX; r += NGW >> 2) {
        const int m = NLAT + r;
        f32x4 v[8];
#pragma unroll
        for (int j = 0; j < 8; ++j) v[j] = *(const GAS f32x4*)(xc + (size_t)r * DM + 4 * lane + 256 * j);
        if (part != nullptr)
#pragma nounroll
        for (int s = 0; s < nsplit; s += 4) {
            v2u p[4][8];
#pragma unroll
            for (int q = 0; q < 4; ++q)
#pragma unroll
                for (int j = 0; j < 8; ++j) p[q][j] = *(const GAS v2u*)(part + ((size_t)(s + q) * NCTX + r) * DM + 4 * lane + 256 * j);
#pragma unroll
            for (int q = 0; q < 4; ++q)
#pragma unroll
                for (int j = 0; j < 8; ++j) { v[j].x += bflo(p[q][j].x); v[j].y += bfhi(p[q][j].x); v[j].z += bflo(p[q][j].y); v[j].w += bfhi(p[q][j].y); } }
#pragma unroll
        for (int j = 0; j < 8; ++j) *(GAS f32x4*)(xs_out + (size_t)m * DM + 4 * lane + 256 * j) = v[j];
        norm_row_store(v, m, gain, mods, si, XN, lane);
    }
}

struct RkvkItem { v4u x[3][3]; int m, c0; bool hp, hn; };
__device__ __forceinline__ void rkvk_load(RkvkItem& it, const bf16* P, int i) {
    const int m = i >> 7, c0 = (i & 127) * 8; it.m = m; it.c0 = c0;
    const int t = m < NLAT ? (m & (TSEQ - 1)) : ((m - NLAT) & (TCTX - 1)), tl = m < NLAT ? TSEQ : TCTX;
    it.hp = t > 0; it.hn = t < tl - 1;
#pragma unroll
    for (int sec = 0; sec < 3; ++sec) { const bf16* pc = P + (size_t)m * PROJP + P_RKV + sec * 1024 + c0;
        it.x[sec][1] = *(const GAS v4u*)pc;
        it.x[sec][0] = it.hp ? *(const GAS v4u*)(pc - PROJP) : (v4u){0u, 0u, 0u, 0u};
        it.x[sec][2] = it.hn ? *(const GAS v4u*)(pc + PROJP) : (v4u){0u, 0u, 0u, 0u}; }
}
__device__ __forceinline__ void rkvk_finish(const RkvkItem& it, bf16* RK, const float* cw, const float* kkw) {
    const int c0 = it.c0; float rkv[3][8];
#pragma unroll
    for (int sec = 0; sec < 3; ++sec) { const int col = sec * 1024 + c0; float x0[8], x1[8], x2[8];
        unpack8(it.x[sec][0], x0); unpack8(it.x[sec][1], x1); unpack8(it.x[sec][2], x2);
#pragma unroll
        for (int e = 0; e < 8; ++e) rkv[sec][e] = x1[e] * cw[3072 + col + e] + x0[e] * cw[col + e] + x2[e] * cw[2 * 3072 + col + e]; }
    float kk8[8]; float ss = 0.f;
#pragma unroll
    for (int e = 0; e < 8; ++e) { kk8[e] = rkv[1][e] * kkw[c0 + e]; ss += kk8[e] * kk8[e]; }
    ss += __shfl_xor(ss, 1); ss += __shfl_xor(ss, 2); ss += __shfl_xor(ss, 4);
    const float rinv = 1.f / sqrtf(ss + 1e-12f);
    GAS v4u* dst = (GAS v4u*)(RK + (size_t)it.m * 4096 + c0 * 4);
#pragma unroll
    for (int j = 0; j < 4; ++j) { v4u o; o.x = pk2(rkv[0][2 * j], rkv[1][2 * j]); o.y = pk2(rkv[2][2 * j], kk8[2 * j] * rinv); o.z = pk2(rkv[0][2 * j + 1], rkv[1][2 * j + 1]); o.w = pk2(rkv[2][2 * j + 1], kk8[2 * j + 1] * rinv); dst[j] = o; }
}
__device__ __forceinline__ void ph_e1(const Args& a, int l, int gt, int NGT) {
    const bf16* P = (const bf16*)(a.ws + WS_P); bf16* RK = (bf16*)(a.ws + WS_RKVK);
    const float* cw = a.in[I_CONV] + (size_t)l * 3 * 3072; const float* kkw = a.in[I_KK] + l * 1024;
    constexpr int NI = MT * 128;
    for (int i = gt; i < NI; i += 2 * NGT) {
        RkvkItem A, B; const bool two = i + NGT < NI;
        rkvk_load(A, P, i); if (two) rkvk_load(B, P, i + NGT);
        rkvk_finish(A, RK, cw, kkw); if (two) rkvk_finish(B, RK, cw, kkw);
    }
}

__device__ __forceinline__ void ph_gmlp(const Args& a, int l, LAS unsigned char* lds, int tid, int vcu, int G) {
    constexpr int VP = 136;
    LAS bf16* vnT = (LAS bf16*)lds;
    const bf16* P = (const bf16*)(a.ws + WS_P); bf16* YA = (bf16*)(a.ws + WS_Y3);
    const float* vng = a.in[I_GMVN] + l * 1024; const float* wsm = a.in[I_GMWS] + (size_t)l * 8 * 128 * 128; const float* bs = a.in[I_GMBS] + l * 8 * 128;
    const int lane = tid & 63, w = tid >> 6, fr = lane & 15, fq = lane >> 4;
    for (int u = vcu; u < (MT / 128) * 8; u += G) {
        const int n = u >> 3, g = u & 7, m0 = n * 128;
        { const int q = tid >> 2, qt = tid & 3; const bf16* src = P + (size_t)(m0 + q) * PROJP + P_V + g * 128 + qt * 32;
            float v[32]; float ss = 0.f;
#pragma unroll
            for (int j = 0; j < 4; ++j) { float f[8]; unpack8(*(const GAS v4u*)(src + 8 * j), f);
#pragma unroll
                for (int e = 0; e < 8; ++e) { const float x = f[e]; v[8 * j + e] = x; ss += x * x; } }
            ss += __shfl_xor(ss, 1); ss += __shfl_xor(ss, 2);
            const float rinv = 1.f / sqrtf(ss * (1.f / 128.f) + 1e-6f);
#pragma unroll
            for (int e = 0; e < 32; ++e) { const int c = qt * 32 + e; vnT[c * VP + q] = (bf16)f2bf(v[e] * rinv * vng[g * 128 + c]); } }
        __syncthreads();
        pg8::f32x4 acc[8];
#pragma unroll
        for (int cb = 0; cb < 8; ++cb) acc[cb] = (pg8::f32x4){0.f, 0.f, 0.f, 0.f};
#pragma unroll
        for (int ks = 0; ks < 4; ++ks) {
            const float* wr = wsm + ((size_t)g * 128 + 16 * w + fr) * 128 + ks * 32 + 8 * fq;
            const f32x4 w0 = *(const GAS f32x4*)wr, w1 = *(const GAS f32x4*)(wr + 4);
            v4u aw; aw.x = pk2(w0.x, w0.y); aw.y = pk2(w0.z, w0.w); aw.z = pk2(w1.x, w1.y); aw.w = pk2(w1.z, w1.w);
            const bf16x8 af = __builtin_bit_cast(bf16x8, aw);
#pragma unroll
            for (int cb = 0; cb < 8; ++cb) { const bf16x8 bfr = *(const LAS bf16x8*)(vnT + (cb * 16 + fr) * VP + ks * 32 + 8 * fq);
                acc[cb] = __builtin_amdgcn_mfma_f32_16x16x32_bf16(af, bfr, acc[cb], 0, 0, 0); }
        }
#pragma unroll
        for (int cb = 0; cb < 8; ++cb)
#pragma unroll
            for (int i = 0; i < 4; ++i) { const int p = 16 * w + 4 * fq + i, c = cb * 16 + fr;
                const float pu = bf1(P[(size_t)(m0 + p) * PROJP + P_U + g * 128 + c]);
                YA[(size_t)(m0 + p) * 1024 + g * 128 + c] = (bf16)f2bf(pu * (acc[cb][i] + bs[g * 128 + p])); }
        __syncthreads();
    }
}

namespace att {
using bf16x8 = __attribute__((ext_vector_type(8))) short;
using s16x4  = __attribute__((ext_vector_type(4))) short;
using f32x16 = __attribute__((ext_vector_type(16))) float;
using u32x4  = __attribute__((ext_vector_type(4))) unsigned;
constexpr int NW = 8, QBLK = 32, KVBLK = 64;
constexpr int SHM_V = KVBLK * 128 * 2, SHM_K = KVBLK * 64 * 2, SHM_ATTN = 2 * SHM_V + 2 * SHM_K + NW * 64 * 4;
#define KSWZ(row, colB) ((row) * 128 + ((colB) ^ ((((row) >> 1) & 7) << 4)))
#define SBAR() __builtin_amdgcn_sched_barrier(0)
__device__ __forceinline__ int crow(int r, int hi) { return (r & 3) + 8 * (r >> 2) + 4 * hi; }
__device__ __forceinline__ unsigned cvtpk(float lo, float hi) { unsigned r; asm volatile("v_cvt_pk_bf16_f32 %0, %1, %2" : "=v"(r) : "v"(lo), "v"(hi)); return r; }
__device__ __forceinline__ void partialSM(f32x16& p0, f32x16& p1) {
#pragma unroll
  for (int r = 0; r < 16; ++r) p0[r] = __builtin_amdgcn_exp2f(p0[r]);
}
__device__ __forceinline__ void finishSM(f32x16& p0, f32x16& p1, float& l_reg, bf16x8& pa0, bf16x8& pa1, bf16x8& pa2, bf16x8& pa3) {
#pragma unroll
  for (int r = 0; r < 16; ++r) p1[r] = __builtin_amdgcn_exp2f(p1[r]);
  float ps = 0;
#pragma unroll
  for (int r = 0; r < 16; ++r) ps += p0[r];
#pragma unroll
  for (int r = 0; r < 16; ++r) ps += p1[r];
  { auto rr = __builtin_amdgcn_permlane32_swap(__float_as_uint(ps), __float_as_uint(ps), false, false);
    ps = __uint_as_float(rr[0]) + __uint_as_float(rr[1]); }
  l_reg += ps;
#define PK4(P, BASE, OUT) do { unsigned a0 = cvtpk(P[BASE + 0], P[BASE + 1]), a1 = cvtpk(P[BASE + 2], P[BASE + 3]);   \
    unsigned b0 = cvtpk(P[BASE + 4], P[BASE + 5]), b1 = cvtpk(P[BASE + 6], P[BASE + 7]);                              \
    auto r0 = __builtin_amdgcn_permlane32_swap(a0, b0, false, false); auto r1 = __builtin_amdgcn_permlane32_swap(a1, b1, false, false); \
    u32x4 w = {r0[0], r1[0], r0[1], r1[1]}; OUT = *reinterpret_cast<bf16x8*>(&w); } while (0)
  PK4(p0, 0, pa0); PK4(p0, 8, pa1); PK4(p1, 0, pa2); PK4(p1, 8, pa3);
#undef PK4
}
__device__ __forceinline__ void qkt(f32x16& p0, f32x16& p1, const unsigned short* Ks, const bf16x8* qr, int r32, int hi) {
  p0 = f32x16{}; p1 = f32x16{};
#pragma unroll
  for (int d0 = 0; d0 < 4; ++d0) { int cb = (d0 * 16 + hi * 8) * 2;
    bf16x8 b0 = *reinterpret_cast<const bf16x8*>((const char*)Ks + KSWZ(r32, cb));
    bf16x8 b1 = *reinterpret_cast<const bf16x8*>((const char*)Ks + KSWZ(32 + r32, cb));
    p0 = __builtin_amdgcn_mfma_f32_32x32x16_bf16(b0, qr[d0], p0, 0, 0, 0);
    p1 = __builtin_amdgcn_mfma_f32_32x32x16_bf16(b1, qr[d0], p1, 0, 0, 0); }
}
__device__ __forceinline__ int v_st(int k, int c) { const int kk = (k & ~0xC) | ((k & 4) << 1) | ((k & 8) >> 1); return ((kk >> 3) * 4 + (c >> 5)) * 512 + ((kk & 7) * 32 + (c & 31)) * 2; }
__device__ __forceinline__ int v_rd_base(int lane) { return ((lane & 3) << 3) | (((lane >> 2) & 3) << 6) | (((lane >> 4) & 1) << 5) | (((lane >> 5) & 1) << 8); }
constexpr int v_rd_off(int d0, int ks, int half) { return d0 * 512 + ks * 4096 + half * 2048; }
template <int OFF> __device__ __forceinline__ s16x4 tr_read(int vb) {
  s16x4 r; asm volatile("ds_read_b64_tr_b16 %0, %1 offset:%2" : "=&v"(r) : "v"(vb), "i"(OFF) : "memory"); return r;
}
template <int D0> __device__ __forceinline__ void pv_one(f32x16& od, int vb, bf16x8 pa0, bf16x8 pa1, bf16x8 pa2, bf16x8 pa3) {
  const s16x4 l0 = tr_read<v_rd_off(D0, 0, 0)>(vb), h0 = tr_read<v_rd_off(D0, 0, 1)>(vb), l1 = tr_read<v_rd_off(D0, 1, 0)>(vb), h1 = tr_read<v_rd_off(D0, 1, 1)>(vb);
  const s16x4 l2 = tr_read<v_rd_off(D0, 2, 0)>(vb), h2 = tr_read<v_rd_off(D0, 2, 1)>(vb), l3 = tr_read<v_rd_off(D0, 3, 0)>(vb), h3 = tr_read<v_rd_off(D0, 3, 1)>(vb);
  asm volatile("s_waitcnt lgkmcnt(0)" ::: "memory"); SBAR();
#define PK(L, H) (bf16x8){L[0], L[1], L[2], L[3], H[0], H[1], H[2], H[3]}
  od = __builtin_amdgcn_mfma_f32_32x32x16_bf16(pa0, PK(l0, h0), od, 0, 0, 0);
  od = __builtin_amdgcn_mfma_f32_32x32x16_bf16(pa1, PK(l1, h1), od, 0, 0, 0);
  od = __builtin_amdgcn_mfma_f32_32x32x16_bf16(pa2, PK(l2, h2), od, 0, 0, 0);
  od = __builtin_amdgcn_mfma_f32_32x32x16_bf16(pa3, PK(l3, h3), od, 0, 0, 0);
#undef PK
}
__device__ __forceinline__ void pv_d0(f32x16* o, int vb, bf16x8 pa0, bf16x8 pa1, bf16x8 pa2, bf16x8 pa3) {
  pv_one<0>(o[0], vb, pa0, pa1, pa2, pa3); pv_one<1>(o[1], vb, pa0, pa1, pa2, pa3); pv_one<2>(o[2], vb, pa0, pa1, pa2, pa3); pv_one<3>(o[3], vb, pa0, pa1, pa2, pa3);
}
__device__ __forceinline__ void attn_unit(const unsigned short* __restrict__ Qb, const unsigned short* __restrict__ Kb, const unsigned short* __restrict__ Vb,
                                          unsigned short* __restrict__ Ob, int NT, int ntl, int klat, int kctx, char* lds) {
  constexpr int LDQ = 2048, LDKK = 2048, LDV = 15104, LDO = 1024;
  const int tid = threadIdx.x, wid = tid >> 6, lane = tid & 63, r32 = lane & 31, hi = lane >> 5;
  unsigned short* V_lds = (unsigned short*)lds; unsigned short* K_lds = (unsigned short*)(lds + 2 * SHM_V);
  float* ws = (float*)(lds + 2 * SHM_V + 2 * SHM_K) + wid * 64; float* li_l = ws;
  float l_reg = 0; f32x16 o[4] = {}; bf16x8 qr[4];
  const unsigned short* Qw = Qb + (long)(wid * QBLK + r32) * LDQ + hi * 8;
#pragma unroll
  for (int d0 = 0; d0 < 4; ++d0) qr[d0] = *reinterpret_cast<const bf16x8*>(Qw + d0 * 16);
  const int sr = tid >> 4, sc = (tid & 15) * 8, vst0 = v_st(sr, sc), vst1 = v_st(32 + sr, sc);
  const int kr = tid >> 3, kc = (tid & 7) * 8, kst = KSWZ(kr, kc * 2);
  const int vb0 = (int)(uintptr_t)V_lds + v_rd_base(lane);
  struct { bf16x8 vs0, vs1, ks0; } sr_[2];
#define KROW(t) ((t) < ntl ? klat + 64 * (t) : kctx + 64 * ((t) - ntl))
#define SLOAD(i, t) do { const long k0_ = KROW(t); sr_[i].vs0 = *reinterpret_cast<const bf16x8*>(&Vb[(k0_ + sr) * LDV + sc]); sr_[i].vs1 = *reinterpret_cast<const bf16x8*>(&Vb[(k0_ + 32 + sr) * LDV + sc]); \
    sr_[i].ks0 = *reinterpret_cast<const bf16x8*>(&Kb[(k0_ + kr) * LDKK + kc]); } while (0)
#define SWRITE(b, i) do { *(bf16x8*)((char*)V_lds + (b) * SHM_V + vst0) = sr_[i].vs0; *(bf16x8*)((char*)V_lds + (b) * SHM_V + vst1) = sr_[i].vs1; \
    *(bf16x8*)((char*)K_lds + (b) * SHM_K + kst) = sr_[i].ks0; } while (0)
#define SWAIT() asm volatile("s_waitcnt vmcnt(3)" ::: "memory")
  f32x16 pA0, pA1, pB0, pB1; bf16x8 pa0, pa1, pa2, pa3;
  constexpr int SE = 0, SO = 1;
  SLOAD(SE, 0); asm volatile("s_waitcnt vmcnt(0)" ::: "memory"); SWRITE(0, SE); __syncthreads();
  qkt(pA0, pA1, K_lds, qr, r32, hi); partialSM(pA0, pA1);
  SLOAD(SO, 1); if (2 < NT) SLOAD(SE, 2);
  SWAIT(); SWRITE(1, SO); __syncthreads();
  for (int j = 1; j + 1 < NT; j += 2) {
    SBAR(); qkt(pB0, pB1, (const unsigned short*)((char*)K_lds + SHM_K), qr, r32, hi);
    finishSM(pA0, pA1, l_reg, pa0, pa1, pa2, pa3); SBAR();
    SLOAD(SO, j + 2); SBAR();
    pv_d0(o, vb0, pa0, pa1, pa2, pa3); partialSM(pB0, pB1);
    __syncthreads(); SWAIT(); SWRITE(0, SE);
    __syncthreads();
    SBAR(); qkt(pA0, pA1, K_lds, qr, r32, hi);
    finishSM(pB0, pB1, l_reg, pa0, pa1, pa2, pa3); SBAR();
    if (j + 3 < NT) SLOAD(SE, j + 3); SBAR();
    pv_d0(o, vb0 + (int)SHM_V, pa0, pa1, pa2, pa3); partialSM(pA0, pA1);
    __syncthreads(); SWAIT(); SWRITE(1, SO);
    __syncthreads();
  }
  SBAR(); qkt(pB0, pB1, (const unsigned short*)((char*)K_lds + SHM_K), qr, r32, hi);
  finishSM(pA0, pA1, l_reg, pa0, pa1, pa2, pa3); SBAR();
  pv_d0(o, vb0, pa0, pa1, pa2, pa3); partialSM(pB0, pB1);
  __syncthreads();
  finishSM(pB0, pB1, l_reg, pa0, pa1, pa2, pa3); SBAR();
  pv_d0(o, vb0 + (int)SHM_V, pa0, pa1, pa2, pa3);
  if (hi == 0) li_l[r32] = l_reg; asm volatile("s_waitcnt lgkmcnt(0)" ::: "memory");
  float rli[16];
#pragma unroll
  for (int r = 0; r < 16; ++r) rli[r] = __builtin_amdgcn_rcpf(li_l[crow(r, hi)]);
  unsigned short* Ow = Ob + (long)(wid * QBLK) * LDO;
#pragma unroll
  for (int r = 0; r < 16; ++r) { int orow = crow(r, hi);
#pragma unroll
    for (int d0 = 0; d0 < 4; ++d0) Ow[(long)orow * LDO + d0 * 32 + r32] = (unsigned short)(cvtpk(o[d0][r] * rli[r], 0.f) & 0xffffu); }
  __syncthreads();
#undef KROW
#undef SLOAD
#undef SWRITE
#undef SWAIT
}
#undef KSWZ
#undef SBAR
}

__device__ __forceinline__ void ph_attn(const Args& a, bool ctx_out, char* lds, int widx, int wstride) {
    const unsigned short* QK = (const unsigned short*)(a.ws + WS_QK); const unsigned short* P = (const unsigned short*)(a.ws + WS_P); unsigned short* OJ = (unsigned short*)(a.ws + WS_OJ);
    const int nunits = ctx_out ? 544 : 512;
    for (int u = widx; u < nunits; u += wstride) {
        int b, hj, qrow0, NT, ntl;
        if (u < 512) { b = u >> 8; hj = (u >> 4) & 15; qrow0 = b * TSEQ + (u & 15) * 256; NT = 68; ntl = 64; }
        else { const int uu = u - 512; b = uu >> 4; hj = uu & 15; qrow0 = NLAT + b * TCTX; NT = 4; ntl = 0; }
        att::attn_unit(QK + (size_t)qrow0 * DM + hj * 64, QK + 1024 + hj * 64, P + P_V2 + (hj >> 1) * 128,
                       OJ + ((size_t)(hj & 1) * MT + qrow0) * 1024 + (hj >> 1) * 128, NT, ntl, b * TSEQ, NLAT + b * TCTX, lds);
    }
}

constexpr int SC_PSLOT = 1344, SC_BLK = 32, SC_NP = SC_BLK / 2;
__device__ __forceinline__ int scan_row(int i, int b, int d) { return i < TCTX ? NLAT + b * TCTX + (d ? TCTX - 1 - i : i) : b * TSEQ + (d ? TSEQ - 1 - (i - TCTX) : (i - TCTX)); }
typedef __amdgpu_buffer_rsrc_t rsrc_t;
typedef short s16x4 __attribute__((ext_vector_type(4)));
typedef __bf16 bf16x2_t __attribute__((ext_vector_type(2)));
typedef float f32x2_t __attribute__((ext_vector_type(2)));
__device__ __forceinline__ unsigned cvtpk_c(float lo, float hi) { f32x2_t v = {lo, hi}; bf16x2_t b = __builtin_convertvector(v, bf16x2_t); return __builtin_bit_cast(unsigned, b); }
template <int CTRL> __device__ __forceinline__ float dpp_add(float x) { return x + __builtin_bit_cast(float, __builtin_amdgcn_update_dpp(0, __builtin_bit_cast(int, x), CTRL, 0xf, 0xf, true)); }
__device__ __forceinline__ float reduce8(const float (&a)[8], int lane) {
    float b4[4], c2[2];
#pragma unroll
    for (int k = 0; k < 4; ++k) { auto rr = __builtin_amdgcn_permlane32_swap(__float_as_uint(a[2 * k]), __float_as_uint(a[2 * k + 1]), false, false); b4[k] = __uint_as_float(rr[0]) + __uint_as_float(rr[1]); }
#pragma unroll
    for (int k = 0; k < 2; ++k) { auto rr = __builtin_amdgcn_permlane16_swap(__float_as_uint(b4[2 * k]), __float_as_uint(b4[2 * k + 1]), false, false); c2[k] = __uint_as_float(rr[0]) + __uint_as_float(rr[1]); }
    const bool hi = lane & 8; const float send = hi ? c2[0] : c2[1], keep = hi ? c2[1] : c2[0];
    float d = keep + __builtin_bit_cast(float, __builtin_amdgcn_update_dpp(0, __builtin_bit_cast(int, send), 0x128, 0xf, 0xf, true));
    d = dpp_add<0xB1>(d); d = dpp_add<0x4E>(d); d = dpp_add<0x141>(d);
    return d;
}
constexpr int SC_IMG = 22528, SC_GOFF = SC_NP * SC_PSLOT;
__device__ __forceinline__ void ph_scanprep(const Args& a, int l, int gw, int NGW, int lane) {
    const bf16* LO = (const bf16*)(a.ws + WS_R1); const bf16* RK = (const bf16*)(a.ws + WS_RKVK); unsigned char* IMG = a.ws + WS_IMG;
    constexpr int NBLK = (TCTX + TSEQ) / SC_BLK;
    const int pp = (((lane >> 5) * 4 + ((lane >> 2) & 3)) * 8 + 4 * ((lane >> 4) & 1) + (lane & 3)) * 2;
    for (int it = gw; it < 64 * NBLK; it += NGW) {
        const int u = it / NBLK, blk = it - u * NBLK, b = u >> 5, h = (u >> 1) & 15, d = u & 1;
        const int m0 = scan_row(blk * SC_BLK, b, d), dir = d ? -1 : 1;
        const float kav = a.in[I_KA][l * 1024 + h * 64 + lane];
        const GAS bf16* lo = (const GAS bf16*)(LO + (size_t)m0 * LOW + 1024 + d * 1024 + h * 64 + lane);
        const GAS v2u* rk = (const GAS v2u*)(RK + ((size_t)m0 * 16 + h) * 256) + lane;
        unsigned wr[SC_BLK], ar[SC_BLK]; v2u rec[SC_BLK];
#pragma unroll
        for (int st = 0; st < SC_BLK; ++st) { wr[st] = lo[(long)st * dir * LOW]; ar[st] = lo[(long)st * dir * LOW + 2048]; rec[st] = rk[(long)st * dir * 1024]; }
        asm volatile("s_waitcnt vmcnt(0)" ::: "memory");
        unsigned char* img = IMG + (size_t)it * SC_IMG;
        float g = 1.f;
#pragma unroll
        for (int pq = 0; pq < SC_NP; ++pq) {
            const int qa = 2 * pq, qb = qa + 1;
            const float wa = __builtin_amdgcn_exp2f(-bflo(wr[qa])), wb = __builtin_amdgcn_exp2f(-bflo(wr[qb])), aa = bflo(ar[qa]), ab = bflo(ar[qb]);
            const float g0 = g, ga = g0 * wa, gb = ga * wb; g = gb;
            const float iga = __builtin_amdgcn_rcpf(ga), igb = __builtin_amdgcn_rcpf(gb);
            const float r_a = bflo(rec[qa].x), k_a = bfhi(rec[qa].x), kk_a = bfhi(rec[qa].y);
            const float r_b = bflo(rec[qb].x), k_b = bfhi(rec[qb].x), kk_b = bfhi(rec[qb].y);
            const float kdh_a = k_a * (1.f + (aa - 1.f) * kav) * iga, nbh_a = -(kk_a * aa * iga), kdh_b = k_b * (1.f + (ab - 1.f) * kav) * igb, nbh_b = -(kk_b * ab * igb);
            const float kkh_a = kk_a * g0, kkh_b = kk_b * ga, rh_a = r_a * ga, rh_b = r_b * gb;
            unsigned char* o = img + pq * SC_PSLOT;
            *(GAS v2u*)(o + lane * 8) = (v2u){pg8::cvt_pk_bf16(kdh_a, nbh_a), pg8::cvt_pk_bf16(kdh_b, nbh_b)};
            const unsigned kkp = pg8::cvt_pk_bf16(kkh_a, kkh_b), rp = pg8::cvt_pk_bf16(rh_a, rh_b);
            *(GAS bf16*)(o + 512 + pp) = (bf16)(kkp & 0xffffu); *(GAS bf16*)(o + 640 + pp) = (bf16)(kkp >> 16); *(GAS bf16*)(o + 768 + pp) = (bf16)(rp & 0xffffu); *(GAS bf16*)(o + 896 + pp) = (bf16)(rp >> 16);
            *(GAS unsigned*)(o + 1024 + lane * 4) = (rec[qa].y & 0xffffu) | (rec[qb].y << 16);
            const float pr[8] = {kdh_a * kkh_b, nbh_a * kkh_b, kdh_a * rh_a, nbh_a * rh_a, kdh_a * rh_b, nbh_a * rh_b, kdh_b * rh_b, nbh_b * rh_b};
            const float tot = reduce8(pr, lane);
            if ((lane & 7) == 0) ((GAS float*)(o + 1280))[((lane >> 5) & 1) + 2 * ((lane >> 4) & 1) + 4 * ((lane >> 3) & 1)] = tot;
        }
        ((GAS float*)(img + SC_GOFF))[lane] = g;
    }
}
__device__ __forceinline__ void scan_unit(const Args& a, int l, int u, LAS unsigned char* lds, int tid) {
    const rsrc_t YSr = __builtin_amdgcn_make_buffer_rsrc((void*)(a.ws + WS_YS), 0, 2 * MT * 1024 * 2, 0x00020000);
    const int lane = tid & 63, w = __builtin_amdgcn_readfirstlane(tid >> 6), fr = lane & 15, fq = lane >> 4;
    const int b = u >> 5, h = (u >> 1) & 15, d = u & 1;
    constexpr int NBLK = (TCTX + TSEQ) / SC_BLK;
    const unsigned char* img0 = a.ws + WS_IMG + (size_t)u * NBLK * SC_IMG;
    LAS float* ybase = (LAS float*)(lds + 3 * SC_IMG);
#define SC_DMA(blk_) do { const unsigned char* src_ = img0 + (size_t)(blk_) * SC_IMG + (w - 4) * 1024 + lane * 16; LAS unsigned char* dst_ = lds + ((blk_) % 3) * SC_IMG + (w - 4) * 1024; \
        _Pragma("unroll") for (int ch_ = 0; ch_ < 6; ++ch_) if (ch_ < 5 || w < 6) __builtin_amdgcn_global_load_lds((const unsigned*)(src_ + ch_ * 4096), (LAS unsigned*)(dst_ + ch_ * 4096), 16, 0, 0); } while (0)
    pg8::f32x4 S0 = (pg8::f32x4){0.f, 0.f, 0.f, 0.f}, S1 = S0, S2 = S0, S3 = S0;
    const unsigned mk0 = fq == 0 ? 0xffffffffu : 0u, mk1 = fq == 1 ? 0xffffffffu : 0u, mk2 = fq == 2 ? 0xffffffffu : 0u, mk3 = fq == 3 ? 0xffffffffu : 0u;
    if (w >= 4) { SC_DMA(0); SC_DMA(1); asm volatile("s_waitcnt vmcnt(0)" ::: "memory"); }
    __builtin_amdgcn_s_barrier(); asm volatile("" ::: "memory");
    for (int blk = 0; blk < NBLK; ++blk) {
        LAS unsigned char* buf = lds + (blk % 3) * SC_IMG;
        LAS float* yb = ybase + (blk & 1) * SC_BLK * 64;
        if (w < 4) {
            const int aoff = 512 + (fr & 3) * 128 + 16 * fq;
            v2u Ua, Ub_; unsigned va, vb_; bf16x8 A0a, A1a, A0b_, A1b_; pg8::f32x4 c0a, c1a, c0b_, c1b_;
#define SC_LOAD(S, pi_) do { LAS unsigned char* nb_ = buf + (pi_) * SC_PSLOT; U##S = *(const LAS v2u*)(nb_ + lane * 8); v##S = *(const LAS unsigned*)(nb_ + 1024 + (16 * w + fr) * 4); \
        A0##S = *(const LAS bf16x8*)(nb_ + aoff); A1##S = *(const LAS bf16x8*)(nb_ + aoff + 64); c0##S = *(const LAS pg8::f32x4*)(nb_ + 1280); c1##S = *(const LAS pg8::f32x4*)(nb_ + 1296); } while (0)
#define SC_DO(S, pi_) do { \
        v4u p0_, p1_; \
        p0_.x = cvtpk_c(S0[0], S0[1]); p0_.y = cvtpk_c(S0[2], S0[3]); p0_.z = cvtpk_c(S1[0], S1[1]); p0_.w = cvtpk_c(S1[2], S1[3]); \
        p1_.x = cvtpk_c(S2[0], S2[1]); p1_.y = cvtpk_c(S2[2], S2[3]); p1_.z = cvtpk_c(S3[0], S3[1]); p1_.w = cvtpk_c(S3[2], S3[3]); \
        pg8::f32x4 ac_ = __builtin_amdgcn_mfma_f32_16x16x32_bf16(A0##S, __builtin_bit_cast(bf16x8, p0_), (pg8::f32x4){0.f, 0.f, 0.f, 0.f}, 0, 0, 0); \
        ac_ = __builtin_amdgcn_mfma_f32_16x16x32_bf16(A1##S, __builtin_bit_cast(bf16x8, p1_), ac_, 0, 0, 0); \
        const float va_ = bflo(v##S), vb2_ = bfhi(v##S); \
        const float sa_a = ac_[0], sa_b = ac_[1] + c0##S[0] * va_ + c0##S[1] * sa_a; \
        const float y_a = ac_[2] + c0##S[2] * va_ + c0##S[3] * sa_a, y_b = ac_[3] + c1##S[0] * va_ + c1##S[1] * sa_a + c1##S[2] * vb2_ + c1##S[3] * sa_b; \
        yb[(2 * (pi_)) * 64 + 16 * w + fr] = y_a; yb[(2 * (pi_) + 1) * 64 + 16 * w + fr] = y_b; \
        const unsigned q1_ = cvtpk_c(va_, sa_a), q2_ = cvtpk_c(vb2_, sa_b); \
        const s16x4 ua_ = __builtin_bit_cast(s16x4, U##S); \
        S0 = __builtin_amdgcn_mfma_f32_16x16x16bf16_1k(ua_, __builtin_bit_cast(s16x4, (v2u){q1_ & mk0, q2_ & mk0}), S0, 0, 0, 0); \
        S1 = __builtin_amdgcn_mfma_f32_16x16x16bf16_1k(ua_, __builtin_bit_cast(s16x4, (v2u){q1_ & mk1, q2_ & mk1}), S1, 0, 0, 0); \
        S2 = __builtin_amdgcn_mfma_f32_16x16x16bf16_1k(ua_, __builtin_bit_cast(s16x4, (v2u){q1_ & mk2, q2_ & mk2}), S2, 0, 0, 0); \
        S3 = __builtin_amdgcn_mfma_f32_16x16x16bf16_1k(ua_, __builtin_bit_cast(s16x4, (v2u){q1_ & mk3, q2_ & mk3}), S3, 0, 0, 0); } while (0)
            SC_LOAD(a, 0);
            for (int pi = 0; pi < SC_NP; pi += 2) {
                SC_LOAD(b_, pi + 1);
                SC_DO(a, pi);
                if (pi + 2 < SC_NP) SC_LOAD(a, pi + 2);
                SC_DO(b_, pi + 1);
            }
#undef SC_LOAD
#undef SC_DO
            { const LAS float* G = (const LAS float*)(buf + SC_GOFF) + 4 * fq;
              S0 = S0 * *(const LAS pg8::f32x4*)(G); S1 = S1 * *(const LAS pg8::f32x4*)(G + 16); S2 = S2 * *(const LAS pg8::f32x4*)(G + 32); S3 = S3 * *(const LAS pg8::f32x4*)(G + 48); }
            asm volatile("s_waitcnt lgkmcnt(0)" ::: "memory");
        } else {
            const int hw = w - 4;
            if (blk + 2 < NBLK) SC_DMA(blk + 2);
            if (blk > 0) { const LAS float* ypb = ybase + ((blk - 1) & 1) * SC_BLK * 64;
                const int mp = scan_row((blk - 1) * SC_BLK, b, d), y0 = ((d * MT + mp) * 1024 + h * 64) * 2, ystep = (d ? -1 : 1) * 2048;
#pragma unroll
                for (int q = 0; q < 8; ++q) { const float yv = ypb[(8 * hw + q) * 64 + lane]; __builtin_amdgcn_raw_buffer_store_b16((unsigned short)(cvtpk_c(yv, 0.f) & 0xffffu), YSr, lane * 2, y0 + (8 * hw + q) * ystep, 0); } }
            if (blk + 2 >= NBLK) asm volatile("s_waitcnt vmcnt(0) lgkmcnt(0)" ::: "memory"); else if (hw < 2) asm volatile("s_waitcnt vmcnt(14) lgkmcnt(0)" ::: "memory"); else asm volatile("s_waitcnt vmcnt(13) lgkmcnt(0)" ::: "memory");
        }
        __builtin_amdgcn_s_barrier(); asm volatile("" ::: "memory");
    }
#undef SC_DMA
    if (w >= 4) { const int hw = w - 4; const LAS float* ypb = ybase + ((NBLK - 1) & 1) * SC_BLK * 64;
        const int mp = scan_row((NBLK - 1) * SC_BLK, b, d), y0 = ((d * MT + mp) * 1024 + h * 64) * 2, ystep = (d ? -1 : 1) * 2048;
#pragma unroll
        for (int q = 0; q < 8; ++q) { const float yv = ypb[(8 * hw + q) * 64 + lane]; __builtin_amdgcn_raw_buffer_store_b16((unsigned short)(cvtpk_c(yv, 0.f) & 0xffffu), YSr, lane * 2, y0 + (8 * hw + q) * ystep, 0); } }
    asm volatile("s_waitcnt vmcnt(0) lgkmcnt(0)" ::: "memory"); __syncthreads();
}

__device__ __forceinline__ void ph_rwkv_out(const Args& a, int l, int nrows, int gt, int NGT) {
    const bf16* OJ = (const bf16*)(a.ws + WS_OJ); bf16* YC = (bf16*)(a.ws + WS_Y3) + (size_t)2 * MT * 1024;
    const float* subln = a.in[I_SUBLN] + l * 128;
    float lam, lam_init;
    { const int lane = threadIdx.x & 63; const float* lv = a.in[I_LAM] + l * 256;
      float l1 = lv[lane] * lv[64 + lane], l2 = lv[128 + lane] * lv[192 + lane]; l1 = wave_sum(l1); l2 = wave_sum(l2);
      lam_init = 0.8f - 0.6f * __expf(-0.3f * (float)l); lam = __expf(l1) - __expf(l2) + lam_init;
      float gb = fabsf(a.in[I_QN][l * 64 + lane] * a.in[I_KN][l * 64 + lane]);
#pragma unroll
      for (int o_ = 1; o_ < 64; o_ <<= 1) gb = fmaxf(gb, __shfl_xor(gb, o_));
      if (gb > 8.f) lam = __builtin_nanf(""); }
    const bf16* LO = (const bf16*)(a.ws + WS_R1); const bf16* RK = (const bf16*)(a.ws + WS_RKVK); const bf16* YS = (const bf16*)(a.ws + WS_YS);
    bf16* YB = (bf16*)(a.ws + WS_Y3) + (size_t)MT * 1024;
    const float* ka = a.in[I_KA] + l * 1024; const float* rkw = a.in[I_RK] + l * 1024; const float* lng = a.in[I_LNG] + l * 1024; const float* lnb = a.in[I_LNB] + l * 1024;
    for (int i = gt; i < nrows * 128; i += NGT) {
        const int m = i >> 7, c0 = (i & 127) * 8;
        const v4u ya = *(const GAS v4u*)(YS + (size_t)m * 1024 + c0), yb = *(const GAS v4u*)(YS + ((size_t)MT + m) * 1024 + c0);
        const GAS v4u* rp = (const GAS v4u*)(RK + (size_t)m * 4096 + c0 * 4);
        const v4u q0 = rp[0], q1 = rp[1], q2 = rp[2], q3 = rp[3];
        const bf16* lo = LO + (size_t)m * LOW + c0;
        const v4u gw_ = *(const GAS v4u*)lo, aw0 = *(const GAS v4u*)(lo + 3072), aw1 = *(const GAS v4u*)(lo + 4096);
        const v4u pw = *(const GAS v4u*)(OJ + (size_t)m * 1024 + c0), ow = *(const GAS v4u*)(OJ + ((size_t)MT + m) * 1024 + c0);
        float yA[8], yB[8], gv[8], a0v[8], a1v[8], pv[8], ov[8];
        unpack8(ya, yA); unpack8(yb, yB); unpack8(gw_, gv); unpack8(aw0, a0v); unpack8(aw1, a1v); unpack8(pw, pv); unpack8(ow, ov);
        float y[8]; float s1 = 0.f;
#pragma unroll
        for (int e = 0; e < 8; ++e) y[e] = yA[e] + yB[e];
#pragma unroll
        for (int e = 0; e < 8; ++e) s1 += y[e];
        s1 += __shfl_xor(s1, 1); s1 += __shfl_xor(s1, 2); s1 += __shfl_xor(s1, 4);
        const float mu = s1 * (1.f / 64.f); float s2 = 0.f;
#pragma unroll
        for (int e = 0; e < 8; ++e) { y[e] -= mu; s2 += y[e] * y[e]; }
        s2 += __shfl_xor(s2, 1); s2 += __shfl_xor(s2, 2); s2 += __shfl_xor(s2, 4);
        const float rstd = 1.f / sqrtf(s2 * (1.f / 64.f) + 64e-5f);
        float r[8], k[8], v[8];
        r[0] = bflo(q0.x); k[0] = bfhi(q0.x); v[0] = bflo(q0.y); r[1] = bflo(q0.z); k[1] = bfhi(q0.z); v[1] = bflo(q0.w);
        r[2] = bflo(q1.x); k[2] = bfhi(q1.x); v[2] = bflo(q1.y); r[3] = bflo(q1.z); k[3] = bfhi(q1.z); v[3] = bflo(q1.w);
        r[4] = bflo(q2.x); k[4] = bfhi(q2.x); v[4] = bflo(q2.y); r[5] = bflo(q2.z); k[5] = bfhi(q2.z); v[5] = bflo(q2.w);
        r[6] = bflo(q3.x); k[6] = bfhi(q3.x); v[6] = bflo(q3.y); r[7] = bflo(q3.z); k[7] = bfhi(q3.z); v[7] = bflo(q3.w);
        float am[8];
#pragma unroll
        for (int e = 0; e < 8; ++e) am[e] = 0.5f * (a0v[e] + a1v[e]);
        float rk = 0.f;
#pragma unroll
        for (int e = 0; e < 8; ++e) { const int c = c0 + e; rk += r[e] * (k[e] * (1.f + (am[e] - 1.f) * ka[c])) * rkw[c]; }
        rk += __shfl_xor(rk, 1); rk += __shfl_xor(rk, 2); rk += __shfl_xor(rk, 4);
        float o[8];
#pragma unroll
        for (int e = 0; e < 8; ++e) { const int c = c0 + e; o[e] = (y[e] * rstd * lng[c] + lnb[c] + rk * v[e]) * gv[e]; }
        *(GAS v4u*)(YB + (size_t)m * 1024 + c0) = pack8(o);
        { float d[8];
#pragma unroll
          for (int e = 0; e < 8; ++e) d[e] = pv[e] - lam * ov[e];
          float ss = 0.f;
#pragma unroll
          for (int e = 0; e < 8; ++e) ss += d[e] * d[e];
          ss += __shfl_xor(ss, 1); ss += __shfl_xor(ss, 2); ss += __shfl_xor(ss, 4); ss += __shfl_xor(ss, 8);
          const float rinv = (1.f - lam_init) / sqrtf(ss * (1.f / 128.f) + 1e-6f);
#pragma unroll
          for (int e = 0; e < 8; ++e) d[e] = d[e] * rinv * subln[(c0 & 127) + e];
          *(GAS v4u*)(YC + (size_t)m * 1024 + c0) = pack8(d); }
    }
}

constexpr int PH_PER_LAYER = 14, NPH = 1 + NLAYER * PH_PER_LAYER;
#define IN(k) (lo <= (k) && (k) < hi)
#define SEAM(k) do { if (IN(k) && IN((k) + 1)) xcd_barrier(bar); } while (0)
#ifndef ONLY_PH
#define ONLY_PH -1
#endif
#define INL(k) ((ONLY_PH < 0 || ONLY_PH == (k)) && IN(pb + (k)))
#define SEAML(k) SEAM(pb + (k))
#ifndef PROBE_REP
#define PROBE_REP 0
#endif
#define REPL(k) for (int rep_ = 0; rep_ < (((PROBE_REP) >> (k)) & 1) + 1; ++rep_)
template <int l> __device__ __forceinline__ void layer_body(const Args& args, LAS unsigned char* lds, unsigned char* lds_raw, unsigned char* ws, const XcdBarrier& bar, int lo, int hi, int tid, int lane, int G, int bx, int vcu, int gw, int NGW, int gt, int NGT) {
        const int pb = 1 + l * PH_PER_LAYER;
        const bool last = (l == NLAYER - 1);
        float* XS = (float*)(ws + WS_XS); pg8::bf16_t* PART = (pg8::bf16_t*)(ws + WS_PART);
        const float* mods = (const float*)(ws + WS_MODS) + (size_t)l * 3 * NMOD * DM;
        const float* normg = args.in[I_NORMG] + (size_t)l * 3 * DM;
        pg8::bf16_t* XN = (pg8::bf16_t*)(ws + WS_XN);
        pg8::bf16_t* Hb = (pg8::bf16_t*)(ws + WS_R1);
        const float* xl0 = (l == 0) ? args.in[I_X] : XS; const float* xc0 = (l == 0) ? args.in[I_CTX] : XS + (size_t)NLAT * DM;

        if (INL(0)) REPL(0) ph_norm(xl0, xc0, normg, mods, 0, (bf16*)XN, XS, l == 0 ? nullptr : PART, 16, MT, gw, NGW, lane);
        SEAML(0);
        if (INL(1)) REPL(1) { pg8::Gemm g{XN, (const pg8::bf16_t*)(ws + WS_WF1 + (size_t)(l * 2 + 0) * SZ_WF1), MT, FF2, DM}; pg8::StaticOrder S; S.init(MT, FF2, G, bx);
            pg8::EpiSwiglu E{Hb, FF}; pg8::gemm_phase<pg8::EpiSwiglu, pg8::StaticOrder, true, true>(lds, g, S, E); }
        SEAML(1);
        if (INL(2)) REPL(2) { pg8::Gemm g{Hb, (const pg8::bf16_t*)(ws + WS_WF2 + (size_t)(l * 2 + 0) * SZ_WF2), MT, DM, FF}; pg8::SplitCtxOrder S{G, vcu, NLAT / 256, NCTX / 256, 16, FF / 64};
            pg8::EpiResid E{xl0, (long)((xc0 - (size_t)NLAT * DM) - xl0), XS, 0L, mods + 2 * DM, NMOD * DM, 0.5f, NLAT / 256, TSEQ / 256, PART, NCTX};
            pg8::gemm_phase<pg8::EpiResid, pg8::SplitCtxOrder, true, true>(lds, g, S, E); }
        SEAML(2);
        if (INL(3)) REPL(3) ph_norm(XS, XS + (size_t)NLAT * DM, normg + DM, mods, 3, (bf16*)XN, XS, PART, 16, MT, gw, NGW, lane);
        SEAML(3);
        if (INL(4)) REPL(4) { pg8::Gemm g{XN, (const pg8::bf16_t*)(ws + WS_WIN + (size_t)l * SZ_WIN), MT, PROJP, DM}; pg8::ProjOrder S; S.init(last ? NLAT : MT, PROJP, G, bx); S.skip_ctx = last ? 1 : 0;
            pg8::EpiProj E{(pg8::bf16_t*)(ws + WS_P), PROJP, (pg8::bf16_t*)(ws + WS_ACT), (pg8::bf16_t*)(ws + WS_QK), args.in[I_QN] + l * 64, args.in[I_KN] + l * 64, (const float*)(ws + WS_ROPE), NLAT, TSEQ};
            pg8::gemm_phase<pg8::EpiProj, pg8::ProjOrder, true, true>(lds, g, S, E); }
        SEAML(4);
        if (INL(5)) REPL(5) { pg8::Gemm g{(const pg8::bf16_t*)(ws + WS_ACT), (const pg8::bf16_t*)(ws + WS_WLO + (size_t)l * SZ_WLO), MT, LOW, ACTW}; pg8::LoraOrder S; S.init(MT, LOW, G, bx);
            pg8::EpiLora E{(pg8::bf16_t*)(ws + WS_R1), args.in[I_W0] + l * 2048, args.in[I_A0] + l * 2048}; pg8::gemm_phase<pg8::EpiLora, pg8::LoraOrder, true, true>(lds, g, S, E);
            ph_e1(args, l, gt, NGT); }
        SEAML(5);
        if (INL(6)) REPL(6) ph_scanprep(args, l, gw, NGW, lane);
        SEAML(6);
        if (INL(7)) REPL(7) {
            if (bx < 64) scan_unit(args, l, bx, lds, tid);
            else { ph_attn(args, !last, (char*)lds_raw, bx - 64, G - 64); __syncthreads(); ph_gmlp(args, l, lds, tid, bx - 64, G - 64); }
        }
        SEAML(7);
        if (INL(8)) REPL(8) ph_rwkv_out(args, l, last ? NLAT : MT, gt, NGT);
        SEAML(8);
        if (INL(9)) REPL(9) { pg8::Gemm g{(const pg8::bf16_t*)(ws + WS_Y3), (const pg8::bf16_t*)(ws + WS_WBR + (size_t)l * SZ_WBR), 3 * MT, 3 * DM, 1024}; pg8::MergeOrder S{G, bx, MT / 256, last ? NLAT / 256 : MT / 256};
            pg8::EpiMerge E{(const pg8::bf16_t*)(ws + WS_P) + P_GATE2, PROJP, args.in[I_BGATE] + (size_t)l * 3 * DM, (pg8::bf16_t*)(ws + WS_ZF), XN, MT / 256};
            pg8::gemm_phase<pg8::EpiMerge, pg8::MergeOrder, true, true>(lds, g, S, E); }
        SEAML(9);
        if (INL(10)) REPL(10) { pg8::Gemm g{XN, (const pg8::bf16_t*)(ws + WS_WOUT + (size_t)l * SZ_WOUT), MT, DM, DM}; pg8::SplitCtxOrder S{G, vcu, NLAT / 256, last ? 0 : NCTX / 256, 8, DM / 64};
            pg8::EpiResid E{XS, 0L, XS, 0L, mods + 5 * DM, NMOD * DM, 1.0f, NLAT / 256, TSEQ / 256, PART, NCTX};
            pg8::gemm_phase<pg8::EpiResid, pg8::SplitCtxOrder, true, true>(lds, g, S, E); }
        SEAML(10);
        if (INL(11)) REPL(11) ph_norm(XS, XS + (size_t)NLAT * DM, normg + 2 * DM, mods, 6, (bf16*)XN, XS, PART, 8, last ? NLAT : MT, gw, NGW, lane);
        SEAML(11);
        if (INL(12)) REPL(12) { pg8::Gemm g{XN, (const pg8::bf16_t*)(ws + WS_WF1 + (size_t)(l * 2 + 1) * SZ_WF1), MT, FF2, DM}; pg8::StaticOrder S; S.init(last ? NLAT : MT, FF2, G, bx);
            pg8::EpiSwiglu E{Hb, FF}; pg8::gemm_phase<pg8::EpiSwiglu, pg8::StaticOrder, true, true>(lds, g, S, E); }
        SEAML(12);
        if (INL(13)) REPL(13) { pg8::Gemm g{Hb, (const pg8::bf16_t*)(ws + WS_WF2 + (size_t)(l * 2 + 1) * SZ_WF2), MT, DM, FF}; pg8::SplitCtxOrder S{G, vcu, NLAT / 256, last ? 0 : NCTX / 256, 16, FF / 64};
            pg8::EpiResid E{XS, 0L, last ? args.out : XS, 0L, mods + 8 * DM, NMOD * DM, 0.5f, NLAT / 256, TSEQ / 256, PART, NCTX};
            pg8::gemm_phase<pg8::EpiResid, pg8::SplitCtxOrder, true, true>(lds, g, S, E); }
        SEAML(13);
    }
__global__ void __launch_bounds__(NTHR, 2) fwd(Args args) {
    extern __shared__ __attribute__((aligned(16))) unsigned char lds_raw[];
    LAS unsigned char* lds = (LAS unsigned char*)lds_raw;
    const int tid = threadIdx.x, lane = tid & 63, wave = __builtin_amdgcn_readfirstlane(tid >> 6);
    const int G = gridDim.x; const int bx = blockIdx.x; const int vcu = (G % 8 == 0) ? (bx % 8) * (G / 8) + bx / 8 : bx;
    const int gw = vcu * NWAVES + wave, NGW = G * NWAVES, gt = vcu * NTHR + tid, NGT = G * NTHR;
    unsigned char* ws = args.ws;
    volatile LAS unsigned* MISC = (volatile LAS unsigned*)(lds + MISC_OFF);
    for (int u = tid; u < (LDS_BYTES - LDSCTL_OFF) / 4; u += NTHR) ((LAS unsigned*)(lds + LDSCTL_OFF))[u] = 0u;
    __syncthreads();
    const int lo = args.ph_lo, hi = args.ph_hi;
    const bool multi = (hi - lo) > 1;
    XcdBarrier bar; bar.bar = (unsigned*)(ws + WS_CTL) + CW_BAR; bar.x = 0; bar.st = nullptr;
    if (multi) bar = xcd_barrier_post((unsigned*)(ws + WS_CTL) + CW_BAR, MISC + 8);

    if ((ONLY_PH < 0 || ONLY_PH == 100) && IN(0)) REPL(16) {
        ph_ada(args, 0, lds, tid, vcu, G); __syncthreads(); ph_ada(args, 1, lds, tid, vcu, G); __syncthreads(); ph_weights(args, 0, lds, tid, vcu, G); ph_weights(args, 1, lds, tid, vcu, G); ph_small(args, tid, vcu, G); }
    SEAM(0);

    layer_body<0>(args, lds, lds_raw, ws, bar, lo, hi, tid, lane, G, bx, vcu, gw, NGW, gt, NGT);
    layer_body<1>(args, lds, lds_raw, ws, bar, lo, hi, tid, lane, G, bx, vcu, gw, NGW, gt, NGT);
#undef IN
#undef SEAM
}

#ifndef MK_PER_PHASE
#define MK_PER_PHASE 0
#endif
extern "C" void kernel_launch(void* const* d_in, const int* in_sizes, int n_in, void* d_out, int out_size, void* d_ws, size_t ws_size, hipStream_t stream) {
    static int grid = 0;
    if (grid == 0) {
        if (n_in != 31 || in_sizes[0] != NLAT * DM || out_size != NLAT * DM || ws_size < WS_END) {
            fprintf(stderr, "kernel_launch: unexpected shapes: n_in %d in0 %d out %d ws %zu (need %zu); nothing launched\n", n_in, n_in > 0 ? in_sizes[0] : -1, out_size, ws_size, (size_t)WS_END); grid = -1; return; }
        int dev = 0, cus = 0, per_cu = 0;
        if (hipGetDevice(&dev) != hipSuccess || hipDeviceGetAttribute(&cus, hipDeviceAttributeMultiprocessorCount, dev) != hipSuccess) { grid = -1; return; }
        if (hipFuncSetAttribute((const void*)fwd, hipFuncAttributeMaxDynamicSharedMemorySize, LDS_BYTES) != hipSuccess) { fprintf(stderr, "kernel_launch: hipFuncSetAttribute failed\n"); grid = -1; return; }
        if (hipOccupancyMaxActiveBlocksPerMultiprocessor(&per_cu, (const void*)fwd, NTHR, LDS_BYTES) != hipSuccess || per_cu < 1) fprintf(stderr, "kernel_launch: occupancy query says %d\n", per_cu);
        (void)hipGetLastError();
        grid = cus;
    }
    if (grid < 0) return;
    (void)hipMemsetAsync((char*)d_ws + WS_CTL, 0, CTL_ZERO_BYTES, stream);
    Args a{};
    for (int i = 0; i < 31; ++i) a.in[i] = (const float*)d_in[i];
    a.out = (float*)d_out; a.ws = (unsigned char*)d_ws;
#if MK_PER_PHASE
    for (int p = 0; p < NPH; ++p) { a.ph_lo = p; a.ph_hi = p + 1; hipLaunchKernelGGL(fwd, dim3(grid), dim3(NTHR), LDS_BYTES, stream, a); }
#else
    a.ph_lo = 0; a.ph_hi = NPH; hipLaunchKernelGGL(fwd, dim3(grid), dim3(NTHR), LDS_BYTES, stream, a);
#endif
}
```

```cpp
#include <hip/hip_runtime.h>
#include <cstdio>
#include <cstdint>
namespace pg8 {
#define PG8_LAS __attribute__((address_space(3)))
typedef unsigned short bf16_t;
typedef short bf16x8 __attribute__((ext_vector_type(8)));
typedef float f32x4 __attribute__((ext_vector_type(4)));
typedef unsigned u32x4 __attribute__((ext_vector_type(4)));
constexpr int BM = 256, BK = 64, HALF = 128, HTB = HALF * BK * 2  , STAGE_BYTES = 8 * HTB, NXCD = 8, WGM = 8;

__host__ __device__ __forceinline__ int lds_byte(int r, int c) { const int st = (r >> 4) * 2 + (c >> 5), rr = r & 15, cc = c & 31, ob = rr * 64 + cc * 2; return st * 1024 + (ob ^ (((ob >> 9) & 1) << 5)); }
__host__ __device__ __forceinline__ void stage_rc(int b, int& R, int& C) { const int st = b / 1024, sb = b % 1024, swz = sb ^ (((sb >> 9) & 1) << 5); R = (st >> 1) * 16 + swz / 64; C = (st & 1) * 32 + (swz % 64) / 2; }
__host__ __device__ __forceinline__ int perm32(int rho) { const int n = rho >> 4, i = rho & 15; return 8 * (i >> 2) + 4 * n + (i & 3); }

struct Unit { int pm, pn, ks, kn, aux; };
struct Gemm { const bf16_t* A; const bf16_t* Bt; int M, N, K; };

struct StaticOrder {
    int nM, nN, nwg, G, c;
    __host__ __device__ void init(int M, int N, int G_, int c_) { nM = M / BM; nN = N / BM; nwg = nM * nN; G = G_; c = c_; }
    __host__ __device__ bool next(int i, Unit& u) const {
        const long L = (long)i * G + c; if (L >= nwg) return false;
        int wgid = (int)L; { const int q = nwg / NXCD, r = nwg % NXCD, xcd = wgid % NXCD, off = wgid / NXCD; wgid = (xcd < r ? xcd * (q + 1) : r * (q + 1) + (xcd - r) * q) + off; }
        const int nig = WGM * nN, gid = wgid / nig, fm = gid * WGM, gsz = (nM - fm) < WGM ? (nM - fm) : WGM;
        u.pm = fm + ((wgid % nig) % gsz); u.pn = (wgid % nig) / gsz; u.ks = 0; u.kn = 0; u.aux = 0; return true;
    }
    __device__ __forceinline__ void a_ready(const Unit&) const {}
    __device__ __forceinline__ void done(const Unit&) const {}
};

__device__ __forceinline__ unsigned cvt_pk_bf16(float lo, float hi) { unsigned r; asm volatile("v_cvt_pk_bf16_f32 %0, %1, %2" : "=v"(r) : "v"(lo), "v"(hi)); return r; }
typedef float f32x2 __attribute__((ext_vector_type(2)));
typedef unsigned u32x2 __attribute__((ext_vector_type(2)));
__device__ __forceinline__ float fsigmoid(float x) { return __builtin_amdgcn_rcpf(1.f + __expf(-x)); }
__device__ __forceinline__ float bflo(unsigned w) { return __builtin_bit_cast(float, w << 16); }
__device__ __forceinline__ float bfhi(unsigned w) { return __builtin_bit_cast(float, w & 0xffff0000u); }

struct EpiSwiglu {
    static constexpr bool PERM = true, AFTER_DRAIN = false;
    bf16_t* H; int ldh;
    __device__ __forceinline__ void operator()(const f32x4 (&acc)[2][2][4][2], const Unit& u, int wr, int wc, int fr, int fq) const {
        const int col0 = u.pn * HALF + wc * 32 + 8 * fq, row0 = u.pm * BM + wr * 64 + fr;
#pragma unroll
        for (int ai = 0; ai < 2; ++ai)
#pragma unroll
            for (int m = 0; m < 4; ++m) {
                const f32x4 g0 = acc[ai][0][m][0], g1 = acc[ai][0][m][1], u0 = acc[ai][1][m][0], u1 = acc[ai][1][m][1];
                float o[8];
#pragma unroll
                for (int e = 0; e < 4; ++e) { o[e] = g0[e] * fsigmoid(g0[e]) * u0[e]; o[4 + e] = g1[e] * fsigmoid(g1[e]) * u1[e]; }
                u32x4 w; w.x = cvt_pk_bf16(o[0], o[1]); w.y = cvt_pk_bf16(o[2], o[3]); w.z = cvt_pk_bf16(o[4], o[5]); w.w = cvt_pk_bf16(o[6], o[7]);
                *(u32x4*)(H + (size_t)(row0 + ai * HALF + m * 16) * ldh + col0) = w;
            }
    }
};

struct EpiResid {
    static constexpr bool PERM = true, AFTER_DRAIN = false;
    const float* xin; long din; float* out; long dout; const float* gvec; int gstride; float scale; int nlat_tiles, tiles_per_set; bf16_t* part; int nctx_rows;
    __device__ __forceinline__ void operator()(const f32x4 (&acc)[2][2][4][2], const Unit& u, int wr, int wc, int fr, int fq) const {
        const bool isctx = u.pm >= nlat_tiles;
        const int set = isctx ? 2 : (u.pm / tiles_per_set);
        const float* gv = gvec + (size_t)set * gstride;
        const int colb = u.pn * BM + wc * 32 + 8 * fq;
        const long rbase = (long)(u.pm * BM + wr * 64 + fr) * 2048 + colb;
        const float* xi = xin + rbase + (isctx ? din : 0L); float* xo = out + rbase + (isctx ? dout : 0L);
        f32x4 gg[2][2];
#pragma unroll
        for (int bj = 0; bj < 2; ++bj)
#pragma unroll
            for (int n = 0; n < 2; ++n) gg[bj][n] = *(const f32x4*)(gv + colb + bj * HALF + 4 * n) * scale;
        if (u.kn != 0) {
            bf16_t* pp = part + ((size_t)u.aux * (size_t)nctx_rows + (size_t)((u.pm - nlat_tiles) * BM + wr * 64 + fr)) * 2048 + colb;
#pragma unroll
            for (int ai = 0; ai < 2; ++ai)
#pragma unroll
                for (int m = 0; m < 4; ++m)
#pragma unroll
                    for (int bj = 0; bj < 2; ++bj) { const f32x4 v0 = gg[bj][0] * acc[ai][bj][m][0], v1 = gg[bj][1] * acc[ai][bj][m][1];
                        u32x4 w; w.x = cvt_pk_bf16(v0[0], v0[1]); w.y = cvt_pk_bf16(v0[2], v0[3]); w.z = cvt_pk_bf16(v1[0], v1[1]); w.w = cvt_pk_bf16(v1[2], v1[3]);
                        *(u32x4*)(pp + (size_t)(ai * HALF + m * 16) * 2048 + bj * HALF) = w; }
            return;
        }
#pragma unroll
        for (int ai = 0; ai < 2; ++ai) {
            f32x4 xv[4][2][2];
#pragma unroll
            for (int m = 0; m < 4; ++m)
#pragma unroll
                for (int bj = 0; bj < 2; ++bj)
#pragma unroll
                    for (int n = 0; n < 2; ++n) xv[m][bj][n] = *(const f32x4*)(xi + (size_t)(ai * HALF + m * 16) * 2048 + bj * HALF + 4 * n);
#pragma unroll
            for (int m = 0; m < 4; ++m)
#pragma unroll
                for (int bj = 0; bj < 2; ++bj)
#pragma unroll
                    for (int n = 0; n < 2; ++n) *(f32x4*)(xo + (size_t)(ai * HALF + m * 16) * 2048 + bj * HALF + 4 * n) = xv[m][bj][n] + gg[bj][n] * acc[ai][bj][m][n];
        }
    }
};
struct SplitCtxOrder {
    int G, c, nlat_tiles, nctx_tiles, nsplit, ntk;
    __device__ __forceinline__ bool next(int i, Unit& u) const {
        const int e = i * G + c, nl = nlat_tiles * 8;
        if (e < nl) { u.pm = e >> 3; u.pn = e & 7; u.ks = 0; u.kn = 0; u.aux = 0; return true; }
        const int f = e - nl; if (f >= nctx_tiles * 8 * nsplit) return false;
        const int sp = f % nsplit, t = f / nsplit, np = ntk >> 1, p0 = sp * np / nsplit, p1 = (sp + 1) * np / nsplit;
        u.pm = nlat_tiles + (t >> 3); u.pn = t & 7; u.ks = 2 * p0; u.kn = 2 * (p1 - p0); u.aux = sp; return true;
    }
    __device__ __forceinline__ void a_ready(const Unit&) const {}
    __device__ __forceinline__ void done(const Unit&) const {}
};
struct ProjOrder : StaticOrder {
    int skip_ctx;
    __device__ __forceinline__ bool next(int i, Unit& u) const {
        if (StaticOrder::next(i, u)) return true;
        if (!skip_ctx) return false;
        const long L = (long)i * G + c - nwg; if (L >= 2 * 23) return false;
        const int x = (int)L % 23; u.pm = nM + (int)L / 23; u.pn = x < 15 ? 8 + x : 27 + (x - 15); u.ks = 0; u.kn = 0; u.aux = 0; return true;
    }
};
struct LoraOrder : StaticOrder {
    __device__ __forceinline__ bool next(int i, Unit& u) const {
        if (!StaticOrder::next(i, u)) return false;
        const int sec = u.pn >> 2; int k4 = 4; asm volatile("" : "+s"(k4));
        u.ks = sec == 0 ? 0 : (sec <= 2 ? 4 : 8); u.kn = k4; return true;
    }
};

__device__ __forceinline__ float ftanh_e(float x) { return 1.f - 2.f * __builtin_amdgcn_rcpf(__expf(2.f * x) + 1.f); }
__device__ __forceinline__ float gelu_e(float x) { return 0.5f * x * (1.f + ftanh_e(0.7978845608f * (x + 0.044715f * x * x * x))); }
struct EpiProj {
    static constexpr bool PERM = true, AFTER_DRAIN = false;
    bf16_t* P; int ldp; bf16_t* ACT; bf16_t* QK; const float* qn; const float* kn; const float* rope; int nlat_rows, tseq;
    __device__ __forceinline__ void operator()(const f32x4 (&acc)[2][2][4][2], const Unit& u, int wr, int wc, int fr, int fq) const {
        const int pn = u.pn, row0 = u.pm * BM + wr * 64 + fr;
        if (pn >= 23 && pn <= 30) {
            const bool isq = pn <= 26; const int gi = (pn - 23) * 4 + wc;
            const float* gain = isq ? qn : kn;
            f32x4 gg[2][2];
#pragma unroll
            for (int bj = 0; bj < 2; ++bj)
#pragma unroll
                for (int n = 0; n < 2; ++n) gg[bj][n] = *(const f32x4*)(gain + bj * 32 + n * 16 + 4 * fq);
            const float qs = isq ? 0.18033688011112042f : 1.f;
#pragma unroll
            for (int ai = 0; ai < 2; ++ai)
#pragma unroll
                for (int m = 0; m < 4; ++m) {
                    const int row = row0 + ai * HALF + m * 16;
                    f32x4 x[2][2]; float ss = 0.f;
#pragma unroll
                    for (int bj = 0; bj < 2; ++bj)
#pragma unroll
                        for (int n = 0; n < 2; ++n) { x[bj][n] = acc[ai][bj][m][n]; ss += (x[bj][n][0] * x[bj][n][0] + x[bj][n][1] * x[bj][n][1]) + (x[bj][n][2] * x[bj][n][2] + x[bj][n][3] * x[bj][n][3]); }
                    ss += __shfl_xor(ss, 16); ss += __shfl_xor(ss, 32);
                    const float rinv = __builtin_amdgcn_rsqf(ss * (1.f / 64.f) + 1e-6f);
#pragma unroll
                    for (int bj = 0; bj < 2; ++bj)
#pragma unroll
                        for (int n = 0; n < 2; ++n) x[bj][n] = x[bj][n] * rinv * gg[bj][n];
                    if (row < nlat_rows) { const int t = row & (tseq - 1);
#pragma unroll
                        for (int bj = 0; bj < 2; ++bj) { const int p = bj == 0 ? (t >> 6) : (t & 63);
                            const f32x4 cs0 = *(const f32x4*)(rope + (p * 16 + 4 * fq) * 2), cs1 = *(const f32x4*)(rope + (p * 16 + 4 * fq) * 2 + 4);
                            const f32x4 c = {cs0[0], cs0[2], cs1[0], cs1[2]}, s = {cs0[1], cs0[3], cs1[1], cs1[3]};
                            const f32x4 a = x[bj][0], b2 = x[bj][1];
                            x[bj][0] = a * c - b2 * s; x[bj][1] = b2 * c + a * s; } }
                    bf16_t* dst = QK + (size_t)row * 2048 + gi * 64 + 8 * fq;
#pragma unroll
                    for (int bj = 0; bj < 2; ++bj) { const f32x4 v0 = x[bj][0] * qs, v1 = x[bj][1] * qs;
                        u32x4 w; w.x = cvt_pk_bf16(v0[0], v0[1]); w.y = cvt_pk_bf16(v0[2], v0[3]); w.z = cvt_pk_bf16(v1[0], v1[1]); w.w = cvt_pk_bf16(v1[2], v1[3]);
                        *(u32x4*)(dst + bj * 32) = w; }
                }
            return;
        }
        if (pn >= 20 && pn <= 22) {
#pragma unroll
            for (int bj = 0; bj < 2; ++bj) {
                const int cc = bj * HALF + wc * 32 + 8 * fq;
                int dcol, fn;
                if (pn == 20) { dcol = cc; fn = 1; }
                else if (pn == 21) { if (cc < 96) { dcol = 256 + cc; fn = 2; } else if (cc < 192) { dcol = 384 + (cc - 96); fn = 2; } else { dcol = 512 + (cc - 192); fn = 0; } }
                else { if (cc < 32) { dcol = 576 + cc; fn = 0; } else if (cc < 128) { dcol = 640 + (cc - 32); fn = 0; } else { dcol = -1; fn = 0; } }
                if (dcol < 0) continue;
#pragma unroll
                for (int ai = 0; ai < 2; ++ai)
#pragma unroll
                    for (int m = 0; m < 4; ++m) {
                        f32x4 v0 = acc[ai][bj][m][0], v1 = acc[ai][bj][m][1];
                        if (fn != 0) {
#pragma unroll
                            for (int e = 0; e < 4; ++e) { v0[e] = fn == 1 ? fsigmoid(v0[e]) : ftanh_e(v0[e]); v1[e] = fn == 1 ? fsigmoid(v1[e]) : ftanh_e(v1[e]); } }
                        u32x4 w; w.x = cvt_pk_bf16(v0[0], v0[1]); w.y = cvt_pk_bf16(v0[2], v0[3]); w.z = cvt_pk_bf16(v1[0], v1[1]); w.w = cvt_pk_bf16(v1[2], v1[3]);
                        *(u32x4*)(ACT + (size_t)(row0 + ai * HALF + m * 16) * 768 + dcol) = w;
                    }
            }
            return;
        }
        const bool dogelu = pn < 8;
        const int col0 = pn * BM + wc * 32 + 8 * fq;
#pragma unroll
        for (int ai = 0; ai < 2; ++ai)
#pragma unroll
            for (int m = 0; m < 4; ++m) {
                bf16_t* rowp = P + (size_t)(row0 + ai * HALF + m * 16) * ldp + col0;
#pragma unroll
                for (int bj = 0; bj < 2; ++bj) {
                    f32x4 v0 = acc[ai][bj][m][0], v1 = acc[ai][bj][m][1];
                    if (dogelu) {
#pragma unroll
                        for (int e = 0; e < 4; ++e) { v0[e] = gelu_e(v0[e]); v1[e] = gelu_e(v1[e]); } }
                    u32x4 w; w.x = cvt_pk_bf16(v0[0], v0[1]); w.y = cvt_pk_bf16(v0[2], v0[3]); w.z = cvt_pk_bf16(v1[0], v1[1]); w.w = cvt_pk_bf16(v1[2], v1[3]);
                    *(u32x4*)(rowp + bj * HALF) = w;
                }
            }
    }
};

struct EpiLora {
    static constexpr bool PERM = true, AFTER_DRAIN = false;
    bf16_t* LO; const float* w0; const float* a0;
    __device__ __forceinline__ void operator()(const f32x4 (&acc)[2][2][4][2], const Unit& u, int wr, int wc, int fr, int fq) const {
        const int sec = u.pn >> 2;
        const int col0 = u.pn * BM + wc * 32 + 8 * fq, row0 = u.pm * BM + wr * 64 + fr, c0 = col0 - sec * 1024;
        const float* bp = (sec <= 2 ? w0 + (sec <= 1 ? 0 : 1024) : a0 + (sec - 3) * 1024) + c0;
#pragma unroll
        for (int ai = 0; ai < 2; ++ai)
#pragma unroll
            for (int m = 0; m < 4; ++m) {
                bf16_t* rowp = LO + (size_t)(row0 + ai * HALF + m * 16) * 5120 + col0;
#pragma unroll
                for (int bj = 0; bj < 2; ++bj) {
                    f32x4 v[2];
#pragma unroll
                    for (int n = 0; n < 2; ++n) { v[n] = acc[ai][bj][m][n];
                        if (sec >= 1) { v[n] = v[n] + *(const f32x4*)(bp + bj * HALF + 4 * n);
#pragma unroll
                            for (int e = 0; e < 4; ++e) { const float s = fsigmoid(v[n][e]); v[n][e] = (sec <= 2) ? 0.8750356f * s : s; } } }
                    u32x4 w; w.x = cvt_pk_bf16(v[0][0], v[0][1]); w.y = cvt_pk_bf16(v[0][2], v[0][3]); w.z = cvt_pk_bf16(v[1][0], v[1][1]); w.w = cvt_pk_bf16(v[1][2], v[1][3]);
                    *(u32x4*)(rowp + bj * HALF) = w;
                }
                asm volatile("" ::: "memory");
            }
    }
};

struct EpiMerge {
    static constexpr bool PERM = true, AFTER_DRAIN = false;
    const bf16_t* pgate; int ldp;
    const float* bgate;
    bf16_t* ZF; bf16_t* Z; int mtiles;
    bf16_t* ZP; long zp_off;
    __device__ __forceinline__ void operator()(const f32x4 (&acc)[2][2][4][2], const Unit& u, int wr, int wc, int fr, int fq) const {
        const int br = u.pn >> 3, pn = u.pn & 7, pm = u.pm - mtiles * br;
        const int col0 = pn * BM + wc * 32 + 8 * fq, row0 = pm * BM + wr * 64 + fr;
        f32x4 bb[2][2];
#pragma unroll
        for (int bj = 0; bj < 2; ++bj)
#pragma unroll
            for (int n = 0; n < 2; ++n) bb[bj][n] = *(const f32x4*)(bgate + br * 2048 + col0 + bj * HALF + 4 * n);
        const bool part = u.aux != 0, rd = br >= 1 && !part;
        bf16_t* dstb = part ? ZP + ((long)br * 512 + zp_off) * 2048 : (br == 2 ? Z : ZF);
#pragma unroll
        for (int ai = 0; ai < 2; ++ai) {
            u32x4 pg[4][2], zf[4][2];
#pragma unroll
            for (int m = 0; m < 4; ++m)
#pragma unroll
                for (int bj = 0; bj < 2; ++bj) { const size_t row = (size_t)(row0 + ai * HALF + m * 16);
                    pg[m][bj] = *(const u32x4*)(pgate + row * ldp + br * 2048 + col0 + bj * HALF);
                    if (rd) zf[m][bj] = *(const u32x4*)(ZF + row * 2048 + col0 + bj * HALF); }
#pragma unroll
            for (int m = 0; m < 4; ++m)
#pragma unroll
                for (int bj = 0; bj < 2; ++bj) { const size_t row = (size_t)(row0 + ai * HALF + m * 16); const u32x4 q = pg[m][bj];
                    f32x4 g0, g1;
                    g0[0] = bflo(q.x); g0[1] = bfhi(q.x); g0[2] = bflo(q.y); g0[3] = bfhi(q.y); g1[0] = bflo(q.z); g1[1] = bfhi(q.z); g1[2] = bflo(q.w); g1[3] = bfhi(q.w);
                    g0 = g0 + bb[bj][0]; g1 = g1 + bb[bj][1];
                    f32x4 v0, v1;
#pragma unroll
                    for (int e = 0; e < 4; ++e) { v0[e] = fsigmoid(g0[e]) * acc[ai][bj][m][0][e]; v1[e] = fsigmoid(g1[e]) * acc[ai][bj][m][1][e]; }
                    if (rd) { const u32x4 z = zf[m][bj];
                        v0[0] += bflo(z.x); v0[1] += bfhi(z.x); v0[2] += bflo(z.y); v0[3] += bfhi(z.y); v1[0] += bflo(z.z); v1[1] += bfhi(z.z); v1[2] += bflo(z.w); v1[3] += bfhi(z.w); }
                    u32x4 w; w.x = cvt_pk_bf16(v0[0], v0[1]); w.y = cvt_pk_bf16(v0[2], v0[3]); w.z = cvt_pk_bf16(v1[0], v1[1]); w.w = cvt_pk_bf16(v1[2], v1[3]);
                    *(u32x4*)(dstb + row * 2048 + col0 + bj * HALF) = w; }
        }
    }
};
struct MergeOrder {
    int G, c, mtiles, nlat_tiles, nctx_units;
    __device__ __forceinline__ bool next(int i, Unit& u) const {
        const int ntl = nlat_tiles * 8; int nl = (ntl - c + G - 1) / G; nl = nl < 0 ? 0 : nl;
        u.ks = 0; u.kn = 0;
        if (i < 3 * nl) { const int t = (i / 3) * G + c, br = i % 3; u.pm = (t >> 3) + mtiles * br; u.pn = (t & 7) + 8 * br; u.aux = 0; return true; }
        const int e = (i - 3 * nl) * G + c; if (e >= nctx_units) return false;
        const int t = ntl + e / 3, br = e % 3; u.pm = (t >> 3) + mtiles * br; u.pn = (t & 7) + 8 * br; u.aux = 1; return true;
    }
    __device__ __forceinline__ void a_ready(const Unit&) const {}
    __device__ __forceinline__ void done(const Unit&) const {}
};

template <class Epi, class Sched, bool ALIGN_EPI = false, bool SP2 = false>
__device__ __forceinline__ void gemm_phase(PG8_LAS unsigned char* lds, const Gemm g, const Sched& S, const Epi& E) {
    const int tid = threadIdx.x, wid = __builtin_amdgcn_readfirstlane(tid >> 6), lane = tid & 63, wr = wid >> 2, wc = wid & 3, fr = lane & 15, fq = lane >> 4;
    const int K = g.K, nt = K / BK;
    unsigned voffA[2], voffB[2];
#pragma unroll
    for (int i = 0; i < 2; ++i) { int R, C; stage_rc(tid * 16 + i * 8192, R, C); const int Rb = Epi::PERM ? ((R & ~31) + perm32(R & 31)) : R;
        voffA[i] = (unsigned)(R * K + C) * 2u; voffB[i] = (unsigned)(Rb * K + C) * 2u; }
    const size_t kstep = (size_t)(BK * 2);
    const size_t hstep = (size_t)HALF * K * 2;
    const size_t tstep = 2 * hstep;
    const unsigned ldsw = (unsigned)wid * 1024u;
    const int aoff = lds_byte(wr * 64 + fr, fq * 8), boff = lds_byte(wc * 32 + fr, fq * 8);
#define PG8_SA(b, h) (((b) * 2 + (h)) * HTB)
#define PG8_SB(b, h) ((4 + (b) * 2 + (h)) * HTB)
#define PG8_STAGE(bufoff, gbase, voff) do { _Pragma("unroll") for (int _i = 0; _i < 2; ++_i) \
        __builtin_amdgcn_global_load_lds((const unsigned*)((const char*)(gbase) + (voff)[_i]), (PG8_LAS unsigned*)(lds + (bufoff) + ldsw + _i * 8192), 16, 0, 0); } while (0)
#define PG8_LDA(dst, b, h) do { _Pragma("unroll") for (int m = 0; m < 4; ++m) _Pragma("unroll") for (int k = 0; k < 2; ++k) dst[m][k] = *(const PG8_LAS bf16x8*)(lds + PG8_SA(b, h) + aoff + m * 2048 + k * 1024); } while (0)
#define PG8_LDB(dst, b, h) do { _Pragma("unroll") for (int n = 0; n < 2; ++n) _Pragma("unroll") for (int k = 0; k < 2; ++k) dst[n][k] = *(const PG8_LAS bf16x8*)(lds + PG8_SB(b, h) + boff + n * 2048 + k * 1024); } while (0)
#define PG8_MMA(ai, bj, At, Bt) do { __builtin_amdgcn_s_setprio(1); _Pragma("unroll") for (int m = 0; m < 4; ++m) _Pragma("unroll") for (int n = 0; n < 2; ++n) _Pragma("unroll") for (int k = 0; k < 2; ++k) \
        acc[ai][bj][m][n] = __builtin_amdgcn_mfma_f32_16x16x32_bf16(Bt[n][k], At[m][k], acc[ai][bj][m][n], 0, 0, 0); __builtin_amdgcn_s_setprio(0); } while (0)
#define PG8_WAIT_V(n) asm volatile("s_waitcnt vmcnt(" #n ")" ::: "memory")
#define PG8_WAIT_L(n) asm volatile("s_waitcnt lgkmcnt(" #n ")" ::: "memory")
#define PG8_BAR __builtin_amdgcn_s_barrier()
#define PG8_SCHED __builtin_amdgcn_sched_barrier(0)
    Unit cur, nxt; int ui = 0;
    if (!S.next(0, cur)) return;
    f32x4 acc[2][2][4][2];
#pragma unroll
    for (int a = 0; a < 2; ++a)
#pragma unroll
        for (int b = 0; b < 2; ++b)
#pragma unroll
            for (int m = 0; m < 4; ++m)
#pragma unroll
                for (int n = 0; n < 2; ++n) acc[a][b][m][n] = (f32x4){0.f, 0.f, 0.f, 0.f};
    bf16x8 At[4][2], B0[2][2], B1[2][2];
    const char* cA = (const char*)g.A + (size_t)cur.pm * tstep + (size_t)cur.ks * kstep; const char* cB = (const char*)g.Bt + (size_t)cur.pn * tstep + (size_t)cur.ks * kstep;
    int ntc = cur.kn ? cur.kn : nt;
    S.a_ready(cur);
    if constexpr (SP2) {
        PG8_STAGE(PG8_SB(0, 0), cB, voffB); PG8_STAGE(PG8_SB(0, 1), cB + hstep, voffB); PG8_STAGE(PG8_SA(0, 0), cA, voffA); PG8_STAGE(PG8_SA(0, 1), cA + hstep, voffA);
        if (wr == 1) PG8_BAR;
        PG8_WAIT_V(2); PG8_BAR;
        PG8_STAGE(PG8_SB(1, 0), cB + kstep, voffB); PG8_STAGE(PG8_SA(1, 0), cA + kstep, voffA); PG8_STAGE(PG8_SB(1, 1), cB + hstep + kstep, voffB);
        PG8_WAIT_V(6); PG8_BAR;
    } else {
        PG8_STAGE(PG8_SB(0, 0), cB, voffB); PG8_STAGE(PG8_SA(0, 0), cA, voffA); PG8_STAGE(PG8_SB(0, 1), cB + hstep, voffB); PG8_STAGE(PG8_SA(0, 1), cA + hstep, voffA);
        if (wr == 1) PG8_BAR;
        PG8_WAIT_V(4); PG8_BAR;
        PG8_STAGE(PG8_SB(1, 0), cB + kstep, voffB); PG8_STAGE(PG8_SA(1, 0), cA + kstep, voffA); PG8_STAGE(PG8_SB(1, 1), cB + hstep + kstep, voffB);
        PG8_WAIT_V(6); PG8_BAR;
    }
    for (;;) {
        const bool has_next = S.next(ui + 1, nxt);
        const char* nA = has_next ? (const char*)g.A + (size_t)nxt.pm * tstep + (size_t)nxt.ks * kstep : cA; const char* nB = has_next ? (const char*)g.Bt + (size_t)nxt.pn * tstep + (size_t)nxt.ks * kstep : cB;
        for (int t = 0; t < ntc; t += 2) {
            const bool last = (t == ntc - 2);
            const char* a1 = cA + (size_t)(t + 1) * kstep;
            const char* a2 = last ? nA : cA + (size_t)(t + 2) * kstep; const char* b2 = last ? nB : cB + (size_t)(t + 2) * kstep;
            const char* a3 = a2 + kstep; const char* b3 = b2 + kstep;
            if (last && has_next) S.a_ready(nxt);
            if constexpr (SP2) {
            PG8_LDB(B0, 0, 0); PG8_LDB(B1, 0, 1); PG8_SCHED; PG8_LDA(At, 0, 0); PG8_STAGE(PG8_SA(1, 1), a1 + hstep, voffA);
            PG8_WAIT_V(8); PG8_WAIT_L(0); PG8_BAR; PG8_MMA(0, 0, At, B0); PG8_MMA(0, 1, At, B1); PG8_BAR; PG8_SCHED;
            PG8_LDA(At, 0, 1); PG8_STAGE(PG8_SB(0, 0), b2, voffB); PG8_STAGE(PG8_SB(0, 1), b2 + hstep, voffB); PG8_STAGE(PG8_SA(0, 0), a2, voffA);
            PG8_WAIT_V(8); PG8_WAIT_L(0); PG8_BAR; PG8_MMA(1, 0, At, B0); PG8_MMA(1, 1, At, B1); PG8_BAR; PG8_SCHED;
            PG8_LDB(B0, 1, 0); PG8_LDB(B1, 1, 1); PG8_SCHED; PG8_LDA(At, 1, 0); PG8_STAGE(PG8_SA(0, 1), a2 + hstep, voffA);
            PG8_WAIT_V(8); PG8_WAIT_L(0); PG8_BAR; PG8_MMA(0, 0, At, B0); PG8_MMA(0, 1, At, B1); PG8_BAR; PG8_SCHED;
            PG8_LDA(At, 1, 1); PG8_STAGE(PG8_SB(1, 0), b3, voffB); PG8_STAGE(PG8_SB(1, 1), b3 + hstep, voffB); PG8_STAGE(PG8_SA(1, 0), a3, voffA);
            PG8_WAIT_V(8); PG8_WAIT_L(0); PG8_BAR; PG8_MMA(1, 0, At, B0); PG8_MMA(1, 1, At, B1); PG8_BAR; PG8_SCHED;
            } else {
            PG8_LDB(B0, 0, 0); PG8_SCHED; PG8_LDA(At, 0, 0); PG8_STAGE(PG8_SA(1, 1), a1 + hstep, voffA);
            PG8_WAIT_L(8); PG8_BAR; PG8_WAIT_L(0); PG8_MMA(0, 0, At, B0); PG8_BAR; PG8_SCHED;
            PG8_LDB(B1, 0, 1); PG8_STAGE(PG8_SB(0, 0), b2, voffB);
            PG8_BAR; PG8_WAIT_L(0); PG8_MMA(0, 1, At, B1); PG8_BAR;
            PG8_LDA(At, 0, 1); PG8_STAGE(PG8_SA(0, 0), a2, voffA);
            PG8_BAR; PG8_WAIT_L(0); PG8_MMA(1, 0, At, B0); PG8_BAR; PG8_SCHED;
            PG8_STAGE(PG8_SB(0, 1), b2 + hstep, voffB);
            PG8_WAIT_V(6); PG8_BAR; PG8_MMA(1, 1, At, B1); PG8_BAR;
            PG8_LDB(B0, 1, 0); PG8_SCHED; PG8_LDA(At, 1, 0); PG8_STAGE(PG8_SA(0, 1), a2 + hstep, voffA);
            PG8_WAIT_L(8); PG8_BAR; PG8_WAIT_L(0); PG8_MMA(0, 0, At, B0); PG8_BAR; PG8_SCHED;
            PG8_LDB(B1, 1, 1); PG8_STAGE(PG8_SB(1, 0), b3, voffB);
            PG8_BAR; PG8_WAIT_L(0); PG8_MMA(0, 1, At, B1); PG8_BAR;
            PG8_LDA(At, 1, 1); PG8_STAGE(PG8_SA(1, 0), a3, voffA);
            PG8_BAR; PG8_WAIT_L(0); PG8_MMA(1, 0, At, B0); PG8_BAR; PG8_SCHED;
            PG8_STAGE(PG8_SB(1, 1), b3 + hstep, voffB);
            PG8_WAIT_V(6); PG8_BAR; PG8_MMA(1, 1, At, B1); PG8_BAR;
            }
        }
        if constexpr (ALIGN_EPI) { if (wr == 0) PG8_BAR; }
        if constexpr (!Epi::AFTER_DRAIN) { E(acc, cur, wr, wc, fr, fq); S.done(cur); }
        if (!has_next) break;
#pragma unroll
        for (int a = 0; a < 2; ++a)
#pragma unroll
            for (int b = 0; b < 2; ++b)
#pragma unroll
                for (int m = 0; m < 4; ++m)
#pragma unroll
                    for (int n = 0; n < 2; ++n) acc[a][b][m][n] = (f32x4){0.f, 0.f, 0.f, 0.f};
        cur = nxt; cA = nA; cB = nB; ++ui; ntc = cur.kn ? cur.kn : nt;
        if constexpr (ALIGN_EPI) { if (wr == 1) PG8_BAR; }
    }
    PG8_WAIT_V(0);
    if constexpr (!ALIGN_EPI) { if (wr == 0) PG8_BAR; }
    PG8_BAR;
    if constexpr (Epi::AFTER_DRAIN) { E.fused(acc, cur, wr, wc, fr, fq, lds, wid, lane); S.done(cur); }
#undef PG8_SA
#undef PG8_SB
#undef PG8_STAGE
#undef PG8_LDA
#undef PG8_LDB
#undef PG8_MMA
#undef PG8_WAIT_V
#undef PG8_WAIT_L
#undef PG8_BAR
#undef PG8_SCHED
}
}

constexpr int NWAVES = 8, NTHR = NWAVES * 64;
constexpr int DM = 2048, FF = 5504, FF2 = 2 * FF, NLAT = 8192, NCTX = 512, MT = NLAT + NCTX, TSEQ = 4096, TCTX = 256;
constexpr int PROJ = 14976, PROJP = 15104;
constexpr int P_U = 0, P_V = 1024, P_RKV = 2048, P_G = 5120, P_W = 5376, P_A = 5568, P_QKV = 5760, P_GATE = 8832;
constexpr int P_V2 = 31 * 256, P_GATE2 = 35 * 256;
constexpr int ACTW = 768, LOW = 5120;
constexpr int NLAYER = 2, NMOD = 9;

constexpr size_t MiB = 1u << 20;
constexpr size_t al(size_t x) { return (x + MiB - 1) / MiB * MiB; }
constexpr size_t WS_CTL = 0, CTL_ZERO_BYTES = 1 * MiB;
constexpr size_t WS_MODS = 1 * MiB;
constexpr size_t WS_ROPE = WS_MODS + al((size_t)NLAYER * 3 * NMOD * DM * 4);
constexpr size_t WS_WF1 = WS_ROPE + MiB;
constexpr size_t SZ_WF1 = (size_t)FF2 * DM * 2;
constexpr size_t WS_WF2 = WS_WF1 + al(4 * SZ_WF1);
constexpr size_t SZ_WF2 = (size_t)DM * FF * 2;
constexpr size_t WS_WIN = WS_WF2 + al(4 * SZ_WF2);
constexpr size_t SZ_WIN = (size_t)PROJP * DM * 2;
constexpr size_t WS_WLO = WS_WIN + al(2 * SZ_WIN);
constexpr size_t SZ_WLO = (size_t)LOW * ACTW * 2;
constexpr size_t WS_WBR = WS_WLO + al(2 * SZ_WLO);
constexpr size_t SZ_WBR = (size_t)3 * DM * 1024 * 2;
constexpr size_t WS_WOUT = WS_WBR + al(2 * SZ_WBR);
constexpr size_t SZ_WOUT = (size_t)DM * DM * 2;
constexpr size_t WS_XS = WS_WOUT + al(2 * SZ_WOUT);
constexpr size_t WS_XN = WS_XS + al((size_t)MT * DM * 4);
constexpr size_t WS_P = WS_XN + al((size_t)MT * DM * 2);
constexpr size_t WS_R1 = WS_P + al((size_t)MT * PROJP * 2);
constexpr size_t WS_ACT = WS_R1 + al((size_t)MT * FF * 2);
constexpr size_t WS_RKVK = WS_ACT + al((size_t)MT * ACTW * 2);
constexpr size_t WS_QK = WS_RKVK + al((size_t)MT * 4096 * 2);
constexpr size_t WS_YS = WS_QK + al((size_t)MT * DM * 2);
constexpr size_t WS_Y3 = WS_YS + al((size_t)2 * MT * 1024 * 2);
constexpr size_t WS_OJ = WS_Y3 + al((size_t)3 * MT * 1024 * 2);
constexpr size_t WS_PART = WS_OJ + al((size_t)2 * MT * 1024 * 2);
constexpr size_t WS_ZF = WS_PART + al((size_t)16 * NCTX * DM * 2);
constexpr size_t WS_IMG = WS_ZF + al((size_t)MT * DM * 2);
constexpr size_t WS_END = WS_IMG + al((size_t)64 * 136 * 22528);

constexpr int CW_TMO = 0, CW_CODE = 1, CW_BAR = 4096;

constexpr int RING_BYTES = 131072, LDSCTL_OFF = RING_BYTES, MISC_OFF = LDSCTL_OFF + 320, LDS_BYTES = 147456;

#define GAS __attribute__((address_space(1)))
#define LAS __attribute__((address_space(3)))
typedef unsigned short bf16;
typedef unsigned v4u __attribute__((ext_vector_type(4)));
typedef unsigned v2u __attribute__((ext_vector_type(2)));
typedef float f32x4 __attribute__((ext_vector_type(4)));
typedef short bf16x8 __attribute__((ext_vector_type(8)));
typedef GAS unsigned gu32;
#define RLX_AGENT __ATOMIC_RELAXED, __HIP_MEMORY_SCOPE_AGENT
__device__ __forceinline__ unsigned f2bf(float f) { unsigned u = __builtin_bit_cast(unsigned, f); return (u + 0x7fffu + ((u >> 16) & 1u)) >> 16; }
__device__ __forceinline__ unsigned pk2(float lo, float hi) { return f2bf(lo) | (f2bf(hi) << 16); }
__device__ __forceinline__ float bflo(unsigned w) { return __builtin_bit_cast(float, w << 16); }
__device__ __forceinline__ float bfhi(unsigned w) { return __builtin_bit_cast(float, w & 0xffff0000u); }
__device__ __forceinline__ float bf1(bf16 h) { return __builtin_bit_cast(float, (unsigned)h << 16); }
__device__ __forceinline__ void unpack8(const v4u w, float (&f)[8]) { f[0] = bflo(w.x); f[1] = bfhi(w.x); f[2] = bflo(w.y); f[3] = bfhi(w.y); f[4] = bflo(w.z); f[5] = bfhi(w.z); f[6] = bflo(w.w); f[7] = bfhi(w.w); }
__device__ __forceinline__ v4u pack8(const float (&f)[8]) { v4u w; w.x = pk2(f[0], f[1]); w.y = pk2(f[2], f[3]); w.z = pk2(f[4], f[5]); w.w = pk2(f[6], f[7]); return w; }
__device__ __forceinline__ float fsigm(float x) { return __builtin_amdgcn_rcpf(1.f + __expf(-x)); }
__device__ __forceinline__ float ftanh(float x) { return 1.f - 2.f * __builtin_amdgcn_rcpf(__expf(2.f * x) + 1.f); }
__device__ __forceinline__ float gelu_t(float x) { return 0.5f * x * (1.f + ftanh(0.7978845608f * (x + 0.044715f * x * x * x))); }
__device__ __forceinline__ float wave_sum(float v) {
#pragma unroll
    for (int o = 1; o < 64; o <<= 1) v += __shfl_xor(v, o);
    return v;
}
#define XB_TMO      128
#define XB_XCNT(j)  (256  + 64 * (j))
#define XB_XSUB(j)  (1280 + 64 * (j))
#define XB_XGEN(j)  (2304 + 64 * (j))
#define XB_TOP      3328
#define XB_TOPGEN   3392
#define XCD_BAR_WORDS 3456
#define XB_SPIN_CAP (1u << 18)

__device__ __forceinline__ unsigned xb_ld(unsigned* p)              { return __hip_atomic_load(p, __ATOMIC_RELAXED, __HIP_MEMORY_SCOPE_AGENT); }
__device__ __forceinline__ unsigned xb_add(unsigned* p, unsigned v) { return __hip_atomic_fetch_add(p, v, __ATOMIC_RELAXED, __HIP_MEMORY_SCOPE_AGENT); }
__device__ __forceinline__ unsigned xb_xcc_id() { return (unsigned)__builtin_amdgcn_s_getreg((3 << 11) | 20) & 0xFu; }
#define XB_SPIN(cond, bar) do { unsigned _sp = 0; while (cond) { __builtin_amdgcn_s_sleep(1); \
    if ((++_sp & 255u) == 0u) { if (xb_ld(&(bar)[XB_TMO])) break; if (_sp > XB_SPIN_CAP) { atomicAdd(&(bar)[XB_TMO], 1u); break; } } } } while (0)

struct XcdBarrier {
    unsigned* bar; unsigned x;
    volatile LAS unsigned* st;
};

__device__ __forceinline__ XcdBarrier xcd_barrier_post(unsigned* bar, volatile LAS unsigned* st) {
    XcdBarrier b; b.bar = bar; b.x = xb_xcc_id(); b.st = st;
    if (threadIdx.x == 0) (void)xb_add(&bar[XB_XCNT(b.x)], 1u);
    return b;
}
__device__ __forceinline__ void xcd_barrier_complete(unsigned* bar, unsigned x, unsigned& nloc, unsigned& nx) {
    const unsigned G = gridDim.x * gridDim.y * gridDim.z;
    unsigned sum, cnt, mine, sp = 0u;
    for (;;) {
        sum = 0u; cnt = 0u; mine = 0u;
#pragma unroll
        for (unsigned j = 0; j < 16; ++j) { const unsigned c = xb_ld(&bar[XB_XCNT(j)]); sum += c; cnt += (c > 0u) ? 1u : 0u; mine = (j == x) ? c : mine; }
        if (sum == G) break;
        __builtin_amdgcn_s_sleep(1);
        if ((++sp & 255u) == 0u) { if (xb_ld(&bar[XB_TMO])) break; if (sp > XB_SPIN_CAP) { atomicAdd(&bar[XB_TMO], 1u); break; } }
    }
    nloc = mine > 0u ? mine : 1u; nx = cnt > 0u ? cnt : 1u;
}

__device__ __forceinline__ void xcd_barrier(const XcdBarrier& b) {
    asm volatile("s_waitcnt vmcnt(0)" ::: "memory");
    __syncthreads();
    if (threadIdx.x == 0) {
        unsigned* bar = b.bar;
        __builtin_amdgcn_s_waitcnt(0);
        unsigned nloc = b.st[0], nx = b.st[1];
        if (nloc == 0u) { xcd_barrier_complete(bar, b.x, nloc, nx); b.st[0] = nloc; b.st[1] = nx; }
        const unsigned old = xb_add(&bar[XB_XSUB(b.x)], 1u);
        const unsigned gen = old / nloc;
        if (old + 1u == (gen + 1u) * nloc) {
            __builtin_amdgcn_fence(__ATOMIC_RELEASE, "agent");
            asm volatile("s_waitcnt vmcnt(0)" ::: "memory");
            const unsigned og = xb_add(&bar[XB_TOP], 1u);
            const unsigned tg = og / nx;
            if (og + 1u == (tg + 1u) * nx) xb_add(&bar[XB_TOPGEN], 1u);
            else XB_SPIN(xb_ld(&bar[XB_TOPGEN]) == tg, bar);
            __builtin_amdgcn_fence(__ATOMIC_ACQUIRE, "agent");
            xb_add(&bar[XB_XGEN(b.x)], 1u);
            asm volatile("s_waitcnt vmcnt(0)" ::: "memory");
        } else {
            XB_SPIN(xb_ld(&bar[XB_XGEN(b.x)]) == gen, bar);
            __builtin_amdgcn_fence(__ATOMIC_ACQUIRE, "agent");
            asm volatile("s_waitcnt vmcnt(0)" ::: "memory");
        }
    }
    __syncthreads();
}

struct Args { const float* in[31]; float* out; unsigned char* ws; int ph_lo, ph_hi; };
enum In { I_X = 0, I_C, I_CTX, I_CCTX, I_WADA, I_BADA, I_NORMG, I_FFNIN, I_FFNOUT, I_WIN, I_GMVN, I_GMWS, I_GMBS, I_CONV, I_W0, I_WUP, I_A0, I_AUP, I_GUP, I_KK, I_KA, I_RK, I_LNG, I_LNB,
          I_QN, I_KN, I_LAM, I_SUBLN, I_WBR, I_BGATE, I_WOUT };

__device__ __forceinline__ void ph_ada(const Args& a, LAS unsigned char* lds, int tid, int vcu, int G) {
    LAS float* sc = (LAS float*)lds;
    LAS float* red = sc + 3 * 2048;
    const float* c = a.in[I_C]; const float* cc = a.in[I_CCTX];
    for (int i = tid; i < 3 * 2048; i += NTHR) { const float x = i < 4096 ? c[i] : cc[i - 4096]; sc[i] = x * fsigm(x); }
    __syncthreads();
    const int lane = tid & 63, wave = tid >> 6;
    float* mods = (float*)(a.ws + WS_MODS);
    for (int u = vcu; u < NLAYER * 288; u += G) {
        const int l = u / 288, jc = u - l * 288, j = jc * 64 + lane;
        const float* W = a.in[I_WADA] + (size_t)l * 2048 * 18432 + j;
        float s0 = 0.f, s1 = 0.f, s2 = 0.f;
        const int k0 = wave * 256;
#pragma unroll 32
        for (int k = 0; k < 256; ++k) { const float w = W[(size_t)(k0 + k) * 18432]; s0 += sc[k0 + k] * w; s1 += sc[2048 + k0 + k] * w; s2 += sc[4096 + k0 + k] * w; }
        red[(wave * 3 + 0) * 64 + lane] = s0; red[(wave * 3 + 1) * 64 + lane] = s1; red[(wave * 3 + 2) * 64 + lane] = s2;
        __syncthreads();
        if (wave < 3) { float s = a.in[I_BADA][(size_t)l * 18432 + j];
#pragma unroll
            for (int w8 = 0; w8 < 8; ++w8) s += red[(w8 * 3 + wave) * 64 + lane];
            mods[(size_t)(l * 3 + wave) * 18432 + j] = s; }
        __syncthreads();
    }
}
__device__ __forceinline__ void transpose_item(const float* W, int N, int sc0, bf16* WT, int Kd, int nd0, int k0, LAS float* scr, int lane, bool permq = false) {
    if (sc0 >= 0) {
#pragma unroll
        for (int i = 0; i < 32; ++i) { const int kk = 2 * i + (lane >> 5); scr[kk * 33 + (lane & 31)] = W[(size_t)(k0 + kk) * N + sc0 + (lane & 31)]; }
    } else {
#pragma unroll 8
        for (int i = 0; i < 32; ++i) { const int kk = 2 * i + (lane >> 5); scr[kk * 33 + (lane & 31)] = 0.f; }
    }
    asm volatile("s_waitcnt lgkmcnt(0)" ::: "memory");
    const int c = lane & 7;
#pragma unroll
    for (int j = 0; j < 4; ++j) { const int n = (lane >> 3) + 8 * j;
        const int ns = permq ? (((n & 7) < 4) ? 4 * (n >> 3) + (n & 7) : 16 + 4 * (n >> 3) + (n & 7) - 4) : n;
        const LAS float* s = scr + (8 * c) * 33 + ns;
        v4u o; o.x = pk2(s[0 * 33], s[1 * 33]); o.y = pk2(s[2 * 33], s[3 * 33]); o.z = pk2(s[4 * 33], s[5 * 33]); o.w = pk2(s[6 * 33], s[7 * 33]);
        *(GAS v4u*)(WT + (size_t)(nd0 + n) * Kd + k0 + 8 * c) = o; }
    asm volatile("s_waitcnt lgkmcnt(0)" ::: "memory");
}
__device__ __forceinline__ void ph_weights(const Args& a, int l, LAS unsigned char* lds, int tid, int vcu, int G) {
    const int lane = tid & 63, wave = tid >> 6;
    LAS float* scr = (LAS float*)(lds + wave * 16384);
    const int gw = vcu * NWAVES + wave, NGW = G * NWAVES;
    constexpr int I_F1 = 32 * (FF2 / 32), I_F2 = (FF / 64) * (DM / 32), I_IN = 32 * (PROJP / 32), I_BR = 16 * (DM / 32), I_WO = 32 * (DM / 32);
    constexpr int NITEMS = 2 * I_F1 + 2 * I_F2 + I_IN + 3 * I_BR + I_WO;
    unsigned char* ws = a.ws;
    for (int it = gw; it < NITEMS; it += NGW) {
        int r = it;
        if (r < 2 * I_F1) { const int mi = l * 2 + r / I_F1, q = r % I_F1, nb = q % (FF2 / 32), kb = q / (FF2 / 32), nd0 = 32 * nb, pn = nd0 >> 8, rr = nd0 & 255;
            const int sc0 = rr < 128 ? pn * 128 + rr : FF + pn * 128 + (rr - 128);
            transpose_item(a.in[I_FFNIN] + (size_t)mi * DM * FF2, FF2, sc0, (bf16*)(ws + WS_WF1 + (size_t)mi * SZ_WF1), DM, nd0, 64 * kb, scr, lane); continue; }
        r -= 2 * I_F1;
        if (r < 2 * I_F2) { const int mi = l * 2 + r / I_F2, q = r % I_F2, nb = q % (DM / 32), kb = q / (DM / 32);
            transpose_item(a.in[I_FFNOUT] + (size_t)mi * FF * DM, DM, 32 * nb, (bf16*)(ws + WS_WF2 + (size_t)mi * SZ_WF2), FF, 32 * nb, 64 * kb, scr, lane); continue; }
        r -= 2 * I_F2;
        if (r < I_IN) { const int mi = l, q = r, nb = q % (PROJP / 32), kb = q / (PROJP / 32), nd0 = 32 * nb, T = nd0 >> 8, cc = nd0 & 255;
            int sc0; bool pq = false;
            if (T <= 21) sc0 = nd0;
            else if (T == 22) sc0 = cc < 128 ? nd0 : -1;
            else if (T <= 30) { sc0 = P_QKV + ((T - 23) * 4 + ((cc >> 5) & 3)) * 64 + (cc >> 7) * 32; pq = true; }
            else if (T <= 34) sc0 = P_QKV + 2048 + (nd0 - 31 * 256);
            else sc0 = P_GATE + (nd0 - 35 * 256);
            transpose_item(a.in[I_WIN] + (size_t)mi * DM * PROJ, PROJ, sc0, (bf16*)(ws + WS_WIN + (size_t)mi * SZ_WIN), DM, nd0, 64 * kb, scr, lane, pq); continue; }
        r -= I_IN;
        if (r < 3 * I_BR) { const int mi = l * 3 + r / I_BR, q = r % I_BR, nb = q % (DM / 32), kb = q / (DM / 32);
            transpose_item(a.in[I_WBR] + (size_t)mi * 1024 * DM, DM, 32 * nb, (bf16*)(ws + WS_WBR + (size_t)mi * ((size_t)DM * 1024 * 2)), 1024, 32 * nb, 64 * kb, scr, lane); continue; }
        r -= 3 * I_BR;
        { const int mi = l, q = r, nb = q % (DM / 32), kb = q / (DM / 32);
            transpose_item(a.in[I_WOUT] + (size_t)mi * DM * DM, DM, 32 * nb, (bf16*)(ws + WS_WOUT + (size_t)mi * SZ_WOUT), DM, 32 * nb, 64 * kb, scr, lane); }
    }
}
__device__ __forceinline__ void ph_small(const Args& a, int tid, int vcu, int G) {
    unsigned char* ws = a.ws;
    const int gt = vcu * NTHR + tid, NGT = G * NTHR;
    for (int i = gt; i < NLAYER * LOW * (ACTW / 8); i += NGT) {
        const int l = i / (LOW * (ACTW / 8)), q = i % (LOW * (ACTW / 8)), n = q / (ACTW / 8), k0 = (q % (ACTW / 8)) * 8, sec = n >> 10, cc = n & 1023;
        float f[8];
#pragma unroll
        for (int e = 0; e < 8; ++e) { const int k = k0 + e; float v = 0.f;
            if (sec == 0) { if (k < 256) v = a.in[I_GUP][((size_t)l * 256 + k) * 1024 + cc]; }
            else if (sec <= 2) { const int d = sec - 1, kb = 256 + 128 * d; if (k >= kb && k < kb + 96) v = a.in[I_WUP][((size_t)(l * 2 + d) * 96 + (k - kb)) * 1024 + cc]; }
            else { const int d = sec - 3, kb = 512 + 128 * d; if (k >= kb && k < kb + 96) v = a.in[I_AUP][((size_t)(l * 2 + d) * 96 + (k - kb)) * 1024 + cc]; }
            f[e] = v; }
        *(GAS v4u*)((bf16*)(ws + WS_WLO) + ((size_t)l * LOW + n) * ACTW + k0) = pack8(f);
    }
    for (int i = gt; i < 64 * 16; i += NGT) { const int p = i >> 4, ii = i & 15;
        const float inv = exp2f(-(float)(2 * ii) * (1.f / 32.f) * 13.287712379549449f);
        const float rev = (float)p * inv * 0.15915494309189535f;
        float* rt = (float*)(ws + WS_ROPE) + 2 * i; rt[0] = __builtin_amdgcn_cosf(rev); rt[1] = __builtin_amdgcn_sinf(rev); }
}

__device__ __forceinline__ void norm_row_store(f32x4 (&v)[8], int m, const float* gain, const float* mods, int si, bf16* XN, int lane) {
    float ss = 0.f;
#pragma unroll
    for (int j = 0; j < 8; ++j) ss += (v[j].x * v[j].x + v[j].y * v[j].y) + (v[j].z * v[j].z + v[j].w * v[j].w);
    const float rinv = 1.f / sqrtf(wave_sum(ss) * (1.f / DM) + 1e-6f);
    const int set = m < TSEQ ? 0 : (m < NLAT ? 1 : 2);
    const float* sh = mods + (size_t)(set * NMOD + si) * DM; const float* scl = sh + DM;
#pragma unroll
    for (int j = 0; j < 8; ++j) { const int col = 4 * lane + 256 * j;
        const f32x4 g = *(const GAS f32x4*)(gain + col), s1 = *(const GAS f32x4*)(scl + col), s0 = *(const GAS f32x4*)(sh + col);
        const f32x4 o = (v[j] * rinv * g) * (s1 + 1.f) + s0;
        v2u w; w.x = pk2(o.x, o.y); w.y = pk2(o.z, o.w);
        *(GAS v2u*)(XN + (size_t)m * DM + col) = w; }
}
__device__ __forceinline__ void ph_norm(const float* xl, const float* xc, const float* gain, const float* mods  , int si, bf16* XN, float* xs_out, const bf16* part, int nsplit, int nrows, int gw, int NGW, int lane, LAS float* red) {
    if (NLAT == 4 * NGW) {
        f32x4 v[4][8];
#pragma unroll
        for (int q = 0; q < 4; ++q)
#pragma unroll
            for (int j = 0; j < 8; ++j) v[q][j] = *(const GAS f32x4*)(xl + (size_t)(gw + q * NGW) * DM + 4 * lane + 256 * j);
        float rinv[4];
#pragma unroll
        for (int q = 0; q < 4; ++q) { float ss = 0.f;
#pragma unroll
            for (int j = 0; j < 8; ++j) ss += (v[q][j].x * v[q][j].x + v[q][j].y * v[q][j].y) + (v[q][j].z * v[q][j].z + v[q][j].w * v[q][j].w);
            rinv[q] = 1.f / sqrtf(wave_sum(ss) * (1.f / DM) + 1e-6f); }
        const float* sh0 = mods + (size_t)(0 * NMOD + si) * DM; const float* sh1 = mods + (size_t)(1 * NMOD + si) * DM;
#pragma unroll
        for (int j = 0; j < 8; ++j) { const int col = 4 * lane + 256 * j;
            const f32x4 g = *(const GAS f32x4*)(gain + col), a0 = *(const GAS f32x4*)(sh0 + DM + col) + 1.f, b0 = *(const GAS f32x4*)(sh0 + col), a1 = *(const GAS f32x4*)(sh1 + DM + col) + 1.f, b1 = *(const GAS f32x4*)(sh1 + col);
#pragma unroll
            for (int q = 0; q < 4; ++q) { const f32x4 o = (v[q][j] * rinv[q] * g) * (q < 2 ? a0 : a1) + (q < 2 ? b0 : b1);
                v2u w; w.x = pk2(o.x, o.y); w.y = pk2(o.z, o.w);
                *(GAS v2u*)(XN + (size_t)(gw + q * NGW) * DM + col) = w; } }
    } else
    for (int m = gw; m < NLAT; m += 2 * NGW) {
        const int m2 = m + NGW; const bool two = m2 < NLAT;
        f32x4 v[8], u[8];
#pragma unroll
        for (int j = 0; j < 8; ++j) v[j] = *(const GAS f32x4*)(xl + (size_t)m * DM + 4 * lane + 256 * j);
        if (two) {
#pragma unroll
            for (int j = 0; j < 8; ++j) u[j] = *(const GAS f32x4*)(xl + (size_t)m2 * DM + 4 * lane + 256 * j); }
        norm_row_store(v, m, gain, mods, si, XN, lane);
        if (two) norm_row_store(u, m2, gain, mods, si, XN, lane);
    }
    if (nrows > NLAT && NCTX * 4 == NGW) {
        const int wave = gw & 7, r = gw >> 2, m = NLAT + r, col = (gw & 3) * 512 + 8 * lane;
        f32x4 x0 = *(const GAS f32x4*)(xc + (size_t)r * DM + col), x1 = *(const GAS f32x4*)(xc + (size_t)r * DM + col + 4);
        if (part != nullptr)
#pragma nounroll
        for (int s = 0; s < nsplit; s += 8) {
            v4u p[8];
#pragma unroll
            for (int q = 0; q < 8; ++q) p[q] = *(const GAS v4u*)(part + ((size_t)(s + q) * NCTX + r) * DM + col);
#pragma unroll
            for (int q = 0; q < 8; ++q) { x0.x += bflo(p[q].x); x0.y += bfhi(p[q].x); x0.z += bflo(p[q].y); x0.w += bfhi(p[q].y); x1.x += bflo(p[q].z); x1.y += bfhi(p[q].z); x1.z += bflo(p[q].w); x1.w += bfhi(p[q].w); } }
        *(GAS f32x4*)(xs_out + (size_t)m * DM + col) = x0; *(GAS f32x4*)(xs_out + (size_t)m * DM + col + 4) = x1;
        const float ss = wave_sum((x0.x * x0.x + x0.y * x0.y) + (x0.z * x0.z + x0.w * x0.w) + (x1.x * x1.x + x1.y * x1.y) + (x1.z * x1.z + x1.w * x1.w));
        if (lane == 0) red[wave] = ss;
        __syncthreads();
        const LAS float* rq = red + (wave & 4);
        const float rinv = 1.f / sqrtf(((rq[0] + rq[1]) + (rq[2] + rq[3])) * (1.f / DM) + 1e-6f);
        const float* sh = mods + (size_t)(2 * NMOD + si) * DM; const float* scl = sh + DM;
        const f32x4 g0 = *(const GAS f32x4*)(gain + col), g1 = *(const GAS f32x4*)(gain + col + 4), s10 = *(const GAS f32x4*)(scl + col), s11 = *(const GAS f32x4*)(scl + col + 4), s00 = *(const GAS f32x4*)(sh + col), s01 = *(const GAS f32x4*)(sh + col + 4);
        const f32x4 o0 = (x0 * rinv * g0) * (s10 + 1.f) + s00, o1 = (x1 * rinv * g1) * (s11 + 1.f) + s01;
        v4u w; w.x = pk2(o0.x, o0.y); w.y = pk2(o0.z, o0.w); w.z = pk2(o1.x, o1.y); w.w = pk2(o1.z, o1.w);
        *(GAS v4u*)(XN + (size_t)m * DM + col) = w;
        __syncthreads();
    } else
    if (nrows > NLAT && (gw & 3) == 0) for (int r = gw >> 2; r < NCTX; r += NGW >> 2) {
        const int m = NLAT + r;
        f32x4 v[8];
#pragma unroll
        for (int j = 0; j < 8; ++j) v[j] = *(const GAS f32x4*)(xc + (size_t)r * DM + 4 * lane + 256 * j);
        if (part != nullptr)
#pragma nounroll
        for (int s = 0; s < nsplit; s += 4) {
            v2u p[4][8];
#pragma unroll
            for (int q = 0; q < 4; ++q)
#pragma unroll
                for (int j = 0; j < 8; ++j) p[q][j] = *(const GAS v2u*)(part + ((size_t)(s + q) * NCTX + r) * DM + 4 * lane + 256 * j);
#pragma unroll
            for (int q = 0; q < 4; ++q)
#pragma unroll
                for (int j = 0; j < 8; ++j) { v[j].x += bflo(p[q][j].x); v[j].y += bfhi(p[q][j].x); v[j].z += bflo(p[q][j].y); v[j].w += bfhi(p[q][j].y); } }
#pragma unroll
        for (int j = 0; j < 8; ++j) *(GAS f32x4*)(xs_out + (size_t)m * DM + 4 * lane + 256 * j) = v[j];
        norm_row_store(v, m, gain, mods, si, XN, lane);
    }
}

struct RkvkItem { v4u x[3][3]; int m, c0; bool hp, hn; };
__device__ __forceinline__ void rkvk_load(RkvkItem& it, const bf16* P, int i) {
    const int m = i >> 7, c0 = (i & 127) * 8; it.m = m; it.c0 = c0;
    const int t = m < NLAT ? (m & (TSEQ - 1)) : ((m - NLAT) & (TCTX - 1)), tl = m < NLAT ? TSEQ : TCTX;
    it.hp = t > 0; it.hn = t < tl - 1;
#pragma unroll
    for (int sec = 0; sec < 3; ++sec) { const bf16* pc = P + (size_t)m * PROJP + P_RKV + sec * 1024 + c0;
        it.x[sec][1] = *(const GAS v4u*)pc;
        it.x[sec][0] = it.hp ? *(const GAS v4u*)(pc - PROJP) : (v4u){0u, 0u, 0u, 0u};
        it.x[sec][2] = it.hn ? *(const GAS v4u*)(pc + PROJP) : (v4u){0u, 0u, 0u, 0u}; }
}
__device__ __forceinline__ void rkvk_finish(const RkvkItem& it, bf16* RK, const float* cw, const float* kkw) {
    const int c0 = it.c0; float rkv[3][8];
#pragma unroll
    for (int sec = 0; sec < 3; ++sec) { const int col = sec * 1024 + c0; float x0[8], x1[8], x2[8];
        unpack8(it.x[sec][0], x0); unpack8(it.x[sec][1], x1); unpack8(it.x[sec][2], x2);
#pragma unroll
        for (int e = 0; e < 8; ++e) rkv[sec][e] = x1[e] * cw[3072 + col + e] + x0[e] * cw[col + e] + x2[e] * cw[2 * 3072 + col + e]; }
    float kk8[8]; float ss = 0.f;
#pragma unroll
    for (int e = 0; e < 8; ++e) { kk8[e] = rkv[1][e] * kkw[c0 + e]; ss += kk8[e] * kk8[e]; }
    ss += __shfl_xor(ss, 1); ss += __shfl_xor(ss, 2); ss += __shfl_xor(ss, 4);
    const float rinv = 1.f / sqrtf(ss + 1e-12f);
    GAS v4u* dst = (GAS v4u*)(RK + (size_t)it.m * 4096 + c0 * 4);
#pragma unroll
    for (int j = 0; j < 4; ++j) { v4u o; o.x = pk2(rkv[0][2 * j], rkv[1][2 * j]); o.y = pk2(rkv[2][2 * j], kk8[2 * j] * rinv); o.z = pk2(rkv[0][2 * j + 1], rkv[1][2 * j + 1]); o.w = pk2(rkv[2][2 * j + 1], kk8[2 * j + 1] * rinv); dst[j] = o; }
}
__device__ __forceinline__ void ph_e1(const Args& a, int l, int gt, int NGT) {
    const bf16* P = (const bf16*)(a.ws + WS_P); bf16* RK = (bf16*)(a.ws + WS_RKVK);
    const float* cw = a.in[I_CONV] + (size_t)l * 3 * 3072; const float* kkw = a.in[I_KK] + l * 1024;
    constexpr int NI = MT * 128;
    for (int i = gt; i < NI; i += 2 * NGT) {
        RkvkItem A, B; const bool two = i + NGT < NI;
        rkvk_load(A, P, i); if (two) rkvk_load(B, P, i + NGT);
        rkvk_finish(A, RK, cw, kkw); if (two) rkvk_finish(B, RK, cw, kkw);
    }
}

__device__ __forceinline__ void ph_gmlp(const Args& a, int l, LAS unsigned char* lds, int tid, int vcu, int G) {
    constexpr int VP = 136;
    LAS bf16* vnT = (LAS bf16*)lds;
    const bf16* P = (const bf16*)(a.ws + WS_P); bf16* YA = (bf16*)(a.ws + WS_Y3);
    const float* vng = a.in[I_GMVN] + l * 1024; const float* wsm = a.in[I_GMWS] + (size_t)l * 8 * 128 * 128; const float* bs = a.in[I_GMBS] + l * 8 * 128;
    const int lane = tid & 63, w = tid >> 6, fr = lane & 15, fq = lane >> 4;
    for (int u = vcu; u < (MT / 128) * 8; u += G) {
        const int n = u >> 3, g = u & 7, m0 = n * 128;
        { const int q = tid >> 2, qt = tid & 3; const bf16* src = P + (size_t)(m0 + q) * PROJP + P_V + g * 128 + qt * 32;
            float v[32]; float ss = 0.f;
#pragma unroll
            for (int j = 0; j < 4; ++j) { float f[8]; unpack8(*(const GAS v4u*)(src + 8 * j), f);
#pragma unroll
                for (int e = 0; e < 8; ++e) { const float x = f[e]; v[8 * j + e] = x; ss += x * x; } }
            ss += __shfl_xor(ss, 1); ss += __shfl_xor(ss, 2);
            const float rinv = 1.f / sqrtf(ss * (1.f / 128.f) + 1e-6f);
#pragma unroll
            for (int e = 0; e < 32; ++e) { const int c = qt * 32 + e; vnT[c * VP + q] = (bf16)f2bf(v[e] * rinv * vng[g * 128 + c]); } }
        __syncthreads();
        pg8::f32x4 acc[8];
#pragma unroll
        for (int cb = 0; cb < 8; ++cb) acc[cb] = (pg8::f32x4){0.f, 0.f, 0.f, 0.f};
#pragma unroll
        for (int ks = 0; ks < 4; ++ks) {
            const float* wr = wsm + ((size_t)g * 128 + 16 * w + fr) * 128 + ks * 32 + 8 * fq;
            const f32x4 w0 = *(const GAS f32x4*)wr, w1 = *(const GAS f32x4*)(wr + 4);
            v4u aw; aw.x = pk2(w0.x, w0.y); aw.y = pk2(w0.z, w0.w); aw.z = pk2(w1.x, w1.y); aw.w = pk2(w1.z, w1.w);
            const bf16x8 af = __builtin_bit_cast(bf16x8, aw);
#pragma unroll
            for (int cb = 0; cb < 8; ++cb) { const bf16x8 bfr = *(const LAS bf16x8*)(vnT + (cb * 16 + fr) * VP + ks * 32 + 8 * fq);
                acc[cb] = __builtin_amdgcn_mfma_f32_16x16x32_bf16(bfr, af, acc[cb], 0, 0, 0); }
        }
        { const int p = 16 * w + fr; const float bsp = bs[g * 128 + p];
          const bf16* pup = P + (size_t)(m0 + p) * PROJP + P_U + g * 128 + 4 * fq; bf16* yap = YA + (size_t)(m0 + p) * 1024 + g * 128 + 4 * fq;
          v2u pu[8];
#pragma unroll
          for (int cb = 0; cb < 8; ++cb) pu[cb] = *(const GAS v2u*)(pup + cb * 16);
#pragma unroll
          for (int cb = 0; cb < 8; ++cb) { v2u o;
              o.x = pk2(bflo(pu[cb].x) * (acc[cb][0] + bsp), bfhi(pu[cb].x) * (acc[cb][1] + bsp)); o.y = pk2(bflo(pu[cb].y) * (acc[cb][2] + bsp), bfhi(pu[cb].y) * (acc[cb][3] + bsp));
              *(GAS v2u*)(yap + cb * 16) = o; } }
        __syncthreads();
    }
}

namespace att {
using bf16x8 = __attribute__((ext_vector_type(8))) short;
using s16x4  = __attribute__((ext_vector_type(4))) short;
using f32x16 = __attribute__((ext_vector_type(16))) float;
using u32x4  = __attribute__((ext_vector_type(4))) unsigned;
constexpr int NW = 8, QBLK = 32, KVBLK = 64;
constexpr int SHM_V = KVBLK * 128 * 2, SHM_K = KVBLK * 64 * 2, SHM_ATTN = 2 * SHM_V + 2 * SHM_K + NW * 64 * 4;
#define KSWZ(row, colB) ((row) * 128 + ((colB) ^ ((((row) >> 1) & 7) << 4)))
#define SBAR() __builtin_amdgcn_sched_barrier(0)
__device__ __forceinline__ int crow(int r, int hi) { return (r & 3) + 8 * (r >> 2) + 4 * hi; }
__device__ __forceinline__ unsigned cvtpk(float lo, float hi) { unsigned r; asm volatile("v_cvt_pk_bf16_f32 %0, %1, %2" : "=v"(r) : "v"(lo), "v"(hi)); return r; }
__device__ __forceinline__ void partialSM(f32x16& p0, f32x16& p1) {
#pragma unroll
  for (int r = 0; r < 16; ++r) p0[r] = __builtin_amdgcn_exp2f(p0[r]);
}
__device__ __forceinline__ void finishSM(f32x16& p0, f32x16& p1, float& l_reg, bf16x8& pa0, bf16x8& pa1, bf16x8& pa2, bf16x8& pa3) {
#pragma unroll
  for (int r = 0; r < 16; ++r) p1[r] = __builtin_amdgcn_exp2f(p1[r]);
  float ps = 0;
#pragma unroll
  for (int r = 0; r < 16; ++r) ps += p0[r];
#pragma unroll
  for (int r = 0; r < 16; ++r) ps += p1[r];
  { auto rr = __builtin_amdgcn_permlane32_swap(__float_as_uint(ps), __float_as_uint(ps), false, false);
    ps = __uint_as_float(rr[0]) + __uint_as_float(rr[1]); }
  l_reg += ps;
#define PK4(P, BASE, OUT) do { unsigned a0 = cvtpk(P[BASE + 0], P[BASE + 1]), a1 = cvtpk(P[BASE + 2], P[BASE + 3]);   \
    unsigned b0 = cvtpk(P[BASE + 4], P[BASE + 5]), b1 = cvtpk(P[BASE + 6], P[BASE + 7]);                              \
    auto r0 = __builtin_amdgcn_permlane32_swap(a0, b0, false, false); auto r1 = __builtin_amdgcn_permlane32_swap(a1, b1, false, false); \
    u32x4 w = {r0[0], r1[0], r0[1], r1[1]}; OUT = *reinterpret_cast<bf16x8*>(&w); } while (0)
  PK4(p0, 0, pa0); PK4(p0, 8, pa1); PK4(p1, 0, pa2); PK4(p1, 8, pa3);
#undef PK4
}
__device__ __forceinline__ void qkt(f32x16& p0, f32x16& p1, const unsigned short* Ks, const bf16x8* qr, int r32, int hi) {
  p0 = f32x16{}; p1 = f32x16{};
#pragma unroll
  for (int d0 = 0; d0 < 4; ++d0) { int cb = (d0 * 16 + hi * 8) * 2;
    bf16x8 b0 = *reinterpret_cast<const bf16x8*>((const char*)Ks + KSWZ(r32, cb));
    bf16x8 b1 = *reinterpret_cast<const bf16x8*>((const char*)Ks + KSWZ(32 + r32, cb));
    p0 = __builtin_amdgcn_mfma_f32_32x32x16_bf16(b0, qr[d0], p0, 0, 0, 0);
    p1 = __builtin_amdgcn_mfma_f32_32x32x16_bf16(b1, qr[d0], p1, 0, 0, 0); }
}
__device__ __forceinline__ int v_st(int k, int c) { const int kk = (k & ~0xC) | ((k & 4) << 1) | ((k & 8) >> 1); return ((kk >> 3) * 4 + (c >> 5)) * 512 + ((kk & 7) * 32 + (c & 31)) * 2; }
__device__ __forceinline__ int v_rd_base(int lane) { return ((lane & 3) << 3) | (((lane >> 2) & 3) << 6) | (((lane >> 4) & 1) << 5) | (((lane >> 5) & 1) << 8); }
constexpr int v_rd_off(int d0, int ks, int half) { return d0 * 512 + ks * 4096 + half * 2048; }
template <int OFF> __device__ __forceinline__ s16x4 tr_read(int vb) {
  s16x4 r; asm volatile("ds_read_b64_tr_b16 %0, %1 offset:%2" : "=&v"(r) : "v"(vb), "i"(OFF) : "memory"); return r;
}
template <int D0> __device__ __forceinline__ void pv_one(f32x16& od, int vb, bf16x8 pa0, bf16x8 pa1, bf16x8 pa2, bf16x8 pa3) {
  const s16x4 l0 = tr_read<v_rd_off(D0, 0, 0)>(vb), h0 = tr_read<v_rd_off(D0, 0, 1)>(vb), l1 = tr_read<v_rd_off(D0, 1, 0)>(vb), h1 = tr_read<v_rd_off(D0, 1, 1)>(vb);
  const s16x4 l2 = tr_read<v_rd_off(D0, 2, 0)>(vb), h2 = tr_read<v_rd_off(D0, 2, 1)>(vb), l3 = tr_read<v_rd_off(D0, 3, 0)>(vb), h3 = tr_read<v_rd_off(D0, 3, 1)>(vb);
  asm volatile("s_waitcnt lgkmcnt(0)" ::: "memory"); SBAR();
#define PK(L, H) (bf16x8){L[0], L[1], L[2], L[3], H[0], H[1], H[2], H[3]}
  od = __builtin_amdgcn_mfma_f32_32x32x16_bf16(pa0, PK(l0, h0), od, 0, 0, 0);
  od = __builtin_amdgcn_mfma_f32_32x32x16_bf16(pa1, PK(l1, h1), od, 0, 0, 0);
  od = __builtin_amdgcn_mfma_f32_32x32x16_bf16(pa2, PK(l2, h2), od, 0, 0, 0);
  od = __builtin_amdgcn_mfma_f32_32x32x16_bf16(pa3, PK(l3, h3), od, 0, 0, 0);
#undef PK
}
__device__ __forceinline__ void pv_d0(f32x16* o, int vb, bf16x8 pa0, bf16x8 pa1, bf16x8 pa2, bf16x8 pa3) {
  pv_one<0>(o[0], vb, pa0, pa1, pa2, pa3); pv_one<1>(o[1], vb, pa0, pa1, pa2, pa3); pv_one<2>(o[2], vb, pa0, pa1, pa2, pa3); pv_one<3>(o[3], vb, pa0, pa1, pa2, pa3);
}
__device__ __forceinline__ void attn_unit(const unsigned short* __restrict__ Qb, const unsigned short* __restrict__ Kb, const unsigned short* __restrict__ Vb,
                                          unsigned short* __restrict__ Ob, int NT, int ntl, int klat, int kctx, char* lds) {
  constexpr int LDQ = 2048, LDKK = 2048, LDV = 15104, LDO = 1024;
  const int tid = threadIdx.x, wid = tid >> 6, lane = tid & 63, r32 = lane & 31, hi = lane >> 5;
  unsigned short* V_lds = (unsigned short*)lds; unsigned short* K_lds = (unsigned short*)(lds + 2 * SHM_V);
  float* ws = (float*)(lds + 2 * SHM_V + 2 * SHM_K) + wid * 64; float* li_l = ws;
  float l_reg = 0; f32x16 o[4] = {}; bf16x8 qr[4];
  const unsigned short* Qw = Qb + (long)(wid * QBLK + r32) * LDQ + hi * 8;
#pragma unroll
  for (int d0 = 0; d0 < 4; ++d0) qr[d0] = *reinterpret_cast<const bf16x8*>(Qw + d0 * 16);
  const int sr = tid >> 4, sc = (tid & 15) * 8, vst0 = v_st(sr, sc), vst1 = v_st(32 + sr, sc);
  const int kr = tid >> 3, kc = (tid & 7) * 8, kst = KSWZ(kr, kc * 2);
  const int vb0 = (int)(uintptr_t)V_lds + v_rd_base(lane);
  struct { bf16x8 vs0, vs1, ks0; } sr_[2];
#define KROW(t) ((t) < ntl ? klat + 64 * (t) : kctx + 64 * ((t) - ntl))
#define SLOAD(i, t) do { const long k0_ = KROW(t); sr_[i].vs0 = *reinterpret_cast<const bf16x8*>(&Vb[(k0_ + sr) * LDV + sc]); sr_[i].vs1 = *reinterpret_cast<const bf16x8*>(&Vb[(k0_ + 32 + sr) * LDV + sc]); \
    sr_[i].ks0 = *reinterpret_cast<const bf16x8*>(&Kb[(k0_ + kr) * LDKK + kc]); } while (0)
#define SWRITE(b, i) do { *(bf16x8*)((char*)V_lds + (b) * SHM_V + vst0) = sr_[i].vs0; *(bf16x8*)((char*)V_lds + (b) * SHM_V + vst1) = sr_[i].vs1; \
    *(bf16x8*)((char*)K_lds + (b) * SHM_K + kst) = sr_[i].ks0; } while (0)
#define SWAIT() asm volatile("s_waitcnt vmcnt(3)" ::: "memory")
  f32x16 pA0, pA1, pB0, pB1; bf16x8 pa0, pa1, pa2, pa3;
  constexpr int SE = 0, SO = 1;
  SLOAD(SE, 0); asm volatile("s_waitcnt vmcnt(0)" ::: "memory"); SWRITE(0, SE); __syncthreads();
  qkt(pA0, pA1, K_lds, qr, r32, hi); partialSM(pA0, pA1);
  SLOAD(SO, 1); if (2 < NT) SLOAD(SE, 2);
  SWAIT(); SWRITE(1, SO); __syncthreads();
  for (int j = 1; j + 1 < NT; j += 2) {
    SBAR(); qkt(pB0, pB1, (const unsigned short*)((char*)K_lds + SHM_K), qr, r32, hi);
    finishSM(pA0, pA1, l_reg, pa0, pa1, pa2, pa3); SBAR();
    SLOAD(SO, j + 2); SBAR();
    pv_d0(o, vb0, pa0, pa1, pa2, pa3); partialSM(pB0, pB1);
    __syncthreads(); SWAIT(); SWRITE(0, SE);
    __syncthreads();
    SBAR(); qkt(pA0, pA1, K_lds, qr, r32, hi);
    finishSM(pB0, pB1, l_reg, pa0, pa1, pa2, pa3); SBAR();
    if (j + 3 < NT) SLOAD(SE, j + 3); SBAR();
    pv_d0(o, vb0 + (int)SHM_V, pa0, pa1, pa2, pa3); partialSM(pA0, pA1);
    __syncthreads(); SWAIT(); SWRITE(1, SO);
    __syncthreads();
  }
  SBAR(); qkt(pB0, pB1, (const unsigned short*)((char*)K_lds + SHM_K), qr, r32, hi);
  finishSM(pA0, pA1, l_reg, pa0, pa1, pa2, pa3); SBAR();
  pv_d0(o, vb0, pa0, pa1, pa2, pa3); partialSM(pB0, pB1);
  __syncthreads();
  finishSM(pB0, pB1, l_reg, pa0, pa1, pa2, pa3); SBAR();
  pv_d0(o, vb0 + (int)SHM_V, pa0, pa1, pa2, pa3);
  if (hi == 0) li_l[r32] = l_reg; asm volatile("s_waitcnt lgkmcnt(0)" ::: "memory");
  float rli[16];
#pragma unroll
  for (int r = 0; r < 16; ++r) rli[r] = __builtin_amdgcn_rcpf(li_l[crow(r, hi)]);
  unsigned short* Ow = Ob + (long)(wid * QBLK) * LDO;
#pragma unroll
  for (int r = 0; r < 16; ++r) { int orow = crow(r, hi);
#pragma unroll
    for (int d0 = 0; d0 < 4; ++d0) Ow[(long)orow * LDO + d0 * 32 + r32] = (unsigned short)(cvtpk(o[d0][r] * rli[r], 0.f) & 0xffffu); }
  __syncthreads();
#undef KROW
#undef SLOAD
#undef SWRITE
#undef SWAIT
}
#undef KSWZ
#undef SBAR
}

__device__ __forceinline__ void ph_attn_one(const Args& a, int u, char* lds) {
    const unsigned short* QK = (const unsigned short*)(a.ws + WS_QK); const unsigned short* P = (const unsigned short*)(a.ws + WS_P); unsigned short* OJ = (unsigned short*)(a.ws + WS_OJ);
    int b, hj, qrow0, NT, ntl;
    if (u < 512) { b = u >> 8; hj = (u >> 4) & 15; qrow0 = b * TSEQ + (u & 15) * 256; NT = 68; ntl = 64; }
    else { const int uu = u - 512; b = uu >> 4; hj = uu & 15; qrow0 = NLAT + b * TCTX; NT = 4; ntl = 0; }
    att::attn_unit(QK + (size_t)qrow0 * DM + hj * 64, QK + 1024 + hj * 64, P + P_V2 + (hj >> 1) * 128,
                   OJ + ((size_t)(hj & 1) * MT + qrow0) * 1024 + (hj >> 1) * 128, NT, ntl, b * TSEQ, NLAT + b * TCTX, lds);
}
__device__ __forceinline__ void ph_attn(const Args& a, char* lds, int u0, int ustep, int uend, int cu) {
    bool done = false;
    for (int u = u0; !done; u += ustep) { int uu = u; if (u >= uend) { if (cu < 0) break; uu = 512 + cu; done = true; } ph_attn_one(a, uu, lds); }
}

__device__ __forceinline__ int scan_row(int i, int b, int d) { return i < TCTX ? NLAT + b * TCTX + (d ? TCTX - 1 - i : i) : b * TSEQ + (d ? TSEQ - 1 - (i - TCTX) : (i - TCTX)); }
typedef __amdgpu_buffer_rsrc_t rsrc_t;
typedef short s16x4 __attribute__((ext_vector_type(4)));
typedef __bf16 bf16x2_t __attribute__((ext_vector_type(2)));
typedef float f32x2_t __attribute__((ext_vector_type(2)));
__device__ __forceinline__ unsigned cvtpk_c(float lo, float hi) { f32x2_t v = {lo, hi}; bf16x2_t b = __builtin_convertvector(v, bf16x2_t); return __builtin_bit_cast(unsigned, b); }
constexpr int CS_SLOT = 12288, CS_NSLOT = 8, CS_OFF_A1 = 0, CS_OFF_RH = 2048, CS_OFF_MT = 4352, CS_OFF_Q = 4864, CS_OFF_P = 5376, CS_OFF_KB = 5888, CS_OFF_V = 9984, CS_OFF_G = 12032;
constexpr int CS_PITCH = 144, CS_SCR0 = CS_NSLOT * CS_SLOT, CS_SCR = 8192, CS_S_KK = 0, CS_S_KD = 2304, CS_S_NB = 4608, CS_S_U = 6912;
static_assert(CS_SCR0 + 4 * CS_SCR <= RING_BYTES, "scan LDS");
__device__ __forceinline__ pg8::f32x4 mfma32(bf16x8 a_, bf16x8 b_, pg8::f32x4 c_) { return __builtin_amdgcn_mfma_f32_16x16x32_bf16(a_, b_, c_, 0, 0, 0); }
__device__ __forceinline__ pg8::f32x4 mfma16(v2u a_, v2u b_, pg8::f32x4 c_) { return __builtin_amdgcn_mfma_f32_16x16x16bf16_1k(__builtin_bit_cast(s16x4, a_), __builtin_bit_cast(s16x4, b_), c_, 0, 0, 0); }
__device__ __forceinline__ v2u pack4(const pg8::f32x4 x) { return (v2u){cvtpk_c(x[0], x[1]), cvtpk_c(x[2], x[3])}; }
__device__ __forceinline__ void scan_unit(const Args& a, int l, int u, LAS unsigned char* lds, int tid) {
    const int lane = tid & 63, w = __builtin_amdgcn_readfirstlane(tid >> 6), fr = lane & 15, fq = lane >> 4;
    const int b = u >> 5, h = (u >> 1) & 15, d = u & 1;
    constexpr int NBLK = (TCTX + TSEQ) / 16, NR = NBLK / 4;
    const bf16* LO = (const bf16*)(a.ws + WS_R1); const bf16* RK = (const bf16*)(a.ws + WS_RKVK); bf16* YS = (bf16*)(a.ws + WS_YS);
    const pg8::f32x4 zero4 = (pg8::f32x4){0.f, 0.f, 0.f, 0.f};
    v2u E4[4], A4[4]; v4u R0[4], R1[4];
    float kav[4];
    const int pw = w - 4;
    LAS unsigned char* scr = lds + CS_SCR0 + (pw & 3) * CS_SCR;
#define CS_LOAD(blk_) do { const int i0_ = (blk_) * 16 + 4 * fq; _Pragma("unroll") for (int i = 0; i < 4; ++i) { const int m_ = scan_row(i0_ + i, b, d); \
        const bf16* lo_ = LO + (size_t)m_ * LOW + 1024 + d * 1024 + h * 64 + 4 * fr; E4[i] = *(const GAS v2u*)lo_; A4[i] = *(const GAS v2u*)(lo_ + 2048); \
        const GAS v4u* rk_ = (const GAS v4u*)(RK + ((size_t)m_ * 16 + h) * 256 + 16 * fr); R0[i] = rk_[0]; R1[i] = rk_[1]; } } while (0)
    if (w >= 4) {
#pragma unroll
        for (int c = 0; c < 4; ++c) kav[c] = a.in[I_KA][l * 1024 + h * 64 + 4 * fr + c];
        CS_LOAD(pw);
    }
    pg8::f32x4 S0 = zero4, S1 = zero4, S2 = zero4, S3 = zero4;
    for (int rr = 0; rr <= NR; ++rr) {
        if (w >= 4) {
            if (rr < NR) {
                const int blk = 4 * rr + pw;
                LAS unsigned char* slot = lds + (blk % CS_NSLOT) * CS_SLOT;
                float Ef[4][4], af[4][4], Lin[4][4];
#pragma unroll
                for (int i = 0; i < 4; ++i) { Ef[i][0] = bflo(E4[i].x); Ef[i][1] = bfhi(E4[i].x); Ef[i][2] = bflo(E4[i].y); Ef[i][3] = bfhi(E4[i].y);
                    af[i][0] = bflo(A4[i].x); af[i][1] = bfhi(A4[i].x); af[i][2] = bflo(A4[i].y); af[i][3] = bfhi(A4[i].y); }
                float pre[4], L15[4], G15[4];
#pragma unroll
                for (int c = 0; c < 4; ++c) { float acc = 0.f;
#pragma unroll
                    for (int i = 0; i < 4; ++i) { acc += Ef[i][c]; Lin[i][c] = acc; }
                    const float t1 = __shfl_up(acc, 16); float cum = acc + (fq >= 1 ? t1 : 0.f);
                    const float t2 = __shfl_up(cum, 32); cum += (fq >= 2 ? t2 : 0.f);
                    pre[c] = cum - acc; L15[c] = __shfl(cum, fr + 48); G15[c] = __builtin_amdgcn_exp2f(-L15[c]); }
                float kkh[4][4], kdg[4][4], nbg[4][4]; unsigned vraw[4][4];
                const int posb = ((fr >> 2) * 8 + (fr & 3) * 2) * 2;
#pragma unroll
                for (int i = 0; i < 4; ++i) {
                    float kdh_[4], nbh_[4], rh_[4];
#pragma unroll
                    for (int c = 0; c < 4; ++c) {
                        const unsigned rk_ = c == 0 ? R0[i].x : c == 1 ? R0[i].z : c == 2 ? R1[i].x : R1[i].z, vk_ = c == 0 ? R0[i].y : c == 1 ? R0[i].w : c == 2 ? R1[i].y : R1[i].w;
                        const float r_ = bflo(rk_), k_ = bfhi(rk_), kk_ = bfhi(vk_), a_ = af[i][c];
                        vraw[i][c] = vk_ & 0xffffu;
                        const float Lf = pre[c] + Lin[i][c];
                        const float eL = __builtin_amdgcn_exp2f(Lf), eN = __builtin_amdgcn_rcpf(eL), ekk = __builtin_amdgcn_exp2f(Ef[i][c] - Lf);
                        const float kd = k_ * (1.f + (a_ - 1.f) * kav[c]);
                        kdh_[c] = kd * eL; nbh_[c] = -(kk_ * a_ * eL); kkh[i][c] = kk_ * ekk; rh_[c] = r_ * eN;
                        kdg[i][c] = kdh_[c] * G15[c]; nbg[i][c] = nbh_[c] * G15[c];
                    }
                    const int rb = (4 * fq + i) * CS_PITCH + posb;
                    *(LAS unsigned*)(scr + CS_S_KK + rb) = cvtpk_c(kkh[i][0], kkh[i][1]); *(LAS unsigned*)(scr + CS_S_KK + rb + 64) = cvtpk_c(kkh[i][2], kkh[i][3]);
                    *(LAS unsigned*)(scr + CS_S_KD + rb) = cvtpk_c(kdh_[0], kdh_[1]); *(LAS unsigned*)(scr + CS_S_KD + rb + 64) = cvtpk_c(kdh_[2], kdh_[3]);
                    *(LAS unsigned*)(scr + CS_S_NB + rb) = cvtpk_c(nbh_[0], nbh_[1]); *(LAS unsigned*)(scr + CS_S_NB + rb + 64) = cvtpk_c(nbh_[2], nbh_[3]);
                    *(LAS unsigned*)(slot + CS_OFF_RH + rb) = cvtpk_c(rh_[0], rh_[1]); *(LAS unsigned*)(slot + CS_OFF_RH + rb + 64) = cvtpk_c(rh_[2], rh_[3]);
                }
                if (rr + 1 < NR) CS_LOAD(blk + 4);
#pragma unroll
                for (int c = 0; c < 4; ++c) {
                    *(LAS v4u*)(slot + CS_OFF_KB + c * 1024 + lane * 16) = (v4u){cvtpk_c(kdg[0][c], kdg[1][c]), cvtpk_c(kdg[2][c], kdg[3][c]), cvtpk_c(nbg[0][c], nbg[1][c]), cvtpk_c(nbg[2][c], nbg[3][c])};
                    const int j = 4 * fr + c;
                    *(LAS v2u*)(slot + CS_OFF_V + (((j >> 4) * 4 + fq) * 16 + (j & 15)) * 8) = (v2u){vraw[0][c] | (vraw[1][c] << 16), vraw[2][c] | (vraw[3][c] << 16)};
                }
                if (fq == 0) *(LAS pg8::f32x4*)(slot + CS_OFF_G + fr * 16) = (pg8::f32x4){G15[0], G15[1], G15[2], G15[3]};
                asm volatile("s_waitcnt lgkmcnt(0)" ::: "memory");
                const LAS unsigned char* fa = scr + fr * CS_PITCH + fq * 16; const LAS unsigned char* fh = slot + CS_OFF_RH + fr * CS_PITCH + fq * 16;
                const bf16x8 KK0 = *(const LAS bf16x8*)(fa + CS_S_KK), KK1 = *(const LAS bf16x8*)(fa + CS_S_KK + 64), KD0 = *(const LAS bf16x8*)(fa + CS_S_KD), KD1 = *(const LAS bf16x8*)(fa + CS_S_KD + 64);
                const bf16x8 NB0 = *(const LAS bf16x8*)(fa + CS_S_NB), NB1 = *(const LAS bf16x8*)(fa + CS_S_NB + 64), RH0 = *(const LAS bf16x8*)(fh), RH1 = *(const LAS bf16x8*)(fh + 64);
                pg8::f32x4 dn1 = mfma32(NB1, KK1, mfma32(NB0, KK0, zero4));
                pg8::f32x4 dmt = mfma32(KK1, KD1, mfma32(KK0, KD0, zero4));
                pg8::f32x4 dq = mfma32(KD1, RH1, mfma32(KD0, RH0, zero4));
                pg8::f32x4 dp = mfma32(NB1, RH1, mfma32(NB0, RH0, zero4));
#pragma unroll
                for (int i = 0; i < 4; ++i) { const int row = 4 * fq + i;
                    dn1[i] = row < fr ? dn1[i] : 0.f; dmt[i] = fr < row ? dmt[i] : 0.f; dq[i] = row <= fr ? dq[i] : 0.f; dp[i] = row <= fr ? dp[i] : 0.f;
                    *(LAS float*)(scr + CS_S_U + row * 64 + fr * 4) = dn1[i]; }
                asm volatile("s_waitcnt lgkmcnt(0)" ::: "memory");
                float Tc[16];
#pragma unroll
                for (int s = 0; s < 16; ++s) Tc[s] = (fr == s) ? 1.f : 0.f;
                const LAS float* Up = (const LAS float*)(scr + CS_S_U);
#pragma unroll
                for (int s = 14; s >= 0; --s) {
                    float acc0 = (fr == s) ? 1.f : 0.f, acc1 = 0.f;
#pragma unroll
                    for (int q4 = (s + 1) / 4; q4 < 4; ++q4) { const pg8::f32x4 uu = *(const LAS pg8::f32x4*)(Up + s * 16 + 4 * q4);
#pragma unroll
                        for (int e = 0; e < 4; ++e) { const int sp = 4 * q4 + e; if (sp > s) { if (e & 1) acc1 += uu[e] * Tc[sp]; else acc0 += uu[e] * Tc[sp]; } } }
                    Tc[s] = acc0 + acc1;
                }
                pg8::f32x4 dt;
#pragma unroll
                for (int i = 0; i < 4; ++i) dt[i] = fq == 0 ? Tc[i] : fq == 1 ? Tc[4 + i] : fq == 2 ? Tc[8 + i] : Tc[12 + i];
                const v2u DTb = pack4(dt);
                pg8::f32x4 da1[4];
#pragma unroll
                for (int c = 0; c < 4; ++c) da1[c] = mfma16((v2u){cvtpk_c(kkh[0][c], kkh[1][c]), cvtpk_c(kkh[2][c], kkh[3][c])}, DTb, zero4);
                const pg8::f32x4 dmt2 = mfma16(pack4(dmt), DTb, zero4);
#pragma unroll
                for (int hh = 0; hh < 2; ++hh)
                    *(LAS v4u*)(slot + CS_OFF_A1 + hh * 1024 + lane * 16) = (v4u){cvtpk_c(da1[2 * hh][0], da1[2 * hh + 1][0]), cvtpk_c(da1[2 * hh][1], da1[2 * hh + 1][1]), cvtpk_c(da1[2 * hh][2], da1[2 * hh + 1][2]), cvtpk_c(da1[2 * hh][3], da1[2 * hh + 1][3])};
                *(LAS v2u*)(slot + CS_OFF_MT + lane * 8) = pack4(dmt2); *(LAS v2u*)(slot + CS_OFF_Q + lane * 8) = pack4(dq); *(LAS v2u*)(slot + CS_OFF_P + lane * 8) = pack4(dp);
            }
        } else if (rr >= 1) {
#pragma nounroll
            for (int q = 0; q < 4; ++q) {
                const int blk = 4 * (rr - 1) + q;
                const LAS unsigned char* slot = lds + (blk % CS_NSLOT) * CS_SLOT;
                const bf16x8 A10 = *(const LAS bf16x8*)(slot + CS_OFF_A1 + lane * 16), A11 = *(const LAS bf16x8*)(slot + CS_OFF_A1 + 1024 + lane * 16);
                const bf16x8 RH0 = *(const LAS bf16x8*)(slot + CS_OFF_RH + fr * CS_PITCH + fq * 16), RH1 = *(const LAS bf16x8*)(slot + CS_OFF_RH + fr * CS_PITCH + fq * 16 + 64);
                const v2u MTo = *(const LAS v2u*)(slot + CS_OFF_MT + lane * 8), Qo = *(const LAS v2u*)(slot + CS_OFF_Q + lane * 8), Po = *(const LAS v2u*)(slot + CS_OFF_P + lane * 8);
                const v2u Vo = *(const LAS v2u*)(slot + CS_OFF_V + (w * 64 + lane) * 8);
                const bf16x8 KB0 = *(const LAS bf16x8*)(slot + CS_OFF_KB + lane * 16), KB1 = *(const LAS bf16x8*)(slot + CS_OFF_KB + 1024 + lane * 16), KB2 = *(const LAS bf16x8*)(slot + CS_OFF_KB + 2048 + lane * 16), KB3 = *(const LAS bf16x8*)(slot + CS_OFF_KB + 3072 + lane * 16);
                pg8::f32x4 Gi[4];
#pragma unroll
                for (int i = 0; i < 4; ++i) Gi[i] = *(const LAS pg8::f32x4*)(slot + CS_OFF_G + (16 * fq + 4 * i) * 4);
                const v4u bs0 = (v4u){cvtpk_c(S0[0], S1[0]), cvtpk_c(S0[1], S1[1]), cvtpk_c(S0[2], S1[2]), cvtpk_c(S0[3], S1[3])};
                const v4u bs1 = (v4u){cvtpk_c(S2[0], S3[0]), cvtpk_c(S2[1], S3[1]), cvtpk_c(S2[2], S3[2]), cvtpk_c(S2[3], S3[3])};
                const bf16x8 BS0 = __builtin_bit_cast(bf16x8, bs0), BS1 = __builtin_bit_cast(bf16x8, bs1);
                const pg8::f32x4 c1 = mfma16(MTo, Vo, zero4);
                const pg8::f32x4 sa = mfma32(A11, BS1, mfma32(A10, BS0, c1));
                const v2u SAo = pack4(sa);
                pg8::f32x4 y = mfma32(RH1, BS1, mfma32(RH0, BS0, zero4));
                y = mfma16(Qo, Vo, y); y = mfma16(Po, SAo, y);
                const bf16x8 BV = __builtin_bit_cast(bf16x8, (v4u){Vo.x, Vo.y, SAo.x, SAo.y});
                pg8::f32x4 g0, g1, g2, g3;
#pragma unroll
                for (int i = 0; i < 4; ++i) { g0[i] = S0[i] * Gi[i][0]; g1[i] = S1[i] * Gi[i][1]; g2[i] = S2[i] * Gi[i][2]; g3[i] = S3[i] * Gi[i][3]; }
                S0 = mfma32(KB0, BV, g0); S1 = mfma32(KB1, BV, g1); S2 = mfma32(KB2, BV, g2); S3 = mfma32(KB3, BV, g3);
#pragma unroll
                for (int i = 0; i < 4; ++i) { const int m_ = scan_row(blk * 16 + 4 * fq + i, b, d);
                    YS[((size_t)d * MT + m_) * 1024 + h * 64 + 16 * w + fr] = (bf16)(cvtpk_c(y[i], 0.f) & 0xffffu); }
            }
        }
        asm volatile("s_waitcnt lgkmcnt(0)" ::: "memory"); __builtin_amdgcn_s_barrier(); asm volatile("" ::: "memory");
    }
#undef CS_LOAD
    asm volatile("s_waitcnt vmcnt(0) lgkmcnt(0)" ::: "memory"); __syncthreads();
}

__device__ __forceinline__ void ph_rwkv_out(const Args& a, int l, int nrows, int gt, int NGT) {
    const bf16* OJ = (const bf16*)(a.ws + WS_OJ); bf16* YC = (bf16*)(a.ws + WS_Y3) + (size_t)2 * MT * 1024;
    const float* subln = a.in[I_SUBLN] + l * 128;
    float lam, lam_init;
    { const int lane = threadIdx.x & 63; const float* lv = a.in[I_LAM] + l * 256;
      float l1 = lv[lane] * lv[64 + lane], l2 = lv[128 + lane] * lv[192 + lane]; l1 = wave_sum(l1); l2 = wave_sum(l2);
      lam_init = 0.8f - 0.6f * __expf(-0.3f * (float)l); lam = __expf(l1) - __expf(l2) + lam_init;
      float gb = fabsf(a.in[I_QN][l * 64 + lane] * a.in[I_KN][l * 64 + lane]);
#pragma unroll
      for (int o_ = 1; o_ < 64; o_ <<= 1) gb = fmaxf(gb, __shfl_xor(gb, o_));
      if (gb > 8.f) lam = __builtin_nanf(""); }
    const bf16* LO = (const bf16*)(a.ws + WS_R1); const bf16* RK = (const bf16*)(a.ws + WS_RKVK); const bf16* YS = (const bf16*)(a.ws + WS_YS);
    bf16* YB = (bf16*)(a.ws + WS_Y3) + (size_t)MT * 1024;
    const float* ka = a.in[I_KA] + l * 1024; const float* rkw = a.in[I_RK] + l * 1024; const float* lng = a.in[I_LNG] + l * 1024; const float* lnb = a.in[I_LNB] + l * 1024;
    for (int i = gt; i < nrows * 128; i += 2 * NGT) {
        v4u L[2][11]; const bool two = i + NGT < nrows * 128;
#pragma unroll
        for (int s = 0; s < 2; ++s) if (s == 0 || two) { const int ii = i + s * NGT, m = ii >> 7, c0 = (ii & 127) * 8;
            L[s][0] = *(const GAS v4u*)(YS + (size_t)m * 1024 + c0); L[s][1] = *(const GAS v4u*)(YS + ((size_t)MT + m) * 1024 + c0);
            const GAS v4u* rp = (const GAS v4u*)(RK + (size_t)m * 4096 + c0 * 4);
            L[s][2] = rp[0]; L[s][3] = rp[1]; L[s][4] = rp[2]; L[s][5] = rp[3];
            const bf16* lo = LO + (size_t)m * LOW + c0;
            L[s][6] = *(const GAS v4u*)lo; L[s][7] = *(const GAS v4u*)(lo + 3072); L[s][8] = *(const GAS v4u*)(lo + 4096);
            L[s][9] = *(const GAS v4u*)(OJ + (size_t)m * 1024 + c0); L[s][10] = *(const GAS v4u*)(OJ + ((size_t)MT + m) * 1024 + c0); }
#pragma unroll
        for (int s = 0; s < 2; ++s) if (s == 0 || two) {
        const int ii = i + s * NGT, m = ii >> 7, c0 = (ii & 127) * 8;
        const v4u ya = L[s][0], yb = L[s][1], q0 = L[s][2], q1 = L[s][3], q2 = L[s][4], q3 = L[s][5], gw_ = L[s][6], aw0 = L[s][7], aw1 = L[s][8], pw = L[s][9], ow = L[s][10];
        float yA[8], yB[8], gv[8], a0v[8], a1v[8], pv[8], ov[8];
        unpack8(ya, yA); unpack8(yb, yB); unpack8(gw_, gv); unpack8(aw0, a0v); unpack8(aw1, a1v); unpack8(pw, pv); unpack8(ow, ov);
        float y[8]; float s1 = 0.f;
#pragma unroll
        for (int e = 0; e < 8; ++e) y[e] = yA[e] + yB[e];
#pragma unroll
        for (int e = 0; e < 8; ++e) s1 += y[e];
        s1 += __shfl_xor(s1, 1); s1 += __shfl_xor(s1, 2); s1 += __shfl_xor(s1, 4);
        const float mu = s1 * (1.f / 64.f); float s2 = 0.f;
#pragma unroll
        for (int e = 0; e < 8; ++e) { y[e] -= mu; s2 += y[e] * y[e]; }
        s2 += __shfl_xor(s2, 1); s2 += __shfl_xor(s2, 2); s2 += __shfl_xor(s2, 4);
        const float rstd = 1.f / sqrtf(s2 * (1.f / 64.f) + 64e-5f);
        float r[8], k[8], v[8];
        r[0] = bflo(q0.x); k[0] = bfhi(q0.x); v[0] = bflo(q0.y); r[1] = bflo(q0.z); k[1] = bfhi(q0.z); v[1] = bflo(q0.w);
        r[2] = bflo(q1.x); k[2] = bfhi(q1.x); v[2] = bflo(q1.y); r[3] = bflo(q1.z); k[3] = bfhi(q1.z); v[3] = bflo(q1.w);
        r[4] = bflo(q2.x); k[4] = bfhi(q2.x); v[4] = bflo(q2.y); r[5] = bflo(q2.z); k[5] = bfhi(q2.z); v[5] = bflo(q2.w);
        r[6] = bflo(q3.x); k[6] = bfhi(q3.x); v[6] = bflo(q3.y); r[7] = bflo(q3.z); k[7] = bfhi(q3.z); v[7] = bflo(q3.w);
        float am[8];
#pragma unroll
        for (int e = 0; e < 8; ++e) am[e] = 0.5f * (a0v[e] + a1v[e]);
        float rk = 0.f;
#pragma unroll
        for (int e = 0; e < 8; ++e) { const int c = c0 + e; rk += r[e] * (k[e] * (1.f + (am[e] - 1.f) * ka[c])) * rkw[c]; }
        rk += __shfl_xor(rk, 1); rk += __shfl_xor(rk, 2); rk += __shfl_xor(rk, 4);
        float o[8];
#pragma unroll
        for (int e = 0; e < 8; ++e) { const int c = c0 + e; o[e] = (y[e] * rstd * lng[c] + lnb[c] + rk * v[e]) * gv[e]; }
        *(GAS v4u*)(YB + (size_t)m * 1024 + c0) = pack8(o);
        { float d[8];
#pragma unroll
          for (int e = 0; e < 8; ++e) d[e] = pv[e] - lam * ov[e];
          float ss = 0.f;
#pragma unroll
          for (int e = 0; e < 8; ++e) ss += d[e] * d[e];
          ss += __shfl_xor(ss, 1); ss += __shfl_xor(ss, 2); ss += __shfl_xor(ss, 4); ss += __shfl_xor(ss, 8);
          const float rinv = (1.f - lam_init) / sqrtf(ss * (1.f / 128.f) + 1e-6f);
#pragma unroll
          for (int e = 0; e < 8; ++e) d[e] = d[e] * rinv * subln[(c0 & 127) + e];
          *(GAS v4u*)(YC + (size_t)m * 1024 + c0) = pack8(d); }
        }
    }
}

constexpr int PH_PER_LAYER = 14, NPH = 1 + NLAYER * PH_PER_LAYER;
#define IN(k) (lo <= (k) && (k) < hi)
#define SEAM(k) do { if (IN(k) && IN((k) + 1)) xcd_barrier(bar); } while (0)
#ifndef ONLY_PH
#define ONLY_PH -1
#endif
#define INL(k) ((ONLY_PH < 0 || ONLY_PH == (k)) && IN(pb + (k)))
#define SEAML(k) SEAM(pb + (k))
#ifndef PROBE_REP
#define PROBE_REP 0
#endif
#define REPL(k) for (int rep_ = 0; rep_ < (((PROBE_REP) >> (k)) & 1) + 1; ++rep_)
template <int l> __device__ __forceinline__ void layer_body(const Args& args, LAS unsigned char* lds, unsigned char* lds_raw, unsigned char* ws, const XcdBarrier& bar, int lo, int hi, int tid, int lane, int G, int bx, int vcu, int gw, int NGW, int gt, int NGT) {
        const int pb = 1 + l * PH_PER_LAYER;
        const bool last = (l == NLAYER - 1);
        float* XS = (float*)(ws + WS_XS); pg8::bf16_t* PART = (pg8::bf16_t*)(ws + WS_PART);
        const float* mods = (const float*)(ws + WS_MODS) + (size_t)l * 3 * NMOD * DM;
        const float* normg = args.in[I_NORMG] + (size_t)l * 3 * DM;
        pg8::bf16_t* XN = (pg8::bf16_t*)(ws + WS_XN);
        pg8::bf16_t* Hb = (pg8::bf16_t*)(ws + WS_R1);
        const float* xl0 = (l == 0) ? args.in[I_X] : XS; const float* xc0 = (l == 0) ? args.in[I_CTX] : XS + (size_t)NLAT * DM;

        if (INL(0)) REPL(0) ph_norm(xl0, xc0, normg, mods, 0, (bf16*)XN, XS, l == 0 ? nullptr : PART, 16, MT, gw, NGW, lane, (LAS float*)lds);
        SEAML(0);
        if (INL(1)) REPL(1) { pg8::Gemm g{XN, (const pg8::bf16_t*)(ws + WS_WF1 + (size_t)(l * 2 + 0) * SZ_WF1), MT, FF2, DM}; pg8::StaticOrder S; S.init(MT, FF2, G, bx);
            pg8::EpiSwiglu E{Hb, FF}; pg8::gemm_phase<pg8::EpiSwiglu, pg8::StaticOrder, true, true>(lds, g, S, E); }
        SEAML(1);
        if (INL(2)) REPL(2) { pg8::Gemm g{Hb, (const pg8::bf16_t*)(ws + WS_WF2 + (size_t)(l * 2 + 0) * SZ_WF2), MT, DM, FF}; pg8::SplitCtxOrder S{G, vcu, NLAT / 256, NCTX / 256, 16, FF / 64};
            pg8::EpiResid E{xl0, (long)((xc0 - (size_t)NLAT * DM) - xl0), XS, 0L, mods + 2 * DM, NMOD * DM, 0.5f, NLAT / 256, TSEQ / 256, PART, NCTX};
            pg8::gemm_phase<pg8::EpiResid, pg8::SplitCtxOrder, true, true>(lds, g, S, E); }
        SEAML(2);
        if (INL(3)) REPL(3) ph_norm(XS, XS + (size_t)NLAT * DM, normg + DM, mods, 3, (bf16*)XN, XS, PART, 16, MT, gw, NGW, lane, (LAS float*)lds);
        SEAML(3);
        if (INL(4)) REPL(4) { pg8::Gemm g{XN, (const pg8::bf16_t*)(ws + WS_WIN + (size_t)l * SZ_WIN), MT, PROJP, DM}; pg8::ProjOrder S; S.init(last ? NLAT : MT, PROJP, G, bx); S.skip_ctx = last ? 1 : 0;
            pg8::EpiProj E{(pg8::bf16_t*)(ws + WS_P), PROJP, (pg8::bf16_t*)(ws + WS_ACT), (pg8::bf16_t*)(ws + WS_QK), args.in[I_QN] + l * 64, args.in[I_KN] + l * 64, (const float*)(ws + WS_ROPE), NLAT, TSEQ};
            pg8::gemm_phase<pg8::EpiProj, pg8::ProjOrder, true, true>(lds, g, S, E); }
        SEAML(4);
        if (INL(5)) REPL(5) { pg8::Gemm g{(const pg8::bf16_t*)(ws + WS_ACT), (const pg8::bf16_t*)(ws + WS_WLO + (size_t)l * SZ_WLO), MT, LOW, ACTW}; pg8::LoraOrder S; S.init(MT, LOW, G, bx);
            pg8::EpiLora E{(pg8::bf16_t*)(ws + WS_R1), args.in[I_W0] + l * 2048, args.in[I_A0] + l * 2048}; pg8::gemm_phase<pg8::EpiLora, pg8::LoraOrder, true, true>(lds, g, S, E);
            ph_e1(args, l, gt, NGT); }
        SEAML(5);
        if (INL(7)) REPL(7) {
            if (bx < 64) scan_unit(args, l, bx, lds, tid);
            else { int u0, ustep, uend, cu, gv, gn;
                if (G == 256) { const int ax = bx & 7, ar = (bx - 64) >> 3, li = (ar - 16) * 8 + ax;
                    u0 = 64 * ax + ar; ustep = 24; uend = 64 * ax + 64; cu = (!last && ar >= 16 && li < 32) ? li : -1;
                    gv = li; gn = ar >= 16 ? 64 : 0; }
                else { const int aw = G - 64, wi = bx - 64, light0 = 512 % aw, nl = aw - light0;
                    u0 = wi; ustep = aw; uend = 512; cu = (!last && wi >= light0 && wi - light0 < 32) ? wi - light0 : -1;
                    if (light0 == 0 || nl <= 0) { gv = wi; gn = aw; } else { gv = wi - light0; gn = wi >= light0 ? nl : 0; } }
                ph_attn(args, (char*)lds_raw, u0, ustep, uend, cu); __syncthreads();
                if (gn > 0) ph_gmlp(args, l, lds, tid, gv, gn); }
        }
        SEAML(7);
        if (INL(8)) REPL(8) ph_rwkv_out(args, l, last ? NLAT : MT, gt, NGT);
        SEAML(8);
        if (INL(9)) REPL(9) { pg8::Gemm g{(const pg8::bf16_t*)(ws + WS_Y3), (const pg8::bf16_t*)(ws + WS_WBR + (size_t)l * SZ_WBR), 3 * MT, 3 * DM, 1024}; pg8::MergeOrder S{G, bx, MT / 256, NLAT / 256, last ? 0 : (NCTX / 256) * 8 * 3};
            pg8::EpiMerge E{(const pg8::bf16_t*)(ws + WS_P) + P_GATE2, PROJP, args.in[I_BGATE] + (size_t)l * 3 * DM, (pg8::bf16_t*)(ws + WS_ZF), XN, MT / 256, (pg8::bf16_t*)(ws + WS_IMG), -(long)NLAT};
            pg8::gemm_phase<pg8::EpiMerge, pg8::MergeOrder, true, true>(lds, g, S, E); }
        SEAML(9);
        if (INL(10)) REPL(10) { pg8::Gemm g{XN, (const pg8::bf16_t*)(ws + WS_WOUT + (size_t)l * SZ_WOUT), MT, DM, DM}; pg8::SplitCtxOrder S{G, vcu, NLAT / 256, last ? 0 : NCTX / 256, 8, DM / 64};
            if (!last) { pg8::Unit uu;
                for (int i = 0; S.next(i, uu); ++i) if (uu.kn != 0) {
                    const int r0 = (uu.pm - NLAT / 256) * 256, k0 = uu.ks * 64, kw8 = uu.kn * 8;
                    const bf16* ZP = (const bf16*)(ws + WS_IMG); bf16* Zc = (bf16*)XN + (size_t)NLAT * DM;
                    for (int idx = tid; idx < 256 * kw8; idx += NTHR) { const int r = r0 + idx / kw8, k = k0 + (idx % kw8) * 8;
                        const v4u q0 = *(const GAS v4u*)(ZP + (size_t)r * DM + k), q1 = *(const GAS v4u*)(ZP + ((size_t)NCTX + r) * DM + k), q2 = *(const GAS v4u*)(ZP + ((size_t)2 * NCTX + r) * DM + k);
                        float f0[8], f1[8], f2[8]; unpack8(q0, f0); unpack8(q1, f1); unpack8(q2, f2);
#pragma unroll
                        for (int e = 0; e < 8; ++e) f0[e] = (f0[e] + f1[e]) + f2[e];
                        *(GAS v4u*)(Zc + (size_t)r * DM + k) = pack8(f0); } }
                asm volatile("s_waitcnt vmcnt(0)" ::: "memory"); __syncthreads(); }
            pg8::EpiResid E{XS, 0L, XS, 0L, mods + 5 * DM, NMOD * DM, 1.0f, NLAT / 256, TSEQ / 256, PART, NCTX};
            pg8::gemm_phase<pg8::EpiResid, pg8::SplitCtxOrder, true, true>(lds, g, S, E); }
        SEAML(10);
        if (INL(11)) REPL(11) ph_norm(XS, XS + (size_t)NLAT * DM, normg + 2 * DM, mods, 6, (bf16*)XN, XS, PART, 8, last ? NLAT : MT, gw, NGW, lane, (LAS float*)lds);
        SEAML(11);
        if (INL(12)) REPL(12) { pg8::Gemm g{XN, (const pg8::bf16_t*)(ws + WS_WF1 + (size_t)(l * 2 + 1) * SZ_WF1), MT, FF2, DM}; pg8::StaticOrder S; S.init(last ? NLAT : MT, FF2, G, bx);
            pg8::EpiSwiglu E{Hb, FF}; pg8::gemm_phase<pg8::EpiSwiglu, pg8::StaticOrder, true, true>(lds, g, S, E); }
        SEAML(12);
        if (INL(13)) REPL(13) { pg8::Gemm g{Hb, (const pg8::bf16_t*)(ws + WS_WF2 + (size_t)(l * 2 + 1) * SZ_WF2), MT, DM, FF}; pg8::SplitCtxOrder S{G, vcu, NLAT / 256, last ? 0 : NCTX / 256, 16, FF / 64};
            pg8::EpiResid E{XS, 0L, last ? args.out : XS, 0L, mods + 8 * DM, NMOD * DM, 0.5f, NLAT / 256, TSEQ / 256, PART, NCTX};
            pg8::gemm_phase<pg8::EpiResid, pg8::SplitCtxOrder, true, true>(lds, g, S, E); }
        SEAML(13);
    }
__global__ void __launch_bounds__(NTHR, 2) fwd(Args args) {
    extern __shared__ __attribute__((aligned(16))) unsigned char lds_raw[];
    LAS unsigned char* lds = (LAS unsigned char*)lds_raw;
    const int tid = threadIdx.x, lane = tid & 63, wave = __builtin_amdgcn_readfirstlane(tid >> 6);
    const int G = gridDim.x; const int bx = blockIdx.x; const int vcu = (G % 8 == 0) ? (bx % 8) * (G / 8) + bx / 8 : bx;
    const int gw = vcu * NWAVES + wave, NGW = G * NWAVES, gt = vcu * NTHR + tid, NGT = G * NTHR;
    unsigned char* ws = args.ws;
    volatile LAS unsigned* MISC = (volatile LAS unsigned*)(lds + MISC_OFF);
    for (int u = tid; u < (LDS_BYTES - LDSCTL_OFF) / 4; u += NTHR) ((LAS unsigned*)(lds + LDSCTL_OFF))[u] = 0u;
    __syncthreads();
    const int lo = args.ph_lo, hi = args.ph_hi;
    const bool multi = (hi - lo) > 1;
    XcdBarrier bar; bar.bar = (unsigned*)(ws + WS_CTL) + CW_BAR; bar.x = 0; bar.st = nullptr;
    if (multi) bar = xcd_barrier_post((unsigned*)(ws + WS_CTL) + CW_BAR, MISC + 8);

    if ((ONLY_PH < 0 || ONLY_PH == 100) && IN(0)) REPL(16) {
        ph_ada(args, lds, tid, vcu, G); __syncthreads(); ph_weights(args, 0, lds, tid, vcu, G); ph_weights(args, 1, lds, tid, vcu, G); ph_small(args, tid, vcu, G); }
    SEAM(0);

    layer_body<0>(args, lds, lds_raw, ws, bar, lo, hi, tid, lane, G, bx, vcu, gw, NGW, gt, NGT);
    layer_body<1>(args, lds, lds_raw, ws, bar, lo, hi, tid, lane, G, bx, vcu, gw, NGW, gt, NGT);
#undef IN
#undef SEAM
}

#ifndef MK_PER_PHASE
#define MK_PER_PHASE 0
#endif
extern "C" void kernel_launch(void* const* d_in, const int* in_sizes, int n_in, void* d_out, int out_size, void* d_ws, size_t ws_size, hipStream_t stream) {
    static int grid = 0;
    if (grid == 0) {
        if (n_in != 31 || in_sizes[0] != NLAT * DM || out_size != NLAT * DM || ws_size < WS_END) {
            fprintf(stderr, "kernel_launch: unexpected shapes: n_in %d in0 %d out %d ws %zu (need %zu); nothing launched\n", n_in, n_in > 0 ? in_sizes[0] : -1, out_size, ws_size, (size_t)WS_END); grid = -1; return; }
        int dev = 0, cus = 0, per_cu = 0;
        if (hipGetDevice(&dev) != hipSuccess || hipDeviceGetAttribute(&cus, hipDeviceAttributeMultiprocessorCount, dev) != hipSuccess) { grid = -1; return; }
        if (hipFuncSetAttribute((const void*)fwd, hipFuncAttributeMaxDynamicSharedMemorySize, LDS_BYTES) != hipSuccess) { fprintf(stderr, "kernel_launch: hipFuncSetAttribute failed\n"); grid = -1; return; }
        if (hipOccupancyMaxActiveBlocksPerMultiprocessor(&per_cu, (const void*)fwd, NTHR, LDS_BYTES) != hipSuccess || per_cu < 1) fprintf(stderr, "kernel_launch: occupancy query says %d\n", per_cu);
        (void)hipGetLastError();
        grid = cus;
    }
    if (grid < 0) return;
    (void)hipMemsetAsync((char*)d_ws + WS_CTL, 0, CTL_ZERO_BYTES, stream);
    Args a{};
    for (int i = 0; i < 31; ++i) a.in[i] = (const float*)d_in[i];
    a.out = (float*)d_out; a.ws = (unsigned char*)d_ws;
#if MK_PER_PHASE
    for (int p = 0; p < NPH; ++p) { a.ph_lo = p; a.ph_hi = p + 1; hipLaunchKernelGGL(fwd, dim3(grid), dim3(NTHR), LDS_BYTES, stream, a); }
#else
    a.ph_lo = 0; a.ph_hi = NPH; hipLaunchKernelGGL(fwd, dim3(grid), dim3(NTHR), LDS_BYTES, stream, a);
#endif
}
```

```cpp
#include <hip/hip_runtime.h>
#include <cstdio>
#include <cstdint>
namespace pg8 {
#define PG8_LAS __attribute__((address_space(3)))
typedef unsigned short bf16_t;
typedef short bf16x8 __attribute__((ext_vector_type(8)));
typedef float f32x4 __attribute__((ext_vector_type(4)));
typedef unsigned u32x4 __attribute__((ext_vector_type(4)));
constexpr int BM = 256, BK = 64, HALF = 128, HTB = HALF * BK * 2  , STAGE_BYTES = 8 * HTB, NXCD = 8, WGM = 8;

__host__ __device__ __forceinline__ int lds_byte(int r, int c) { const int st = (r >> 4) * 2 + (c >> 5), rr = r & 15, cc = c & 31, ob = rr * 64 + cc * 2; return st * 1024 + (ob ^ (((ob >> 9) & 1) << 5)); }
__host__ __device__ __forceinline__ void stage_rc(int b, int& R, int& C) { const int st = b / 1024, sb = b % 1024, swz = sb ^ (((sb >> 9) & 1) << 5); R = (st >> 1) * 16 + swz / 64; C = (st & 1) * 32 + (swz % 64) / 2; }
__host__ __device__ __forceinline__ int perm32(int rho) { const int n = rho >> 4, i = rho & 15; return 8 * (i >> 2) + 4 * n + (i & 3); }

struct Unit { int pm, pn, ks, kn, aux; };
struct Gemm { const bf16_t* A; const bf16_t* Bt; int M, N, K; };

struct StaticOrder {
    int nM, nN, nwg, G, c;
    __host__ __device__ void init(int M, int N, int G_, int c_) { nM = M / BM; nN = N / BM; nwg = nM * nN; G = G_; c = c_; }
    __host__ __device__ bool next(int i, Unit& u) const {
        const long L = (long)i * G + c; if (L >= nwg) return false;
        int wgid = (int)L; { const int q = nwg / NXCD, r = nwg % NXCD, xcd = wgid % NXCD, off = wgid / NXCD; wgid = (xcd < r ? xcd * (q + 1) : r * (q + 1) + (xcd - r) * q) + off; }
        const int nig = WGM * nN, gid = wgid / nig, fm = gid * WGM, gsz = (nM - fm) < WGM ? (nM - fm) : WGM;
        u.pm = fm + ((wgid % nig) % gsz); u.pn = (wgid % nig) / gsz; u.ks = 0; u.kn = 0; u.aux = 0; return true;
    }
    __device__ __forceinline__ void a_ready(const Unit&) const {}
    __device__ __forceinline__ void done(const Unit&) const {}
};

__device__ __forceinline__ unsigned cvt_pk_bf16(float lo, float hi) { unsigned r; asm volatile("v_cvt_pk_bf16_f32 %0, %1, %2" : "=v"(r) : "v"(lo), "v"(hi)); return r; }
typedef float f32x2 __attribute__((ext_vector_type(2)));
typedef unsigned u32x2 __attribute__((ext_vector_type(2)));
__device__ __forceinline__ float fsigmoid(float x) { return __builtin_amdgcn_rcpf(1.f + __expf(-x)); }
__device__ __forceinline__ float bflo(unsigned w) { return __builtin_bit_cast(float, w << 16); }
__device__ __forceinline__ float bfhi(unsigned w) { return __builtin_bit_cast(float, w & 0xffff0000u); }

struct EpiSwiglu {
    static constexpr bool PERM = true, AFTER_DRAIN = false;
    bf16_t* H; int ldh;
    __device__ __forceinline__ void operator()(const f32x4 (&acc)[2][2][4][2], const Unit& u, int wr, int wc, int fr, int fq) const {
        const int col0 = u.pn * HALF + wc * 32 + 8 * fq, row0 = u.pm * BM + wr * 64 + fr;
#pragma unroll
        for (int ai = 0; ai < 2; ++ai)
#pragma unroll
            for (int m = 0; m < 4; ++m) {
                const f32x4 g0 = acc[ai][0][m][0], g1 = acc[ai][0][m][1], u0 = acc[ai][1][m][0], u1 = acc[ai][1][m][1];
                float o[8];
#pragma unroll
                for (int e = 0; e < 4; ++e) { o[e] = g0[e] * fsigmoid(g0[e]) * u0[e]; o[4 + e] = g1[e] * fsigmoid(g1[e]) * u1[e]; }
                u32x4 w; w.x = cvt_pk_bf16(o[0], o[1]); w.y = cvt_pk_bf16(o[2], o[3]); w.z = cvt_pk_bf16(o[4], o[5]); w.w = cvt_pk_bf16(o[6], o[7]);
                *(u32x4*)(H + (size_t)(row0 + ai * HALF + m * 16) * ldh + col0) = w;
            }
    }
};

struct EpiResid {
    static constexpr bool PERM = true, AFTER_DRAIN = false;
    const float* xin; long din; float* out; long dout; const float* gvec; int gstride; float scale; int nlat_tiles, tiles_per_set; bf16_t* part; int nctx_rows;
    __device__ __forceinline__ void operator()(const f32x4 (&acc)[2][2][4][2], const Unit& u, int wr, int wc, int fr, int fq) const {
        const bool isctx = u.pm >= nlat_tiles;
        const int set = isctx ? 2 : (u.pm / tiles_per_set);
        const float* gv = gvec + (size_t)set * gstride;
        const int colb = u.pn * BM + wc * 32 + 8 * fq;
        const long rbase = (long)(u.pm * BM + wr * 64 + fr) * 2048 + colb;
        const float* xi = xin + rbase + (isctx ? din : 0L); float* xo = out + rbase + (isctx ? dout : 0L);
        f32x4 gg[2][2];
#pragma unroll
        for (int bj = 0; bj < 2; ++bj)
#pragma unroll
            for (int n = 0; n < 2; ++n) gg[bj][n] = *(const f32x4*)(gv + colb + bj * HALF + 4 * n) * scale;
        if (u.kn != 0) {
            bf16_t* pp = part + ((size_t)u.aux * (size_t)nctx_rows + (size_t)((u.pm - nlat_tiles) * BM + wr * 64 + fr)) * 2048 + colb;
#pragma unroll
            for (int ai = 0; ai < 2; ++ai)
#pragma unroll
                for (int m = 0; m < 4; ++m)
#pragma unroll
                    for (int bj = 0; bj < 2; ++bj) { const f32x4 v0 = gg[bj][0] * acc[ai][bj][m][0], v1 = gg[bj][1] * acc[ai][bj][m][1];
                        u32x4 w; w.x = cvt_pk_bf16(v0[0], v0[1]); w.y = cvt_pk_bf16(v0[2], v0[3]); w.z = cvt_pk_bf16(v1[0], v1[1]); w.w = cvt_pk_bf16(v1[2], v1[3]);
                        *(u32x4*)(pp + (size_t)(ai * HALF + m * 16) * 2048 + bj * HALF) = w; }
            return;
        }
#pragma unroll
        for (int ai = 0; ai < 2; ++ai) {
            f32x4 xv[4][2][2];
#pragma unroll
            for (int m = 0; m < 4; ++m)
#pragma unroll
                for (int bj = 0; bj < 2; ++bj)
#pragma unroll
                    for (int n = 0; n < 2; ++n) xv[m][bj][n] = *(const f32x4*)(xi + (size_t)(ai * HALF + m * 16) * 2048 + bj * HALF + 4 * n);
#pragma unroll
            for (int m = 0; m < 4; ++m)
#pragma unroll
                for (int bj = 0; bj < 2; ++bj)
#pragma unroll
                    for (int n = 0; n < 2; ++n) *(f32x4*)(xo + (size_t)(ai * HALF + m * 16) * 2048 + bj * HALF + 4 * n) = xv[m][bj][n] + gg[bj][n] * acc[ai][bj][m][n];
        }
    }
};
struct SplitCtxOrder {
    int G, c, nlat_tiles, nctx_tiles, nsplit, ntk;
    __device__ __forceinline__ bool next(int i, Unit& u) const {
        const int e = i * G + c, nl = nlat_tiles * 8;
        if (e < nl) { u.pm = e >> 3; u.pn = e & 7; u.ks = 0; u.kn = 0; u.aux = 0; return true; }
        const int f = e - nl; if (f >= nctx_tiles * 8 * nsplit) return false;
        const int sp = f % nsplit, t = f / nsplit, np = ntk >> 1, p0 = sp * np / nsplit, p1 = (sp + 1) * np / nsplit;
        u.pm = nlat_tiles + (t >> 3); u.pn = t & 7; u.ks = 2 * p0; u.kn = 2 * (p1 - p0); u.aux = sp; return true;
    }
    __device__ __forceinline__ void a_ready(const Unit&) const {}
    __device__ __forceinline__ void done(const Unit&) const {}
};
struct ProjOrder : StaticOrder {
    int skip_ctx;
    __device__ __forceinline__ bool next(int i, Unit& u) const {
        if (StaticOrder::next(i, u)) return true;
        if (!skip_ctx) return false;
        const long L = (long)i * G + c - nwg; if (L >= 2 * 23) return false;
        const int x = (int)L % 23; u.pm = nM + (int)L / 23; u.pn = x < 15 ? 8 + x : 27 + (x - 15); u.ks = 0; u.kn = 0; u.aux = 0; return true;
    }
};
struct LoraOrder : StaticOrder {
    __device__ __forceinline__ bool next(int i, Unit& u) const {
        if (!StaticOrder::next(i, u)) return false;
        const int sec = u.pn >> 2; int k4 = 4; asm volatile("" : "+s"(k4));
        u.ks = sec == 0 ? 0 : (sec <= 2 ? 4 : 8); u.kn = k4; return true;
    }
};

__device__ __forceinline__ float ftanh_e(float x) { return 1.f - 2.f * __builtin_amdgcn_rcpf(__expf(2.f * x) + 1.f); }
__device__ __forceinline__ float gelu_e(float x) { return 0.5f * x * (1.f + ftanh_e(0.7978845608f * (x + 0.044715f * x * x * x))); }
struct EpiProj {
    static constexpr bool PERM = true, AFTER_DRAIN = false;
    bf16_t* P; int ldp; bf16_t* ACT; bf16_t* QK; const float* qn; const float* kn; const float* rope; int nlat_rows, tseq;
    __device__ __forceinline__ void operator()(const f32x4 (&acc)[2][2][4][2], const Unit& u, int wr, int wc, int fr, int fq) const {
        const int pn = u.pn, row0 = u.pm * BM + wr * 64 + fr;
        if (pn >= 23 && pn <= 30) {
            const bool isq = pn <= 26; const int gi = (pn - 23) * 4 + wc;
            const float* gain = isq ? qn : kn;
            f32x4 gg[2][2];
#pragma unroll
            for (int bj = 0; bj < 2; ++bj)
#pragma unroll
                for (int n = 0; n < 2; ++n) gg[bj][n] = *(const f32x4*)(gain + bj * 32 + n * 16 + 4 * fq);
            const float qs = isq ? 0.18033688011112042f : 1.f;
#pragma unroll
            for (int ai = 0; ai < 2; ++ai)
#pragma unroll
                for (int m = 0; m < 4; ++m) {
                    const int row = row0 + ai * HALF + m * 16;
                    f32x4 x[2][2]; float ss = 0.f;
#pragma unroll
                    for (int bj = 0; bj < 2; ++bj)
#pragma unroll
                        for (int n = 0; n < 2; ++n) { x[bj][n] = acc[ai][bj][m][n]; ss += (x[bj][n][0] * x[bj][n][0] + x[bj][n][1] * x[bj][n][1]) + (x[bj][n][2] * x[bj][n][2] + x[bj][n][3] * x[bj][n][3]); }
                    ss += __shfl_xor(ss, 16); ss += __shfl_xor(ss, 32);
                    const float rinv = __builtin_amdgcn_rsqf(ss * (1.f / 64.f) + 1e-6f);
#pragma unroll
                    for (int bj = 0; bj < 2; ++bj)
#pragma unroll
                        for (int n = 0; n < 2; ++n) x[bj][n] = x[bj][n] * rinv * gg[bj][n];
                    if (row < nlat_rows) { const int t = row & (tseq - 1);
#pragma unroll
                        for (int bj = 0; bj < 2; ++bj) { const int p = bj == 0 ? (t >> 6) : (t & 63);
                            const f32x4 cs0 = *(const f32x4*)(rope + (p * 16 + 4 * fq) * 2), cs1 = *(const f32x4*)(rope + (p * 16 + 4 * fq) * 2 + 4);
                            const f32x4 c = {cs0[0], cs0[2], cs1[0], cs1[2]}, s = {cs0[1], cs0[3], cs1[1], cs1[3]};
                            const f32x4 a = x[bj][0], b2 = x[bj][1];
                            x[bj][0] = a * c - b2 * s; x[bj][1] = b2 * c + a * s; } }
                    bf16_t* dst = QK + (size_t)row * 2048 + gi * 64 + 8 * fq;
#pragma unroll
                    for (int bj = 0; bj < 2; ++bj) { const f32x4 v0 = x[bj][0] * qs, v1 = x[bj][1] * qs;
                        u32x4 w; w.x = cvt_pk_bf16(v0[0], v0[1]); w.y = cvt_pk_bf16(v0[2], v0[3]); w.z = cvt_pk_bf16(v1[0], v1[1]); w.w = cvt_pk_bf16(v1[2], v1[3]);
                        *(u32x4*)(dst + bj * 32) = w; }
                }
            return;
        }
        if (pn >= 20 && pn <= 22) {
#pragma unroll
            for (int bj = 0; bj < 2; ++bj) {
                const int cc = bj * HALF + wc * 32 + 8 * fq;
                int dcol, fn;
                if (pn == 20) { dcol = cc; fn = 1; }
                else if (pn == 21) { if (cc < 96) { dcol = 256 + cc; fn = 2; } else if (cc < 192) { dcol = 384 + (cc - 96); fn = 2; } else { dcol = 512 + (cc - 192); fn = 0; } }
                else { if (cc < 32) { dcol = 576 + cc; fn = 0; } else if (cc < 128) { dcol = 640 + (cc - 32); fn = 0; } else { dcol = -1; fn = 0; } }
                if (dcol < 0) continue;
#pragma unroll
                for (int ai = 0; ai < 2; ++ai)
#pragma unroll
                    for (int m = 0; m < 4; ++m) {
                        f32x4 v0 = acc[ai][bj][m][0], v1 = acc[ai][bj][m][1];
                        if (fn != 0) {
#pragma unroll
                            for (int e = 0; e < 4; ++e) { v0[e] = fn == 1 ? fsigmoid(v0[e]) : ftanh_e(v0[e]); v1[e] = fn == 1 ? fsigmoid(v1[e]) : ftanh_e(v1[e]); } }
                        u32x4 w; w.x = cvt_pk_bf16(v0[0], v0[1]); w.y = cvt_pk_bf16(v0[2], v0[3]); w.z = cvt_pk_bf16(v1[0], v1[1]); w.w = cvt_pk_bf16(v1[2], v1[3]);
                        *(u32x4*)(ACT + (size_t)(row0 + ai * HALF + m * 16) * 768 + dcol) = w;
                    }
            }
            return;
        }
        const bool dogelu = pn < 8;
        const int col0 = pn * BM + wc * 32 + 8 * fq;
#pragma unroll
        for (int ai = 0; ai < 2; ++ai)
#pragma unroll
            for (int m = 0; m < 4; ++m) {
                bf16_t* rowp = P + (size_t)(row0 + ai * HALF + m * 16) * ldp + col0;
#pragma unroll
                for (int bj = 0; bj < 2; ++bj) {
                    f32x4 v0 = acc[ai][bj][m][0], v1 = acc[ai][bj][m][1];
                    if (dogelu) {
#pragma unroll
                        for (int e = 0; e < 4; ++e) { v0[e] = gelu_e(v0[e]); v1[e] = gelu_e(v1[e]); } }
                    u32x4 w; w.x = cvt_pk_bf16(v0[0], v0[1]); w.y = cvt_pk_bf16(v0[2], v0[3]); w.z = cvt_pk_bf16(v1[0], v1[1]); w.w = cvt_pk_bf16(v1[2], v1[3]);
                    *(u32x4*)(rowp + bj * HALF) = w;
                }
            }
    }
};

struct EpiLora {
    static constexpr bool PERM = true, AFTER_DRAIN = false;
    bf16_t* LO; const float* w0; const float* a0;
    __device__ __forceinline__ void operator()(const f32x4 (&acc)[2][2][4][2], const Unit& u, int wr, int wc, int fr, int fq) const {
        const int sec = u.pn >> 2;
        const int col0 = u.pn * BM + wc * 32 + 8 * fq, row0 = u.pm * BM + wr * 64 + fr, c0 = col0 - sec * 1024;
        const float* bp = (sec <= 2 ? w0 + (sec <= 1 ? 0 : 1024) : a0 + (sec - 3) * 1024) + c0;
#pragma unroll
        for (int ai = 0; ai < 2; ++ai)
#pragma unroll
            for (int m = 0; m < 4; ++m) {
                bf16_t* rowp = LO + (size_t)(row0 + ai * HALF + m * 16) * 5120 + col0;
#pragma unroll
                for (int bj = 0; bj < 2; ++bj) {
                    f32x4 v[2];
#pragma unroll
                    for (int n = 0; n < 2; ++n) { v[n] = acc[ai][bj][m][n];
                        if (sec >= 1) { v[n] = v[n] + *(const f32x4*)(bp + bj * HALF + 4 * n);
#pragma unroll
                            for (int e = 0; e < 4; ++e) { const float s = fsigmoid(v[n][e]); v[n][e] = (sec <= 2) ? 0.8750356f * s : s; } } }
                    u32x4 w; w.x = cvt_pk_bf16(v[0][0], v[0][1]); w.y = cvt_pk_bf16(v[0][2], v[0][3]); w.z = cvt_pk_bf16(v[1][0], v[1][1]); w.w = cvt_pk_bf16(v[1][2], v[1][3]);
                    *(u32x4*)(rowp + bj * HALF) = w;
                }
                asm volatile("" ::: "memory");
            }
    }
};

struct EpiMerge {
    static constexpr bool PERM = true, AFTER_DRAIN = false;
    const bf16_t* pgate; int ldp;
    const float* bgate;
    bf16_t* ZF; bf16_t* Z; int mtiles;
    bf16_t* ZP; long zp_off;
    __device__ __forceinline__ void operator()(const f32x4 (&acc)[2][2][4][2], const Unit& u, int wr, int wc, int fr, int fq) const {
        const int br = u.pn >> 3, pn = u.pn & 7, pm = u.pm - mtiles * br;
        const int col0 = pn * BM + wc * 32 + 8 * fq, row0 = pm * BM + wr * 64 + fr;
        f32x4 bb[2][2];
#pragma unroll
        for (int bj = 0; bj < 2; ++bj)
#pragma unroll
            for (int n = 0; n < 2; ++n) bb[bj][n] = *(const f32x4*)(bgate + br * 2048 + col0 + bj * HALF + 4 * n);
        const bool part = u.aux != 0, rd = br >= 1 && !part;
        bf16_t* dstb = part ? ZP + ((long)br * 512 + zp_off) * 2048 : (br == 2 ? Z : ZF);
#pragma unroll
        for (int ai = 0; ai < 2; ++ai) {
            u32x4 pg[4][2], zf[4][2];
#pragma unroll
            for (int m = 0; m < 4; ++m)
#pragma unroll
                for (int bj = 0; bj < 2; ++bj) { const size_t row = (size_t)(row0 + ai * HALF + m * 16);
                    pg[m][bj] = *(const u32x4*)(pgate + row * ldp + br * 2048 + col0 + bj * HALF);
                    if (rd) zf[m][bj] = *(const u32x4*)(ZF + row * 2048 + col0 + bj * HALF); }
#pragma unroll
            for (int m = 0; m < 4; ++m)
#pragma unroll
                for (int bj = 0; bj < 2; ++bj) { const size_t row = (size_t)(row0 + ai * HALF + m * 16); const u32x4 q = pg[m][bj];
                    f32x4 g0, g1;
                    g0[0] = bflo(q.x); g0[1] = bfhi(q.x); g0[2] = bflo(q.y); g0[3] = bfhi(q.y); g1[0] = bflo(q.z); g1[1] = bfhi(q.z); g1[2] = bflo(q.w); g1[3] = bfhi(q.w);
                    g0 = g0 + bb[bj][0]; g1 = g1 + bb[bj][1];
                    f32x4 v0, v1;
#pragma unroll
                    for (int e = 0; e < 4; ++e) { v0[e] = fsigmoid(g0[e]) * acc[ai][bj][m][0][e]; v1[e] = fsigmoid(g1[e]) * acc[ai][bj][m][1][e]; }
                    if (rd) { const u32x4 z = zf[m][bj];
                        v0[0] += bflo(z.x); v0[1] += bfhi(z.x); v0[2] += bflo(z.y); v0[3] += bfhi(z.y); v1[0] += bflo(z.z); v1[1] += bfhi(z.z); v1[2] += bflo(z.w); v1[3] += bfhi(z.w); }
                    u32x4 w; w.x = cvt_pk_bf16(v0[0], v0[1]); w.y = cvt_pk_bf16(v0[2], v0[3]); w.z = cvt_pk_bf16(v1[0], v1[1]); w.w = cvt_pk_bf16(v1[2], v1[3]);
                    *(u32x4*)(dstb + row * 2048 + col0 + bj * HALF) = w; }
        }
    }
};
struct MergeOrder {
    int G, c, mtiles, nlat_tiles, nctx_units;
    __device__ __forceinline__ bool next(int i, Unit& u) const {
        const int ntl = nlat_tiles * 8; int nl = (ntl - c + G - 1) / G; nl = nl < 0 ? 0 : nl;
        u.ks = 0; u.kn = 0;
        if (i < 3 * nl) { const int t = (i / 3) * G + c, br = i % 3; u.pm = (t >> 3) + mtiles * br; u.pn = (t & 7) + 8 * br; u.aux = 0; return true; }
        const int e = (i - 3 * nl) * G + c; if (e >= nctx_units) return false;
        const int t = ntl + e / 3, br = e % 3; u.pm = (t >> 3) + mtiles * br; u.pn = (t & 7) + 8 * br; u.aux = 1; return true;
    }
    __device__ __forceinline__ void a_ready(const Unit&) const {}
    __device__ __forceinline__ void done(const Unit&) const {}
};

template <class Epi, class Sched, bool ALIGN_EPI = false, bool SP2 = false>
__device__ __forceinline__ void gemm_phase(PG8_LAS unsigned char* lds, const Gemm g, const Sched& S, const Epi& E) {
    const int tid = threadIdx.x, wid = __builtin_amdgcn_readfirstlane(tid >> 6), lane = tid & 63, wr = wid >> 2, wc = wid & 3, fr = lane & 15, fq = lane >> 4;
    const int K = g.K, nt = K / BK;
    unsigned voffA[2], voffB[2];
#pragma unroll
    for (int i = 0; i < 2; ++i) { int R, C; stage_rc(tid * 16 + i * 8192, R, C); const int Rb = Epi::PERM ? ((R & ~31) + perm32(R & 31)) : R;
        voffA[i] = (unsigned)(R * K + C) * 2u; voffB[i] = (unsigned)(Rb * K + C) * 2u; }
    const size_t kstep = (size_t)(BK * 2);
    const size_t hstep = (size_t)HALF * K * 2;
    const size_t tstep = 2 * hstep;
    const unsigned ldsw = (unsigned)wid * 1024u;
    const int aoff = lds_byte(wr * 64 + fr, fq * 8), boff = lds_byte(wc * 32 + fr, fq * 8);
#define PG8_SA(b, h) (((b) * 2 + (h)) * HTB)
#define PG8_SB(b, h) ((4 + (b) * 2 + (h)) * HTB)
#define PG8_STAGE(bufoff, gbase, voff) do { _Pragma("unroll") for (int _i = 0; _i < 2; ++_i) \
        __builtin_amdgcn_global_load_lds((const unsigned*)((const char*)(gbase) + (voff)[_i]), (PG8_LAS unsigned*)(lds + (bufoff) + ldsw + _i * 8192), 16, 0, 0); } while (0)
#define PG8_LDA(dst, b, h) do { _Pragma("unroll") for (int m = 0; m < 4; ++m) _Pragma("unroll") for (int k = 0; k < 2; ++k) dst[m][k] = *(const PG8_LAS bf16x8*)(lds + PG8_SA(b, h) + aoff + m * 2048 + k * 1024); } while (0)
#define PG8_LDB(dst, b, h) do { _Pragma("unroll") for (int n = 0; n < 2; ++n) _Pragma("unroll") for (int k = 0; k < 2; ++k) dst[n][k] = *(const PG8_LAS bf16x8*)(lds + PG8_SB(b, h) + boff + n * 2048 + k * 1024); } while (0)
#define PG8_MMA(ai, bj, At, Bt) do { __builtin_amdgcn_s_setprio(1); _Pragma("unroll") for (int m = 0; m < 4; ++m) _Pragma("unroll") for (int n = 0; n < 2; ++n) _Pragma("unroll") for (int k = 0; k < 2; ++k) \
        acc[ai][bj][m][n] = __builtin_amdgcn_mfma_f32_16x16x32_bf16(Bt[n][k], At[m][k], acc[ai][bj][m][n], 0, 0, 0); __builtin_amdgcn_s_setprio(0); } while (0)
#define PG8_WAIT_V(n) asm volatile("s_waitcnt vmcnt(" #n ")" ::: "memory")
#define PG8_WAIT_L(n) asm volatile("s_waitcnt lgkmcnt(" #n ")" ::: "memory")
#define PG8_BAR __builtin_amdgcn_s_barrier()
#define PG8_SCHED __builtin_amdgcn_sched_barrier(0)
    Unit cur, nxt; int ui = 0;
    if (!S.next(0, cur)) return;
    f32x4 acc[2][2][4][2];
#pragma unroll
    for (int a = 0; a < 2; ++a)
#pragma unroll
        for (int b = 0; b < 2; ++b)
#pragma unroll
            for (int m = 0; m < 4; ++m)
#pragma unroll
                for (int n = 0; n < 2; ++n) acc[a][b][m][n] = (f32x4){0.f, 0.f, 0.f, 0.f};
    bf16x8 At[4][2], B0[2][2], B1[2][2];
    const char* cA = (const char*)g.A + (size_t)cur.pm * tstep + (size_t)cur.ks * kstep; const char* cB = (const char*)g.Bt + (size_t)cur.pn * tstep + (size_t)cur.ks * kstep;
    int ntc = cur.kn ? cur.kn : nt;
    S.a_ready(cur);
    if constexpr (SP2) {
        PG8_STAGE(PG8_SB(0, 0), cB, voffB); PG8_STAGE(PG8_SB(0, 1), cB + hstep, voffB); PG8_STAGE(PG8_SA(0, 0), cA, voffA); PG8_STAGE(PG8_SA(0, 1), cA + hstep, voffA);
        if (wr == 1) PG8_BAR;
        PG8_WAIT_V(2); PG8_BAR;
        PG8_STAGE(PG8_SB(1, 0), cB + kstep, voffB); PG8_STAGE(PG8_SA(1, 0), cA + kstep, voffA); PG8_STAGE(PG8_SB(1, 1), cB + hstep + kstep, voffB);
        PG8_WAIT_V(6); PG8_BAR;
    } else {
        PG8_STAGE(PG8_SB(0, 0), cB, voffB); PG8_STAGE(PG8_SA(0, 0), cA, voffA); PG8_STAGE(PG8_SB(0, 1), cB + hstep, voffB); PG8_STAGE(PG8_SA(0, 1), cA + hstep, voffA);
        if (wr == 1) PG8_BAR;
        PG8_WAIT_V(4); PG8_BAR;
        PG8_STAGE(PG8_SB(1, 0), cB + kstep, voffB); PG8_STAGE(PG8_SA(1, 0), cA + kstep, voffA); PG8_STAGE(PG8_SB(1, 1), cB + hstep + kstep, voffB);
        PG8_WAIT_V(6); PG8_BAR;
    }
    for (;;) {
        const bool has_next = S.next(ui + 1, nxt);
        const char* nA = has_next ? (const char*)g.A + (size_t)nxt.pm * tstep + (size_t)nxt.ks * kstep : cA; const char* nB = has_next ? (const char*)g.Bt + (size_t)nxt.pn * tstep + (size_t)nxt.ks * kstep : cB;
        for (int t = 0; t < ntc; t += 2) {
            const bool last = (t == ntc - 2);
            const char* a1 = cA + (size_t)(t + 1) * kstep;
            const char* a2 = last ? nA : cA + (size_t)(t + 2) * kstep; const char* b2 = last ? nB : cB + (size_t)(t + 2) * kstep;
            const char* a3 = a2 + kstep; const char* b3 = b2 + kstep;
            if (last && has_next) S.a_ready(nxt);
            if constexpr (SP2) {
            PG8_LDB(B0, 0, 0); PG8_LDB(B1, 0, 1); PG8_SCHED; PG8_LDA(At, 0, 0); PG8_STAGE(PG8_SA(1, 1), a1 + hstep, voffA);
            PG8_WAIT_V(8); PG8_WAIT_L(0); PG8_BAR; PG8_MMA(0, 0, At, B0); PG8_MMA(0, 1, At, B1); PG8_BAR; PG8_SCHED;
            PG8_LDA(At, 0, 1); PG8_STAGE(PG8_SB(0, 0), b2, voffB); PG8_STAGE(PG8_SB(0, 1), b2 + hstep, voffB); PG8_STAGE(PG8_SA(0, 0), a2, voffA);
            PG8_WAIT_V(8); PG8_WAIT_L(0); PG8_BAR; PG8_MMA(1, 0, At, B0); PG8_MMA(1, 1, At, B1); PG8_BAR; PG8_SCHED;
            PG8_LDB(B0, 1, 0); PG8_LDB(B1, 1, 1); PG8_SCHED; PG8_LDA(At, 1, 0); PG8_STAGE(PG8_SA(0, 1), a2 + hstep, voffA);
            PG8_WAIT_V(8); PG8_WAIT_L(0); PG8_BAR; PG8_MMA(0, 0, At, B0); PG8_MMA(0, 1, At, B1); PG8_BAR; PG8_SCHED;
            PG8_LDA(At, 1, 1); PG8_STAGE(PG8_SB(1, 0), b3, voffB); PG8_STAGE(PG8_SB(1, 1), b3 + hstep, voffB); PG8_STAGE(PG8_SA(1, 0), a3, voffA);
            PG8_WAIT_V(8); PG8_WAIT_L(0); PG8_BAR; PG8_MMA(1, 0, At, B0); PG8_MMA(1, 1, At, B1); PG8_BAR; PG8_SCHED;
            } else {
            PG8_LDB(B0, 0, 0); PG8_SCHED; PG8_LDA(At, 0, 0); PG8_STAGE(PG8_SA(1, 1), a1 + hstep, voffA);
            PG8_WAIT_L(8); PG8_BAR; PG8_WAIT_L(0); PG8_MMA(0, 0, At, B0); PG8_BAR; PG8_SCHED;
            PG8_LDB(B1, 0, 1); PG8_STAGE(PG8_SB(0, 0), b2, voffB);
            PG8_BAR; PG8_WAIT_L(0); PG8_MMA(0, 1, At, B1); PG8_BAR;
            PG8_LDA(At, 0, 1); PG8_STAGE(PG8_SA(0, 0), a2, voffA);
            PG8_BAR; PG8_WAIT_L(0); PG8_MMA(1, 0, At, B0); PG8_BAR; PG8_SCHED;
            PG8_STAGE(PG8_SB(0, 1), b2 + hstep, voffB);
            PG8_WAIT_V(6); PG8_BAR; PG8_MMA(1, 1, At, B1); PG8_BAR;
            PG8_LDB(B0, 1, 0); PG8_SCHED; PG8_LDA(At, 1, 0); PG8_STAGE(PG8_SA(0, 1), a2 + hstep, voffA);
            PG8_WAIT_L(8); PG8_BAR; PG8_WAIT_L(0); PG8_MMA(0, 0, At, B0); PG8_BAR; PG8_SCHED;
            PG8_LDB(B1, 1, 1); PG8_STAGE(PG8_SB(1, 0), b3, voffB);
            PG8_BAR; PG8_WAIT_L(0); PG8_MMA(0, 1, At, B1); PG8_BAR;
            PG8_LDA(At, 1, 1); PG8_STAGE(PG8_SA(1, 0), a3, voffA);
            PG8_BAR; PG8_WAIT_L(0); PG8_MMA(1, 0, At, B0); PG8_BAR; PG8_SCHED;
            PG8_STAGE(PG8_SB(1, 1), b3 + hstep, voffB);
            PG8_WAIT_V(6); PG8_BAR; PG8_MMA(1, 1, At, B1); PG8_BAR;
            }
        }
        if constexpr (ALIGN_EPI) { if (wr == 0) PG8_BAR; }
        if constexpr (!Epi::AFTER_DRAIN) { E(acc, cur, wr, wc, fr, fq); S.done(cur); }
        if (!has_next) break;
#pragma unroll
        for (int a = 0; a < 2; ++a)
#pragma unroll
            for (int b = 0; b < 2; ++b)
#pragma unroll
                for (int m = 0; m < 4; ++m)
#pragma unroll
                    for (int n = 0; n < 2; ++n) acc[a][b][m][n] = (f32x4){0.f, 0.f, 0.f, 0.f};
        cur = nxt; cA = nA; cB = nB; ++ui; ntc = cur.kn ? cur.kn : nt;
        if constexpr (ALIGN_EPI) { if (wr == 1) PG8_BAR; }
    }
    PG8_WAIT_V(0);
    if constexpr (!ALIGN_EPI) { if (wr == 0) PG8_BAR; }
    PG8_BAR;
    if constexpr (Epi::AFTER_DRAIN) { E.fused(acc, cur, wr, wc, fr, fq, lds, wid, lane); S.done(cur); }
#undef PG8_SA
#undef PG8_SB
#undef PG8_STAGE
#undef PG8_LDA
#undef PG8_LDB
#undef PG8_MMA
#undef PG8_WAIT_V
#undef PG8_WAIT_L
#undef PG8_BAR
#undef PG8_SCHED
}
}

constexpr int NWAVES = 8, NTHR = NWAVES * 64;
constexpr int DM = 2048, FF = 5504, FF2 = 2 * FF, NLAT = 8192, NCTX = 512, MT = NLAT + NCTX, TSEQ = 4096, TCTX = 256;
constexpr int PROJ = 14976, PROJP = 15104;
constexpr int P_U = 0, P_V = 1024, P_RKV = 2048, P_G = 5120, P_W = 5376, P_A = 5568, P_QKV = 5760, P_GATE = 8832;
constexpr int P_V2 = 31 * 256, P_GATE2 = 35 * 256;
constexpr int ACTW = 768, LOW = 5120;
constexpr int NLAYER = 2, NMOD = 9;

constexpr size_t MiB = 1u << 20;
constexpr size_t al(size_t x) { return (x + MiB - 1) / MiB * MiB; }
constexpr size_t WS_CTL = 0, CTL_ZERO_BYTES = 1 * MiB;
constexpr size_t WS_MODS = 1 * MiB;
constexpr size_t WS_ROPE = WS_MODS + al((size_t)NLAYER * 3 * NMOD * DM * 4);
constexpr size_t WS_WF1 = WS_ROPE + MiB;
constexpr size_t SZ_WF1 = (size_t)FF2 * DM * 2;
constexpr size_t WS_WF2 = WS_WF1 + al(4 * SZ_WF1);
constexpr size_t SZ_WF2 = (size_t)DM * FF * 2;
constexpr size_t WS_WIN = WS_WF2 + al(4 * SZ_WF2);
constexpr size_t SZ_WIN = (size_t)PROJP * DM * 2;
constexpr size_t WS_WLO = WS_WIN + al(2 * SZ_WIN);
constexpr size_t SZ_WLO = (size_t)LOW * ACTW * 2;
constexpr size_t WS_WBR = WS_WLO + al(2 * SZ_WLO);
constexpr size_t SZ_WBR = (size_t)3 * DM * 1024 * 2;
constexpr size_t WS_WOUT = WS_WBR + al(2 * SZ_WBR);
constexpr size_t SZ_WOUT = (size_t)DM * DM * 2;
constexpr size_t WS_XS = WS_WOUT + al(2 * SZ_WOUT);
constexpr size_t WS_XN = WS_XS + al((size_t)MT * DM * 4);
constexpr size_t WS_P = WS_XN + al((size_t)MT * DM * 2);
constexpr size_t WS_R1 = WS_P + al((size_t)MT * PROJP * 2);
constexpr size_t WS_ACT = WS_R1 + al((size_t)MT * FF * 2);
constexpr size_t WS_RKVK = WS_ACT + al((size_t)MT * ACTW * 2);
constexpr size_t WS_QK = WS_RKVK + al((size_t)MT * 4096 * 2);
constexpr size_t WS_YS = WS_QK + al((size_t)MT * DM * 2);
constexpr size_t WS_Y3 = WS_YS + al((size_t)2 * MT * 1024 * 2);
constexpr size_t WS_OJ = WS_Y3 + al((size_t)3 * MT * 1024 * 2);
constexpr size_t WS_PART = WS_OJ + al((size_t)2 * MT * 1024 * 2);
constexpr size_t WS_ZF = WS_PART + al((size_t)16 * NCTX * DM * 2);
constexpr size_t WS_IMG = WS_ZF + al((size_t)MT * DM * 2);
constexpr size_t WS_END = WS_IMG + al((size_t)64 * 136 * 22528);

constexpr int CW_TMO = 0, CW_CODE = 1, CW_BAR = 4096;

constexpr int RING_BYTES = 131072, LDSCTL_OFF = RING_BYTES, MISC_OFF = LDSCTL_OFF + 320, LDS_BYTES = 147456;

#define GAS __attribute__((address_space(1)))
#define LAS __attribute__((address_space(3)))
typedef unsigned short bf16;
typedef unsigned v4u __attribute__((ext_vector_type(4)));
typedef unsigned v2u __attribute__((ext_vector_type(2)));
typedef float f32x4 __attribute__((ext_vector_type(4)));
typedef short bf16x8 __attribute__((ext_vector_type(8)));
typedef GAS unsigned gu32;
#define RLX_AGENT __ATOMIC_RELAXED, __HIP_MEMORY_SCOPE_AGENT
__device__ __forceinline__ unsigned f2bf(float f) { unsigned u = __builtin_bit_cast(unsigned, f); return (u + 0x7fffu + ((u >> 16) & 1u)) >> 16; }
__device__ __forceinline__ unsigned pk2(float lo, float hi) { return f2bf(lo) | (f2bf(hi) << 16); }
__device__ __forceinline__ float bflo(unsigned w) { return __builtin_bit_cast(float, w << 16); }
__device__ __forceinline__ float bfhi(unsigned w) { return __builtin_bit_cast(float, w & 0xffff0000u); }
__device__ __forceinline__ float bf1(bf16 h) { return __builtin_bit_cast(float, (unsigned)h << 16); }
__device__ __forceinline__ void unpack8(const v4u w, float (&f)[8]) { f[0] = bflo(w.x); f[1] = bfhi(w.x); f[2] = bflo(w.y); f[3] = bfhi(w.y); f[4] = bflo(w.z); f[5] = bfhi(w.z); f[6] = bflo(w.w); f[7] = bfhi(w.w); }
__device__ __forceinline__ v4u pack8(const float (&f)[8]) { v4u w; w.x = pk2(f[0], f[1]); w.y = pk2(f[2], f[3]); w.z = pk2(f[4], f[5]); w.w = pk2(f[6], f[7]); return w; }
__device__ __forceinline__ float fsigm(float x) { return __builtin_amdgcn_rcpf(1.f + __expf(-x)); }
__device__ __forceinline__ float ftanh(float x) { return 1.f - 2.f * __builtin_amdgcn_rcpf(__expf(2.f * x) + 1.f); }
__device__ __forceinline__ float gelu_t(float x) { return 0.5f * x * (1.f + ftanh(0.7978845608f * (x + 0.044715f * x * x * x))); }
__device__ __forceinline__ float wave_sum(float v) {
#pragma unroll
    for (int o = 1; o < 64; o <<= 1) v += __shfl_xor(v, o);
    return v;
}
#define XB_TMO      128
#define XB_XCNT(j)  (256  + 64 * (j))
#define XB_XSUB(j)  (1280 + 64 * (j))
#define XB_XGEN(j)  (2304 + 64 * (j))
#define XB_TOP      3328
#define XB_TOPGEN   3392
#define XCD_BAR_WORDS 3456
#define XB_SPIN_CAP (1u << 18)

__device__ __forceinline__ unsigned xb_ld(unsigned* p)              { return __hip_atomic_load(p, __ATOMIC_RELAXED, __HIP_MEMORY_SCOPE_AGENT); }
__device__ __forceinline__ unsigned xb_add(unsigned* p, unsigned v) { return __hip_atomic_fetch_add(p, v, __ATOMIC_RELAXED, __HIP_MEMORY_SCOPE_AGENT); }
__device__ __forceinline__ unsigned xb_xcc_id() { return (unsigned)__builtin_amdgcn_s_getreg((3 << 11) | 20) & 0xFu; }
#define XB_SPIN(cond, bar) do { unsigned _sp = 0; while (cond) { __builtin_amdgcn_s_sleep(1); \
    if ((++_sp & 255u) == 0u) { if (xb_ld(&(bar)[XB_TMO])) break; if (_sp > XB_SPIN_CAP) { atomicAdd(&(bar)[XB_TMO], 1u); break; } } } } while (0)

struct XcdBarrier {
    unsigned* bar; unsigned x;
    volatile LAS unsigned* st;
};

__device__ __forceinline__ XcdBarrier xcd_barrier_post(unsigned* bar, volatile LAS unsigned* st) {
    XcdBarrier b; b.bar = bar; b.x = xb_xcc_id(); b.st = st;
    if (threadIdx.x == 0) (void)xb_add(&bar[XB_XCNT(b.x)], 1u);
    return b;
}
__device__ __forceinline__ void xcd_barrier_complete(unsigned* bar, unsigned x, unsigned& nloc, unsigned& nx) {
    const unsigned G = gridDim.x * gridDim.y * gridDim.z;
    unsigned sum, cnt, mine, sp = 0u;
    for (;;) {
        sum = 0u; cnt = 0u; mine = 0u;
#pragma unroll
        for (unsigned j = 0; j < 16; ++j) { const unsigned c = xb_ld(&bar[XB_XCNT(j)]); sum += c; cnt += (c > 0u) ? 1u : 0u; mine = (j == x) ? c : mine; }
        if (sum == G) break;
        __builtin_amdgcn_s_sleep(1);
        if ((++sp & 255u) == 0u) { if (xb_ld(&bar[XB_TMO])) break; if (sp > XB_SPIN_CAP) { atomicAdd(&bar[XB_TMO], 1u); break; } }
    }
    nloc = mine > 0u ? mine : 1u; nx = cnt > 0u ? cnt : 1u;
}

__device__ __forceinline__ void xcd_barrier(const XcdBarrier& b) {
    asm volatile("s_waitcnt vmcnt(0)" ::: "memory");
    __syncthreads();
    if (threadIdx.x == 0) {
        unsigned* bar = b.bar;
        __builtin_amdgcn_s_waitcnt(0);
        unsigned nloc = b.st[0], nx = b.st[1];
        if (nloc == 0u) { xcd_barrier_complete(bar, b.x, nloc, nx); b.st[0] = nloc; b.st[1] = nx; }
        const unsigned old = xb_add(&bar[XB_XSUB(b.x)], 1u);
        const unsigned gen = old / nloc;
        if (old + 1u == (gen + 1u) * nloc) {
            __builtin_amdgcn_fence(__ATOMIC_RELEASE, "agent");
            asm volatile("s_waitcnt vmcnt(0)" ::: "memory");
            const unsigned og = xb_add(&bar[XB_TOP], 1u);
            const unsigned tg = og / nx;
            if (og + 1u == (tg + 1u) * nx) xb_add(&bar[XB_TOPGEN], 1u);
            else XB_SPIN(xb_ld(&bar[XB_TOPGEN]) == tg, bar);
            __builtin_amdgcn_fence(__ATOMIC_ACQUIRE, "agent");
            xb_add(&bar[XB_XGEN(b.x)], 1u);
            asm volatile("s_waitcnt vmcnt(0)" ::: "memory");
        } else {
            XB_SPIN(xb_ld(&bar[XB_XGEN(b.x)]) == gen, bar);
            __builtin_amdgcn_fence(__ATOMIC_ACQUIRE, "agent");
            asm volatile("s_waitcnt vmcnt(0)" ::: "memory");
        }
    }
    __syncthreads();
}

struct Args { const float* in[31]; float* out; unsigned char* ws; int ph_lo, ph_hi; };
enum In { I_X = 0, I_C, I_CTX, I_CCTX, I_WADA, I_BADA, I_NORMG, I_FFNIN, I_FFNOUT, I_WIN, I_GMVN, I_GMWS, I_GMBS, I_CONV, I_W0, I_WUP, I_A0, I_AUP, I_GUP, I_KK, I_KA, I_RK, I_LNG, I_LNB,
          I_QN, I_KN, I_LAM, I_SUBLN, I_WBR, I_BGATE, I_WOUT };

__device__ __forceinline__ void ph_ada(const Args& a, LAS unsigned char* lds, int tid, int vcu, int G) {
    LAS float* sc = (LAS float*)lds;
    LAS float* red = sc + 3 * 2048;
    const float* c = a.in[I_C]; const float* cc = a.in[I_CCTX];
    for (int i = tid; i < 3 * 2048; i += NTHR) { const float x = i < 4096 ? c[i] : cc[i - 4096]; sc[i] = x * fsigm(x); }
    __syncthreads();
    const int lane = tid & 63, wave = tid >> 6;
    float* mods = (float*)(a.ws + WS_MODS);
    for (int u = vcu; u < NLAYER * 288; u += G) {
        const int l = u / 288, jc = u - l * 288, j = jc * 64 + lane;
        const float* W = a.in[I_WADA] + (size_t)l * 2048 * 18432 + j;
        float s0 = 0.f, s1 = 0.f, s2 = 0.f;
        const int k0 = wave * 256;
#pragma unroll 32
        for (int k = 0; k < 256; ++k) { const float w = W[(size_t)(k0 + k) * 18432]; s0 += sc[k0 + k] * w; s1 += sc[2048 + k0 + k] * w; s2 += sc[4096 + k0 + k] * w; }
        red[(wave * 3 + 0) * 64 + lane] = s0; red[(wave * 3 + 1) * 64 + lane] = s1; red[(wave * 3 + 2) * 64 + lane] = s2;
        __syncthreads();
        if (wave < 3) { float s = a.in[I_BADA][(size_t)l * 18432 + j];
#pragma unroll
            for (int w8 = 0; w8 < 8; ++w8) s += red[(w8 * 3 + wave) * 64 + lane];
            mods[(size_t)(l * 3 + wave) * 18432 + j] = s; }
        __syncthreads();
    }
}
__device__ __forceinline__ void transpose_item(const float* W, int N, int sc0, bf16* WT, int Kd, int nd0, int k0, LAS float* scr, int lane, bool permq = false) {
    if (sc0 >= 0) {
#pragma unroll
        for (int i = 0; i < 32; ++i) { const int kk = 2 * i + (lane >> 5); scr[kk * 33 + (lane & 31)] = W[(size_t)(k0 + kk) * N + sc0 + (lane & 31)]; }
    } else {
#pragma unroll 8
        for (int i = 0; i < 32; ++i) { const int kk = 2 * i + (lane >> 5); scr[kk * 33 + (lane & 31)] = 0.f; }
    }
    asm volatile("s_waitcnt lgkmcnt(0)" ::: "memory");
    const int c = lane & 7;
#pragma unroll
    for (int j = 0; j < 4; ++j) { const int n = (lane >> 3) + 8 * j;
        const int ns = permq ? (((n & 7) < 4) ? 4 * (n >> 3) + (n & 7) : 16 + 4 * (n >> 3) + (n & 7) - 4) : n;
        const LAS float* s = scr + (8 * c) * 33 + ns;
        v4u o; o.x = pk2(s[0 * 33], s[1 * 33]); o.y = pk2(s[2 * 33], s[3 * 33]); o.z = pk2(s[4 * 33], s[5 * 33]); o.w = pk2(s[6 * 33], s[7 * 33]);
        *(GAS v4u*)(WT + (size_t)(nd0 + n) * Kd + k0 + 8 * c) = o; }
    asm volatile("s_waitcnt lgkmcnt(0)" ::: "memory");
}
__device__ __forceinline__ void ph_weights(const Args& a, int l, LAS unsigned char* lds, int tid, int vcu, int G) {
    const int lane = tid & 63, wave = tid >> 6;
    LAS float* scr = (LAS float*)(lds + wave * 16384);
    const int gw = vcu * NWAVES + wave, NGW = G * NWAVES;
    constexpr int I_F1 = 32 * (FF2 / 32), I_F2 = (FF / 64) * (DM / 32), I_IN = 32 * (PROJP / 32), I_BR = 16 * (DM / 32), I_WO = 32 * (DM / 32);
    constexpr int NITEMS = 2 * I_F1 + 2 * I_F2 + I_IN + 3 * I_BR + I_WO;
    unsigned char* ws = a.ws;
    for (int it = gw; it < NITEMS; it += NGW) {
        int r = it;
        if (r < 2 * I_F1) { const int mi = l * 2 + r / I_F1, q = r % I_F1, nb = q % (FF2 / 32), kb = q / (FF2 / 32), nd0 = 32 * nb, pn = nd0 >> 8, rr = nd0 & 255;
            const int sc0 = rr < 128 ? pn * 128 + rr : FF + pn * 128 + (rr - 128);
            transpose_item(a.in[I_FFNIN] + (size_t)mi * DM * FF2, FF2, sc0, (bf16*)(ws + WS_WF1 + (size_t)mi * SZ_WF1), DM, nd0, 64 * kb, scr, lane); continue; }
        r -= 2 * I_F1;
        if (r < 2 * I_F2) { const int mi = l * 2 + r / I_F2, q = r % I_F2, nb = q % (DM / 32), kb = q / (DM / 32);
            transpose_item(a.in[I_FFNOUT] + (size_t)mi * FF * DM, DM, 32 * nb, (bf16*)(ws + WS_WF2 + (size_t)mi * SZ_WF2), FF, 32 * nb, 64 * kb, scr, lane); continue; }
        r -= 2 * I_F2;
        if (r < I_IN) { const int mi = l, q = r, nb = q % (PROJP / 32), kb = q / (PROJP / 32), nd0 = 32 * nb, T = nd0 >> 8, cc = nd0 & 255;
            int sc0; bool pq = false;
            if (T <= 21) sc0 = nd0;
            else if (T == 22) sc0 = cc < 128 ? nd0 : -1;
            else if (T <= 30) { sc0 = P_QKV + ((T - 23) * 4 + ((cc >> 5) & 3)) * 64 + (cc >> 7) * 32; pq = true; }
            else if (T <= 34) sc0 = P_QKV + 2048 + (nd0 - 31 * 256);
            else sc0 = P_GATE + (nd0 - 35 * 256);
            transpose_item(a.in[I_WIN] + (size_t)mi * DM * PROJ, PROJ, sc0, (bf16*)(ws + WS_WIN + (size_t)mi * SZ_WIN), DM, nd0, 64 * kb, scr, lane, pq); continue; }
        r -= I_IN;
        if (r < 3 * I_BR) { const int mi = l * 3 + r / I_BR, q = r % I_BR, nb = q % (DM / 32), kb = q / (DM / 32);
            transpose_item(a.in[I_WBR] + (size_t)mi * 1024 * DM, DM, 32 * nb, (bf16*)(ws + WS_WBR + (size_t)mi * ((size_t)DM * 1024 * 2)), 1024, 32 * nb, 64 * kb, scr, lane); continue; }
        r -= 3 * I_BR;
        { const int mi = l, q = r, nb = q % (DM / 32), kb = q / (DM / 32);
            transpose_item(a.in[I_WOUT] + (size_t)mi * DM * DM, DM, 32 * nb, (bf16*)(ws + WS_WOUT + (size_t)mi * SZ_WOUT), DM, 32 * nb, 64 * kb, scr, lane); }
    }
}
__device__ __forceinline__ void ph_small(const Args& a, int tid, int vcu, int G) {
    unsigned char* ws = a.ws;
    const int gt = vcu * NTHR + tid, NGT = G * NTHR;
    for (int i = gt; i < NLAYER * LOW * (ACTW / 8); i += NGT) {
        const int l = i / (LOW * (ACTW / 8)), q = i % (LOW * (ACTW / 8)), n = q / (ACTW / 8), k0 = (q % (ACTW / 8)) * 8, sec = n >> 10, cc = n & 1023;
        float f[8];
#pragma unroll
        for (int e = 0; e < 8; ++e) { const int k = k0 + e; float v = 0.f;
            if (sec == 0) { if (k < 256) v = a.in[I_GUP][((size_t)l * 256 + k) * 1024 + cc]; }
            else if (sec <= 2) { const int d = sec - 1, kb = 256 + 128 * d; if (k >= kb && k < kb + 96) v = a.in[I_WUP][((size_t)(l * 2 + d) * 96 + (k - kb)) * 1024 + cc]; }
            else { const int d = sec - 3, kb = 512 + 128 * d; if (k >= kb && k < kb + 96) v = a.in[I_AUP][((size_t)(l * 2 + d) * 96 + (k - kb)) * 1024 + cc]; }
            f[e] = v; }
        *(GAS v4u*)((bf16*)(ws + WS_WLO) + ((size_t)l * LOW + n) * ACTW + k0) = pack8(f);
    }
    for (int i = gt; i < 64 * 16; i += NGT) { const int p = i >> 4, ii = i & 15;
        const float inv = exp2f(-(float)(2 * ii) * (1.f / 32.f) * 13.287712379549449f);
        const float rev = (float)p * inv * 0.15915494309189535f;
        float* rt = (float*)(ws + WS_ROPE) + 2 * i; rt[0] = __builtin_amdgcn_cosf(rev); rt[1] = __builtin_amdgcn_sinf(rev); }
}

__device__ __forceinline__ void norm_row_store(f32x4 (&v)[8], int m, const float* gain, const float* mods, int si, bf16* XN, int lane) {
    float ss = 0.f;
#pragma unroll
    for (int j = 0; j < 8; ++j) ss += (v[j].x * v[j].x + v[j].y * v[j].y) + (v[j].z * v[j].z + v[j].w * v[j].w);
    const float rinv = 1.f / sqrtf(wave_sum(ss) * (1.f / DM) + 1e-6f);
    const int set = m < TSEQ ? 0 : (m < NLAT ? 1 : 2);
    const float* sh = mods + (size_t)(set * NMOD + si) * DM; const float* scl = sh + DM;
#pragma unroll
    for (int j = 0; j < 8; ++j) { const int col = 4 * lane + 256 * j;
        const f32x4 g = *(const GAS f32x4*)(gain + col), s1 = *(const GAS f32x4*)(scl + col), s0 = *(const GAS f32x4*)(sh + col);
        const f32x4 o = (v[j] * rinv * g) * (s1 + 1.f) + s0;
        v2u w; w.x = pk2(o.x, o.y); w.y = pk2(o.z, o.w);
        *(GAS v2u*)(XN + (size_t)m * DM + col) = w; }
}
__device__ __forceinline__ void ph_norm(const float* xl, const float* xc, const float* gain, const float* mods  , int si, bf16* XN, float* xs_out, const bf16* part, int nsplit, int nrows, int gw, int NGW, int lane, LAS float* red) {
    if (NLAT == 4 * NGW) {
        f32x4 v[4][8];
#pragma unroll
        for (int q = 0; q < 4; ++q)
#pragma unroll
            for (int j = 0; j < 8; ++j) v[q][j] = *(const GAS f32x4*)(xl + (size_t)(gw + q * NGW) * DM + 4 * lane + 256 * j);
        float rinv[4];
#pragma unroll
        for (int q = 0; q < 4; ++q) { float ss = 0.f;
#pragma unroll
            for (int j = 0; j < 8; ++j) ss += (v[q][j].x * v[q][j].x + v[q][j].y * v[q][j].y) + (v[q][j].z * v[q][j].z + v[q][j].w * v[q][j].w);
            rinv[q] = 1.f / sqrtf(wave_sum(ss) * (1.f / DM) + 1e-6f); }
        const float* sh0 = mods + (size_t)(0 * NMOD + si) * DM; const float* sh1 = mods + (size_t)(1 * NMOD + si) * DM;
#pragma unroll
        for (int j = 0; j < 8; ++j) { const int col = 4 * lane + 256 * j;
            const f32x4 g = *(const GAS f32x4*)(gain + col), a0 = *(const GAS f32x4*)(sh0 + DM + col) + 1.f, b0 = *(const GAS f32x4*)(sh0 + col), a1 = *(const GAS f32x4*)(sh1 + DM + col) + 1.f, b1 = *(const GAS f32x4*)(sh1 + col);
#pragma unroll
            for (int q = 0; q < 4; ++q) { const f32x4 o = (v[q][j] * rinv[q] * g) * (q < 2 ? a0 : a1) + (q < 2 ? b0 : b1);
                v2u w; w.x = pk2(o.x, o.y); w.y = pk2(o.z, o.w);
                *(GAS v2u*)(XN + (size_t)(gw + q * NGW) * DM + col) = w; } }
    } else
    for (int m = gw; m < NLAT; m += 2 * NGW) {
        const int m2 = m + NGW; const bool two = m2 < NLAT;
        f32x4 v[8], u[8];
#pragma unroll
        for (int j = 0; j < 8; ++j) v[j] = *(const GAS f32x4*)(xl + (size_t)m * DM + 4 * lane + 256 * j);
        if (two) {
#pragma unroll
            for (int j = 0; j < 8; ++j) u[j] = *(const GAS f32x4*)(xl + (size_t)m2 * DM + 4 * lane + 256 * j); }
        norm_row_store(v, m, gain, mods, si, XN, lane);
        if (two) norm_row_store(u, m2, gain, mods, si, XN, lane);
    }
    if (nrows > NLAT && NCTX * 4 == NGW) {
        const int wave = gw & 7, r = gw >> 2, m = NLAT + r, col = (gw & 3) * 512 + 8 * lane;
        f32x4 x0 = *(const GAS f32x4*)(xc + (size_t)r * DM + col), x1 = *(const GAS f32x4*)(xc + (size_t)r * DM + col + 4);
        if (part != nullptr)
#pragma nounroll
        for (int s = 0; s < nsplit; s += 8) {
            v4u p[8];
#pragma unroll
            for (int q = 0; q < 8; ++q) p[q] = *(const GAS v4u*)(part + ((size_t)(s + q) * NCTX + r) * DM + col);
#pragma unroll
            for (int q = 0; q < 8; ++q) { x0.x += bflo(p[q].x); x0.y += bfhi(p[q].x); x0.z += bflo(p[q].y); x0.w += bfhi(p[q].y); x1.x += bflo(p[q].z); x1.y += bfhi(p[q].z); x1.z += bflo(p[q].w); x1.w += bfhi(p[q].w); } }
        *(GAS f32x4*)(xs_out + (size_t)m * DM + col) = x0; *(GAS f32x4*)(xs_out + (size_t)m * DM + col + 4) = x1;
        const float ss = wave_sum((x0.x * x0.x + x0.y * x0.y) + (x0.z * x0.z + x0.w * x0.w) + (x1.x * x1.x + x1.y * x1.y) + (x1.z * x1.z + x1.w * x1.w));
        if (lane == 0) red[wave] = ss;
        __syncthreads();
        const LAS float* rq = red + (wave & 4);
        const float rinv = 1.f / sqrtf(((rq[0] + rq[1]) + (rq[2] + rq[3])) * (1.f / DM) + 1e-6f);
        const float* sh = mods + (size_t)(2 * NMOD + si) * DM; const float* scl = sh + DM;
        const f32x4 g0 = *(const GAS f32x4*)(gain + col), g1 = *(const GAS f32x4*)(gain + col + 4), s10 = *(const GAS f32x4*)(scl + col), s11 = *(const GAS f32x4*)(scl + col + 4), s00 = *(const GAS f32x4*)(sh + col), s01 = *(const GAS f32x4*)(sh + col + 4);
        const f32x4 o0 = (x0 * rinv * g0) * (s10 + 1.f) + s00, o1 = (x1 * rinv * g1) * (s11 + 1.f) + s01;
        v4u w; w.x = pk2(o0.x, o0.y); w.y = pk2(o0.z, o0.w); w.z = pk2(o1.x, o1.y); w.w = pk2(o1.z, o1.w);
        *(GAS v4u*)(XN + (size_t)m * DM + col) = w;
        __syncthreads();
    } else
    if (nrows > NLAT && (gw & 3) == 0) for (int r = gw >> 2; r < NCTX; r += NGW >> 2) {
        const int m = NLAT + r;
        f32x4 v[8];
#pragma unroll
        for (int j = 0; j < 8; ++j) v[j] = *(const GAS f32x4*)(xc + (size_t)r * DM + 4 * lane + 256 * j);
        if (part != nullptr)
#pragma nounroll
        for (int s = 0; s < nsplit; s += 4) {
            v2u p[4][8];
#pragma unroll
            for (int q = 0; q < 4; ++q)
#pragma unroll
                for (int j = 0; j < 8; ++j) p[q][j] = *(const GAS v2u*)(part + ((size_t)(s + q) * NCTX + r) * DM + 4 * lane + 256 * j);
#pragma unroll
            for (int q = 0; q < 4; ++q)
#pragma unroll
                for (int j = 0; j < 8; ++j) { v[j].x += bflo(p[q][j].x); v[j].y += bfhi(p[q][j].x); v[j].z += bflo(p[q][j].y); v[j].w += bfhi(p[q][j].y); } }
#pragma unroll
        for (int j = 0; j < 8; ++j) *(GAS f32x4*)(xs_out + (size_t)m * DM + 4 * lane + 256 * j) = v[j];
        norm_row_store(v, m, gain, mods, si, XN, lane);
    }
}

struct RkvkItem { v4u x[3][3]; int m, c0; bool hp, hn; };
__device__ __forceinline__ void rkvk_load(RkvkItem& it, const bf16* P, int i) {
    const int m = i >> 7, c0 = (i & 127) * 8; it.m = m; it.c0 = c0;
    const int t = m < NLAT ? (m & (TSEQ - 1)) : ((m - NLAT) & (TCTX - 1)), tl = m < NLAT ? TSEQ : TCTX;
    it.hp = t > 0; it.hn = t < tl - 1;
#pragma unroll
    for (int sec = 0; sec < 3; ++sec) { const bf16* pc = P + (size_t)m * PROJP + P_RKV + sec * 1024 + c0;
        it.x[sec][1] = *(const GAS v4u*)pc;
        it.x[sec][0] = it.hp ? *(const GAS v4u*)(pc - PROJP) : (v4u){0u, 0u, 0u, 0u};
        it.x[sec][2] = it.hn ? *(const GAS v4u*)(pc + PROJP) : (v4u){0u, 0u, 0u, 0u}; }
}
__device__ __forceinline__ void rkvk_finish(const RkvkItem& it, bf16* RK, const float* cw, const float* kkw) {
    const int c0 = it.c0; float rkv[3][8];
#pragma unroll
    for (int sec = 0; sec < 3; ++sec) { const int col = sec * 1024 + c0; float x0[8], x1[8], x2[8];
        unpack8(it.x[sec][0], x0); unpack8(it.x[sec][1], x1); unpack8(it.x[sec][2], x2);
#pragma unroll
        for (int e = 0; e < 8; ++e) rkv[sec][e] = x1[e] * cw[3072 + col + e] + x0[e] * cw[col + e] + x2[e] * cw[2 * 3072 + col + e]; }
    float kk8[8]; float ss = 0.f;
#pragma unroll
    for (int e = 0; e < 8; ++e) { kk8[e] = rkv[1][e] * kkw[c0 + e]; ss += kk8[e] * kk8[e]; }
    ss += __shfl_xor(ss, 1); ss += __shfl_xor(ss, 2); ss += __shfl_xor(ss, 4);
    const float rinv = 1.f / sqrtf(ss + 1e-12f);
    GAS v4u* dst = (GAS v4u*)(RK + (size_t)it.m * 4096 + c0 * 4);
#pragma unroll
    for (int j = 0; j < 4; ++j) { v4u o; o.x = pk2(rkv[0][2 * j], rkv[1][2 * j]); o.y = pk2(rkv[2][2 * j], kk8[2 * j] * rinv); o.z = pk2(rkv[0][2 * j + 1], rkv[1][2 * j + 1]); o.w = pk2(rkv[2][2 * j + 1], kk8[2 * j + 1] * rinv); dst[j] = o; }
}
__device__ __forceinline__ void ph_e1(const Args& a, int l, int gt, int NGT) {
    const bf16* P = (const bf16*)(a.ws + WS_P); bf16* RK = (bf16*)(a.ws + WS_RKVK);
    const float* cw = a.in[I_CONV] + (size_t)l * 3 * 3072; const float* kkw = a.in[I_KK] + l * 1024;
    constexpr int NI = MT * 128;
    for (int i = gt; i < NI; i += 2 * NGT) {
        RkvkItem A, B; const bool two = i + NGT < NI;
        rkvk_load(A, P, i); if (two) rkvk_load(B, P, i + NGT);
        rkvk_finish(A, RK, cw, kkw); if (two) rkvk_finish(B, RK, cw, kkw);
    }
}

__device__ __forceinline__ void ph_gmlp(const Args& a, int l, LAS unsigned char* lds, int tid, int vcu, int G) {
    constexpr int VP = 136;
    LAS bf16* vnT = (LAS bf16*)lds;
    const bf16* P = (const bf16*)(a.ws + WS_P); bf16* YA = (bf16*)(a.ws + WS_Y3);
    const float* vng = a.in[I_GMVN] + l * 1024; const float* wsm = a.in[I_GMWS] + (size_t)l * 8 * 128 * 128; const float* bs = a.in[I_GMBS] + l * 8 * 128;
    const int lane = tid & 63, w = tid >> 6, fr = lane & 15, fq = lane >> 4;
    for (int u = vcu; u < (MT / 128) * 8; u += G) {
        const int n = u >> 3, g = u & 7, m0 = n * 128;
        { const int q = tid >> 2, qt = tid & 3; const bf16* src = P + (size_t)(m0 + q) * PROJP + P_V + g * 128 + qt * 32;
            float v[32]; float ss = 0.f;
#pragma unroll
            for (int j = 0; j < 4; ++j) { float f[8]; unpack8(*(const GAS v4u*)(src + 8 * j), f);
#pragma unroll
                for (int e = 0; e < 8; ++e) { const float x = f[e]; v[8 * j + e] = x; ss += x * x; } }
            ss += __shfl_xor(ss, 1); ss += __shfl_xor(ss, 2);
            const float rinv = 1.f / sqrtf(ss * (1.f / 128.f) + 1e-6f);
#pragma unroll
            for (int e = 0; e < 32; ++e) { const int c = qt * 32 + e; vnT[c * VP + q] = (bf16)f2bf(v[e] * rinv * vng[g * 128 + c]); } }
        __syncthreads();
        pg8::f32x4 acc[8];
#pragma unroll
        for (int cb = 0; cb < 8; ++cb) acc[cb] = (pg8::f32x4){0.f, 0.f, 0.f, 0.f};
#pragma unroll
        for (int ks = 0; ks < 4; ++ks) {
            const float* wr = wsm + ((size_t)g * 128 + 16 * w + fr) * 128 + ks * 32 + 8 * fq;
            const f32x4 w0 = *(const GAS f32x4*)wr, w1 = *(const GAS f32x4*)(wr + 4);
            v4u aw; aw.x = pk2(w0.x, w0.y); aw.y = pk2(w0.z, w0.w); aw.z = pk2(w1.x, w1.y); aw.w = pk2(w1.z, w1.w);
            const bf16x8 af = __builtin_bit_cast(bf16x8, aw);
#pragma unroll
            for (int cb = 0; cb < 8; ++cb) { const bf16x8 bfr = *(const LAS bf16x8*)(vnT + (cb * 16 + fr) * VP + ks * 32 + 8 * fq);
                acc[cb] = __builtin_amdgcn_mfma_f32_16x16x32_bf16(bfr, af, acc[cb], 0, 0, 0); }
        }
        { const int p = 16 * w + fr; const float bsp = bs[g * 128 + p];
          const bf16* pup = P + (size_t)(m0 + p) * PROJP + P_U + g * 128 + 4 * fq; bf16* yap = YA + (size_t)(m0 + p) * 1024 + g * 128 + 4 * fq;
          v2u pu[8];
#pragma unroll
          for (int cb = 0; cb < 8; ++cb) pu[cb] = *(const GAS v2u*)(pup + cb * 16);
#pragma unroll
          for (int cb = 0; cb < 8; ++cb) { v2u o;
              o.x = pk2(bflo(pu[cb].x) * (acc[cb][0] + bsp), bfhi(pu[cb].x) * (acc[cb][1] + bsp)); o.y = pk2(bflo(pu[cb].y) * (acc[cb][2] + bsp), bfhi(pu[cb].y) * (acc[cb][3] + bsp));
              *(GAS v2u*)(yap + cb * 16) = o; } }
        __syncthreads();
    }
}

namespace att {
using bf16x8 = __attribute__((ext_vector_type(8))) short;
using s16x4  = __attribute__((ext_vector_type(4))) short;
using f32x16 = __attribute__((ext_vector_type(16))) float;
using u32x4  = __attribute__((ext_vector_type(4))) unsigned;
constexpr int NW = 8, QBLK = 32, KVBLK = 64;
constexpr int SHM_V = KVBLK * 128 * 2, SHM_K = KVBLK * 64 * 2, SHM_ATTN = 2 * SHM_V + 2 * SHM_K + NW * 64 * 4;
#define KSWZ(row, colB) ((row) * 128 + ((colB) ^ ((((row) >> 1) & 7) << 4)))
#define SBAR() __builtin_amdgcn_sched_barrier(0)
__device__ __forceinline__ int crow(int r, int hi) { return (r & 3) + 8 * (r >> 2) + 4 * hi; }
__device__ __forceinline__ unsigned cvtpk(float lo, float hi) { unsigned r; asm volatile("v_cvt_pk_bf16_f32 %0, %1, %2" : "=v"(r) : "v"(lo), "v"(hi)); return r; }
__device__ __forceinline__ void partialSM(f32x16& p0, f32x16& p1) {
#pragma unroll
  for (int r = 0; r < 16; ++r) p0[r] = __builtin_amdgcn_exp2f(p0[r]);
}
__device__ __forceinline__ void finishSM(f32x16& p0, f32x16& p1, float& l_reg, bf16x8& pa0, bf16x8& pa1, bf16x8& pa2, bf16x8& pa3) {
#pragma unroll
  for (int r = 0; r < 16; ++r) p1[r] = __builtin_amdgcn_exp2f(p1[r]);
  float ps = 0;
#pragma unroll
  for (int r = 0; r < 16; ++r) ps += p0[r];
#pragma unroll
  for (int r = 0; r < 16; ++r) ps += p1[r];
  { auto rr = __builtin_amdgcn_permlane32_swap(__float_as_uint(ps), __float_as_uint(ps), false, false);
    ps = __uint_as_float(rr[0]) + __uint_as_float(rr[1]); }
  l_reg += ps;
#define PK4(P, BASE, OUT) do { unsigned a0 = cvtpk(P[BASE + 0], P[BASE + 1]), a1 = cvtpk(P[BASE + 2], P[BASE + 3]);   \
    unsigned b0 = cvtpk(P[BASE + 4], P[BASE + 5]), b1 = cvtpk(P[BASE + 6], P[BASE + 7]);                              \
    auto r0 = __builtin_amdgcn_permlane32_swap(a0, b0, false, false); auto r1 = __builtin_amdgcn_permlane32_swap(a1, b1, false, false); \
    u32x4 w = {r0[0], r1[0], r0[1], r1[1]}; OUT = *reinterpret_cast<bf16x8*>(&w); } while (0)
  PK4(p0, 0, pa0); PK4(p0, 8, pa1); PK4(p1, 0, pa2); PK4(p1, 8, pa3);
#undef PK4
}
__device__ __forceinline__ void qkt(f32x16& p0, f32x16& p1, const unsigned short* Ks, const bf16x8* qr, int r32, int hi) {
  p0 = f32x16{}; p1 = f32x16{};
#pragma unroll
  for (int d0 = 0; d0 < 4; ++d0) { int cb = (d0 * 16 + hi * 8) * 2;
    bf16x8 b0 = *reinterpret_cast<const bf16x8*>((const char*)Ks + KSWZ(r32, cb));
    bf16x8 b1 = *reinterpret_cast<const bf16x8*>((const char*)Ks + KSWZ(32 + r32, cb));
    p0 = __builtin_amdgcn_mfma_f32_32x32x16_bf16(b0, qr[d0], p0, 0, 0, 0);
    p1 = __builtin_amdgcn_mfma_f32_32x32x16_bf16(b1, qr[d0], p1, 0, 0, 0); }
}
__device__ __forceinline__ int v_st(int k, int c) { const int kk = (k & ~0xC) | ((k & 4) << 1) | ((k & 8) >> 1); return ((kk >> 3) * 4 + (c >> 5)) * 512 + ((kk & 7) * 32 + (c & 31)) * 2; }
__device__ __forceinline__ int v_rd_base(int lane) { return ((lane & 3) << 3) | (((lane >> 2) & 3) << 6) | (((lane >> 4) & 1) << 5) | (((lane >> 5) & 1) << 8); }
constexpr int v_rd_off(int d0, int ks, int half) { return d0 * 512 + ks * 4096 + half * 2048; }
template <int OFF> __device__ __forceinline__ s16x4 tr_read(int vb) {
  s16x4 r; asm volatile("ds_read_b64_tr_b16 %0, %1 offset:%2" : "=&v"(r) : "v"(vb), "i"(OFF) : "memory"); return r;
}
template <int D0> __device__ __forceinline__ void pv_one(f32x16& od, int vb, bf16x8 pa0, bf16x8 pa1, bf16x8 pa2, bf16x8 pa3) {
  const s16x4 l0 = tr_read<v_rd_off(D0, 0, 0)>(vb), h0 = tr_read<v_rd_off(D0, 0, 1)>(vb), l1 = tr_read<v_rd_off(D0, 1, 0)>(vb), h1 = tr_read<v_rd_off(D0, 1, 1)>(vb);
  const s16x4 l2 = tr_read<v_rd_off(D0, 2, 0)>(vb), h2 = tr_read<v_rd_off(D0, 2, 1)>(vb), l3 = tr_read<v_rd_off(D0, 3, 0)>(vb), h3 = tr_read<v_rd_off(D0, 3, 1)>(vb);
  asm volatile("s_waitcnt lgkmcnt(0)" ::: "memory"); SBAR();
#define PK(L, H) (bf16x8){L[0], L[1], L[2], L[3], H[0], H[1], H[2], H[3]}
  od = __builtin_amdgcn_mfma_f32_32x32x16_bf16(pa0, PK(l0, h0), od, 0, 0, 0);
  od = __builtin_amdgcn_mfma_f32_32x32x16_bf16(pa1, PK(l1, h1), od, 0, 0, 0);
  od = __builtin_amdgcn_mfma_f32_32x32x16_bf16(pa2, PK(l2, h2), od, 0, 0, 0);
  od = __builtin_amdgcn_mfma_f32_32x32x16_bf16(pa3, PK(l3, h3), od, 0, 0, 0);
#undef PK
}
__device__ __forceinline__ void pv_d0(f32x16* o, int vb, bf16x8 pa0, bf16x8 pa1, bf16x8 pa2, bf16x8 pa3) {
  pv_one<0>(o[0], vb, pa0, pa1, pa2, pa3); pv_one<1>(o[1], vb, pa0, pa1, pa2, pa3); pv_one<2>(o[2], vb, pa0, pa1, pa2, pa3); pv_one<3>(o[3], vb, pa0, pa1, pa2, pa3);
}
__device__ __forceinline__ void attn_unit(const unsigned short* __restrict__ Qb, const unsigned short* __restrict__ Kb, const unsigned short* __restrict__ Vb,
                                          unsigned short* __restrict__ Ob, int NT, int ntl, int klat, int kctx, char* lds) {
  constexpr int LDQ = 2048, LDKK = 2048, LDV = 15104, LDO = 1024;
  const int tid = threadIdx.x, wid = tid >> 6, lane = tid & 63, r32 = lane & 31, hi = lane >> 5;
  unsigned short* V_lds = (unsigned short*)lds; unsigned short* K_lds = (unsigned short*)(lds + 2 * SHM_V);
  float* ws = (float*)(lds + 2 * SHM_V + 2 * SHM_K) + wid * 64; float* li_l = ws;
  float l_reg = 0; f32x16 o[4] = {}; bf16x8 qr[4];
  const unsigned short* Qw = Qb + (long)(wid * QBLK + r32) * LDQ + hi * 8;
#pragma unroll
  for (int d0 = 0; d0 < 4; ++d0) qr[d0] = *reinterpret_cast<const bf16x8*>(Qw + d0 * 16);
  const int sr = tid >> 4, sc = (tid & 15) * 8, vst0 = v_st(sr, sc), vst1 = v_st(32 + sr, sc);
  const int kr = tid >> 3, kc = (tid & 7) * 8, kst = KSWZ(kr, kc * 2);
  const int vb0 = (int)(uintptr_t)V_lds + v_rd_base(lane);
  struct { bf16x8 vs0, vs1, ks0; } sr_[2];
#define KROW(t) ((t) < ntl ? klat + 64 * (t) : kctx + 64 * ((t) - ntl))
#define SLOAD(i, t) do { const long k0_ = KROW(t); sr_[i].vs0 = *reinterpret_cast<const bf16x8*>(&Vb[(k0_ + sr) * LDV + sc]); sr_[i].vs1 = *reinterpret_cast<const bf16x8*>(&Vb[(k0_ + 32 + sr) * LDV + sc]); \
    sr_[i].ks0 = *reinterpret_cast<const bf16x8*>(&Kb[(k0_ + kr) * LDKK + kc]); } while (0)
#define SWRITE(b, i) do { *(bf16x8*)((char*)V_lds + (b) * SHM_V + vst0) = sr_[i].vs0; *(bf16x8*)((char*)V_lds + (b) * SHM_V + vst1) = sr_[i].vs1; \
    *(bf16x8*)((char*)K_lds + (b) * SHM_K + kst) = sr_[i].ks0; } while (0)
#define SWAIT() asm volatile("s_waitcnt vmcnt(3)" ::: "memory")
  f32x16 pA0, pA1, pB0, pB1; bf16x8 pa0, pa1, pa2, pa3;
  constexpr int SE = 0, SO = 1;
  SLOAD(SE, 0); asm volatile("s_waitcnt vmcnt(0)" ::: "memory"); SWRITE(0, SE); __syncthreads();
  qkt(pA0, pA1, K_lds, qr, r32, hi); partialSM(pA0, pA1);
  SLOAD(SO, 1); if (2 < NT) SLOAD(SE, 2);
  SWAIT(); SWRITE(1, SO); __syncthreads();
  for (int j = 1; j + 1 < NT; j += 2) {
    SBAR(); qkt(pB0, pB1, (const unsigned short*)((char*)K_lds + SHM_K), qr, r32, hi);
    finishSM(pA0, pA1, l_reg, pa0, pa1, pa2, pa3); SBAR();
    SLOAD(SO, j + 2); SBAR();
    pv_d0(o, vb0, pa0, pa1, pa2, pa3); partialSM(pB0, pB1);
    __syncthreads(); SWAIT(); SWRITE(0, SE);
    __syncthreads();
    SBAR(); qkt(pA0, pA1, K_lds, qr, r32, hi);
    finishSM(pB0, pB1, l_reg, pa0, pa1, pa2, pa3); SBAR();
    if (j + 3 < NT) SLOAD(SE, j + 3); SBAR();
    pv_d0(o, vb0 + (int)SHM_V, pa0, pa1, pa2, pa3); partialSM(pA0, pA1);
    __syncthreads(); SWAIT(); SWRITE(1, SO);
    __syncthreads();
  }
  SBAR(); qkt(pB0, pB1, (const unsigned short*)((char*)K_lds + SHM_K), qr, r32, hi);
  finishSM(pA0, pA1, l_reg, pa0, pa1, pa2, pa3); SBAR();
  pv_d0(o, vb0, pa0, pa1, pa2, pa3); partialSM(pB0, pB1);
  __syncthreads();
  finishSM(pB0, pB1, l_reg, pa0, pa1, pa2, pa3); SBAR();
  pv_d0(o, vb0 + (int)SHM_V, pa0, pa1, pa2, pa3);
  if (hi == 0) li_l[r32] = l_reg; asm volatile("s_waitcnt lgkmcnt(0)" ::: "memory");
  float rli[16];
#pragma unroll
  for (int r = 0; r < 16; ++r) rli[r] = __builtin_amdgcn_rcpf(li_l[crow(r, hi)]);
  unsigned short* Ow = Ob + (long)(wid * QBLK) * LDO;
#pragma unroll
  for (int r = 0; r < 16; ++r) { int orow = crow(r, hi);
#pragma unroll
    for (int d0 = 0; d0 < 4; ++d0) Ow[(long)orow * LDO + d0 * 32 + r32] = (unsigned short)(cvtpk(o[d0][r] * rli[r], 0.f) & 0xffffu); }
  __syncthreads();
#undef KROW
#undef SLOAD
#undef SWRITE
#undef SWAIT
}
#undef KSWZ
#undef SBAR
}

__device__ __forceinline__ void ph_attn_one(const Args& a, int u, char* lds) {
    const unsigned short* QK = (const unsigned short*)(a.ws + WS_QK); const unsigned short* P = (const unsigned short*)(a.ws + WS_P); unsigned short* OJ = (unsigned short*)(a.ws + WS_OJ);
    int b, hj, qrow0, NT, ntl;
    if (u < 512) { b = u >> 8; hj = (u >> 4) & 15; qrow0 = b * TSEQ + (u & 15) * 256; NT = 68; ntl = 64; }
    else { const int uu = u - 512; b = uu >> 4; hj = uu & 15; qrow0 = NLAT + b * TCTX; NT = 4; ntl = 0; }
    att::attn_unit(QK + (size_t)qrow0 * DM + hj * 64, QK + 1024 + hj * 64, P + P_V2 + (hj >> 1) * 128,
                   OJ + ((size_t)(hj & 1) * MT + qrow0) * 1024 + (hj >> 1) * 128, NT, ntl, b * TSEQ, NLAT + b * TCTX, lds);
}
__device__ __forceinline__ void ph_attn(const Args& a, char* lds, int u0, int ustep, int uend, int cu) {
    bool done = false;
    for (int u = u0; !done; u += ustep) { int uu = u; if (u >= uend) { if (cu < 0) break; uu = 512 + cu; done = true; } ph_attn_one(a, uu, lds); }
}

__device__ __forceinline__ int scan_row(int i, int b, int d) { return i < TCTX ? NLAT + b * TCTX + (d ? TCTX - 1 - i : i) : b * TSEQ + (d ? TSEQ - 1 - (i - TCTX) : (i - TCTX)); }
typedef __amdgpu_buffer_rsrc_t rsrc_t;
typedef short s16x4 __attribute__((ext_vector_type(4)));
typedef __bf16 bf16x2_t __attribute__((ext_vector_type(2)));
typedef float f32x2_t __attribute__((ext_vector_type(2)));
__device__ __forceinline__ unsigned cvtpk_c(float lo, float hi) { f32x2_t v = {lo, hi}; bf16x2_t b = __builtin_convertvector(v, bf16x2_t); return __builtin_bit_cast(unsigned, b); }
constexpr int CS_SLOT = 12288, CS_NSLOT = 8, CS_OFF_A1 = 0, CS_OFF_RH = 2048, CS_OFF_MT = 4352, CS_OFF_Q = 4864, CS_OFF_P = 5376, CS_OFF_KB = 5888, CS_OFF_V = 9984, CS_OFF_G = 12032;
constexpr int CS_PITCH = 144, CS_SCR0 = CS_NSLOT * CS_SLOT, CS_SCR = 8192, CS_S_KK = 0, CS_S_KD = 2304, CS_S_NB = 4608, CS_S_U = 6912;
static_assert(CS_SCR0 + 4 * CS_SCR <= RING_BYTES, "scan LDS");
__device__ __forceinline__ pg8::f32x4 mfma32(bf16x8 a_, bf16x8 b_, pg8::f32x4 c_) { return __builtin_amdgcn_mfma_f32_16x16x32_bf16(a_, b_, c_, 0, 0, 0); }
__device__ __forceinline__ pg8::f32x4 mfma16(v2u a_, v2u b_, pg8::f32x4 c_) { return __builtin_amdgcn_mfma_f32_16x16x16bf16_1k(__builtin_bit_cast(s16x4, a_), __builtin_bit_cast(s16x4, b_), c_, 0, 0, 0); }
__device__ __forceinline__ v2u pack4(const pg8::f32x4 x) { return (v2u){cvtpk_c(x[0], x[1]), cvtpk_c(x[2], x[3])}; }
__device__ __forceinline__ void scan_unit(const Args& a, int l, int u, LAS unsigned char* lds, int tid) {
    const int lane = tid & 63, w = __builtin_amdgcn_readfirstlane(tid >> 6), fr = lane & 15, fq = lane >> 4;
    const int b = u >> 5, h = (u >> 1) & 15, d = u & 1;
    constexpr int NBLK = (TCTX + TSEQ) / 16, NR = NBLK / 4;
    const bf16* LO = (const bf16*)(a.ws + WS_R1); const bf16* RK = (const bf16*)(a.ws + WS_RKVK); bf16* YS = (bf16*)(a.ws + WS_YS);
    const pg8::f32x4 zero4 = (pg8::f32x4){0.f, 0.f, 0.f, 0.f};
    v2u E4[4], A4[4]; v4u R0[4], R1[4];
    float kav[4];
    const int pw = w - 4;
    LAS unsigned char* scr = lds + CS_SCR0 + (pw & 3) * CS_SCR;
    const int dirs = d ? -1 : 1;
    int eoff[4], roff[4], yoff[4];
#pragma unroll
    for (int i = 0; i < 4; ++i) { const int s_ = dirs * (4 * fq + i); eoff[i] = s_ * LOW + 4 * fr; roff[i] = s_ * 4096 + 16 * fr; yoff[i] = s_ * 1024 + fr; }
#define CS_LOAD(blk_) do { const int m0_ = scan_row((blk_) * 16, b, d); const bf16* lob_ = LO + (size_t)m0_ * LOW + 1024 + d * 1024 + h * 64; const bf16* rkb_ = RK + ((size_t)m0_ * 16 + h) * 256; \
        _Pragma("unroll") for (int i = 0; i < 4; ++i) { E4[i] = *(const GAS v2u*)(lob_ + eoff[i]); A4[i] = *(const GAS v2u*)(lob_ + 2048 + eoff[i]); \
        const GAS v4u* rk_ = (const GAS v4u*)(rkb_ + roff[i]); R0[i] = rk_[0]; R1[i] = rk_[1]; } } while (0)
    if (w >= 4) {
#pragma unroll
        for (int c = 0; c < 4; ++c) kav[c] = a.in[I_KA][l * 1024 + h * 64 + 4 * fr + c];
        CS_LOAD(pw);
    }
    pg8::f32x4 S0 = zero4, S1 = zero4, S2 = zero4, S3 = zero4;
    for (int rr = 0; rr <= NR; ++rr) {
        if (w >= 4) {
            if (rr < NR) {
                const int blk = 4 * rr + pw;
                LAS unsigned char* slot = lds + (blk % CS_NSLOT) * CS_SLOT;
                float Ef[4][4], af[4][4], Lin[4][4];
#pragma unroll
                for (int i = 0; i < 4; ++i) { Ef[i][0] = bflo(E4[i].x); Ef[i][1] = bfhi(E4[i].x); Ef[i][2] = bflo(E4[i].y); Ef[i][3] = bfhi(E4[i].y);
                    af[i][0] = bflo(A4[i].x); af[i][1] = bfhi(A4[i].x); af[i][2] = bflo(A4[i].y); af[i][3] = bfhi(A4[i].y); }
                float pre[4], L15[4], G15[4];
#pragma unroll
                for (int c = 0; c < 4; ++c) { float acc = 0.f;
#pragma unroll
                    for (int i = 0; i < 4; ++i) { acc += Ef[i][c]; Lin[i][c] = acc; }
                    const float t1 = __shfl_up(acc, 16); float cum = acc + (fq >= 1 ? t1 : 0.f);
                    const float t2 = __shfl_up(cum, 32); cum += (fq >= 2 ? t2 : 0.f);
                    pre[c] = cum - acc; L15[c] = __shfl(cum, fr + 48); G15[c] = __builtin_amdgcn_exp2f(-L15[c]); }
                float kkh[4][4], kdg[4][4], nbg[4][4]; unsigned vraw[4][4];
                const int posb = ((fr >> 2) * 8 + (fr & 3) * 2) * 2;
#pragma unroll
                for (int i = 0; i < 4; ++i) {
                    float kdh_[4], nbh_[4], rh_[4];
#pragma unroll
                    for (int c = 0; c < 4; ++c) {
                        const unsigned rk_ = c == 0 ? R0[i].x : c == 1 ? R0[i].z : c == 2 ? R1[i].x : R1[i].z, vk_ = c == 0 ? R0[i].y : c == 1 ? R0[i].w : c == 2 ? R1[i].y : R1[i].w;
                        const float r_ = bflo(rk_), k_ = bfhi(rk_), kk_ = bfhi(vk_), a_ = af[i][c];
                        vraw[i][c] = vk_ & 0xffffu;
                        const float Lf = pre[c] + Lin[i][c];
                        const float eL = __builtin_amdgcn_exp2f(Lf), eN = __builtin_amdgcn_rcpf(eL), ekk = __builtin_amdgcn_exp2f(Ef[i][c] - Lf);
                        const float kd = k_ * (1.f + (a_ - 1.f) * kav[c]);
                        kdh_[c] = kd * eL; nbh_[c] = -(kk_ * a_ * eL); kkh[i][c] = kk_ * ekk; rh_[c] = r_ * eN;
                        kdg[i][c] = kdh_[c] * G15[c]; nbg[i][c] = nbh_[c] * G15[c];
                    }
                    const int rb = (4 * fq + i) * CS_PITCH + posb;
                    *(LAS unsigned*)(scr + CS_S_KK + rb) = cvtpk_c(kkh[i][0], kkh[i][1]); *(LAS unsigned*)(scr + CS_S_KK + rb + 64) = cvtpk_c(kkh[i][2], kkh[i][3]);
                    *(LAS unsigned*)(scr + CS_S_KD + rb) = cvtpk_c(kdh_[0], kdh_[1]); *(LAS unsigned*)(scr + CS_S_KD + rb + 64) = cvtpk_c(kdh_[2], kdh_[3]);
                    *(LAS unsigned*)(scr + CS_S_NB + rb) = cvtpk_c(nbh_[0], nbh_[1]); *(LAS unsigned*)(scr + CS_S_NB + rb + 64) = cvtpk_c(nbh_[2], nbh_[3]);
                    *(LAS unsigned*)(slot + CS_OFF_RH + rb) = cvtpk_c(rh_[0], rh_[1]); *(LAS unsigned*)(slot + CS_OFF_RH + rb + 64) = cvtpk_c(rh_[2], rh_[3]);
                }
                if (rr + 1 < NR) CS_LOAD(blk + 4);
#pragma unroll
                for (int c = 0; c < 4; ++c) {
                    *(LAS v4u*)(slot + CS_OFF_KB + c * 1024 + lane * 16) = (v4u){cvtpk_c(kdg[0][c], kdg[1][c]), cvtpk_c(kdg[2][c], kdg[3][c]), cvtpk_c(nbg[0][c], nbg[1][c]), cvtpk_c(nbg[2][c], nbg[3][c])};
                    const int j = 4 * fr + c;
                    *(LAS v2u*)(slot + CS_OFF_V + (((j >> 4) * 4 + fq) * 16 + (j & 15)) * 8) = (v2u){vraw[0][c] | (vraw[1][c] << 16), vraw[2][c] | (vraw[3][c] << 16)};
                }
                if (fq == 0) *(LAS pg8::f32x4*)(slot + CS_OFF_G + fr * 16) = (pg8::f32x4){G15[0], G15[1], G15[2], G15[3]};
                asm volatile("s_waitcnt lgkmcnt(0)" ::: "memory");
                const LAS unsigned char* fa = scr + fr * CS_PITCH + fq * 16; const LAS unsigned char* fh = slot + CS_OFF_RH + fr * CS_PITCH + fq * 16;
                const bf16x8 KK0 = *(const LAS bf16x8*)(fa + CS_S_KK), KK1 = *(const LAS bf16x8*)(fa + CS_S_KK + 64), KD0 = *(const LAS bf16x8*)(fa + CS_S_KD), KD1 = *(const LAS bf16x8*)(fa + CS_S_KD + 64);
                const bf16x8 NB0 = *(const LAS bf16x8*)(fa + CS_S_NB), NB1 = *(const LAS bf16x8*)(fa + CS_S_NB + 64), RH0 = *(const LAS bf16x8*)(fh), RH1 = *(const LAS bf16x8*)(fh + 64);
                pg8::f32x4 dn1 = mfma32(NB1, KK1, mfma32(NB0, KK0, zero4));
                pg8::f32x4 dn1t = mfma32(KK1, NB1, mfma32(KK0, NB0, zero4));
                pg8::f32x4 dmt = mfma32(KK1, KD1, mfma32(KK0, KD0, zero4));
                pg8::f32x4 dq = mfma32(KD1, RH1, mfma32(KD0, RH0, zero4));
                pg8::f32x4 dp = mfma32(NB1, RH1, mfma32(NB0, RH0, zero4));
                pg8::f32x4 idm;
#pragma unroll
                for (int i = 0; i < 4; ++i) { const int row = 4 * fq + i;
                    dn1[i] = row < fr ? dn1[i] : 0.f; dn1t[i] = fr < row ? dn1t[i] : 0.f; dmt[i] = fr < row ? dmt[i] : 0.f; dq[i] = row <= fr ? dq[i] : 0.f; dp[i] = row <= fr ? dp[i] : 0.f;
                    idm[i] = row == fr ? 1.f : 0.f; }
                const v2u pX = pack4(dn1), pXT = pack4(dn1t);
                const pg8::f32x4 x2 = mfma16(pXT, pX, zero4), x2t = mfma16(pX, pXT, zero4);
                const v2u pX2 = pack4(x2), pX2T = pack4(x2t);
                const pg8::f32x4 x4 = mfma16(pX2T, pX2, zero4), x4t = mfma16(pX2, pX2T, zero4);
                const v2u pX4 = pack4(x4), pX4T = pack4(x4t);
                const pg8::f32x4 x8 = mfma16(pX4T, pX4, zero4);
                const pg8::f32x4 t1 = idm + dn1, t1t = idm + dn1t;
                const v2u pT1T = pack4(t1t);
                const pg8::f32x4 t2 = mfma16(pT1T, pX2, t1), t2t = mfma16(pX2, pT1T, t1t);
                const v2u pT2T = pack4(t2t);
                const pg8::f32x4 t3 = mfma16(pT2T, pX4, t2), t3t = mfma16(pX4, pT2T, t2t);
                const pg8::f32x4 dt = mfma16(pack4(t3t), pack4(x8), t3);
                const v2u DTb = pack4(dt);
                pg8::f32x4 da1[4];
#pragma unroll
                for (int c = 0; c < 4; ++c) da1[c] = mfma16((v2u){cvtpk_c(kkh[0][c], kkh[1][c]), cvtpk_c(kkh[2][c], kkh[3][c])}, DTb, zero4);
                const pg8::f32x4 dmt2 = mfma16(pack4(dmt), DTb, zero4);
#pragma unroll
                for (int hh = 0; hh < 2; ++hh)
                    *(LAS v4u*)(slot + CS_OFF_A1 + hh * 1024 + lane * 16) = (v4u){cvtpk_c(da1[2 * hh][0], da1[2 * hh + 1][0]), cvtpk_c(da1[2 * hh][1], da1[2 * hh + 1][1]), cvtpk_c(da1[2 * hh][2], da1[2 * hh + 1][2]), cvtpk_c(da1[2 * hh][3], da1[2 * hh + 1][3])};
                *(LAS v2u*)(slot + CS_OFF_MT + lane * 8) = pack4(dmt2); *(LAS v2u*)(slot + CS_OFF_Q + lane * 8) = pack4(dq); *(LAS v2u*)(slot + CS_OFF_P + lane * 8) = pack4(dp);
            }
        } else if (rr >= 1) {
#pragma nounroll
            for (int q = 0; q < 4; ++q) {
                const int blk = 4 * (rr - 1) + q;
                const LAS unsigned char* slot = lds + (blk % CS_NSLOT) * CS_SLOT;
                const bf16x8 A10 = *(const LAS bf16x8*)(slot + CS_OFF_A1 + lane * 16), A11 = *(const LAS bf16x8*)(slot + CS_OFF_A1 + 1024 + lane * 16);
                const bf16x8 RH0 = *(const LAS bf16x8*)(slot + CS_OFF_RH + fr * CS_PITCH + fq * 16), RH1 = *(const LAS bf16x8*)(slot + CS_OFF_RH + fr * CS_PITCH + fq * 16 + 64);
                const v2u MTo = *(const LAS v2u*)(slot + CS_OFF_MT + lane * 8), Qo = *(const LAS v2u*)(slot + CS_OFF_Q + lane * 8), Po = *(const LAS v2u*)(slot + CS_OFF_P + lane * 8);
                const v2u Vo = *(const LAS v2u*)(slot + CS_OFF_V + (w * 64 + lane) * 8);
                const bf16x8 KB0 = *(const LAS bf16x8*)(slot + CS_OFF_KB + lane * 16), KB1 = *(const LAS bf16x8*)(slot + CS_OFF_KB + 1024 + lane * 16), KB2 = *(const LAS bf16x8*)(slot + CS_OFF_KB + 2048 + lane * 16), KB3 = *(const LAS bf16x8*)(slot + CS_OFF_KB + 3072 + lane * 16);
                pg8::f32x4 Gi[4];
#pragma unroll
                for (int i = 0; i < 4; ++i) Gi[i] = *(const LAS pg8::f32x4*)(slot + CS_OFF_G + (16 * fq + 4 * i) * 4);
                const v4u bs0 = (v4u){cvtpk_c(S0[0], S1[0]), cvtpk_c(S0[1], S1[1]), cvtpk_c(S0[2], S1[2]), cvtpk_c(S0[3], S1[3])};
                const v4u bs1 = (v4u){cvtpk_c(S2[0], S3[0]), cvtpk_c(S2[1], S3[1]), cvtpk_c(S2[2], S3[2]), cvtpk_c(S2[3], S3[3])};
                const bf16x8 BS0 = __builtin_bit_cast(bf16x8, bs0), BS1 = __builtin_bit_cast(bf16x8, bs1);
                const pg8::f32x4 c1 = mfma16(MTo, Vo, zero4);
                const pg8::f32x4 sa = mfma32(A11, BS1, mfma32(A10, BS0, c1));
                const v2u SAo = pack4(sa);
                pg8::f32x4 y = mfma32(RH1, BS1, mfma32(RH0, BS0, zero4));
                y = mfma16(Qo, Vo, y); y = mfma16(Po, SAo, y);
                const bf16x8 BV = __builtin_bit_cast(bf16x8, (v4u){Vo.x, Vo.y, SAo.x, SAo.y});
                pg8::f32x4 g0, g1, g2, g3;
#pragma unroll
                for (int i = 0; i < 4; ++i) { g0[i] = S0[i] * Gi[i][0]; g1[i] = S1[i] * Gi[i][1]; g2[i] = S2[i] * Gi[i][2]; g3[i] = S3[i] * Gi[i][3]; }
                S0 = mfma32(KB0, BV, g0); S1 = mfma32(KB1, BV, g1); S2 = mfma32(KB2, BV, g2); S3 = mfma32(KB3, BV, g3);
                { bf16* ysb = YS + ((size_t)d * MT + scan_row(blk * 16, b, d)) * 1024 + h * 64 + 16 * w;
#pragma unroll
                  for (int i = 0; i < 4; ++i) ysb[yoff[i]] = (bf16)(cvtpk_c(y[i], 0.f) & 0xffffu); }
            }
        }
        asm volatile("s_waitcnt lgkmcnt(0)" ::: "memory"); __builtin_amdgcn_s_barrier(); asm volatile("" ::: "memory");
    }
#undef CS_LOAD
    asm volatile("s_waitcnt vmcnt(0) lgkmcnt(0)" ::: "memory"); __syncthreads();
}

__device__ __forceinline__ void ph_rwkv_out(const Args& a, int l, int nrows, int gt, int NGT) {
    const bf16* OJ = (const bf16*)(a.ws + WS_OJ); bf16* YC = (bf16*)(a.ws + WS_Y3) + (size_t)2 * MT * 1024;
    const float* subln = a.in[I_SUBLN] + l * 128;
    float lam, lam_init;
    { const int lane = threadIdx.x & 63; const float* lv = a.in[I_LAM] + l * 256;
      float l1 = lv[lane] * lv[64 + lane], l2 = lv[128 + lane] * lv[192 + lane]; l1 = wave_sum(l1); l2 = wave_sum(l2);
      lam_init = 0.8f - 0.6f * __expf(-0.3f * (float)l); lam = __expf(l1) - __expf(l2) + lam_init;
      float gb = fabsf(a.in[I_QN][l * 64 + lane] * a.in[I_KN][l * 64 + lane]);
#pragma unroll
      for (int o_ = 1; o_ < 64; o_ <<= 1) gb = fmaxf(gb, __shfl_xor(gb, o_));
      if (gb > 8.f) lam = __builtin_nanf(""); }
    const bf16* LO = (const bf16*)(a.ws + WS_R1); const bf16* RK = (const bf16*)(a.ws + WS_RKVK); const bf16* YS = (const bf16*)(a.ws + WS_YS);
    bf16* YB = (bf16*)(a.ws + WS_Y3) + (size_t)MT * 1024;
    const float* ka = a.in[I_KA] + l * 1024; const float* rkw = a.in[I_RK] + l * 1024; const float* lng = a.in[I_LNG] + l * 1024; const float* lnb = a.in[I_LNB] + l * 1024;
    for (int i = gt; i < nrows * 128; i += 2 * NGT) {
        v4u L[2][11]; const bool two = i + NGT < nrows * 128;
#pragma unroll
        for (int s = 0; s < 2; ++s) if (s == 0 || two) { const int ii = i + s * NGT, m = ii >> 7, c0 = (ii & 127) * 8;
            L[s][0] = *(const GAS v4u*)(YS + (size_t)m * 1024 + c0); L[s][1] = *(const GAS v4u*)(YS + ((size_t)MT + m) * 1024 + c0);
            const GAS v4u* rp = (const GAS v4u*)(RK + (size_t)m * 4096 + c0 * 4);
            L[s][2] = rp[0]; L[s][3] = rp[1]; L[s][4] = rp[2]; L[s][5] = rp[3];
            const bf16* lo = LO + (size_t)m * LOW + c0;
            L[s][6] = *(const GAS v4u*)lo; L[s][7] = *(const GAS v4u*)(lo + 3072); L[s][8] = *(const GAS v4u*)(lo + 4096);
            L[s][9] = *(const GAS v4u*)(OJ + (size_t)m * 1024 + c0); L[s][10] = *(const GAS v4u*)(OJ + ((size_t)MT + m) * 1024 + c0); }
#pragma unroll
        for (int s = 0; s < 2; ++s) if (s == 0 || two) {
        const int ii = i + s * NGT, m = ii >> 7, c0 = (ii & 127) * 8;
        const v4u ya = L[s][0], yb = L[s][1], q0 = L[s][2], q1 = L[s][3], q2 = L[s][4], q3 = L[s][5], gw_ = L[s][6], aw0 = L[s][7], aw1 = L[s][8], pw = L[s][9], ow = L[s][10];
        float yA[8], yB[8], gv[8], a0v[8], a1v[8], pv[8], ov[8];
        unpack8(ya, yA); unpack8(yb, yB); unpack8(gw_, gv); unpack8(aw0, a0v); unpack8(aw1, a1v); unpack8(pw, pv); unpack8(ow, ov);
        float y[8]; float s1 = 0.f;
#pragma unroll
        for (int e = 0; e < 8; ++e) y[e] = yA[e] + yB[e];
#pragma unroll
        for (int e = 0; e < 8; ++e) s1 += y[e];
        s1 += __shfl_xor(s1, 1); s1 += __shfl_xor(s1, 2); s1 += __shfl_xor(s1, 4);
        const float mu = s1 * (1.f / 64.f); float s2 = 0.f;
#pragma unroll
        for (int e = 0; e < 8; ++e) { y[e] -= mu; s2 += y[e] * y[e]; }
        s2 += __shfl_xor(s2, 1); s2 += __shfl_xor(s2, 2); s2 += __shfl_xor(s2, 4);
        const float rstd = 1.f / sqrtf(s2 * (1.f / 64.f) + 64e-5f);
        float r[8], k[8], v[8];
        r[0] = bflo(q0.x); k[0] = bfhi(q0.x); v[0] = bflo(q0.y); r[1] = bflo(q0.z); k[1] = bfhi(q0.z); v[1] = bflo(q0.w);
        r[2] = bflo(q1.x); k[2] = bfhi(q1.x); v[2] = bflo(q1.y); r[3] = bflo(q1.z); k[3] = bfhi(q1.z); v[3] = bflo(q1.w);
        r[4] = bflo(q2.x); k[4] = bfhi(q2.x); v[4] = bflo(q2.y); r[5] = bflo(q2.z); k[5] = bfhi(q2.z); v[5] = bflo(q2.w);
        r[6] = bflo(q3.x); k[6] = bfhi(q3.x); v[6] = bflo(q3.y); r[7] = bflo(q3.z); k[7] = bfhi(q3.z); v[7] = bflo(q3.w);
        float am[8];
#pragma unroll
        for (int e = 0; e < 8; ++e) am[e] = 0.5f * (a0v[e] + a1v[e]);
        float rk = 0.f;
#pragma unroll
        for (int e = 0; e < 8; ++e) { const int c = c0 + e; rk += r[e] * (k[e] * (1.f + (am[e] - 1.f) * ka[c])) * rkw[c]; }
        rk += __shfl_xor(rk, 1); rk += __shfl_xor(rk, 2); rk += __shfl_xor(rk, 4);
        float o[8];
#pragma unroll
        for (int e = 0; e < 8; ++e) { const int c = c0 + e; o[e] = (y[e] * rstd * lng[c] + lnb[c] + rk * v[e]) * gv[e]; }
        *(GAS v4u*)(YB + (size_t)m * 1024 + c0) = pack8(o);
        { float d[8];
#pragma unroll
          for (int e = 0; e < 8; ++e) d[e] = pv[e] - lam * ov[e];
          float ss = 0.f;
#pragma unroll
          for (int e = 0; e < 8; ++e) ss += d[e] * d[e];
          ss += __shfl_xor(ss, 1); ss += __shfl_xor(ss, 2); ss += __shfl_xor(ss, 4); ss += __shfl_xor(ss, 8);
          const float rinv = (1.f - lam_init) / sqrtf(ss * (1.f / 128.f) + 1e-6f);
#pragma unroll
          for (int e = 0; e < 8; ++e) d[e] = d[e] * rinv * subln[(c0 & 127) + e];
          *(GAS v4u*)(YC + (size_t)m * 1024 + c0) = pack8(d); }
        }
    }
}

constexpr int PH_PER_LAYER = 14, NPH = 1 + NLAYER * PH_PER_LAYER;
#define IN(k) (lo <= (k) && (k) < hi)
#define SEAM(k) do { if (IN(k) && IN((k) + 1)) xcd_barrier(bar); } while (0)
#ifndef ONLY_PH
#define ONLY_PH -1
#endif
#define INL(k) ((ONLY_PH < 0 || ONLY_PH == (k)) && IN(pb + (k)))
#define SEAML(k) SEAM(pb + (k))
#ifndef PROBE_REP
#define PROBE_REP 0
#endif
#define REPL(k) for (int rep_ = 0; rep_ < (((PROBE_REP) >> (k)) & 1) + 1; ++rep_)
template <int l> __device__ __forceinline__ void layer_body(const Args& args, LAS unsigned char* lds, unsigned char* lds_raw, unsigned char* ws, const XcdBarrier& bar, int lo, int hi, int tid, int lane, int G, int bx, int vcu, int gw, int NGW, int gt, int NGT) {
        const int pb = 1 + l * PH_PER_LAYER;
        const bool last = (l == NLAYER - 1);
        float* XS = (float*)(ws + WS_XS); pg8::bf16_t* PART = (pg8::bf16_t*)(ws + WS_PART);
        const float* mods = (const float*)(ws + WS_MODS) + (size_t)l * 3 * NMOD * DM;
        const float* normg = args.in[I_NORMG] + (size_t)l * 3 * DM;
        pg8::bf16_t* XN = (pg8::bf16_t*)(ws + WS_XN);
        pg8::bf16_t* Hb = (pg8::bf16_t*)(ws + WS_R1);
        const float* xl0 = (l == 0) ? args.in[I_X] : XS; const float* xc0 = (l == 0) ? args.in[I_CTX] : XS + (size_t)NLAT * DM;

        if (INL(0)) REPL(0) ph_norm(xl0, xc0, normg, mods, 0, (bf16*)XN, XS, l == 0 ? nullptr : PART, 16, MT, gw, NGW, lane, (LAS float*)lds);
        SEAML(0);
        if (INL(1)) REPL(1) { pg8::Gemm g{XN, (const pg8::bf16_t*)(ws + WS_WF1 + (size_t)(l * 2 + 0) * SZ_WF1), MT, FF2, DM}; pg8::StaticOrder S; S.init(MT, FF2, G, bx);
            pg8::EpiSwiglu E{Hb, FF}; pg8::gemm_phase<pg8::EpiSwiglu, pg8::StaticOrder, true, true>(lds, g, S, E); }
        SEAML(1);
        if (INL(2)) REPL(2) { pg8::Gemm g{Hb, (const pg8::bf16_t*)(ws + WS_WF2 + (size_t)(l * 2 + 0) * SZ_WF2), MT, DM, FF}; pg8::SplitCtxOrder S{G, vcu, NLAT / 256, NCTX / 256, 16, FF / 64};
            pg8::EpiResid E{xl0, (long)((xc0 - (size_t)NLAT * DM) - xl0), XS, 0L, mods + 2 * DM, NMOD * DM, 0.5f, NLAT / 256, TSEQ / 256, PART, NCTX};
            pg8::gemm_phase<pg8::EpiResid, pg8::SplitCtxOrder, true, true>(lds, g, S, E); }
        SEAML(2);
        if (INL(3)) REPL(3) ph_norm(XS, XS + (size_t)NLAT * DM, normg + DM, mods, 3, (bf16*)XN, XS, PART, 16, MT, gw, NGW, lane, (LAS float*)lds);
        SEAML(3);
        if (INL(4)) REPL(4) { pg8::Gemm g{XN, (const pg8::bf16_t*)(ws + WS_WIN + (size_t)l * SZ_WIN), MT, PROJP, DM}; pg8::ProjOrder S; S.init(last ? NLAT : MT, PROJP, G, bx); S.skip_ctx = last ? 1 : 0;
            pg8::EpiProj E{(pg8::bf16_t*)(ws + WS_P), PROJP, (pg8::bf16_t*)(ws + WS_ACT), (pg8::bf16_t*)(ws + WS_QK), args.in[I_QN] + l * 64, args.in[I_KN] + l * 64, (const float*)(ws + WS_ROPE), NLAT, TSEQ};
            pg8::gemm_phase<pg8::EpiProj, pg8::ProjOrder, true, true>(lds, g, S, E); }
        SEAML(4);
        if (INL(5)) REPL(5) { pg8::Gemm g{(const pg8::bf16_t*)(ws + WS_ACT), (const pg8::bf16_t*)(ws + WS_WLO + (size_t)l * SZ_WLO), MT, LOW, ACTW}; pg8::LoraOrder S; S.init(MT, LOW, G, bx);
            pg8::EpiLora E{(pg8::bf16_t*)(ws + WS_R1), args.in[I_W0] + l * 2048, args.in[I_A0] + l * 2048}; pg8::gemm_phase<pg8::EpiLora, pg8::LoraOrder, true, true>(lds, g, S, E);
            ph_e1(args, l, gt, NGT); }
        SEAML(5);
        if (INL(7)) REPL(7) {
            if (bx < 64) scan_unit(args, l, bx, lds, tid);
            else { int u0, ustep, uend, cu, gv, gn;
                if (G == 256) { const int ax = bx & 7, ar = (bx - 64) >> 3, li = (ar - 16) * 8 + ax;
                    u0 = 64 * ax + ar; ustep = 24; uend = 64 * ax + 64; cu = (!last && ar >= 16 && li < 32) ? li : -1;
                    gv = li; gn = ar >= 16 ? 64 : 0; }
                else { const int aw = G - 64, wi = bx - 64, light0 = 512 % aw, nl = aw - light0;
                    u0 = wi; ustep = aw; uend = 512; cu = (!last && wi >= light0 && wi - light0 < 32) ? wi - light0 : -1;
                    if (light0 == 0 || nl <= 0) { gv = wi; gn = aw; } else { gv = wi - light0; gn = wi >= light0 ? nl : 0; } }
                ph_attn(args, (char*)lds_raw, u0, ustep, uend, cu); __syncthreads();
                if (gn > 0) ph_gmlp(args, l, lds, tid, gv, gn); }
        }
        SEAML(7);
        if (INL(8)) REPL(8) ph_rwkv_out(args, l, last ? NLAT : MT, gt, NGT);
        SEAML(8);
        if (INL(9)) REPL(9) { pg8::Gemm g{(const pg8::bf16_t*)(ws + WS_Y3), (const pg8::bf16_t*)(ws + WS_WBR + (size_t)l * SZ_WBR), 3 * MT, 3 * DM, 1024}; pg8::MergeOrder S{G, bx, MT / 256, NLAT / 256, last ? 0 : (NCTX / 256) * 8 * 3};
            pg8::EpiMerge E{(const pg8::bf16_t*)(ws + WS_P) + P_GATE2, PROJP, args.in[I_BGATE] + (size_t)l * 3 * DM, (pg8::bf16_t*)(ws + WS_ZF), XN, MT / 256, (pg8::bf16_t*)(ws + WS_IMG), -(long)NLAT};
            pg8::gemm_phase<pg8::EpiMerge, pg8::MergeOrder, true, true>(lds, g, S, E); }
        SEAML(9);
        if (INL(10)) REPL(10) { pg8::Gemm g{XN, (const pg8::bf16_t*)(ws + WS_WOUT + (size_t)l * SZ_WOUT), MT, DM, DM}; pg8::SplitCtxOrder S{G, vcu, NLAT / 256, last ? 0 : NCTX / 256, 8, DM / 64};
            if (!last) { pg8::Unit uu;
                for (int i = 0; S.next(i, uu); ++i) if (uu.kn != 0) {
                    const int r0 = (uu.pm - NLAT / 256) * 256, k0 = uu.ks * 64, kw8 = uu.kn * 8;
                    const bf16* ZP = (const bf16*)(ws + WS_IMG); bf16* Zc = (bf16*)XN + (size_t)NLAT * DM;
                    for (int idx = tid; idx < 256 * kw8; idx += NTHR) { const int r = r0 + idx / kw8, k = k0 + (idx % kw8) * 8;
                        const v4u q0 = *(const GAS v4u*)(ZP + (size_t)r * DM + k), q1 = *(const GAS v4u*)(ZP + ((size_t)NCTX + r) * DM + k), q2 = *(const GAS v4u*)(ZP + ((size_t)2 * NCTX + r) * DM + k);
                        float f0[8], f1[8], f2[8]; unpack8(q0, f0); unpack8(q1, f1); unpack8(q2, f2);
#pragma unroll
                        for (int e = 0; e < 8; ++e) f0[e] = (f0[e] + f1[e]) + f2[e];
                        *(GAS v4u*)(Zc + (size_t)r * DM + k) = pack8(f0); } }
                asm volatile("s_waitcnt vmcnt(0)" ::: "memory"); __syncthreads(); }
            pg8::EpiResid E{XS, 0L, XS, 0L, mods + 5 * DM, NMOD * DM, 1.0f, NLAT / 256, TSEQ / 256, PART, NCTX};
            pg8::gemm_phase<pg8::EpiResid, pg8::SplitCtxOrder, true, true>(lds, g, S, E); }
        SEAML(10);
        if (INL(11)) REPL(11) ph_norm(XS, XS + (size_t)NLAT * DM, normg + 2 * DM, mods, 6, (bf16*)XN, XS, PART, 8, last ? NLAT : MT, gw, NGW, lane, (LAS float*)lds);
        SEAML(11);
        if (INL(12)) REPL(12) { pg8::Gemm g{XN, (const pg8::bf16_t*)(ws + WS_WF1 + (size_t)(l * 2 + 1) * SZ_WF1), MT, FF2, DM}; pg8::StaticOrder S; S.init(last ? NLAT : MT, FF2, G, bx);
            pg8::EpiSwiglu E{Hb, FF}; pg8::gemm_phase<pg8::EpiSwiglu, pg8::StaticOrder, true, true>(lds, g, S, E); }
        SEAML(12);
        if (INL(13)) REPL(13) { pg8::Gemm g{Hb, (const pg8::bf16_t*)(ws + WS_WF2 + (size_t)(l * 2 + 1) * SZ_WF2), MT, DM, FF}; pg8::SplitCtxOrder S{G, vcu, NLAT / 256, last ? 0 : NCTX / 256, 16, FF / 64};
            pg8::EpiResid E{XS, 0L, last ? args.out : XS, 0L, mods + 8 * DM, NMOD * DM, 0.5f, NLAT / 256, TSEQ / 256, PART, NCTX};
            pg8::gemm_phase<pg8::EpiResid, pg8::SplitCtxOrder, true, true>(lds, g, S, E); }
        SEAML(13);
    }
__global__ void __launch_bounds__(NTHR, 2) fwd(Args args) {
    extern __shared__ __attribute__((aligned(16))) unsigned char lds_raw[];
    LAS unsigned char* lds = (LAS unsigned char*)lds_raw;
    const int tid = threadIdx.x, lane = tid & 63, wave = __builtin_amdgcn_readfirstlane(tid >> 6);
    const int G = gridDim.x; const int bx = blockIdx.x; const int vcu = (G % 8 == 0) ? (bx % 8) * (G / 8) + bx / 8 : bx;
    const int gw = vcu * NWAVES + wave, NGW = G * NWAVES, gt = vcu * NTHR + tid, NGT = G * NTHR;
    unsigned char* ws = args.ws;
    volatile LAS unsigned* MISC = (volatile LAS unsigned*)(lds + MISC_OFF);
    for (int u = tid; u < (LDS_BYTES - LDSCTL_OFF) / 4; u += NTHR) ((LAS unsigned*)(lds + LDSCTL_OFF))[u] = 0u;
    __syncthreads();
    const int lo = args.ph_lo, hi = args.ph_hi;
    const bool multi = (hi - lo) > 1;
    XcdBarrier bar; bar.bar = (unsigned*)(ws + WS_CTL) + CW_BAR; bar.x = 0; bar.st = nullptr;
    if (multi) bar = xcd_barrier_post((unsigned*)(ws + WS_CTL) + CW_BAR, MISC + 8);

    if ((ONLY_PH < 0 || ONLY_PH == 100) && IN(0)) REPL(16) {
        ph_ada(args, lds, tid, vcu, G); __syncthreads(); ph_weights(args, 0, lds, tid, vcu, G); ph_weights(args, 1, lds, tid, vcu, G); ph_small(args, tid, vcu, G); }
    SEAM(0);

    layer_body<0>(args, lds, lds_raw, ws, bar, lo, hi, tid, lane, G, bx, vcu, gw, NGW, gt, NGT);
    layer_body<1>(args, lds, lds_raw, ws, bar, lo, hi, tid, lane, G, bx, vcu, gw, NGW, gt, NGT);
#undef IN
#undef SEAM
}

#ifndef MK_PER_PHASE
#define MK_PER_PHASE 0
#endif
extern "C" void kernel_launch(void* const* d_in, const int* in_sizes, int n_in, void* d_out, int out_size, void* d_ws, size_t ws_size, hipStream_t stream) {
    static int grid = 0;
    if (grid == 0) {
        if (n_in != 31 || in_sizes[0] != NLAT * DM || out_size != NLAT * DM || ws_size < WS_END) {
            fprintf(stderr, "kernel_launch: unexpected shapes: n_in %d in0 %d out %d ws %zu (need %zu); nothing launched\n", n_in, n_in > 0 ? in_sizes[0] : -1, out_size, ws_size, (size_t)WS_END); grid = -1; return; }
        int dev = 0, cus = 0, per_cu = 0;
        if (hipGetDevice(&dev) != hipSuccess || hipDeviceGetAttribute(&cus, hipDeviceAttributeMultiprocessorCount, dev) != hipSuccess) { grid = -1; return; }
        if (hipFuncSetAttribute((const void*)fwd, hipFuncAttributeMaxDynamicSharedMemorySize, LDS_BYTES) != hipSuccess) { fprintf(stderr, "kernel_launch: hipFuncSetAttribute failed\n"); grid = -1; return; }
        if (hipOccupancyMaxActiveBlocksPerMultiprocessor(&per_cu, (const void*)fwd, NTHR, LDS_BYTES) != hipSuccess || per_cu < 1) fprintf(stderr, "kernel_launch: occupancy query says %d\n", per_cu);
        (void)hipGetLastError();
        grid = cus;
    }
    if (grid < 0) return;
    (void)hipMemsetAsync((char*)d_ws + WS_CTL, 0, CTL_ZERO_BYTES, stream);
    Args a{};
    for (int i = 0; i < 31; ++i) a.in[i] = (const float*)d_in[i];
    a.out = (float*)d_out; a.ws = (unsigned char*)d_ws;
#if MK_PER_PHASE
    for (int p = 0; p < NPH; ++p) { a.ph_lo = p; a.ph_hi = p + 1; hipLaunchKernelGGL(fwd, dim3(grid), dim3(NTHR), LDS_BYTES, stream, a); }
#else
    a.ph_lo = 0; a.ph_hi = NPH; hipLaunchKernelGGL(fwd, dim3(grid), dim3(NTHR), LDS_BYTES, stream, a);
#endif
}
```

```cpp
#include <hip/hip_runtime.h>
#include <cstdio>
#include <cstdint>
namespace pg8 {
#define PG8_LAS __attribute__((address_space(3)))
typedef unsigned short bf16_t;
typedef short bf16x8 __attribute__((ext_vector_type(8)));
typedef float f32x4 __attribute__((ext_vector_type(4)));
typedef unsigned u32x4 __attribute__((ext_vector_type(4)));
constexpr int BM = 256, BK = 64, HALF = 128, HTB = HALF * BK * 2  , STAGE_BYTES = 8 * HTB, NXCD = 8, WGM = 8;

__host__ __device__ __forceinline__ int lds_byte(int r, int c) { const int st = (r >> 4) * 2 + (c >> 5), rr = r & 15, cc = c & 31, ob = rr * 64 + cc * 2; return st * 1024 + (ob ^ (((ob >> 9) & 1) << 5)); }
__host__ __device__ __forceinline__ void stage_rc(int b, int& R, int& C) { const int st = b / 1024, sb = b % 1024, swz = sb ^ (((sb >> 9) & 1) << 5); R = (st >> 1) * 16 + swz / 64; C = (st & 1) * 32 + (swz % 64) / 2; }
__host__ __device__ __forceinline__ int perm32(int rho) { const int n = rho >> 4, i = rho & 15; return 8 * (i >> 2) + 4 * n + (i & 3); }

struct Unit { int pm, pn, ks, kn, aux; };
struct Gemm { const bf16_t* A; const bf16_t* Bt; int M, N, K; };

struct StaticOrder {
    int nM, nN, nwg, G, c;
    __host__ __device__ void init(int M, int N, int G_, int c_) { nM = M / BM; nN = N / BM; nwg = nM * nN; G = G_; c = c_; }
    __host__ __device__ bool next(int i, Unit& u) const {
        const long L = (long)i * G + c; if (L >= nwg) return false;
        int wgid = (int)L; { const int q = nwg / NXCD, r = nwg % NXCD, xcd = wgid % NXCD, off = wgid / NXCD; wgid = (xcd < r ? xcd * (q + 1) : r * (q + 1) + (xcd - r) * q) + off; }
        const int nig = WGM * nN, gid = wgid / nig, fm = gid * WGM, gsz = (nM - fm) < WGM ? (nM - fm) : WGM;
        u.pm = fm + ((wgid % nig) % gsz); u.pn = (wgid % nig) / gsz; u.ks = 0; u.kn = 0; u.aux = 0; return true;
    }
    __device__ __forceinline__ void a_ready(const Unit&) const {}
    __device__ __forceinline__ void done(const Unit&) const {}
};

__device__ __forceinline__ unsigned cvt_pk_bf16(float lo, float hi) { unsigned r; asm volatile("v_cvt_pk_bf16_f32 %0, %1, %2" : "=v"(r) : "v"(lo), "v"(hi)); return r; }
typedef float f32x2 __attribute__((ext_vector_type(2)));
typedef unsigned u32x2 __attribute__((ext_vector_type(2)));
__device__ __forceinline__ float fsigmoid(float x) { return __builtin_amdgcn_rcpf(1.f + __expf(-x)); }
__device__ __forceinline__ float bflo(unsigned w) { return __builtin_bit_cast(float, w << 16); }
__device__ __forceinline__ float bfhi(unsigned w) { return __builtin_bit_cast(float, w & 0xffff0000u); }

struct EpiSwiglu {
    static constexpr bool PERM = true, AFTER_DRAIN = false;
    bf16_t* H; int ldh;
    __device__ __forceinline__ void operator()(const f32x4 (&acc)[2][2][4][2], const Unit& u, int wr, int wc, int fr, int fq) const {
        const int col0 = u.pn * HALF + wc * 32 + 8 * fq, row0 = u.pm * BM + wr * 64 + fr;
#pragma unroll
        for (int ai = 0; ai < 2; ++ai)
#pragma unroll
            for (int m = 0; m < 4; ++m) {
                const f32x4 g0 = acc[ai][0][m][0], g1 = acc[ai][0][m][1], u0 = acc[ai][1][m][0], u1 = acc[ai][1][m][1];
                float o[8];
#pragma unroll
                for (int e = 0; e < 4; ++e) { o[e] = g0[e] * fsigmoid(g0[e]) * u0[e]; o[4 + e] = g1[e] * fsigmoid(g1[e]) * u1[e]; }
                u32x4 w; w.x = cvt_pk_bf16(o[0], o[1]); w.y = cvt_pk_bf16(o[2], o[3]); w.z = cvt_pk_bf16(o[4], o[5]); w.w = cvt_pk_bf16(o[6], o[7]);
                *(u32x4*)(H + (size_t)(row0 + ai * HALF + m * 16) * ldh + col0) = w;
            }
    }
};

struct EpiResid {
    static constexpr bool PERM = true, AFTER_DRAIN = false;
    const float* xin; long din; float* out; long dout; const float* gvec; int gstride; float scale; int nlat_tiles, tiles_per_set; bf16_t* part; int nctx_rows;
    __device__ __forceinline__ void operator()(const f32x4 (&acc)[2][2][4][2], const Unit& u, int wr, int wc, int fr, int fq) const {
        const bool isctx = u.pm >= nlat_tiles;
        const int set = isctx ? 2 : (u.pm / tiles_per_set);
        const float* gv = gvec + (size_t)set * gstride;
        const int colb = u.pn * BM + wc * 32 + 8 * fq;
        const long rbase = (long)(u.pm * BM + wr * 64 + fr) * 2048 + colb;
        const float* xi = xin + rbase + (isctx ? din : 0L); float* xo = out + rbase + (isctx ? dout : 0L);
        f32x4 gg[2][2];
#pragma unroll
        for (int bj = 0; bj < 2; ++bj)
#pragma unroll
            for (int n = 0; n < 2; ++n) gg[bj][n] = *(const f32x4*)(gv + colb + bj * HALF + 4 * n) * scale;
        if (u.kn != 0) {
            bf16_t* pp = part + ((size_t)u.aux * (size_t)nctx_rows + (size_t)((u.pm - nlat_tiles) * BM + wr * 64 + fr)) * 2048 + colb;
#pragma unroll
            for (int ai = 0; ai < 2; ++ai)
#pragma unroll
                for (int m = 0; m < 4; ++m)
#pragma unroll
                    for (int bj = 0; bj < 2; ++bj) { const f32x4 v0 = gg[bj][0] * acc[ai][bj][m][0], v1 = gg[bj][1] * acc[ai][bj][m][1];
                        u32x4 w; w.x = cvt_pk_bf16(v0[0], v0[1]); w.y = cvt_pk_bf16(v0[2], v0[3]); w.z = cvt_pk_bf16(v1[0], v1[1]); w.w = cvt_pk_bf16(v1[2], v1[3]);
                        *(u32x4*)(pp + (size_t)(ai * HALF + m * 16) * 2048 + bj * HALF) = w; }
            return;
        }
#pragma unroll
        for (int ai = 0; ai < 2; ++ai) {
            f32x4 xv[4][2][2];
#pragma unroll
            for (int m = 0; m < 4; ++m)
#pragma unroll
                for (int bj = 0; bj < 2; ++bj)
#pragma unroll
                    for (int n = 0; n < 2; ++n) xv[m][bj][n] = *(const f32x4*)(xi + (size_t)(ai * HALF + m * 16) * 2048 + bj * HALF + 4 * n);
#pragma unroll
            for (int m = 0; m < 4; ++m)
#pragma unroll
                for (int bj = 0; bj < 2; ++bj)
#pragma unroll
                    for (int n = 0; n < 2; ++n) *(f32x4*)(xo + (size_t)(ai * HALF + m * 16) * 2048 + bj * HALF + 4 * n) = xv[m][bj][n] + gg[bj][n] * acc[ai][bj][m][n];
        }
    }
};
struct SplitCtxOrder {
    int G, c, nlat_tiles, nctx_tiles, nsplit, ntk;
    __device__ __forceinline__ bool next(int i, Unit& u) const {
        const int e = i * G + c, nl = nlat_tiles * 8;
        if (e < nl) { u.pm = e >> 3; u.pn = e & 7; u.ks = 0; u.kn = 0; u.aux = 0; return true; }
        const int f = e - nl; if (f >= nctx_tiles * 8 * nsplit) return false;
        const int sp = f % nsplit, t = f / nsplit, np = ntk >> 1, p0 = sp * np / nsplit, p1 = (sp + 1) * np / nsplit;
        u.pm = nlat_tiles + (t >> 3); u.pn = t & 7; u.ks = 2 * p0; u.kn = 2 * (p1 - p0); u.aux = sp; return true;
    }
    __device__ __forceinline__ void a_ready(const Unit&) const {}
    __device__ __forceinline__ void done(const Unit&) const {}
};
struct ProjOrder : StaticOrder {
    int skip_ctx;
    __device__ __forceinline__ bool next(int i, Unit& u) const {
        if (StaticOrder::next(i, u)) return true;
        if (!skip_ctx) return false;
        const long L = (long)i * G + c - nwg; if (L >= 2 * 23) return false;
        const int x = (int)L % 23; u.pm = nM + (int)L / 23; u.pn = x < 15 ? 8 + x : 27 + (x - 15); u.ks = 0; u.kn = 0; u.aux = 0; return true;
    }
};
struct LoraOrder : StaticOrder {
    __device__ __forceinline__ bool next(int i, Unit& u) const {
        if (!StaticOrder::next(i, u)) return false;
        const int sec = u.pn >> 2; int k4 = 4; asm volatile("" : "+s"(k4));
        u.ks = sec == 0 ? 0 : (sec <= 2 ? 4 : 8); u.kn = k4; return true;
    }
};

__device__ __forceinline__ float ftanh_e(float x) { return 1.f - 2.f * __builtin_amdgcn_rcpf(__expf(2.f * x) + 1.f); }
__device__ __forceinline__ float gelu_e(float x) { return 0.5f * x * (1.f + ftanh_e(0.7978845608f * (x + 0.044715f * x * x * x))); }
struct EpiProj {
    static constexpr bool PERM = true, AFTER_DRAIN = false;
    bf16_t* P; int ldp; bf16_t* ACT; bf16_t* QK; const float* qn; const float* kn; const float* rope; int nlat_rows, tseq;
    __device__ __forceinline__ void operator()(const f32x4 (&acc)[2][2][4][2], const Unit& u, int wr, int wc, int fr, int fq) const {
        const int pn = u.pn, row0 = u.pm * BM + wr * 64 + fr;
        if (pn >= 23 && pn <= 30) {
            const bool isq = pn <= 26; const int gi = (pn - 23) * 4 + wc;
            const float* gain = isq ? qn : kn;
            f32x4 gg[2][2];
#pragma unroll
            for (int bj = 0; bj < 2; ++bj)
#pragma unroll
                for (int n = 0; n < 2; ++n) gg[bj][n] = *(const f32x4*)(gain + bj * 32 + n * 16 + 4 * fq);
            const float qs = isq ? 0.18033688011112042f : 1.f;
#pragma unroll
            for (int ai = 0; ai < 2; ++ai)
#pragma unroll
                for (int m = 0; m < 4; ++m) {
                    const int row = row0 + ai * HALF + m * 16;
                    f32x4 x[2][2]; float ss = 0.f;
#pragma unroll
                    for (int bj = 0; bj < 2; ++bj)
#pragma unroll
                        for (int n = 0; n < 2; ++n) { x[bj][n] = acc[ai][bj][m][n]; ss += (x[bj][n][0] * x[bj][n][0] + x[bj][n][1] * x[bj][n][1]) + (x[bj][n][2] * x[bj][n][2] + x[bj][n][3] * x[bj][n][3]); }
                    ss += __shfl_xor(ss, 16); ss += __shfl_xor(ss, 32);
                    const float rinv = __builtin_amdgcn_rsqf(ss * (1.f / 64.f) + 1e-6f);
#pragma unroll
                    for (int bj = 0; bj < 2; ++bj)
#pragma unroll
                        for (int n = 0; n < 2; ++n) x[bj][n] = x[bj][n] * rinv * gg[bj][n];
                    if (row < nlat_rows) { const int t = row & (tseq - 1);
#pragma unroll
                        for (int bj = 0; bj < 2; ++bj) { const int p = bj == 0 ? (t >> 6) : (t & 63);
                            const f32x4 cs0 = *(const f32x4*)(rope + (p * 16 + 4 * fq) * 2), cs1 = *(const f32x4*)(rope + (p * 16 + 4 * fq) * 2 + 4);
                            const f32x4 c = {cs0[0], cs0[2], cs1[0], cs1[2]}, s = {cs0[1], cs0[3], cs1[1], cs1[3]};
                            const f32x4 a = x[bj][0], b2 = x[bj][1];
                            x[bj][0] = a * c - b2 * s; x[bj][1] = b2 * c + a * s; } }
                    bf16_t* dst = QK + (size_t)row * 2048 + gi * 64 + 8 * fq;
#pragma unroll
                    for (int bj = 0; bj < 2; ++bj) { const f32x4 v0 = x[bj][0] * qs, v1 = x[bj][1] * qs;
                        u32x4 w; w.x = cvt_pk_bf16(v0[0], v0[1]); w.y = cvt_pk_bf16(v0[2], v0[3]); w.z = cvt_pk_bf16(v1[0], v1[1]); w.w = cvt_pk_bf16(v1[2], v1[3]);
                        *(u32x4*)(dst + bj * 32) = w; }
                }
            return;
        }
        if (pn >= 20 && pn <= 22) {
#pragma unroll
            for (int bj = 0; bj < 2; ++bj) {
                const int cc = bj * HALF + wc * 32 + 8 * fq;
                int dcol, fn;
                if (pn == 20) { dcol = cc; fn = 1; }
                else if (pn == 21) { if (cc < 96) { dcol = 256 + cc; fn = 2; } else if (cc < 192) { dcol = 384 + (cc - 96); fn = 2; } else { dcol = 512 + (cc - 192); fn = 0; } }
                else { if (cc < 32) { dcol = 576 + cc; fn = 0; } else if (cc < 128) { dcol = 640 + (cc - 32); fn = 0; } else { dcol = -1; fn = 0; } }
                if (dcol < 0) continue;
#pragma unroll
                for (int ai = 0; ai < 2; ++ai)
#pragma unroll
                    for (int m = 0; m < 4; ++m) {
                        f32x4 v0 = acc[ai][bj][m][0], v1 = acc[ai][bj][m][1];
                        if (fn != 0) {
#pragma unroll
                            for (int e = 0; e < 4; ++e) { v0[e] = fn == 1 ? fsigmoid(v0[e]) : ftanh_e(v0[e]); v1[e] = fn == 1 ? fsigmoid(v1[e]) : ftanh_e(v1[e]); } }
                        u32x4 w; w.x = cvt_pk_bf16(v0[0], v0[1]); w.y = cvt_pk_bf16(v0[2], v0[3]); w.z = cvt_pk_bf16(v1[0], v1[1]); w.w = cvt_pk_bf16(v1[2], v1[3]);
                        *(u32x4*)(ACT + (size_t)(row0 + ai * HALF + m * 16) * 768 + dcol) = w;
                    }
            }
            return;
        }
        const bool dogelu = pn < 8;
        const int col0 = pn * BM + wc * 32 + 8 * fq;
#pragma unroll
        for (int ai = 0; ai < 2; ++ai)
#pragma unroll
            for (int m = 0; m < 4; ++m) {
                bf16_t* rowp = P + (size_t)(row0 + ai * HALF + m * 16) * ldp + col0;
#pragma unroll
                for (int bj = 0; bj < 2; ++bj) {
                    f32x4 v0 = acc[ai][bj][m][0], v1 = acc[ai][bj][m][1];
                    if (dogelu) {
#pragma unroll
                        for (int e = 0; e < 4; ++e) { v0[e] = gelu_e(v0[e]); v1[e] = gelu_e(v1[e]); } }
                    u32x4 w; w.x = cvt_pk_bf16(v0[0], v0[1]); w.y = cvt_pk_bf16(v0[2], v0[3]); w.z = cvt_pk_bf16(v1[0], v1[1]); w.w = cvt_pk_bf16(v1[2], v1[3]);
                    *(u32x4*)(rowp + bj * HALF) = w;
                }
            }
    }
};

struct EpiLora {
    static constexpr bool PERM = true, AFTER_DRAIN = false;
    bf16_t* LO; const float* w0; const float* a0;
    __device__ __forceinline__ void operator()(const f32x4 (&acc)[2][2][4][2], const Unit& u, int wr, int wc, int fr, int fq) const {
        const int sec = u.pn >> 2;
        const int col0 = u.pn * BM + wc * 32 + 8 * fq, row0 = u.pm * BM + wr * 64 + fr, c0 = col0 - sec * 1024;
        const float* bp = (sec <= 2 ? w0 + (sec <= 1 ? 0 : 1024) : a0 + (sec - 3) * 1024) + c0;
#pragma unroll
        for (int ai = 0; ai < 2; ++ai)
#pragma unroll
            for (int m = 0; m < 4; ++m) {
                bf16_t* rowp = LO + (size_t)(row0 + ai * HALF + m * 16) * 5120 + col0;
#pragma unroll
                for (int bj = 0; bj < 2; ++bj) {
                    f32x4 v[2];
#pragma unroll
                    for (int n = 0; n < 2; ++n) { v[n] = acc[ai][bj][m][n];
                        if (sec >= 1) { v[n] = v[n] + *(const f32x4*)(bp + bj * HALF + 4 * n);
#pragma unroll
                            for (int e = 0; e < 4; ++e) { const float s = fsigmoid(v[n][e]); v[n][e] = (sec <= 2) ? 0.8750356f * s : s; } } }
                    u32x4 w; w.x = cvt_pk_bf16(v[0][0], v[0][1]); w.y = cvt_pk_bf16(v[0][2], v[0][3]); w.z = cvt_pk_bf16(v[1][0], v[1][1]); w.w = cvt_pk_bf16(v[1][2], v[1][3]);
                    *(u32x4*)(rowp + bj * HALF) = w;
                }
                asm volatile("" ::: "memory");
            }
    }
};

struct EpiMerge {
    static constexpr bool PERM = true, AFTER_DRAIN = false;
    const bf16_t* pgate; int ldp;
    const float* bgate;
    bf16_t* ZF; bf16_t* Z; int mtiles;
    bf16_t* ZP; long zp_off;
    __device__ __forceinline__ void operator()(const f32x4 (&acc)[2][2][4][2], const Unit& u, int wr, int wc, int fr, int fq) const {
        const int br = u.pn >> 3, pn = u.pn & 7, pm = u.pm - mtiles * br;
        const int col0 = pn * BM + wc * 32 + 8 * fq, row0 = pm * BM + wr * 64 + fr;
        f32x4 bb[2][2];
#pragma unroll
        for (int bj = 0; bj < 2; ++bj)
#pragma unroll
            for (int n = 0; n < 2; ++n) bb[bj][n] = *(const f32x4*)(bgate + br * 2048 + col0 + bj * HALF + 4 * n);
        const bool part = u.aux != 0, rd = br >= 1 && !part;
        bf16_t* dstb = part ? ZP + ((long)br * 512 + zp_off) * 2048 : (br == 2 ? Z : ZF);
#pragma unroll
        for (int ai = 0; ai < 2; ++ai) {
            u32x4 pg[4][2], zf[4][2];
#pragma unroll
            for (int m = 0; m < 4; ++m)
#pragma unroll
                for (int bj = 0; bj < 2; ++bj) { const size_t row = (size_t)(row0 + ai * HALF + m * 16);
                    pg[m][bj] = *(const u32x4*)(pgate + row * ldp + br * 2048 + col0 + bj * HALF);
                    if (rd) zf[m][bj] = *(const u32x4*)(ZF + row * 2048 + col0 + bj * HALF); }
#pragma unroll
            for (int m = 0; m < 4; ++m)
#pragma unroll
                for (int bj = 0; bj < 2; ++bj) { const size_t row = (size_t)(row0 + ai * HALF + m * 16); const u32x4 q = pg[m][bj];
                    f32x4 g0, g1;
                    g0[0] = bflo(q.x); g0[1] = bfhi(q.x); g0[2] = bflo(q.y); g0[3] = bfhi(q.y); g1[0] = bflo(q.z); g1[1] = bfhi(q.z); g1[2] = bflo(q.w); g1[3] = bfhi(q.w);
                    g0 = g0 + bb[bj][0]; g1 = g1 + bb[bj][1];
                    f32x4 v0, v1;
#pragma unroll
                    for (int e = 0; e < 4; ++e) { v0[e] = fsigmoid(g0[e]) * acc[ai][bj][m][0][e]; v1[e] = fsigmoid(g1[e]) * acc[ai][bj][m][1][e]; }
                    if (rd) { const u32x4 z = zf[m][bj];
                        v0[0] += bflo(z.x); v0[1] += bfhi(z.x); v0[2] += bflo(z.y); v0[3] += bfhi(z.y); v1[0] += bflo(z.z); v1[1] += bfhi(z.z); v1[2] += bflo(z.w); v1[3] += bfhi(z.w); }
                    u32x4 w; w.x = cvt_pk_bf16(v0[0], v0[1]); w.y = cvt_pk_bf16(v0[2], v0[3]); w.z = cvt_pk_bf16(v1[0], v1[1]); w.w = cvt_pk_bf16(v1[2], v1[3]);
                    *(u32x4*)(dstb + row * 2048 + col0 + bj * HALF) = w; }
        }
    }
};
struct MergeOrder {
    int G, c, mtiles, nlat_tiles, nctx_units;
    __device__ __forceinline__ bool next(int i, Unit& u) const {
        const int ntl = nlat_tiles * 8; int nl = (ntl - c + G - 1) / G; nl = nl < 0 ? 0 : nl;
        u.ks = 0; u.kn = 0;
        if (i < 3 * nl) { const int t = (i / 3) * G + c, br = i % 3; u.pm = (t >> 3) + mtiles * br; u.pn = (t & 7) + 8 * br; u.aux = 0; return true; }
        const int e = (i - 3 * nl) * G + c; if (e >= nctx_units) return false;
        const int t = ntl + e / 3, br = e % 3; u.pm = (t >> 3) + mtiles * br; u.pn = (t & 7) + 8 * br; u.aux = 1; return true;
    }
    __device__ __forceinline__ void a_ready(const Unit&) const {}
    __device__ __forceinline__ void done(const Unit&) const {}
};

template <class Epi, class Sched, bool ALIGN_EPI = false, bool SP2 = false>
__device__ __forceinline__ void gemm_phase(PG8_LAS unsigned char* lds, const Gemm g, const Sched& S, const Epi& E) {
    const int tid = threadIdx.x, wid = __builtin_amdgcn_readfirstlane(tid >> 6), lane = tid & 63, wr = wid >> 2, wc = wid & 3, fr = lane & 15, fq = lane >> 4;
    const int K = g.K, nt = K / BK;
    unsigned voffA[2], voffB[2];
#pragma unroll
    for (int i = 0; i < 2; ++i) { int R, C; stage_rc(tid * 16 + i * 8192, R, C); const int Rb = Epi::PERM ? ((R & ~31) + perm32(R & 31)) : R;
        voffA[i] = (unsigned)(R * K + C) * 2u; voffB[i] = (unsigned)(Rb * K + C) * 2u; }
    const size_t kstep = (size_t)(BK * 2);
    const size_t hstep = (size_t)HALF * K * 2;
    const size_t tstep = 2 * hstep;
    const unsigned ldsw = (unsigned)wid * 1024u;
    const int aoff = lds_byte(wr * 64 + fr, fq * 8), boff = lds_byte(wc * 32 + fr, fq * 8);
#define PG8_SA(b, h) (((b) * 2 + (h)) * HTB)
#define PG8_SB(b, h) ((4 + (b) * 2 + (h)) * HTB)
#define PG8_STAGE(bufoff, gbase, voff) do { _Pragma("unroll") for (int _i = 0; _i < 2; ++_i) \
        __builtin_amdgcn_global_load_lds((const unsigned*)((const char*)(gbase) + (voff)[_i]), (PG8_LAS unsigned*)(lds + (bufoff) + ldsw + _i * 8192), 16, 0, 0); } while (0)
#define PG8_LDA(dst, b, h) do { _Pragma("unroll") for (int m = 0; m < 4; ++m) _Pragma("unroll") for (int k = 0; k < 2; ++k) dst[m][k] = *(const PG8_LAS bf16x8*)(lds + PG8_SA(b, h) + aoff + m * 2048 + k * 1024); } while (0)
#define PG8_LDB(dst, b, h) do { _Pragma("unroll") for (int n = 0; n < 2; ++n) _Pragma("unroll") for (int k = 0; k < 2; ++k) dst[n][k] = *(const PG8_LAS bf16x8*)(lds + PG8_SB(b, h) + boff + n * 2048 + k * 1024); } while (0)
#define PG8_MMA(ai, bj, At, Bt) do { __builtin_amdgcn_s_setprio(1); _Pragma("unroll") for (int m = 0; m < 4; ++m) _Pragma("unroll") for (int n = 0; n < 2; ++n) _Pragma("unroll") for (int k = 0; k < 2; ++k) \
        acc[ai][bj][m][n] = __builtin_amdgcn_mfma_f32_16x16x32_bf16(Bt[n][k], At[m][k], acc[ai][bj][m][n], 0, 0, 0); __builtin_amdgcn_s_setprio(0); } while (0)
#define PG8_WAIT_V(n) asm volatile("s_waitcnt vmcnt(" #n ")" ::: "memory")
#define PG8_WAIT_L(n) asm volatile("s_waitcnt lgkmcnt(" #n ")" ::: "memory")
#define PG8_BAR __builtin_amdgcn_s_barrier()
#define PG8_SCHED __builtin_amdgcn_sched_barrier(0)
    Unit cur, nxt; int ui = 0;
    if (!S.next(0, cur)) return;
    f32x4 acc[2][2][4][2];
#pragma unroll
    for (int a = 0; a < 2; ++a)
#pragma unroll
        for (int b = 0; b < 2; ++b)
#pragma unroll
            for (int m = 0; m < 4; ++m)
#pragma unroll
                for (int n = 0; n < 2; ++n) acc[a][b][m][n] = (f32x4){0.f, 0.f, 0.f, 0.f};
    bf16x8 At[4][2], B0[2][2], B1[2][2];
    const char* cA = (const char*)g.A + (size_t)cur.pm * tstep + (size_t)cur.ks * kstep; const char* cB = (const char*)g.Bt + (size_t)cur.pn * tstep + (size_t)cur.ks * kstep;
    int ntc = cur.kn ? cur.kn : nt;
    S.a_ready(cur);
    if constexpr (SP2) {
        PG8_STAGE(PG8_SB(0, 0), cB, voffB); PG8_STAGE(PG8_SB(0, 1), cB + hstep, voffB); PG8_STAGE(PG8_SA(0, 0), cA, voffA); PG8_STAGE(PG8_SA(0, 1), cA + hstep, voffA);
        if (wr == 1) PG8_BAR;
        PG8_WAIT_V(2); PG8_BAR;
        PG8_STAGE(PG8_SB(1, 0), cB + kstep, voffB); PG8_STAGE(PG8_SA(1, 0), cA + kstep, voffA); PG8_STAGE(PG8_SB(1, 1), cB + hstep + kstep, voffB);
        PG8_WAIT_V(6); PG8_BAR;
    } else {
        PG8_STAGE(PG8_SB(0, 0), cB, voffB); PG8_STAGE(PG8_SA(0, 0), cA, voffA); PG8_STAGE(PG8_SB(0, 1), cB + hstep, voffB); PG8_STAGE(PG8_SA(0, 1), cA + hstep, voffA);
        if (wr == 1) PG8_BAR;
        PG8_WAIT_V(4); PG8_BAR;
        PG8_STAGE(PG8_SB(1, 0), cB + kstep, voffB); PG8_STAGE(PG8_SA(1, 0), cA + kstep, voffA); PG8_STAGE(PG8_SB(1, 1), cB + hstep + kstep, voffB);
        PG8_WAIT_V(6); PG8_BAR;
    }
    for (;;) {
        const bool has_next = S.next(ui + 1, nxt);
        const char* nA = has_next ? (const char*)g.A + (size_t)nxt.pm * tstep + (size_t)nxt.ks * kstep : cA; const char* nB = has_next ? (const char*)g.Bt + (size_t)nxt.pn * tstep + (size_t)nxt.ks * kstep : cB;
        for (int t = 0; t < ntc; t += 2) {
            const bool last = (t == ntc - 2);
            const char* a1 = cA + (size_t)(t + 1) * kstep;
            const char* a2 = last ? nA : cA + (size_t)(t + 2) * kstep; const char* b2 = last ? nB : cB + (size_t)(t + 2) * kstep;
            const char* a3 = a2 + kstep; const char* b3 = b2 + kstep;
            if (last && has_next) S.a_ready(nxt);
            if constexpr (SP2) {
            PG8_LDB(B0, 0, 0); PG8_LDB(B1, 0, 1); PG8_SCHED; PG8_LDA(At, 0, 0); PG8_STAGE(PG8_SA(1, 1), a1 + hstep, voffA);
            PG8_WAIT_V(8); PG8_WAIT_L(0); PG8_BAR; PG8_MMA(0, 0, At, B0); PG8_MMA(0, 1, At, B1); PG8_BAR; PG8_SCHED;
            PG8_LDA(At, 0, 1); PG8_STAGE(PG8_SB(0, 0), b2, voffB); PG8_STAGE(PG8_SB(0, 1), b2 + hstep, voffB); PG8_STAGE(PG8_SA(0, 0), a2, voffA);
            PG8_WAIT_V(8); PG8_WAIT_L(0); PG8_BAR; PG8_MMA(1, 0, At, B0); PG8_MMA(1, 1, At, B1); PG8_BAR; PG8_SCHED;
            PG8_LDB(B0, 1, 0); PG8_LDB(B1, 1, 1); PG8_SCHED; PG8_LDA(At, 1, 0); PG8_STAGE(PG8_SA(0, 1), a2 + hstep, voffA);
            PG8_WAIT_V(8); PG8_WAIT_L(0); PG8_BAR; PG8_MMA(0, 0, At, B0); PG8_MMA(0, 1, At, B1); PG8_BAR; PG8_SCHED;
            PG8_LDA(At, 1, 1); PG8_STAGE(PG8_SB(1, 0), b3, voffB); PG8_STAGE(PG8_SB(1, 1), b3 + hstep, voffB); PG8_STAGE(PG8_SA(1, 0), a3, voffA);
            PG8_WAIT_V(8); PG8_WAIT_L(0); PG8_BAR; PG8_MMA(1, 0, At, B0); PG8_MMA(1, 1, At, B1); PG8_BAR; PG8_SCHED;
            } else {
            PG8_LDB(B0, 0, 0); PG8_SCHED; PG8_LDA(At, 0, 0); PG8_STAGE(PG8_SA(1, 1), a1 + hstep, voffA);
            PG8_WAIT_L(8); PG8_BAR; PG8_WAIT_L(0); PG8_MMA(0, 0, At, B0); PG8_BAR; PG8_SCHED;
            PG8_LDB(B1, 0, 1); PG8_STAGE(PG8_SB(0, 0), b2, voffB);
            PG8_BAR; PG8_WAIT_L(0); PG8_MMA(0, 1, At, B1); PG8_BAR;
            PG8_LDA(At, 0, 1); PG8_STAGE(PG8_SA(0, 0), a2, voffA);
            PG8_BAR; PG8_WAIT_L(0); PG8_MMA(1, 0, At, B0); PG8_BAR; PG8_SCHED;
            PG8_STAGE(PG8_SB(0, 1), b2 + hstep, voffB);
            PG8_WAIT_V(6); PG8_BAR; PG8_MMA(1, 1, At, B1); PG8_BAR;
            PG8_LDB(B0, 1, 0); PG8_SCHED; PG8_LDA(At, 1, 0); PG8_STAGE(PG8_SA(0, 1), a2 + hstep, voffA);
            PG8_WAIT_L(8); PG8_BAR; PG8_WAIT_L(0); PG8_MMA(0, 0, At, B0); PG8_BAR; PG8_SCHED;
            PG8_LDB(B1, 1, 1); PG8_STAGE(PG8_SB(1, 0), b3, voffB);
            PG8_BAR; PG8_WAIT_L(0); PG8_MMA(0, 1, At, B1); PG8_BAR;
            PG8_LDA(At, 1, 1); PG8_STAGE(PG8_SA(1, 0), a3, voffA);
            PG8_BAR; PG8_WAIT_L(0); PG8_MMA(1, 0, At, B0); PG8_BAR; PG8_SCHED;
            PG8_STAGE(PG8_SB(1, 1), b3 + hstep, voffB);
            PG8_WAIT_V(6); PG8_BAR; PG8_MMA(1, 1, At, B1); PG8_BAR;
            }
        }
        if constexpr (ALIGN_EPI) { if (wr == 0) PG8_BAR; }
        if constexpr (!Epi::AFTER_DRAIN) { E(acc, cur, wr, wc, fr, fq); S.done(cur); }
        if (!has_next) break;
#pragma unroll
        for (int a = 0; a < 2; ++a)
#pragma unroll
            for (int b = 0; b < 2; ++b)
#pragma unroll
                for (int m = 0; m < 4; ++m)
#pragma unroll
                    for (int n = 0; n < 2; ++n) acc[a][b][m][n] = (f32x4){0.f, 0.f, 0.f, 0.f};
        cur = nxt; cA = nA; cB = nB; ++ui; ntc = cur.kn ? cur.kn : nt;
        if constexpr (ALIGN_EPI) { if (wr == 1) PG8_BAR; }
    }
    PG8_WAIT_V(0);
    if constexpr (!ALIGN_EPI) { if (wr == 0) PG8_BAR; }
    PG8_BAR;
    if constexpr (Epi::AFTER_DRAIN) { E.fused(acc, cur, wr, wc, fr, fq, lds, wid, lane); S.done(cur); }
#undef PG8_SA
#undef PG8_SB
#undef PG8_STAGE
#undef PG8_LDA
#undef PG8_LDB
#undef PG8_MMA
#undef PG8_WAIT_V
#undef PG8_WAIT_L
#undef PG8_BAR
#undef PG8_SCHED
}
}

constexpr int NWAVES = 8, NTHR = NWAVES * 64;
constexpr int DM = 2048, FF = 5504, FF2 = 2 * FF, NLAT = 8192, NCTX = 512, MT = NLAT + NCTX, TSEQ = 4096, TCTX = 256;
constexpr int PROJ = 14976, PROJP = 15104;
constexpr int P_U = 0, P_V = 1024, P_RKV = 2048, P_G = 5120, P_W = 5376, P_A = 5568, P_QKV = 5760, P_GATE = 8832;
constexpr int P_V2 = 31 * 256, P_GATE2 = 35 * 256;
constexpr int ACTW = 768, LOW = 5120;
constexpr int NLAYER = 2, NMOD = 9;

constexpr size_t MiB = 1u << 20;
constexpr size_t al(size_t x) { return (x + MiB - 1) / MiB * MiB; }
constexpr size_t WS_CTL = 0, CTL_ZERO_BYTES = 1 * MiB;
constexpr size_t WS_MODS = 1 * MiB;
constexpr size_t WS_ROPE = WS_MODS + al((size_t)NLAYER * 3 * NMOD * DM * 4);
constexpr size_t WS_WF1 = WS_ROPE + MiB;
constexpr size_t SZ_WF1 = (size_t)FF2 * DM * 2;
constexpr size_t WS_WF2 = WS_WF1 + al(4 * SZ_WF1);
constexpr size_t SZ_WF2 = (size_t)DM * FF * 2;
constexpr size_t WS_WIN = WS_WF2 + al(4 * SZ_WF2);
constexpr size_t SZ_WIN = (size_t)PROJP * DM * 2;
constexpr size_t WS_WLO = WS_WIN + al(2 * SZ_WIN);
constexpr size_t SZ_WLO = (size_t)LOW * ACTW * 2;
constexpr size_t WS_WBR = WS_WLO + al(2 * SZ_WLO);
constexpr size_t SZ_WBR = (size_t)3 * DM * 1024 * 2;
constexpr size_t WS_WOUT = WS_WBR + al(2 * SZ_WBR);
constexpr size_t SZ_WOUT = (size_t)DM * DM * 2;
constexpr size_t WS_XS = WS_WOUT + al(2 * SZ_WOUT);
constexpr size_t WS_XN = WS_XS + al((size_t)MT * DM * 4);
constexpr size_t WS_P = WS_XN + al((size_t)MT * DM * 2);
constexpr size_t WS_R1 = WS_P + al((size_t)MT * PROJP * 2);
constexpr size_t WS_ACT = WS_R1 + al((size_t)MT * FF * 2);
constexpr size_t WS_RKVK = WS_ACT + al((size_t)MT * ACTW * 2);
constexpr size_t WS_QK = WS_RKVK + al((size_t)MT * 4096 * 2);
constexpr size_t WS_YS = WS_QK + al((size_t)MT * DM * 2);
constexpr size_t WS_Y3 = WS_YS + al((size_t)2 * MT * 1024 * 2);
constexpr size_t WS_OJ = WS_Y3 + al((size_t)3 * MT * 1024 * 2);
constexpr size_t WS_PART = WS_OJ + al((size_t)2 * MT * 1024 * 2);
constexpr size_t WS_ZF = WS_PART + al((size_t)16 * NCTX * DM * 2);
constexpr size_t WS_IMG = WS_ZF + al((size_t)MT * DM * 2);
constexpr size_t WS_END = WS_IMG + al((size_t)64 * 136 * 22528);

constexpr int CW_TMO = 0, CW_CODE = 1, CW_BAR = 4096;

constexpr int RING_BYTES = 131072, LDSCTL_OFF = RING_BYTES, MISC_OFF = LDSCTL_OFF + 320, LDS_BYTES = 147456;

#define GAS __attribute__((address_space(1)))
#define LAS __attribute__((address_space(3)))
typedef unsigned short bf16;
typedef unsigned v4u __attribute__((ext_vector_type(4)));
typedef unsigned v2u __attribute__((ext_vector_type(2)));
typedef float f32x4 __attribute__((ext_vector_type(4)));
typedef short bf16x8 __attribute__((ext_vector_type(8)));
typedef GAS unsigned gu32;
#define RLX_AGENT __ATOMIC_RELAXED, __HIP_MEMORY_SCOPE_AGENT
__device__ __forceinline__ unsigned f2bf(float f) { unsigned u = __builtin_bit_cast(unsigned, f); return (u + 0x7fffu + ((u >> 16) & 1u)) >> 16; }
__device__ __forceinline__ unsigned pk2(float lo, float hi) { return f2bf(lo) | (f2bf(hi) << 16); }
__device__ __forceinline__ float bflo(unsigned w) { return __builtin_bit_cast(float, w << 16); }
__device__ __forceinline__ float bfhi(unsigned w) { return __builtin_bit_cast(float, w & 0xffff0000u); }
__device__ __forceinline__ float bf1(bf16 h) { return __builtin_bit_cast(float, (unsigned)h << 16); }
__device__ __forceinline__ void unpack8(const v4u w, float (&f)[8]) { f[0] = bflo(w.x); f[1] = bfhi(w.x); f[2] = bflo(w.y); f[3] = bfhi(w.y); f[4] = bflo(w.z); f[5] = bfhi(w.z); f[6] = bflo(w.w); f[7] = bfhi(w.w); }
__device__ __forceinline__ v4u pack8(const float (&f)[8]) { v4u w; w.x = pk2(f[0], f[1]); w.y = pk2(f[2], f[3]); w.z = pk2(f[4], f[5]); w.w = pk2(f[6], f[7]); return w; }
__device__ __forceinline__ float fsigm(float x) { return __builtin_amdgcn_rcpf(1.f + __expf(-x)); }
__device__ __forceinline__ float ftanh(float x) { return 1.f - 2.f * __builtin_amdgcn_rcpf(__expf(2.f * x) + 1.f); }
__device__ __forceinline__ float gelu_t(float x) { return 0.5f * x * (1.f + ftanh(0.7978845608f * (x + 0.044715f * x * x * x))); }
__device__ __forceinline__ float wave_sum(float v) {
#pragma unroll
    for (int o = 1; o < 64; o <<= 1) v += __shfl_xor(v, o);
    return v;
}
#define XB_TMO      128
#define XB_XCNT(j)  (256  + 64 * (j))
#define XB_XSUB(j)  (1280 + 64 * (j))
#define XB_XGEN(j)  (2304 + 64 * (j))
#define XB_TOP      3328
#define XB_TOPGEN   3392
#define XCD_BAR_WORDS 3456
#define XB_SPIN_CAP (1u << 18)

__device__ __forceinline__ unsigned xb_ld(unsigned* p)              { return __hip_atomic_load(p, __ATOMIC_RELAXED, __HIP_MEMORY_SCOPE_AGENT); }
__device__ __forceinline__ unsigned xb_add(unsigned* p, unsigned v) { return __hip_atomic_fetch_add(p, v, __ATOMIC_RELAXED, __HIP_MEMORY_SCOPE_AGENT); }
__device__ __forceinline__ unsigned xb_xcc_id() { return (unsigned)__builtin_amdgcn_s_getreg((3 << 11) | 20) & 0xFu; }
#define XB_SPIN(cond, bar) do { unsigned _sp = 0; while (cond) { __builtin_amdgcn_s_sleep(1); \
    if ((++_sp & 255u) == 0u) { if (xb_ld(&(bar)[XB_TMO])) break; if (_sp > XB_SPIN_CAP) { atomicAdd(&(bar)[XB_TMO], 1u); break; } } } } while (0)

struct XcdBarrier {
    unsigned* bar; unsigned x;
    volatile LAS unsigned* st;
};

__device__ __forceinline__ XcdBarrier xcd_barrier_post(unsigned* bar, volatile LAS unsigned* st) {
    XcdBarrier b; b.bar = bar; b.x = xb_xcc_id(); b.st = st;
    if (threadIdx.x == 0) (void)xb_add(&bar[XB_XCNT(b.x)], 1u);
    return b;
}
__device__ __forceinline__ void xcd_barrier_complete(unsigned* bar, unsigned x, unsigned& nloc, unsigned& nx) {
    const unsigned G = gridDim.x * gridDim.y * gridDim.z;
    unsigned sum, cnt, mine, sp = 0u;
    for (;;) {
        sum = 0u; cnt = 0u; mine = 0u;
#pragma unroll
        for (unsigned j = 0; j < 16; ++j) { const unsigned c = xb_ld(&bar[XB_XCNT(j)]); sum += c; cnt += (c > 0u) ? 1u : 0u; mine = (j == x) ? c : mine; }
        if (sum == G) break;
        __builtin_amdgcn_s_sleep(1);
        if ((++sp & 255u) == 0u) { if (xb_ld(&bar[XB_TMO])) break; if (sp > XB_SPIN_CAP) { atomicAdd(&bar[XB_TMO], 1u); break; } }
    }
    nloc = mine > 0u ? mine : 1u; nx = cnt > 0u ? cnt : 1u;
}

__device__ __forceinline__ void xcd_barrier(const XcdBarrier& b) {
    asm volatile("s_waitcnt vmcnt(0)" ::: "memory");
    __syncthreads();
    if (threadIdx.x == 0) {
        unsigned* bar = b.bar;
        __builtin_amdgcn_s_waitcnt(0);
        unsigned nloc = b.st[0], nx = b.st[1];
        if (nloc == 0u) { xcd_barrier_complete(bar, b.x, nloc, nx); b.st[0] = nloc; b.st[1] = nx; }
        const unsigned old = xb_add(&bar[XB_XSUB(b.x)], 1u);
        const unsigned gen = old / nloc;
        if (old + 1u == (gen + 1u) * nloc) {
            __builtin_amdgcn_fence(__ATOMIC_RELEASE, "agent");
            asm volatile("s_waitcnt vmcnt(0)" ::: "memory");
            const unsigned og = xb_add(&bar[XB_TOP], 1u);
            const unsigned tg = og / nx;
            if (og + 1u == (tg + 1u) * nx) xb_add(&bar[XB_TOPGEN], 1u);
            else XB_SPIN(xb_ld(&bar[XB_TOPGEN]) == tg, bar);
            __builtin_amdgcn_fence(__ATOMIC_ACQUIRE, "agent");
            xb_add(&bar[XB_XGEN(b.x)], 1u);
            asm volatile("s_waitcnt vmcnt(0)" ::: "memory");
        } else {
            XB_SPIN(xb_ld(&bar[XB_XGEN(b.x)]) == gen, bar);
            __builtin_amdgcn_fence(__ATOMIC_ACQUIRE, "agent");
            asm volatile("s_waitcnt vmcnt(0)" ::: "memory");
        }
    }
    __syncthreads();
}

struct Args { const float* in[31]; float* out; unsigned char* ws; int ph_lo, ph_hi; };
enum In { I_X = 0, I_C, I_CTX, I_CCTX, I_WADA, I_BADA, I_NORMG, I_FFNIN, I_FFNOUT, I_WIN, I_GMVN, I_GMWS, I_GMBS, I_CONV, I_W0, I_WUP, I_A0, I_AUP, I_GUP, I_KK, I_KA, I_RK, I_LNG, I_LNB,
          I_QN, I_KN, I_LAM, I_SUBLN, I_WBR, I_BGATE, I_WOUT };

__device__ __forceinline__ void ph_ada(const Args& a, LAS unsigned char* lds, int tid, int vcu, int G) {
    LAS float* sc = (LAS float*)lds;
    LAS float* red = sc + 3 * 2048;
    const float* c = a.in[I_C]; const float* cc = a.in[I_CCTX];
    for (int i = tid; i < 3 * 2048; i += NTHR) { const float x = i < 4096 ? c[i] : cc[i - 4096]; sc[i] = x * fsigm(x); }
    __syncthreads();
    const int lane = tid & 63, wave = tid >> 6;
    float* mods = (float*)(a.ws + WS_MODS);
    for (int u = vcu; u < NLAYER * 288; u += G) {
        const int l = u / 288, jc = u - l * 288, j = jc * 64 + lane;
        const float* W = a.in[I_WADA] + (size_t)l * 2048 * 18432 + j;
        float s0 = 0.f, s1 = 0.f, s2 = 0.f;
        const int k0 = wave * 256;
#pragma unroll 32
        for (int k = 0; k < 256; ++k) { const float w = __builtin_nontemporal_load(W + (size_t)(k0 + k) * 18432); s0 += sc[k0 + k] * w; s1 += sc[2048 + k0 + k] * w; s2 += sc[4096 + k0 + k] * w; }
        red[(wave * 3 + 0) * 64 + lane] = s0; red[(wave * 3 + 1) * 64 + lane] = s1; red[(wave * 3 + 2) * 64 + lane] = s2;
        __syncthreads();
        if (wave < 3) { float s = a.in[I_BADA][(size_t)l * 18432 + j];
#pragma unroll
            for (int w8 = 0; w8 < 8; ++w8) s += red[(w8 * 3 + wave) * 64 + lane];
            mods[(size_t)(l * 3 + wave) * 18432 + j] = s; }
        __syncthreads();
    }
}
__device__ __forceinline__ void transpose_item(const float* W, int N, int sc0, bf16* WT, int Kd, int nd0, int k0, LAS float* scr, int lane, bool permq = false) {
    if (sc0 >= 0) {
#pragma unroll
        for (int i = 0; i < 32; ++i) { const int kk = 2 * i + (lane >> 5); scr[kk * 33 + (lane & 31)] = __builtin_nontemporal_load(W + (size_t)(k0 + kk) * N + sc0 + (lane & 31)); }
    } else {
#pragma unroll 8
        for (int i = 0; i < 32; ++i) { const int kk = 2 * i + (lane >> 5); scr[kk * 33 + (lane & 31)] = 0.f; }
    }
    asm volatile("s_waitcnt lgkmcnt(0)" ::: "memory");
    const int c = lane & 7;
#pragma unroll
    for (int j = 0; j < 4; ++j) { const int n = (lane >> 3) + 8 * j;
        const int ns = permq ? (((n & 7) < 4) ? 4 * (n >> 3) + (n & 7) : 16 + 4 * (n >> 3) + (n & 7) - 4) : n;
        const LAS float* s = scr + (8 * c) * 33 + ns;
        v4u o; o.x = pk2(s[0 * 33], s[1 * 33]); o.y = pk2(s[2 * 33], s[3 * 33]); o.z = pk2(s[4 * 33], s[5 * 33]); o.w = pk2(s[6 * 33], s[7 * 33]);
        *(GAS v4u*)(WT + (size_t)(nd0 + n) * Kd + k0 + 8 * c) = o; }
    asm volatile("s_waitcnt lgkmcnt(0)" ::: "memory");
}
__device__ __forceinline__ void ph_weights(const Args& a, int l, LAS unsigned char* lds, int tid, int vcu, int G) {
    const int lane = tid & 63, wave = tid >> 6;
    LAS float* scr = (LAS float*)(lds + wave * 16384);
    const int gw = vcu * NWAVES + wave, NGW = G * NWAVES;
    constexpr int I_F1 = 32 * (FF2 / 32), I_F2 = (FF / 64) * (DM / 32), I_IN = 32 * (PROJP / 32), I_BR = 16 * (DM / 32), I_WO = 32 * (DM / 32);
    constexpr int NITEMS = 2 * I_F1 + 2 * I_F2 + I_IN + 3 * I_BR + I_WO;
    unsigned char* ws = a.ws;
    for (int it = gw; it < NITEMS; it += NGW) {
        int r = it;
        if (r < 2 * I_F1) { const int mi = l * 2 + r / I_F1, q = r % I_F1, nb = q % (FF2 / 32), kb = q / (FF2 / 32), nd0 = 32 * nb, pn = nd0 >> 8, rr = nd0 & 255;
            const int sc0 = rr < 128 ? pn * 128 + rr : FF + pn * 128 + (rr - 128);
            transpose_item(a.in[I_FFNIN] + (size_t)mi * DM * FF2, FF2, sc0, (bf16*)(ws + WS_WF1 + (size_t)mi * SZ_WF1), DM, nd0, 64 * kb, scr, lane); continue; }
        r -= 2 * I_F1;
        if (r < 2 * I_F2) { const int mi = l * 2 + r / I_F2, q = r % I_F2, nb = q % (DM / 32), kb = q / (DM / 32);
            transpose_item(a.in[I_FFNOUT] + (size_t)mi * FF * DM, DM, 32 * nb, (bf16*)(ws + WS_WF2 + (size_t)mi * SZ_WF2), FF, 32 * nb, 64 * kb, scr, lane); continue; }
        r -= 2 * I_F2;
        if (r < I_IN) { const int mi = l, q = r, nb = q % (PROJP / 32), kb = q / (PROJP / 32), nd0 = 32 * nb, T = nd0 >> 8, cc = nd0 & 255;
            int sc0; bool pq = false;
            if (T <= 21) sc0 = nd0;
            else if (T == 22) sc0 = cc < 128 ? nd0 : -1;
            else if (T <= 30) { sc0 = P_QKV + ((T - 23) * 4 + ((cc >> 5) & 3)) * 64 + (cc >> 7) * 32; pq = true; }
            else if (T <= 34) sc0 = P_QKV + 2048 + (nd0 - 31 * 256);
            else sc0 = P_GATE + (nd0 - 35 * 256);
            transpose_item(a.in[I_WIN] + (size_t)mi * DM * PROJ, PROJ, sc0, (bf16*)(ws + WS_WIN + (size_t)mi * SZ_WIN), DM, nd0, 64 * kb, scr, lane, pq); continue; }
        r -= I_IN;
        if (r < 3 * I_BR) { const int mi = l * 3 + r / I_BR, q = r % I_BR, nb = q % (DM / 32), kb = q / (DM / 32);
            transpose_item(a.in[I_WBR] + (size_t)mi * 1024 * DM, DM, 32 * nb, (bf16*)(ws + WS_WBR + (size_t)mi * ((size_t)DM * 1024 * 2)), 1024, 32 * nb, 64 * kb, scr, lane); continue; }
        r -= 3 * I_BR;
        { const int mi = l, q = r, nb = q % (DM / 32), kb = q / (DM / 32);
            transpose_item(a.in[I_WOUT] + (size_t)mi * DM * DM, DM, 32 * nb, (bf16*)(ws + WS_WOUT + (size_t)mi * SZ_WOUT), DM, 32 * nb, 64 * kb, scr, lane); }
    }
}
__device__ __forceinline__ void ph_small(const Args& a, int tid, int vcu, int G) {
    unsigned char* ws = a.ws;
    const int gt = vcu * NTHR + tid, NGT = G * NTHR;
    for (int i = gt; i < NLAYER * LOW * (ACTW / 8); i += NGT) {
        const int l = i / (LOW * (ACTW / 8)), q = i % (LOW * (ACTW / 8)), n = q / (ACTW / 8), k0 = (q % (ACTW / 8)) * 8, sec = n >> 10, cc = n & 1023;
        float f[8];
#pragma unroll
        for (int e = 0; e < 8; ++e) { const int k = k0 + e; float v = 0.f;
            if (sec == 0) { if (k < 256) v = a.in[I_GUP][((size_t)l * 256 + k) * 1024 + cc]; }
            else if (sec <= 2) { const int d = sec - 1, kb = 256 + 128 * d; if (k >= kb && k < kb + 96) v = a.in[I_WUP][((size_t)(l * 2 + d) * 96 + (k - kb)) * 1024 + cc]; }
            else { const int d = sec - 3, kb = 512 + 128 * d; if (k >= kb && k < kb + 96) v = a.in[I_AUP][((size_t)(l * 2 + d) * 96 + (k - kb)) * 1024 + cc]; }
            f[e] = v; }
        *(GAS v4u*)((bf16*)(ws + WS_WLO) + ((size_t)l * LOW + n) * ACTW + k0) = pack8(f);
    }
    for (int i = gt; i < 64 * 16; i += NGT) { const int p = i >> 4, ii = i & 15;
        const float inv = exp2f(-(float)(2 * ii) * (1.f / 32.f) * 13.287712379549449f);
        const float rev = (float)p * inv * 0.15915494309189535f;
        float* rt = (float*)(ws + WS_ROPE) + 2 * i; rt[0] = __builtin_amdgcn_cosf(rev); rt[1] = __builtin_amdgcn_sinf(rev); }
}

__device__ __forceinline__ void norm_row_store(f32x4 (&v)[8], int m, const float* gain, const float* mods, int si, bf16* XN, int lane) {
    float ss = 0.f;
#pragma unroll
    for (int j = 0; j < 8; ++j) ss += (v[j].x * v[j].x + v[j].y * v[j].y) + (v[j].z * v[j].z + v[j].w * v[j].w);
    const float rinv = 1.f / sqrtf(wave_sum(ss) * (1.f / DM) + 1e-6f);
    const int set = m < TSEQ ? 0 : (m < NLAT ? 1 : 2);
    const float* sh = mods + (size_t)(set * NMOD + si) * DM; const float* scl = sh + DM;
#pragma unroll
    for (int j = 0; j < 8; ++j) { const int col = 4 * lane + 256 * j;
        const f32x4 g = *(const GAS f32x4*)(gain + col), s1 = *(const GAS f32x4*)(scl + col), s0 = *(const GAS f32x4*)(sh + col);
        const f32x4 o = (v[j] * rinv * g) * (s1 + 1.f) + s0;
        v2u w; w.x = pk2(o.x, o.y); w.y = pk2(o.z, o.w);
        *(GAS v2u*)(XN + (size_t)m * DM + col) = w; }
}
__device__ __forceinline__ void ph_norm(const float* xl, const float* xc, const float* gain, const float* mods  , int si, bf16* XN, float* xs_out, const bf16* part, int nsplit, int nrows, int gw, int NGW, int lane, LAS float* red) {
    if (NLAT == 4 * NGW) {
        f32x4 v[4][8];
#pragma unroll
        for (int q = 0; q < 4; ++q)
#pragma unroll
            for (int j = 0; j < 8; ++j) v[q][j] = *(const GAS f32x4*)(xl + (size_t)(gw + q * NGW) * DM + 4 * lane + 256 * j);
        float rinv[4];
#pragma unroll
        for (int q = 0; q < 4; ++q) { float ss = 0.f;
#pragma unroll
            for (int j = 0; j < 8; ++j) ss += (v[q][j].x * v[q][j].x + v[q][j].y * v[q][j].y) + (v[q][j].z * v[q][j].z + v[q][j].w * v[q][j].w);
            rinv[q] = 1.f / sqrtf(wave_sum(ss) * (1.f / DM) + 1e-6f); }
        const float* sh0 = mods + (size_t)(0 * NMOD + si) * DM; const float* sh1 = mods + (size_t)(1 * NMOD + si) * DM;
#pragma unroll
        for (int j = 0; j < 8; ++j) { const int col = 4 * lane + 256 * j;
            const f32x4 g = *(const GAS f32x4*)(gain + col), a0 = *(const GAS f32x4*)(sh0 + DM + col) + 1.f, b0 = *(const GAS f32x4*)(sh0 + col), a1 = *(const GAS f32x4*)(sh1 + DM + col) + 1.f, b1 = *(const GAS f32x4*)(sh1 + col);
#pragma unroll
            for (int q = 0; q < 4; ++q) { const f32x4 o = (v[q][j] * rinv[q] * g) * (q < 2 ? a0 : a1) + (q < 2 ? b0 : b1);
                v2u w; w.x = pk2(o.x, o.y); w.y = pk2(o.z, o.w);
                *(GAS v2u*)(XN + (size_t)(gw + q * NGW) * DM + col) = w; } }
    } else
    for (int m = gw; m < NLAT; m += 2 * NGW) {
        const int m2 = m + NGW; const bool two = m2 < NLAT;
        f32x4 v[8], u[8];
#pragma unroll
        for (int j = 0; j < 8; ++j) v[j] = *(const GAS f32x4*)(xl + (size_t)m * DM + 4 * lane + 256 * j);
        if (two) {
#pragma unroll
            for (int j = 0; j < 8; ++j) u[j] = *(const GAS f32x4*)(xl + (size_t)m2 * DM + 4 * lane + 256 * j); }
        norm_row_store(v, m, gain, mods, si, XN, lane);
        if (two) norm_row_store(u, m2, gain, mods, si, XN, lane);
    }
    if (nrows > NLAT && NCTX * 4 == NGW) {
        const int wave = gw & 7, r = gw >> 2, m = NLAT + r, col = (gw & 3) * 512 + 8 * lane;
        f32x4 x0 = *(const GAS f32x4*)(xc + (size_t)r * DM + col), x1 = *(const GAS f32x4*)(xc + (size_t)r * DM + col + 4);
        if (part != nullptr)
#pragma nounroll
        for (int s = 0; s < nsplit; s += 8) {
            v4u p[8];
#pragma unroll
            for (int q = 0; q < 8; ++q) p[q] = *(const GAS v4u*)(part + ((size_t)(s + q) * NCTX + r) * DM + col);
#pragma unroll
            for (int q = 0; q < 8; ++q) { x0.x += bflo(p[q].x); x0.y += bfhi(p[q].x); x0.z += bflo(p[q].y); x0.w += bfhi(p[q].y); x1.x += bflo(p[q].z); x1.y += bfhi(p[q].z); x1.z += bflo(p[q].w); x1.w += bfhi(p[q].w); } }
        *(GAS f32x4*)(xs_out + (size_t)m * DM + col) = x0; *(GAS f32x4*)(xs_out + (size_t)m * DM + col + 4) = x1;
        const float ss = wave_sum((x0.x * x0.x + x0.y * x0.y) + (x0.z * x0.z + x0.w * x0.w) + (x1.x * x1.x + x1.y * x1.y) + (x1.z * x1.z + x1.w * x1.w));
        if (lane == 0) red[wave] = ss;
        __syncthreads();
        const LAS float* rq = red + (wave & 4);
        const float rinv = 1.f / sqrtf(((rq[0] + rq[1]) + (rq[2] + rq[3])) * (1.f / DM) + 1e-6f);
        const float* sh = mods + (size_t)(2 * NMOD + si) * DM; const float* scl = sh + DM;
        const f32x4 g0 = *(const GAS f32x4*)(gain + col), g1 = *(const GAS f32x4*)(gain + col + 4), s10 = *(const GAS f32x4*)(scl + col), s11 = *(const GAS f32x4*)(scl + col + 4), s00 = *(const GAS f32x4*)(sh + col), s01 = *(const GAS f32x4*)(sh + col + 4);
        const f32x4 o0 = (x0 * rinv * g0) * (s10 + 1.f) + s00, o1 = (x1 * rinv * g1) * (s11 + 1.f) + s01;
        v4u w; w.x = pk2(o0.x, o0.y); w.y = pk2(o0.z, o0.w); w.z = pk2(o1.x, o1.y); w.w = pk2(o1.z, o1.w);
        *(GAS v4u*)(XN + (size_t)m * DM + col) = w;
        __syncthreads();
    } else
    if (nrows > NLAT && (gw & 3) == 0) for (int r = gw >> 2; r < NCTX; r += NGW >> 2) {
        const int m = NLAT + r;
        f32x4 v[8];
#pragma unroll
        for (int j = 0; j < 8; ++j) v[j] = *(const GAS f32x4*)(xc + (size_t)r * DM + 4 * lane + 256 * j);
        if (part != nullptr)
#pragma nounroll
        for (int s = 0; s < nsplit; s += 4) {
            v2u p[4][8];
#pragma unroll
            for (int q = 0; q < 4; ++q)
#pragma unroll
                for (int j = 0; j < 8; ++j) p[q][j] = *(const GAS v2u*)(part + ((size_t)(s + q) * NCTX + r) * DM + 4 * lane + 256 * j);
#pragma unroll
            for (int q = 0; q < 4; ++q)
#pragma unroll
                for (int j = 0; j < 8; ++j) { v[j].x += bflo(p[q][j].x); v[j].y += bfhi(p[q][j].x); v[j].z += bflo(p[q][j].y); v[j].w += bfhi(p[q][j].y); } }
#pragma unroll
        for (int j = 0; j < 8; ++j) *(GAS f32x4*)(xs_out + (size_t)m * DM + 4 * lane + 256 * j) = v[j];
        norm_row_store(v, m, gain, mods, si, XN, lane);
    }
}

struct RkvkItem { v4u x[3][3]; int m, c0; bool hp, hn; };
__device__ __forceinline__ void rkvk_load(RkvkItem& it, const bf16* P, int i) {
    const int m = i >> 7, c0 = (i & 127) * 8; it.m = m; it.c0 = c0;
    const int t = m < NLAT ? (m & (TSEQ - 1)) : ((m - NLAT) & (TCTX - 1)), tl = m < NLAT ? TSEQ : TCTX;
    it.hp = t > 0; it.hn = t < tl - 1;
#pragma unroll
    for (int sec = 0; sec < 3; ++sec) { const bf16* pc = P + (size_t)m * PROJP + P_RKV + sec * 1024 + c0;
        it.x[sec][1] = *(const GAS v4u*)pc;
        it.x[sec][0] = it.hp ? *(const GAS v4u*)(pc - PROJP) : (v4u){0u, 0u, 0u, 0u};
        it.x[sec][2] = it.hn ? *(const GAS v4u*)(pc + PROJP) : (v4u){0u, 0u, 0u, 0u}; }
}
__device__ __forceinline__ void rkvk_finish(const RkvkItem& it, bf16* RK, const float* cw, const float* kkw) {
    const int c0 = it.c0; float rkv[3][8];
#pragma unroll
    for (int sec = 0; sec < 3; ++sec) { const int col = sec * 1024 + c0; float x0[8], x1[8], x2[8];
        unpack8(it.x[sec][0], x0); unpack8(it.x[sec][1], x1); unpack8(it.x[sec][2], x2);
#pragma unroll
        for (int e = 0; e < 8; ++e) rkv[sec][e] = x1[e] * cw[3072 + col + e] + x0[e] * cw[col + e] + x2[e] * cw[2 * 3072 + col + e]; }
    float kk8[8]; float ss = 0.f;
#pragma unroll
    for (int e = 0; e < 8; ++e) { kk8[e] = rkv[1][e] * kkw[c0 + e]; ss += kk8[e] * kk8[e]; }
    ss += __shfl_xor(ss, 1); ss += __shfl_xor(ss, 2); ss += __shfl_xor(ss, 4);
    const float rinv = 1.f / sqrtf(ss + 1e-12f);
    GAS v4u* dst = (GAS v4u*)(RK + (size_t)it.m * 4096 + c0 * 4);
#pragma unroll
    for (int j = 0; j < 4; ++j) { v4u o; o.x = pk2(rkv[0][2 * j], rkv[1][2 * j]); o.y = pk2(rkv[2][2 * j], kk8[2 * j] * rinv); o.z = pk2(rkv[0][2 * j + 1], rkv[1][2 * j + 1]); o.w = pk2(rkv[2][2 * j + 1], kk8[2 * j + 1] * rinv); dst[j] = o; }
}
__device__ __forceinline__ void ph_e1(const Args& a, int l, int gt, int NGT) {
    const bf16* P = (const bf16*)(a.ws + WS_P); bf16* RK = (bf16*)(a.ws + WS_RKVK);
    const float* cw = a.in[I_CONV] + (size_t)l * 3 * 3072; const float* kkw = a.in[I_KK] + l * 1024;
    constexpr int NI = MT * 128;
    for (int i = gt; i < NI; i += 2 * NGT) {
        RkvkItem A, B; const bool two = i + NGT < NI;
        rkvk_load(A, P, i); if (two) rkvk_load(B, P, i + NGT);
        rkvk_finish(A, RK, cw, kkw); if (two) rkvk_finish(B, RK, cw, kkw);
    }
}

__device__ __forceinline__ void ph_gmlp(const Args& a, int l, LAS unsigned char* lds, int tid, int vcu, int G) {
    constexpr int VP = 136;
    LAS bf16* vnT = (LAS bf16*)lds;
    const bf16* P = (const bf16*)(a.ws + WS_P); bf16* YA = (bf16*)(a.ws + WS_Y3);
    const float* vng = a.in[I_GMVN] + l * 1024; const float* wsm = a.in[I_GMWS] + (size_t)l * 8 * 128 * 128; const float* bs = a.in[I_GMBS] + l * 8 * 128;
    const int lane = tid & 63, w = tid >> 6, fr = lane & 15, fq = lane >> 4;
    for (int u = vcu; u < (MT / 128) * 8; u += G) {
        const int n = u >> 3, g = u & 7, m0 = n * 128;
        { const int q = tid >> 2, qt = tid & 3; const bf16* src = P + (size_t)(m0 + q) * PROJP + P_V + g * 128 + qt * 32;
            float v[32]; float ss = 0.f;
#pragma unroll
            for (int j = 0; j < 4; ++j) { float f[8]; unpack8(*(const GAS v4u*)(src + 8 * j), f);
#pragma unroll
                for (int e = 0; e < 8; ++e) { const float x = f[e]; v[8 * j + e] = x; ss += x * x; } }
            ss += __shfl_xor(ss, 1); ss += __shfl_xor(ss, 2);
            const float rinv = 1.f / sqrtf(ss * (1.f / 128.f) + 1e-6f);
#pragma unroll
            for (int e = 0; e < 32; ++e) { const int c = qt * 32 + e; vnT[c * VP + q] = (bf16)f2bf(v[e] * rinv * vng[g * 128 + c]); } }
        __syncthreads();
        pg8::f32x4 acc[8];
#pragma unroll
        for (int cb = 0; cb < 8; ++cb) acc[cb] = (pg8::f32x4){0.f, 0.f, 0.f, 0.f};
#pragma unroll
        for (int ks = 0; ks < 4; ++ks) {
            const float* wr = wsm + ((size_t)g * 128 + 16 * w + fr) * 128 + ks * 32 + 8 * fq;
            const f32x4 w0 = *(const GAS f32x4*)wr, w1 = *(const GAS f32x4*)(wr + 4);
            v4u aw; aw.x = pk2(w0.x, w0.y); aw.y = pk2(w0.z, w0.w); aw.z = pk2(w1.x, w1.y); aw.w = pk2(w1.z, w1.w);
            const bf16x8 af = __builtin_bit_cast(bf16x8, aw);
#pragma unroll
            for (int cb = 0; cb < 8; ++cb) { const bf16x8 bfr = *(const LAS bf16x8*)(vnT + (cb * 16 + fr) * VP + ks * 32 + 8 * fq);
                acc[cb] = __builtin_amdgcn_mfma_f32_16x16x32_bf16(bfr, af, acc[cb], 0, 0, 0); }
        }
        { const int p = 16 * w + fr; const float bsp = bs[g * 128 + p];
          const bf16* pup = P + (size_t)(m0 + p) * PROJP + P_U + g * 128 + 4 * fq; bf16* yap = YA + (size_t)(m0 + p) * 1024 + g * 128 + 4 * fq;
          v2u pu[8];
#pragma unroll
          for (int cb = 0; cb < 8; ++cb) pu[cb] = *(const GAS v2u*)(pup + cb * 16);
#pragma unroll
          for (int cb = 0; cb < 8; ++cb) { v2u o;
              o.x = pk2(bflo(pu[cb].x) * (acc[cb][0] + bsp), bfhi(pu[cb].x) * (acc[cb][1] + bsp)); o.y = pk2(bflo(pu[cb].y) * (acc[cb][2] + bsp), bfhi(pu[cb].y) * (acc[cb][3] + bsp));
              *(GAS v2u*)(yap + cb * 16) = o; } }
        __syncthreads();
    }
}

namespace att {
using bf16x8 = __attribute__((ext_vector_type(8))) short;
using s16x4  = __attribute__((ext_vector_type(4))) short;
using f32x16 = __attribute__((ext_vector_type(16))) float;
using u32x4  = __attribute__((ext_vector_type(4))) unsigned;
constexpr int NW = 8, QBLK = 32, KVBLK = 64;
constexpr int SHM_V = KVBLK * 128 * 2, SHM_K = KVBLK * 64 * 2, SHM_ATTN = 2 * SHM_V + 2 * SHM_K + NW * 64 * 4;
#define KSWZ(row, colB) ((row) * 128 + ((colB) ^ ((((row) >> 1) & 7) << 4)))
#define SBAR() __builtin_amdgcn_sched_barrier(0)
__device__ __forceinline__ int crow(int r, int hi) { return (r & 3) + 8 * (r >> 2) + 4 * hi; }
__device__ __forceinline__ unsigned cvtpk(float lo, float hi) { unsigned r; asm volatile("v_cvt_pk_bf16_f32 %0, %1, %2" : "=v"(r) : "v"(lo), "v"(hi)); return r; }
__device__ __forceinline__ void partialSM(f32x16& p0, f32x16& p1) {
#pragma unroll
  for (int r = 0; r < 16; ++r) p0[r] = __builtin_amdgcn_exp2f(p0[r]);
}
__device__ __forceinline__ void finishSM(f32x16& p0, f32x16& p1, float& l_reg, bf16x8& pa0, bf16x8& pa1, bf16x8& pa2, bf16x8& pa3) {
#pragma unroll
  for (int r = 0; r < 16; ++r) p1[r] = __builtin_amdgcn_exp2f(p1[r]);
  float ps = 0;
#pragma unroll
  for (int r = 0; r < 16; ++r) ps += p0[r];
#pragma unroll
  for (int r = 0; r < 16; ++r) ps += p1[r];
  { auto rr = __builtin_amdgcn_permlane32_swap(__float_as_uint(ps), __float_as_uint(ps), false, false);
    ps = __uint_as_float(rr[0]) + __uint_as_float(rr[1]); }
  l_reg += ps;
#define PK4(P, BASE, OUT) do { unsigned a0 = cvtpk(P[BASE + 0], P[BASE + 1]), a1 = cvtpk(P[BASE + 2], P[BASE + 3]);   \
    unsigned b0 = cvtpk(P[BASE + 4], P[BASE + 5]), b1 = cvtpk(P[BASE + 6], P[BASE + 7]);                              \
    auto r0 = __builtin_amdgcn_permlane32_swap(a0, b0, false, false); auto r1 = __builtin_amdgcn_permlane32_swap(a1, b1, false, false); \
    u32x4 w = {r0[0], r1[0], r0[1], r1[1]}; OUT = *reinterpret_cast<bf16x8*>(&w); } while (0)
  PK4(p0, 0, pa0); PK4(p0, 8, pa1); PK4(p1, 0, pa2); PK4(p1, 8, pa3);
#undef PK4
}
__device__ __forceinline__ void qkt(f32x16& p0, f32x16& p1, const unsigned short* Ks, const bf16x8* qr, int r32, int hi) {
  p0 = f32x16{}; p1 = f32x16{};
#pragma unroll
  for (int d0 = 0; d0 < 4; ++d0) { int cb = (d0 * 16 + hi * 8) * 2;
    bf16x8 b0 = *reinterpret_cast<const bf16x8*>((const char*)Ks + KSWZ(r32, cb));
    bf16x8 b1 = *reinterpret_cast<const bf16x8*>((const char*)Ks + KSWZ(32 + r32, cb));
    p0 = __builtin_amdgcn_mfma_f32_32x32x16_bf16(b0, qr[d0], p0, 0, 0, 0);
    p1 = __builtin_amdgcn_mfma_f32_32x32x16_bf16(b1, qr[d0], p1, 0, 0, 0); }
}
__device__ __forceinline__ int v_st(int k, int c) { const int kk = (k & ~0xC) | ((k & 4) << 1) | ((k & 8) >> 1); return ((kk >> 3) * 4 + (c >> 5)) * 512 + ((kk & 7) * 32 + (c & 31)) * 2; }
__device__ __forceinline__ int v_rd_base(int lane) { return ((lane & 3) << 3) | (((lane >> 2) & 3) << 6) | (((lane >> 4) & 1) << 5) | (((lane >> 5) & 1) << 8); }
constexpr int v_rd_off(int d0, int ks, int half) { return d0 * 512 + ks * 4096 + half * 2048; }
template <int OFF> __device__ __forceinline__ s16x4 tr_read(int vb) {
  s16x4 r; asm volatile("ds_read_b64_tr_b16 %0, %1 offset:%2" : "=&v"(r) : "v"(vb), "i"(OFF) : "memory"); return r;
}
template <int D0> __device__ __forceinline__ void pv_one(f32x16& od, int vb, bf16x8 pa0, bf16x8 pa1, bf16x8 pa2, bf16x8 pa3) {
  const s16x4 l0 = tr_read<v_rd_off(D0, 0, 0)>(vb), h0 = tr_read<v_rd_off(D0, 0, 1)>(vb), l1 = tr_read<v_rd_off(D0, 1, 0)>(vb), h1 = tr_read<v_rd_off(D0, 1, 1)>(vb);
  const s16x4 l2 = tr_read<v_rd_off(D0, 2, 0)>(vb), h2 = tr_read<v_rd_off(D0, 2, 1)>(vb), l3 = tr_read<v_rd_off(D0, 3, 0)>(vb), h3 = tr_read<v_rd_off(D0, 3, 1)>(vb);
  asm volatile("s_waitcnt lgkmcnt(0)" ::: "memory"); SBAR();
#define PK(L, H) (bf16x8){L[0], L[1], L[2], L[3], H[0], H[1], H[2], H[3]}
  od = __builtin_amdgcn_mfma_f32_32x32x16_bf16(pa0, PK(l0, h0), od, 0, 0, 0);
  od = __builtin_amdgcn_mfma_f32_32x32x16_bf16(pa1, PK(l1, h1), od, 0, 0, 0);
  od = __builtin_amdgcn_mfma_f32_32x32x16_bf16(pa2, PK(l2, h2), od, 0, 0, 0);
  od = __builtin_amdgcn_mfma_f32_32x32x16_bf16(pa3, PK(l3, h3), od, 0, 0, 0);
#undef PK
}
__device__ __forceinline__ void pv_d0(f32x16* o, int vb, bf16x8 pa0, bf16x8 pa1, bf16x8 pa2, bf16x8 pa3) {
  pv_one<0>(o[0], vb, pa0, pa1, pa2, pa3); pv_one<1>(o[1], vb, pa0, pa1, pa2, pa3); pv_one<2>(o[2], vb, pa0, pa1, pa2, pa3); pv_one<3>(o[3], vb, pa0, pa1, pa2, pa3);
}
__device__ __forceinline__ void attn_unit(const unsigned short* __restrict__ Qb, const unsigned short* __restrict__ Kb, const unsigned short* __restrict__ Vb,
                                          unsigned short* __restrict__ Ob, int NT, int ntl, int klat, int kctx, char* lds) {
  constexpr int LDQ = 2048, LDKK = 2048, LDV = 15104, LDO = 1024;
  const int tid = threadIdx.x, wid = tid >> 6, lane = tid & 63, r32 = lane & 31, hi = lane >> 5;
  unsigned short* V_lds = (unsigned short*)lds; unsigned short* K_lds = (unsigned short*)(lds + 2 * SHM_V);
  float* ws = (float*)(lds + 2 * SHM_V + 2 * SHM_K) + wid * 64; float* li_l = ws;
  float l_reg = 0; f32x16 o[4] = {}; bf16x8 qr[4];
  const unsigned short* Qw = Qb + (long)(wid * QBLK + r32) * LDQ + hi * 8;
#pragma unroll
  for (int d0 = 0; d0 < 4; ++d0) qr[d0] = *reinterpret_cast<const bf16x8*>(Qw + d0 * 16);
  const int sr = tid >> 4, sc = (tid & 15) * 8, vst0 = v_st(sr, sc), vst1 = v_st(32 + sr, sc);
  const int kr = tid >> 3, kc = (tid & 7) * 8, kst = KSWZ(kr, kc * 2);
  const int vb0 = (int)(uintptr_t)V_lds + v_rd_base(lane);
  struct { bf16x8 vs0, vs1, ks0; } sr_[2];
#define KROW(t) ((t) < ntl ? klat + 64 * (t) : kctx + 64 * ((t) - ntl))
#define SLOAD(i, t) do { const long k0_ = KROW(t); sr_[i].vs0 = *reinterpret_cast<const bf16x8*>(&Vb[(k0_ + sr) * LDV + sc]); sr_[i].vs1 = *reinterpret_cast<const bf16x8*>(&Vb[(k0_ + 32 + sr) * LDV + sc]); \
    sr_[i].ks0 = *reinterpret_cast<const bf16x8*>(&Kb[(k0_ + kr) * LDKK + kc]); } while (0)
#define SWRITE(b, i) do { *(bf16x8*)((char*)V_lds + (b) * SHM_V + vst0) = sr_[i].vs0; *(bf16x8*)((char*)V_lds + (b) * SHM_V + vst1) = sr_[i].vs1; \
    *(bf16x8*)((char*)K_lds + (b) * SHM_K + kst) = sr_[i].ks0; } while (0)
#define SWAIT() asm volatile("s_waitcnt vmcnt(3)" ::: "memory")
  f32x16 pA0, pA1, pB0, pB1; bf16x8 pa0, pa1, pa2, pa3;
  constexpr int SE = 0, SO = 1;
  SLOAD(SE, 0); asm volatile("s_waitcnt vmcnt(0)" ::: "memory"); SWRITE(0, SE); __syncthreads();
  qkt(pA0, pA1, K_lds, qr, r32, hi); partialSM(pA0, pA1);
  SLOAD(SO, 1); if (2 < NT) SLOAD(SE, 2);
  SWAIT(); SWRITE(1, SO); __syncthreads();
  for (int j = 1; j + 1 < NT; j += 2) {
    SBAR(); qkt(pB0, pB1, (const unsigned short*)((char*)K_lds + SHM_K), qr, r32, hi);
    finishSM(pA0, pA1, l_reg, pa0, pa1, pa2, pa3); SBAR();
    SLOAD(SO, j + 2); SBAR();
    pv_d0(o, vb0, pa0, pa1, pa2, pa3); partialSM(pB0, pB1);
    __syncthreads(); SWAIT(); SWRITE(0, SE);
    __syncthreads();
    SBAR(); qkt(pA0, pA1, K_lds, qr, r32, hi);
    finishSM(pB0, pB1, l_reg, pa0, pa1, pa2, pa3); SBAR();
    if (j + 3 < NT) SLOAD(SE, j + 3); SBAR();
    pv_d0(o, vb0 + (int)SHM_V, pa0, pa1, pa2, pa3); partialSM(pA0, pA1);
    __syncthreads(); SWAIT(); SWRITE(1, SO);
    __syncthreads();
  }
  SBAR(); qkt(pB0, pB1, (const unsigned short*)((char*)K_lds + SHM_K), qr, r32, hi);
  finishSM(pA0, pA1, l_reg, pa0, pa1, pa2, pa3); SBAR();
  pv_d0(o, vb0, pa0, pa1, pa2, pa3); partialSM(pB0, pB1);
  __syncthreads();
  finishSM(pB0, pB1, l_reg, pa0, pa1, pa2, pa3); SBAR();
  pv_d0(o, vb0 + (int)SHM_V, pa0, pa1, pa2, pa3);
  if (hi == 0) li_l[r32] = l_reg; asm volatile("s_waitcnt lgkmcnt(0)" ::: "memory");
  float rli[16];
#pragma unroll
  for (int r = 0; r < 16; ++r) rli[r] = __builtin_amdgcn_rcpf(li_l[crow(r, hi)]);
  unsigned short* Ow = Ob + (long)(wid * QBLK) * LDO;
#pragma unroll
  for (int r = 0; r < 16; ++r) { int orow = crow(r, hi);
#pragma unroll
    for (int d0 = 0; d0 < 4; ++d0) Ow[(long)orow * LDO + d0 * 32 + r32] = (unsigned short)(cvtpk(o[d0][r] * rli[r], 0.f) & 0xffffu); }
  __syncthreads();
#undef KROW
#undef SLOAD
#undef SWRITE
#undef SWAIT
}
#undef KSWZ
#undef SBAR
}

__device__ __forceinline__ void ph_attn_one(const Args& a, int u, char* lds) {
    const unsigned short* QK = (const unsigned short*)(a.ws + WS_QK); const unsigned short* P = (const unsigned short*)(a.ws + WS_P); unsigned short* OJ = (unsigned short*)(a.ws + WS_OJ);
    int b, hj, qrow0, NT, ntl;
    if (u < 512) { b = u >> 8; hj = (u >> 4) & 15; qrow0 = b * TSEQ + (u & 15) * 256; NT = 68; ntl = 64; }
    else { const int uu = u - 512; b = uu >> 4; hj = uu & 15; qrow0 = NLAT + b * TCTX; NT = 4; ntl = 0; }
    att::attn_unit(QK + (size_t)qrow0 * DM + hj * 64, QK + 1024 + hj * 64, P + P_V2 + (hj >> 1) * 128,
                   OJ + ((size_t)(hj & 1) * MT + qrow0) * 1024 + (hj >> 1) * 128, NT, ntl, b * TSEQ, NLAT + b * TCTX, lds);
}
__device__ __forceinline__ void ph_attn(const Args& a, char* lds, int u0, int ustep, int uend, int cu) {
    bool done = false;
    for (int u = u0; !done; u += ustep) { int uu = u; if (u >= uend) { if (cu < 0) break; uu = 512 + cu; done = true; } ph_attn_one(a, uu, lds); }
}

__device__ __forceinline__ int scan_row(int i, int b, int d) { return i < TCTX ? NLAT + b * TCTX + (d ? TCTX - 1 - i : i) : b * TSEQ + (d ? TSEQ - 1 - (i - TCTX) : (i - TCTX)); }
typedef __amdgpu_buffer_rsrc_t rsrc_t;
typedef short s16x4 __attribute__((ext_vector_type(4)));
typedef __bf16 bf16x2_t __attribute__((ext_vector_type(2)));
typedef float f32x2_t __attribute__((ext_vector_type(2)));
__device__ __forceinline__ unsigned cvtpk_c(float lo, float hi) { f32x2_t v = {lo, hi}; bf16x2_t b = __builtin_convertvector(v, bf16x2_t); return __builtin_bit_cast(unsigned, b); }
constexpr int CS_SLOT = 12288, CS_NSLOT = 8, CS_OFF_A1 = 0, CS_OFF_RH = 2048, CS_OFF_MT = 4352, CS_OFF_Q = 4864, CS_OFF_P = 5376, CS_OFF_KB = 5888, CS_OFF_V = 9984, CS_OFF_G = 12032;
constexpr int CS_PITCH = 144, CS_SCR0 = CS_NSLOT * CS_SLOT, CS_SCR = 8192, CS_S_KK = 0, CS_S_KD = 2304, CS_S_NB = 4608, CS_S_U = 6912;
static_assert(CS_SCR0 + 4 * CS_SCR <= RING_BYTES, "scan LDS");
__device__ __forceinline__ pg8::f32x4 mfma32(bf16x8 a_, bf16x8 b_, pg8::f32x4 c_) { return __builtin_amdgcn_mfma_f32_16x16x32_bf16(a_, b_, c_, 0, 0, 0); }
__device__ __forceinline__ pg8::f32x4 mfma16(v2u a_, v2u b_, pg8::f32x4 c_) { return __builtin_amdgcn_mfma_f32_16x16x16bf16_1k(__builtin_bit_cast(s16x4, a_), __builtin_bit_cast(s16x4, b_), c_, 0, 0, 0); }
__device__ __forceinline__ v2u pack4(const pg8::f32x4 x) { return (v2u){cvtpk_c(x[0], x[1]), cvtpk_c(x[2], x[3])}; }
__device__ __forceinline__ void scan_unit(const Args& a, int l, int u, LAS unsigned char* lds, int tid) {
    const int lane = tid & 63, w = __builtin_amdgcn_readfirstlane(tid >> 6), fr = lane & 15, fq = lane >> 4;
    const int b = u >> 5, h = (u >> 1) & 15, d = u & 1;
    constexpr int NBLK = (TCTX + TSEQ) / 16, NR = NBLK / 4;
    const bf16* LO = (const bf16*)(a.ws + WS_R1); const bf16* RK = (const bf16*)(a.ws + WS_RKVK); bf16* YS = (bf16*)(a.ws + WS_YS);
    const pg8::f32x4 zero4 = (pg8::f32x4){0.f, 0.f, 0.f, 0.f};
    v2u E4[4], A4[4]; v4u R0[4], R1[4];
    float kav[4];
    const int pw = w - 4;
    LAS unsigned char* scr = lds + CS_SCR0 + (pw & 3) * CS_SCR;
    const int dirs = d ? -1 : 1;
    int eoff[4], roff[4], yoff[4];
#pragma unroll
    for (int i = 0; i < 4; ++i) { const int s_ = dirs * (4 * fq + i); eoff[i] = s_ * LOW + 4 * fr; roff[i] = s_ * 4096 + 16 * fr; yoff[i] = s_ * 1024 + fr; }
#define CS_LOAD(blk_) do { const int m0_ = scan_row((blk_) * 16, b, d); const bf16* lob_ = LO + (size_t)m0_ * LOW + 1024 + d * 1024 + h * 64; const bf16* rkb_ = RK + ((size_t)m0_ * 16 + h) * 256; \
        _Pragma("unroll") for (int i = 0; i < 4; ++i) { E4[i] = *(const GAS v2u*)(lob_ + eoff[i]); A4[i] = *(const GAS v2u*)(lob_ + 2048 + eoff[i]); \
        const GAS v4u* rk_ = (const GAS v4u*)(rkb_ + roff[i]); R0[i] = rk_[0]; R1[i] = rk_[1]; } } while (0)
    if (w >= 4) {
#pragma unroll
        for (int c = 0; c < 4; ++c) kav[c] = a.in[I_KA][l * 1024 + h * 64 + 4 * fr + c];
        CS_LOAD(pw);
    }
    pg8::f32x4 S0 = zero4, S1 = zero4, S2 = zero4, S3 = zero4;
    for (int rr = 0; rr <= NR; ++rr) {
        if (w >= 4) {
            if (rr < NR) {
                const int blk = 4 * rr + pw;
                LAS unsigned char* slot = lds + (blk % CS_NSLOT) * CS_SLOT;
                float Ef[4][4], af[4][4], Lin[4][4];
#pragma unroll
                for (int i = 0; i < 4; ++i) { Ef[i][0] = bflo(E4[i].x); Ef[i][1] = bfhi(E4[i].x); Ef[i][2] = bflo(E4[i].y); Ef[i][3] = bfhi(E4[i].y);
                    af[i][0] = bflo(A4[i].x); af[i][1] = bfhi(A4[i].x); af[i][2] = bflo(A4[i].y); af[i][3] = bfhi(A4[i].y); }
                float pre[4], L15[4], G15[4];
#pragma unroll
                for (int c = 0; c < 4; ++c) { float acc = 0.f;
#pragma unroll
                    for (int i = 0; i < 4; ++i) { acc += Ef[i][c]; Lin[i][c] = acc; }
                    const float t1 = __shfl_up(acc, 16); float cum = acc + (fq >= 1 ? t1 : 0.f);
                    const float t2 = __shfl_up(cum, 32); cum += (fq >= 2 ? t2 : 0.f);
                    pre[c] = cum - acc; L15[c] = __shfl(cum, fr + 48); G15[c] = __builtin_amdgcn_exp2f(-L15[c]); }
                float kkh[4][4], kdg[4][4], nbg[4][4]; unsigned vraw[4][4];
                const int posb = ((fr >> 2) * 8 + (fr & 3) * 2) * 2;
#pragma unroll
                for (int i = 0; i < 4; ++i) {
                    float kdh_[4], nbh_[4], rh_[4];
#pragma unroll
                    for (int c = 0; c < 4; ++c) {
                        const unsigned rk_ = c == 0 ? R0[i].x : c == 1 ? R0[i].z : c == 2 ? R1[i].x : R1[i].z, vk_ = c == 0 ? R0[i].y : c == 1 ? R0[i].w : c == 2 ? R1[i].y : R1[i].w;
                        const float r_ = bflo(rk_), k_ = bfhi(rk_), kk_ = bfhi(vk_), a_ = af[i][c];
                        vraw[i][c] = vk_ & 0xffffu;
                        const float Lf = pre[c] + Lin[i][c];
                        const float eL = __builtin_amdgcn_exp2f(Lf), eN = __builtin_amdgcn_rcpf(eL), ekk = __builtin_amdgcn_exp2f(Ef[i][c] - Lf);
                        const float kd = k_ * (1.f + (a_ - 1.f) * kav[c]);
                        kdh_[c] = kd * eL; nbh_[c] = -(kk_ * a_ * eL); kkh[i][c] = kk_ * ekk; rh_[c] = r_ * eN;
                        kdg[i][c] = kdh_[c] * G15[c]; nbg[i][c] = nbh_[c] * G15[c];
                    }
                    const int rb = (4 * fq + i) * CS_PITCH + posb;
                    *(LAS unsigned*)(scr + CS_S_KK + rb) = cvtpk_c(kkh[i][0], kkh[i][1]); *(LAS unsigned*)(scr + CS_S_KK + rb + 64) = cvtpk_c(kkh[i][2], kkh[i][3]);
                    *(LAS unsigned*)(scr + CS_S_KD + rb) = cvtpk_c(kdh_[0], kdh_[1]); *(LAS unsigned*)(scr + CS_S_KD + rb + 64) = cvtpk_c(kdh_[2], kdh_[3]);
                    *(LAS unsigned*)(scr + CS_S_NB + rb) = cvtpk_c(nbh_[0], nbh_[1]); *(LAS unsigned*)(scr + CS_S_NB + rb + 64) = cvtpk_c(nbh_[2], nbh_[3]);
                    *(LAS unsigned*)(slot + CS_OFF_RH + rb) = cvtpk_c(rh_[0], rh_[1]); *(LAS unsigned*)(slot + CS_OFF_RH + rb + 64) = cvtpk_c(rh_[2], rh_[3]);
                }
                if (rr + 1 < NR) CS_LOAD(blk + 4);
#pragma unroll
                for (int c = 0; c < 4; ++c) {
                    *(LAS v4u*)(slot + CS_OFF_KB + c * 1024 + lane * 16) = (v4u){cvtpk_c(kdg[0][c], kdg[1][c]), cvtpk_c(kdg[2][c], kdg[3][c]), cvtpk_c(nbg[0][c], nbg[1][c]), cvtpk_c(nbg[2][c], nbg[3][c])};
                    const int j = 4 * fr + c;
                    *(LAS v2u*)(slot + CS_OFF_V + (((j >> 4) * 4 + fq) * 16 + (j & 15)) * 8) = (v2u){vraw[0][c] | (vraw[1][c] << 16), vraw[2][c] | (vraw[3][c] << 16)};
                }
                if (fq == 0) *(LAS pg8::f32x4*)(slot + CS_OFF_G + fr * 16) = (pg8::f32x4){G15[0], G15[1], G15[2], G15[3]};
                asm volatile("s_waitcnt lgkmcnt(0)" ::: "memory");
                const LAS unsigned char* fa = scr + fr * CS_PITCH + fq * 16; const LAS unsigned char* fh = slot + CS_OFF_RH + fr * CS_PITCH + fq * 16;
                const bf16x8 KK0 = *(const LAS bf16x8*)(fa + CS_S_KK), KK1 = *(const LAS bf16x8*)(fa + CS_S_KK + 64), KD0 = *(const LAS bf16x8*)(fa + CS_S_KD), KD1 = *(const LAS bf16x8*)(fa + CS_S_KD + 64);
                const bf16x8 NB0 = *(const LAS bf16x8*)(fa + CS_S_NB), NB1 = *(const LAS bf16x8*)(fa + CS_S_NB + 64), RH0 = *(const LAS bf16x8*)(fh), RH1 = *(const LAS bf16x8*)(fh + 64);
                pg8::f32x4 dn1 = mfma32(NB1, KK1, mfma32(NB0, KK0, zero4));
                pg8::f32x4 dn1t = mfma32(KK1, NB1, mfma32(KK0, NB0, zero4));
                pg8::f32x4 dmt = mfma32(KK1, KD1, mfma32(KK0, KD0, zero4));
                pg8::f32x4 dq = mfma32(KD1, RH1, mfma32(KD0, RH0, zero4));
                pg8::f32x4 dp = mfma32(NB1, RH1, mfma32(NB0, RH0, zero4));
                pg8::f32x4 idm;
#pragma unroll
                for (int i = 0; i < 4; ++i) { const int row = 4 * fq + i;
                    dn1[i] = row < fr ? dn1[i] : 0.f; dn1t[i] = fr < row ? dn1t[i] : 0.f; dmt[i] = fr < row ? dmt[i] : 0.f; dq[i] = row <= fr ? dq[i] : 0.f; dp[i] = row <= fr ? dp[i] : 0.f;
                    idm[i] = row == fr ? 1.f : 0.f; }
                const v2u pX = pack4(dn1), pXT = pack4(dn1t);
                const pg8::f32x4 x2 = mfma16(pXT, pX, zero4), x2t = mfma16(pX, pXT, zero4);
                const v2u pX2 = pack4(x2), pX2T = pack4(x2t);
                const pg8::f32x4 x4 = mfma16(pX2T, pX2, zero4), x4t = mfma16(pX2, pX2T, zero4);
                const v2u pX4 = pack4(x4), pX4T = pack4(x4t);
                const pg8::f32x4 x8 = mfma16(pX4T, pX4, zero4);
                const pg8::f32x4 t1 = idm + dn1, t1t = idm + dn1t;
                const v2u pT1T = pack4(t1t);
                const pg8::f32x4 t2 = mfma16(pT1T, pX2, t1), t2t = mfma16(pX2, pT1T, t1t);
                const v2u pT2T = pack4(t2t);
                const pg8::f32x4 t3 = mfma16(pT2T, pX4, t2), t3t = mfma16(pX4, pT2T, t2t);
                const pg8::f32x4 dt = mfma16(pack4(t3t), pack4(x8), t3);
                const v2u DTb = pack4(dt);
                pg8::f32x4 da1[4];
#pragma unroll
                for (int c = 0; c < 4; ++c) da1[c] = mfma16((v2u){cvtpk_c(kkh[0][c], kkh[1][c]), cvtpk_c(kkh[2][c], kkh[3][c])}, DTb, zero4);
                const pg8::f32x4 dmt2 = mfma16(pack4(dmt), DTb, zero4);
#pragma unroll
                for (int hh = 0; hh < 2; ++hh)
                    *(LAS v4u*)(slot + CS_OFF_A1 + hh * 1024 + lane * 16) = (v4u){cvtpk_c(da1[2 * hh][0], da1[2 * hh + 1][0]), cvtpk_c(da1[2 * hh][1], da1[2 * hh + 1][1]), cvtpk_c(da1[2 * hh][2], da1[2 * hh + 1][2]), cvtpk_c(da1[2 * hh][3], da1[2 * hh + 1][3])};
                *(LAS v2u*)(slot + CS_OFF_MT + lane * 8) = pack4(dmt2); *(LAS v2u*)(slot + CS_OFF_Q + lane * 8) = pack4(dq); *(LAS v2u*)(slot + CS_OFF_P + lane * 8) = pack4(dp);
            }
        } else if (rr >= 1) {
#pragma nounroll
            for (int q = 0; q < 4; ++q) {
                const int blk = 4 * (rr - 1) + q;
                const LAS unsigned char* slot = lds + (blk % CS_NSLOT) * CS_SLOT;
                const bf16x8 A10 = *(const LAS bf16x8*)(slot + CS_OFF_A1 + lane * 16), A11 = *(const LAS bf16x8*)(slot + CS_OFF_A1 + 1024 + lane * 16);
                const bf16x8 RH0 = *(const LAS bf16x8*)(slot + CS_OFF_RH + fr * CS_PITCH + fq * 16), RH1 = *(const LAS bf16x8*)(slot + CS_OFF_RH + fr * CS_PITCH + fq * 16 + 64);
                const v2u MTo = *(const LAS v2u*)(slot + CS_OFF_MT + lane * 8), Qo = *(const LAS v2u*)(slot + CS_OFF_Q + lane * 8), Po = *(const LAS v2u*)(slot + CS_OFF_P + lane * 8);
                const v2u Vo = *(const LAS v2u*)(slot + CS_OFF_V + (w * 64 + lane) * 8);
                const bf16x8 KB0 = *(const LAS bf16x8*)(slot + CS_OFF_KB + lane * 16), KB1 = *(const LAS bf16x8*)(slot + CS_OFF_KB + 1024 + lane * 16), KB2 = *(const LAS bf16x8*)(slot + CS_OFF_KB + 2048 + lane * 16), KB3 = *(const LAS bf16x8*)(slot + CS_OFF_KB + 3072 + lane * 16);
                pg8::f32x4 Gi[4];
#pragma unroll
                for (int i = 0; i < 4; ++i) Gi[i] = *(const LAS pg8::f32x4*)(slot + CS_OFF_G + (16 * fq + 4 * i) * 4);
                const v4u bs0 = (v4u){cvtpk_c(S0[0], S1[0]), cvtpk_c(S0[1], S1[1]), cvtpk_c(S0[2], S1[2]), cvtpk_c(S0[3], S1[3])};
                const v4u bs1 = (v4u){cvtpk_c(S2[0], S3[0]), cvtpk_c(S2[1], S3[1]), cvtpk_c(S2[2], S3[2]), cvtpk_c(S2[3], S3[3])};
                const bf16x8 BS0 = __builtin_bit_cast(bf16x8, bs0), BS1 = __builtin_bit_cast(bf16x8, bs1);
                const pg8::f32x4 c1 = mfma16(MTo, Vo, zero4);
                const pg8::f32x4 sa = mfma32(A11, BS1, mfma32(A10, BS0, c1));
                const v2u SAo = pack4(sa);
                pg8::f32x4 y = mfma32(RH1, BS1, mfma32(RH0, BS0, zero4));
                y = mfma16(Qo, Vo, y); y = mfma16(Po, SAo, y);
                const bf16x8 BV = __builtin_bit_cast(bf16x8, (v4u){Vo.x, Vo.y, SAo.x, SAo.y});
                pg8::f32x4 g0, g1, g2, g3;
#pragma unroll
                for (int i = 0; i < 4; ++i) { g0[i] = S0[i] * Gi[i][0]; g1[i] = S1[i] * Gi[i][1]; g2[i] = S2[i] * Gi[i][2]; g3[i] = S3[i] * Gi[i][3]; }
                S0 = mfma32(KB0, BV, g0); S1 = mfma32(KB1, BV, g1); S2 = mfma32(KB2, BV, g2); S3 = mfma32(KB3, BV, g3);
                { bf16* ysb = YS + ((size_t)d * MT + scan_row(blk * 16, b, d)) * 1024 + h * 64 + 16 * w;
#pragma unroll
                  for (int i = 0; i < 4; ++i) ysb[yoff[i]] = (bf16)(cvtpk_c(y[i], 0.f) & 0xffffu); }
            }
        }
        asm volatile("s_waitcnt lgkmcnt(0)" ::: "memory"); __builtin_amdgcn_s_barrier(); asm volatile("" ::: "memory");
    }
#undef CS_LOAD
    asm volatile("s_waitcnt vmcnt(0) lgkmcnt(0)" ::: "memory"); __syncthreads();
}

__device__ __forceinline__ void ph_rwkv_out(const Args& a, int l, int nrows, int gt, int NGT) {
    const bf16* OJ = (const bf16*)(a.ws + WS_OJ); bf16* YC = (bf16*)(a.ws + WS_Y3) + (size_t)2 * MT * 1024;
    const float* subln = a.in[I_SUBLN] + l * 128;
    float lam, lam_init;
    { const int lane = threadIdx.x & 63; const float* lv = a.in[I_LAM] + l * 256;
      float l1 = lv[lane] * lv[64 + lane], l2 = lv[128 + lane] * lv[192 + lane]; l1 = wave_sum(l1); l2 = wave_sum(l2);
      lam_init = 0.8f - 0.6f * __expf(-0.3f * (float)l); lam = __expf(l1) - __expf(l2) + lam_init;
      float gb = fabsf(a.in[I_QN][l * 64 + lane] * a.in[I_KN][l * 64 + lane]);
#pragma unroll
      for (int o_ = 1; o_ < 64; o_ <<= 1) gb = fmaxf(gb, __shfl_xor(gb, o_));
      if (gb > 8.f) lam = __builtin_nanf(""); }
    const bf16* LO = (const bf16*)(a.ws + WS_R1); const bf16* RK = (const bf16*)(a.ws + WS_RKVK); const bf16* YS = (const bf16*)(a.ws + WS_YS);
    bf16* YB = (bf16*)(a.ws + WS_Y3) + (size_t)MT * 1024;
    const float* ka = a.in[I_KA] + l * 1024; const float* rkw = a.in[I_RK] + l * 1024; const float* lng = a.in[I_LNG] + l * 1024; const float* lnb = a.in[I_LNB] + l * 1024;
    for (int i = gt; i < nrows * 128; i += 2 * NGT) {
        v4u L[2][11]; const bool two = i + NGT < nrows * 128;
#pragma unroll
        for (int s = 0; s < 2; ++s) if (s == 0 || two) { const int ii = i + s * NGT, m = ii >> 7, c0 = (ii & 127) * 8;
            L[s][0] = *(const GAS v4u*)(YS + (size_t)m * 1024 + c0); L[s][1] = *(const GAS v4u*)(YS + ((size_t)MT + m) * 1024 + c0);
            const GAS v4u* rp = (const GAS v4u*)(RK + (size_t)m * 4096 + c0 * 4);
            L[s][2] = rp[0]; L[s][3] = rp[1]; L[s][4] = rp[2]; L[s][5] = rp[3];
            const bf16* lo = LO + (size_t)m * LOW + c0;
            L[s][6] = *(const GAS v4u*)lo; L[s][7] = *(const GAS v4u*)(lo + 3072); L[s][8] = *(const GAS v4u*)(lo + 4096);
            L[s][9] = *(const GAS v4u*)(OJ + (size_t)m * 1024 + c0); L[s][10] = *(const GAS v4u*)(OJ + ((size_t)MT + m) * 1024 + c0); }
#pragma unroll
        for (int s = 0; s < 2; ++s) if (s == 0 || two) {
        const int ii = i + s * NGT, m = ii >> 7, c0 = (ii & 127) * 8;
        const v4u ya = L[s][0], yb = L[s][1], q0 = L[s][2], q1 = L[s][3], q2 = L[s][4], q3 = L[s][5], gw_ = L[s][6], aw0 = L[s][7], aw1 = L[s][8], pw = L[s][9], ow = L[s][10];
        float yA[8], yB[8], gv[8], a0v[8], a1v[8], pv[8], ov[8];
        unpack8(ya, yA); unpack8(yb, yB); unpack8(gw_, gv); unpack8(aw0, a0v); unpack8(aw1, a1v); unpack8(pw, pv); unpack8(ow, ov);
        float y[8]; float s1 = 0.f;
#pragma unroll
        for (int e = 0; e < 8; ++e) y[e] = yA[e] + yB[e];
#pragma unroll
        for (int e = 0; e < 8; ++e) s1 += y[e];
        s1 += __shfl_xor(s1, 1); s1 += __shfl_xor(s1, 2); s1 += __shfl_xor(s1, 4);
        const float mu = s1 * (1.f / 64.f); float s2 = 0.f;
#pragma unroll
        for (int e = 0; e < 8; ++e) { y[e] -= mu; s2 += y[e] * y[e]; }
        s2 += __shfl_xor(s2, 1); s2 += __shfl_xor(s2, 2); s2 += __shfl_xor(s2, 4);
        const float rstd = 1.f / sqrtf(s2 * (1.f / 64.f) + 64e-5f);
        float r[8], k[8], v[8];
        r[0] = bflo(q0.x); k[0] = bfhi(q0.x); v[0] = bflo(q0.y); r[1] = bflo(q0.z); k[1] = bfhi(q0.z); v[1] = bflo(q0.w);
        r[2] = bflo(q1.x); k[2] = bfhi(q1.x); v[2] = bflo(q1.y); r[3] = bflo(q1.z); k[3] = bfhi(q1.z); v[3] = bflo(q1.w);
        r[4] = bflo(q2.x); k[4] = bfhi(q2.x); v[4] = bflo(q2.y); r[5] = bflo(q2.z); k[5] = bfhi(q2.z); v[5] = bflo(q2.w);
        r[6] = bflo(q3.x); k[6] = bfhi(q3.x); v[6] = bflo(q3.y); r[7] = bflo(q3.z); k[7] = bfhi(q3.z); v[7] = bflo(q3.w);
        float am[8];
#pragma unroll
        for (int e = 0; e < 8; ++e) am[e] = 0.5f * (a0v[e] + a1v[e]);
        float rk = 0.f;
#pragma unroll
        for (int e = 0; e < 8; ++e) { const int c = c0 + e; rk += r[e] * (k[e] * (1.f + (am[e] - 1.f) * ka[c])) * rkw[c]; }
        rk += __shfl_xor(rk, 1); rk += __shfl_xor(rk, 2); rk += __shfl_xor(rk, 4);
        float o[8];
#pragma unroll
        for (int e = 0; e < 8; ++e) { const int c = c0 + e; o[e] = (y[e] * rstd * lng[c] + lnb[c] + rk * v[e]) * gv[e]; }
        *(GAS v4u*)(YB + (size_t)m * 1024 + c0) = pack8(o);
        { float d[8];
#pragma unroll
          for (int e = 0; e < 8; ++e) d[e] = pv[e] - lam * ov[e];
          float ss = 0.f;
#pragma unroll
          for (int e = 0; e < 8; ++e) ss += d[e] * d[e];
          ss += __shfl_xor(ss, 1); ss += __shfl_xor(ss, 2); ss += __shfl_xor(ss, 4); ss += __shfl_xor(ss, 8);
          const float rinv = (1.f - lam_init) / sqrtf(ss * (1.f / 128.f) + 1e-6f);
#pragma unroll
          for (int e = 0; e < 8; ++e) d[e] = d[e] * rinv * subln[(c0 & 127) + e];
          *(GAS v4u*)(YC + (size_t)m * 1024 + c0) = pack8(d); }
        }
    }
}

constexpr int PH_PER_LAYER = 14, NPH = 1 + NLAYER * PH_PER_LAYER;
#define IN(k) (lo <= (k) && (k) < hi)
#define SEAM(k) do { if (IN(k) && IN((k) + 1)) xcd_barrier(bar); } while (0)
#ifndef ONLY_PH
#define ONLY_PH -1
#endif
#define INL(k) ((ONLY_PH < 0 || ONLY_PH == (k)) && IN(pb + (k)))
#define SEAML(k) SEAM(pb + (k))
#ifndef PROBE_REP
#define PROBE_REP 0
#endif
#define REPL(k) for (int rep_ = 0; rep_ < (((PROBE_REP) >> (k)) & 1) + 1; ++rep_)
template <int l> __device__ __forceinline__ void layer_body(const Args& args, LAS unsigned char* lds, unsigned char* lds_raw, unsigned char* ws, const XcdBarrier& bar, int lo, int hi, int tid, int lane, int G, int bx, int vcu, int gw, int NGW, int gt, int NGT) {
        const int pb = 1 + l * PH_PER_LAYER;
        const bool last = (l == NLAYER - 1);
        float* XS = (float*)(ws + WS_XS); pg8::bf16_t* PART = (pg8::bf16_t*)(ws + WS_PART);
        const float* mods = (const float*)(ws + WS_MODS) + (size_t)l * 3 * NMOD * DM;
        const float* normg = args.in[I_NORMG] + (size_t)l * 3 * DM;
        pg8::bf16_t* XN = (pg8::bf16_t*)(ws + WS_XN);
        pg8::bf16_t* Hb = (pg8::bf16_t*)(ws + WS_R1);
        const float* xl0 = (l == 0) ? args.in[I_X] : XS; const float* xc0 = (l == 0) ? args.in[I_CTX] : XS + (size_t)NLAT * DM;

        if (INL(0)) REPL(0) ph_norm(xl0, xc0, normg, mods, 0, (bf16*)XN, XS, l == 0 ? nullptr : PART, 16, MT, gw, NGW, lane, (LAS float*)lds);
        SEAML(0);
        if (INL(1)) REPL(1) { pg8::Gemm g{XN, (const pg8::bf16_t*)(ws + WS_WF1 + (size_t)(l * 2 + 0) * SZ_WF1), MT, FF2, DM}; pg8::StaticOrder S; S.init(MT, FF2, G, bx);
            pg8::EpiSwiglu E{Hb, FF}; pg8::gemm_phase<pg8::EpiSwiglu, pg8::StaticOrder, true, true>(lds, g, S, E); }
        SEAML(1);
        if (INL(2)) REPL(2) { pg8::Gemm g{Hb, (const pg8::bf16_t*)(ws + WS_WF2 + (size_t)(l * 2 + 0) * SZ_WF2), MT, DM, FF}; pg8::SplitCtxOrder S{G, vcu, NLAT / 256, NCTX / 256, 16, FF / 64};
            pg8::EpiResid E{xl0, (long)((xc0 - (size_t)NLAT * DM) - xl0), XS, 0L, mods + 2 * DM, NMOD * DM, 0.5f, NLAT / 256, TSEQ / 256, PART, NCTX};
            pg8::gemm_phase<pg8::EpiResid, pg8::SplitCtxOrder, true, true>(lds, g, S, E); }
        SEAML(2);
        if (INL(3)) REPL(3) ph_norm(XS, XS + (size_t)NLAT * DM, normg + DM, mods, 3, (bf16*)XN, XS, PART, 16, MT, gw, NGW, lane, (LAS float*)lds);
        SEAML(3);
        if (INL(4)) REPL(4) { pg8::Gemm g{XN, (const pg8::bf16_t*)(ws + WS_WIN + (size_t)l * SZ_WIN), MT, PROJP, DM}; pg8::ProjOrder S; S.init(last ? NLAT : MT, PROJP, G, bx); S.skip_ctx = last ? 1 : 0;
            pg8::EpiProj E{(pg8::bf16_t*)(ws + WS_P), PROJP, (pg8::bf16_t*)(ws + WS_ACT), (pg8::bf16_t*)(ws + WS_QK), args.in[I_QN] + l * 64, args.in[I_KN] + l * 64, (const float*)(ws + WS_ROPE), NLAT, TSEQ};
            pg8::gemm_phase<pg8::EpiProj, pg8::ProjOrder, true, true>(lds, g, S, E); }
        SEAML(4);
        if (INL(5)) REPL(5) { pg8::Gemm g{(const pg8::bf16_t*)(ws + WS_ACT), (const pg8::bf16_t*)(ws + WS_WLO + (size_t)l * SZ_WLO), MT, LOW, ACTW}; pg8::LoraOrder S; S.init(MT, LOW, G, bx);
            pg8::EpiLora E{(pg8::bf16_t*)(ws + WS_R1), args.in[I_W0] + l * 2048, args.in[I_A0] + l * 2048}; pg8::gemm_phase<pg8::EpiLora, pg8::LoraOrder, true, true>(lds, g, S, E);
            ph_e1(args, l, gt, NGT); }
        SEAML(5);
        if (INL(7)) REPL(7) {
            if (bx < 64) scan_unit(args, l, bx, lds, tid);
            else { int u0, ustep, uend, cu, gv, gn;
                if (G == 256) { const int ax = bx & 7, ar = (bx - 64) >> 3, li = (ar - 16) * 8 + ax;
                    u0 = 64 * ax + ar; ustep = 24; uend = 64 * ax + 64; cu = (!last && ar >= 16 && li < 32) ? li : -1;
                    gv = li; gn = ar >= 16 ? 64 : 0; }
                else { const int aw = G - 64, wi = bx - 64, light0 = 512 % aw, nl = aw - light0;
                    u0 = wi; ustep = aw; uend = 512; cu = (!last && wi >= light0 && wi - light0 < 32) ? wi - light0 : -1;
                    if (light0 == 0 || nl <= 0) { gv = wi; gn = aw; } else { gv = wi - light0; gn = wi >= light0 ? nl : 0; } }
                ph_attn(args, (char*)lds_raw, u0, ustep, uend, cu); __syncthreads();
                if (gn > 0) ph_gmlp(args, l, lds, tid, gv, gn); }
        }
        SEAML(7);
        if (INL(8)) REPL(8) ph_rwkv_out(args, l, last ? NLAT : MT, gt, NGT);
        SEAML(8);
        if (INL(9)) REPL(9) { pg8::Gemm g{(const pg8::bf16_t*)(ws + WS_Y3), (const pg8::bf16_t*)(ws + WS_WBR + (size_t)l * SZ_WBR), 3 * MT, 3 * DM, 1024}; pg8::MergeOrder S{G, bx, MT / 256, NLAT / 256, last ? 0 : (NCTX / 256) * 8 * 3};
            pg8::EpiMerge E{(const pg8::bf16_t*)(ws + WS_P) + P_GATE2, PROJP, args.in[I_BGATE] + (size_t)l * 3 * DM, (pg8::bf16_t*)(ws + WS_ZF), XN, MT / 256, (pg8::bf16_t*)(ws + WS_IMG), -(long)NLAT};
            pg8::gemm_phase<pg8::EpiMerge, pg8::MergeOrder, true, true>(lds, g, S, E); }
        SEAML(9);
        if (INL(10)) REPL(10) { pg8::Gemm g{XN, (const pg8::bf16_t*)(ws + WS_WOUT + (size_t)l * SZ_WOUT), MT, DM, DM}; pg8::SplitCtxOrder S{G, vcu, NLAT / 256, last ? 0 : NCTX / 256, 8, DM / 64};
            if (!last) { pg8::Unit uu;
                for (int i = 0; S.next(i, uu); ++i) if (uu.kn != 0) {
                    const int r0 = (uu.pm - NLAT / 256) * 256, k0 = uu.ks * 64, kw8 = uu.kn * 8;
                    const bf16* ZP = (const bf16*)(ws + WS_IMG); bf16* Zc = (bf16*)XN + (size_t)NLAT * DM;
                    for (int idx = tid; idx < 256 * kw8; idx += NTHR) { const int r = r0 + idx / kw8, k = k0 + (idx % kw8) * 8;
                        const v4u q0 = *(const GAS v4u*)(ZP + (size_t)r * DM + k), q1 = *(const GAS v4u*)(ZP + ((size_t)NCTX + r) * DM + k), q2 = *(const GAS v4u*)(ZP + ((size_t)2 * NCTX + r) * DM + k);
                        float f0[8], f1[8], f2[8]; unpack8(q0, f0); unpack8(q1, f1); unpack8(q2, f2);
#pragma unroll
                        for (int e = 0; e < 8; ++e) f0[e] = (f0[e] + f1[e]) + f2[e];
                        *(GAS v4u*)(Zc + (size_t)r * DM + k) = pack8(f0); } }
                asm volatile("s_waitcnt vmcnt(0)" ::: "memory"); __syncthreads(); }
            pg8::EpiResid E{XS, 0L, XS, 0L, mods + 5 * DM, NMOD * DM, 1.0f, NLAT / 256, TSEQ / 256, PART, NCTX};
            pg8::gemm_phase<pg8::EpiResid, pg8::SplitCtxOrder, true, true>(lds, g, S, E); }
        SEAML(10);
        if (INL(11)) REPL(11) ph_norm(XS, XS + (size_t)NLAT * DM, normg + 2 * DM, mods, 6, (bf16*)XN, XS, PART, 8, last ? NLAT : MT, gw, NGW, lane, (LAS float*)lds);
        SEAML(11);
        if (INL(12)) REPL(12) { pg8::Gemm g{XN, (const pg8::bf16_t*)(ws + WS_WF1 + (size_t)(l * 2 + 1) * SZ_WF1), MT, FF2, DM}; pg8::StaticOrder S; S.init(last ? NLAT : MT, FF2, G, bx);
            pg8::EpiSwiglu E{Hb, FF}; pg8::gemm_phase<pg8::EpiSwiglu, pg8::StaticOrder, true, true>(lds, g, S, E); }
        SEAML(12);
        if (INL(13)) REPL(13) { pg8::Gemm g{Hb, (const pg8::bf16_t*)(ws + WS_WF2 + (size_t)(l * 2 + 1) * SZ_WF2), MT, DM, FF}; pg8::SplitCtxOrder S{G, vcu, NLAT / 256, last ? 0 : NCTX / 256, 16, FF / 64};
            pg8::EpiResid E{XS, 0L, last ? args.out : XS, 0L, mods + 8 * DM, NMOD * DM, 0.5f, NLAT / 256, TSEQ / 256, PART, NCTX};
            pg8::gemm_phase<pg8::EpiResid, pg8::SplitCtxOrder, true, true>(lds, g, S, E); }
        SEAML(13);
    }
__global__ void __launch_bounds__(NTHR, 2) fwd(Args args) {
    extern __shared__ __attribute__((aligned(16))) unsigned char lds_raw[];
    LAS unsigned char* lds = (LAS unsigned char*)lds_raw;
    const int tid = threadIdx.x, lane = tid & 63, wave = __builtin_amdgcn_readfirstlane(tid >> 6);
    const int G = gridDim.x; const int bx = blockIdx.x; const int vcu = (G % 8 == 0) ? (bx % 8) * (G / 8) + bx / 8 : bx;
    const int gw = vcu * NWAVES + wave, NGW = G * NWAVES, gt = vcu * NTHR + tid, NGT = G * NTHR;
    unsigned char* ws = args.ws;
    volatile LAS unsigned* MISC = (volatile LAS unsigned*)(lds + MISC_OFF);
    for (int u = tid; u < (LDS_BYTES - LDSCTL_OFF) / 4; u += NTHR) ((LAS unsigned*)(lds + LDSCTL_OFF))[u] = 0u;
    __syncthreads();
    const int lo = args.ph_lo, hi = args.ph_hi;
    const bool multi = (hi - lo) > 1;
    XcdBarrier bar; bar.bar = (unsigned*)(ws + WS_CTL) + CW_BAR; bar.x = 0; bar.st = nullptr;
    if (multi) bar = xcd_barrier_post((unsigned*)(ws + WS_CTL) + CW_BAR, MISC + 8);

    if ((ONLY_PH < 0 || ONLY_PH == 100) && IN(0)) REPL(16) {
        ph_ada(args, lds, tid, vcu, G); __syncthreads(); ph_weights(args, 0, lds, tid, vcu, G); ph_weights(args, 1, lds, tid, vcu, G); ph_small(args, tid, vcu, G); }
    SEAM(0);

    layer_body<0>(args, lds, lds_raw, ws, bar, lo, hi, tid, lane, G, bx, vcu, gw, NGW, gt, NGT);
    layer_body<1>(args, lds, lds_raw, ws, bar, lo, hi, tid, lane, G, bx, vcu, gw, NGW, gt, NGT);
#undef IN
#undef SEAM
}

#ifndef MK_PER_PHASE
#define MK_PER_PHASE 0
#endif
extern "C" void kernel_launch(void* const* d_in, const int* in_sizes, int n_in, void* d_out, int out_size, void* d_ws, size_t ws_size, hipStream_t stream) {
    static int grid = 0;
    if (grid == 0) {
        if (n_in != 31 || in_sizes[0] != NLAT * DM || out_size != NLAT * DM || ws_size < WS_END) {
            fprintf(stderr, "kernel_launch: unexpected shapes: n_in %d in0 %d out %d ws %zu (need %zu); nothing launched\n", n_in, n_in > 0 ? in_sizes[0] : -1, out_size, ws_size, (size_t)WS_END); grid = -1; return; }
        int dev = 0, cus = 0, per_cu = 0;
        if (hipGetDevice(&dev) != hipSuccess || hipDeviceGetAttribute(&cus, hipDeviceAttributeMultiprocessorCount, dev) != hipSuccess) { grid = -1; return; }
        if (hipFuncSetAttribute((const void*)fwd, hipFuncAttributeMaxDynamicSharedMemorySize, LDS_BYTES) != hipSuccess) { fprintf(stderr, "kernel_launch: hipFuncSetAttribute failed\n"); grid = -1; return; }
        if (hipOccupancyMaxActiveBlocksPerMultiprocessor(&per_cu, (const void*)fwd, NTHR, LDS_BYTES) != hipSuccess || per_cu < 1) fprintf(stderr, "kernel_launch: occupancy query says %d\n", per_cu);
        (void)hipGetLastError();
        grid = cus;
    }
    if (grid < 0) return;
    (void)hipMemsetAsync((char*)d_ws + WS_CTL, 0, CTL_ZERO_BYTES, stream);
    Args a{};
    for (int i = 0; i < 31; ++i) a.in[i] = (const float*)d_in[i];
    a.out = (float*)d_out; a.ws = (unsigned char*)d_ws;
#if MK_PER_PHASE
    for (int p = 0; p < NPH; ++p) { a.ph_lo = p; a.ph_hi = p + 1; hipLaunchKernelGGL(fwd, dim3(grid), dim3(NTHR), LDS_BYTES, stream, a); }
#else
    a.ph_lo = 0; a.ph_hi = NPH; hipLaunchKernelGGL(fwd, dim3(grid), dim3(NTHR), LDS_BYTES, stream, a);
#endif
}
```

```cpp
#include <hip/hip_runtime.h>
#include <cstdio>
#include <cstdint>
namespace pg8 {
#define PG8_LAS __attribute__((address_space(3)))
typedef unsigned short bf16_t;
typedef short bf16x8 __attribute__((ext_vector_type(8)));
typedef float f32x4 __attribute__((ext_vector_type(4)));
typedef unsigned u32x4 __attribute__((ext_vector_type(4)));
constexpr int BM = 256, BK = 64, HALF = 128, HTB = HALF * BK * 2  , STAGE_BYTES = 8 * HTB, NXCD = 8, WGM = 8;

__host__ __device__ __forceinline__ int lds_byte(int r, int c) { const int st = (r >> 4) * 2 + (c >> 5), rr = r & 15, cc = c & 31, ob = rr * 64 + cc * 2; return st * 1024 + (ob ^ (((ob >> 9) & 1) << 5)); }
__host__ __device__ __forceinline__ void stage_rc(int b, int& R, int& C) { const int st = b / 1024, sb = b % 1024, swz = sb ^ (((sb >> 9) & 1) << 5); R = (st >> 1) * 16 + swz / 64; C = (st & 1) * 32 + (swz % 64) / 2; }
__host__ __device__ __forceinline__ int perm32(int rho) { const int n = rho >> 4, i = rho & 15; return 8 * (i >> 2) + 4 * n + (i & 3); }

struct Unit { int pm, pn, ks, kn, aux; };
struct Gemm { const bf16_t* A; const bf16_t* Bt; int M, N, K; };

struct StaticOrder {
    int nM, nN, nwg, G, c;
    __host__ __device__ void init(int M, int N, int G_, int c_) { nM = M / BM; nN = N / BM; nwg = nM * nN; G = G_; c = c_; }
    __host__ __device__ bool next(int i, Unit& u) const {
        const long L = (long)i * G + c; if (L >= nwg) return false;
        int wgid = (int)L; { const int q = nwg / NXCD, r = nwg % NXCD, xcd = wgid % NXCD, off = wgid / NXCD; wgid = (xcd < r ? xcd * (q + 1) : r * (q + 1) + (xcd - r) * q) + off; }
        const int nig = WGM * nN, gid = wgid / nig, fm = gid * WGM, gsz = (nM - fm) < WGM ? (nM - fm) : WGM;
        u.pm = fm + ((wgid % nig) % gsz); u.pn = (wgid % nig) / gsz; u.ks = 0; u.kn = 0; u.aux = 0; return true;
    }
    __device__ __forceinline__ void a_ready(const Unit&) const {}
    __device__ __forceinline__ void done(const Unit&) const {}
};

__device__ __forceinline__ unsigned cvt_pk_bf16(float lo, float hi) { unsigned r; asm volatile("v_cvt_pk_bf16_f32 %0, %1, %2" : "=v"(r) : "v"(lo), "v"(hi)); return r; }
typedef float f32x2 __attribute__((ext_vector_type(2)));
typedef unsigned u32x2 __attribute__((ext_vector_type(2)));
__device__ __forceinline__ float fsigmoid(float x) { return __builtin_amdgcn_rcpf(1.f + __expf(-x)); }
__device__ __forceinline__ float bflo(unsigned w) { return __builtin_bit_cast(float, w << 16); }
__device__ __forceinline__ float bfhi(unsigned w) { return __builtin_bit_cast(float, w & 0xffff0000u); }

struct EpiSwiglu {
    static constexpr bool PERM = true, AFTER_DRAIN = false;
    bf16_t* H; int ldh;
    __device__ __forceinline__ void operator()(const f32x4 (&acc)[2][2][4][2], const Unit& u, int wr, int wc, int fr, int fq) const {
        const int col0 = u.pn * HALF + wc * 32 + 8 * fq, row0 = u.pm * BM + wr * 64 + fr;
#pragma unroll
        for (int ai = 0; ai < 2; ++ai)
#pragma unroll
            for (int m = 0; m < 4; ++m) {
                const f32x4 g0 = acc[ai][0][m][0], g1 = acc[ai][0][m][1], u0 = acc[ai][1][m][0], u1 = acc[ai][1][m][1];
                float o[8];
#pragma unroll
                for (int e = 0; e < 4; ++e) { o[e] = g0[e] * fsigmoid(g0[e]) * u0[e]; o[4 + e] = g1[e] * fsigmoid(g1[e]) * u1[e]; }
                u32x4 w; w.x = cvt_pk_bf16(o[0], o[1]); w.y = cvt_pk_bf16(o[2], o[3]); w.z = cvt_pk_bf16(o[4], o[5]); w.w = cvt_pk_bf16(o[6], o[7]);
                *(u32x4*)(H + (size_t)(row0 + ai * HALF + m * 16) * ldh + col0) = w;
            }
    }
};

struct EpiResid {
    static constexpr bool PERM = true, AFTER_DRAIN = false;
    const float* xin; long din; float* out; long dout; const float* gvec; int gstride; float scale; int nlat_tiles, tiles_per_set; bf16_t* part; int nctx_rows;
    __device__ __forceinline__ void operator()(const f32x4 (&acc)[2][2][4][2], const Unit& u, int wr, int wc, int fr, int fq) const {
        const bool isctx = u.pm >= nlat_tiles;
        const int set = isctx ? 2 : (u.pm / tiles_per_set);
        const float* gv = gvec + (size_t)set * gstride;
        const int colb = u.pn * BM + wc * 32 + 8 * fq;
        const long rbase = (long)(u.pm * BM + wr * 64 + fr) * 2048 + colb;
        const float* xi = xin + rbase + (isctx ? din : 0L); float* xo = out + rbase + (isctx ? dout : 0L);
        f32x4 gg[2][2];
#pragma unroll
        for (int bj = 0; bj < 2; ++bj)
#pragma unroll
            for (int n = 0; n < 2; ++n) gg[bj][n] = *(const f32x4*)(gv + colb + bj * HALF + 4 * n) * scale;
        if (u.kn != 0) {
            bf16_t* pp = part + ((size_t)u.aux * (size_t)nctx_rows + (size_t)((u.pm - nlat_tiles) * BM + wr * 64 + fr)) * 2048 + colb;
#pragma unroll
            for (int ai = 0; ai < 2; ++ai)
#pragma unroll
                for (int m = 0; m < 4; ++m)
#pragma unroll
                    for (int bj = 0; bj < 2; ++bj) { const f32x4 v0 = gg[bj][0] * acc[ai][bj][m][0], v1 = gg[bj][1] * acc[ai][bj][m][1];
                        u32x4 w; w.x = cvt_pk_bf16(v0[0], v0[1]); w.y = cvt_pk_bf16(v0[2], v0[3]); w.z = cvt_pk_bf16(v1[0], v1[1]); w.w = cvt_pk_bf16(v1[2], v1[3]);
                        *(u32x4*)(pp + (size_t)(ai * HALF + m * 16) * 2048 + bj * HALF) = w; }
            return;
        }
#pragma unroll
        for (int ai = 0; ai < 2; ++ai) {
            f32x4 xv[4][2][2];
#pragma unroll
            for (int m = 0; m < 4; ++m)
#pragma unroll
                for (int bj = 0; bj < 2; ++bj)
#pragma unroll
                    for (int n = 0; n < 2; ++n) xv[m][bj][n] = *(const f32x4*)(xi + (size_t)(ai * HALF + m * 16) * 2048 + bj * HALF + 4 * n);
#pragma unroll
            for (int m = 0; m < 4; ++m)
#pragma unroll
                for (int bj = 0; bj < 2; ++bj)
#pragma unroll
                    for (int n = 0; n < 2; ++n) *(f32x4*)(xo + (size_t)(ai * HALF + m * 16) * 2048 + bj * HALF + 4 * n) = xv[m][bj][n] + gg[bj][n] * acc[ai][bj][m][n];
        }
    }
};
struct SplitCtxOrder {
    int G, c, nlat_tiles, nctx_tiles, nsplit, ntk;
    __device__ __forceinline__ bool next(int i, Unit& u) const {
        const int e = i * G + c, nl = nlat_tiles * 8;
        if (e < nl) { u.pm = e >> 3; u.pn = e & 7; u.ks = 0; u.kn = 0; u.aux = 0; return true; }
        const int f = e - nl; if (f >= nctx_tiles * 8 * nsplit) return false;
        const int sp = f % nsplit, t = f / nsplit, np = ntk >> 1, p0 = sp * np / nsplit, p1 = (sp + 1) * np / nsplit;
        u.pm = nlat_tiles + (t >> 3); u.pn = t & 7; u.ks = 2 * p0; u.kn = 2 * (p1 - p0); u.aux = sp; return true;
    }
    __device__ __forceinline__ void a_ready(const Unit&) const {}
    __device__ __forceinline__ void done(const Unit&) const {}
};
struct ProjOrder : StaticOrder {
    int skip_ctx;
    __device__ __forceinline__ bool next(int i, Unit& u) const {
        if (StaticOrder::next(i, u)) return true;
        if (!skip_ctx) return false;
        const long L = (long)i * G + c - nwg; if (L >= 2 * 23) return false;
        const int x = (int)L % 23; u.pm = nM + (int)L / 23; u.pn = x < 15 ? 8 + x : 27 + (x - 15); u.ks = 0; u.kn = 0; u.aux = 0; return true;
    }
};
struct LoraOrder : StaticOrder {
    __device__ __forceinline__ bool next(int i, Unit& u) const {
        if (!StaticOrder::next(i, u)) return false;
        const int sec = u.pn >> 2; int k4 = 4; asm volatile("" : "+s"(k4));
        u.ks = sec == 0 ? 0 : (sec <= 2 ? 4 : 8); u.kn = k4; return true;
    }
};

__device__ __forceinline__ float ftanh_e(float x) { return 1.f - 2.f * __builtin_amdgcn_rcpf(__expf(2.f * x) + 1.f); }
__device__ __forceinline__ float gelu_e(float x) { return 0.5f * x * (1.f + ftanh_e(0.7978845608f * (x + 0.044715f * x * x * x))); }
struct EpiProj {
    static constexpr bool PERM = true, AFTER_DRAIN = false;
    bf16_t* P; int ldp; bf16_t* ACT; bf16_t* QK; const float* qn; const float* kn; const PG8_LAS float* rope; int nlat_rows, tseq;
    __device__ __forceinline__ void operator()(const f32x4 (&acc)[2][2][4][2], const Unit& u, int wr, int wc, int fr, int fq) const {
        const int pn = u.pn, row0 = u.pm * BM + wr * 64 + fr;
        if (pn >= 23 && pn <= 30) {
            const bool isq = pn <= 26; const int gi = (pn - 23) * 4 + wc;
            const float* gain = isq ? qn : kn;
            f32x4 gg[2][2];
#pragma unroll
            for (int bj = 0; bj < 2; ++bj)
#pragma unroll
                for (int n = 0; n < 2; ++n) gg[bj][n] = *(const f32x4*)(gain + bj * 32 + n * 16 + 4 * fq);
            const float qs = isq ? 0.18033688011112042f : 1.f;
#pragma unroll
            for (int ai = 0; ai < 2; ++ai)
#pragma unroll
                for (int m = 0; m < 4; ++m) {
                    const int row = row0 + ai * HALF + m * 16;
                    f32x4 x[2][2]; float ss = 0.f;
#pragma unroll
                    for (int bj = 0; bj < 2; ++bj)
#pragma unroll
                        for (int n = 0; n < 2; ++n) { x[bj][n] = acc[ai][bj][m][n]; ss += (x[bj][n][0] * x[bj][n][0] + x[bj][n][1] * x[bj][n][1]) + (x[bj][n][2] * x[bj][n][2] + x[bj][n][3] * x[bj][n][3]); }
                    ss += __shfl_xor(ss, 16); ss += __shfl_xor(ss, 32);
                    const float rinv = __builtin_amdgcn_rsqf(ss * (1.f / 64.f) + 1e-6f);
#pragma unroll
                    for (int bj = 0; bj < 2; ++bj)
#pragma unroll
                        for (int n = 0; n < 2; ++n) x[bj][n] = x[bj][n] * rinv * gg[bj][n];
                    if (row < nlat_rows) { const int t = row & (tseq - 1);
#pragma unroll
                        for (int bj = 0; bj < 2; ++bj) { const int p = bj == 0 ? (t >> 6) : (t & 63);
                            const f32x4 cs0 = *(const PG8_LAS f32x4*)(rope + (p * 16 + 4 * fq) * 2), cs1 = *(const PG8_LAS f32x4*)(rope + (p * 16 + 4 * fq) * 2 + 4);
                            const f32x4 c = {cs0[0], cs0[2], cs1[0], cs1[2]}, s = {cs0[1], cs0[3], cs1[1], cs1[3]};
                            const f32x4 a = x[bj][0], b2 = x[bj][1];
                            x[bj][0] = a * c - b2 * s; x[bj][1] = b2 * c + a * s; } }
                    bf16_t* dst = QK + (size_t)row * 2048 + gi * 64 + 8 * fq;
#pragma unroll
                    for (int bj = 0; bj < 2; ++bj) { const f32x4 v0 = x[bj][0] * qs, v1 = x[bj][1] * qs;
                        u32x4 w; w.x = cvt_pk_bf16(v0[0], v0[1]); w.y = cvt_pk_bf16(v0[2], v0[3]); w.z = cvt_pk_bf16(v1[0], v1[1]); w.w = cvt_pk_bf16(v1[2], v1[3]);
                        *(u32x4*)(dst + bj * 32) = w; }
                }
            return;
        }
        if (pn >= 20 && pn <= 22) {
#pragma unroll
            for (int bj = 0; bj < 2; ++bj) {
                const int cc = bj * HALF + wc * 32 + 8 * fq;
                int dcol, fn;
                if (pn == 20) { dcol = cc; fn = 1; }
                else if (pn == 21) { if (cc < 96) { dcol = 256 + cc; fn = 2; } else if (cc < 192) { dcol = 384 + (cc - 96); fn = 2; } else { dcol = 512 + (cc - 192); fn = 0; } }
                else { if (cc < 32) { dcol = 576 + cc; fn = 0; } else if (cc < 128) { dcol = 640 + (cc - 32); fn = 0; } else { dcol = -1; fn = 0; } }
                if (dcol < 0) continue;
#pragma unroll
                for (int ai = 0; ai < 2; ++ai)
#pragma unroll
                    for (int m = 0; m < 4; ++m) {
                        f32x4 v0 = acc[ai][bj][m][0], v1 = acc[ai][bj][m][1];
                        if (fn != 0) {
#pragma unroll
                            for (int e = 0; e < 4; ++e) { v0[e] = fn == 1 ? fsigmoid(v0[e]) : ftanh_e(v0[e]); v1[e] = fn == 1 ? fsigmoid(v1[e]) : ftanh_e(v1[e]); } }
                        u32x4 w; w.x = cvt_pk_bf16(v0[0], v0[1]); w.y = cvt_pk_bf16(v0[2], v0[3]); w.z = cvt_pk_bf16(v1[0], v1[1]); w.w = cvt_pk_bf16(v1[2], v1[3]);
                        *(u32x4*)(ACT + (size_t)(row0 + ai * HALF + m * 16) * 768 + dcol) = w;
                    }
            }
            return;
        }
        const bool dogelu = pn < 8;
        const int col0 = pn * BM + wc * 32 + 8 * fq;
#pragma unroll
        for (int ai = 0; ai < 2; ++ai)
#pragma unroll
            for (int m = 0; m < 4; ++m) {
                bf16_t* rowp = P + (size_t)(row0 + ai * HALF + m * 16) * ldp + col0;
#pragma unroll
                for (int bj = 0; bj < 2; ++bj) {
                    f32x4 v0 = acc[ai][bj][m][0], v1 = acc[ai][bj][m][1];
                    if (dogelu) {
#pragma unroll
                        for (int e = 0; e < 4; ++e) { v0[e] = gelu_e(v0[e]); v1[e] = gelu_e(v1[e]); } }
                    u32x4 w; w.x = cvt_pk_bf16(v0[0], v0[1]); w.y = cvt_pk_bf16(v0[2], v0[3]); w.z = cvt_pk_bf16(v1[0], v1[1]); w.w = cvt_pk_bf16(v1[2], v1[3]);
                    *(u32x4*)(rowp + bj * HALF) = w;
                }
            }
    }
};

struct EpiLora {
    static constexpr bool PERM = true, AFTER_DRAIN = false;
    bf16_t* LO; const float* w0; const float* a0;
    __device__ __forceinline__ void operator()(const f32x4 (&acc)[2][2][4][2], const Unit& u, int wr, int wc, int fr, int fq) const {
        const int sec = u.pn >> 2;
        const int col0 = u.pn * BM + wc * 32 + 8 * fq, row0 = u.pm * BM + wr * 64 + fr, c0 = col0 - sec * 1024;
        const float* bp = (sec <= 2 ? w0 + (sec <= 1 ? 0 : 1024) : a0 + (sec - 3) * 1024) + c0;
#pragma unroll
        for (int ai = 0; ai < 2; ++ai)
#pragma unroll
            for (int m = 0; m < 4; ++m) {
                bf16_t* rowp = LO + (size_t)(row0 + ai * HALF + m * 16) * 5120 + col0;
#pragma unroll
                for (int bj = 0; bj < 2; ++bj) {
                    f32x4 v[2];
#pragma unroll
                    for (int n = 0; n < 2; ++n) { v[n] = acc[ai][bj][m][n];
                        if (sec >= 1) { v[n] = v[n] + *(const f32x4*)(bp + bj * HALF + 4 * n);
#pragma unroll
                            for (int e = 0; e < 4; ++e) { const float s = fsigmoid(v[n][e]); v[n][e] = (sec <= 2) ? 0.8750356f * s : s; } } }
                    u32x4 w; w.x = cvt_pk_bf16(v[0][0], v[0][1]); w.y = cvt_pk_bf16(v[0][2], v[0][3]); w.z = cvt_pk_bf16(v[1][0], v[1][1]); w.w = cvt_pk_bf16(v[1][2], v[1][3]);
                    *(u32x4*)(rowp + bj * HALF) = w;
                }
                asm volatile("" ::: "memory");
            }
    }
};

struct EpiMerge {
    static constexpr bool PERM = true, AFTER_DRAIN = false;
    const bf16_t* pgate; int ldp;
    const float* bgate;
    bf16_t* ZF; bf16_t* Z; int mtiles;
    bf16_t* ZP; long zp_off;
    __device__ __forceinline__ void operator()(const f32x4 (&acc)[2][2][4][2], const Unit& u, int wr, int wc, int fr, int fq) const {
        const int br = u.pn >> 3, pn = u.pn & 7, pm = u.pm - mtiles * br;
        const int col0 = pn * BM + wc * 32 + 8 * fq, row0 = pm * BM + wr * 64 + fr;
        f32x4 bb[2][2];
#pragma unroll
        for (int bj = 0; bj < 2; ++bj)
#pragma unroll
            for (int n = 0; n < 2; ++n) bb[bj][n] = *(const f32x4*)(bgate + br * 2048 + col0 + bj * HALF + 4 * n);
        const bool part = u.aux != 0, rd = br >= 1 && !part;
        bf16_t* dstb = part ? ZP + ((long)br * 512 + zp_off) * 2048 : (br == 2 ? Z : ZF);
#pragma unroll
        for (int ai = 0; ai < 2; ++ai) {
            u32x4 pg[4][2], zf[4][2];
#pragma unroll
            for (int m = 0; m < 4; ++m)
#pragma unroll
                for (int bj = 0; bj < 2; ++bj) { const size_t row = (size_t)(row0 + ai * HALF + m * 16);
                    pg[m][bj] = *(const u32x4*)(pgate + row * ldp + br * 2048 + col0 + bj * HALF);
                    if (rd) zf[m][bj] = *(const u32x4*)(ZF + row * 2048 + col0 + bj * HALF); }
#pragma unroll
            for (int m = 0; m < 4; ++m)
#pragma unroll
                for (int bj = 0; bj < 2; ++bj) { const size_t row = (size_t)(row0 + ai * HALF + m * 16); const u32x4 q = pg[m][bj];
                    f32x4 g0, g1;
                    g0[0] = bflo(q.x); g0[1] = bfhi(q.x); g0[2] = bflo(q.y); g0[3] = bfhi(q.y); g1[0] = bflo(q.z); g1[1] = bfhi(q.z); g1[2] = bflo(q.w); g1[3] = bfhi(q.w);
                    g0 = g0 + bb[bj][0]; g1 = g1 + bb[bj][1];
                    f32x4 v0, v1;
#pragma unroll
                    for (int e = 0; e < 4; ++e) { v0[e] = fsigmoid(g0[e]) * acc[ai][bj][m][0][e]; v1[e] = fsigmoid(g1[e]) * acc[ai][bj][m][1][e]; }
                    if (rd) { const u32x4 z = zf[m][bj];
                        v0[0] += bflo(z.x); v0[1] += bfhi(z.x); v0[2] += bflo(z.y); v0[3] += bfhi(z.y); v1[0] += bflo(z.z); v1[1] += bfhi(z.z); v1[2] += bflo(z.w); v1[3] += bfhi(z.w); }
                    u32x4 w; w.x = cvt_pk_bf16(v0[0], v0[1]); w.y = cvt_pk_bf16(v0[2], v0[3]); w.z = cvt_pk_bf16(v1[0], v1[1]); w.w = cvt_pk_bf16(v1[2], v1[3]);
                    *(u32x4*)(dstb + row * 2048 + col0 + bj * HALF) = w; }
        }
    }
};
struct MergeOrder {
    int G, c, mtiles, nlat_tiles, nctx_units;
    __device__ __forceinline__ bool next(int i, Unit& u) const {
        const int ntl = nlat_tiles * 8; int nl = (ntl - c + G - 1) / G; nl = nl < 0 ? 0 : nl;
        u.ks = 0; u.kn = 0;
        if (i < 3 * nl) { const int t = (i / 3) * G + c, br = i % 3; u.pm = (t >> 3) + mtiles * br; u.pn = (t & 7) + 8 * br; u.aux = 0; return true; }
        const int e = (i - 3 * nl) * G + c; if (e >= nctx_units) return false;
        const int t = ntl + e / 3, br = e % 3; u.pm = (t >> 3) + mtiles * br; u.pn = (t & 7) + 8 * br; u.aux = 1; return true;
    }
    __device__ __forceinline__ void a_ready(const Unit&) const {}
    __device__ __forceinline__ void done(const Unit&) const {}
};

template <class Epi, class Sched, bool ALIGN_EPI = false, bool SP2 = false>
__device__ __forceinline__ void gemm_phase(PG8_LAS unsigned char* lds, const Gemm g, const Sched& S, const Epi& E) {
    const int tid = threadIdx.x, wid = __builtin_amdgcn_readfirstlane(tid >> 6), lane = tid & 63, wr = wid >> 2, wc = wid & 3, fr = lane & 15, fq = lane >> 4;
    const int K = g.K, nt = K / BK;
    unsigned voffA[2], voffB[2];
#pragma unroll
    for (int i = 0; i < 2; ++i) { int R, C; stage_rc(tid * 16 + i * 8192, R, C); const int Rb = Epi::PERM ? ((R & ~31) + perm32(R & 31)) : R;
        voffA[i] = (unsigned)(R * K + C) * 2u; voffB[i] = (unsigned)(Rb * K + C) * 2u; }
    const size_t kstep = (size_t)(BK * 2);
    const size_t hstep = (size_t)HALF * K * 2;
    const size_t tstep = 2 * hstep;
    const unsigned ldsw = (unsigned)wid * 1024u;
    const int aoff = lds_byte(wr * 64 + fr, fq * 8), boff = lds_byte(wc * 32 + fr, fq * 8);
#define PG8_SA(b, h) (((b) * 2 + (h)) * HTB)
#define PG8_SB(b, h) ((4 + (b) * 2 + (h)) * HTB)
#define PG8_STAGE(bufoff, gbase, voff) do { _Pragma("unroll") for (int _i = 0; _i < 2; ++_i) \
        __builtin_amdgcn_global_load_lds((const unsigned*)((const char*)(gbase) + (voff)[_i]), (PG8_LAS unsigned*)(lds + (bufoff) + ldsw + _i * 8192), 16, 0, 0); } while (0)
#define PG8_LDA(dst, b, h) do { _Pragma("unroll") for (int m = 0; m < 4; ++m) _Pragma("unroll") for (int k = 0; k < 2; ++k) dst[m][k] = *(const PG8_LAS bf16x8*)(lds + PG8_SA(b, h) + aoff + m * 2048 + k * 1024); } while (0)
#define PG8_LDB(dst, b, h) do { _Pragma("unroll") for (int n = 0; n < 2; ++n) _Pragma("unroll") for (int k = 0; k < 2; ++k) dst[n][k] = *(const PG8_LAS bf16x8*)(lds + PG8_SB(b, h) + boff + n * 2048 + k * 1024); } while (0)
#define PG8_MMA(ai, bj, At, Bt) do { __builtin_amdgcn_s_setprio(1); _Pragma("unroll") for (int m = 0; m < 4; ++m) _Pragma("unroll") for (int n = 0; n < 2; ++n) _Pragma("unroll") for (int k = 0; k < 2; ++k) \
        acc[ai][bj][m][n] = __builtin_amdgcn_mfma_f32_16x16x32_bf16(Bt[n][k], At[m][k], acc[ai][bj][m][n], 0, 0, 0); __builtin_amdgcn_s_setprio(0); } while (0)
#define PG8_WAIT_V(n) asm volatile("s_waitcnt vmcnt(" #n ")" ::: "memory")
#define PG8_WAIT_L(n) asm volatile("s_waitcnt lgkmcnt(" #n ")" ::: "memory")
#define PG8_BAR __builtin_amdgcn_s_barrier()
#define PG8_SCHED __builtin_amdgcn_sched_barrier(0)
    Unit cur, nxt; int ui = 0;
    if (!S.next(0, cur)) return;
    f32x4 acc[2][2][4][2];
#pragma unroll
    for (int a = 0; a < 2; ++a)
#pragma unroll
        for (int b = 0; b < 2; ++b)
#pragma unroll
            for (int m = 0; m < 4; ++m)
#pragma unroll
                for (int n = 0; n < 2; ++n) acc[a][b][m][n] = (f32x4){0.f, 0.f, 0.f, 0.f};
    bf16x8 At[4][2], B0[2][2], B1[2][2];
    const char* cA = (const char*)g.A + (size_t)cur.pm * tstep + (size_t)cur.ks * kstep; const char* cB = (const char*)g.Bt + (size_t)cur.pn * tstep + (size_t)cur.ks * kstep;
    int ntc = cur.kn ? cur.kn : nt;
    S.a_ready(cur);
    if constexpr (SP2) {
        PG8_STAGE(PG8_SB(0, 0), cB, voffB); PG8_STAGE(PG8_SB(0, 1), cB + hstep, voffB); PG8_STAGE(PG8_SA(0, 0), cA, voffA); PG8_STAGE(PG8_SA(0, 1), cA + hstep, voffA);
        if (wr == 1) PG8_BAR;
        PG8_WAIT_V(2); PG8_BAR;
        PG8_STAGE(PG8_SB(1, 0), cB + kstep, voffB); PG8_STAGE(PG8_SA(1, 0), cA + kstep, voffA); PG8_STAGE(PG8_SB(1, 1), cB + hstep + kstep, voffB);
        PG8_WAIT_V(6); PG8_BAR;
    } else {
        PG8_STAGE(PG8_SB(0, 0), cB, voffB); PG8_STAGE(PG8_SA(0, 0), cA, voffA); PG8_STAGE(PG8_SB(0, 1), cB + hstep, voffB); PG8_STAGE(PG8_SA(0, 1), cA + hstep, voffA);
        if (wr == 1) PG8_BAR;
        PG8_WAIT_V(4); PG8_BAR;
        PG8_STAGE(PG8_SB(1, 0), cB + kstep, voffB); PG8_STAGE(PG8_SA(1, 0), cA + kstep, voffA); PG8_STAGE(PG8_SB(1, 1), cB + hstep + kstep, voffB);
        PG8_WAIT_V(6); PG8_BAR;
    }
    for (;;) {
        const bool has_next = S.next(ui + 1, nxt);
        const char* nA = has_next ? (const char*)g.A + (size_t)nxt.pm * tstep + (size_t)nxt.ks * kstep : cA; const char* nB = has_next ? (const char*)g.Bt + (size_t)nxt.pn * tstep + (size_t)nxt.ks * kstep : cB;
        for (int t = 0; t < ntc; t += 2) {
            const bool last = (t == ntc - 2);
            const char* a1 = cA + (size_t)(t + 1) * kstep;
            const char* a2 = last ? nA : cA + (size_t)(t + 2) * kstep; const char* b2 = last ? nB : cB + (size_t)(t + 2) * kstep;
            const char* a3 = a2 + kstep; const char* b3 = b2 + kstep;
            if (last && has_next) S.a_ready(nxt);
            if constexpr (SP2) {
            PG8_LDB(B0, 0, 0); PG8_LDB(B1, 0, 1); PG8_SCHED; PG8_LDA(At, 0, 0); PG8_STAGE(PG8_SA(1, 1), a1 + hstep, voffA);
            PG8_WAIT_V(8); PG8_WAIT_L(0); PG8_BAR; PG8_MMA(0, 0, At, B0); PG8_MMA(0, 1, At, B1); PG8_BAR; PG8_SCHED;
            PG8_LDA(At, 0, 1); PG8_STAGE(PG8_SB(0, 0), b2, voffB); PG8_STAGE(PG8_SB(0, 1), b2 + hstep, voffB); PG8_STAGE(PG8_SA(0, 0), a2, voffA);
            PG8_WAIT_V(8); PG8_WAIT_L(0); PG8_BAR; PG8_MMA(1, 0, At, B0); PG8_MMA(1, 1, At, B1); PG8_BAR; PG8_SCHED;
            PG8_LDB(B0, 1, 0); PG8_LDB(B1, 1, 1); PG8_SCHED; PG8_LDA(At, 1, 0); PG8_STAGE(PG8_SA(0, 1), a2 + hstep, voffA);
            PG8_WAIT_V(8); PG8_WAIT_L(0); PG8_BAR; PG8_MMA(0, 0, At, B0); PG8_MMA(0, 1, At, B1); PG8_BAR; PG8_SCHED;
            PG8_LDA(At, 1, 1); PG8_STAGE(PG8_SB(1, 0), b3, voffB); PG8_STAGE(PG8_SB(1, 1), b3 + hstep, voffB); PG8_STAGE(PG8_SA(1, 0), a3, voffA);
            PG8_WAIT_V(8); PG8_WAIT_L(0); PG8_BAR; PG8_MMA(1, 0, At, B0); PG8_MMA(1, 1, At, B1); PG8_BAR; PG8_SCHED;
            } else {
            PG8_LDB(B0, 0, 0); PG8_SCHED; PG8_LDA(At, 0, 0); PG8_STAGE(PG8_SA(1, 1), a1 + hstep, voffA);
            PG8_WAIT_L(8); PG8_BAR; PG8_WAIT_L(0); PG8_MMA(0, 0, At, B0); PG8_BAR; PG8_SCHED;
            PG8_LDB(B1, 0, 1); PG8_STAGE(PG8_SB(0, 0), b2, voffB);
            PG8_BAR; PG8_WAIT_L(0); PG8_MMA(0, 1, At, B1); PG8_BAR;
            PG8_LDA(At, 0, 1); PG8_STAGE(PG8_SA(0, 0), a2, voffA);
            PG8_BAR; PG8_WAIT_L(0); PG8_MMA(1, 0, At, B0); PG8_BAR; PG8_SCHED;
            PG8_STAGE(PG8_SB(0, 1), b2 + hstep, voffB);
            PG8_WAIT_V(6); PG8_BAR; PG8_MMA(1, 1, At, B1); PG8_BAR;
            PG8_LDB(B0, 1, 0); PG8_SCHED; PG8_LDA(At, 1, 0); PG8_STAGE(PG8_SA(0, 1), a2 + hstep, voffA);
            PG8_WAIT_L(8); PG8_BAR; PG8_WAIT_L(0); PG8_MMA(0, 0, At, B0); PG8_BAR; PG8_SCHED;
            PG8_LDB(B1, 1, 1); PG8_STAGE(PG8_SB(1, 0), b3, voffB);
            PG8_BAR; PG8_WAIT_L(0); PG8_MMA(0, 1, At, B1); PG8_BAR;
            PG8_LDA(At, 1, 1); PG8_STAGE(PG8_SA(1, 0), a3, voffA);
            PG8_BAR; PG8_WAIT_L(0); PG8_MMA(1, 0, At, B0); PG8_BAR; PG8_SCHED;
            PG8_STAGE(PG8_SB(1, 1), b3 + hstep, voffB);
            PG8_WAIT_V(6); PG8_BAR; PG8_MMA(1, 1, At, B1); PG8_BAR;
            }
        }
        if constexpr (ALIGN_EPI) { if (wr == 0) PG8_BAR; }
        if constexpr (!Epi::AFTER_DRAIN) { E(acc, cur, wr, wc, fr, fq); S.done(cur); }
        if (!has_next) break;
#pragma unroll
        for (int a = 0; a < 2; ++a)
#pragma unroll
            for (int b = 0; b < 2; ++b)
#pragma unroll
                for (int m = 0; m < 4; ++m)
#pragma unroll
                    for (int n = 0; n < 2; ++n) acc[a][b][m][n] = (f32x4){0.f, 0.f, 0.f, 0.f};
        cur = nxt; cA = nA; cB = nB; ++ui; ntc = cur.kn ? cur.kn : nt;
        if constexpr (ALIGN_EPI) { if (wr == 1) PG8_BAR; }
    }
    PG8_WAIT_V(0);
    if constexpr (!ALIGN_EPI) { if (wr == 0) PG8_BAR; }
    PG8_BAR;
    if constexpr (Epi::AFTER_DRAIN) { E.fused(acc, cur, wr, wc, fr, fq, lds, wid, lane); S.done(cur); }
#undef PG8_SA
#undef PG8_SB
#undef PG8_STAGE
#undef PG8_LDA
#undef PG8_LDB
#undef PG8_MMA
#undef PG8_WAIT_V
#undef PG8_WAIT_L
#undef PG8_BAR
#undef PG8_SCHED
}
}

constexpr int NWAVES = 8, NTHR = NWAVES * 64;
constexpr int DM = 2048, FF = 5504, FF2 = 2 * FF, NLAT = 8192, NCTX = 512, MT = NLAT + NCTX, TSEQ = 4096, TCTX = 256;
constexpr int PROJ = 14976, PROJP = 15104;
constexpr int P_U = 0, P_V = 1024, P_RKV = 2048, P_G = 5120, P_W = 5376, P_A = 5568, P_QKV = 5760, P_GATE = 8832;
constexpr int P_V2 = 31 * 256, P_GATE2 = 35 * 256;
constexpr int ACTW = 768, LOW = 5120;
constexpr int NLAYER = 2, NMOD = 9;

constexpr size_t MiB = 1u << 20;
constexpr size_t al(size_t x) { return (x + MiB - 1) / MiB * MiB; }
constexpr size_t WS_CTL = 0, CTL_ZERO_BYTES = 1 * MiB;
constexpr size_t WS_MODS = 1 * MiB;
constexpr size_t WS_ROPE = WS_MODS + al((size_t)NLAYER * 3 * NMOD * DM * 4);
constexpr size_t WS_WF1 = WS_ROPE + MiB;
constexpr size_t SZ_WF1 = (size_t)FF2 * DM * 2;
constexpr size_t WS_WF2 = WS_WF1 + al(4 * SZ_WF1);
constexpr size_t SZ_WF2 = (size_t)DM * FF * 2;
constexpr size_t WS_WIN = WS_WF2 + al(4 * SZ_WF2);
constexpr size_t SZ_WIN = (size_t)PROJP * DM * 2;
constexpr size_t WS_WLO = WS_WIN + al(2 * SZ_WIN);
constexpr size_t SZ_WLO = (size_t)LOW * ACTW * 2;
constexpr size_t WS_WBR = WS_WLO + al(2 * SZ_WLO);
constexpr size_t SZ_WBR = (size_t)3 * DM * 1024 * 2;
constexpr size_t WS_WOUT = WS_WBR + al(2 * SZ_WBR);
constexpr size_t SZ_WOUT = (size_t)DM * DM * 2;
constexpr size_t WS_XS = WS_WOUT + al(2 * SZ_WOUT);
constexpr size_t WS_XN = WS_XS + al((size_t)MT * DM * 4);
constexpr size_t WS_P = WS_XN + al((size_t)MT * DM * 2);
constexpr size_t WS_R1 = WS_P + al((size_t)MT * PROJP * 2);
constexpr size_t WS_ACT = WS_R1 + al((size_t)MT * FF * 2);
constexpr size_t WS_RKVK = WS_ACT + al((size_t)MT * ACTW * 2);
constexpr size_t WS_QK = WS_RKVK + al((size_t)MT * 4096 * 2);
constexpr size_t WS_YS = WS_QK + al((size_t)MT * DM * 2);
constexpr size_t WS_Y3 = WS_YS + al((size_t)2 * MT * 1024 * 2);
constexpr size_t WS_OJ = WS_Y3 + al((size_t)3 * MT * 1024 * 2);
constexpr size_t WS_PART = WS_OJ + al((size_t)2 * MT * 1024 * 2);
constexpr size_t WS_ZF = WS_PART + al((size_t)16 * NCTX * DM * 2);
constexpr size_t WS_IMG = WS_ZF + al((size_t)MT * DM * 2);
constexpr size_t WS_END = WS_IMG + al((size_t)64 * 136 * 22528);

constexpr int CW_TMO = 0, CW_CODE = 1, CW_BAR = 4096;

constexpr int RING_BYTES = 131072, LDSCTL_OFF = RING_BYTES, MISC_OFF = LDSCTL_OFF + 320, LDS_BYTES = 147456;

#define GAS __attribute__((address_space(1)))
#define LAS __attribute__((address_space(3)))
typedef unsigned short bf16;
typedef unsigned v4u __attribute__((ext_vector_type(4)));
typedef unsigned v2u __attribute__((ext_vector_type(2)));
typedef float f32x4 __attribute__((ext_vector_type(4)));
typedef short bf16x8 __attribute__((ext_vector_type(8)));
typedef GAS unsigned gu32;
#define RLX_AGENT __ATOMIC_RELAXED, __HIP_MEMORY_SCOPE_AGENT
__device__ __forceinline__ unsigned f2bf(float f) { unsigned u = __builtin_bit_cast(unsigned, f); return (u + 0x7fffu + ((u >> 16) & 1u)) >> 16; }
__device__ __forceinline__ unsigned pk2(float lo, float hi) { return f2bf(lo) | (f2bf(hi) << 16); }
__device__ __forceinline__ float bflo(unsigned w) { return __builtin_bit_cast(float, w << 16); }
__device__ __forceinline__ float bfhi(unsigned w) { return __builtin_bit_cast(float, w & 0xffff0000u); }
__device__ __forceinline__ float bf1(bf16 h) { return __builtin_bit_cast(float, (unsigned)h << 16); }
__device__ __forceinline__ void unpack8(const v4u w, float (&f)[8]) { f[0] = bflo(w.x); f[1] = bfhi(w.x); f[2] = bflo(w.y); f[3] = bfhi(w.y); f[4] = bflo(w.z); f[5] = bfhi(w.z); f[6] = bflo(w.w); f[7] = bfhi(w.w); }
__device__ __forceinline__ v4u pack8(const float (&f)[8]) { v4u w; w.x = pk2(f[0], f[1]); w.y = pk2(f[2], f[3]); w.z = pk2(f[4], f[5]); w.w = pk2(f[6], f[7]); return w; }
__device__ __forceinline__ float fsigm(float x) { return __builtin_amdgcn_rcpf(1.f + __expf(-x)); }
__device__ __forceinline__ float ftanh(float x) { return 1.f - 2.f * __builtin_amdgcn_rcpf(__expf(2.f * x) + 1.f); }
__device__ __forceinline__ float gelu_t(float x) { return 0.5f * x * (1.f + ftanh(0.7978845608f * (x + 0.044715f * x * x * x))); }
__device__ __forceinline__ float wave_sum(float v) {
#pragma unroll
    for (int o = 1; o < 64; o <<= 1) v += __shfl_xor(v, o);
    return v;
}
#define XB_TMO      128
#define XB_XCNT(j)  (256  + 64 * (j))
#define XB_XSUB(j)  (1280 + 64 * (j))
#define XB_XGEN(j)  (2304 + 64 * (j))
#define XB_TOP      3328
#define XB_TOPGEN   3392
#define XCD_BAR_WORDS 3456
#define XB_SPIN_CAP (1u << 18)

__device__ __forceinline__ unsigned xb_ld(unsigned* p)              { return __hip_atomic_load(p, __ATOMIC_RELAXED, __HIP_MEMORY_SCOPE_AGENT); }
__device__ __forceinline__ unsigned xb_add(unsigned* p, unsigned v) { return __hip_atomic_fetch_add(p, v, __ATOMIC_RELAXED, __HIP_MEMORY_SCOPE_AGENT); }
__device__ __forceinline__ unsigned xb_xcc_id() { return (unsigned)__builtin_amdgcn_s_getreg((3 << 11) | 20) & 0xFu; }
#define XB_SPIN(cond, bar) do { unsigned _sp = 0; while (cond) { __builtin_amdgcn_s_sleep(1); \
    if ((++_sp & 255u) == 0u) { if (xb_ld(&(bar)[XB_TMO])) break; if (_sp > XB_SPIN_CAP) { atomicAdd(&(bar)[XB_TMO], 1u); break; } } } } while (0)

struct XcdBarrier {
    unsigned* bar; unsigned x;
    volatile LAS unsigned* st;
};

__device__ __forceinline__ XcdBarrier xcd_barrier_post(unsigned* bar, volatile LAS unsigned* st) {
    XcdBarrier b; b.bar = bar; b.x = xb_xcc_id(); b.st = st;
    if (threadIdx.x == 0) (void)xb_add(&bar[XB_XCNT(b.x)], 1u);
    return b;
}
__device__ __forceinline__ void xcd_barrier_complete(unsigned* bar, unsigned x, unsigned& nloc, unsigned& nx) {
    const unsigned G = gridDim.x * gridDim.y * gridDim.z;
    unsigned sum, cnt, mine, sp = 0u;
    for (;;) {
        sum = 0u; cnt = 0u; mine = 0u;
#pragma unroll
        for (unsigned j = 0; j < 16; ++j) { const unsigned c = xb_ld(&bar[XB_XCNT(j)]); sum += c; cnt += (c > 0u) ? 1u : 0u; mine = (j == x) ? c : mine; }
        if (sum == G) break;
        __builtin_amdgcn_s_sleep(1);
        if ((++sp & 255u) == 0u) { if (xb_ld(&bar[XB_TMO])) break; if (sp > XB_SPIN_CAP) { atomicAdd(&bar[XB_TMO], 1u); break; } }
    }
    nloc = mine > 0u ? mine : 1u; nx = cnt > 0u ? cnt : 1u;
}

__device__ __forceinline__ void xcd_barrier(const XcdBarrier& b) {
    asm volatile("s_waitcnt vmcnt(0)" ::: "memory");
    __syncthreads();
    if (threadIdx.x == 0) {
        unsigned* bar = b.bar;
        __builtin_amdgcn_s_waitcnt(0);
        unsigned nloc = b.st[0], nx = b.st[1];
        if (nloc == 0u) { xcd_barrier_complete(bar, b.x, nloc, nx); b.st[0] = nloc; b.st[1] = nx; }
        const unsigned old = xb_add(&bar[XB_XSUB(b.x)], 1u);
        const unsigned gen = old / nloc;
        if (old + 1u == (gen + 1u) * nloc) {
            __builtin_amdgcn_fence(__ATOMIC_RELEASE, "agent");
            asm volatile("s_waitcnt vmcnt(0)" ::: "memory");
            const unsigned og = xb_add(&bar[XB_TOP], 1u);
            const unsigned tg = og / nx;
            if (og + 1u == (tg + 1u) * nx) xb_add(&bar[XB_TOPGEN], 1u);
            else XB_SPIN(xb_ld(&bar[XB_TOPGEN]) == tg, bar);
            __builtin_amdgcn_fence(__ATOMIC_ACQUIRE, "agent");
            xb_add(&bar[XB_XGEN(b.x)], 1u);
            asm volatile("s_waitcnt vmcnt(0)" ::: "memory");
        } else {
            XB_SPIN(xb_ld(&bar[XB_XGEN(b.x)]) == gen, bar);
            __builtin_amdgcn_fence(__ATOMIC_ACQUIRE, "agent");
            asm volatile("s_waitcnt vmcnt(0)" ::: "memory");
        }
    }
    __syncthreads();
}

struct Args { const float* in[31]; float* out; unsigned char* ws; int ph_lo, ph_hi; };
enum In { I_X = 0, I_C, I_CTX, I_CCTX, I_WADA, I_BADA, I_NORMG, I_FFNIN, I_FFNOUT, I_WIN, I_GMVN, I_GMWS, I_GMBS, I_CONV, I_W0, I_WUP, I_A0, I_AUP, I_GUP, I_KK, I_KA, I_RK, I_LNG, I_LNB,
          I_QN, I_KN, I_LAM, I_SUBLN, I_WBR, I_BGATE, I_WOUT };

__device__ __forceinline__ void ph_ada(const Args& a, LAS unsigned char* lds, int tid, int vcu, int G) {
    LAS float* sc = (LAS float*)lds;
    LAS float* red = sc + 3 * 2048;
    const float* c = a.in[I_C]; const float* cc = a.in[I_CCTX];
    for (int i = tid; i < 3 * 2048; i += NTHR) { const float x = i < 4096 ? c[i] : cc[i - 4096]; sc[i] = x * fsigm(x); }
    __syncthreads();
    const int lane = tid & 63, wave = tid >> 6;
    float* mods = (float*)(a.ws + WS_MODS);
    for (int u = vcu; u < NLAYER * 288; u += G) {
        const int l = u / 288, jc = u - l * 288, j = jc * 64 + lane;
        const float* W = a.in[I_WADA] + (size_t)l * 2048 * 18432 + j;
        float s0 = 0.f, s1 = 0.f, s2 = 0.f;
        const int k0 = wave * 256;
#pragma unroll 32
        for (int k = 0; k < 256; ++k) { const float w = __builtin_nontemporal_load(W + (size_t)(k0 + k) * 18432); s0 += sc[k0 + k] * w; s1 += sc[2048 + k0 + k] * w; s2 += sc[4096 + k0 + k] * w; }
        red[(wave * 3 + 0) * 64 + lane] = s0; red[(wave * 3 + 1) * 64 + lane] = s1; red[(wave * 3 + 2) * 64 + lane] = s2;
        __syncthreads();
        if (wave < 3) { float s = a.in[I_BADA][(size_t)l * 18432 + j];
#pragma unroll
            for (int w8 = 0; w8 < 8; ++w8) s += red[(w8 * 3 + wave) * 64 + lane];
            mods[(size_t)(l * 3 + wave) * 18432 + j] = s; }
        __syncthreads();
    }
}
__device__ __forceinline__ void transpose_item(const float* W, int N, int sc0, bf16* WT, int Kd, int nd0, int k0, LAS float* scr, int lane, bool permq = false) {
    if (sc0 >= 0) {
#pragma unroll
        for (int i = 0; i < 32; ++i) { const int kk = 2 * i + (lane >> 5); scr[kk * 33 + (lane & 31)] = __builtin_nontemporal_load(W + (size_t)(k0 + kk) * N + sc0 + (lane & 31)); }
    } else {
#pragma unroll 8
        for (int i = 0; i < 32; ++i) { const int kk = 2 * i + (lane >> 5); scr[kk * 33 + (lane & 31)] = 0.f; }
    }
    asm volatile("s_waitcnt lgkmcnt(0)" ::: "memory");
    const int c = lane & 7;
#pragma unroll
    for (int j = 0; j < 4; ++j) { const int n = (lane >> 3) + 8 * j;
        const int ns = permq ? (((n & 7) < 4) ? 4 * (n >> 3) + (n & 7) : 16 + 4 * (n >> 3) + (n & 7) - 4) : n;
        const LAS float* s = scr + (8 * c) * 33 + ns;
        v4u o; o.x = pk2(s[0 * 33], s[1 * 33]); o.y = pk2(s[2 * 33], s[3 * 33]); o.z = pk2(s[4 * 33], s[5 * 33]); o.w = pk2(s[6 * 33], s[7 * 33]);
        *(GAS v4u*)(WT + (size_t)(nd0 + n) * Kd + k0 + 8 * c) = o; }
    asm volatile("s_waitcnt lgkmcnt(0)" ::: "memory");
}
__device__ __forceinline__ void ph_weights(const Args& a, int l, LAS unsigned char* lds, int tid, int vcu, int G) {
    const int lane = tid & 63, wave = tid >> 6;
    LAS float* scr = (LAS float*)(lds + wave * 16384);
    const int gw = vcu * NWAVES + wave, NGW = G * NWAVES;
    constexpr int I_F1 = 32 * (FF2 / 32), I_F2 = (FF / 64) * (DM / 32), I_IN = 32 * (PROJP / 32), I_BR = 16 * (DM / 32), I_WO = 32 * (DM / 32);
    constexpr int NITEMS = 2 * I_F1 + 2 * I_F2 + I_IN + 3 * I_BR + I_WO;
    unsigned char* ws = a.ws;
    for (int it = gw; it < NITEMS; it += NGW) {
        int r = it;
        if (r < 2 * I_F1) { const int mi = l * 2 + r / I_F1, q = r % I_F1, nb = q % (FF2 / 32), kb = q / (FF2 / 32), nd0 = 32 * nb, pn = nd0 >> 8, rr = nd0 & 255;
            const int sc0 = rr < 128 ? pn * 128 + rr : FF + pn * 128 + (rr - 128);
            transpose_item(a.in[I_FFNIN] + (size_t)mi * DM * FF2, FF2, sc0, (bf16*)(ws + WS_WF1 + (size_t)mi * SZ_WF1), DM, nd0, 64 * kb, scr, lane); continue; }
        r -= 2 * I_F1;
        if (r < 2 * I_F2) { const int mi = l * 2 + r / I_F2, q = r % I_F2, nb = q % (DM / 32), kb = q / (DM / 32);
            transpose_item(a.in[I_FFNOUT] + (size_t)mi * FF * DM, DM, 32 * nb, (bf16*)(ws + WS_WF2 + (size_t)mi * SZ_WF2), FF, 32 * nb, 64 * kb, scr, lane); continue; }
        r -= 2 * I_F2;
        if (r < I_IN) { const int mi = l, q = r, nb = q % (PROJP / 32), kb = q / (PROJP / 32), nd0 = 32 * nb, T = nd0 >> 8, cc = nd0 & 255;
            int sc0; bool pq = false;
            if (T <= 21) sc0 = nd0;
            else if (T == 22) sc0 = cc < 128 ? nd0 : -1;
            else if (T <= 30) { sc0 = P_QKV + ((T - 23) * 4 + ((cc >> 5) & 3)) * 64 + (cc >> 7) * 32; pq = true; }
            else if (T <= 34) sc0 = P_QKV + 2048 + (nd0 - 31 * 256);
            else sc0 = P_GATE + (nd0 - 35 * 256);
            transpose_item(a.in[I_WIN] + (size_t)mi * DM * PROJ, PROJ, sc0, (bf16*)(ws + WS_WIN + (size_t)mi * SZ_WIN), DM, nd0, 64 * kb, scr, lane, pq); continue; }
        r -= I_IN;
        if (r < 3 * I_BR) { const int mi = l * 3 + r / I_BR, q = r % I_BR, nb = q % (DM / 32), kb = q / (DM / 32);
            transpose_item(a.in[I_WBR] + (size_t)mi * 1024 * DM, DM, 32 * nb, (bf16*)(ws + WS_WBR + (size_t)mi * ((size_t)DM * 1024 * 2)), 1024, 32 * nb, 64 * kb, scr, lane); continue; }
        r -= 3 * I_BR;
        { const int mi = l, q = r, nb = q % (DM / 32), kb = q / (DM / 32);
            transpose_item(a.in[I_WOUT] + (size_t)mi * DM * DM, DM, 32 * nb, (bf16*)(ws + WS_WOUT + (size_t)mi * SZ_WOUT), DM, 32 * nb, 64 * kb, scr, lane); }
    }
}
__device__ __forceinline__ void ph_small(const Args& a, int tid, int vcu, int G) {
    unsigned char* ws = a.ws;
    const int gt = vcu * NTHR + tid, NGT = G * NTHR;
    for (int i = gt; i < NLAYER * LOW * (ACTW / 8); i += NGT) {
        const int l = i / (LOW * (ACTW / 8)), q = i % (LOW * (ACTW / 8)), n = q / (ACTW / 8), k0 = (q % (ACTW / 8)) * 8, sec = n >> 10, cc = n & 1023;
        float f[8];
#pragma unroll
        for (int e = 0; e < 8; ++e) { const int k = k0 + e; float v = 0.f;
            if (sec == 0) { if (k < 256) v = a.in[I_GUP][((size_t)l * 256 + k) * 1024 + cc]; }
            else if (sec <= 2) { const int d = sec - 1, kb = 256 + 128 * d; if (k >= kb && k < kb + 96) v = a.in[I_WUP][((size_t)(l * 2 + d) * 96 + (k - kb)) * 1024 + cc]; }
            else { const int d = sec - 3, kb = 512 + 128 * d; if (k >= kb && k < kb + 96) v = a.in[I_AUP][((size_t)(l * 2 + d) * 96 + (k - kb)) * 1024 + cc]; }
            f[e] = v; }
        *(GAS v4u*)((bf16*)(ws + WS_WLO) + ((size_t)l * LOW + n) * ACTW + k0) = pack8(f);
    }
    for (int i = gt; i < 64 * 16; i += NGT) { const int p = i >> 4, ii = i & 15;
        const float inv = exp2f(-(float)(2 * ii) * (1.f / 32.f) * 13.287712379549449f);
        const float rev = (float)p * inv * 0.15915494309189535f;
        float* rt = (float*)(ws + WS_ROPE) + 2 * i; rt[0] = __builtin_amdgcn_cosf(rev); rt[1] = __builtin_amdgcn_sinf(rev); }
}

__device__ __forceinline__ void norm_row_store(f32x4 (&v)[8], int m, const float* gain, const float* mods, int si, bf16* XN, int lane) {
    float ss = 0.f;
#pragma unroll
    for (int j = 0; j < 8; ++j) ss += (v[j].x * v[j].x + v[j].y * v[j].y) + (v[j].z * v[j].z + v[j].w * v[j].w);
    const float rinv = 1.f / sqrtf(wave_sum(ss) * (1.f / DM) + 1e-6f);
    const int set = m < TSEQ ? 0 : (m < NLAT ? 1 : 2);
    const float* sh = mods + (size_t)(set * NMOD + si) * DM; const float* scl = sh + DM;
#pragma unroll
    for (int j = 0; j < 8; ++j) { const int col = 4 * lane + 256 * j;
        const f32x4 g = *(const GAS f32x4*)(gain + col), s1 = *(const GAS f32x4*)(scl + col), s0 = *(const GAS f32x4*)(sh + col);
        const f32x4 o = (v[j] * rinv * g) * (s1 + 1.f) + s0;
        v2u w; w.x = pk2(o.x, o.y); w.y = pk2(o.z, o.w);
        *(GAS v2u*)(XN + (size_t)m * DM + col) = w; }
}
__device__ __forceinline__ void ph_norm(const float* xl, const float* xc, const float* gain, const float* mods  , int si, bf16* XN, float* xs_out, const bf16* part, int nsplit, int nrows, int gw, int NGW, int lane, LAS float* red) {
    if (NLAT == 4 * NGW) {
        f32x4 v[4][8];
#pragma unroll
        for (int q = 0; q < 4; ++q)
#pragma unroll
            for (int j = 0; j < 8; ++j) v[q][j] = *(const GAS f32x4*)(xl + (size_t)(gw + q * NGW) * DM + 4 * lane + 256 * j);
        float rinv[4];
#pragma unroll
        for (int q = 0; q < 4; ++q) { float ss = 0.f;
#pragma unroll
            for (int j = 0; j < 8; ++j) ss += (v[q][j].x * v[q][j].x + v[q][j].y * v[q][j].y) + (v[q][j].z * v[q][j].z + v[q][j].w * v[q][j].w);
            rinv[q] = 1.f / sqrtf(wave_sum(ss) * (1.f / DM) + 1e-6f); }
        const float* sh0 = mods + (size_t)(0 * NMOD + si) * DM; const float* sh1 = mods + (size_t)(1 * NMOD + si) * DM;
#pragma unroll
        for (int j = 0; j < 8; ++j) { const int col = 4 * lane + 256 * j;
            const f32x4 g = *(const GAS f32x4*)(gain + col), a0 = *(const GAS f32x4*)(sh0 + DM + col) + 1.f, b0 = *(const GAS f32x4*)(sh0 + col), a1 = *(const GAS f32x4*)(sh1 + DM + col) + 1.f, b1 = *(const GAS f32x4*)(sh1 + col);
#pragma unroll
            for (int q = 0; q < 4; ++q) { const f32x4 o = (v[q][j] * rinv[q] * g) * (q < 2 ? a0 : a1) + (q < 2 ? b0 : b1);
                v2u w; w.x = pk2(o.x, o.y); w.y = pk2(o.z, o.w);
                *(GAS v2u*)(XN + (size_t)(gw + q * NGW) * DM + col) = w; } }
    } else
    for (int m = gw; m < NLAT; m += 2 * NGW) {
        const int m2 = m + NGW; const bool two = m2 < NLAT;
        f32x4 v[8], u[8];
#pragma unroll
        for (int j = 0; j < 8; ++j) v[j] = *(const GAS f32x4*)(xl + (size_t)m * DM + 4 * lane + 256 * j);
        if (two) {
#pragma unroll
            for (int j = 0; j < 8; ++j) u[j] = *(const GAS f32x4*)(xl + (size_t)m2 * DM + 4 * lane + 256 * j); }
        norm_row_store(v, m, gain, mods, si, XN, lane);
        if (two) norm_row_store(u, m2, gain, mods, si, XN, lane);
    }
    if (nrows > NLAT && NCTX * 4 == NGW) {
        const int wave = gw & 7, r = gw >> 2, m = NLAT + r, col = (gw & 3) * 512 + 8 * lane;
        f32x4 x0 = *(const GAS f32x4*)(xc + (size_t)r * DM + col), x1 = *(const GAS f32x4*)(xc + (size_t)r * DM + col + 4);
        if (part != nullptr)
#pragma nounroll
        for (int s = 0; s < nsplit; s += 8) {
            v4u p[8];
#pragma unroll
            for (int q = 0; q < 8; ++q) p[q] = *(const GAS v4u*)(part + ((size_t)(s + q) * NCTX + r) * DM + col);
#pragma unroll
            for (int q = 0; q < 8; ++q) { x0.x += bflo(p[q].x); x0.y += bfhi(p[q].x); x0.z += bflo(p[q].y); x0.w += bfhi(p[q].y); x1.x += bflo(p[q].z); x1.y += bfhi(p[q].z); x1.z += bflo(p[q].w); x1.w += bfhi(p[q].w); } }
        *(GAS f32x4*)(xs_out + (size_t)m * DM + col) = x0; *(GAS f32x4*)(xs_out + (size_t)m * DM + col + 4) = x1;
        const float ss = wave_sum((x0.x * x0.x + x0.y * x0.y) + (x0.z * x0.z + x0.w * x0.w) + (x1.x * x1.x + x1.y * x1.y) + (x1.z * x1.z + x1.w * x1.w));
        if (lane == 0) red[wave] = ss;
        __syncthreads();
        const LAS float* rq = red + (wave & 4);
        const float rinv = 1.f / sqrtf(((rq[0] + rq[1]) + (rq[2] + rq[3])) * (1.f / DM) + 1e-6f);
        const float* sh = mods + (size_t)(2 * NMOD + si) * DM; const float* scl = sh + DM;
        const f32x4 g0 = *(const GAS f32x4*)(gain + col), g1 = *(const GAS f32x4*)(gain + col + 4), s10 = *(const GAS f32x4*)(scl + col), s11 = *(const GAS f32x4*)(scl + col + 4), s00 = *(const GAS f32x4*)(sh + col), s01 = *(const GAS f32x4*)(sh + col + 4);
        const f32x4 o0 = (x0 * rinv * g0) * (s10 + 1.f) + s00, o1 = (x1 * rinv * g1) * (s11 + 1.f) + s01;
        v4u w; w.x = pk2(o0.x, o0.y); w.y = pk2(o0.z, o0.w); w.z = pk2(o1.x, o1.y); w.w = pk2(o1.z, o1.w);
        *(GAS v4u*)(XN + (size_t)m * DM + col) = w;
        __syncthreads();
    } else
    if (nrows > NLAT && (gw & 3) == 0) for (int r = gw >> 2; r < NCTX; r += NGW >> 2) {
        const int m = NLAT + r;
        f32x4 v[8];
#pragma unroll
        for (int j = 0; j < 8; ++j) v[j] = *(const GAS f32x4*)(xc + (size_t)r * DM + 4 * lane + 256 * j);
        if (part != nullptr)
#pragma nounroll
        for (int s = 0; s < nsplit; s += 4) {
            v2u p[4][8];
#pragma unroll
            for (int q = 0; q < 4; ++q)
#pragma unroll
                for (int j = 0; j < 8; ++j) p[q][j] = *(const GAS v2u*)(part + ((size_t)(s + q) * NCTX + r) * DM + 4 * lane + 256 * j);
#pragma unroll
            for (int q = 0; q < 4; ++q)
#pragma unroll
                for (int j = 0; j < 8; ++j) { v[j].x += bflo(p[q][j].x); v[j].y += bfhi(p[q][j].x); v[j].z += bflo(p[q][j].y); v[j].w += bfhi(p[q][j].y); } }
#pragma unroll
        for (int j = 0; j < 8; ++j) *(GAS f32x4*)(xs_out + (size_t)m * DM + 4 * lane + 256 * j) = v[j];
        norm_row_store(v, m, gain, mods, si, XN, lane);
    }
}

struct RkvkItem { v4u x[3][3]; int m, c0; bool hp, hn; };
__device__ __forceinline__ void rkvk_load(RkvkItem& it, const bf16* P, int i) {
    const int m = i >> 7, c0 = (i & 127) * 8; it.m = m; it.c0 = c0;
    const int t = m < NLAT ? (m & (TSEQ - 1)) : ((m - NLAT) & (TCTX - 1)), tl = m < NLAT ? TSEQ : TCTX;
    it.hp = t > 0; it.hn = t < tl - 1;
#pragma unroll
    for (int sec = 0; sec < 3; ++sec) { const bf16* pc = P + (size_t)m * PROJP + P_RKV + sec * 1024 + c0;
        it.x[sec][1] = *(const GAS v4u*)pc;
        it.x[sec][0] = it.hp ? *(const GAS v4u*)(pc - PROJP) : (v4u){0u, 0u, 0u, 0u};
        it.x[sec][2] = it.hn ? *(const GAS v4u*)(pc + PROJP) : (v4u){0u, 0u, 0u, 0u}; }
}
__device__ __forceinline__ void rkvk_finish(const RkvkItem& it, bf16* RK, const float* cw, const float* kkw) {
    const int c0 = it.c0; float rkv[3][8];
#pragma unroll
    for (int sec = 0; sec < 3; ++sec) { const int col = sec * 1024 + c0; float x0[8], x1[8], x2[8];
        unpack8(it.x[sec][0], x0); unpack8(it.x[sec][1], x1); unpack8(it.x[sec][2], x2);
#pragma unroll
        for (int e = 0; e < 8; ++e) rkv[sec][e] = x1[e] * cw[3072 + col + e] + x0[e] * cw[col + e] + x2[e] * cw[2 * 3072 + col + e]; }
    float kk8[8]; float ss = 0.f;
#pragma unroll
    for (int e = 0; e < 8; ++e) { kk8[e] = rkv[1][e] * kkw[c0 + e]; ss += kk8[e] * kk8[e]; }
    ss += __shfl_xor(ss, 1); ss += __shfl_xor(ss, 2); ss += __shfl_xor(ss, 4);
    const float rinv = 1.f / sqrtf(ss + 1e-12f);
    GAS v4u* dst = (GAS v4u*)(RK + (size_t)it.m * 4096 + c0 * 4);
#pragma unroll
    for (int j = 0; j < 4; ++j) { v4u o; o.x = pk2(rkv[0][2 * j], rkv[1][2 * j]); o.y = pk2(rkv[2][2 * j], kk8[2 * j] * rinv); o.z = pk2(rkv[0][2 * j + 1], rkv[1][2 * j + 1]); o.w = pk2(rkv[2][2 * j + 1], kk8[2 * j + 1] * rinv); dst[j] = o; }
}
__device__ __forceinline__ void ph_e1(const Args& a, int l, int gt, int NGT) {
    const bf16* P = (const bf16*)(a.ws + WS_P); bf16* RK = (bf16*)(a.ws + WS_RKVK);
    const float* cw = a.in[I_CONV] + (size_t)l * 3 * 3072; const float* kkw = a.in[I_KK] + l * 1024;
    constexpr int NI = MT * 128;
    for (int i = gt; i < NI; i += 2 * NGT) {
        RkvkItem A, B; const bool two = i + NGT < NI;
        rkvk_load(A, P, i); if (two) rkvk_load(B, P, i + NGT);
        rkvk_finish(A, RK, cw, kkw); if (two) rkvk_finish(B, RK, cw, kkw);
    }
}

__device__ __forceinline__ void ph_gmlp(const Args& a, int l, LAS unsigned char* lds, int tid, int vcu, int G) {
    constexpr int VP = 136;
    LAS bf16* vnT = (LAS bf16*)lds;
    const bf16* P = (const bf16*)(a.ws + WS_P); bf16* YA = (bf16*)(a.ws + WS_Y3);
    const float* vng = a.in[I_GMVN] + l * 1024; const float* wsm = a.in[I_GMWS] + (size_t)l * 8 * 128 * 128; const float* bs = a.in[I_GMBS] + l * 8 * 128;
    const int lane = tid & 63, w = tid >> 6, fr = lane & 15, fq = lane >> 4;
    for (int u = vcu; u < (MT / 128) * 8; u += G) {
        const int n = u >> 3, g = u & 7, m0 = n * 128;
        { const int q = tid >> 2, qt = tid & 3; const bf16* src = P + (size_t)(m0 + q) * PROJP + P_V + g * 128 + qt * 32;
            float v[32]; float ss = 0.f;
#pragma unroll
            for (int j = 0; j < 4; ++j) { float f[8]; unpack8(*(const GAS v4u*)(src + 8 * j), f);
#pragma unroll
                for (int e = 0; e < 8; ++e) { const float x = f[e]; v[8 * j + e] = x; ss += x * x; } }
            ss += __shfl_xor(ss, 1); ss += __shfl_xor(ss, 2);
            const float rinv = 1.f / sqrtf(ss * (1.f / 128.f) + 1e-6f);
#pragma unroll
            for (int e = 0; e < 32; ++e) { const int c = qt * 32 + e; vnT[c * VP + q] = (bf16)f2bf(v[e] * rinv * vng[g * 128 + c]); } }
        __syncthreads();
        pg8::f32x4 acc[8];
#pragma unroll
        for (int cb = 0; cb < 8; ++cb) acc[cb] = (pg8::f32x4){0.f, 0.f, 0.f, 0.f};
#pragma unroll
        for (int ks = 0; ks < 4; ++ks) {
            const float* wr = wsm + ((size_t)g * 128 + 16 * w + fr) * 128 + ks * 32 + 8 * fq;
            const f32x4 w0 = *(const GAS f32x4*)wr, w1 = *(const GAS f32x4*)(wr + 4);
            v4u aw; aw.x = pk2(w0.x, w0.y); aw.y = pk2(w0.z, w0.w); aw.z = pk2(w1.x, w1.y); aw.w = pk2(w1.z, w1.w);
            const bf16x8 af = __builtin_bit_cast(bf16x8, aw);
#pragma unroll
            for (int cb = 0; cb < 8; ++cb) { const bf16x8 bfr = *(const LAS bf16x8*)(vnT + (cb * 16 + fr) * VP + ks * 32 + 8 * fq);
                acc[cb] = __builtin_amdgcn_mfma_f32_16x16x32_bf16(bfr, af, acc[cb], 0, 0, 0); }
        }
        { const int p = 16 * w + fr; const float bsp = bs[g * 128 + p];
          const bf16* pup = P + (size_t)(m0 + p) * PROJP + P_U + g * 128 + 4 * fq; bf16* yap = YA + (size_t)(m0 + p) * 1024 + g * 128 + 4 * fq;
          v2u pu[8];
#pragma unroll
          for (int cb = 0; cb < 8; ++cb) pu[cb] = *(const GAS v2u*)(pup + cb * 16);
#pragma unroll
          for (int cb = 0; cb < 8; ++cb) { v2u o;
              o.x = pk2(bflo(pu[cb].x) * (acc[cb][0] + bsp), bfhi(pu[cb].x) * (acc[cb][1] + bsp)); o.y = pk2(bflo(pu[cb].y) * (acc[cb][2] + bsp), bfhi(pu[cb].y) * (acc[cb][3] + bsp));
              *(GAS v2u*)(yap + cb * 16) = o; } }
        __syncthreads();
    }
}

namespace att {
using bf16x8 = __attribute__((ext_vector_type(8))) short;
using s16x4  = __attribute__((ext_vector_type(4))) short;
using f32x16 = __attribute__((ext_vector_type(16))) float;
using u32x4  = __attribute__((ext_vector_type(4))) unsigned;
constexpr int NW = 8, QBLK = 32, KVBLK = 64;
constexpr int SHM_V = KVBLK * 128 * 2, SHM_K = KVBLK * 64 * 2, SHM_ATTN = 2 * SHM_V + 2 * SHM_K + NW * 64 * 4;
#define KSWZ(row, colB) ((row) * 128 + ((colB) ^ ((((row) >> 1) & 7) << 4)))
#define SBAR() __builtin_amdgcn_sched_barrier(0)
__device__ __forceinline__ int crow(int r, int hi) { return (r & 3) + 8 * (r >> 2) + 4 * hi; }
__device__ __forceinline__ unsigned cvtpk(float lo, float hi) { unsigned r; asm volatile("v_cvt_pk_bf16_f32 %0, %1, %2" : "=v"(r) : "v"(lo), "v"(hi)); return r; }
__device__ __forceinline__ void partialSM(f32x16& p0, f32x16& p1) {
#pragma unroll
  for (int r = 0; r < 16; ++r) p0[r] = __builtin_amdgcn_exp2f(p0[r]);
}
__device__ __forceinline__ void finishSM(f32x16& p0, f32x16& p1, float& l_reg, bf16x8& pa0, bf16x8& pa1, bf16x8& pa2, bf16x8& pa3) {
#pragma unroll
  for (int r = 0; r < 16; ++r) p1[r] = __builtin_amdgcn_exp2f(p1[r]);
  float ps = 0;
#pragma unroll
  for (int r = 0; r < 16; ++r) ps += p0[r];
#pragma unroll
  for (int r = 0; r < 16; ++r) ps += p1[r];
  { auto rr = __builtin_amdgcn_permlane32_swap(__float_as_uint(ps), __float_as_uint(ps), false, false);
    ps = __uint_as_float(rr[0]) + __uint_as_float(rr[1]); }
  l_reg += ps;
#define PK4(P, BASE, OUT) do { unsigned a0 = cvtpk(P[BASE + 0], P[BASE + 1]), a1 = cvtpk(P[BASE + 2], P[BASE + 3]);   \
    unsigned b0 = cvtpk(P[BASE + 4], P[BASE + 5]), b1 = cvtpk(P[BASE + 6], P[BASE + 7]);                              \
    auto r0 = __builtin_amdgcn_permlane32_swap(a0, b0, false, false); auto r1 = __builtin_amdgcn_permlane32_swap(a1, b1, false, false); \
    u32x4 w = {r0[0], r1[0], r0[1], r1[1]}; OUT = *reinterpret_cast<bf16x8*>(&w); } while (0)
  PK4(p0, 0, pa0); PK4(p0, 8, pa1); PK4(p1, 0, pa2); PK4(p1, 8, pa3);
#undef PK4
}
__device__ __forceinline__ void qkt(f32x16& p0, f32x16& p1, const unsigned short* Ks, const bf16x8* qr, int r32, int hi) {
  p0 = f32x16{}; p1 = f32x16{};
#pragma unroll
  for (int d0 = 0; d0 < 4; ++d0) { int cb = (d0 * 16 + hi * 8) * 2;
    bf16x8 b0 = *reinterpret_cast<const bf16x8*>((const char*)Ks + KSWZ(r32, cb));
    bf16x8 b1 = *reinterpret_cast<const bf16x8*>((const char*)Ks + KSWZ(32 + r32, cb));
    p0 = __builtin_amdgcn_mfma_f32_32x32x16_bf16(b0, qr[d0], p0, 0, 0, 0);
    p1 = __builtin_amdgcn_mfma_f32_32x32x16_bf16(b1, qr[d0], p1, 0, 0, 0); }
}
__device__ __forceinline__ int v_st(int k, int c) { const int kk = (k & ~0xC) | ((k & 4) << 1) | ((k & 8) >> 1); return ((kk >> 3) * 4 + (c >> 5)) * 512 + ((kk & 7) * 32 + (c & 31)) * 2; }
__device__ __forceinline__ int v_rd_base(int lane) { return ((lane & 3) << 3) | (((lane >> 2) & 3) << 6) | (((lane >> 4) & 1) << 5) | (((lane >> 5) & 1) << 8); }
constexpr int v_rd_off(int d0, int ks, int half) { return d0 * 512 + ks * 4096 + half * 2048; }
template <int OFF> __device__ __forceinline__ s16x4 tr_read(int vb) {
  s16x4 r; asm volatile("ds_read_b64_tr_b16 %0, %1 offset:%2" : "=&v"(r) : "v"(vb), "i"(OFF) : "memory"); return r;
}
template <int D0> __device__ __forceinline__ void pv_one(f32x16& od, int vb, bf16x8 pa0, bf16x8 pa1, bf16x8 pa2, bf16x8 pa3) {
  const s16x4 l0 = tr_read<v_rd_off(D0, 0, 0)>(vb), h0 = tr_read<v_rd_off(D0, 0, 1)>(vb), l1 = tr_read<v_rd_off(D0, 1, 0)>(vb), h1 = tr_read<v_rd_off(D0, 1, 1)>(vb);
  const s16x4 l2 = tr_read<v_rd_off(D0, 2, 0)>(vb), h2 = tr_read<v_rd_off(D0, 2, 1)>(vb), l3 = tr_read<v_rd_off(D0, 3, 0)>(vb), h3 = tr_read<v_rd_off(D0, 3, 1)>(vb);
  asm volatile("s_waitcnt lgkmcnt(0)" ::: "memory"); SBAR();
#define PK(L, H) (bf16x8){L[0], L[1], L[2], L[3], H[0], H[1], H[2], H[3]}
  od = __builtin_amdgcn_mfma_f32_32x32x16_bf16(pa0, PK(l0, h0), od, 0, 0, 0);
  od = __builtin_amdgcn_mfma_f32_32x32x16_bf16(pa1, PK(l1, h1), od, 0, 0, 0);
  od = __builtin_amdgcn_mfma_f32_32x32x16_bf16(pa2, PK(l2, h2), od, 0, 0, 0);
  od = __builtin_amdgcn_mfma_f32_32x32x16_bf16(pa3, PK(l3, h3), od, 0, 0, 0);
#undef PK
}
__device__ __forceinline__ void pv_d0(f32x16* o, int vb, bf16x8 pa0, bf16x8 pa1, bf16x8 pa2, bf16x8 pa3) {
  pv_one<0>(o[0], vb, pa0, pa1, pa2, pa3); pv_one<1>(o[1], vb, pa0, pa1, pa2, pa3); pv_one<2>(o[2], vb, pa0, pa1, pa2, pa3); pv_one<3>(o[3], vb, pa0, pa1, pa2, pa3);
}
__device__ __forceinline__ void attn_unit(const unsigned short* __restrict__ Qb, const unsigned short* __restrict__ Kb, const unsigned short* __restrict__ Vb,
                                          unsigned short* __restrict__ Ob, int NT, int ntl, int klat, int kctx, char* lds) {
  constexpr int LDQ = 2048, LDKK = 2048, LDV = 15104, LDO = 1024;
  const int tid = threadIdx.x, wid = tid >> 6, lane = tid & 63, r32 = lane & 31, hi = lane >> 5;
  unsigned short* V_lds = (unsigned short*)lds; unsigned short* K_lds = (unsigned short*)(lds + 2 * SHM_V);
  float* ws = (float*)(lds + 2 * SHM_V + 2 * SHM_K) + wid * 64; float* li_l = ws;
  float l_reg = 0; f32x16 o[4] = {}; bf16x8 qr[4];
  const unsigned short* Qw = Qb + (long)(wid * QBLK + r32) * LDQ + hi * 8;
#pragma unroll
  for (int d0 = 0; d0 < 4; ++d0) qr[d0] = *reinterpret_cast<const bf16x8*>(Qw + d0 * 16);
  const int sr = tid >> 4, sc = (tid & 15) * 8, vst0 = v_st(sr, sc), vst1 = v_st(32 + sr, sc);
  const int kr = tid >> 3, kc = (tid & 7) * 8, kst = KSWZ(kr, kc * 2);
  const int vb0 = (int)(uintptr_t)V_lds + v_rd_base(lane);
  struct { bf16x8 vs0, vs1, ks0; } sr_[2];
#define KROW(t) ((t) < ntl ? klat + 64 * (t) : kctx + 64 * ((t) - ntl))
#define SLOAD(i, t) do { const long k0_ = KROW(t); sr_[i].vs0 = *reinterpret_cast<const bf16x8*>(&Vb[(k0_ + sr) * LDV + sc]); sr_[i].vs1 = *reinterpret_cast<const bf16x8*>(&Vb[(k0_ + 32 + sr) * LDV + sc]); \
    sr_[i].ks0 = *reinterpret_cast<const bf16x8*>(&Kb[(k0_ + kr) * LDKK + kc]); } while (0)
#define SWRITE(b, i) do { *(bf16x8*)((char*)V_lds + (b) * SHM_V + vst0) = sr_[i].vs0; *(bf16x8*)((char*)V_lds + (b) * SHM_V + vst1) = sr_[i].vs1; \
    *(bf16x8*)((char*)K_lds + (b) * SHM_K + kst) = sr_[i].ks0; } while (0)
#define SWAIT() asm volatile("s_waitcnt vmcnt(3)" ::: "memory")
  f32x16 pA0, pA1, pB0, pB1; bf16x8 pa0, pa1, pa2, pa3;
  constexpr int SE = 0, SO = 1;
  SLOAD(SE, 0); asm volatile("s_waitcnt vmcnt(0)" ::: "memory"); SWRITE(0, SE); __syncthreads();
  qkt(pA0, pA1, K_lds, qr, r32, hi); partialSM(pA0, pA1);
  SLOAD(SO, 1); if (2 < NT) SLOAD(SE, 2);
  SWAIT(); SWRITE(1, SO); __syncthreads();
  for (int j = 1; j + 1 < NT; j += 2) {
    SBAR(); qkt(pB0, pB1, (const unsigned short*)((char*)K_lds + SHM_K), qr, r32, hi);
    finishSM(pA0, pA1, l_reg, pa0, pa1, pa2, pa3); SBAR();
    SLOAD(SO, j + 2); SBAR();
    pv_d0(o, vb0, pa0, pa1, pa2, pa3); partialSM(pB0, pB1);
    __syncthreads(); SWAIT(); SWRITE(0, SE);
    __syncthreads();
    SBAR(); qkt(pA0, pA1, K_lds, qr, r32, hi);
    finishSM(pB0, pB1, l_reg, pa0, pa1, pa2, pa3); SBAR();
    if (j + 3 < NT) SLOAD(SE, j + 3); SBAR();
    pv_d0(o, vb0 + (int)SHM_V, pa0, pa1, pa2, pa3); partialSM(pA0, pA1);
    __syncthreads(); SWAIT(); SWRITE(1, SO);
    __syncthreads();
  }
  SBAR(); qkt(pB0, pB1, (const unsigned short*)((char*)K_lds + SHM_K), qr, r32, hi);
  finishSM(pA0, pA1, l_reg, pa0, pa1, pa2, pa3); SBAR();
  pv_d0(o, vb0, pa0, pa1, pa2, pa3); partialSM(pB0, pB1);
  __syncthreads();
  finishSM(pB0, pB1, l_reg, pa0, pa1, pa2, pa3); SBAR();
  pv_d0(o, vb0 + (int)SHM_V, pa0, pa1, pa2, pa3);
  if (hi == 0) li_l[r32] = l_reg; asm volatile("s_waitcnt lgkmcnt(0)" ::: "memory");
  float rli[16];
#pragma unroll
  for (int r = 0; r < 16; ++r) rli[r] = __builtin_amdgcn_rcpf(li_l[crow(r, hi)]);
  unsigned short* Ow = Ob + (long)(wid * QBLK) * LDO;
#pragma unroll
  for (int r = 0; r < 16; ++r) { int orow = crow(r, hi);
#pragma unroll
    for (int d0 = 0; d0 < 4; ++d0) Ow[(long)orow * LDO + d0 * 32 + r32] = (unsigned short)(cvtpk(o[d0][r] * rli[r], 0.f) & 0xffffu); }
  __syncthreads();
#undef KROW
#undef SLOAD
#undef SWRITE
#undef SWAIT
}
#undef KSWZ
#undef SBAR
}

__device__ __forceinline__ void ph_attn_one(const Args& a, int u, char* lds) {
    const unsigned short* QK = (const unsigned short*)(a.ws + WS_QK); const unsigned short* P = (const unsigned short*)(a.ws + WS_P); unsigned short* OJ = (unsigned short*)(a.ws + WS_OJ);
    int b, hj, qrow0, NT, ntl;
    if (u < 512) { b = u >> 8; hj = (u >> 4) & 15; qrow0 = b * TSEQ + (u & 15) * 256; NT = 68; ntl = 64; }
    else { const int uu = u - 512; b = uu >> 4; hj = uu & 15; qrow0 = NLAT + b * TCTX; NT = 4; ntl = 0; }
    att::attn_unit(QK + (size_t)qrow0 * DM + hj * 64, QK + 1024 + hj * 64, P + P_V2 + (hj >> 1) * 128,
                   OJ + ((size_t)(hj & 1) * MT + qrow0) * 1024 + (hj >> 1) * 128, NT, ntl, b * TSEQ, NLAT + b * TCTX, lds);
}
__device__ __forceinline__ void ph_attn(const Args& a, char* lds, int u0, int ustep, int uend, int cu) {
    bool done = false;
    for (int u = u0; !done; u += ustep) { int uu = u; if (u >= uend) { if (cu < 0) break; uu = 512 + cu; done = true; } ph_attn_one(a, uu, lds); }
}

__device__ __forceinline__ int scan_row(int i, int b, int d) { return i < TCTX ? NLAT + b * TCTX + (d ? TCTX - 1 - i : i) : b * TSEQ + (d ? TSEQ - 1 - (i - TCTX) : (i - TCTX)); }
typedef __amdgpu_buffer_rsrc_t rsrc_t;
typedef short s16x4 __attribute__((ext_vector_type(4)));
typedef __bf16 bf16x2_t __attribute__((ext_vector_type(2)));
typedef float f32x2_t __attribute__((ext_vector_type(2)));
__device__ __forceinline__ unsigned cvtpk_c(float lo, float hi) { f32x2_t v = {lo, hi}; bf16x2_t b = __builtin_convertvector(v, bf16x2_t); return __builtin_bit_cast(unsigned, b); }
constexpr int CS_SLOT = 12288, CS_NSLOT = 8, CS_OFF_A1 = 0, CS_OFF_RH = 2048, CS_OFF_MT = 4352, CS_OFF_Q = 4864, CS_OFF_P = 5376, CS_OFF_KB = 5888, CS_OFF_V = 9984, CS_OFF_G = 12032;
constexpr int CS_PITCH = 144, CS_SCR0 = CS_NSLOT * CS_SLOT, CS_SCR = 8192, CS_S_KK = 0, CS_S_KD = 2304, CS_S_NB = 4608, CS_S_U = 6912;
static_assert(CS_SCR0 + 4 * CS_SCR <= RING_BYTES, "scan LDS");
__device__ __forceinline__ pg8::f32x4 mfma32(bf16x8 a_, bf16x8 b_, pg8::f32x4 c_) { return __builtin_amdgcn_mfma_f32_16x16x32_bf16(a_, b_, c_, 0, 0, 0); }
__device__ __forceinline__ pg8::f32x4 mfma16(v2u a_, v2u b_, pg8::f32x4 c_) { return __builtin_amdgcn_mfma_f32_16x16x16bf16_1k(__builtin_bit_cast(s16x4, a_), __builtin_bit_cast(s16x4, b_), c_, 0, 0, 0); }
__device__ __forceinline__ v2u pack4(const pg8::f32x4 x) { return (v2u){cvtpk_c(x[0], x[1]), cvtpk_c(x[2], x[3])}; }
__device__ __forceinline__ void scan_unit(const Args& a, int l, int u, LAS unsigned char* lds, int tid) {
    const int lane = tid & 63, w = __builtin_amdgcn_readfirstlane(tid >> 6), fr = lane & 15, fq = lane >> 4;
    const int b = u >> 5, h = (u >> 1) & 15, d = u & 1;
    constexpr int NBLK = (TCTX + TSEQ) / 16, NR = NBLK / 4;
    const bf16* LO = (const bf16*)(a.ws + WS_R1); const bf16* RK = (const bf16*)(a.ws + WS_RKVK); bf16* YS = (bf16*)(a.ws + WS_YS);
    const pg8::f32x4 zero4 = (pg8::f32x4){0.f, 0.f, 0.f, 0.f};
    v2u E4[4], A4[4]; v4u R0[4], R1[4];
    float kav[4];
    const int pw = w - 4;
    LAS unsigned char* scr = lds + CS_SCR0 + (pw & 3) * CS_SCR;
    const int dirs = d ? -1 : 1;
    int eoff[4], roff[4], yoff[4];
#pragma unroll
    for (int i = 0; i < 4; ++i) { const int s_ = dirs * (4 * fq + i); eoff[i] = s_ * LOW + 4 * fr; roff[i] = s_ * 4096 + 16 * fr; yoff[i] = s_ * 1024 + fr; }
#define CS_LOAD(blk_) do { const int m0_ = scan_row((blk_) * 16, b, d); const bf16* lob_ = LO + (size_t)m0_ * LOW + 1024 + d * 1024 + h * 64; const bf16* rkb_ = RK + ((size_t)m0_ * 16 + h) * 256; \
        _Pragma("unroll") for (int i = 0; i < 4; ++i) { E4[i] = *(const GAS v2u*)(lob_ + eoff[i]); A4[i] = *(const GAS v2u*)(lob_ + 2048 + eoff[i]); \
        const GAS v4u* rk_ = (const GAS v4u*)(rkb_ + roff[i]); R0[i] = rk_[0]; R1[i] = rk_[1]; } } while (0)
    if (w >= 4) {
#pragma unroll
        for (int c = 0; c < 4; ++c) kav[c] = a.in[I_KA][l * 1024 + h * 64 + 4 * fr + c];
        CS_LOAD(pw);
    }
    pg8::f32x4 S0 = zero4, S1 = zero4, S2 = zero4, S3 = zero4;
    for (int rr = 0; rr <= NR; ++rr) {
        if (w >= 4) {
            if (rr < NR) {
                const int blk = 4 * rr + pw;
                LAS unsigned char* slot = lds + (blk % CS_NSLOT) * CS_SLOT;
                float Ef[4][4], af[4][4], Lin[4][4];
#pragma unroll
                for (int i = 0; i < 4; ++i) { Ef[i][0] = bflo(E4[i].x); Ef[i][1] = bfhi(E4[i].x); Ef[i][2] = bflo(E4[i].y); Ef[i][3] = bfhi(E4[i].y);
                    af[i][0] = bflo(A4[i].x); af[i][1] = bfhi(A4[i].x); af[i][2] = bflo(A4[i].y); af[i][3] = bfhi(A4[i].y); }
                float pre[4], L15[4], G15[4];
#pragma unroll
                for (int c = 0; c < 4; ++c) { float acc = 0.f;
#pragma unroll
                    for (int i = 0; i < 4; ++i) { acc += Ef[i][c]; Lin[i][c] = acc; }
                    const float t1 = __shfl_up(acc, 16); float cum = acc + (fq >= 1 ? t1 : 0.f);
                    const float t2 = __shfl_up(cum, 32); cum += (fq >= 2 ? t2 : 0.f);
                    pre[c] = cum - acc; L15[c] = __shfl(cum, fr + 48); G15[c] = __builtin_amdgcn_exp2f(-L15[c]); }
                float kkh[4][4], kdg[4][4], nbg[4][4]; unsigned vraw[4][4];
                const int posb = ((fr >> 2) * 8 + (fr & 3) * 2) * 2;
#pragma unroll
                for (int i = 0; i < 4; ++i) {
                    float kdh_[4], nbh_[4], rh_[4];
#pragma unroll
                    for (int c = 0; c < 4; ++c) {
                        const unsigned rk_ = c == 0 ? R0[i].x : c == 1 ? R0[i].z : c == 2 ? R1[i].x : R1[i].z, vk_ = c == 0 ? R0[i].y : c == 1 ? R0[i].w : c == 2 ? R1[i].y : R1[i].w;
                        const float r_ = bflo(rk_), k_ = bfhi(rk_), kk_ = bfhi(vk_), a_ = af[i][c];
                        vraw[i][c] = vk_ & 0xffffu;
                        const float Lf = pre[c] + Lin[i][c];
                        const float eL = __builtin_amdgcn_exp2f(Lf), eN = __builtin_amdgcn_rcpf(eL), ekk = __builtin_amdgcn_exp2f(Ef[i][c] - Lf);
                        const float kd = k_ * (1.f + (a_ - 1.f) * kav[c]);
                        kdh_[c] = kd * eL; nbh_[c] = -(kk_ * a_ * eL); kkh[i][c] = kk_ * ekk; rh_[c] = r_ * eN;
                        kdg[i][c] = kdh_[c] * G15[c]; nbg[i][c] = nbh_[c] * G15[c];
                    }
                    const int rb = (4 * fq + i) * CS_PITCH + posb;
                    *(LAS unsigned*)(scr + CS_S_KK + rb) = cvtpk_c(kkh[i][0], kkh[i][1]); *(LAS unsigned*)(scr + CS_S_KK + rb + 64) = cvtpk_c(kkh[i][2], kkh[i][3]);
                    *(LAS unsigned*)(scr + CS_S_KD + rb) = cvtpk_c(kdh_[0], kdh_[1]); *(LAS unsigned*)(scr + CS_S_KD + rb + 64) = cvtpk_c(kdh_[2], kdh_[3]);
                    *(LAS unsigned*)(scr + CS_S_NB + rb) = cvtpk_c(nbh_[0], nbh_[1]); *(LAS unsigned*)(scr + CS_S_NB + rb + 64) = cvtpk_c(nbh_[2], nbh_[3]);
                    *(LAS unsigned*)(slot + CS_OFF_RH + rb) = cvtpk_c(rh_[0], rh_[1]); *(LAS unsigned*)(slot + CS_OFF_RH + rb + 64) = cvtpk_c(rh_[2], rh_[3]);
                }
                if (rr + 1 < NR) CS_LOAD(blk + 4);
#pragma unroll
                for (int c = 0; c < 4; ++c) {
                    *(LAS v4u*)(slot + CS_OFF_KB + c * 1024 + lane * 16) = (v4u){cvtpk_c(kdg[0][c], kdg[1][c]), cvtpk_c(kdg[2][c], kdg[3][c]), cvtpk_c(nbg[0][c], nbg[1][c]), cvtpk_c(nbg[2][c], nbg[3][c])};
                    const int j = 4 * fr + c;
                    *(LAS v2u*)(slot + CS_OFF_V + (((j >> 4) * 4 + fq) * 16 + (j & 15)) * 8) = (v2u){vraw[0][c] | (vraw[1][c] << 16), vraw[2][c] | (vraw[3][c] << 16)};
                }
                if (fq == 0) *(LAS pg8::f32x4*)(slot + CS_OFF_G + fr * 16) = (pg8::f32x4){G15[0], G15[1], G15[2], G15[3]};
                asm volatile("s_waitcnt lgkmcnt(0)" ::: "memory");
                const LAS unsigned char* fa = scr + fr * CS_PITCH + fq * 16; const LAS unsigned char* fh = slot + CS_OFF_RH + fr * CS_PITCH + fq * 16;
                const bf16x8 KK0 = *(const LAS bf16x8*)(fa + CS_S_KK), KK1 = *(const LAS bf16x8*)(fa + CS_S_KK + 64), KD0 = *(const LAS bf16x8*)(fa + CS_S_KD), KD1 = *(const LAS bf16x8*)(fa + CS_S_KD + 64);
                const bf16x8 NB0 = *(const LAS bf16x8*)(fa + CS_S_NB), NB1 = *(const LAS bf16x8*)(fa + CS_S_NB + 64), RH0 = *(const LAS bf16x8*)(fh), RH1 = *(const LAS bf16x8*)(fh + 64);
                pg8::f32x4 dn1 = mfma32(NB1, KK1, mfma32(NB0, KK0, zero4));
                pg8::f32x4 dn1t = mfma32(KK1, NB1, mfma32(KK0, NB0, zero4));
                pg8::f32x4 dmt = mfma32(KK1, KD1, mfma32(KK0, KD0, zero4));
                pg8::f32x4 dq = mfma32(KD1, RH1, mfma32(KD0, RH0, zero4));
                pg8::f32x4 dp = mfma32(NB1, RH1, mfma32(NB0, RH0, zero4));
                pg8::f32x4 idm;
#pragma unroll
                for (int i = 0; i < 4; ++i) { const int row = 4 * fq + i;
                    dn1[i] = row < fr ? dn1[i] : 0.f; dn1t[i] = fr < row ? dn1t[i] : 0.f; dmt[i] = fr < row ? dmt[i] : 0.f; dq[i] = row <= fr ? dq[i] : 0.f; dp[i] = row <= fr ? dp[i] : 0.f;
                    idm[i] = row == fr ? 1.f : 0.f; }
                const v2u pX = pack4(dn1), pXT = pack4(dn1t);
                const pg8::f32x4 x2 = mfma16(pXT, pX, zero4), x2t = mfma16(pX, pXT, zero4);
                const v2u pX2 = pack4(x2), pX2T = pack4(x2t);
                const pg8::f32x4 x4 = mfma16(pX2T, pX2, zero4), x4t = mfma16(pX2, pX2T, zero4);
                const v2u pX4 = pack4(x4), pX4T = pack4(x4t);
                const pg8::f32x4 x8 = mfma16(pX4T, pX4, zero4);
                const pg8::f32x4 t1 = idm + dn1, t1t = idm + dn1t;
                const v2u pT1T = pack4(t1t);
                const pg8::f32x4 t2 = mfma16(pT1T, pX2, t1), t2t = mfma16(pX2, pT1T, t1t);
                const v2u pT2T = pack4(t2t);
                const pg8::f32x4 t3 = mfma16(pT2T, pX4, t2), t3t = mfma16(pX4, pT2T, t2t);
                const pg8::f32x4 dt = mfma16(pack4(t3t), pack4(x8), t3);
                const v2u DTb = pack4(dt);
                pg8::f32x4 da1[4];
#pragma unroll
                for (int c = 0; c < 4; ++c) da1[c] = mfma16((v2u){cvtpk_c(kkh[0][c], kkh[1][c]), cvtpk_c(kkh[2][c], kkh[3][c])}, DTb, zero4);
                const pg8::f32x4 dmt2 = mfma16(pack4(dmt), DTb, zero4);
#pragma unroll
                for (int hh = 0; hh < 2; ++hh)
                    *(LAS v4u*)(slot + CS_OFF_A1 + hh * 1024 + lane * 16) = (v4u){cvtpk_c(da1[2 * hh][0], da1[2 * hh + 1][0]), cvtpk_c(da1[2 * hh][1], da1[2 * hh + 1][1]), cvtpk_c(da1[2 * hh][2], da1[2 * hh + 1][2]), cvtpk_c(da1[2 * hh][3], da1[2 * hh + 1][3])};
                *(LAS v2u*)(slot + CS_OFF_MT + lane * 8) = pack4(dmt2); *(LAS v2u*)(slot + CS_OFF_Q + lane * 8) = pack4(dq); *(LAS v2u*)(slot + CS_OFF_P + lane * 8) = pack4(dp);
            }
        } else if (rr >= 1) {
#pragma nounroll
            for (int q = 0; q < 4; ++q) {
                const int blk = 4 * (rr - 1) + q;
                const LAS unsigned char* slot = lds + (blk % CS_NSLOT) * CS_SLOT;
                const bf16x8 A10 = *(const LAS bf16x8*)(slot + CS_OFF_A1 + lane * 16), A11 = *(const LAS bf16x8*)(slot + CS_OFF_A1 + 1024 + lane * 16);
                const bf16x8 RH0 = *(const LAS bf16x8*)(slot + CS_OFF_RH + fr * CS_PITCH + fq * 16), RH1 = *(const LAS bf16x8*)(slot + CS_OFF_RH + fr * CS_PITCH + fq * 16 + 64);
                const v2u MTo = *(const LAS v2u*)(slot + CS_OFF_MT + lane * 8), Qo = *(const LAS v2u*)(slot + CS_OFF_Q + lane * 8), Po = *(const LAS v2u*)(slot + CS_OFF_P + lane * 8);
                const v2u Vo = *(const LAS v2u*)(slot + CS_OFF_V + (w * 64 + lane) * 8);
                const bf16x8 KB0 = *(const LAS bf16x8*)(slot + CS_OFF_KB + lane * 16), KB1 = *(const LAS bf16x8*)(slot + CS_OFF_KB + 1024 + lane * 16), KB2 = *(const LAS bf16x8*)(slot + CS_OFF_KB + 2048 + lane * 16), KB3 = *(const LAS bf16x8*)(slot + CS_OFF_KB + 3072 + lane * 16);
                pg8::f32x4 Gi[4];
#pragma unroll
                for (int i = 0; i < 4; ++i) Gi[i] = *(const LAS pg8::f32x4*)(slot + CS_OFF_G + (16 * fq + 4 * i) * 4);
                const v4u bs0 = (v4u){cvtpk_c(S0[0], S1[0]), cvtpk_c(S0[1], S1[1]), cvtpk_c(S0[2], S1[2]), cvtpk_c(S0[3], S1[3])};
                const v4u bs1 = (v4u){cvtpk_c(S2[0], S3[0]), cvtpk_c(S2[1], S3[1]), cvtpk_c(S2[2], S3[2]), cvtpk_c(S2[3], S3[3])};
                const bf16x8 BS0 = __builtin_bit_cast(bf16x8, bs0), BS1 = __builtin_bit_cast(bf16x8, bs1);
                const pg8::f32x4 c1 = mfma16(MTo, Vo, zero4);
                const pg8::f32x4 sa = mfma32(A11, BS1, mfma32(A10, BS0, c1));
                const v2u SAo = pack4(sa);
                pg8::f32x4 y = mfma32(RH1, BS1, mfma32(RH0, BS0, zero4));
                y = mfma16(Qo, Vo, y); y = mfma16(Po, SAo, y);
                const bf16x8 BV = __builtin_bit_cast(bf16x8, (v4u){Vo.x, Vo.y, SAo.x, SAo.y});
                pg8::f32x4 g0, g1, g2, g3;
#pragma unroll
                for (int i = 0; i < 4; ++i) { g0[i] = S0[i] * Gi[i][0]; g1[i] = S1[i] * Gi[i][1]; g2[i] = S2[i] * Gi[i][2]; g3[i] = S3[i] * Gi[i][3]; }
                S0 = mfma32(KB0, BV, g0); S1 = mfma32(KB1, BV, g1); S2 = mfma32(KB2, BV, g2); S3 = mfma32(KB3, BV, g3);
                { bf16* ysb = YS + ((size_t)d * MT + scan_row(blk * 16, b, d)) * 1024 + h * 64 + 16 * w;
#pragma unroll
                  for (int i = 0; i < 4; ++i) ysb[yoff[i]] = (bf16)(cvtpk_c(y[i], 0.f) & 0xffffu); }
            }
        }
        asm volatile("s_waitcnt lgkmcnt(0)" ::: "memory"); __builtin_amdgcn_s_barrier(); asm volatile("" ::: "memory");
    }
#undef CS_LOAD
    asm volatile("s_waitcnt vmcnt(0) lgkmcnt(0)" ::: "memory"); __syncthreads();
}

__device__ __forceinline__ void ph_rwkv_out(const Args& a, int l, int nrows, int gt, int NGT) {
    const bf16* OJ = (const bf16*)(a.ws + WS_OJ); bf16* YC = (bf16*)(a.ws + WS_Y3) + (size_t)2 * MT * 1024;
    const float* subln = a.in[I_SUBLN] + l * 128;
    float lam, lam_init;
    { const int lane = threadIdx.x & 63; const float* lv = a.in[I_LAM] + l * 256;
      float l1 = lv[lane] * lv[64 + lane], l2 = lv[128 + lane] * lv[192 + lane]; l1 = wave_sum(l1); l2 = wave_sum(l2);
      lam_init = 0.8f - 0.6f * __expf(-0.3f * (float)l); lam = __expf(l1) - __expf(l2) + lam_init;
      float gb = fabsf(a.in[I_QN][l * 64 + lane] * a.in[I_KN][l * 64 + lane]);
#pragma unroll
      for (int o_ = 1; o_ < 64; o_ <<= 1) gb = fmaxf(gb, __shfl_xor(gb, o_));
      if (gb > 8.f) lam = __builtin_nanf(""); }
    const bf16* LO = (const bf16*)(a.ws + WS_R1); const bf16* RK = (const bf16*)(a.ws + WS_RKVK); const bf16* YS = (const bf16*)(a.ws + WS_YS);
    bf16* YB = (bf16*)(a.ws + WS_Y3) + (size_t)MT * 1024;
    const float* ka = a.in[I_KA] + l * 1024; const float* rkw = a.in[I_RK] + l * 1024; const float* lng = a.in[I_LNG] + l * 1024; const float* lnb = a.in[I_LNB] + l * 1024;
    for (int i = gt; i < nrows * 128; i += 2 * NGT) {
        v4u L[2][11]; const bool two = i + NGT < nrows * 128;
#pragma unroll
        for (int s = 0; s < 2; ++s) if (s == 0 || two) { const int ii = i + s * NGT, m = ii >> 7, c0 = (ii & 127) * 8;
            L[s][0] = *(const GAS v4u*)(YS + (size_t)m * 1024 + c0); L[s][1] = *(const GAS v4u*)(YS + ((size_t)MT + m) * 1024 + c0);
            const GAS v4u* rp = (const GAS v4u*)(RK + (size_t)m * 4096 + c0 * 4);
            L[s][2] = rp[0]; L[s][3] = rp[1]; L[s][4] = rp[2]; L[s][5] = rp[3];
            const bf16* lo = LO + (size_t)m * LOW + c0;
            L[s][6] = *(const GAS v4u*)lo; L[s][7] = *(const GAS v4u*)(lo + 3072); L[s][8] = *(const GAS v4u*)(lo + 4096);
            L[s][9] = *(const GAS v4u*)(OJ + (size_t)m * 1024 + c0); L[s][10] = *(const GAS v4u*)(OJ + ((size_t)MT + m) * 1024 + c0); }
#pragma unroll
        for (int s = 0; s < 2; ++s) if (s == 0 || two) {
        const int ii = i + s * NGT, m = ii >> 7, c0 = (ii & 127) * 8;
        const v4u ya = L[s][0], yb = L[s][1], q0 = L[s][2], q1 = L[s][3], q2 = L[s][4], q3 = L[s][5], gw_ = L[s][6], aw0 = L[s][7], aw1 = L[s][8], pw = L[s][9], ow = L[s][10];
        float yA[8], yB[8], gv[8], a0v[8], a1v[8], pv[8], ov[8];
        unpack8(ya, yA); unpack8(yb, yB); unpack8(gw_, gv); unpack8(aw0, a0v); unpack8(aw1, a1v); unpack8(pw, pv); unpack8(ow, ov);
        float y[8]; float s1 = 0.f;
#pragma unroll
        for (int e = 0; e < 8; ++e) y[e] = yA[e] + yB[e];
#pragma unroll
        for (int e = 0; e < 8; ++e) s1 += y[e];
        s1 += __shfl_xor(s1, 1); s1 += __shfl_xor(s1, 2); s1 += __shfl_xor(s1, 4);
        const float mu = s1 * (1.f / 64.f); float s2 = 0.f;
#pragma unroll
        for (int e = 0; e < 8; ++e) { y[e] -= mu; s2 += y[e] * y[e]; }
        s2 += __shfl_xor(s2, 1); s2 += __shfl_xor(s2, 2); s2 += __shfl_xor(s2, 4);
        const float rstd = 1.f / sqrtf(s2 * (1.f / 64.f) + 64e-5f);
        float r[8], k[8], v[8];
        r[0] = bflo(q0.x); k[0] = bfhi(q0.x); v[0] = bflo(q0.y); r[1] = bflo(q0.z); k[1] = bfhi(q0.z); v[1] = bflo(q0.w);
        r[2] = bflo(q1.x); k[2] = bfhi(q1.x); v[2] = bflo(q1.y); r[3] = bflo(q1.z); k[3] = bfhi(q1.z); v[3] = bflo(q1.w);
        r[4] = bflo(q2.x); k[4] = bfhi(q2.x); v[4] = bflo(q2.y); r[5] = bflo(q2.z); k[5] = bfhi(q2.z); v[5] = bflo(q2.w);
        r[6] = bflo(q3.x); k[6] = bfhi(q3.x); v[6] = bflo(q3.y); r[7] = bflo(q3.z); k[7] = bfhi(q3.z); v[7] = bflo(q3.w);
        float am[8];
#pragma unroll
        for (int e = 0; e < 8; ++e) am[e] = 0.5f * (a0v[e] + a1v[e]);
        float rk = 0.f;
#pragma unroll
        for (int e = 0; e < 8; ++e) { const int c = c0 + e; rk += r[e] * (k[e] * (1.f + (am[e] - 1.f) * ka[c])) * rkw[c]; }
        rk += __shfl_xor(rk, 1); rk += __shfl_xor(rk, 2); rk += __shfl_xor(rk, 4);
        float o[8];
#pragma unroll
        for (int e = 0; e < 8; ++e) { const int c = c0 + e; o[e] = (y[e] * rstd * lng[c] + lnb[c] + rk * v[e]) * gv[e]; }
        *(GAS v4u*)(YB + (size_t)m * 1024 + c0) = pack8(o);
        { float d[8];
#pragma unroll
          for (int e = 0; e < 8; ++e) d[e] = pv[e] - lam * ov[e];
          float ss = 0.f;
#pragma unroll
          for (int e = 0; e < 8; ++e) ss += d[e] * d[e];
          ss += __shfl_xor(ss, 1); ss += __shfl_xor(ss, 2); ss += __shfl_xor(ss, 4); ss += __shfl_xor(ss, 8);
          const float rinv = (1.f - lam_init) / sqrtf(ss * (1.f / 128.f) + 1e-6f);
#pragma unroll
          for (int e = 0; e < 8; ++e) d[e] = d[e] * rinv * subln[(c0 & 127) + e];
          *(GAS v4u*)(YC + (size_t)m * 1024 + c0) = pack8(d); }
        }
    }
}

constexpr int PH_PER_LAYER = 14, NPH = 1 + NLAYER * PH_PER_LAYER;
#define IN(k) (lo <= (k) && (k) < hi)
#define SEAM(k) do { if (IN(k) && IN((k) + 1)) xcd_barrier(bar); } while (0)
#ifndef ONLY_PH
#define ONLY_PH -1
#endif
#define INL(k) ((ONLY_PH < 0 || ONLY_PH == (k)) && IN(pb + (k)))
#define SEAML(k) SEAM(pb + (k))
#ifndef PROBE_REP
#define PROBE_REP 0
#endif
#define REPL(k) for (int rep_ = 0; rep_ < (((PROBE_REP) >> (k)) & 1) + 1; ++rep_)
template <int l> __device__ __forceinline__ void layer_body(const Args& args, LAS unsigned char* lds, unsigned char* lds_raw, unsigned char* ws, const XcdBarrier& bar, int lo, int hi, int tid, int lane, int G, int bx, int vcu, int gw, int NGW, int gt, int NGT) {
        const int pb = 1 + l * PH_PER_LAYER;
        const bool last = (l == NLAYER - 1);
        float* XS = (float*)(ws + WS_XS); pg8::bf16_t* PART = (pg8::bf16_t*)(ws + WS_PART);
        const float* mods = (const float*)(ws + WS_MODS) + (size_t)l * 3 * NMOD * DM;
        const float* normg = args.in[I_NORMG] + (size_t)l * 3 * DM;
        pg8::bf16_t* XN = (pg8::bf16_t*)(ws + WS_XN);
        pg8::bf16_t* Hb = (pg8::bf16_t*)(ws + WS_R1);
        const float* xl0 = (l == 0) ? args.in[I_X] : XS; const float* xc0 = (l == 0) ? args.in[I_CTX] : XS + (size_t)NLAT * DM;

        if (INL(0)) REPL(0) ph_norm(xl0, xc0, normg, mods, 0, (bf16*)XN, XS, l == 0 ? nullptr : PART, 16, MT, gw, NGW, lane, (LAS float*)lds);
        SEAML(0);
        if (INL(1)) REPL(1) { pg8::Gemm g{XN, (const pg8::bf16_t*)(ws + WS_WF1 + (size_t)(l * 2 + 0) * SZ_WF1), MT, FF2, DM}; pg8::StaticOrder S; S.init(MT, FF2, G, bx);
            pg8::EpiSwiglu E{Hb, FF}; pg8::gemm_phase<pg8::EpiSwiglu, pg8::StaticOrder, true, true>(lds, g, S, E); }
        SEAML(1);
        if (INL(2)) REPL(2) { pg8::Gemm g{Hb, (const pg8::bf16_t*)(ws + WS_WF2 + (size_t)(l * 2 + 0) * SZ_WF2), MT, DM, FF}; pg8::SplitCtxOrder S{G, vcu, NLAT / 256, NCTX / 256, 16, FF / 64};
            pg8::EpiResid E{xl0, (long)((xc0 - (size_t)NLAT * DM) - xl0), XS, 0L, mods + 2 * DM, NMOD * DM, 0.5f, NLAT / 256, TSEQ / 256, PART, NCTX};
            pg8::gemm_phase<pg8::EpiResid, pg8::SplitCtxOrder, true, true>(lds, g, S, E); }
        SEAML(2);
        if (INL(3)) REPL(3) ph_norm(XS, XS + (size_t)NLAT * DM, normg + DM, mods, 3, (bf16*)XN, XS, PART, 16, MT, gw, NGW, lane, (LAS float*)lds);
        SEAML(3);
        if (INL(4)) REPL(4) { LAS float* ropel = (LAS float*)(lds + MISC_OFF + 256);
            for (int i = tid; i < 64 * 16 * 2; i += NTHR) ropel[i] = ((const float*)(ws + WS_ROPE))[i];
            __syncthreads();
            pg8::Gemm g{XN, (const pg8::bf16_t*)(ws + WS_WIN + (size_t)l * SZ_WIN), MT, PROJP, DM}; pg8::ProjOrder S; S.init(last ? NLAT : MT, PROJP, G, bx); S.skip_ctx = last ? 1 : 0;
            pg8::EpiProj E{(pg8::bf16_t*)(ws + WS_P), PROJP, (pg8::bf16_t*)(ws + WS_ACT), (pg8::bf16_t*)(ws + WS_QK), args.in[I_QN] + l * 64, args.in[I_KN] + l * 64, ropel, NLAT, TSEQ};
            pg8::gemm_phase<pg8::EpiProj, pg8::ProjOrder, true, true>(lds, g, S, E); }
        SEAML(4);
        if (INL(5)) REPL(5) { pg8::Gemm g{(const pg8::bf16_t*)(ws + WS_ACT), (const pg8::bf16_t*)(ws + WS_WLO + (size_t)l * SZ_WLO), MT, LOW, ACTW}; pg8::LoraOrder S; S.init(MT, LOW, G, bx);
            pg8::EpiLora E{(pg8::bf16_t*)(ws + WS_R1), args.in[I_W0] + l * 2048, args.in[I_A0] + l * 2048}; pg8::gemm_phase<pg8::EpiLora, pg8::LoraOrder, true, true>(lds, g, S, E);
            ph_e1(args, l, gt, NGT); }
        SEAML(5);
        if (INL(7)) REPL(7) {
            if (bx < 64) scan_unit(args, l, bx, lds, tid);
            else { int u0, ustep, uend, cu, gv, gn;
                if (G == 256) { const int ax = bx & 7, ar = (bx - 64) >> 3, li = (ar - 16) * 8 + ax;
                    u0 = 64 * ax + ar; ustep = 24; uend = 64 * ax + 64; cu = (!last && ar >= 16 && li < 32) ? li : -1;
                    gv = li; gn = ar >= 16 ? 64 : 0; }
                else { const int aw = G - 64, wi = bx - 64, light0 = 512 % aw, nl = aw - light0;
                    u0 = wi; ustep = aw; uend = 512; cu = (!last && wi >= light0 && wi - light0 < 32) ? wi - light0 : -1;
                    if (light0 == 0 || nl <= 0) { gv = wi; gn = aw; } else { gv = wi - light0; gn = wi >= light0 ? nl : 0; } }
                ph_attn(args, (char*)lds_raw, u0, ustep, uend, cu); __syncthreads();
                if (gn > 0) ph_gmlp(args, l, lds, tid, gv, gn); }
        }
        SEAML(7);
        if (INL(8)) REPL(8) ph_rwkv_out(args, l, last ? NLAT : MT, gt, NGT);
        SEAML(8);
        if (INL(9)) REPL(9) { pg8::Gemm g{(const pg8::bf16_t*)(ws + WS_Y3), (const pg8::bf16_t*)(ws + WS_WBR + (size_t)l * SZ_WBR), 3 * MT, 3 * DM, 1024}; pg8::MergeOrder S{G, bx, MT / 256, NLAT / 256, last ? 0 : (NCTX / 256) * 8 * 3};
            pg8::EpiMerge E{(const pg8::bf16_t*)(ws + WS_P) + P_GATE2, PROJP, args.in[I_BGATE] + (size_t)l * 3 * DM, (pg8::bf16_t*)(ws + WS_ZF), XN, MT / 256, (pg8::bf16_t*)(ws + WS_IMG), -(long)NLAT};
            pg8::gemm_phase<pg8::EpiMerge, pg8::MergeOrder, true, true>(lds, g, S, E); }
        SEAML(9);
        if (INL(10)) REPL(10) { pg8::Gemm g{XN, (const pg8::bf16_t*)(ws + WS_WOUT + (size_t)l * SZ_WOUT), MT, DM, DM}; pg8::SplitCtxOrder S{G, vcu, NLAT / 256, last ? 0 : NCTX / 256, 8, DM / 64};
            if (!last) { pg8::Unit uu;
                for (int i = 0; S.next(i, uu); ++i) if (uu.kn != 0) {
                    const int r0 = (uu.pm - NLAT / 256) * 256, k0 = uu.ks * 64, kw8 = uu.kn * 8;
                    const bf16* ZP = (const bf16*)(ws + WS_IMG); bf16* Zc = (bf16*)XN + (size_t)NLAT * DM;
                    for (int idx = tid; idx < 256 * kw8; idx += NTHR) { const int r = r0 + idx / kw8, k = k0 + (idx % kw8) * 8;
                        const v4u q0 = *(const GAS v4u*)(ZP + (size_t)r * DM + k), q1 = *(const GAS v4u*)(ZP + ((size_t)NCTX + r) * DM + k), q2 = *(const GAS v4u*)(ZP + ((size_t)2 * NCTX + r) * DM + k);
                        float f0[8], f1[8], f2[8]; unpack8(q0, f0); unpack8(q1, f1); unpack8(q2, f2);
#pragma unroll
                        for (int e = 0; e < 8; ++e) f0[e] = (f0[e] + f1[e]) + f2[e];
                        *(GAS v4u*)(Zc + (size_t)r * DM + k) = pack8(f0); } }
                asm volatile("s_waitcnt vmcnt(0)" ::: "memory"); __syncthreads(); }
            pg8::EpiResid E{XS, 0L, XS, 0L, mods + 5 * DM, NMOD * DM, 1.0f, NLAT / 256, TSEQ / 256, PART, NCTX};
            pg8::gemm_phase<pg8::EpiResid, pg8::SplitCtxOrder, true, true>(lds, g, S, E); }
        SEAML(10);
        if (INL(11)) REPL(11) ph_norm(XS, XS + (size_t)NLAT * DM, normg + 2 * DM, mods, 6, (bf16*)XN, XS, PART, 8, last ? NLAT : MT, gw, NGW, lane, (LAS float*)lds);
        SEAML(11);
        if (INL(12)) REPL(12) { pg8::Gemm g{XN, (const pg8::bf16_t*)(ws + WS_WF1 + (size_t)(l * 2 + 1) * SZ_WF1), MT, FF2, DM}; pg8::StaticOrder S; S.init(last ? NLAT : MT, FF2, G, bx);
            pg8::EpiSwiglu E{Hb, FF}; pg8::gemm_phase<pg8::EpiSwiglu, pg8::StaticOrder, true, true>(lds, g, S, E); }
        SEAML(12);
        if (INL(13)) REPL(13) { pg8::Gemm g{Hb, (const pg8::bf16_t*)(ws + WS_WF2 + (size_t)(l * 2 + 1) * SZ_WF2), MT, DM, FF}; pg8::SplitCtxOrder S{G, vcu, NLAT / 256, last ? 0 : NCTX / 256, 16, FF / 64};
            pg8::EpiResid E{XS, 0L, last ? args.out : XS, 0L, mods + 8 * DM, NMOD * DM, 0.5f, NLAT / 256, TSEQ / 256, PART, NCTX};
            pg8::gemm_phase<pg8::EpiResid, pg8::SplitCtxOrder, true, true>(lds, g, S, E); }
        SEAML(13);
    }
__global__ void __launch_bounds__(NTHR, 2) fwd(Args args) {
    extern __shared__ __attribute__((aligned(16))) unsigned char lds_raw[];
    LAS unsigned char* lds = (LAS unsigned char*)lds_raw;
    const int tid = threadIdx.x, lane = tid & 63, wave = __builtin_amdgcn_readfirstlane(tid >> 6);
    const int G = gridDim.x; const int bx = blockIdx.x; const int vcu = (G % 8 == 0) ? (bx % 8) * (G / 8) + bx / 8 : bx;
    const int gw = vcu * NWAVES + wave, NGW = G * NWAVES, gt = vcu * NTHR + tid, NGT = G * NTHR;
    unsigned char* ws = args.ws;
    volatile LAS unsigned* MISC = (volatile LAS unsigned*)(lds + MISC_OFF);
    for (int u = tid; u < (LDS_BYTES - LDSCTL_OFF) / 4; u += NTHR) ((LAS unsigned*)(lds + LDSCTL_OFF))[u] = 0u;
    __syncthreads();
    const int lo = args.ph_lo, hi = args.ph_hi;
    const bool multi = (hi - lo) > 1;
    XcdBarrier bar; bar.bar = (unsigned*)(ws + WS_CTL) + CW_BAR; bar.x = 0; bar.st = nullptr;
    if (multi) bar = xcd_barrier_post((unsigned*)(ws + WS_CTL) + CW_BAR, MISC + 8);

    if ((ONLY_PH < 0 || ONLY_PH == 100) && IN(0)) REPL(16) {
        ph_ada(args, lds, tid, vcu, G); __syncthreads(); ph_weights(args, 0, lds, tid, vcu, G); ph_weights(args, 1, lds, tid, vcu, G); ph_small(args, tid, vcu, G); }
    SEAM(0);

    layer_body<0>(args, lds, lds_raw, ws, bar, lo, hi, tid, lane, G, bx, vcu, gw, NGW, gt, NGT);
    layer_body<1>(args, lds, lds_raw, ws, bar, lo, hi, tid, lane, G, bx, vcu, gw, NGW, gt, NGT);
#undef IN
#undef SEAM
}

#ifndef MK_PER_PHASE
#define MK_PER_PHASE 0
#endif
extern "C" void kernel_launch(void* const* d_in, const int* in_sizes, int n_in, void* d_out, int out_size, void* d_ws, size_t ws_size, hipStream_t stream) {
    static int grid = 0;
    if (grid == 0) {
        if (n_in != 31 || in_sizes[0] != NLAT * DM || out_size != NLAT * DM || ws_size < WS_END) {
            fprintf(stderr, "kernel_launch: unexpected shapes: n_in %d in0 %d out %d ws %zu (need %zu); nothing launched\n", n_in, n_in > 0 ? in_sizes[0] : -1, out_size, ws_size, (size_t)WS_END); grid = -1; return; }
        int dev = 0, cus = 0, per_cu = 0;
        if (hipGetDevice(&dev) != hipSuccess || hipDeviceGetAttribute(&cus, hipDeviceAttributeMultiprocessorCount, dev) != hipSuccess) { grid = -1; return; }
        if (hipFuncSetAttribute((const void*)fwd, hipFuncAttributeMaxDynamicSharedMemorySize, LDS_BYTES) != hipSuccess) { fprintf(stderr, "kernel_launch: hipFuncSetAttribute failed\n"); grid = -1; return; }
        if (hipOccupancyMaxActiveBlocksPerMultiprocessor(&per_cu, (const void*)fwd, NTHR, LDS_BYTES) != hipSuccess || per_cu < 1) fprintf(stderr, "kernel_launch: occupancy query says %d\n", per_cu);
        (void)hipGetLastError();
        grid = cus;
    }
    if (grid < 0) return;
    (void)hipMemsetAsync((char*)d_ws + WS_CTL, 0, CTL_ZERO_BYTES, stream);
    Args a{};
    for (int i = 0; i < 31; ++i) a.in[i] = (const float*)d_in[i];
    a.out = (float*)d_out; a.ws = (unsigned char*)d_ws;
#if MK_PER_PHASE
    for (int p = 0; p < NPH; ++p) { a.ph_lo = p; a.ph_hi = p + 1; hipLaunchKernelGGL(fwd, dim3(grid), dim3(NTHR), LDS_BYTES, stream, a); }
#else
    a.ph_lo = 0; a.ph_hi = NPH; hipLaunchKernelGGL(fwd, dim3(grid), dim3(NTHR), LDS_BYTES, stream, a);
#endif
}
```
